# Optimizing an MI355X kernel written in HIP

```python
import math
import jax, jax.numpy as jnp
from jax import lax
import numpy as np

D_MODEL = 1024
BATCH = 2
SEQ = 8192
DEPTH = 2

CHUNK = 64
EPS = 1e-6
N_BRANCHES = 2
D_CONV = D_MODEL
CONV_KERNEL = 31
D_POOL = D_MODEL
POOL_WINDOWS = (2, 4, 8, 16)
N_POOL_GROUPS = len(POOL_WINDOWS)
POOL_GROUP = D_POOL // N_POOL_GROUPS
D_IN = 2 * D_CONV + D_POOL + N_BRANCHES * D_MODEL
N_MOD = 6
PEER_HEADS = 8
PEER_NKEYS = 128
PEER_EXPERTS = PEER_NKEYS * PEER_NKEYS
PEER_DKEY = 256
PEER_DHALF = PEER_DKEY // 2
PEER_TOPK = 16
PEER_BLOCK = 128

kernel_name = "hybrid_gated_conv_pool_peer_encoder"


def _rmsnorm(x, g):
    x32 = x.astype(jnp.float32)
    y = x32 * lax.rsqrt(jnp.mean(x32 * x32, axis=-1, keepdims=True) + EPS)
    return (y * g.astype(jnp.float32)).astype(x.dtype)


def _modulate(h, shift, scale):
    return h * (1 + scale[:, None, :]) + shift[:, None, :]


def _conv_branch(val, gate, conv_w, conv_b, ln_g, ln_b, w_co):
    u = val * jax.nn.sigmoid(gate)
    u = lax.conv_general_dilated(
        u, conv_w[:, None, :], window_strides=(1,),
        padding=[(CONV_KERNEL - 1, 0)],
        dimension_numbers=("NWC", "WIO", "NWC"),
        feature_group_count=D_CONV) + conv_b
    u32 = u.astype(jnp.float32)
    mu = jnp.mean(u32, axis=-1, keepdims=True)
    var = jnp.mean(jnp.square(u32 - mu), axis=-1, keepdims=True)
    u = ((u32 - mu) * lax.rsqrt(var + EPS) * ln_g.astype(jnp.float32)
         + ln_b.astype(jnp.float32)).astype(val.dtype)
    return jax.nn.silu(u) @ w_co


def _causal_pool(p):
    B, S, _ = p.shape
    p32 = p.astype(jnp.float32)
    csp = jnp.concatenate([jnp.zeros((B, 1, D_POOL), jnp.float32), jnp.cumsum(p32, axis=1)], axis=1)
    t = jnp.arange(S)
    outs = []
    for g, w in enumerate(POOL_WINDOWS):
        lo, hi = g * POOL_GROUP, (g + 1) * POOL_GROUP
        sl = csp[..., lo:hi]
        upper = sl[:, 1:]
        lower = jnp.concatenate([jnp.zeros((B, w - 1, POOL_GROUP), jnp.float32), sl[:, :S + 1 - w]], axis=1)
        cnt = jnp.minimum(t + 1, w).astype(jnp.float32)
        outs.append((upper - lower) / cnt[None, :, None] - p32[..., lo:hi])
    return jnp.stack(outs, axis=2).astype(p.dtype)


def _peer(h, wq, keys, u_tab, v_tab):
    B, S, D = h.shape
    tokens = h.reshape(-1, PEER_BLOCK, D)

    def block(ht):
        T = ht.shape[0]
        q = (ht @ wq).reshape(T, PEER_HEADS, 2, PEER_DHALF)
        s = jnp.einsum("thpk,hpnk->thpn", q, keys).astype(jnp.float32)
        sv, si = lax.top_k(s, PEER_TOPK)
        cand = sv[:, :, 0, :, None] + sv[:, :, 1, None, :]
        cv, ci = lax.top_k(cand.reshape(T, PEER_HEADS, PEER_TOPK * PEER_TOPK), PEER_TOPK)
        i1 = jnp.take_along_axis(si[:, :, 0], ci // PEER_TOPK, axis=-1)
        i2 = jnp.take_along_axis(si[:, :, 1], ci % PEER_TOPK, axis=-1)
        expert = i1 * PEER_NKEYS + i2
        gw = jax.nn.softmax(cv, axis=-1).astype(ht.dtype)
        u_sel = u_tab[expert]
        v_sel = v_tab[expert]
        act = jax.nn.gelu(jnp.einsum("thkd,td->thk", u_sel, ht), approximate=False)
        return jnp.einsum("thk,thkd->td", gw * act, v_sel)

    return lax.map(block, tokens).reshape(B, S, D)


def setup_inputs(seed: int = 0) -> dict:
    key = jax.random.key(seed)
    ks = jax.random.split(key, 24)
    f32 = jnp.float32
    L, D = DEPTH, D_MODEL
    nrm = lambda k, shape, s: jax.random.normal(k, shape, f32) * s
    return {
        "x": nrm(ks[0], (BATCH, SEQ, D), 1.0),
        "c": nrm(ks[1], (BATCH, D), 1.0),
        "ada_w": nrm(ks[2], (L, D, N_MOD * D), 0.5 * D ** -0.5),
        "ada_b": nrm(ks[3], (L, N_MOD * D), 0.02),
        "norm1_g": 1.0 + nrm(ks[4], (L, D), 0.05),
        "w_in": nrm(ks[5], (L, D, D_IN), D ** -0.5),
        "b_in": nrm(ks[6], (L, D_IN), 0.02),
        "conv_w": nrm(ks[7], (L, CONV_KERNEL, D_CONV), CONV_KERNEL ** -0.5),
        "conv_b": nrm(ks[8], (L, D_CONV), 0.02),
        "conv_ln_g": 1.0 + nrm(ks[9], (L, D_CONV), 0.05),
        "conv_ln_b": nrm(ks[10], (L, D_CONV), 0.02),
        "w_conv_out": nrm(ks[11], (L, D_CONV, D), D_CONV ** -0.5),
        "pool_w": nrm(ks[12], (L, N_POOL_GROUPS, POOL_GROUP, POOL_GROUP), POOL_GROUP ** -0.5),
        "pool_scale": 0.5 + nrm(ks[13], (L, D_POOL), 0.1),
        "w_out": nrm(ks[14], (L, D, D), D ** -0.5),
        "b_out": nrm(ks[15], (L, D), 0.02),
        "norm2_g": 1.0 + nrm(ks[16], (L, D), 0.05),
        "peer_wq": nrm(ks[17], (L, D, PEER_HEADS * PEER_DKEY), D ** -0.5),
        "peer_keys": nrm(ks[18], (L, PEER_HEADS, 2, PEER_NKEYS, PEER_DHALF), PEER_DHALF ** -0.5),
        "peer_u": nrm(ks[19], (L, PEER_EXPERTS, D), D ** -0.5),
        "peer_v": nrm(ks[20], (L, PEER_EXPERTS, D), 1.0),
        "final_g": 1.0 + nrm(ks[21], (D,), 0.05),
    }


def reference(x, c, ada_w, ada_b, norm1_g, w_in, b_in, conv_w, conv_b, conv_ln_g, conv_ln_b,
              w_conv_out, pool_w, pool_scale, w_out, b_out, norm2_g, peer_wq, peer_keys,
              peer_u, peer_v, final_g):
    B, S, D = x.shape
    c_act = jax.nn.silu(c)
    for l in range(DEPTH):
        mod = c_act @ ada_w[l] + ada_b[l]
        sh1, sc1, g1, sh2, sc2, g2 = jnp.split(mod, N_MOD, axis=-1)

        h = _modulate(_rmsnorm(x, norm1_g[l]), sh1, sc1)
        z = h @ w_in[l] + b_in[l]
        za, zb, zp, zg = jnp.split(z, [D_CONV, 2 * D_CONV, 2 * D_CONV + D_POOL], axis=-1)
        conv_out = _conv_branch(za, zb, conv_w[l], conv_b[l], conv_ln_g[l], conv_ln_b[l], w_conv_out[l])
        pooled = _causal_pool(zp)
        pool_out = jnp.einsum("bsgc,gcd->bsgd", pooled, pool_w[l]).reshape(B, S, D_POOL) * pool_scale[l]
        gates = jax.nn.sigmoid(zg).reshape(B, S, N_BRANCHES, D)
        y = gates[:, :, 0] * conv_out + gates[:, :, 1] * pool_out
        x = x + g1[:, None, :] * (y @ w_out[l] + b_out[l])

        h = _modulate(_rmsnorm(x, norm2_g[l]), sh2, sc2)
        x = x + g2[:, None, :] * _peer(h, peer_wq[l], peer_keys[l], peer_u[l], peer_v[l])
    return _rmsnorm(x, final_g)
```

```cpp
#include <hip/hip_runtime.h>
#include <cstdint>
#include <cstdio>

#define GAS __attribute__((address_space(1)))
#define LAS __attribute__((address_space(3)))
typedef unsigned short bf16;
typedef float f32x4 __attribute__((ext_vector_type(4)));
typedef float f32x2 __attribute__((ext_vector_type(2)));
typedef unsigned u32x4 __attribute__((ext_vector_type(4)));
typedef unsigned u32x2 __attribute__((ext_vector_type(2)));
typedef __bf16 bf16x2_t __attribute__((ext_vector_type(2)));

constexpr int BATCH = 2, SEQ = 8192, D = 1024, M = BATCH * SEQ, DEPTH = 2;
constexpr int DIN = 5120, NMODV = 6 * D, CONVK = 31, NHEAD = 8, NKEYS = 128, DQ = 2048, TOPK = 16, NEXP = 16384;
constexpr float EPS = 1e-6f;
constexpr int NWAVES = 8, NTHREADS = NWAVES * 64;

constexpr size_t MiB = 1u << 20;
constexpr size_t WS_CTL = 0;
constexpr size_t WS_MODP = 1 * MiB;
constexpr size_t WS_MOD = 4 * MiB;
constexpr size_t WS_WIN = 8 * MiB;
constexpr size_t WS_WCO = 28 * MiB;
constexpr size_t WS_WOUT = 32 * MiB;
constexpr size_t WS_WQ = 36 * MiB;
constexpr size_t WS_POOL = 44 * MiB;
constexpr size_t WS_KEYS = 45 * MiB;
constexpr size_t WS_UB = 48 * MiB;
constexpr size_t WS_VB = 112 * MiB;
constexpr size_t WS_H = 176 * MiB;
constexpr size_t WS_UG = 208 * MiB;
constexpr size_t WS_Y = WS_UG;
constexpr size_t WS_ZP = 240 * MiB;
constexpr size_t WS_TMP = WS_ZP;
constexpr size_t WS_Q = WS_UG;
constexpr size_t WS_G = 272 * MiB;
constexpr size_t WS_AC = 336 * MiB;
constexpr size_t WS_PL = 368 * MiB;
constexpr size_t WS_S = WS_G;
constexpr size_t WS_EID = 400 * MiB;
constexpr size_t WS_GW = 408 * MiB;
constexpr size_t WS_END = 416 * MiB;

constexpr int LDS_BYTES = 147456;

__device__ __forceinline__ unsigned f2bf(float f) { unsigned u = __builtin_bit_cast(unsigned, f); return (u + 0x7fffu + ((u >> 16) & 1u)) >> 16; }
__device__ __forceinline__ unsigned pk2(float lo, float hi) { return f2bf(lo) | (f2bf(hi) << 16); }
__device__ __forceinline__ float bflo(unsigned w) { return __builtin_bit_cast(float, w << 16); }
__device__ __forceinline__ float bfhi(unsigned w) { return __builtin_bit_cast(float, w & 0xffff0000u); }
__device__ __forceinline__ float sigm(float x) { return 1.f / (1.f + __expf(-x)); }
__device__ __forceinline__ float wave_sum(float v) {
#pragma unroll
    for (int o = 1; o < 64; o <<= 1) v += __shfl_xor(v, o);
    return v;
}
__device__ __forceinline__ float wave_max(float v) {
#pragma unroll
    for (int o = 1; o < 64; o <<= 1) v = fmaxf(v, __shfl_xor(v, o));
    return v;
}
__device__ __forceinline__ u32x4 pack8(const f32x4& a, const f32x4& b) { u32x4 w; w.x = pk2(a.x, a.y); w.y = pk2(a.z, a.w); w.z = pk2(b.x, b.y); w.w = pk2(b.z, b.w); return w; }
__device__ __forceinline__ void unpack8(const u32x4& w, f32x4& a, f32x4& b) { a = (f32x4){bflo(w.x), bfhi(w.x), bflo(w.y), bfhi(w.y)}; b = (f32x4){bflo(w.z), bfhi(w.z), bflo(w.w), bfhi(w.w)}; }

struct Ctx { int tid, lane, wave, gw, ngw, nblk, blk; LAS unsigned char* lds; };

struct Args { const float* in[22]; float* out; unsigned char* ws; int ph_lo, ph_hi; };
enum { I_X = 0, I_C, I_ADAW, I_ADAB, I_N1G, I_WIN, I_BIN, I_CONVW, I_CONVB, I_LNG, I_LNB, I_WCO, I_POOLW, I_POOLS, I_WOUT, I_BOUT, I_N2G, I_WQ, I_KEYS, I_PU, I_PV, I_FG };

__device__ __forceinline__ void transpose_item(const float* W, int K, int N, int k0, int n0, bf16* WT, int dstrow0, LAS float* scr, int lane) {
#pragma unroll 8
    for (int i = 0; i < 32; ++i) { const int kk = 2 * i + (lane >> 5); scr[kk * 33 + (lane & 31)] = W[(size_t)(k0 + kk) * N + n0 + (lane & 31)]; }
    asm volatile("s_waitcnt lgkmcnt(0)" ::: "memory");
    const int c = lane & 7;
#pragma unroll
    for (int j = 0; j < 4; ++j) { const int n = (lane >> 3) + 8 * j; const LAS float* s = scr + (8 * c) * 33 + n;
        u32x4 o; o.x = pk2(s[0 * 33], s[1 * 33]); o.y = pk2(s[2 * 33], s[3 * 33]); o.z = pk2(s[4 * 33], s[5 * 33]); o.w = pk2(s[6 * 33], s[7 * 33]);
        *(u32x4*)(WT + (size_t)(dstrow0 + n) * K + k0 + 8 * c) = o; }
    asm volatile("s_waitcnt lgkmcnt(0)" ::: "memory");
}
__device__ __forceinline__ int win_dstrow(int n0) {
    if (n0 < 1024) return 256 * (n0 >> 7) + (n0 & 127);
    if (n0 < 2048) { const int c = n0 - 1024; return 256 * (c >> 7) + 128 + (c & 127); }
    return n0;
}
__device__ __forceinline__ void phase_prep(const Ctx& C, const Args& a) {
    unsigned char* ws = a.ws;
    LAS float* scr = (LAS float*)(C.lds + C.wave * 16384);
    constexpr int I_IN = 16 * 160, I_CO = 16 * 32, I_PO = 4 * (4 * 8), I_OUT = 16 * 32, I_Q = 16 * 64, I_L = I_IN + I_CO + I_PO + I_OUT + I_Q;
    for (int it = C.gw; it < DEPTH * I_L; it += C.ngw) {
        const int l = it / I_L; int r = it % I_L;
        if (r < I_IN) { const int kb = r / 160, nb = r % 160; transpose_item(a.in[I_WIN] + (size_t)l * D * DIN, D, DIN, 64 * kb, 32 * nb, (bf16*)(ws + WS_WIN) + (size_t)l * DIN * D, win_dstrow(32 * nb), scr, C.lane); continue; } r -= I_IN;
        if (r < I_CO) { const int kb = r / 32, nb = r % 32; transpose_item(a.in[I_WCO] + (size_t)l * D * D, D, D, 64 * kb, 32 * nb, (bf16*)(ws + WS_WCO) + (size_t)l * D * D, 32 * nb, scr, C.lane); continue; } r -= I_CO;
        if (r < I_PO) { const int g = r / 32, q = r % 32, kb = q / 8, nb = q % 8; transpose_item(a.in[I_POOLW] + ((size_t)l * 4 + g) * 256 * 256, 256, 256, 64 * kb, 32 * nb, (bf16*)(ws + WS_POOL) + ((size_t)l * 1024 + 256 * g) * 256, 32 * nb, scr, C.lane); continue; } r -= I_PO;
        if (r < I_OUT) { const int kb = r / 32, nb = r % 32; transpose_item(a.in[I_WOUT] + (size_t)l * D * D, D, D, 64 * kb, 32 * nb, (bf16*)(ws + WS_WOUT) + (size_t)l * D * D, 32 * nb, scr, C.lane); continue; } r -= I_OUT;
        { const int kb = r / 64, nb = r % 64; transpose_item(a.in[I_WQ] + (size_t)l * D * DQ, D, DQ, 64 * kb, 32 * nb, (bf16*)(ws + WS_WQ) + (size_t)l * DQ * D, 32 * nb, scr, C.lane); }
    }
    const int gt = C.blk * NTHREADS + C.tid, ngt = C.nblk * NTHREADS;
    for (int i = gt; i < DEPTH * 2048 * 32; i += ngt) {
        const int l = i / (2048 * 32), r = i % (2048 * 32), n = r / 32, k8 = (r % 32) * 8;
        const int h = n >> 8, p = (n >> 7) & 1, key = n & 127, pk = k8 >> 7, kk = k8 & 127;
        u32x4 o = (u32x4){0u, 0u, 0u, 0u};
        if (pk == p) { const float* s = a.in[I_KEYS] + ((((size_t)l * 8 + h) * 2 + p) * 128 + key) * 128 + kk; const f32x4 v0 = *(const f32x4*)s, v1 = *(const f32x4*)(s + 4); o = pack8(v0, v1); }
        *(u32x4*)((bf16*)(ws + WS_KEYS) + ((size_t)l * 2048 + n) * 256 + k8) = o;
    }
    for (int t = 0; t < 2; ++t) {
        const float* src = a.in[t == 0 ? I_PU : I_PV]; bf16* dst = (bf16*)(ws + (t == 0 ? WS_UB : WS_VB));
        for (size_t i = gt; i < (size_t)DEPTH * NEXP * D / 8; i += ngt) { const f32x4 v0 = *(const f32x4*)(src + i * 8), v1 = *(const f32x4*)(src + i * 8 + 4); *(u32x4*)(dst + i * 8) = pack8(v0, v1); }
    }
    for (int it = gt; it < 32 * 3072; it += ngt) {
        const int ks = it / 3072, cg = it % 3072, l = cg / 1536, n4 = (cg % 1536) * 4;
        f32x4 a0 = (f32x4){0.f, 0.f, 0.f, 0.f}, a1 = a0;
        const float* wp = a.in[I_ADAW] + ((size_t)l * D + ks * 32) * NMODV + n4; const float* c0 = a.in[I_C] + ks * 32; const float* c1 = c0 + D;
#pragma unroll 8
        for (int kk = 0; kk < 32; ++kk) { const f32x4 w = *(const f32x4*)(wp + (size_t)kk * NMODV); const float x0 = c0[kk], x1 = c1[kk]; a0 += w * (x0 * sigm(x0)); a1 += w * (x1 * sigm(x1)); }
        float* mp = (float*)(ws + WS_MODP) + (((size_t)ks * 2 + l) * 2) * NMODV + n4;
        *(f32x4*)mp = a0; *(f32x4*)(mp + NMODV) = a1;
    }
}
__device__ __forceinline__ void phase_modreduce(const Ctx& C, const Args& a) {
    const int gt = C.blk * NTHREADS + C.tid, ngt = C.nblk * NTHREADS;
    for (int i = gt; i < 2 * 2 * NMODV; i += ngt) {
        const int l = i / (2 * NMODV), n = i % NMODV; float s = a.in[I_ADAB][(size_t)l * NMODV + n];
        const float* mp = (const float*)(a.ws + WS_MODP) + i;
        for (int ks = 0; ks < 32; ++ks) s += mp[(size_t)ks * 4 * NMODV];
        ((float*)(a.ws + WS_MOD))[i] = s;
    }
}
__device__ __forceinline__ const float* modp(const Args& a, int l, int b, int v) { return (const float*)(a.ws + WS_MOD) + ((size_t)l * 2 + b) * NMODV + v * D; }

__device__ __forceinline__ void normmod_row(const f32x4 (&x)[4], const float* g, const float* sh, const float* sc, int lane, f32x4 (&h)[4]) {
    float s = 0.f;
#pragma unroll
    for (int j = 0; j < 4; ++j) s += (x[j].x * x[j].x + x[j].y * x[j].y) + (x[j].z * x[j].z + x[j].w * x[j].w);
    const float rstd = 1.f / sqrtf(wave_sum(s) * (1.f / D) + EPS);
#pragma unroll
    for (int j = 0; j < 4; ++j) { const int c = 4 * lane + 256 * j; const f32x4 gv = *(const f32x4*)(g + c), shv = *(const f32x4*)(sh + c), scv = *(const f32x4*)(sc + c);
        h[j] = (x[j] * rstd) * gv * (scv + 1.f) + shv; }
}
__device__ __forceinline__ void store_row_bf16(bf16* row, const f32x4 (&h)[4], int lane) {
#pragma unroll
    for (int j = 0; j < 4; ++j) { u32x2 w; w.x = pk2(h[j].x, h[j].y); w.y = pk2(h[j].z, h[j].w); *(u32x2*)(row + 4 * lane + 256 * j) = w; }
}
__device__ __forceinline__ void phase_norm(const Ctx& C, const Args& a, const float* X, const float* g, int l, int vsh, int vsc) {
    bf16* H = (bf16*)(a.ws + WS_H);
    for (int m = C.gw; m < M; m += C.ngw) {
        const int b = m >> 13; f32x4 x[4], h[4];
#pragma unroll
        for (int j = 0; j < 4; ++j) x[j] = *(const f32x4*)(X + (size_t)m * D + 4 * C.lane + 256 * j);
        normmod_row(x, g, modp(a, l, b, vsh), modp(a, l, b, vsc), C.lane, h);
        store_row_bf16(H + (size_t)m * D, h, C.lane);
    }
}

struct EpiIn {
    const float* bin; bf16 *UG, *ZP, *G;
    __device__ __forceinline__ void apply(int row, int pn, int cl8, f32x4 a0, f32x4 a1, f32x4 b0, f32x4 b1) const {
        if (pn < 8) {
            const int c = 128 * pn + cl8;
            a0 += *(const f32x4*)(bin + c); a1 += *(const f32x4*)(bin + c + 4); b0 += *(const f32x4*)(bin + 1024 + c); b1 += *(const f32x4*)(bin + 1024 + c + 4);
            f32x4 u0, u1;
#pragma unroll
            for (int i = 0; i < 4; ++i) { u0[i] = a0[i] * sigm(b0[i]); u1[i] = a1[i] * sigm(b1[i]); }
            *(u32x4*)(UG + (size_t)row * D + c) = pack8(u0, u1);
        } else if (pn < 12) {
            const int c = 256 * (pn - 8) + cl8;
            a0 += *(const f32x4*)(bin + 2048 + c); a1 += *(const f32x4*)(bin + 2048 + c + 4); b0 += *(const f32x4*)(bin + 2048 + 128 + c); b1 += *(const f32x4*)(bin + 2048 + 128 + c + 4);
            *(u32x4*)(ZP + (size_t)row * D + c) = pack8(a0, a1); *(u32x4*)(ZP + (size_t)row * D + c + 128) = pack8(b0, b1);
        } else {
            const int c = 256 * (pn - 12) + cl8;
            a0 += *(const f32x4*)(bin + 3072 + c); a1 += *(const f32x4*)(bin + 3072 + c + 4); b0 += *(const f32x4*)(bin + 3072 + 128 + c); b1 += *(const f32x4*)(bin + 3072 + 128 + c + 4);
#pragma unroll
            for (int i = 0; i < 4; ++i) { a0[i] = sigm(a0[i]); a1[i] = sigm(a1[i]); b0[i] = sigm(b0[i]); b1[i] = sigm(b1[i]); }
            *(u32x4*)(G + (size_t)row * 2048 + c) = pack8(a0, a1); *(u32x4*)(G + (size_t)row * 2048 + c + 128) = pack8(b0, b1);
        }
    }
};
struct EpiPool {
    const bf16* G; const float* scale; bf16* TMP;
    __device__ __forceinline__ void apply(int row, int pn, int cl8, f32x4 a0, f32x4 a1, f32x4 b0, f32x4 b1) const {
        const int c = 256 * pn + cl8; f32x4 g0, g1;
        unpack8(*(const u32x4*)(G + (size_t)row * 2048 + 1024 + c), g0, g1);
        a0 = a0 * g0 * *(const f32x4*)(scale + c); a1 = a1 * g1 * *(const f32x4*)(scale + c + 4);
        *(u32x4*)(TMP + (size_t)row * D + c) = pack8(a0, a1);
        unpack8(*(const u32x4*)(G + (size_t)row * 2048 + 1024 + c + 128), g0, g1);
        b0 = b0 * g0 * *(const f32x4*)(scale + c + 128); b1 = b1 * g1 * *(const f32x4*)(scale + c + 132);
        *(u32x4*)(TMP + (size_t)row * D + c + 128) = pack8(b0, b1);
    }
};
struct EpiConv {
    const bf16* G; const bf16* TMP; bf16* Y;
    __device__ __forceinline__ void apply(int row, int pn, int cl8, f32x4 a0, f32x4 a1, f32x4 b0, f32x4 b1) const {
        const int c = 256 * pn + cl8; f32x4 g0, g1, t0, t1;
        unpack8(*(const u32x4*)(G + (size_t)row * 2048 + c), g0, g1); unpack8(*(const u32x4*)(TMP + (size_t)row * D + c), t0, t1);
        *(u32x4*)(Y + (size_t)row * D + c) = pack8(a0 * g0 + t0, a1 * g1 + t1);
        unpack8(*(const u32x4*)(G + (size_t)row * 2048 + c + 128), g0, g1); unpack8(*(const u32x4*)(TMP + (size_t)row * D + c + 128), t0, t1);
        *(u32x4*)(Y + (size_t)row * D + c + 128) = pack8(b0 * g0 + t0, b1 * g1 + t1);
    }
};
struct EpiOut {
    const float* xold; float* xnew; const float* g1;   const float* bout;
    __device__ __forceinline__ void apply(int row, int pn, int cl8, f32x4 a0, f32x4 a1, f32x4 b0, f32x4 b1) const {
        const int c = 256 * pn + cl8; const float* g = g1 + (size_t)(row >> 13) * NMODV; const size_t o = (size_t)row * D + c;
        *(f32x4*)(xnew + o) = *(const f32x4*)(xold + o) + *(const f32x4*)(g + c) * (a0 + *(const f32x4*)(bout + c));
        *(f32x4*)(xnew + o + 4) = *(const f32x4*)(xold + o + 4) + *(const f32x4*)(g + c + 4) * (a1 + *(const f32x4*)(bout + c + 4));
        *(f32x4*)(xnew + o + 128) = *(const f32x4*)(xold + o + 128) + *(const f32x4*)(g + c + 128) * (b0 + *(const f32x4*)(bout + c + 128));
        *(f32x4*)(xnew + o + 132) = *(const f32x4*)(xold + o + 132) + *(const f32x4*)(g + c + 132) * (b1 + *(const f32x4*)(bout + c + 132));
    }
};
struct EpiQ {
    bf16* Q;
    __device__ __forceinline__ void apply(int row, int pn, int cl8, f32x4 a0, f32x4 a1, f32x4 b0, f32x4 b1) const {
        const size_t o = (size_t)row * DQ + 256 * pn + cl8; *(u32x4*)(Q + o) = pack8(a0, a1); *(u32x4*)(Q + o + 128) = pack8(b0, b1);
    }
};
struct EpiS {
    float* S;
    __device__ __forceinline__ void apply(int row, int pn, int cl8, f32x4 a0, f32x4 a1, f32x4 b0, f32x4 b1) const {
        const size_t o = (size_t)row * DQ + 256 * pn + cl8; *(f32x4*)(S + o) = a0; *(f32x4*)(S + o + 4) = a1; *(f32x4*)(S + o + 128) = b0; *(f32x4*)(S + o + 132) = b1;
    }
};

template <class F>
__device__ __forceinline__ void naive_gemm(const Ctx& C, const bf16* A, int lda, int acol, const bf16* Bt, int ldb, int Mr, int N, int K, const F& f) {
    LAS float* As = (LAS float*)C.lds;
    LAS float* Bs = (LAS float*)(C.lds + 8192);
    const int ntm = Mr / 128, ntn = N / 256, tid = C.tid, cg = tid & 15, r0 = tid >> 4;
    for (int tile = C.blk; tile < ntm * ntn; tile += C.nblk) {
        const int tm = tile / ntn, pn = tile % ntn;
        f32x4 acc[4][4];
#pragma unroll
        for (int i = 0; i < 4; ++i)
#pragma unroll
            for (int j = 0; j < 4; ++j) acc[i][j] = (f32x4){0.f, 0.f, 0.f, 0.f};
        const bf16* ap = A + (size_t)(tm * 128 + (tid >> 2)) * lda + pn * acol + (tid & 3) * 4;
        const bf16* bp = Bt + (size_t)(pn * 256 + (tid >> 1)) * ldb + (tid & 1) * 8;
        for (int k0 = 0; k0 < K; k0 += 16) {
            const u32x2 av = *(const u32x2*)(ap + k0); const u32x4 bv = *(const u32x4*)(bp + k0);
            __syncthreads();
            { const int r = tid >> 2, kq = (tid & 3) * 4; As[(kq + 0) * 128 + r] = bflo(av.x); As[(kq + 1) * 128 + r] = bfhi(av.x); As[(kq + 2) * 128 + r] = bflo(av.y); As[(kq + 3) * 128 + r] = bfhi(av.y); }
            { const int n = tid >> 1, kq = (tid & 1) * 8; Bs[(kq + 0) * 256 + n] = bflo(bv.x); Bs[(kq + 1) * 256 + n] = bfhi(bv.x); Bs[(kq + 2) * 256 + n] = bflo(bv.y); Bs[(kq + 3) * 256 + n] = bfhi(bv.y);
              Bs[(kq + 4) * 256 + n] = bflo(bv.z); Bs[(kq + 5) * 256 + n] = bfhi(bv.z); Bs[(kq + 6) * 256 + n] = bflo(bv.w); Bs[(kq + 7) * 256 + n] = bfhi(bv.w); }
            __syncthreads();
#pragma unroll
            for (int kk = 0; kk < 16; ++kk) {
                const f32x4 b0 = *(const LAS f32x4*)(Bs + kk * 256 + cg * 8), b1 = *(const LAS f32x4*)(Bs + kk * 256 + cg * 8 + 4), b2 = *(const LAS f32x4*)(Bs + kk * 256 + 128 + cg * 8), b3 = *(const LAS f32x4*)(Bs + kk * 256 + 128 + cg * 8 + 4);
#pragma unroll
                for (int i = 0; i < 4; ++i) { const float av1 = As[kk * 128 + r0 + 32 * i]; acc[i][0] += b0 * av1; acc[i][1] += b1 * av1; acc[i][2] += b2 * av1; acc[i][3] += b3 * av1; }
            }
        }
#pragma unroll
        for (int i = 0; i < 4; ++i) f.apply(tm * 128 + r0 + 32 * i, pn, cg * 8, acc[i][0], acc[i][1], acc[i][2], acc[i][3]);
    }
}

template <int W>
__device__ __forceinline__ void pool_item(const bf16* ZP, bf16* PL, int m0, int t0, int c0) {
    float p0[47], p1[47];
#pragma unroll
    for (int i = 0; i < 47; ++i) { const int r = t0 - 15 + i; unsigned w = 0u; if (i >= 15 - (W - 1)) { if (r >= 0) w = *(const unsigned*)(ZP + (size_t)(m0 - 15 + i) * D + c0); } p0[i] = bflo(w); p1[i] = bfhi(w); }
#pragma unroll
    for (int ti = 0; ti < 32; ++ti) {
        float s0 = 0.f, s1 = 0.f;
#pragma unroll
        for (int j = 0; j < W; ++j) { s0 += p0[ti + 15 - j]; s1 += p1[ti + 15 - j]; }
        const int cnt = (t0 + ti + 1) < W ? (t0 + ti + 1) : W; const float inv = 1.f / (float)cnt;
        *(unsigned*)(PL + (size_t)(m0 + ti) * D + c0) = pk2(s0 * inv - p0[ti + 15], s1 * inv - p1[ti + 15]);
    }
}
__device__ __forceinline__ void phase_convpool(const Ctx& C, const Args& a, int l) {
    const bf16* UG = (const bf16*)(a.ws + WS_UG); const bf16* ZP = (const bf16*)(a.ws + WS_ZP);
    bf16* AC = (bf16*)(a.ws + WS_AC); bf16* PL = (bf16*)(a.ws + WS_PL);
    const float* cw = a.in[I_CONVW] + (size_t)l * CONVK * D; const float* cb = a.in[I_CONVB] + (size_t)l * D;
    const float* lng = a.in[I_LNG] + (size_t)l * D; const float* lnb = a.in[I_LNB] + (size_t)l * D;
    LAS float* red = (LAS float*)C.lds;
    LAS float* stat = (LAS float*)(C.lds + 2048);
    int c0 = 2 * C.tid;
    asm volatile("" : "+v"(c0));
    float w0[31], w1[31];
#pragma unroll
    for (int k = 0; k < 31; ++k) { const f32x2 w = *(const f32x2*)(cw + (size_t)k * D + c0); w0[k] = w.x; w1[k] = w.y; }
    for (int item = C.blk; item < M / 32; item += C.nblk) {
        const int m0 = item * 32, t0 = m0 & (SEQ - 1);
        asm volatile("" : "+v"(c0));
        float a0[32], a1[32];
#pragma unroll
        for (int i = 0; i < 32; ++i) { a0[i] = 0.f; a1[i] = 0.f; }
#pragma unroll
        for (int ri = 0; ri < 62; ++ri) {
            unsigned w = 0u; if (t0 - 30 + ri >= 0) w = *(const unsigned*)(UG + (size_t)(m0 - 30 + ri) * D + c0);
            const float u0 = bflo(w), u1 = bfhi(w);
#pragma unroll
            for (int ti = 0; ti < 32; ++ti) { const int d = ti + 30 - ri; if (d >= 0 && d <= 30) { a0[ti] += w0[30 - d] * u0; a1[ti] += w1[30 - d] * u1; } }
            if ((ri & 7) == 7) asm volatile("" ::: "memory");
        }
        const f32x2 bb = *(const f32x2*)(cb + c0);
        __syncthreads();
#pragma unroll
        for (int ti = 0; ti < 32; ++ti) {
            a0[ti] += bb.x; a1[ti] += bb.y;
            const float s = wave_sum(a0[ti] + a1[ti]), q = wave_sum(a0[ti] * a0[ti] + a1[ti] * a1[ti]);
            if (C.lane == 0) { red[C.wave * 64 + ti] = s; red[C.wave * 64 + 32 + ti] = q; }
        }
        __syncthreads();
        if (C.tid < 32) { float s = 0.f, q = 0.f;
#pragma unroll
            for (int w = 0; w < 8; ++w) { s += red[w * 64 + C.tid]; q += red[w * 64 + 32 + C.tid]; }
            const float mean = s * (1.f / D), var = fmaxf(q * (1.f / D) - mean * mean, 0.f); stat[C.tid] = mean; stat[32 + C.tid] = 1.f / sqrtf(var + EPS); }
        __syncthreads();
        const f32x2 gg = *(const f32x2*)(lng + c0), be = *(const f32x2*)(lnb + c0);
#pragma unroll
        for (int ti = 0; ti < 32; ++ti) { const float mean = stat[ti], rstd = stat[32 + ti];
            const float y0 = (a0[ti] - mean) * rstd * gg.x + be.x, y1 = (a1[ti] - mean) * rstd * gg.y + be.y;
            *(unsigned*)(AC + (size_t)(m0 + ti) * D + c0) = pk2(y0 * sigm(y0), y1 * sigm(y1)); }
        asm volatile("" ::: "memory");
        const int g = C.tid >> 7;
        if (g == 0) pool_item<2>(ZP, PL, m0, t0, c0); else if (g == 1) pool_item<4>(ZP, PL, m0, t0, c0); else if (g == 2) pool_item<8>(ZP, PL, m0, t0, c0); else pool_item<16>(ZP, PL, m0, t0, c0);
    }
}

__device__ __forceinline__ int wave_min_i(int v) {
#pragma unroll
    for (int o = 1; o < 64; o <<= 1) { const int t = __shfl_xor(v, o); v = t < v ? t : v; }
    return v;
}
__device__ __forceinline__ void phase_topk(const Ctx& C, const Args& a) {
    const float* S = (const float*)(a.ws + WS_S); int* EID = (int*)(a.ws + WS_EID); float* GW = (float*)(a.ws + WS_GW);
    const int lane = C.lane; const float NEG = -3.0e38f;
    for (int it = C.gw; it < M * NHEAD; it += C.ngw) {
        const int tok = it >> 3, h = it & 7;
        float hv[2] = {0.f, 0.f}; int hi[2] = {0, 0};
#pragma unroll
        for (int p = 0; p < 2; ++p) {
            const f32x2 v = *(const f32x2*)(S + (size_t)tok * DQ + h * 256 + p * 128 + 2 * lane);
            float v0 = v.x, v1 = v.y; float sv = 0.f; int si = 0;
            for (int k = 0; k < TOPK; ++k) {
                const float m = fmaxf(v0, v1), wm = wave_max(m);
                const int cand = (v0 == wm) ? 2 * lane : ((v1 == wm) ? 2 * lane + 1 : 9999);
                const int idx = wave_min_i(cand);
                if (idx == 2 * lane) v0 = NEG; else if (idx == 2 * lane + 1) v1 = NEG;
                if (lane == k) { sv = wm; si = idx; }
            }
            hv[p] = sv; hi[p] = si;
        }
        float cv[4];
#pragma unroll
        for (int e = 0; e < 4; ++e) cv[e] = __shfl(hv[0], lane >> 2) + __shfl(hv[1], (lane & 3) * 4 + e);
        float tv = 0.f; int tf = 0;
        for (int k = 0; k < TOPK; ++k) {
            const float m = fmaxf(fmaxf(cv[0], cv[1]), fmaxf(cv[2], cv[3])), wm = wave_max(m);
            const int cand = (cv[0] == wm) ? 4 * lane : (cv[1] == wm) ? 4 * lane + 1 : (cv[2] == wm) ? 4 * lane + 2 : (cv[3] == wm) ? 4 * lane + 3 : 9999;
            const int idx = wave_min_i(cand);
            if (idx == 4 * lane) cv[0] = NEG; else if (idx == 4 * lane + 1) cv[1] = NEG; else if (idx == 4 * lane + 2) cv[2] = NEG; else if (idx == 4 * lane + 3) cv[3] = NEG;
            if (lane == k) { tv = wm; tf = idx; }
        }
        const float mx = __shfl(tv, 0); float ex = __expf(tv - mx); float sum = ex;
        sum += __shfl_xor(sum, 1); sum += __shfl_xor(sum, 2); sum += __shfl_xor(sum, 4); sum += __shfl_xor(sum, 8);
        const int i1 = __shfl(hi[0], (tf >> 4) & 15), i2 = __shfl(hi[1], tf & 15);
        if (lane < 16) { EID[(size_t)tok * 128 + h * 16 + lane] = i1 * 128 + i2; GW[(size_t)tok * 128 + h * 16 + lane] = ex / sum; }
    }
}

__device__ __forceinline__ void phase_topk_serial(const Ctx& C, const Args& a) {
    float* S = (float*)(a.ws + WS_S); int* EID = (int*)(a.ws + WS_EID); float* GW = (float*)(a.ws + WS_GW);
    float* SCR = (float*)(a.ws + WS_Q);
    const float NEG = -3.0e38f;
    const int gt = C.blk * NTHREADS + C.tid, ngt = C.nblk * NTHREADS;
    for (int it = gt; it < M * NHEAD; it += ngt) {
        const int tok = it >> 3, h = it & 7;
        float* sc = SCR + (size_t)it * 128;
        for (int p = 0; p < 2; ++p) {
            float* sp = S + (size_t)tok * DQ + h * 256 + p * 128;
            for (int k = 0; k < 16; ++k) {
                float best = NEG; int bi = 0;
                for (int n = 0; n < 128; ++n) { const float v = sp[n]; if (v > best) { best = v; bi = n; } }
                sc[p * 16 + k] = best; ((int*)sc)[32 + p * 16 + k] = bi; sp[bi] = NEG;
            }
        }
        float tv[16]; int tf[16];
        float mx = NEG, lastv = 0.f; int lastn = -1;
#pragma unroll
        for (int k = 0; k < 16; ++k) {
            float best = NEG; int bi = 0;
            for (int n = 0; n < 256; ++n) { const float v = sc[n >> 4] + sc[16 + (n & 15)];
                const bool elig = (k == 0) || (v < lastv) || (v == lastv && n > lastn);
                if (elig && v > best) { best = v; bi = n; } }
            tv[k] = best; tf[k] = bi; lastv = best; lastn = bi; if (k == 0) mx = best;
        }
        float sum = 0.f;
#pragma unroll
        for (int k = 0; k < 16; ++k) { tv[k] = __expf(tv[k] - mx); sum += tv[k]; }
#pragma unroll
        for (int k = 0; k < 16; ++k) { const int i1 = ((int*)sc)[32 + (tf[k] >> 4)], i2 = ((int*)sc)[48 + (tf[k] & 15)];
            EID[(size_t)tok * 128 + h * 16 + k] = i1 * 128 + i2; GW[(size_t)tok * 128 + h * 16 + k] = tv[k] / sum; }
    }
}

__device__ __forceinline__ void phase_peer(const Ctx& C, const Args& a, int l) {
    const bf16* UB = (const bf16*)(a.ws + WS_UB) + (size_t)l * NEXP * D; const bf16* VB = (const bf16*)(a.ws + WS_VB) + (size_t)l * NEXP * D;
    const int* EID = (const int*)(a.ws + WS_EID); const float* GW = (const float*)(a.ws + WS_GW);
    float* XW = a.out; bf16* H = (bf16*)(a.ws + WS_H); const int lane = C.lane;
    for (int m = C.gw; m < M; m += C.ngw) {
        const int b = m >> 13; f32x4 x[4], h[4], o[4];
#pragma unroll
        for (int j = 0; j < 4; ++j) { x[j] = *(const f32x4*)(XW + (size_t)m * D + 4 * lane + 256 * j); o[j] = (f32x4){0.f, 0.f, 0.f, 0.f}; }
        normmod_row(x, a.in[I_N2G] + (size_t)l * D, modp(a, l, b, 3), modp(a, l, b, 4), lane, h);
        const int e0 = EID[(size_t)m * 128 + lane], e1 = EID[(size_t)m * 128 + 64 + lane];
        const float g0 = GW[(size_t)m * 128 + lane], g1 = GW[(size_t)m * 128 + 64 + lane];
        for (int k = 0; k < 128; ++k) {
            const int e = __shfl(k < 64 ? e0 : e1, k & 63); const float gwk = __shfl(k < 64 ? g0 : g1, k & 63);
            const bf16* ur = UB + (size_t)e * D + 4 * lane; const bf16* vr = VB + (size_t)e * D + 4 * lane;
            u32x2 uw[4], vw[4];
#pragma unroll
            for (int j = 0; j < 4; ++j) { uw[j] = *(const u32x2*)(ur + 256 * j); vw[j] = *(const u32x2*)(vr + 256 * j); }
            float d = 0.f;
#pragma unroll
            for (int j = 0; j < 4; ++j) d += (bflo(uw[j].x) * h[j].x + bfhi(uw[j].x) * h[j].y) + (bflo(uw[j].y) * h[j].z + bfhi(uw[j].y) * h[j].w);
            d = wave_sum(d);
            const float act = 0.5f * d * (1.f + erff(d * 0.70710678118654752f)), cf = gwk * act;
#pragma unroll
            for (int j = 0; j < 4; ++j) { o[j].x += cf * bflo(vw[j].x); o[j].y += cf * bfhi(vw[j].x); o[j].z += cf * bflo(vw[j].y); o[j].w += cf * bfhi(vw[j].y); }
        }
        const float* g2 = modp(a, l, b, 5);
#pragma unroll
        for (int j = 0; j < 4; ++j) x[j] += *(const f32x4*)(g2 + 4 * lane + 256 * j) * o[j];
        if (l + 1 < DEPTH) {
#pragma unroll
            for (int j = 0; j < 4; ++j) *(f32x4*)(XW + (size_t)m * D + 4 * lane + 256 * j) = x[j];
            normmod_row(x, a.in[I_N1G] + (size_t)(l + 1) * D, modp(a, l + 1, b, 0), modp(a, l + 1, b, 1), lane, h);
            store_row_bf16(H + (size_t)m * D, h, lane);
        } else {
            float s = 0.f;
#pragma unroll
            for (int j = 0; j < 4; ++j) s += (x[j].x * x[j].x + x[j].y * x[j].y) + (x[j].z * x[j].z + x[j].w * x[j].w);
            const float rstd = 1.f / sqrtf(wave_sum(s) * (1.f / D) + EPS);
#pragma unroll
            for (int j = 0; j < 4; ++j) *(f32x4*)(a.out + (size_t)m * D + 4 * lane + 256 * j) = x[j] * rstd * *(const f32x4*)(a.in[I_FG] + 4 * lane + 256 * j);
        }
    }
}

constexpr int PH_PREP = 0, PH_MODR = 1, PH_N1 = 2, PH_L0 = 3, PH_PER_LAYER = 9, N_PHASES = PH_L0 + DEPTH * PH_PER_LAYER;
__global__ void __launch_bounds__(NTHREADS, 2) fwd_kernel(Args a) {
    extern __shared__ __attribute__((aligned(16))) unsigned char lds_raw[];
    unsigned char* ws = a.ws;
    for (int ph = a.ph_lo; ph < a.ph_hi; ++ph) {
        int tid_ = threadIdx.x; asm volatile("" : "+v"(tid_));
        Ctx C; C.tid = tid_; C.lane = C.tid & 63; C.wave = __builtin_amdgcn_readfirstlane(C.tid >> 6); C.nblk = gridDim.x; C.blk = blockIdx.x;
        C.gw = C.blk * NWAVES + C.wave; C.ngw = C.nblk * NWAVES; C.lds = (LAS unsigned char*)lds_raw;
        if (ph == PH_PREP) phase_prep(C, a);
        else if (ph == PH_MODR) phase_modreduce(C, a);
        else if (ph == PH_N1) phase_norm(C, a, a.in[I_X], a.in[I_N1G], 0, 0, 1);
        else {
            const int l = (ph - PH_L0) / PH_PER_LAYER, s = (ph - PH_L0) % PH_PER_LAYER;
            bf16* H = (bf16*)(ws + WS_H);
            if (s == 0) { EpiIn E{a.in[I_BIN] + (size_t)l * DIN, (bf16*)(ws + WS_UG), (bf16*)(ws + WS_ZP), (bf16*)(ws + WS_G)};
                naive_gemm(C, H, D, 0, (const bf16*)(ws + WS_WIN) + (size_t)l * DIN * D, D, M, DIN, D, E); }
            else if (s == 1) phase_convpool(C, a, l);
            else if (s == 2) {
                EpiPool E1{(const bf16*)(ws + WS_G), a.in[I_POOLS] + (size_t)l * D, (bf16*)(ws + WS_TMP)};
                naive_gemm(C, (const bf16*)(ws + WS_PL), D, 256, (const bf16*)(ws + WS_POOL) + (size_t)l * 1024 * 256, 256, M, D, 256, E1);
                __syncthreads();
                EpiConv E2{(const bf16*)(ws + WS_G), (const bf16*)(ws + WS_TMP), (bf16*)(ws + WS_Y)};
                naive_gemm(C, (const bf16*)(ws + WS_AC), D, 0, (const bf16*)(ws + WS_WCO) + (size_t)l * D * D, D, M, D, D, E2); }
            else if (s == 3) { EpiOut E{l == 0 ? a.in[I_X] : a.out, a.out, modp(a, l, 0, 2), a.in[I_BOUT] + (size_t)l * D};
                naive_gemm(C, (const bf16*)(ws + WS_Y), D, 0, (const bf16*)(ws + WS_WOUT) + (size_t)l * D * D, D, M, D, D, E); }
            else if (s == 4) phase_norm(C, a, a.out, a.in[I_N2G] + (size_t)l * D, l, 3, 4);
            else if (s == 5) { EpiQ E{(bf16*)(ws + WS_Q)}; naive_gemm(C, H, D, 0, (const bf16*)(ws + WS_WQ) + (size_t)l * DQ * D, D, M, DQ, D, E); }
            else if (s == 6) { EpiS E{(float*)(ws + WS_S)}; naive_gemm(C, (const bf16*)(ws + WS_Q), DQ, 256, (const bf16*)(ws + WS_KEYS) + (size_t)l * 2048 * 256, 256, M, DQ, 256, E); }
            else if (s == 7) phase_topk(C, a);
            else phase_peer(C, a, l);
        }
    }
}

extern "C" void kernel_launch(void* const* d_in, const int* in_sizes, int n_in, void* d_out, int out_size, void* d_ws, size_t ws_size, hipStream_t stream) {
    static int grid = 0;
    if (grid == 0) {
        if (n_in != 22 || out_size != M * D || ws_size < WS_END) { fprintf(stderr, "kernel_launch: unexpected shapes (n_in %d out %d ws %zu)\n", n_in, out_size, ws_size); grid = -1; return; }
        int dev = 0, cus = 0;
        if (hipGetDevice(&dev) != hipSuccess || hipDeviceGetAttribute(&cus, hipDeviceAttributeMultiprocessorCount, dev) != hipSuccess) { grid = -1; return; }
        if (hipFuncSetAttribute((const void*)fwd_kernel, hipFuncAttributeMaxDynamicSharedMemorySize, LDS_BYTES) != hipSuccess) { grid = -1; return; }
        grid = cus;
    }
    if (grid < 0) return;
    Args a{};
    for (int i = 0; i < 22; ++i) a.in[i] = (const float*)d_in[i];
    a.out = (float*)d_out; a.ws = (unsigned char*)d_ws;
    for (int ph = 0; ph < N_PHASES; ++ph) { a.ph_lo = ph; a.ph_hi = ph + 1; hipLaunchKernelGGL(fwd_kernel, dim3(grid), dim3(NTHREADS), LDS_BYTES, stream, a); }
}
```

```cpp
#define ONE_LAUNCH 1
#include <hip/hip_runtime.h>
#include <cstdint>
#include <cstdio>

#define GAS __attribute__((address_space(1)))
#define LAS __attribute__((address_space(3)))
typedef unsigned short bf16;
typedef float f32x4 __attribute__((ext_vector_type(4)));
typedef float f32x2 __attribute__((ext_vector_type(2)));
typedef unsigned u32x4 __attribute__((ext_vector_type(4)));
typedef unsigned u32x2 __attribute__((ext_vector_type(2)));
typedef __bf16 bf16x2_t __attribute__((ext_vector_type(2)));

constexpr int BATCH = 2, SEQ = 8192, D = 1024, M = BATCH * SEQ, DEPTH = 2;
constexpr int DIN = 5120, NMODV = 6 * D, CONVK = 31, NHEAD = 8, NKEYS = 128, DQ = 2048, TOPK = 16, NEXP = 16384;
constexpr float EPS = 1e-6f;
constexpr int NWAVES = 8, NTHREADS = NWAVES * 64;

constexpr size_t MiB = 1u << 20;
constexpr size_t WS_CTL = 0;
constexpr size_t WS_MODP = 1 * MiB;
constexpr size_t WS_MOD = 4 * MiB;
constexpr size_t WS_WIN = 8 * MiB;
constexpr size_t WS_WCO = 28 * MiB;
constexpr size_t WS_WOUT = 32 * MiB;
constexpr size_t WS_WQ = 36 * MiB;
constexpr size_t WS_POOL = 44 * MiB;
constexpr size_t WS_KEYS = 45 * MiB;
constexpr size_t WS_UB = 48 * MiB;
constexpr size_t WS_VB = 112 * MiB;
constexpr size_t WS_H = 176 * MiB;
constexpr size_t WS_UG = 208 * MiB;
constexpr size_t WS_Y = WS_UG;
constexpr size_t WS_ZP = 240 * MiB;
constexpr size_t WS_TMP = WS_ZP;
constexpr size_t WS_Q = WS_UG;
constexpr size_t WS_G = 272 * MiB;
constexpr size_t WS_AC = 336 * MiB;
constexpr size_t WS_PL = 368 * MiB;
constexpr size_t WS_S = WS_G;
constexpr size_t WS_EID = 400 * MiB;
constexpr size_t WS_GW = 408 * MiB;
constexpr size_t WS_END = 416 * MiB;

constexpr int LDS_BYTES = 147456;

__device__ __forceinline__ unsigned f2bf(float f) { unsigned u = __builtin_bit_cast(unsigned, f); return (u + 0x7fffu + ((u >> 16) & 1u)) >> 16; }
__device__ __forceinline__ unsigned pk2(float lo, float hi) { return f2bf(lo) | (f2bf(hi) << 16); }
__device__ __forceinline__ float bflo(unsigned w) { return __builtin_bit_cast(float, w << 16); }
__device__ __forceinline__ float bfhi(unsigned w) { return __builtin_bit_cast(float, w & 0xffff0000u); }
__device__ __forceinline__ float sigm(float x) { return 1.f / (1.f + __expf(-x)); }
__device__ __forceinline__ float wave_sum(float v) {
#pragma unroll
    for (int o = 1; o < 64; o <<= 1) v += __shfl_xor(v, o);
    return v;
}
__device__ __forceinline__ float wave_max(float v) {
#pragma unroll
    for (int o = 1; o < 64; o <<= 1) v = fmaxf(v, __shfl_xor(v, o));
    return v;
}
__device__ __forceinline__ u32x4 pack8(const f32x4& a, const f32x4& b) { u32x4 w; w.x = pk2(a.x, a.y); w.y = pk2(a.z, a.w); w.z = pk2(b.x, b.y); w.w = pk2(b.z, b.w); return w; }
__device__ __forceinline__ void unpack8(const u32x4& w, f32x4& a, f32x4& b) { a = (f32x4){bflo(w.x), bfhi(w.x), bflo(w.y), bfhi(w.y)}; b = (f32x4){bflo(w.z), bfhi(w.z), bflo(w.w), bfhi(w.w)}; }

struct Ctx { int tid, lane, wave, gw, ngw, nblk, blk; LAS unsigned char* lds; };

struct Args { const float* in[22]; float* out; unsigned char* ws; int ph_lo, ph_hi; };
enum { I_X = 0, I_C, I_ADAW, I_ADAB, I_N1G, I_WIN, I_BIN, I_CONVW, I_CONVB, I_LNG, I_LNB, I_WCO, I_POOLW, I_POOLS, I_WOUT, I_BOUT, I_N2G, I_WQ, I_KEYS, I_PU, I_PV, I_FG };

__device__ __forceinline__ void transpose_item(const float* W, int K, int N, int k0, int n0, bf16* WT, int dstrow0, LAS float* scr, int lane) {
#pragma unroll 8
    for (int i = 0; i < 32; ++i) { const int kk = 2 * i + (lane >> 5); scr[kk * 33 + (lane & 31)] = W[(size_t)(k0 + kk) * N + n0 + (lane & 31)]; }
    asm volatile("s_waitcnt lgkmcnt(0)" ::: "memory");
    const int c = lane & 7;
#pragma unroll
    for (int j = 0; j < 4; ++j) { const int n = (lane >> 3) + 8 * j; const LAS float* s = scr + (8 * c) * 33 + n;
        u32x4 o; o.x = pk2(s[0 * 33], s[1 * 33]); o.y = pk2(s[2 * 33], s[3 * 33]); o.z = pk2(s[4 * 33], s[5 * 33]); o.w = pk2(s[6 * 33], s[7 * 33]);
        *(u32x4*)(WT + (size_t)(dstrow0 + n) * K + k0 + 8 * c) = o; }
    asm volatile("s_waitcnt lgkmcnt(0)" ::: "memory");
}
__device__ __forceinline__ int win_dstrow(int n0) {
    if (n0 < 1024) return 256 * (n0 >> 7) + (n0 & 127);
    if (n0 < 2048) { const int c = n0 - 1024; return 256 * (c >> 7) + 128 + (c & 127); }
    return n0;
}
__device__ __forceinline__ void phase_prep(const Ctx& C, const Args& a) {
    unsigned char* ws = a.ws;
    LAS float* scr = (LAS float*)(C.lds + C.wave * 16384);
    constexpr int I_IN = 16 * 160, I_CO = 16 * 32, I_PO = 4 * (4 * 8), I_OUT = 16 * 32, I_Q = 16 * 64, I_L = I_IN + I_CO + I_PO + I_OUT + I_Q;
    for (int it = C.gw; it < DEPTH * I_L; it += C.ngw) {
        const int l = it / I_L; int r = it % I_L;
        if (r < I_IN) { const int kb = r / 160, nb = r % 160; transpose_item(a.in[I_WIN] + (size_t)l * D * DIN, D, DIN, 64 * kb, 32 * nb, (bf16*)(ws + WS_WIN) + (size_t)l * DIN * D, win_dstrow(32 * nb), scr, C.lane); continue; } r -= I_IN;
        if (r < I_CO) { const int kb = r / 32, nb = r % 32; transpose_item(a.in[I_WCO] + (size_t)l * D * D, D, D, 64 * kb, 32 * nb, (bf16*)(ws + WS_WCO) + (size_t)l * D * D, 32 * nb, scr, C.lane); continue; } r -= I_CO;
        if (r < I_PO) { const int g = r / 32, q = r % 32, kb = q / 8, nb = q % 8; transpose_item(a.in[I_POOLW] + ((size_t)l * 4 + g) * 256 * 256, 256, 256, 64 * kb, 32 * nb, (bf16*)(ws + WS_POOL) + ((size_t)l * 1024 + 256 * g) * 256, 32 * nb, scr, C.lane); continue; } r -= I_PO;
        if (r < I_OUT) { const int kb = r / 32, nb = r % 32; transpose_item(a.in[I_WOUT] + (size_t)l * D * D, D, D, 64 * kb, 32 * nb, (bf16*)(ws + WS_WOUT) + (size_t)l * D * D, 32 * nb, scr, C.lane); continue; } r -= I_OUT;
        { const int kb = r / 64, nb = r % 64; transpose_item(a.in[I_WQ] + (size_t)l * D * DQ, D, DQ, 64 * kb, 32 * nb, (bf16*)(ws + WS_WQ) + (size_t)l * DQ * D, 32 * nb, scr, C.lane); }
    }
    const int gt = C.blk * NTHREADS + C.tid, ngt = C.nblk * NTHREADS;
    for (int i = gt; i < DEPTH * 2048 * 32; i += ngt) {
        const int l = i / (2048 * 32), r = i % (2048 * 32), n = r / 32, k8 = (r % 32) * 8;
        const int h = n >> 8, p = (n >> 7) & 1, key = n & 127, pk = k8 >> 7, kk = k8 & 127;
        u32x4 o = (u32x4){0u, 0u, 0u, 0u};
        if (pk == p) { const float* s = a.in[I_KEYS] + ((((size_t)l * 8 + h) * 2 + p) * 128 + key) * 128 + kk; const f32x4 v0 = *(const f32x4*)s, v1 = *(const f32x4*)(s + 4); o = pack8(v0, v1); }
        *(u32x4*)((bf16*)(ws + WS_KEYS) + ((size_t)l * 2048 + n) * 256 + k8) = o;
    }
    for (int t = 0; t < 2; ++t) {
        const float* src = a.in[t == 0 ? I_PU : I_PV]; bf16* dst = (bf16*)(ws + (t == 0 ? WS_UB : WS_VB));
        for (size_t i = gt; i < (size_t)DEPTH * NEXP * D / 8; i += ngt) { const f32x4 v0 = *(const f32x4*)(src + i * 8), v1 = *(const f32x4*)(src + i * 8 + 4); *(u32x4*)(dst + i * 8) = pack8(v0, v1); }
    }
    for (int it = gt; it < 32 * 3072; it += ngt) {
        const int ks = it / 3072, cg = it % 3072, l = cg / 1536, n4 = (cg % 1536) * 4;
        f32x4 a0 = (f32x4){0.f, 0.f, 0.f, 0.f}, a1 = a0;
        const float* wp = a.in[I_ADAW] + ((size_t)l * D + ks * 32) * NMODV + n4; const float* c0 = a.in[I_C] + ks * 32; const float* c1 = c0 + D;
#pragma unroll 8
        for (int kk = 0; kk < 32; ++kk) { const f32x4 w = *(const f32x4*)(wp + (size_t)kk * NMODV); const float x0 = c0[kk], x1 = c1[kk]; a0 += w * (x0 * sigm(x0)); a1 += w * (x1 * sigm(x1)); }
        float* mp = (float*)(ws + WS_MODP) + (((size_t)ks * 2 + l) * 2) * NMODV + n4;
        *(f32x4*)mp = a0; *(f32x4*)(mp + NMODV) = a1;
    }
}
__device__ __forceinline__ void phase_modreduce(const Ctx& C, const Args& a) {
    const int gt = C.blk * NTHREADS + C.tid, ngt = C.nblk * NTHREADS;
    for (int i = gt; i < 2 * 2 * NMODV; i += ngt) {
        const int l = i / (2 * NMODV), n = i % NMODV; float s = a.in[I_ADAB][(size_t)l * NMODV + n];
        const float* mp = (const float*)(a.ws + WS_MODP) + i;
        for (int ks = 0; ks < 32; ++ks) s += mp[(size_t)ks * 4 * NMODV];
        ((float*)(a.ws + WS_MOD))[i] = s;
    }
}
__device__ __forceinline__ const float* modp(const Args& a, int l, int b, int v) { return (const float*)(a.ws + WS_MOD) + ((size_t)l * 2 + b) * NMODV + v * D; }

__device__ __forceinline__ void normmod_row(const f32x4 (&x)[4], const float* g, const float* sh, const float* sc, int lane, f32x4 (&h)[4]) {
    float s = 0.f;
#pragma unroll
    for (int j = 0; j < 4; ++j) s += (x[j].x * x[j].x + x[j].y * x[j].y) + (x[j].z * x[j].z + x[j].w * x[j].w);
    const float rstd = 1.f / sqrtf(wave_sum(s) * (1.f / D) + EPS);
#pragma unroll
    for (int j = 0; j < 4; ++j) { const int c = 4 * lane + 256 * j; const f32x4 gv = *(const f32x4*)(g + c), shv = *(const f32x4*)(sh + c), scv = *(const f32x4*)(sc + c);
        h[j] = (x[j] * rstd) * gv * (scv + 1.f) + shv; }
}
__device__ __forceinline__ void store_row_bf16(bf16* row, const f32x4 (&h)[4], int lane) {
#pragma unroll
    for (int j = 0; j < 4; ++j) { u32x2 w; w.x = pk2(h[j].x, h[j].y); w.y = pk2(h[j].z, h[j].w); *(u32x2*)(row + 4 * lane + 256 * j) = w; }
}
__device__ __forceinline__ void phase_norm(const Ctx& C, const Args& a, const float* X, const float* g, int l, int vsh, int vsc) {
    bf16* H = (bf16*)(a.ws + WS_H);
    for (int m = C.gw; m < M; m += C.ngw) {
        const int b = m >> 13; f32x4 x[4], h[4];
#pragma unroll
        for (int j = 0; j < 4; ++j) x[j] = *(const f32x4*)(X + (size_t)m * D + 4 * C.lane + 256 * j);
        normmod_row(x, g, modp(a, l, b, vsh), modp(a, l, b, vsc), C.lane, h);
        store_row_bf16(H + (size_t)m * D, h, C.lane);
    }
}

struct EpiIn {
    const float* bin; bf16 *UG, *ZP, *G;
    __device__ __forceinline__ void apply(int row, int pn, int cl8, f32x4 a0, f32x4 a1, f32x4 b0, f32x4 b1) const {
        if (pn < 8) {
            const int c = 128 * pn + cl8;
            a0 += *(const f32x4*)(bin + c); a1 += *(const f32x4*)(bin + c + 4); b0 += *(const f32x4*)(bin + 1024 + c); b1 += *(const f32x4*)(bin + 1024 + c + 4);
            f32x4 u0, u1;
#pragma unroll
            for (int i = 0; i < 4; ++i) { u0[i] = a0[i] * sigm(b0[i]); u1[i] = a1[i] * sigm(b1[i]); }
            *(u32x4*)(UG + (size_t)row * D + c) = pack8(u0, u1);
        } else if (pn < 12) {
            const int c = 256 * (pn - 8) + cl8;
            a0 += *(const f32x4*)(bin + 2048 + c); a1 += *(const f32x4*)(bin + 2048 + c + 4); b0 += *(const f32x4*)(bin + 2048 + 128 + c); b1 += *(const f32x4*)(bin + 2048 + 128 + c + 4);
            *(u32x4*)(ZP + (size_t)row * D + c) = pack8(a0, a1); *(u32x4*)(ZP + (size_t)row * D + c + 128) = pack8(b0, b1);
        } else {
            const int c = 256 * (pn - 12) + cl8;
            a0 += *(const f32x4*)(bin + 3072 + c); a1 += *(const f32x4*)(bin + 3072 + c + 4); b0 += *(const f32x4*)(bin + 3072 + 128 + c); b1 += *(const f32x4*)(bin + 3072 + 128 + c + 4);
#pragma unroll
            for (int i = 0; i < 4; ++i) { a0[i] = sigm(a0[i]); a1[i] = sigm(a1[i]); b0[i] = sigm(b0[i]); b1[i] = sigm(b1[i]); }
            *(u32x4*)(G + (size_t)row * 2048 + c) = pack8(a0, a1); *(u32x4*)(G + (size_t)row * 2048 + c + 128) = pack8(b0, b1);
        }
    }
};
struct EpiPool {
    const bf16* G; const float* scale; bf16* TMP;
    __device__ __forceinline__ void apply(int row, int pn, int cl8, f32x4 a0, f32x4 a1, f32x4 b0, f32x4 b1) const {
        const int c = 256 * pn + cl8; f32x4 g0, g1;
        unpack8(*(const u32x4*)(G + (size_t)row * 2048 + 1024 + c), g0, g1);
        a0 = a0 * g0 * *(const f32x4*)(scale + c); a1 = a1 * g1 * *(const f32x4*)(scale + c + 4);
        *(u32x4*)(TMP + (size_t)row * D + c) = pack8(a0, a1);
        unpack8(*(const u32x4*)(G + (size_t)row * 2048 + 1024 + c + 128), g0, g1);
        b0 = b0 * g0 * *(const f32x4*)(scale + c + 128); b1 = b1 * g1 * *(const f32x4*)(scale + c + 132);
        *(u32x4*)(TMP + (size_t)row * D + c + 128) = pack8(b0, b1);
    }
};
struct EpiConv {
    const bf16* G; const bf16* TMP; bf16* Y;
    __device__ __forceinline__ void apply(int row, int pn, int cl8, f32x4 a0, f32x4 a1, f32x4 b0, f32x4 b1) const {
        const int c = 256 * pn + cl8; f32x4 g0, g1, t0, t1;
        unpack8(*(const u32x4*)(G + (size_t)row * 2048 + c), g0, g1); unpack8(*(const u32x4*)(TMP + (size_t)row * D + c), t0, t1);
        *(u32x4*)(Y + (size_t)row * D + c) = pack8(a0 * g0 + t0, a1 * g1 + t1);
        unpack8(*(const u32x4*)(G + (size_t)row * 2048 + c + 128), g0, g1); unpack8(*(const u32x4*)(TMP + (size_t)row * D + c + 128), t0, t1);
        *(u32x4*)(Y + (size_t)row * D + c + 128) = pack8(b0 * g0 + t0, b1 * g1 + t1);
    }
};
struct EpiOut {
    const float* xold; float* xnew; const float* g1;   const float* bout;
    __device__ __forceinline__ void apply(int row, int pn, int cl8, f32x4 a0, f32x4 a1, f32x4 b0, f32x4 b1) const {
        const int c = 256 * pn + cl8; const float* g = g1 + (size_t)(row >> 13) * NMODV; const size_t o = (size_t)row * D + c;
        *(f32x4*)(xnew + o) = *(const f32x4*)(xold + o) + *(const f32x4*)(g + c) * (a0 + *(const f32x4*)(bout + c));
        *(f32x4*)(xnew + o + 4) = *(const f32x4*)(xold + o + 4) + *(const f32x4*)(g + c + 4) * (a1 + *(const f32x4*)(bout + c + 4));
        *(f32x4*)(xnew + o + 128) = *(const f32x4*)(xold + o + 128) + *(const f32x4*)(g + c + 128) * (b0 + *(const f32x4*)(bout + c + 128));
        *(f32x4*)(xnew + o + 132) = *(const f32x4*)(xold + o + 132) + *(const f32x4*)(g + c + 132) * (b1 + *(const f32x4*)(bout + c + 132));
    }
};
struct EpiQ {
    bf16* Q;
    __device__ __forceinline__ void apply(int row, int pn, int cl8, f32x4 a0, f32x4 a1, f32x4 b0, f32x4 b1) const {
        const size_t o = (size_t)row * DQ + 256 * pn + cl8; *(u32x4*)(Q + o) = pack8(a0, a1); *(u32x4*)(Q + o + 128) = pack8(b0, b1);
    }
};
struct EpiS {
    float* S;
    __device__ __forceinline__ void apply(int row, int pn, int cl8, f32x4 a0, f32x4 a1, f32x4 b0, f32x4 b1) const {
        const size_t o = (size_t)row * DQ + 256 * pn + cl8; *(f32x4*)(S + o) = a0; *(f32x4*)(S + o + 4) = a1; *(f32x4*)(S + o + 128) = b0; *(f32x4*)(S + o + 132) = b1;
    }
};

namespace pg8 {
#define PG8_LAS __attribute__((address_space(3)))
typedef unsigned short bf16_t;
typedef short bf16x8 __attribute__((ext_vector_type(8)));
typedef float f32x4 __attribute__((ext_vector_type(4)));
typedef unsigned u32x4 __attribute__((ext_vector_type(4)));
constexpr int BM = 256, BK = 64, HALF = 128, HTB = HALF * BK * 2  , STAGE_BYTES = 8 * HTB, NXCD = 8, WGM = 8;

__host__ __device__ __forceinline__ int lds_byte(int r, int c) { const int st = (r >> 4) * 2 + (c >> 5), rr = r & 15, cc = c & 31, ob = rr * 64 + cc * 2; return st * 1024 + (ob ^ (((ob >> 9) & 1) << 5)); }
__host__ __device__ __forceinline__ void stage_rc(int b, int& R, int& C) { const int st = b / 1024, sb = b % 1024, swz = sb ^ (((sb >> 9) & 1) << 5); R = (st >> 1) * 16 + swz / 64; C = (st & 1) * 32 + (swz % 64) / 2; }
__host__ __device__ __forceinline__ int perm32(int rho) { const int n = rho >> 4, i = rho & 15; return 8 * (i >> 2) + 4 * n + (i & 3); }

struct Unit { int pm, pn; };
struct Gemm { const bf16_t* A; const bf16_t* Bt; int M, N, K, lda, ldb, acol; };

struct StaticOrder {
    int nM, nN, nwg, G, c;
    __host__ __device__ void init(int M, int N, int G_, int c_) { nM = M / BM; nN = N / BM; nwg = nM * nN; G = G_; c = c_; }
    __host__ __device__ bool next(int i, Unit& u) const {
        const long L = (long)i * G + c; if (L >= nwg) return false;
        int wgid = (int)L; { const int q = nwg / NXCD, r = nwg % NXCD, xcd = wgid % NXCD, off = wgid / NXCD; wgid = (xcd < r ? xcd * (q + 1) : r * (q + 1) + (xcd - r) * q) + off; }
        const int nig = WGM * nN, gid = wgid / nig, fm = gid * WGM, gsz = (nM - fm) < WGM ? (nM - fm) : WGM;
        u.pm = fm + ((wgid % nig) % gsz); u.pn = (wgid % nig) / gsz; return true;
    }
    __device__ __forceinline__ void a_ready(const Unit&) const {}
    __device__ __forceinline__ void done(const Unit&) const {}
};


template <class Epi, class Sched, bool ALIGN_EPI = false, bool SP2 = false>
__device__ __forceinline__ void gemm_phase(PG8_LAS unsigned char* lds, const Gemm g, const Sched& S, const Epi& E) {
    const int tid = threadIdx.x, wid = __builtin_amdgcn_readfirstlane(tid >> 6), lane = tid & 63, wr = wid >> 2, wc = wid & 3, fr = lane & 15, fq = lane >> 4;
    const int K = g.K, nt = K / BK;
    unsigned voffA[2], voffB[2];
#pragma unroll
    for (int i = 0; i < 2; ++i) { int R, C; stage_rc(tid * 16 + i * 8192, R, C); const int Rb = Epi::PERM ? ((R & ~31) + perm32(R & 31)) : R;
        voffA[i] = (unsigned)(R * g.lda + C) * 2u; voffB[i] = (unsigned)(Rb * g.ldb + C) * 2u; }
    const size_t kstep = (size_t)(BK * 2);
    const size_t hstepA = (size_t)HALF * g.lda * 2, hstepB = (size_t)HALF * g.ldb * 2;
    const size_t tstepA = 2 * hstepA, tstepB = 2 * hstepB, acolb = (size_t)g.acol * 2;
    const unsigned ldsw = (unsigned)wid * 1024u;
    const int aoff = lds_byte(wr * 64 + fr, fq * 8), boff = lds_byte(wc * 32 + fr, fq * 8);
#define PG8_SA(b, h) (((b) * 2 + (h)) * HTB)
#define PG8_SB(b, h) ((4 + (b) * 2 + (h)) * HTB)
#define PG8_STAGE(bufoff, gbase, voff) do { _Pragma("unroll") for (int _i = 0; _i < 2; ++_i) \
        __builtin_amdgcn_global_load_lds((const unsigned*)((const char*)(gbase) + (voff)[_i]), (PG8_LAS unsigned*)(lds + (bufoff) + ldsw + _i * 8192), 16, 0, 0); } while (0)
#define PG8_LDA(dst, b, h) do { _Pragma("unroll") for (int m = 0; m < 4; ++m) _Pragma("unroll") for (int k = 0; k < 2; ++k) dst[m][k] = *(const PG8_LAS bf16x8*)(lds + PG8_SA(b, h) + aoff + m * 2048 + k * 1024); } while (0)
#define PG8_LDB(dst, b, h) do { _Pragma("unroll") for (int n = 0; n < 2; ++n) _Pragma("unroll") for (int k = 0; k < 2; ++k) dst[n][k] = *(const PG8_LAS bf16x8*)(lds + PG8_SB(b, h) + boff + n * 2048 + k * 1024); } while (0)
#define PG8_MMA(ai, bj, At, Bt) do { __builtin_amdgcn_s_setprio(1); _Pragma("unroll") for (int m = 0; m < 4; ++m) _Pragma("unroll") for (int n = 0; n < 2; ++n) _Pragma("unroll") for (int k = 0; k < 2; ++k) \
        acc[ai][bj][m][n] = __builtin_amdgcn_mfma_f32_16x16x32_bf16(Bt[n][k], At[m][k], acc[ai][bj][m][n], 0, 0, 0); __builtin_amdgcn_s_setprio(0); } while (0)
#define PG8_WAIT_V(n) asm volatile("s_waitcnt vmcnt(" #n ")" ::: "memory")
#define PG8_WAIT_L(n) asm volatile("s_waitcnt lgkmcnt(" #n ")" ::: "memory")
#define PG8_BAR __builtin_amdgcn_s_barrier()
#define PG8_SCHED __builtin_amdgcn_sched_barrier(0)
    Unit cur, nxt; int ui = 0;
    if (!S.next(0, cur)) return;
    f32x4 acc[2][2][4][2];
#pragma unroll
    for (int a = 0; a < 2; ++a)
#pragma unroll
        for (int b = 0; b < 2; ++b)
#pragma unroll
            for (int m = 0; m < 4; ++m)
#pragma unroll
                for (int n = 0; n < 2; ++n) acc[a][b][m][n] = (f32x4){0.f, 0.f, 0.f, 0.f};
    bf16x8 At[4][2], B0[2][2], B1[2][2];
    const char* cA = (const char*)g.A + (size_t)cur.pm * tstepA + (size_t)cur.pn * acolb; const char* cB = (const char*)g.Bt + (size_t)cur.pn * tstepB;
    S.a_ready(cur);
    if constexpr (SP2) {
        PG8_STAGE(PG8_SB(0, 0), cB, voffB); PG8_STAGE(PG8_SB(0, 1), cB + hstepB, voffB); PG8_STAGE(PG8_SA(0, 0), cA, voffA); PG8_STAGE(PG8_SA(0, 1), cA + hstepA, voffA);
        if (wr == 1) PG8_BAR;
        PG8_WAIT_V(2); PG8_BAR;
        PG8_STAGE(PG8_SB(1, 0), cB + kstep, voffB); PG8_STAGE(PG8_SA(1, 0), cA + kstep, voffA); PG8_STAGE(PG8_SB(1, 1), cB + hstepB + kstep, voffB);
        PG8_WAIT_V(6); PG8_BAR;
    } else {
        PG8_STAGE(PG8_SB(0, 0), cB, voffB); PG8_STAGE(PG8_SA(0, 0), cA, voffA); PG8_STAGE(PG8_SB(0, 1), cB + hstepB, voffB); PG8_STAGE(PG8_SA(0, 1), cA + hstepA, voffA);
        if (wr == 1) PG8_BAR;
        PG8_WAIT_V(4); PG8_BAR;
        PG8_STAGE(PG8_SB(1, 0), cB + kstep, voffB); PG8_STAGE(PG8_SA(1, 0), cA + kstep, voffA); PG8_STAGE(PG8_SB(1, 1), cB + hstepB + kstep, voffB);
        PG8_WAIT_V(6); PG8_BAR;
    }
    for (;;) {
        const bool has_next = S.next(ui + 1, nxt);
        const char* nA = has_next ? (const char*)g.A + (size_t)nxt.pm * tstepA + (size_t)nxt.pn * acolb : cA; const char* nB = has_next ? (const char*)g.Bt + (size_t)nxt.pn * tstepB : cB;
#pragma nounroll
        for (int t = 0; t < nt; t += 2) {
            const bool last = (t == nt - 2);
            const char* a1 = cA + (size_t)(t + 1) * kstep;
            const char* a2 = last ? nA : cA + (size_t)(t + 2) * kstep; const char* b2 = last ? nB : cB + (size_t)(t + 2) * kstep;
            const char* a3 = a2 + kstep; const char* b3 = b2 + kstep;
            if (last && has_next) S.a_ready(nxt);
            if constexpr (SP2) {
            PG8_LDB(B0, 0, 0); PG8_LDB(B1, 0, 1); PG8_SCHED; PG8_LDA(At, 0, 0); PG8_STAGE(PG8_SA(1, 1), a1 + hstepA, voffA);
            PG8_WAIT_V(8); PG8_WAIT_L(0); PG8_BAR; PG8_MMA(0, 0, At, B0); PG8_MMA(0, 1, At, B1); PG8_BAR; PG8_SCHED;
            PG8_LDA(At, 0, 1); PG8_STAGE(PG8_SB(0, 0), b2, voffB); PG8_STAGE(PG8_SB(0, 1), b2 + hstepB, voffB); PG8_STAGE(PG8_SA(0, 0), a2, voffA);
            PG8_WAIT_V(8); PG8_WAIT_L(0); PG8_BAR; PG8_MMA(1, 0, At, B0); PG8_MMA(1, 1, At, B1); PG8_BAR; PG8_SCHED;
            PG8_LDB(B0, 1, 0); PG8_LDB(B1, 1, 1); PG8_SCHED; PG8_LDA(At, 1, 0); PG8_STAGE(PG8_SA(0, 1), a2 + hstepA, voffA);
            PG8_WAIT_V(8); PG8_WAIT_L(0); PG8_BAR; PG8_MMA(0, 0, At, B0); PG8_MMA(0, 1, At, B1); PG8_BAR; PG8_SCHED;
            PG8_LDA(At, 1, 1); PG8_STAGE(PG8_SB(1, 0), b3, voffB); PG8_STAGE(PG8_SB(1, 1), b3 + hstepB, voffB); PG8_STAGE(PG8_SA(1, 0), a3, voffA);
            PG8_WAIT_V(8); PG8_WAIT_L(0); PG8_BAR; PG8_MMA(1, 0, At, B0); PG8_MMA(1, 1, At, B1); PG8_BAR; PG8_SCHED;
            } else {
            PG8_LDB(B0, 0, 0); PG8_SCHED; PG8_LDA(At, 0, 0); PG8_STAGE(PG8_SA(1, 1), a1 + hstepA, voffA);
            PG8_WAIT_L(8); PG8_BAR; PG8_WAIT_L(0); PG8_MMA(0, 0, At, B0); PG8_BAR; PG8_SCHED;
            PG8_LDB(B1, 0, 1); PG8_STAGE(PG8_SB(0, 0), b2, voffB);
            PG8_BAR; PG8_WAIT_L(0); PG8_MMA(0, 1, At, B1); PG8_BAR;
            PG8_LDA(At, 0, 1); PG8_STAGE(PG8_SA(0, 0), a2, voffA);
            PG8_BAR; PG8_WAIT_L(0); PG8_MMA(1, 0, At, B0); PG8_BAR; PG8_SCHED;
            PG8_STAGE(PG8_SB(0, 1), b2 + hstepB, voffB);
            PG8_WAIT_V(6); PG8_BAR; PG8_MMA(1, 1, At, B1); PG8_BAR;
            PG8_LDB(B0, 1, 0); PG8_SCHED; PG8_LDA(At, 1, 0); PG8_STAGE(PG8_SA(0, 1), a2 + hstepA, voffA);
            PG8_WAIT_L(8); PG8_BAR; PG8_WAIT_L(0); PG8_MMA(0, 0, At, B0); PG8_BAR; PG8_SCHED;
            PG8_LDB(B1, 1, 1); PG8_STAGE(PG8_SB(1, 0), b3, voffB);
            PG8_BAR; PG8_WAIT_L(0); PG8_MMA(0, 1, At, B1); PG8_BAR;
            PG8_LDA(At, 1, 1); PG8_STAGE(PG8_SA(1, 0), a3, voffA);
            PG8_BAR; PG8_WAIT_L(0); PG8_MMA(1, 0, At, B0); PG8_BAR; PG8_SCHED;
            PG8_STAGE(PG8_SB(1, 1), b3 + hstepB, voffB);
            PG8_WAIT_V(6); PG8_BAR; PG8_MMA(1, 1, At, B1); PG8_BAR;
            }
        }
        if constexpr (ALIGN_EPI) { if (wr == 0) PG8_BAR; }
        if constexpr (!Epi::AFTER_DRAIN) { E(acc, cur, wr, wc, fr, fq); S.done(cur); }
        if (!has_next) break;
#pragma unroll
        for (int a = 0; a < 2; ++a)
#pragma unroll
            for (int b = 0; b < 2; ++b)
#pragma unroll
                for (int m = 0; m < 4; ++m)
#pragma unroll
                    for (int n = 0; n < 2; ++n) acc[a][b][m][n] = (f32x4){0.f, 0.f, 0.f, 0.f};
        cur = nxt; cA = nA; cB = nB; ++ui;
        if constexpr (ALIGN_EPI) { if (wr == 1) PG8_BAR; }
    }
    PG8_WAIT_V(0);
    if constexpr (!ALIGN_EPI) { if (wr == 0) PG8_BAR; }
    PG8_BAR;
    if constexpr (Epi::AFTER_DRAIN) { E.fused(acc, cur, wr, wc, fr, fq, lds, wid, lane); S.done(cur); }
#undef PG8_SA
#undef PG8_SB
#undef PG8_STAGE
#undef PG8_LDA
#undef PG8_LDB
#undef PG8_MMA
#undef PG8_WAIT_V
#undef PG8_WAIT_L
#undef PG8_BAR
#undef PG8_SCHED
}

template <class F> struct EpiW {
    static constexpr bool PERM = true, AFTER_DRAIN = false; F f;
    __device__ __forceinline__ void operator()(const f32x4 (&acc)[2][2][4][2], const Unit& u, int wr, int wc, int fr, int fq) const {
#pragma unroll
        for (int ai = 0; ai < 2; ++ai)
#pragma unroll
            for (int m = 0; m < 4; ++m) { f.apply(u.pm * BM + ai * HALF + wr * 64 + m * 16 + fr, u.pn, wc * 32 + 8 * fq, acc[ai][0][m][0], acc[ai][0][m][1], acc[ai][1][m][0], acc[ai][1][m][1]);
                asm volatile("" ::: "memory"); }
    }
};
}

template <class F>
__device__ __forceinline__ void mfma_gemm(const Ctx& C, const bf16* A, int lda, int acol, const bf16* Bt, int ldb, int Mr, int N, int K, const F& f) {
    pg8::Gemm g{A, Bt, Mr, N, K, lda, ldb, acol}; pg8::StaticOrder S; S.init(Mr, N, C.nblk, C.blk); pg8::EpiW<F> E{f};
    pg8::gemm_phase<pg8::EpiW<F>, pg8::StaticOrder, true, true>(C.lds, g, S, E);
}

template <class F>
__device__ __forceinline__ void naive_gemm(const Ctx& C, const bf16* A, int lda, int acol, const bf16* Bt, int ldb, int Mr, int N, int K, const F& f) {
    LAS float* As = (LAS float*)C.lds;
    LAS float* Bs = (LAS float*)(C.lds + 8192);
    const int ntm = Mr / 128, ntn = N / 256, tid = C.tid, cg = tid & 15, r0 = tid >> 4;
    for (int tile = C.blk; tile < ntm * ntn; tile += C.nblk) {
        const int tm = tile / ntn, pn = tile % ntn;
        f32x4 acc[4][4];
#pragma unroll
        for (int i = 0; i < 4; ++i)
#pragma unroll
            for (int j = 0; j < 4; ++j) acc[i][j] = (f32x4){0.f, 0.f, 0.f, 0.f};
        const bf16* ap = A + (size_t)(tm * 128 + (tid >> 2)) * lda + pn * acol + (tid & 3) * 4;
        const bf16* bp = Bt + (size_t)(pn * 256 + (tid >> 1)) * ldb + (tid & 1) * 8;
        for (int k0 = 0; k0 < K; k0 += 16) {
            const u32x2 av = *(const u32x2*)(ap + k0); const u32x4 bv = *(const u32x4*)(bp + k0);
            __syncthreads();
            { const int r = tid >> 2, kq = (tid & 3) * 4; As[(kq + 0) * 128 + r] = bflo(av.x); As[(kq + 1) * 128 + r] = bfhi(av.x); As[(kq + 2) * 128 + r] = bflo(av.y); As[(kq + 3) * 128 + r] = bfhi(av.y); }
            { const int n = tid >> 1, kq = (tid & 1) * 8; Bs[(kq + 0) * 256 + n] = bflo(bv.x); Bs[(kq + 1) * 256 + n] = bfhi(bv.x); Bs[(kq + 2) * 256 + n] = bflo(bv.y); Bs[(kq + 3) * 256 + n] = bfhi(bv.y);
              Bs[(kq + 4) * 256 + n] = bflo(bv.z); Bs[(kq + 5) * 256 + n] = bfhi(bv.z); Bs[(kq + 6) * 256 + n] = bflo(bv.w); Bs[(kq + 7) * 256 + n] = bfhi(bv.w); }
            __syncthreads();
#pragma unroll
            for (int kk = 0; kk < 16; ++kk) {
                const f32x4 b0 = *(const LAS f32x4*)(Bs + kk * 256 + cg * 8), b1 = *(const LAS f32x4*)(Bs + kk * 256 + cg * 8 + 4), b2 = *(const LAS f32x4*)(Bs + kk * 256 + 128 + cg * 8), b3 = *(const LAS f32x4*)(Bs + kk * 256 + 128 + cg * 8 + 4);
#pragma unroll
                for (int i = 0; i < 4; ++i) { const float av1 = As[kk * 128 + r0 + 32 * i]; acc[i][0] += b0 * av1; acc[i][1] += b1 * av1; acc[i][2] += b2 * av1; acc[i][3] += b3 * av1; }
            }
        }
#pragma unroll
        for (int i = 0; i < 4; ++i) f.apply(tm * 128 + r0 + 32 * i, pn, cg * 8, acc[i][0], acc[i][1], acc[i][2], acc[i][3]);
    }
}

template <int W>
__device__ __forceinline__ void pool_item(const bf16* ZP, bf16* PL, int m0, int t0, int c0) {
    float p0[47], p1[47];
#pragma unroll
    for (int i = 0; i < 47; ++i) { const int r = t0 - 15 + i; unsigned w = 0u; if (i >= 15 - (W - 1)) { if (r >= 0) w = *(const unsigned*)(ZP + (size_t)(m0 - 15 + i) * D + c0); } p0[i] = bflo(w); p1[i] = bfhi(w); }
#pragma unroll
    for (int ti = 0; ti < 32; ++ti) {
        float s0 = 0.f, s1 = 0.f;
#pragma unroll
        for (int j = 0; j < W; ++j) { s0 += p0[ti + 15 - j]; s1 += p1[ti + 15 - j]; }
        const int cnt = (t0 + ti + 1) < W ? (t0 + ti + 1) : W; const float inv = 1.f / (float)cnt;
        *(unsigned*)(PL + (size_t)(m0 + ti) * D + c0) = pk2(s0 * inv - p0[ti + 15], s1 * inv - p1[ti + 15]);
    }
}
__device__ __forceinline__ void phase_convpool(const Ctx& C, const Args& a, int l) {
    const bf16* UG = (const bf16*)(a.ws + WS_UG); const bf16* ZP = (const bf16*)(a.ws + WS_ZP);
    bf16* AC = (bf16*)(a.ws + WS_AC); bf16* PL = (bf16*)(a.ws + WS_PL);
    const float* cw = a.in[I_CONVW] + (size_t)l * CONVK * D; const float* cb = a.in[I_CONVB] + (size_t)l * D;
    const float* lng = a.in[I_LNG] + (size_t)l * D; const float* lnb = a.in[I_LNB] + (size_t)l * D;
    LAS float* red = (LAS float*)C.lds;
    LAS float* stat = (LAS float*)(C.lds + 2048);
    int c0 = 2 * C.tid;
    asm volatile("" : "+v"(c0));
    float w0[31], w1[31];
#pragma unroll
    for (int k = 0; k < 31; ++k) { const f32x2 w = *(const f32x2*)(cw + (size_t)k * D + c0); w0[k] = w.x; w1[k] = w.y; }
    for (int item = C.blk; item < M / 32; item += C.nblk) {
        const int m0 = item * 32, t0 = m0 & (SEQ - 1);
        asm volatile("" : "+v"(c0));
        float a0[32], a1[32];
#pragma unroll
        for (int i = 0; i < 32; ++i) { a0[i] = 0.f; a1[i] = 0.f; }
#pragma unroll
        for (int ri = 0; ri < 62; ++ri) {
            unsigned w = 0u; if (t0 - 30 + ri >= 0) w = *(const unsigned*)(UG + (size_t)(m0 - 30 + ri) * D + c0);
            const float u0 = bflo(w), u1 = bfhi(w);
#pragma unroll
            for (int ti = 0; ti < 32; ++ti) { const int d = ti + 30 - ri; if (d >= 0 && d <= 30) { a0[ti] += w0[30 - d] * u0; a1[ti] += w1[30 - d] * u1; } }
            if ((ri & 7) == 7) asm volatile("" ::: "memory");
        }
        const f32x2 bb = *(const f32x2*)(cb + c0);
        __syncthreads();
#pragma unroll
        for (int ti = 0; ti < 32; ++ti) {
            a0[ti] += bb.x; a1[ti] += bb.y;
            const float s = wave_sum(a0[ti] + a1[ti]), q = wave_sum(a0[ti] * a0[ti] + a1[ti] * a1[ti]);
            if (C.lane == 0) { red[C.wave * 64 + ti] = s; red[C.wave * 64 + 32 + ti] = q; }
        }
        __syncthreads();
        if (C.tid < 32) { float s = 0.f, q = 0.f;
#pragma unroll
            for (int w = 0; w < 8; ++w) { s += red[w * 64 + C.tid]; q += red[w * 64 + 32 + C.tid]; }
            const float mean = s * (1.f / D), var = fmaxf(q * (1.f / D) - mean * mean, 0.f); stat[C.tid] = mean; stat[32 + C.tid] = 1.f / sqrtf(var + EPS); }
        __syncthreads();
        const f32x2 gg = *(const f32x2*)(lng + c0), be = *(const f32x2*)(lnb + c0);
#pragma unroll
        for (int ti = 0; ti < 32; ++ti) { const float mean = stat[ti], rstd = stat[32 + ti];
            const float y0 = (a0[ti] - mean) * rstd * gg.x + be.x, y1 = (a1[ti] - mean) * rstd * gg.y + be.y;
            *(unsigned*)(AC + (size_t)(m0 + ti) * D + c0) = pk2(y0 * sigm(y0), y1 * sigm(y1)); }
        asm volatile("" ::: "memory");
        const int g = C.tid >> 7;
        if (g == 0) pool_item<2>(ZP, PL, m0, t0, c0); else if (g == 1) pool_item<4>(ZP, PL, m0, t0, c0); else if (g == 2) pool_item<8>(ZP, PL, m0, t0, c0); else pool_item<16>(ZP, PL, m0, t0, c0);
    }
}

__device__ __forceinline__ int wave_min_i(int v) {
#pragma unroll
    for (int o = 1; o < 64; o <<= 1) { const int t = __shfl_xor(v, o); v = t < v ? t : v; }
    return v;
}
__device__ __forceinline__ void phase_topk(const Ctx& C, const Args& a) {
    const float* S = (const float*)(a.ws + WS_S); int* EID = (int*)(a.ws + WS_EID); float* GW = (float*)(a.ws + WS_GW);
    const int lane = C.lane; const float NEG = -3.0e38f;
    for (int it = C.gw; it < M * NHEAD; it += C.ngw) {
        const int tok = it >> 3, h = it & 7;
        float hv[2] = {0.f, 0.f}; int hi[2] = {0, 0};
#pragma unroll
        for (int p = 0; p < 2; ++p) {
            const f32x2 v = *(const f32x2*)(S + (size_t)tok * DQ + h * 256 + p * 128 + 2 * lane);
            float v0 = v.x, v1 = v.y; float sv = 0.f; int si = 0;
            for (int k = 0; k < TOPK; ++k) {
                const float m = fmaxf(v0, v1), wm = wave_max(m);
                const int cand = (v0 == wm) ? 2 * lane : ((v1 == wm) ? 2 * lane + 1 : 9999);
                const int idx = wave_min_i(cand);
                if (idx == 2 * lane) v0 = NEG; else if (idx == 2 * lane + 1) v1 = NEG;
                if (lane == k) { sv = wm; si = idx; }
            }
            hv[p] = sv; hi[p] = si;
        }
        float cv[4];
#pragma unroll
        for (int e = 0; e < 4; ++e) cv[e] = __shfl(hv[0], lane >> 2) + __shfl(hv[1], (lane & 3) * 4 + e);
        float tv = 0.f; int tf = 0;
        for (int k = 0; k < TOPK; ++k) {
            const float m = fmaxf(fmaxf(cv[0], cv[1]), fmaxf(cv[2], cv[3])), wm = wave_max(m);
            const int cand = (cv[0] == wm) ? 4 * lane : (cv[1] == wm) ? 4 * lane + 1 : (cv[2] == wm) ? 4 * lane + 2 : (cv[3] == wm) ? 4 * lane + 3 : 9999;
            const int idx = wave_min_i(cand);
            if (idx == 4 * lane) cv[0] = NEG; else if (idx == 4 * lane + 1) cv[1] = NEG; else if (idx == 4 * lane + 2) cv[2] = NEG; else if (idx == 4 * lane + 3) cv[3] = NEG;
            if (lane == k) { tv = wm; tf = idx; }
        }
        const float mx = __shfl(tv, 0); float ex = __expf(tv - mx); float sum = ex;
        sum += __shfl_xor(sum, 1); sum += __shfl_xor(sum, 2); sum += __shfl_xor(sum, 4); sum += __shfl_xor(sum, 8);
        const int i1 = __shfl(hi[0], (tf >> 4) & 15), i2 = __shfl(hi[1], tf & 15);
        if (lane < 16) { EID[(size_t)tok * 128 + h * 16 + lane] = i1 * 128 + i2; GW[(size_t)tok * 128 + h * 16 + lane] = ex / sum; }
    }
}

__device__ __forceinline__ void phase_topk_serial(const Ctx& C, const Args& a) {
    float* S = (float*)(a.ws + WS_S); int* EID = (int*)(a.ws + WS_EID); float* GW = (float*)(a.ws + WS_GW);
    float* SCR = (float*)(a.ws + WS_Q);
    const float NEG = -3.0e38f;
    const int gt = C.blk * NTHREADS + C.tid, ngt = C.nblk * NTHREADS;
    for (int it = gt; it < M * NHEAD; it += ngt) {
        const int tok = it >> 3, h = it & 7;
        float* sc = SCR + (size_t)it * 128;
        for (int p = 0; p < 2; ++p) {
            float* sp = S + (size_t)tok * DQ + h * 256 + p * 128;
            for (int k = 0; k < 16; ++k) {
                float best = NEG; int bi = 0;
                for (int n = 0; n < 128; ++n) { const float v = sp[n]; if (v > best) { best = v; bi = n; } }
                sc[p * 16 + k] = best; ((int*)sc)[32 + p * 16 + k] = bi; sp[bi] = NEG;
            }
        }
        float tv[16]; int tf[16];
        float mx = NEG, lastv = 0.f; int lastn = -1;
#pragma unroll
        for (int k = 0; k < 16; ++k) {
            float best = NEG; int bi = 0;
            for (int n = 0; n < 256; ++n) { const float v = sc[n >> 4] + sc[16 + (n & 15)];
                const bool elig = (k == 0) || (v < lastv) || (v == lastv && n > lastn);
                if (elig && v > best) { best = v; bi = n; } }
            tv[k] = best; tf[k] = bi; lastv = best; lastn = bi; if (k == 0) mx = best;
        }
        float sum = 0.f;
#pragma unroll
        for (int k = 0; k < 16; ++k) { tv[k] = __expf(tv[k] - mx); sum += tv[k]; }
#pragma unroll
        for (int k = 0; k < 16; ++k) { const int i1 = ((int*)sc)[32 + (tf[k] >> 4)], i2 = ((int*)sc)[48 + (tf[k] & 15)];
            EID[(size_t)tok * 128 + h * 16 + k] = i1 * 128 + i2; GW[(size_t)tok * 128 + h * 16 + k] = tv[k] / sum; }
    }
}

__device__ __forceinline__ void phase_peer(const Ctx& C, const Args& a, int l) {
    const bf16* UB = (const bf16*)(a.ws + WS_UB) + (size_t)l * NEXP * D; const bf16* VB = (const bf16*)(a.ws + WS_VB) + (size_t)l * NEXP * D;
    const int* EID = (const int*)(a.ws + WS_EID); const float* GW = (const float*)(a.ws + WS_GW);
    float* XW = a.out; bf16* H = (bf16*)(a.ws + WS_H); const int lane = C.lane;
    for (int m = C.gw; m < M; m += C.ngw) {
        const int b = m >> 13; f32x4 x[4], h[4], o[4];
#pragma unroll
        for (int j = 0; j < 4; ++j) { x[j] = *(const f32x4*)(XW + (size_t)m * D + 4 * lane + 256 * j); o[j] = (f32x4){0.f, 0.f, 0.f, 0.f}; }
        normmod_row(x, a.in[I_N2G] + (size_t)l * D, modp(a, l, b, 3), modp(a, l, b, 4), lane, h);
        const int e0 = EID[(size_t)m * 128 + lane], e1 = EID[(size_t)m * 128 + 64 + lane];
        const float g0 = GW[(size_t)m * 128 + lane], g1 = GW[(size_t)m * 128 + 64 + lane];
        for (int k = 0; k < 128; ++k) {
            const int e = __shfl(k < 64 ? e0 : e1, k & 63); const float gwk = __shfl(k < 64 ? g0 : g1, k & 63);
            const bf16* ur = UB + (size_t)e * D + 4 * lane; const bf16* vr = VB + (size_t)e * D + 4 * lane;
            u32x2 uw[4], vw[4];
#pragma unroll
            for (int j = 0; j < 4; ++j) { uw[j] = *(const u32x2*)(ur + 256 * j); vw[j] = *(const u32x2*)(vr + 256 * j); }
            float d = 0.f;
#pragma unroll
            for (int j = 0; j < 4; ++j) d += (bflo(uw[j].x) * h[j].x + bfhi(uw[j].x) * h[j].y) + (bflo(uw[j].y) * h[j].z + bfhi(uw[j].y) * h[j].w);
            d = wave_sum(d);
            const float act = 0.5f * d * (1.f + erff(d * 0.70710678118654752f)), cf = gwk * act;
#pragma unroll
            for (int j = 0; j < 4; ++j) { o[j].x += cf * bflo(vw[j].x); o[j].y += cf * bfhi(vw[j].x); o[j].z += cf * bflo(vw[j].y); o[j].w += cf * bfhi(vw[j].y); }
        }
        const float* g2 = modp(a, l, b, 5);
#pragma unroll
        for (int j = 0; j < 4; ++j) x[j] += *(const f32x4*)(g2 + 4 * lane + 256 * j) * o[j];
        if (l + 1 < DEPTH) {
#pragma unroll
            for (int j = 0; j < 4; ++j) *(f32x4*)(XW + (size_t)m * D + 4 * lane + 256 * j) = x[j];
            normmod_row(x, a.in[I_N1G] + (size_t)(l + 1) * D, modp(a, l + 1, b, 0), modp(a, l + 1, b, 1), lane, h);
            store_row_bf16(H + (size_t)m * D, h, lane);
        } else {
            float s = 0.f;
#pragma unroll
            for (int j = 0; j < 4; ++j) s += (x[j].x * x[j].x + x[j].y * x[j].y) + (x[j].z * x[j].z + x[j].w * x[j].w);
            const float rstd = 1.f / sqrtf(wave_sum(s) * (1.f / D) + EPS);
#pragma unroll
            for (int j = 0; j < 4; ++j) *(f32x4*)(a.out + (size_t)m * D + 4 * lane + 256 * j) = x[j] * rstd * *(const f32x4*)(a.in[I_FG] + 4 * lane + 256 * j);
        }
    }
}

#ifndef USE_NAIVE
#define GEMM mfma_gemm
#else
#define GEMM naive_gemm
#endif
#define RLX_AGENT __ATOMIC_RELAXED, __HIP_MEMORY_SCOPE_AGENT
#define XB_TMO      128
#define XB_XCNT(j)  (256  + 64 * (j))
#define XB_XSUB(j)  (1280 + 64 * (j))
#define XB_XGEN(j)  (2304 + 64 * (j))
#define XB_TOP      3328
#define XB_TOPGEN   3392
#define XCD_BAR_WORDS 3456
#define XB_SPIN_CAP (1u << 18)

__device__ __forceinline__ unsigned xb_ld(unsigned* p)              { return __hip_atomic_load(p, __ATOMIC_RELAXED, __HIP_MEMORY_SCOPE_AGENT); }
__device__ __forceinline__ unsigned xb_add(unsigned* p, unsigned v) { return __hip_atomic_fetch_add(p, v, __ATOMIC_RELAXED, __HIP_MEMORY_SCOPE_AGENT); }
__device__ __forceinline__ unsigned xb_xcc_id() { return (unsigned)__builtin_amdgcn_s_getreg((3 << 11) | 20) & 0xFu; }
#define XB_SPIN(cond, bar) do { unsigned _sp = 0; while (cond) { __builtin_amdgcn_s_sleep(1); \
    if ((++_sp & 255u) == 0u) { if (xb_ld(&(bar)[XB_TMO])) break; if (_sp > XB_SPIN_CAP) { atomicAdd(&(bar)[XB_TMO], 1u); break; } } } } while (0)

struct XcdBarrier {
    unsigned* bar; unsigned x;
    volatile LAS unsigned* st;
};

__device__ __forceinline__ XcdBarrier xcd_barrier_post(unsigned* bar, volatile LAS unsigned* st) {
    XcdBarrier b; b.bar = bar; b.x = xb_xcc_id(); b.st = st;
    if (threadIdx.x == 0) (void)xb_add(&bar[XB_XCNT(b.x)], 1u);
    return b;
}
__device__ __forceinline__ void xcd_barrier_complete(unsigned* bar, unsigned x, unsigned& nloc, unsigned& nx) {
    const unsigned G = gridDim.x * gridDim.y * gridDim.z;
    unsigned sum, cnt, mine, sp = 0u;
    for (;;) {
        sum = 0u; cnt = 0u; mine = 0u;
#pragma unroll
        for (unsigned j = 0; j < 16; ++j) { const unsigned c = xb_ld(&bar[XB_XCNT(j)]); sum += c; cnt += (c > 0u) ? 1u : 0u; mine = (j == x) ? c : mine; }
        if (sum == G) break;
        __builtin_amdgcn_s_sleep(1);
        if ((++sp & 255u) == 0u) { if (xb_ld(&bar[XB_TMO])) break; if (sp > XB_SPIN_CAP) { atomicAdd(&bar[XB_TMO], 1u); break; } }
    }
    nloc = mine > 0u ? mine : 1u; nx = cnt > 0u ? cnt : 1u;
}

__device__ __forceinline__ void xcd_barrier(const XcdBarrier& b) {
    asm volatile("s_waitcnt vmcnt(0)" ::: "memory");
    __syncthreads();
    if (threadIdx.x == 0) {
        unsigned* bar = b.bar;
        __builtin_amdgcn_s_waitcnt(0);
        unsigned nloc = b.st[0], nx = b.st[1];
        if (nloc == 0u) { xcd_barrier_complete(bar, b.x, nloc, nx); b.st[0] = nloc; b.st[1] = nx; }
        const unsigned old = xb_add(&bar[XB_XSUB(b.x)], 1u);
        const unsigned gen = old / nloc;
        if (old + 1u == (gen + 1u) * nloc) {
            __builtin_amdgcn_fence(__ATOMIC_RELEASE, "agent");
            asm volatile("s_waitcnt vmcnt(0)" ::: "memory");
            const unsigned og = xb_add(&bar[XB_TOP], 1u);
            const unsigned tg = og / nx;
            if (og + 1u == (tg + 1u) * nx) xb_add(&bar[XB_TOPGEN], 1u);
            else XB_SPIN(xb_ld(&bar[XB_TOPGEN]) == tg, bar);
            __builtin_amdgcn_fence(__ATOMIC_ACQUIRE, "agent");
            xb_add(&bar[XB_XGEN(b.x)], 1u);
            asm volatile("s_waitcnt vmcnt(0)" ::: "memory");
        } else {
            XB_SPIN(xb_ld(&bar[XB_XGEN(b.x)]) == gen, bar);
            __builtin_amdgcn_fence(__ATOMIC_ACQUIRE, "agent");
            asm volatile("s_waitcnt vmcnt(0)" ::: "memory");
        }
    }
    __syncthreads();
}

constexpr int CW_BAR = 4096;
constexpr size_t CTL_ZERO_BYTES = 65536;
constexpr int LDSCTL_OFF = 131072, MISC_OFF = LDSCTL_OFF + 320;
constexpr int PH_PREP = 0, PH_MODR = 1, PH_N1 = 2, PH_L0 = 3, PH_PER_LAYER = 10, N_PHASES = PH_L0 + DEPTH * PH_PER_LAYER;
__device__ __forceinline__ Ctx make_ctx(LAS unsigned char* lds) {
    int tid_ = threadIdx.x; asm volatile("" : "+v"(tid_));
    Ctx C; C.tid = tid_; C.lane = C.tid & 63; C.wave = __builtin_amdgcn_readfirstlane(C.tid >> 6); C.nblk = gridDim.x; C.blk = blockIdx.x;
    C.gw = C.blk * NWAVES + C.wave; C.ngw = C.nblk * NWAVES; C.lds = lds; return C;
}
#define PH(k, ...) if (a.ph_lo <= (k) && (k) < a.ph_hi) { const Ctx C = make_ctx(lds); __VA_ARGS__; if ((k) + 1 < a.ph_hi) xcd_barrier(bar); }
template <int l>
__device__ __forceinline__ void run_layer(const Args& a, LAS unsigned char* lds, const XcdBarrier& bar) {
    unsigned char* ws = a.ws; constexpr int B0 = PH_L0 + l * PH_PER_LAYER;
    PH(B0 + 0, EpiIn E{a.in[I_BIN] + (size_t)l * DIN, (bf16*)(ws + WS_UG), (bf16*)(ws + WS_ZP), (bf16*)(ws + WS_G)};
               GEMM(C, (const bf16*)(ws + WS_H), D, 0, (const bf16*)(ws + WS_WIN) + (size_t)l * DIN * D, D, M, DIN, D, E))
    PH(B0 + 1, phase_convpool(C, a, l))
    PH(B0 + 2, EpiPool E{(const bf16*)(ws + WS_G), a.in[I_POOLS] + (size_t)l * D, (bf16*)(ws + WS_TMP)};
               GEMM(C, (const bf16*)(ws + WS_PL), D, 256, (const bf16*)(ws + WS_POOL) + (size_t)l * 1024 * 256, 256, M, D, 256, E))
    PH(B0 + 3, EpiConv E{(const bf16*)(ws + WS_G), (const bf16*)(ws + WS_TMP), (bf16*)(ws + WS_Y)};
               GEMM(C, (const bf16*)(ws + WS_AC), D, 0, (const bf16*)(ws + WS_WCO) + (size_t)l * D * D, D, M, D, D, E))
    PH(B0 + 4, EpiOut E{l == 0 ? a.in[I_X] : a.out, a.out, modp(a, l, 0, 2), a.in[I_BOUT] + (size_t)l * D};
               GEMM(C, (const bf16*)(ws + WS_Y), D, 0, (const bf16*)(ws + WS_WOUT) + (size_t)l * D * D, D, M, D, D, E))
    PH(B0 + 5, phase_norm(C, a, a.out, a.in[I_N2G] + (size_t)l * D, l, 3, 4))
    PH(B0 + 6, EpiQ E{(bf16*)(ws + WS_Q)}; GEMM(C, (const bf16*)(ws + WS_H), D, 0, (const bf16*)(ws + WS_WQ) + (size_t)l * DQ * D, D, M, DQ, D, E))
    PH(B0 + 7, EpiS E{(float*)(ws + WS_S)}; GEMM(C, (const bf16*)(ws + WS_Q), DQ, 256, (const bf16*)(ws + WS_KEYS) + (size_t)l * 2048 * 256, 256, M, DQ, 256, E))
    PH(B0 + 8, phase_topk(C, a))
    PH(B0 + 9, phase_peer(C, a, l))
}
__global__ void __launch_bounds__(NTHREADS, 2) fwd_kernel(Args a) {
    extern __shared__ __attribute__((aligned(16))) unsigned char lds_raw[];
    LAS unsigned char* lds = (LAS unsigned char*)lds_raw;
    for (int u = threadIdx.x; u < (LDS_BYTES - LDSCTL_OFF) / 4; u += NTHREADS) ((LAS unsigned*)(lds + LDSCTL_OFF))[u] = 0u;
    __syncthreads();
    const XcdBarrier bar = xcd_barrier_post((unsigned*)(a.ws + WS_CTL) + CW_BAR, (volatile LAS unsigned*)(lds + MISC_OFF) + 8);
    PH(PH_PREP, phase_prep(C, a))
    PH(PH_MODR, phase_modreduce(C, a))
    PH(PH_N1, phase_norm(C, a, a.in[I_X], a.in[I_N1G], 0, 0, 1))
    run_layer<0>(a, lds, bar);
    run_layer<1>(a, lds, bar);
}

extern "C" void kernel_launch(void* const* d_in, const int* in_sizes, int n_in, void* d_out, int out_size, void* d_ws, size_t ws_size, hipStream_t stream) {
    static int grid = 0;
    if (grid == 0) {
        if (n_in != 22 || out_size != M * D || ws_size < WS_END) { fprintf(stderr, "kernel_launch: unexpected shapes (n_in %d out %d ws %zu)\n", n_in, out_size, ws_size); grid = -1; return; }
        int dev = 0, cus = 0;
        if (hipGetDevice(&dev) != hipSuccess || hipDeviceGetAttribute(&cus, hipDeviceAttributeMultiprocessorCount, dev) != hipSuccess) { grid = -1; return; }
        if (hipFuncSetAttribute((const void*)fwd_kernel, hipFuncAttributeMaxDynamicSharedMemorySize, LDS_BYTES) != hipSuccess) { grid = -1; return; }
        grid = cus;
    }
    if (grid < 0) return;
    Args a{};
    for (int i = 0; i < 22; ++i) a.in[i] = (const float*)d_in[i];
    a.out = (float*)d_out; a.ws = (unsigned char*)d_ws;
    (void)hipMemsetAsync((char*)d_ws + WS_CTL, 0, CTL_ZERO_BYTES, stream);
#ifndef ONE_LAUNCH
    for (int ph = 0; ph < N_PHASES; ++ph) { a.ph_lo = ph; a.ph_hi = ph + 1; hipLaunchKernelGGL(fwd_kernel, dim3(grid), dim3(NTHREADS), LDS_BYTES, stream, a); }
#else
    a.ph_lo = 0; a.ph_hi = N_PHASES; hipLaunchKernelGGL(fwd_kernel, dim3(grid), dim3(NTHREADS), LDS_BYTES, stream, a);
#endif
}
```

```cpp
#define ONE_LAUNCH 1
#include <hip/hip_runtime.h>
#include <cstdint>
#include <cstdio>

#define GAS __attribute__((address_space(1)))
#define LAS __attribute__((address_space(3)))
typedef unsigned short bf16;
typedef float f32x4 __attribute__((ext_vector_type(4)));
typedef float f32x2 __attribute__((ext_vector_type(2)));
typedef unsigned u32x4 __attribute__((ext_vector_type(4)));
typedef unsigned u32x2 __attribute__((ext_vector_type(2)));
typedef __bf16 bf16x2_t __attribute__((ext_vector_type(2)));

constexpr int BATCH = 2, SEQ = 8192, D = 1024, M = BATCH * SEQ, DEPTH = 2;
constexpr int DIN = 5120, NMODV = 6 * D, CONVK = 31, NHEAD = 8, NKEYS = 128, DQ = 2048, TOPK = 16, NEXP = 16384;
constexpr float EPS = 1e-6f;
constexpr int NWAVES = 8, NTHREADS = NWAVES * 64;

constexpr size_t MiB = 1u << 20;
constexpr size_t WS_CTL = 0;
constexpr size_t WS_MODP = 1 * MiB;
constexpr size_t WS_MOD = 4 * MiB;
constexpr size_t WS_WIN = 8 * MiB;
constexpr size_t WS_WCO = 28 * MiB;
constexpr size_t WS_WOUT = 32 * MiB;
constexpr size_t WS_WQ = 36 * MiB;
constexpr size_t WS_POOL = 44 * MiB;
constexpr size_t WS_KEYS = 45 * MiB;
constexpr size_t WS_UB = 48 * MiB;
constexpr size_t WS_VB = 112 * MiB;
constexpr size_t WS_H = 176 * MiB;
constexpr size_t WS_UG = 208 * MiB;
constexpr size_t WS_Y = WS_UG;
constexpr size_t WS_ZP = 240 * MiB;
constexpr size_t WS_TMP = WS_ZP;
constexpr size_t WS_Q = WS_UG;
constexpr size_t WS_G = 272 * MiB;
constexpr size_t WS_AC = 336 * MiB;
constexpr size_t WS_PL = 368 * MiB;
constexpr size_t WS_S = WS_G;
constexpr size_t WS_EID = 400 * MiB;
constexpr size_t WS_GW = 408 * MiB;
constexpr size_t WS_END = 416 * MiB;

constexpr int LDS_BYTES = 147456;

__device__ __forceinline__ unsigned f2bf(float f) { unsigned u = __builtin_bit_cast(unsigned, f); return (u + 0x7fffu + ((u >> 16) & 1u)) >> 16; }
__device__ __forceinline__ unsigned pk2(float lo, float hi) { return f2bf(lo) | (f2bf(hi) << 16); }
__device__ __forceinline__ float bflo(unsigned w) { return __builtin_bit_cast(float, w << 16); }
__device__ __forceinline__ float bfhi(unsigned w) { return __builtin_bit_cast(float, w & 0xffff0000u); }
__device__ __forceinline__ float sigm(float x) { return 1.f / (1.f + __expf(-x)); }
__device__ __forceinline__ float wave_sum(float v) {
#pragma unroll
    for (int o = 1; o < 64; o <<= 1) v += __shfl_xor(v, o);
    return v;
}
__device__ __forceinline__ float wave_max(float v) {
#pragma unroll
    for (int o = 1; o < 64; o <<= 1) v = fmaxf(v, __shfl_xor(v, o));
    return v;
}
__device__ __forceinline__ u32x4 pack8(const f32x4& a, const f32x4& b) { u32x4 w; w.x = pk2(a.x, a.y); w.y = pk2(a.z, a.w); w.z = pk2(b.x, b.y); w.w = pk2(b.z, b.w); return w; }
__device__ __forceinline__ void unpack8(const u32x4& w, f32x4& a, f32x4& b) { a = (f32x4){bflo(w.x), bfhi(w.x), bflo(w.y), bfhi(w.y)}; b = (f32x4){bflo(w.z), bfhi(w.z), bflo(w.w), bfhi(w.w)}; }

struct Ctx { int tid, lane, wave, gw, ngw, nblk, blk; LAS unsigned char* lds; };

struct Args { const float* in[22]; float* out; unsigned char* ws; int ph_lo, ph_hi; };
enum { I_X = 0, I_C, I_ADAW, I_ADAB, I_N1G, I_WIN, I_BIN, I_CONVW, I_CONVB, I_LNG, I_LNB, I_WCO, I_POOLW, I_POOLS, I_WOUT, I_BOUT, I_N2G, I_WQ, I_KEYS, I_PU, I_PV, I_FG };

__device__ __forceinline__ void transpose_item(const float* W, int K, int N, int k0, int n0, bf16* WT, int dstrow0, LAS float* scr, int lane) {
#pragma unroll 8
    for (int i = 0; i < 32; ++i) { const int kk = 2 * i + (lane >> 5); scr[kk * 33 + (lane & 31)] = W[(size_t)(k0 + kk) * N + n0 + (lane & 31)]; }
    asm volatile("s_waitcnt lgkmcnt(0)" ::: "memory");
    const int c = lane & 7;
#pragma unroll
    for (int j = 0; j < 4; ++j) { const int n = (lane >> 3) + 8 * j; const LAS float* s = scr + (8 * c) * 33 + n;
        u32x4 o; o.x = pk2(s[0 * 33], s[1 * 33]); o.y = pk2(s[2 * 33], s[3 * 33]); o.z = pk2(s[4 * 33], s[5 * 33]); o.w = pk2(s[6 * 33], s[7 * 33]);
        *(u32x4*)(WT + (size_t)(dstrow0 + n) * K + k0 + 8 * c) = o; }
    asm volatile("s_waitcnt lgkmcnt(0)" ::: "memory");
}
__device__ __forceinline__ int win_dstrow(int n0) {
    if (n0 < 1024) return 256 * (n0 >> 7) + (n0 & 127);
    if (n0 < 2048) { const int c = n0 - 1024; return 256 * (c >> 7) + 128 + (c & 127); }
    return n0;
}
__device__ __forceinline__ void phase_prep(const Ctx& C, const Args& a) {
    unsigned char* ws = a.ws;
    LAS float* scr = (LAS float*)(C.lds + C.wave * 16384);
    constexpr int I_IN = 16 * 160, I_CO = 16 * 32, I_PO = 4 * (4 * 8), I_OUT = 16 * 32, I_Q = 16 * 64, I_L = I_IN + I_CO + I_PO + I_OUT + I_Q;
    for (int it = C.gw; it < DEPTH * I_L; it += C.ngw) {
        const int l = it / I_L; int r = it % I_L;
        if (r < I_IN) { const int kb = r / 160, nb = r % 160; transpose_item(a.in[I_WIN] + (size_t)l * D * DIN, D, DIN, 64 * kb, 32 * nb, (bf16*)(ws + WS_WIN) + (size_t)l * DIN * D, win_dstrow(32 * nb), scr, C.lane); continue; } r -= I_IN;
        if (r < I_CO) { const int kb = r / 32, nb = r % 32; transpose_item(a.in[I_WCO] + (size_t)l * D * D, D, D, 64 * kb, 32 * nb, (bf16*)(ws + WS_WCO) + (size_t)l * D * D, 32 * nb, scr, C.lane); continue; } r -= I_CO;
        if (r < I_PO) { const int g = r / 32, q = r % 32, kb = q / 8, nb = q % 8; transpose_item(a.in[I_POOLW] + ((size_t)l * 4 + g) * 256 * 256, 256, 256, 64 * kb, 32 * nb, (bf16*)(ws + WS_POOL) + ((size_t)l * 1024 + 256 * g) * 256, 32 * nb, scr, C.lane); continue; } r -= I_PO;
        if (r < I_OUT) { const int kb = r / 32, nb = r % 32; transpose_item(a.in[I_WOUT] + (size_t)l * D * D, D, D, 64 * kb, 32 * nb, (bf16*)(ws + WS_WOUT) + (size_t)l * D * D, 32 * nb, scr, C.lane); continue; } r -= I_OUT;
        { const int kb = r / 64, nb = r % 64; transpose_item(a.in[I_WQ] + (size_t)l * D * DQ, D, DQ, 64 * kb, 32 * nb, (bf16*)(ws + WS_WQ) + (size_t)l * DQ * D, 32 * nb, scr, C.lane); }
    }
    const int gt = C.blk * NTHREADS + C.tid, ngt = C.nblk * NTHREADS;
    for (int i = gt; i < DEPTH * 2048 * 32; i += ngt) {
        const int l = i / (2048 * 32), r = i % (2048 * 32), n = r / 32, k8 = (r % 32) * 8;
        const int h = n >> 8, p = (n >> 7) & 1, key = n & 127, pk = k8 >> 7, kk = k8 & 127;
        u32x4 o = (u32x4){0u, 0u, 0u, 0u};
        if (pk == p) { const float* s = a.in[I_KEYS] + ((((size_t)l * 8 + h) * 2 + p) * 128 + key) * 128 + kk; const f32x4 v0 = *(const f32x4*)s, v1 = *(const f32x4*)(s + 4); o = pack8(v0, v1); }
        *(u32x4*)((bf16*)(ws + WS_KEYS) + ((size_t)l * 2048 + n) * 256 + k8) = o;
    }
    for (int t = 0; t < 2; ++t) {
        const float* src = a.in[t == 0 ? I_PU : I_PV]; bf16* dst = (bf16*)(ws + (t == 0 ? WS_UB : WS_VB));
        for (size_t i = gt; i < (size_t)DEPTH * NEXP * D / 8; i += ngt) { const f32x4 v0 = *(const f32x4*)(src + i * 8), v1 = *(const f32x4*)(src + i * 8 + 4); *(u32x4*)(dst + i * 8) = pack8(v0, v1); }
    }
    for (int it = gt; it < 32 * 3072; it += ngt) {
        const int ks = it / 3072, cg = it % 3072, l = cg / 1536, n4 = (cg % 1536) * 4;
        f32x4 a0 = (f32x4){0.f, 0.f, 0.f, 0.f}, a1 = a0;
        const float* wp = a.in[I_ADAW] + ((size_t)l * D + ks * 32) * NMODV + n4; const float* c0 = a.in[I_C] + ks * 32; const float* c1 = c0 + D;
#pragma unroll 8
        for (int kk = 0; kk < 32; ++kk) { const f32x4 w = *(const f32x4*)(wp + (size_t)kk * NMODV); const float x0 = c0[kk], x1 = c1[kk]; a0 += w * (x0 * sigm(x0)); a1 += w * (x1 * sigm(x1)); }
        float* mp = (float*)(ws + WS_MODP) + (((size_t)ks * 2 + l) * 2) * NMODV + n4;
        *(f32x4*)mp = a0; *(f32x4*)(mp + NMODV) = a1;
    }
}
__device__ __forceinline__ void phase_modreduce(const Ctx& C, const Args& a) {
    const int gt = C.blk * NTHREADS + C.tid, ngt = C.nblk * NTHREADS;
    for (int i = gt; i < 2 * 2 * NMODV; i += ngt) {
        const int l = i / (2 * NMODV), n = i % NMODV; float s = a.in[I_ADAB][(size_t)l * NMODV + n];
        const float* mp = (const float*)(a.ws + WS_MODP) + i;
        for (int ks = 0; ks < 32; ++ks) s += mp[(size_t)ks * 4 * NMODV];
        ((float*)(a.ws + WS_MOD))[i] = s;
    }
}
__device__ __forceinline__ const float* modp(const Args& a, int l, int b, int v) { return (const float*)(a.ws + WS_MOD) + ((size_t)l * 2 + b) * NMODV + v * D; }

__device__ __forceinline__ void normmod_row(const f32x4 (&x)[4], const float* g, const float* sh, const float* sc, int lane, f32x4 (&h)[4]) {
    float s = 0.f;
#pragma unroll
    for (int j = 0; j < 4; ++j) s += (x[j].x * x[j].x + x[j].y * x[j].y) + (x[j].z * x[j].z + x[j].w * x[j].w);
    const float rstd = 1.f / sqrtf(wave_sum(s) * (1.f / D) + EPS);
#pragma unroll
    for (int j = 0; j < 4; ++j) { const int c = 4 * lane + 256 * j; const f32x4 gv = *(const f32x4*)(g + c), shv = *(const f32x4*)(sh + c), scv = *(const f32x4*)(sc + c);
        h[j] = (x[j] * rstd) * gv * (scv + 1.f) + shv; }
}
__device__ __forceinline__ void store_row_bf16(bf16* row, const f32x4 (&h)[4], int lane) {
#pragma unroll
    for (int j = 0; j < 4; ++j) { u32x2 w; w.x = pk2(h[j].x, h[j].y); w.y = pk2(h[j].z, h[j].w); *(u32x2*)(row + 4 * lane + 256 * j) = w; }
}
__device__ __forceinline__ void phase_norm(const Ctx& C, const Args& a, const float* X, const float* g, int l, int vsh, int vsc) {
    bf16* H = (bf16*)(a.ws + WS_H);
    for (int m = C.gw; m < M; m += C.ngw) {
        const int b = m >> 13; f32x4 x[4], h[4];
#pragma unroll
        for (int j = 0; j < 4; ++j) x[j] = *(const f32x4*)(X + (size_t)m * D + 4 * C.lane + 256 * j);
        normmod_row(x, g, modp(a, l, b, vsh), modp(a, l, b, vsc), C.lane, h);
        store_row_bf16(H + (size_t)m * D, h, C.lane);
    }
}

struct EpiIn {
    const float* bin; bf16 *UG, *ZP, *G;
    __device__ __forceinline__ void apply(int row, int pn, int cl8, f32x4 a0, f32x4 a1, f32x4 b0, f32x4 b1) const {
        if (pn < 8) {
            const int c = 128 * pn + cl8;
            a0 += *(const f32x4*)(bin + c); a1 += *(const f32x4*)(bin + c + 4); b0 += *(const f32x4*)(bin + 1024 + c); b1 += *(const f32x4*)(bin + 1024 + c + 4);
            f32x4 u0, u1;
#pragma unroll
            for (int i = 0; i < 4; ++i) { u0[i] = a0[i] * sigm(b0[i]); u1[i] = a1[i] * sigm(b1[i]); }
            *(u32x4*)(UG + (size_t)row * D + c) = pack8(u0, u1);
        } else if (pn < 12) {
            const int c = 256 * (pn - 8) + cl8;
            a0 += *(const f32x4*)(bin + 2048 + c); a1 += *(const f32x4*)(bin + 2048 + c + 4); b0 += *(const f32x4*)(bin + 2048 + 128 + c); b1 += *(const f32x4*)(bin + 2048 + 128 + c + 4);
            *(u32x4*)(ZP + (size_t)row * D + c) = pack8(a0, a1); *(u32x4*)(ZP + (size_t)row * D + c + 128) = pack8(b0, b1);
        } else {
            const int c = 256 * (pn - 12) + cl8;
            a0 += *(const f32x4*)(bin + 3072 + c); a1 += *(const f32x4*)(bin + 3072 + c + 4); b0 += *(const f32x4*)(bin + 3072 + 128 + c); b1 += *(const f32x4*)(bin + 3072 + 128 + c + 4);
#pragma unroll
            for (int i = 0; i < 4; ++i) { a0[i] = sigm(a0[i]); a1[i] = sigm(a1[i]); b0[i] = sigm(b0[i]); b1[i] = sigm(b1[i]); }
            *(u32x4*)(G + (size_t)row * 2048 + c) = pack8(a0, a1); *(u32x4*)(G + (size_t)row * 2048 + c + 128) = pack8(b0, b1);
        }
    }
};
struct EpiPool {
    const bf16* G; const float* scale; bf16* TMP;
    __device__ __forceinline__ void apply(int row, int pn, int cl8, f32x4 a0, f32x4 a1, f32x4 b0, f32x4 b1) const {
        const int c = 256 * pn + cl8; f32x4 g0, g1;
        unpack8(*(const u32x4*)(G + (size_t)row * 2048 + 1024 + c), g0, g1);
        a0 = a0 * g0 * *(const f32x4*)(scale + c); a1 = a1 * g1 * *(const f32x4*)(scale + c + 4);
        *(u32x4*)(TMP + (size_t)row * D + c) = pack8(a0, a1);
        unpack8(*(const u32x4*)(G + (size_t)row * 2048 + 1024 + c + 128), g0, g1);
        b0 = b0 * g0 * *(const f32x4*)(scale + c + 128); b1 = b1 * g1 * *(const f32x4*)(scale + c + 132);
        *(u32x4*)(TMP + (size_t)row * D + c + 128) = pack8(b0, b1);
    }
};
struct EpiConv {
    const bf16* G; const bf16* TMP; bf16* Y;
    __device__ __forceinline__ void apply(int row, int pn, int cl8, f32x4 a0, f32x4 a1, f32x4 b0, f32x4 b1) const {
        const int c = 256 * pn + cl8; f32x4 g0, g1, t0, t1;
        unpack8(*(const u32x4*)(G + (size_t)row * 2048 + c), g0, g1); unpack8(*(const u32x4*)(TMP + (size_t)row * D + c), t0, t1);
        *(u32x4*)(Y + (size_t)row * D + c) = pack8(a0 * g0 + t0, a1 * g1 + t1);
        unpack8(*(const u32x4*)(G + (size_t)row * 2048 + c + 128), g0, g1); unpack8(*(const u32x4*)(TMP + (size_t)row * D + c + 128), t0, t1);
        *(u32x4*)(Y + (size_t)row * D + c + 128) = pack8(b0 * g0 + t0, b1 * g1 + t1);
    }
};
struct EpiOut {
    const float* xold; float* xnew; const float* g1;   const float* bout;
    __device__ __forceinline__ void apply(int row, int pn, int cl8, f32x4 a0, f32x4 a1, f32x4 b0, f32x4 b1) const {
        const int c = 256 * pn + cl8; const float* g = g1 + (size_t)(row >> 13) * NMODV; const size_t o = (size_t)row * D + c;
        *(f32x4*)(xnew + o) = *(const f32x4*)(xold + o) + *(const f32x4*)(g + c) * (a0 + *(const f32x4*)(bout + c));
        *(f32x4*)(xnew + o + 4) = *(const f32x4*)(xold + o + 4) + *(const f32x4*)(g + c + 4) * (a1 + *(const f32x4*)(bout + c + 4));
        *(f32x4*)(xnew + o + 128) = *(const f32x4*)(xold + o + 128) + *(const f32x4*)(g + c + 128) * (b0 + *(const f32x4*)(bout + c + 128));
        *(f32x4*)(xnew + o + 132) = *(const f32x4*)(xold + o + 132) + *(const f32x4*)(g + c + 132) * (b1 + *(const f32x4*)(bout + c + 132));
    }
};
struct EpiQ {
    bf16* Q;
    __device__ __forceinline__ void apply(int row, int pn, int cl8, f32x4 a0, f32x4 a1, f32x4 b0, f32x4 b1) const {
        const size_t o = (size_t)row * DQ + 256 * pn + cl8; *(u32x4*)(Q + o) = pack8(a0, a1); *(u32x4*)(Q + o + 128) = pack8(b0, b1);
    }
};
struct EpiS {
    float* S;
    __device__ __forceinline__ void apply(int row, int pn, int cl8, f32x4 a0, f32x4 a1, f32x4 b0, f32x4 b1) const {
        const size_t o = (size_t)row * DQ + 256 * pn + cl8; *(f32x4*)(S + o) = a0; *(f32x4*)(S + o + 4) = a1; *(f32x4*)(S + o + 128) = b0; *(f32x4*)(S + o + 132) = b1;
    }
};

namespace pg8 {
#define PG8_LAS __attribute__((address_space(3)))
typedef unsigned short bf16_t;
typedef short bf16x8 __attribute__((ext_vector_type(8)));
typedef float f32x4 __attribute__((ext_vector_type(4)));
typedef unsigned u32x4 __attribute__((ext_vector_type(4)));
constexpr int BM = 256, BK = 64, HALF = 128, HTB = HALF * BK * 2  , STAGE_BYTES = 8 * HTB, NXCD = 8, WGM = 8;

__host__ __device__ __forceinline__ int lds_byte(int r, int c) { const int st = (r >> 4) * 2 + (c >> 5), rr = r & 15, cc = c & 31, ob = rr * 64 + cc * 2; return st * 1024 + (ob ^ (((ob >> 9) & 1) << 5)); }
__host__ __device__ __forceinline__ void stage_rc(int b, int& R, int& C) { const int st = b / 1024, sb = b % 1024, swz = sb ^ (((sb >> 9) & 1) << 5); R = (st >> 1) * 16 + swz / 64; C = (st & 1) * 32 + (swz % 64) / 2; }
__host__ __device__ __forceinline__ int perm32(int rho) { const int n = rho >> 4, i = rho & 15; return 8 * (i >> 2) + 4 * n + (i & 3); }

struct Unit { int pm, pn; };
struct Gemm { const bf16_t* A; const bf16_t* Bt; int M, N, K, lda, ldb, acol; };

struct StaticOrder {
    int nM, nN, nwg, G, c;
    __host__ __device__ void init(int M, int N, int G_, int c_) { nM = M / BM; nN = N / BM; nwg = nM * nN; G = G_; c = c_; }
    __host__ __device__ bool next(int i, Unit& u) const {
        const long L = (long)i * G + c; if (L >= nwg) return false;
        int wgid = (int)L; { const int q = nwg / NXCD, r = nwg % NXCD, xcd = wgid % NXCD, off = wgid / NXCD; wgid = (xcd < r ? xcd * (q + 1) : r * (q + 1) + (xcd - r) * q) + off; }
        const int nig = WGM * nN, gid = wgid / nig, fm = gid * WGM, gsz = (nM - fm) < WGM ? (nM - fm) : WGM;
        u.pm = fm + ((wgid % nig) % gsz); u.pn = (wgid % nig) / gsz; return true;
    }
    __device__ __forceinline__ void a_ready(const Unit&) const {}
    __device__ __forceinline__ void done(const Unit&) const {}
};


template <class Epi, class Sched, bool ALIGN_EPI = false, bool SP2 = false>
__device__ __forceinline__ void gemm_phase(PG8_LAS unsigned char* lds, const Gemm g, const Sched& S, const Epi& E) {
    const int tid = threadIdx.x, wid = __builtin_amdgcn_readfirstlane(tid >> 6), lane = tid & 63, wr = wid >> 2, wc = wid & 3, fr = lane & 15, fq = lane >> 4;
    const int K = g.K, nt = K / BK;
    unsigned voffA[2], voffB[2];
#pragma unroll
    for (int i = 0; i < 2; ++i) { int R, C; stage_rc(tid * 16 + i * 8192, R, C); const int Rb = Epi::PERM ? ((R & ~31) + perm32(R & 31)) : R;
        voffA[i] = (unsigned)(R * g.lda + C) * 2u; voffB[i] = (unsigned)(Rb * g.ldb + C) * 2u; }
    const size_t kstep = (size_t)(BK * 2);
    const size_t hstepA = (size_t)HALF * g.lda * 2, hstepB = (size_t)HALF * g.ldb * 2;
    const size_t tstepA = 2 * hstepA, tstepB = 2 * hstepB, acolb = (size_t)g.acol * 2;
    const unsigned ldsw = (unsigned)wid * 1024u;
    const int aoff = lds_byte(wr * 64 + fr, fq * 8), boff = lds_byte(wc * 32 + fr, fq * 8);
#define PG8_SA(b, h) (((b) * 2 + (h)) * HTB)
#define PG8_SB(b, h) ((4 + (b) * 2 + (h)) * HTB)
#define PG8_STAGE(bufoff, gbase, voff) do { _Pragma("unroll") for (int _i = 0; _i < 2; ++_i) \
        __builtin_amdgcn_global_load_lds((const unsigned*)((const char*)(gbase) + (voff)[_i]), (PG8_LAS unsigned*)(lds + (bufoff) + ldsw + _i * 8192), 16, 0, 0); } while (0)
#define PG8_LDA(dst, b, h) do { _Pragma("unroll") for (int m = 0; m < 4; ++m) _Pragma("unroll") for (int k = 0; k < 2; ++k) dst[m][k] = *(const PG8_LAS bf16x8*)(lds + PG8_SA(b, h) + aoff + m * 2048 + k * 1024); } while (0)
#define PG8_LDB(dst, b, h) do { _Pragma("unroll") for (int n = 0; n < 2; ++n) _Pragma("unroll") for (int k = 0; k < 2; ++k) dst[n][k] = *(const PG8_LAS bf16x8*)(lds + PG8_SB(b, h) + boff + n * 2048 + k * 1024); } while (0)
#define PG8_MMA(ai, bj, At, Bt) do { __builtin_amdgcn_s_setprio(1); _Pragma("unroll") for (int m = 0; m < 4; ++m) _Pragma("unroll") for (int n = 0; n < 2; ++n) _Pragma("unroll") for (int k = 0; k < 2; ++k) \
        acc[ai][bj][m][n] = __builtin_amdgcn_mfma_f32_16x16x32_bf16(Bt[n][k], At[m][k], acc[ai][bj][m][n], 0, 0, 0); __builtin_amdgcn_s_setprio(0); } while (0)
#define PG8_WAIT_V(n) asm volatile("s_waitcnt vmcnt(" #n ")" ::: "memory")
#define PG8_WAIT_L(n) asm volatile("s_waitcnt lgkmcnt(" #n ")" ::: "memory")
#define PG8_BAR __builtin_amdgcn_s_barrier()
#define PG8_SCHED __builtin_amdgcn_sched_barrier(0)
    Unit cur, nxt; int ui = 0;
    if (!S.next(0, cur)) return;
    f32x4 acc[2][2][4][2];
#pragma unroll
    for (int a = 0; a < 2; ++a)
#pragma unroll
        for (int b = 0; b < 2; ++b)
#pragma unroll
            for (int m = 0; m < 4; ++m)
#pragma unroll
                for (int n = 0; n < 2; ++n) acc[a][b][m][n] = (f32x4){0.f, 0.f, 0.f, 0.f};
    bf16x8 At[4][2], B0[2][2], B1[2][2];
    const char* cA = (const char*)g.A + (size_t)cur.pm * tstepA + (size_t)cur.pn * acolb; const char* cB = (const char*)g.Bt + (size_t)cur.pn * tstepB;
    S.a_ready(cur);
    if constexpr (SP2) {
        PG8_STAGE(PG8_SB(0, 0), cB, voffB); PG8_STAGE(PG8_SB(0, 1), cB + hstepB, voffB); PG8_STAGE(PG8_SA(0, 0), cA, voffA); PG8_STAGE(PG8_SA(0, 1), cA + hstepA, voffA);
        if (wr == 1) PG8_BAR;
        PG8_WAIT_V(2); PG8_BAR;
        PG8_STAGE(PG8_SB(1, 0), cB + kstep, voffB); PG8_STAGE(PG8_SA(1, 0), cA + kstep, voffA); PG8_STAGE(PG8_SB(1, 1), cB + hstepB + kstep, voffB);
        PG8_WAIT_V(6); PG8_BAR;
    } else {
        PG8_STAGE(PG8_SB(0, 0), cB, voffB); PG8_STAGE(PG8_SA(0, 0), cA, voffA); PG8_STAGE(PG8_SB(0, 1), cB + hstepB, voffB); PG8_STAGE(PG8_SA(0, 1), cA + hstepA, voffA);
        if (wr == 1) PG8_BAR;
        PG8_WAIT_V(4); PG8_BAR;
        PG8_STAGE(PG8_SB(1, 0), cB + kstep, voffB); PG8_STAGE(PG8_SA(1, 0), cA + kstep, voffA); PG8_STAGE(PG8_SB(1, 1), cB + hstepB + kstep, voffB);
        PG8_WAIT_V(6); PG8_BAR;
    }
    for (;;) {
        const bool has_next = S.next(ui + 1, nxt);
        const char* nA = has_next ? (const char*)g.A + (size_t)nxt.pm * tstepA + (size_t)nxt.pn * acolb : cA; const char* nB = has_next ? (const char*)g.Bt + (size_t)nxt.pn * tstepB : cB;
#pragma nounroll
        for (int t = 0; t < nt; t += 2) {
            const bool last = (t == nt - 2);
            const char* a1 = cA + (size_t)(t + 1) * kstep;
            const char* a2 = last ? nA : cA + (size_t)(t + 2) * kstep; const char* b2 = last ? nB : cB + (size_t)(t + 2) * kstep;
            const char* a3 = a2 + kstep; const char* b3 = b2 + kstep;
            if (last && has_next) S.a_ready(nxt);
            if constexpr (SP2) {
            PG8_LDB(B0, 0, 0); PG8_LDB(B1, 0, 1); PG8_SCHED; PG8_LDA(At, 0, 0); PG8_STAGE(PG8_SA(1, 1), a1 + hstepA, voffA);
            PG8_WAIT_V(8); PG8_WAIT_L(0); PG8_BAR; PG8_MMA(0, 0, At, B0); PG8_MMA(0, 1, At, B1); PG8_BAR; PG8_SCHED;
            PG8_LDA(At, 0, 1); PG8_STAGE(PG8_SB(0, 0), b2, voffB); PG8_STAGE(PG8_SB(0, 1), b2 + hstepB, voffB); PG8_STAGE(PG8_SA(0, 0), a2, voffA);
            PG8_WAIT_V(8); PG8_WAIT_L(0); PG8_BAR; PG8_MMA(1, 0, At, B0); PG8_MMA(1, 1, At, B1); PG8_BAR; PG8_SCHED;
            PG8_LDB(B0, 1, 0); PG8_LDB(B1, 1, 1); PG8_SCHED; PG8_LDA(At, 1, 0); PG8_STAGE(PG8_SA(0, 1), a2 + hstepA, voffA);
            PG8_WAIT_V(8); PG8_WAIT_L(0); PG8_BAR; PG8_MMA(0, 0, At, B0); PG8_MMA(0, 1, At, B1); PG8_BAR; PG8_SCHED;
            PG8_LDA(At, 1, 1); PG8_STAGE(PG8_SB(1, 0), b3, voffB); PG8_STAGE(PG8_SB(1, 1), b3 + hstepB, voffB); PG8_STAGE(PG8_SA(1, 0), a3, voffA);
            PG8_WAIT_V(8); PG8_WAIT_L(0); PG8_BAR; PG8_MMA(1, 0, At, B0); PG8_MMA(1, 1, At, B1); PG8_BAR; PG8_SCHED;
            } else {
            PG8_LDB(B0, 0, 0); PG8_SCHED; PG8_LDA(At, 0, 0); PG8_STAGE(PG8_SA(1, 1), a1 + hstepA, voffA);
            PG8_WAIT_L(8); PG8_BAR; PG8_WAIT_L(0); PG8_MMA(0, 0, At, B0); PG8_BAR; PG8_SCHED;
            PG8_LDB(B1, 0, 1); PG8_STAGE(PG8_SB(0, 0), b2, voffB);
            PG8_BAR; PG8_WAIT_L(0); PG8_MMA(0, 1, At, B1); PG8_BAR;
            PG8_LDA(At, 0, 1); PG8_STAGE(PG8_SA(0, 0), a2, voffA);
            PG8_BAR; PG8_WAIT_L(0); PG8_MMA(1, 0, At, B0); PG8_BAR; PG8_SCHED;
            PG8_STAGE(PG8_SB(0, 1), b2 + hstepB, voffB);
            PG8_WAIT_V(6); PG8_BAR; PG8_MMA(1, 1, At, B1); PG8_BAR;
            PG8_LDB(B0, 1, 0); PG8_SCHED; PG8_LDA(At, 1, 0); PG8_STAGE(PG8_SA(0, 1), a2 + hstepA, voffA);
            PG8_WAIT_L(8); PG8_BAR; PG8_WAIT_L(0); PG8_MMA(0, 0, At, B0); PG8_BAR; PG8_SCHED;
            PG8_LDB(B1, 1, 1); PG8_STAGE(PG8_SB(1, 0), b3, voffB);
            PG8_BAR; PG8_WAIT_L(0); PG8_MMA(0, 1, At, B1); PG8_BAR;
            PG8_LDA(At, 1, 1); PG8_STAGE(PG8_SA(1, 0), a3, voffA);
            PG8_BAR; PG8_WAIT_L(0); PG8_MMA(1, 0, At, B0); PG8_BAR; PG8_SCHED;
            PG8_STAGE(PG8_SB(1, 1), b3 + hstepB, voffB);
            PG8_WAIT_V(6); PG8_BAR; PG8_MMA(1, 1, At, B1); PG8_BAR;
            }
        }
        if constexpr (ALIGN_EPI) { if (wr == 0) PG8_BAR; }
        if constexpr (!Epi::AFTER_DRAIN) { E(acc, cur, wr, wc, fr, fq); S.done(cur); }
        if (!has_next) break;
#pragma unroll
        for (int a = 0; a < 2; ++a)
#pragma unroll
            for (int b = 0; b < 2; ++b)
#pragma unroll
                for (int m = 0; m < 4; ++m)
#pragma unroll
                    for (int n = 0; n < 2; ++n) acc[a][b][m][n] = (f32x4){0.f, 0.f, 0.f, 0.f};
        cur = nxt; cA = nA; cB = nB; ++ui;
        if constexpr (ALIGN_EPI) { if (wr == 1) PG8_BAR; }
    }
    PG8_WAIT_V(0);
    if constexpr (!ALIGN_EPI) { if (wr == 0) PG8_BAR; }
    PG8_BAR;
    if constexpr (Epi::AFTER_DRAIN) { E.fused(acc, cur, wr, wc, fr, fq, lds, wid, lane); S.done(cur); }
#undef PG8_SA
#undef PG8_SB
#undef PG8_STAGE
#undef PG8_LDA
#undef PG8_LDB
#undef PG8_MMA
#undef PG8_WAIT_V
#undef PG8_WAIT_L
#undef PG8_BAR
#undef PG8_SCHED
}

template <class F> struct EpiW {
    static constexpr bool PERM = true, AFTER_DRAIN = false; F f;
    __device__ __forceinline__ void operator()(const f32x4 (&acc)[2][2][4][2], const Unit& u, int wr, int wc, int fr, int fq) const {
#pragma unroll
        for (int ai = 0; ai < 2; ++ai)
#pragma unroll
            for (int m = 0; m < 4; ++m) { f.apply(u.pm * BM + ai * HALF + wr * 64 + m * 16 + fr, u.pn, wc * 32 + 8 * fq, acc[ai][0][m][0], acc[ai][0][m][1], acc[ai][1][m][0], acc[ai][1][m][1]);
                asm volatile("" ::: "memory"); }
    }
};
}

template <class F>
__device__ __forceinline__ void mfma_gemm(const Ctx& C, const bf16* A, int lda, int acol, const bf16* Bt, int ldb, int Mr, int N, int K, const F& f) {
    pg8::Gemm g{A, Bt, Mr, N, K, lda, ldb, acol}; pg8::StaticOrder S; S.init(Mr, N, C.nblk, C.blk); pg8::EpiW<F> E{f};
    pg8::gemm_phase<pg8::EpiW<F>, pg8::StaticOrder, true, true>(C.lds, g, S, E);
}

template <class F>
__device__ __forceinline__ void naive_gemm(const Ctx& C, const bf16* A, int lda, int acol, const bf16* Bt, int ldb, int Mr, int N, int K, const F& f) {
    LAS float* As = (LAS float*)C.lds;
    LAS float* Bs = (LAS float*)(C.lds + 8192);
    const int ntm = Mr / 128, ntn = N / 256, tid = C.tid, cg = tid & 15, r0 = tid >> 4;
    for (int tile = C.blk; tile < ntm * ntn; tile += C.nblk) {
        const int tm = tile / ntn, pn = tile % ntn;
        f32x4 acc[4][4];
#pragma unroll
        for (int i = 0; i < 4; ++i)
#pragma unroll
            for (int j = 0; j < 4; ++j) acc[i][j] = (f32x4){0.f, 0.f, 0.f, 0.f};
        const bf16* ap = A + (size_t)(tm * 128 + (tid >> 2)) * lda + pn * acol + (tid & 3) * 4;
        const bf16* bp = Bt + (size_t)(pn * 256 + (tid >> 1)) * ldb + (tid & 1) * 8;
        for (int k0 = 0; k0 < K; k0 += 16) {
            const u32x2 av = *(const u32x2*)(ap + k0); const u32x4 bv = *(const u32x4*)(bp + k0);
            __syncthreads();
            { const int r = tid >> 2, kq = (tid & 3) * 4; As[(kq + 0) * 128 + r] = bflo(av.x); As[(kq + 1) * 128 + r] = bfhi(av.x); As[(kq + 2) * 128 + r] = bflo(av.y); As[(kq + 3) * 128 + r] = bfhi(av.y); }
            { const int n = tid >> 1, kq = (tid & 1) * 8; Bs[(kq + 0) * 256 + n] = bflo(bv.x); Bs[(kq + 1) * 256 + n] = bfhi(bv.x); Bs[(kq + 2) * 256 + n] = bflo(bv.y); Bs[(kq + 3) * 256 + n] = bfhi(bv.y);
              Bs[(kq + 4) * 256 + n] = bflo(bv.z); Bs[(kq + 5) * 256 + n] = bfhi(bv.z); Bs[(kq + 6) * 256 + n] = bflo(bv.w); Bs[(kq + 7) * 256 + n] = bfhi(bv.w); }
            __syncthreads();
#pragma unroll
            for (int kk = 0; kk < 16; ++kk) {
                const f32x4 b0 = *(const LAS f32x4*)(Bs + kk * 256 + cg * 8), b1 = *(const LAS f32x4*)(Bs + kk * 256 + cg * 8 + 4), b2 = *(const LAS f32x4*)(Bs + kk * 256 + 128 + cg * 8), b3 = *(const LAS f32x4*)(Bs + kk * 256 + 128 + cg * 8 + 4);
#pragma unroll
                for (int i = 0; i < 4; ++i) { const float av1 = As[kk * 128 + r0 + 32 * i]; acc[i][0] += b0 * av1; acc[i][1] += b1 * av1; acc[i][2] += b2 * av1; acc[i][3] += b3 * av1; }
            }
        }
#pragma unroll
        for (int i = 0; i < 4; ++i) f.apply(tm * 128 + r0 + 32 * i, pn, cg * 8, acc[i][0], acc[i][1], acc[i][2], acc[i][3]);
    }
}

template <int W>
__device__ __forceinline__ void pool_item(const bf16* ZP, bf16* PL, int m0, int t0, int c0) {
    float p0[47], p1[47];
#pragma unroll
    for (int i = 0; i < 47; ++i) { const int r = t0 - 15 + i; unsigned w = 0u; if (i >= 15 - (W - 1)) { if (r >= 0) w = *(const unsigned*)(ZP + (size_t)(m0 - 15 + i) * D + c0); } p0[i] = bflo(w); p1[i] = bfhi(w); }
#pragma unroll
    for (int ti = 0; ti < 32; ++ti) {
        float s0 = 0.f, s1 = 0.f;
#pragma unroll
        for (int j = 0; j < W; ++j) { s0 += p0[ti + 15 - j]; s1 += p1[ti + 15 - j]; }
        const int cnt = (t0 + ti + 1) < W ? (t0 + ti + 1) : W; const float inv = 1.f / (float)cnt;
        *(unsigned*)(PL + (size_t)(m0 + ti) * D + c0) = pk2(s0 * inv - p0[ti + 15], s1 * inv - p1[ti + 15]);
    }
}
__device__ __forceinline__ void phase_convpool(const Ctx& C, const Args& a, int l) {
    const bf16* UG = (const bf16*)(a.ws + WS_UG); const bf16* ZP = (const bf16*)(a.ws + WS_ZP);
    bf16* AC = (bf16*)(a.ws + WS_AC); bf16* PL = (bf16*)(a.ws + WS_PL);
    const float* cw = a.in[I_CONVW] + (size_t)l * CONVK * D; const float* cb = a.in[I_CONVB] + (size_t)l * D;
    const float* lng = a.in[I_LNG] + (size_t)l * D; const float* lnb = a.in[I_LNB] + (size_t)l * D;
    LAS float* red = (LAS float*)C.lds;
    LAS float* stat = (LAS float*)(C.lds + 2048);
    int c0 = 2 * C.tid;
    asm volatile("" : "+v"(c0));
    float w0[31], w1[31];
#pragma unroll
    for (int k = 0; k < 31; ++k) { const f32x2 w = *(const f32x2*)(cw + (size_t)k * D + c0); w0[k] = w.x; w1[k] = w.y; }
    for (int item = C.blk; item < M / 32; item += C.nblk) {
        const int m0 = item * 32, t0 = m0 & (SEQ - 1);
        asm volatile("" : "+v"(c0));
        float a0[32], a1[32];
#pragma unroll
        for (int i = 0; i < 32; ++i) { a0[i] = 0.f; a1[i] = 0.f; }
#pragma unroll
        for (int ri = 0; ri < 62; ++ri) {
            unsigned w = 0u; if (t0 - 30 + ri >= 0) w = *(const unsigned*)(UG + (size_t)(m0 - 30 + ri) * D + c0);
            const float u0 = bflo(w), u1 = bfhi(w);
#pragma unroll
            for (int ti = 0; ti < 32; ++ti) { const int d = ti + 30 - ri; if (d >= 0 && d <= 30) { a0[ti] += w0[30 - d] * u0; a1[ti] += w1[30 - d] * u1; } }
            if ((ri & 7) == 7) asm volatile("" ::: "memory");
        }
        const f32x2 bb = *(const f32x2*)(cb + c0);
        __syncthreads();
#pragma unroll
        for (int ti = 0; ti < 32; ++ti) {
            a0[ti] += bb.x; a1[ti] += bb.y;
            const float s = wave_sum(a0[ti] + a1[ti]), q = wave_sum(a0[ti] * a0[ti] + a1[ti] * a1[ti]);
            if (C.lane == 0) { red[C.wave * 64 + ti] = s; red[C.wave * 64 + 32 + ti] = q; }
        }
        __syncthreads();
        if (C.tid < 32) { float s = 0.f, q = 0.f;
#pragma unroll
            for (int w = 0; w < 8; ++w) { s += red[w * 64 + C.tid]; q += red[w * 64 + 32 + C.tid]; }
            const float mean = s * (1.f / D), var = fmaxf(q * (1.f / D) - mean * mean, 0.f); stat[C.tid] = mean; stat[32 + C.tid] = 1.f / sqrtf(var + EPS); }
        __syncthreads();
        const f32x2 gg = *(const f32x2*)(lng + c0), be = *(const f32x2*)(lnb + c0);
#pragma unroll
        for (int ti = 0; ti < 32; ++ti) { const float mean = stat[ti], rstd = stat[32 + ti];
            const float y0 = (a0[ti] - mean) * rstd * gg.x + be.x, y1 = (a1[ti] - mean) * rstd * gg.y + be.y;
            *(unsigned*)(AC + (size_t)(m0 + ti) * D + c0) = pk2(y0 * sigm(y0), y1 * sigm(y1)); }
        asm volatile("" ::: "memory");
        const int g = C.tid >> 7;
        if (g == 0) pool_item<2>(ZP, PL, m0, t0, c0); else if (g == 1) pool_item<4>(ZP, PL, m0, t0, c0); else if (g == 2) pool_item<8>(ZP, PL, m0, t0, c0); else pool_item<16>(ZP, PL, m0, t0, c0);
    }
}

typedef unsigned u32;
template <int CTRL> __device__ __forceinline__ u32 dppu(u32 x) { return (u32)__builtin_amdgcn_update_dpp(0, (int)x, CTRL, 0xf, 0xf, true); }
constexpr int DPP_XOR1 = 0xB1, DPP_REV4 = 0x1B, DPP_DUPE = 0xA0, DPP_DUPO = 0xF5, DPP_HMIRROR = 0x141, DPP_MIRROR = 0x140;
__device__ __forceinline__ u32 umax_(u32 a, u32 b) { return a > b ? a : b; }
__device__ __forceinline__ u32 umin_(u32 a, u32 b) { return a < b ? a : b; }
#define TK_CE(x, i, j) do { const u32 hi_ = umax_(x[i], x[j]), lo_ = umin_(x[i], x[j]); x[i] = hi_; x[j] = lo_; } while (0)
__device__ __forceinline__ void tk_local_merge(u32 (&x)[8]) {
    TK_CE(x, 0, 4); TK_CE(x, 1, 5); TK_CE(x, 2, 6); TK_CE(x, 3, 7);
    TK_CE(x, 0, 2); TK_CE(x, 1, 3); TK_CE(x, 4, 6); TK_CE(x, 5, 7);
    TK_CE(x, 0, 1); TK_CE(x, 2, 3); TK_CE(x, 4, 5); TK_CE(x, 6, 7);
}
template <int CTRL> __device__ __forceinline__ void tk_level(u32 (&x)[8], bool even) {
    u32 t[8];
#pragma unroll
    for (int c = 0; c < 8; ++c) t[c] = dppu<CTRL>(x[7 - c]);
#pragma unroll
    for (int c = 0; c < 8; ++c) x[c] = umax_(x[c], t[c]);
#pragma unroll
    for (int c = 0; c < 8; ++c) { const u32 p = dppu<DPP_XOR1>(x[c]); x[c] = even ? umax_(x[c], p) : umin_(x[c], p); }
    tk_local_merge(x);
}
__device__ __forceinline__ void tk_top16(u32 (&x)[8], bool even) {
    TK_CE(x, 0, 1); TK_CE(x, 2, 3); TK_CE(x, 4, 5); TK_CE(x, 6, 7);
    TK_CE(x, 0, 2); TK_CE(x, 1, 3); TK_CE(x, 4, 6); TK_CE(x, 5, 7);
    TK_CE(x, 1, 2); TK_CE(x, 5, 6);
    TK_CE(x, 0, 4); TK_CE(x, 1, 5); TK_CE(x, 2, 6); TK_CE(x, 3, 7);
    TK_CE(x, 2, 4); TK_CE(x, 3, 5);
    TK_CE(x, 1, 2); TK_CE(x, 3, 4); TK_CE(x, 5, 6);
    { u32 t[8];
#pragma unroll
      for (int c = 0; c < 8; ++c) t[c] = dppu<DPP_XOR1>(x[7 - c]);
#pragma unroll
      for (int c = 0; c < 8; ++c) x[c] = even ? umax_(x[c], t[c]) : umin_(x[c], t[c]); }
    tk_local_merge(x);
    tk_level<DPP_REV4>(x, even); tk_level<DPP_HMIRROR>(x, even); tk_level<DPP_MIRROR>(x, even);
}
__device__ __forceinline__ u32 tk_f2key(float v, int slot) { const u32 u = __builtin_bit_cast(u32, v); const u32 k = u ^ ((u32)((int)u >> 31) | 0x80000000u); return (k & ~127u) | (u32)(127 - slot); }
__device__ __forceinline__ float tk_key2f(u32 k) { k &= ~127u; const u32 m = (u32)((int)k >> 31); return __builtin_bit_cast(float, k ^ (~m | 0x80000000u)); }
__device__ __forceinline__ u32 tk_sel8v(u32 r0, u32 r1, u32 r2, u32 r3, u32 r4, u32 r5, u32 r6, u32 r7, int idx) {
    const bool b0 = idx & 1, b1 = idx & 2, b2 = idx & 4;
    const u32 s01 = b0 ? r1 : r0, s23 = b0 ? r3 : r2, s45 = b0 ? r5 : r4, s67 = b0 ? r7 : r6;
    const u32 s03 = b1 ? s23 : s01, s47 = b1 ? s67 : s45;
    return b2 ? s47 : s03; }
#define tk_sel8(r, idx) tk_sel8v(r[0], r[1], r[2], r[3], r[4], r[5], r[6], r[7], idx)
__device__ __forceinline__ void phase_topk(const Ctx& C, const Args& a) {
    const float* S = (const float*)(a.ws + WS_S); int* EID = (int*)(a.ws + WS_EID); float* GW = (float*)(a.ws + WS_GW);
    const int lane = C.lane, r = lane & 15, q = lane >> 4; const bool even = (lane & 1) == 0;
    for (int it = C.gw; it < M * NHEAD / 4; it += C.ngw) {
        const int pair = it * 4 + q, tok = pair >> 3, h = pair & 7;
        u32 xa[8], xb[8];
        { const float* sp = S + (size_t)tok * DQ + h * 256 + 8 * r; const f32x4 v0 = *(const f32x4*)sp, v1 = *(const f32x4*)(sp + 4), w0 = *(const f32x4*)(sp + 128), w1 = *(const f32x4*)(sp + 132);
#pragma unroll
          for (int c = 0; c < 4; ++c) { xa[c] = tk_f2key(v0[c], 8 * r + c); xa[4 + c] = tk_f2key(v1[c], 8 * r + 4 + c); xb[c] = tk_f2key(w0[c], 8 * r + c); xb[4 + c] = tk_f2key(w1[c], 8 * r + 4 + c); } }
        tk_top16(xa, even); tk_top16(xb, even);
        u32 La[8], Ha[8], Lb[8], Hb[8];
#pragma unroll
        for (int c = 0; c < 8; ++c) { La[c] = dppu<DPP_DUPE>(xa[c]); Ha[c] = dppu<DPP_DUPO>(xa[c]); Lb[c] = dppu<DPP_DUPE>(xb[c]); Hb[c] = dppu<DPP_DUPO>(xb[c]); }
        const u32 a_lane = (r < 8) ? tk_sel8(La, r & 7) : tk_sel8(Ha, r & 7), b_lane = (r < 8) ? tk_sel8(Lb, r & 7) : tk_sel8(Hb, r & 7);
        const float va = tk_key2f(a_lane), vbl = tk_key2f(b_lane), va0 = tk_key2f(La[0]);
        u32 ck[8];
#pragma unroll
        for (int j = 0; j < 8; ++j) { constexpr int lim[8] = {15, 7, 4, 3, 2, 1, 1, 1};
            float v = va + tk_key2f(Lb[j]); bool valid = r <= lim[j];
            if (j == 1) { v = (r >= 8) ? va0 + vbl : v; valid = valid || (r >= 8); }
            ck[j] = valid ? tk_f2key(v, 8 * r + j) : 0u; }
        tk_top16(ck, even);
        const float mx = tk_key2f(dppu<DPP_DUPE>(ck[0]));
        float ex[8], sum = 0.f;
#pragma unroll
        for (int c = 0; c < 8; ++c) { ex[c] = __expf(tk_key2f(ck[c]) - mx); sum += ex[c]; }
        sum += __builtin_bit_cast(float, dppu<DPP_XOR1>(__builtin_bit_cast(u32, sum)));
        const float inv = 1.f / sum;
        int eo[8]; float go[8];
#pragma unroll
        for (int c = 0; c < 8; ++c) { const int slot = 127 - (int)(ck[c] & 127u), i = slot >> 3, j = slot & 7; const bool sp = (j == 1) && (i >= 8);
            const int i2 = sp ? 0 : i, j2 = sp ? i : j;
            const u32 ka = (u32)__builtin_amdgcn_ds_bpermute(((lane & ~15) + i2) << 2, (int)a_lane), kb = (u32)__builtin_amdgcn_ds_bpermute(((lane & ~15) + j2) << 2, (int)b_lane);
            eo[c] = (127 - (int)(ka & 127u)) * 128 + (127 - (int)(kb & 127u)); go[c] = ex[c] * inv; }
        if (r < 2) { int* ep = EID + (size_t)tok * 128 + h * 16 + r * 8; float* gp = GW + (size_t)tok * 128 + h * 16 + r * 8;
            *(u32x4*)ep = (u32x4){(u32)eo[0], (u32)eo[1], (u32)eo[2], (u32)eo[3]}; *(u32x4*)(ep + 4) = (u32x4){(u32)eo[4], (u32)eo[5], (u32)eo[6], (u32)eo[7]};
            *(f32x4*)gp = (f32x4){go[0], go[1], go[2], go[3]}; *(f32x4*)(gp + 4) = (f32x4){go[4], go[5], go[6], go[7]}; }
    }
}

__device__ __forceinline__ float dpp_sum63(float v) {
#define DPPF(x, ctrl, rm, bc) __builtin_bit_cast(float, __builtin_amdgcn_update_dpp(0, __builtin_bit_cast(int, x), ctrl, rm, 0xf, bc))
    v += DPPF(v, 0x111, 0xf, true); v += DPPF(v, 0x112, 0xf, true); v += DPPF(v, 0x114, 0xf, true); v += DPPF(v, 0x118, 0xf, true);
    v += DPPF(v, 0x142, 0xa, false); v += DPPF(v, 0x143, 0xc, false);
#undef DPPF
    return v;
}
__device__ __forceinline__ float dot2bf(unsigned w, unsigned x, float acc) { return __builtin_amdgcn_fdot2_f32_bf16(__builtin_bit_cast(bf16x2_t, w), __builtin_bit_cast(bf16x2_t, x), acc, false); }
constexpr int PNB = 8;
__device__ __forceinline__ void peer_load(u32x4 (&buf)[PNB][2], const bf16* T, int ev0, int ev1, int k0, int lane) {
    const int evs = (k0 < 64) ? ev0 : ev1;
#pragma unroll
    for (int i = 0; i < PNB; ++i) { const int e = __builtin_amdgcn_readlane(evs, (k0 & 63) + i); const bf16* rb = T + (size_t)e * D + 8 * lane;
        buf[i][0] = *(const u32x4*)rb; buf[i][1] = *(const u32x4*)(rb + 512); }
}
__device__ __forceinline__ void phase_peer(const Ctx& C, const Args& a, int l) {
    const bf16* UB = (const bf16*)(a.ws + WS_UB) + (size_t)l * NEXP * D; const bf16* VB = (const bf16*)(a.ws + WS_VB) + (size_t)l * NEXP * D;
    const int* EID = (const int*)(a.ws + WS_EID); const float* GW = (const float*)(a.ws + WS_GW);
    float* XW = a.out; bf16* H = (bf16*)(a.ws + WS_H);
    for (int m = C.gw; m < M; m += C.ngw) {
        int lane = C.lane; asm volatile("" : "+v"(lane));
        const int b = m >> 13; f32x4 x[2][2];
        int ev0, ev1; float gwv0, gwv1;
        ev0 = EID[(size_t)m * 128 + lane]; ev1 = EID[(size_t)m * 128 + 64 + lane]; gwv0 = GW[(size_t)m * 128 + lane]; gwv1 = GW[(size_t)m * 128 + 64 + lane];
#pragma unroll
        for (int j = 0; j < 2; ++j) { x[j][0] = *(const f32x4*)(XW + (size_t)m * D + 8 * lane + 512 * j); x[j][1] = *(const f32x4*)(XW + (size_t)m * D + 8 * lane + 512 * j + 4); }
        u32x4 hp[2];
        { float ss = 0.f;
#pragma unroll
          for (int j = 0; j < 2; ++j)
#pragma unroll
            for (int q = 0; q < 2; ++q) ss += (x[j][q].x * x[j][q].x + x[j][q].y * x[j][q].y) + (x[j][q].z * x[j][q].z + x[j][q].w * x[j][q].w);
          const float rstd = 1.f / sqrtf(wave_sum(ss) * (1.f / D) + EPS);
          const float* g = a.in[I_N2G] + (size_t)l * D; const float* sh = modp(a, l, b, 3); const float* sc = modp(a, l, b, 4);
#pragma unroll
          for (int j = 0; j < 2; ++j) { f32x4 hv[2];
#pragma unroll
            for (int q = 0; q < 2; ++q) { const int c = 8 * lane + 512 * j + 4 * q; hv[q] = (x[j][q] * rstd) * *(const f32x4*)(g + c) * (*(const f32x4*)(sc + c) + 1.f) + *(const f32x4*)(sh + c); }
            hp[j] = pack8(hv[0], hv[1]); } }
        float dv0 = 0.f, dv1 = 0.f;
        u32x4 A[PNB][2], Bf[PNB][2];
#define PEER_DOT(buf, kbase) do { _Pragma("unroll") for (int i = 0; i < PNB; ++i) { float d = 0.f; \
            d = dot2bf(buf[i][0].x, hp[0].x, d); d = dot2bf(buf[i][0].y, hp[0].y, d); d = dot2bf(buf[i][0].z, hp[0].z, d); d = dot2bf(buf[i][0].w, hp[0].w, d); \
            d = dot2bf(buf[i][1].x, hp[1].x, d); d = dot2bf(buf[i][1].y, hp[1].y, d); d = dot2bf(buf[i][1].z, hp[1].z, d); d = dot2bf(buf[i][1].w, hp[1].w, d); \
            d = dpp_sum63(d); const float tot = __builtin_bit_cast(float, __builtin_amdgcn_readlane(__builtin_bit_cast(int, d), 63)); const int kk = (kbase) + i; \
            dv0 = (lane == kk) ? tot : dv0; dv1 = (lane + 64 == kk) ? tot : dv1; } } while (0)
        peer_load(A, UB, ev0, ev1, 0, lane);
#pragma nounroll
        for (int k = 0; k < 128; k += 2 * PNB) {
            peer_load(Bf, UB, ev0, ev1, k + PNB, lane);
            PEER_DOT(A, k);
            if (k + 2 * PNB < 128) peer_load(A, UB, ev0, ev1, k + 2 * PNB, lane);
            PEER_DOT(Bf, k + PNB);
        }
#undef PEER_DOT
        const float cf0 = gwv0 * 0.5f * dv0 * (1.f + erff(dv0 * 0.70710678118654752f)), cf1 = gwv1 * 0.5f * dv1 * (1.f + erff(dv1 * 0.70710678118654752f));
        f32x4 o[2][2];
#pragma unroll
        for (int j = 0; j < 2; ++j) { o[j][0] = (f32x4){0.f, 0.f, 0.f, 0.f}; o[j][1] = o[j][0]; }
#define PEER_ACC(buf, i, c) do { _Pragma("unroll") for (int j = 0; j < 2; ++j) { const u32x4 w = buf[i][j]; \
            o[j][0].x += c * bflo(w.x); o[j][0].y += c * bfhi(w.x); o[j][0].z += c * bflo(w.y); o[j][0].w += c * bfhi(w.y); \
            o[j][1].x += c * bflo(w.z); o[j][1].y += c * bfhi(w.z); o[j][1].z += c * bflo(w.w); o[j][1].w += c * bfhi(w.w); } } while (0)
        peer_load(A, VB, ev0, ev1, 0, lane);
#pragma nounroll
        for (int k = 0; k < 128; k += 2 * PNB) {
            peer_load(Bf, VB, ev0, ev1, k + PNB, lane);
            { const int cfs = __builtin_bit_cast(int, k < 64 ? cf0 : cf1);
#pragma unroll
              for (int i = 0; i < PNB; ++i) { const float c = __builtin_bit_cast(float, __builtin_amdgcn_readlane(cfs, (k & 63) + i)); PEER_ACC(A, i, c); } }
            if (k + 2 * PNB < 128) peer_load(A, VB, ev0, ev1, k + 2 * PNB, lane);
            { const int cfs = __builtin_bit_cast(int, k < 64 ? cf0 : cf1);
#pragma unroll
              for (int i = 0; i < PNB; ++i) { const float c = __builtin_bit_cast(float, __builtin_amdgcn_readlane(cfs, (k & 63) + PNB + i)); PEER_ACC(Bf, i, c); } }
        }
#undef PEER_ACC
        asm volatile("" : "+v"(lane));
#pragma unroll
        for (int j = 0; j < 2; ++j) { x[j][0] = *(const f32x4*)(XW + (size_t)m * D + 8 * lane + 512 * j); x[j][1] = *(const f32x4*)(XW + (size_t)m * D + 8 * lane + 512 * j + 4); }
        const float* g2 = modp(a, l, b, 5);
#pragma unroll
        for (int j = 0; j < 2; ++j)
#pragma unroll
            for (int q = 0; q < 2; ++q) x[j][q] += *(const f32x4*)(g2 + 8 * lane + 512 * j + 4 * q) * o[j][q];
        float ss = 0.f;
#pragma unroll
        for (int j = 0; j < 2; ++j)
#pragma unroll
            for (int q = 0; q < 2; ++q) ss += (x[j][q].x * x[j][q].x + x[j][q].y * x[j][q].y) + (x[j][q].z * x[j][q].z + x[j][q].w * x[j][q].w);
        const float rstd = 1.f / sqrtf(wave_sum(ss) * (1.f / D) + EPS);
        if (l + 1 < DEPTH) {
            const float* g = a.in[I_N1G] + (size_t)(l + 1) * D; const float* sh = modp(a, l + 1, b, 0); const float* sc = modp(a, l + 1, b, 1);
#pragma unroll
            for (int j = 0; j < 2; ++j) { f32x4 hv[2];
#pragma unroll
                for (int q = 0; q < 2; ++q) { const int c = 8 * lane + 512 * j + 4 * q; *(f32x4*)(XW + (size_t)m * D + c) = x[j][q];
                    hv[q] = (x[j][q] * rstd) * *(const f32x4*)(g + c) * (*(const f32x4*)(sc + c) + 1.f) + *(const f32x4*)(sh + c); }
                *(u32x4*)(H + (size_t)m * D + 8 * lane + 512 * j) = pack8(hv[0], hv[1]); }
        } else {
#pragma unroll
            for (int j = 0; j < 2; ++j)
#pragma unroll
                for (int q = 0; q < 2; ++q) { const int c = 8 * lane + 512 * j + 4 * q; *(f32x4*)(a.out + (size_t)m * D + c) = x[j][q] * rstd * *(const f32x4*)(a.in[I_FG] + c); }
        }
    }
}

#ifndef USE_NAIVE
#define GEMM mfma_gemm
#else
#define GEMM naive_gemm
#endif
#define RLX_AGENT __ATOMIC_RELAXED, __HIP_MEMORY_SCOPE_AGENT
#define XB_TMO      128
#define XB_XCNT(j)  (256  + 64 * (j))
#define XB_XSUB(j)  (1280 + 64 * (j))
#define XB_XGEN(j)  (2304 + 64 * (j))
#define XB_TOP      3328
#define XB_TOPGEN   3392
#define XCD_BAR_WORDS 3456
#define XB_SPIN_CAP (1u << 18)

__device__ __forceinline__ unsigned xb_ld(unsigned* p)              { return __hip_atomic_load(p, __ATOMIC_RELAXED, __HIP_MEMORY_SCOPE_AGENT); }
__device__ __forceinline__ unsigned xb_add(unsigned* p, unsigned v) { return __hip_atomic_fetch_add(p, v, __ATOMIC_RELAXED, __HIP_MEMORY_SCOPE_AGENT); }
__device__ __forceinline__ unsigned xb_xcc_id() { return (unsigned)__builtin_amdgcn_s_getreg((3 << 11) | 20) & 0xFu; }
#define XB_SPIN(cond, bar) do { unsigned _sp = 0; while (cond) { __builtin_amdgcn_s_sleep(1); \
    if ((++_sp & 255u) == 0u) { if (xb_ld(&(bar)[XB_TMO])) break; if (_sp > XB_SPIN_CAP) { atomicAdd(&(bar)[XB_TMO], 1u); break; } } } } while (0)

struct XcdBarrier {
    unsigned* bar; unsigned x;
    volatile LAS unsigned* st;
};

__device__ __forceinline__ XcdBarrier xcd_barrier_post(unsigned* bar, volatile LAS unsigned* st) {
    XcdBarrier b; b.bar = bar; b.x = xb_xcc_id(); b.st = st;
    if (threadIdx.x == 0) (void)xb_add(&bar[XB_XCNT(b.x)], 1u);
    return b;
}
__device__ __forceinline__ void xcd_barrier_complete(unsigned* bar, unsigned x, unsigned& nloc, unsigned& nx) {
    const unsigned G = gridDim.x * gridDim.y * gridDim.z;
    unsigned sum, cnt, mine, sp = 0u;
    for (;;) {
        sum = 0u; cnt = 0u; mine = 0u;
#pragma unroll
        for (unsigned j = 0; j < 16; ++j) { const unsigned c = xb_ld(&bar[XB_XCNT(j)]); sum += c; cnt += (c > 0u) ? 1u : 0u; mine = (j == x) ? c : mine; }
        if (sum == G) break;
        __builtin_amdgcn_s_sleep(1);
        if ((++sp & 255u) == 0u) { if (xb_ld(&bar[XB_TMO])) break; if (sp > XB_SPIN_CAP) { atomicAdd(&bar[XB_TMO], 1u); break; } }
    }
    nloc = mine > 0u ? mine : 1u; nx = cnt > 0u ? cnt : 1u;
}

__device__ __forceinline__ void xcd_barrier(const XcdBarrier& b) {
    asm volatile("s_waitcnt vmcnt(0)" ::: "memory");
    __syncthreads();
    if (threadIdx.x == 0) {
        unsigned* bar = b.bar;
        __builtin_amdgcn_s_waitcnt(0);
        unsigned nloc = b.st[0], nx = b.st[1];
        if (nloc == 0u) { xcd_barrier_complete(bar, b.x, nloc, nx); b.st[0] = nloc; b.st[1] = nx; }
        const unsigned old = xb_add(&bar[XB_XSUB(b.x)], 1u);
        const unsigned gen = old / nloc;
        if (old + 1u == (gen + 1u) * nloc) {
            __builtin_amdgcn_fence(__ATOMIC_RELEASE, "agent");
            asm volatile("s_waitcnt vmcnt(0)" ::: "memory");
            const unsigned og = xb_add(&bar[XB_TOP], 1u);
            const unsigned tg = og / nx;
            if (og + 1u == (tg + 1u) * nx) xb_add(&bar[XB_TOPGEN], 1u);
            else XB_SPIN(xb_ld(&bar[XB_TOPGEN]) == tg, bar);
            __builtin_amdgcn_fence(__ATOMIC_ACQUIRE, "agent");
            xb_add(&bar[XB_XGEN(b.x)], 1u);
            asm volatile("s_waitcnt vmcnt(0)" ::: "memory");
        } else {
            XB_SPIN(xb_ld(&bar[XB_XGEN(b.x)]) == gen, bar);
            __builtin_amdgcn_fence(__ATOMIC_ACQUIRE, "agent");
            asm volatile("s_waitcnt vmcnt(0)" ::: "memory");
        }
    }
    __syncthreads();
}

constexpr int CW_BAR = 4096;
constexpr size_t CTL_ZERO_BYTES = 65536;
constexpr int LDSCTL_OFF = 131072, MISC_OFF = LDSCTL_OFF + 320;
constexpr int PH_PREP = 0, PH_MODR = 1, PH_N1 = 2, PH_L0 = 3, PH_PER_LAYER = 10, N_PHASES = PH_L0 + DEPTH * PH_PER_LAYER;
__device__ __forceinline__ Ctx make_ctx(LAS unsigned char* lds) {
    int tid_ = threadIdx.x; asm volatile("" : "+v"(tid_));
    Ctx C; C.tid = tid_; C.lane = C.tid & 63; C.wave = __builtin_amdgcn_readfirstlane(C.tid >> 6); C.nblk = gridDim.x; C.blk = blockIdx.x;
    C.gw = C.blk * NWAVES + C.wave; C.ngw = C.nblk * NWAVES; C.lds = lds; return C;
}
#ifndef ONLYPH
#define ONLYPH -1
#endif
constexpr unsigned long long REP_MASK = 0ull;
#define PH(k, ...) if ((ONLYPH < 0 || ONLYPH == (k)) && a.ph_lo <= (k) && (k) < a.ph_hi) { for (int r_ = 0; r_ < 1 + (int)((REP_MASK >> (k)) & 1ull); ++r_) { const Ctx C = make_ctx(lds); __VA_ARGS__; } if ((k) + 1 < a.ph_hi) xcd_barrier(bar); }
template <int l>
__device__ __forceinline__ void run_layer(const Args& a, LAS unsigned char* lds, const XcdBarrier& bar) {
    unsigned char* ws = a.ws; constexpr int B0 = PH_L0 + l * PH_PER_LAYER;
    PH(B0 + 0, EpiIn E{a.in[I_BIN] + (size_t)l * DIN, (bf16*)(ws + WS_UG), (bf16*)(ws + WS_ZP), (bf16*)(ws + WS_G)};
               GEMM(C, (const bf16*)(ws + WS_H), D, 0, (const bf16*)(ws + WS_WIN) + (size_t)l * DIN * D, D, M, DIN, D, E))
    PH(B0 + 1, phase_convpool(C, a, l))
    PH(B0 + 2, EpiPool E{(const bf16*)(ws + WS_G), a.in[I_POOLS] + (size_t)l * D, (bf16*)(ws + WS_TMP)};
               GEMM(C, (const bf16*)(ws + WS_PL), D, 256, (const bf16*)(ws + WS_POOL) + (size_t)l * 1024 * 256, 256, M, D, 256, E))
    PH(B0 + 3, EpiConv E{(const bf16*)(ws + WS_G), (const bf16*)(ws + WS_TMP), (bf16*)(ws + WS_Y)};
               GEMM(C, (const bf16*)(ws + WS_AC), D, 0, (const bf16*)(ws + WS_WCO) + (size_t)l * D * D, D, M, D, D, E))
    PH(B0 + 4, EpiOut E{l == 0 ? a.in[I_X] : a.out, a.out, modp(a, l, 0, 2), a.in[I_BOUT] + (size_t)l * D};
               GEMM(C, (const bf16*)(ws + WS_Y), D, 0, (const bf16*)(ws + WS_WOUT) + (size_t)l * D * D, D, M, D, D, E))
    PH(B0 + 5, phase_norm(C, a, a.out, a.in[I_N2G] + (size_t)l * D, l, 3, 4))
    PH(B0 + 6, EpiQ E{(bf16*)(ws + WS_Q)}; GEMM(C, (const bf16*)(ws + WS_H), D, 0, (const bf16*)(ws + WS_WQ) + (size_t)l * DQ * D, D, M, DQ, D, E))
    PH(B0 + 7, EpiS E{(float*)(ws + WS_S)}; GEMM(C, (const bf16*)(ws + WS_Q), DQ, 256, (const bf16*)(ws + WS_KEYS) + (size_t)l * 2048 * 256, 256, M, DQ, 256, E))
    PH(B0 + 8, phase_topk(C, a))
    PH(B0 + 9, phase_peer(C, a, l))
}
__global__ void __launch_bounds__(NTHREADS, 2) fwd_kernel(Args a) {
    extern __shared__ __attribute__((aligned(16))) unsigned char lds_raw[];
    LAS unsigned char* lds = (LAS unsigned char*)lds_raw;
    for (int u = threadIdx.x; u < (LDS_BYTES - LDSCTL_OFF) / 4; u += NTHREADS) ((LAS unsigned*)(lds + LDSCTL_OFF))[u] = 0u;
    __syncthreads();
    const XcdBarrier bar = xcd_barrier_post((unsigned*)(a.ws + WS_CTL) + CW_BAR, (volatile LAS unsigned*)(lds + MISC_OFF) + 8);
    PH(PH_PREP, phase_prep(C, a))
    PH(PH_MODR, phase_modreduce(C, a))
    PH(PH_N1, phase_norm(C, a, a.in[I_X], a.in[I_N1G], 0, 0, 1))
    run_layer<0>(a, lds, bar);
    run_layer<1>(a, lds, bar);
}

extern "C" void kernel_launch(void* const* d_in, const int* in_sizes, int n_in, void* d_out, int out_size, void* d_ws, size_t ws_size, hipStream_t stream) {
    static int grid = 0;
    if (grid == 0) {
        if (n_in != 22 || out_size != M * D || ws_size < WS_END) { fprintf(stderr, "kernel_launch: unexpected shapes (n_in %d out %d ws %zu)\n", n_in, out_size, ws_size); grid = -1; return; }
        int dev = 0, cus = 0;
        if (hipGetDevice(&dev) != hipSuccess || hipDeviceGetAttribute(&cus, hipDeviceAttributeMultiprocessorCount, dev) != hipSuccess) { grid = -1; return; }
        if (hipFuncSetAttribute((const void*)fwd_kernel, hipFuncAttributeMaxDynamicSharedMemorySize, LDS_BYTES) != hipSuccess) { grid = -1; return; }
        grid = cus;
    }
    if (grid < 0) return;
    Args a{};
    for (int i = 0; i < 22; ++i) a.in[i] = (const float*)d_in[i];
    a.out = (float*)d_out; a.ws = (unsigned char*)d_ws;
    (void)hipMemsetAsync((char*)d_ws + WS_CTL, 0, CTL_ZERO_BYTES, stream);
#ifndef ONE_LAUNCH
    for (int ph = 0; ph < N_PHASES; ++ph) { a.ph_lo = ph; a.ph_hi = ph + 1; hipLaunchKernelGGL(fwd_kernel, dim3(grid), dim3(NTHREADS), LDS_BYTES, stream, a); }
#else
    a.ph_lo = 0; a.ph_hi = N_PHASES; hipLaunchKernelGGL(fwd_kernel, dim3(grid), dim3(NTHREADS), LDS_BYTES, stream, a);
#endif
}
```

```cpp
#define ONE_LAUNCH 1
#include <hip/hip_runtime.h>
#include <cstdint>
#include <cstdio>

#define GAS __attribute__((address_space(1)))
#define LAS __attribute__((address_space(3)))
typedef unsigned short bf16;
typedef float f32x4 __attribute__((ext_vector_type(4)));
typedef float f32x2 __attribute__((ext_vector_type(2)));
typedef unsigned u32x4 __attribute__((ext_vector_type(4)));
typedef unsigned u32x2 __attribute__((ext_vector_type(2)));
typedef __bf16 bf16x2_t __attribute__((ext_vector_type(2)));

constexpr int BATCH = 2, SEQ = 8192, D = 1024, M = BATCH * SEQ, DEPTH = 2;
constexpr int DIN = 5120, NMODV = 6 * D, CONVK = 31, NHEAD = 8, NKEYS = 128, DQ = 2048, TOPK = 16, NEXP = 16384;
constexpr float EPS = 1e-6f;
constexpr int NWAVES = 8, NTHREADS = NWAVES * 64;

constexpr size_t MiB = 1u << 20;
constexpr size_t WS_CTL = 0;
constexpr size_t WS_MODP = 1 * MiB;
constexpr size_t WS_MOD = 4 * MiB;
constexpr size_t WS_WIN = 8 * MiB;
constexpr size_t WS_WCO = 28 * MiB;
constexpr size_t WS_WOUT = 32 * MiB;
constexpr size_t WS_WQ = 36 * MiB;
constexpr size_t WS_POOL = 44 * MiB;
constexpr size_t WS_KEYS = 45 * MiB;
constexpr size_t WS_UB = 48 * MiB;
constexpr size_t WS_USC = 80 * MiB;
constexpr size_t WS_VSC = 81 * MiB;
constexpr size_t WS_VB = 112 * MiB;
constexpr size_t WS_H = 176 * MiB;
constexpr size_t WS_UG = 208 * MiB;
constexpr size_t WS_Y = WS_UG;
constexpr size_t WS_ZP = 240 * MiB;
constexpr size_t WS_TMP = WS_ZP;
constexpr size_t WS_Q = WS_UG;
constexpr size_t WS_G = 272 * MiB;
constexpr size_t WS_AC = 336 * MiB;
constexpr size_t WS_PL = 368 * MiB;
constexpr size_t WS_S = WS_G;
constexpr size_t WS_EID = 400 * MiB;
constexpr size_t WS_GW = 408 * MiB;
constexpr size_t WS_END = 416 * MiB;

constexpr int LDS_BYTES = 147456;

__device__ __forceinline__ unsigned f2bf(float f) { unsigned u = __builtin_bit_cast(unsigned, f); return (u + 0x7fffu + ((u >> 16) & 1u)) >> 16; }
__device__ __forceinline__ unsigned pk2(float lo, float hi) { return f2bf(lo) | (f2bf(hi) << 16); }
__device__ __forceinline__ float bflo(unsigned w) { return __builtin_bit_cast(float, w << 16); }
__device__ __forceinline__ float bfhi(unsigned w) { return __builtin_bit_cast(float, w & 0xffff0000u); }
__device__ __forceinline__ float sigm(float x) { return 1.f / (1.f + __expf(-x)); }
__device__ __forceinline__ float wave_sum(float v) {
#pragma unroll
    for (int o = 1; o < 64; o <<= 1) v += __shfl_xor(v, o);
    return v;
}
__device__ __forceinline__ float wave_max(float v) {
#pragma unroll
    for (int o = 1; o < 64; o <<= 1) v = fmaxf(v, __shfl_xor(v, o));
    return v;
}
__device__ __forceinline__ u32x4 pack8(const f32x4& a, const f32x4& b) { u32x4 w; w.x = pk2(a.x, a.y); w.y = pk2(a.z, a.w); w.z = pk2(b.x, b.y); w.w = pk2(b.z, b.w); return w; }
__device__ __forceinline__ void unpack8(const u32x4& w, f32x4& a, f32x4& b) { a = (f32x4){bflo(w.x), bfhi(w.x), bflo(w.y), bfhi(w.y)}; b = (f32x4){bflo(w.z), bfhi(w.z), bflo(w.w), bfhi(w.w)}; }

struct Ctx { int tid, lane, wave, gw, ngw, nblk, blk; LAS unsigned char* lds; };

struct Args { const float* in[22]; float* out; unsigned char* ws; int ph_lo, ph_hi; };
enum { I_X = 0, I_C, I_ADAW, I_ADAB, I_N1G, I_WIN, I_BIN, I_CONVW, I_CONVB, I_LNG, I_LNB, I_WCO, I_POOLW, I_POOLS, I_WOUT, I_BOUT, I_N2G, I_WQ, I_KEYS, I_PU, I_PV, I_FG };

__device__ __forceinline__ void transpose_item(const float* W, int K, int N, int k0, int n0, bf16* WT, int dstrow0, LAS float* scr, int lane) {
#pragma unroll 8
    for (int i = 0; i < 32; ++i) { const int kk = 2 * i + (lane >> 5); scr[kk * 33 + (lane & 31)] = W[(size_t)(k0 + kk) * N + n0 + (lane & 31)]; }
    asm volatile("s_waitcnt lgkmcnt(0)" ::: "memory");
    const int c = lane & 7;
#pragma unroll
    for (int j = 0; j < 4; ++j) { const int n = (lane >> 3) + 8 * j; const LAS float* s = scr + (8 * c) * 33 + n;
        u32x4 o; o.x = pk2(s[0 * 33], s[1 * 33]); o.y = pk2(s[2 * 33], s[3 * 33]); o.z = pk2(s[4 * 33], s[5 * 33]); o.w = pk2(s[6 * 33], s[7 * 33]);
        *(u32x4*)(WT + (size_t)(dstrow0 + n) * K + k0 + 8 * c) = o; }
    asm volatile("s_waitcnt lgkmcnt(0)" ::: "memory");
}
__device__ __forceinline__ int win_dstrow(int n0) {
    if (n0 < 1024) return 256 * (n0 >> 7) + (n0 & 127);
    if (n0 < 2048) { const int c = n0 - 1024; return 256 * (c >> 7) + 128 + (c & 127); }
    return n0;
}
__device__ __forceinline__ void phase_prep(const Ctx& C, const Args& a) {
    unsigned char* ws = a.ws;
    LAS float* scr = (LAS float*)(C.lds + C.wave * 16384);
    constexpr int I_IN = 16 * 160, I_CO = 16 * 32, I_PO = 4 * (4 * 8), I_OUT = 16 * 32, I_Q = 16 * 64, I_L = I_IN + I_CO + I_PO + I_OUT + I_Q;
    for (int it = C.gw; it < DEPTH * I_L; it += C.ngw) {
        const int l = it / I_L; int r = it % I_L;
        if (r < I_IN) { const int kb = r / 160, nb = r % 160; transpose_item(a.in[I_WIN] + (size_t)l * D * DIN, D, DIN, 64 * kb, 32 * nb, (bf16*)(ws + WS_WIN) + (size_t)l * DIN * D, win_dstrow(32 * nb), scr, C.lane); continue; } r -= I_IN;
        if (r < I_CO) { const int kb = r / 32, nb = r % 32; transpose_item(a.in[I_WCO] + (size_t)l * D * D, D, D, 64 * kb, 32 * nb, (bf16*)(ws + WS_WCO) + (size_t)l * D * D, 32 * nb, scr, C.lane); continue; } r -= I_CO;
        if (r < I_PO) { const int g = r / 32, q = r % 32, kb = q / 8, nb = q % 8; transpose_item(a.in[I_POOLW] + ((size_t)l * 4 + g) * 256 * 256, 256, 256, 64 * kb, 32 * nb, (bf16*)(ws + WS_POOL) + ((size_t)l * 1024 + 256 * g) * 256, 32 * nb, scr, C.lane); continue; } r -= I_PO;
        if (r < I_OUT) { const int kb = r / 32, nb = r % 32; transpose_item(a.in[I_WOUT] + (size_t)l * D * D, D, D, 64 * kb, 32 * nb, (bf16*)(ws + WS_WOUT) + (size_t)l * D * D, 32 * nb, scr, C.lane); continue; } r -= I_OUT;
        { const int kb = r / 64, nb = r % 64; transpose_item(a.in[I_WQ] + (size_t)l * D * DQ, D, DQ, 64 * kb, 32 * nb, (bf16*)(ws + WS_WQ) + (size_t)l * DQ * D, 32 * nb, scr, C.lane); }
    }
    const int gt = C.blk * NTHREADS + C.tid, ngt = C.nblk * NTHREADS;
    for (int i = gt; i < DEPTH * 2048 * 32; i += ngt) {
        const int l = i / (2048 * 32), r = i % (2048 * 32), n = r / 32, k8 = (r % 32) * 8;
        const int h = n >> 8, p = (n >> 7) & 1, key = n & 127, pk = k8 >> 7, kk = k8 & 127;
        u32x4 o = (u32x4){0u, 0u, 0u, 0u};
        if (pk == p) { const float* s = a.in[I_KEYS] + ((((size_t)l * 8 + h) * 2 + p) * 128 + key) * 128 + kk; const f32x4 v0 = *(const f32x4*)s, v1 = *(const f32x4*)(s + 4); o = pack8(v0, v1); }
        *(u32x4*)((bf16*)(ws + WS_KEYS) + ((size_t)l * 2048 + n) * 256 + k8) = o;
    }
    for (int t = 0; t < 2; ++t) {
        const float* src = a.in[t == 0 ? I_PU : I_PV]; unsigned char* dst = ws + (t == 0 ? WS_UB : WS_VB); float* scl = (float*)(ws + (t == 0 ? WS_USC : WS_VSC));
        for (int row = C.gw; row < DEPTH * NEXP; row += C.ngw) {
            const float* sp = src + (size_t)row * D + 16 * C.lane; f32x4 v[4]; float am = 0.f;
#pragma unroll
            for (int q = 0; q < 4; ++q) { v[q] = *(const f32x4*)(sp + 4 * q); am = fmaxf(am, fmaxf(fmaxf(fabsf(v[q].x), fabsf(v[q].y)), fmaxf(fabsf(v[q].z), fabsf(v[q].w)))); }
            am = wave_max(am);
            const float inv = am > 0.f ? 440.f / am : 0.f; u32x4 w;
#pragma unroll
            for (int q = 0; q < 4; ++q) { int p = __builtin_amdgcn_cvt_pk_fp8_f32(v[q].x * inv, v[q].y * inv, 0, false); p = __builtin_amdgcn_cvt_pk_fp8_f32(v[q].z * inv, v[q].w * inv, p, true); w[q] = (unsigned)p; }
            *(u32x4*)(dst + (size_t)row * D + 16 * C.lane) = w;
            if (C.lane == 0) scl[row] = am * (1.f / 440.f);
        }
    }
    for (int it = gt; it < 32 * 3072; it += ngt) {
        const int ks = it / 3072, cg = it % 3072, l = cg / 1536, n4 = (cg % 1536) * 4;
        f32x4 a0 = (f32x4){0.f, 0.f, 0.f, 0.f}, a1 = a0;
        const float* wp = a.in[I_ADAW] + ((size_t)l * D + ks * 32) * NMODV + n4; const float* c0 = a.in[I_C] + ks * 32; const float* c1 = c0 + D;
#pragma unroll 8
        for (int kk = 0; kk < 32; ++kk) { const f32x4 w = *(const f32x4*)(wp + (size_t)kk * NMODV); const float x0 = c0[kk], x1 = c1[kk]; a0 += w * (x0 * sigm(x0)); a1 += w * (x1 * sigm(x1)); }
        float* mp = (float*)(ws + WS_MODP) + (((size_t)ks * 2 + l) * 2) * NMODV + n4;
        *(f32x4*)mp = a0; *(f32x4*)(mp + NMODV) = a1;
    }
}
__device__ __forceinline__ void phase_modreduce(const Ctx& C, const Args& a) {
    const int gt = C.blk * NTHREADS + C.tid, ngt = C.nblk * NTHREADS;
    for (int i = gt; i < 2 * 2 * NMODV; i += ngt) {
        const int l = i / (2 * NMODV), n = i % NMODV; float s = a.in[I_ADAB][(size_t)l * NMODV + n];
        const float* mp = (const float*)(a.ws + WS_MODP) + i;
        for (int ks = 0; ks < 32; ++ks) s += mp[(size_t)ks * 4 * NMODV];
        ((float*)(a.ws + WS_MOD))[i] = s;
    }
}
__device__ __forceinline__ const float* modp(const Args& a, int l, int b, int v) { return (const float*)(a.ws + WS_MOD) + ((size_t)l * 2 + b) * NMODV + v * D; }

__device__ __forceinline__ void normmod_row(const f32x4 (&x)[4], const float* g, const float* sh, const float* sc, int lane, f32x4 (&h)[4]) {
    float s = 0.f;
#pragma unroll
    for (int j = 0; j < 4; ++j) s += (x[j].x * x[j].x + x[j].y * x[j].y) + (x[j].z * x[j].z + x[j].w * x[j].w);
    const float rstd = 1.f / sqrtf(wave_sum(s) * (1.f / D) + EPS);
#pragma unroll
    for (int j = 0; j < 4; ++j) { const int c = 4 * lane + 256 * j; const f32x4 gv = *(const f32x4*)(g + c), shv = *(const f32x4*)(sh + c), scv = *(const f32x4*)(sc + c);
        h[j] = (x[j] * rstd) * gv * (scv + 1.f) + shv; }
}
__device__ __forceinline__ void store_row_bf16(bf16* row, const f32x4 (&h)[4], int lane) {
#pragma unroll
    for (int j = 0; j < 4; ++j) { u32x2 w; w.x = pk2(h[j].x, h[j].y); w.y = pk2(h[j].z, h[j].w); *(u32x2*)(row + 4 * lane + 256 * j) = w; }
}
__device__ __forceinline__ void phase_norm(const Ctx& C, const Args& a, const float* X, const float* g, int l, int vsh, int vsc) {
    bf16* H = (bf16*)(a.ws + WS_H);
    for (int m = C.gw; m < M; m += C.ngw) {
        const int b = m >> 13; f32x4 x[4], h[4];
#pragma unroll
        for (int j = 0; j < 4; ++j) x[j] = *(const f32x4*)(X + (size_t)m * D + 4 * C.lane + 256 * j);
        normmod_row(x, g, modp(a, l, b, vsh), modp(a, l, b, vsc), C.lane, h);
        store_row_bf16(H + (size_t)m * D, h, C.lane);
    }
}

struct EpiIn {
    const float* bin; bf16 *UG, *ZP, *G;
    __device__ __forceinline__ void apply(int row, int pn, int cl8, f32x4 a0, f32x4 a1, f32x4 b0, f32x4 b1) const {
        if (pn < 8) {
            const int c = 128 * pn + cl8;
            a0 += *(const f32x4*)(bin + c); a1 += *(const f32x4*)(bin + c + 4); b0 += *(const f32x4*)(bin + 1024 + c); b1 += *(const f32x4*)(bin + 1024 + c + 4);
            f32x4 u0, u1;
#pragma unroll
            for (int i = 0; i < 4; ++i) { u0[i] = a0[i] * sigm(b0[i]); u1[i] = a1[i] * sigm(b1[i]); }
            *(u32x4*)(UG + (size_t)row * D + c) = pack8(u0, u1);
        } else if (pn < 12) {
            const int c = 256 * (pn - 8) + cl8;
            a0 += *(const f32x4*)(bin + 2048 + c); a1 += *(const f32x4*)(bin + 2048 + c + 4); b0 += *(const f32x4*)(bin + 2048 + 128 + c); b1 += *(const f32x4*)(bin + 2048 + 128 + c + 4);
            *(u32x4*)(ZP + (size_t)row * D + c) = pack8(a0, a1); *(u32x4*)(ZP + (size_t)row * D + c + 128) = pack8(b0, b1);
        } else {
            const int c = 256 * (pn - 12) + cl8;
            a0 += *(const f32x4*)(bin + 3072 + c); a1 += *(const f32x4*)(bin + 3072 + c + 4); b0 += *(const f32x4*)(bin + 3072 + 128 + c); b1 += *(const f32x4*)(bin + 3072 + 128 + c + 4);
#pragma unroll
            for (int i = 0; i < 4; ++i) { a0[i] = sigm(a0[i]); a1[i] = sigm(a1[i]); b0[i] = sigm(b0[i]); b1[i] = sigm(b1[i]); }
            *(u32x4*)(G + (size_t)row * 2048 + c) = pack8(a0, a1); *(u32x4*)(G + (size_t)row * 2048 + c + 128) = pack8(b0, b1);
        }
    }
};
struct EpiPool {
    const bf16* G; const float* scale; bf16* TMP;
    __device__ __forceinline__ void apply(int row, int pn, int cl8, f32x4 a0, f32x4 a1, f32x4 b0, f32x4 b1) const {
        const int c = 256 * pn + cl8; f32x4 g0, g1;
        unpack8(*(const u32x4*)(G + (size_t)row * 2048 + 1024 + c), g0, g1);
        a0 = a0 * g0 * *(const f32x4*)(scale + c); a1 = a1 * g1 * *(const f32x4*)(scale + c + 4);
        *(u32x4*)(TMP + (size_t)row * D + c) = pack8(a0, a1);
        unpack8(*(const u32x4*)(G + (size_t)row * 2048 + 1024 + c + 128), g0, g1);
        b0 = b0 * g0 * *(const f32x4*)(scale + c + 128); b1 = b1 * g1 * *(const f32x4*)(scale + c + 132);
        *(u32x4*)(TMP + (size_t)row * D + c + 128) = pack8(b0, b1);
    }
};
struct EpiConv {
    const bf16* G; const bf16* TMP; bf16* Y;
    __device__ __forceinline__ void apply(int row, int pn, int cl8, f32x4 a0, f32x4 a1, f32x4 b0, f32x4 b1) const {
        const int c = 256 * pn + cl8; f32x4 g0, g1, t0, t1;
        unpack8(*(const u32x4*)(G + (size_t)row * 2048 + c), g0, g1); unpack8(*(const u32x4*)(TMP + (size_t)row * D + c), t0, t1);
        *(u32x4*)(Y + (size_t)row * D + c) = pack8(a0 * g0 + t0, a1 * g1 + t1);
        unpack8(*(const u32x4*)(G + (size_t)row * 2048 + c + 128), g0, g1); unpack8(*(const u32x4*)(TMP + (size_t)row * D + c + 128), t0, t1);
        *(u32x4*)(Y + (size_t)row * D + c + 128) = pack8(b0 * g0 + t0, b1 * g1 + t1);
    }
};
struct EpiOut {
    const float* xold; float* xnew; const float* g1;   const float* bout;
    __device__ __forceinline__ void apply(int row, int pn, int cl8, f32x4 a0, f32x4 a1, f32x4 b0, f32x4 b1) const {
        const int c = 256 * pn + cl8; const float* g = g1 + (size_t)(row >> 13) * NMODV; const size_t o = (size_t)row * D + c;
        *(f32x4*)(xnew + o) = *(const f32x4*)(xold + o) + *(const f32x4*)(g + c) * (a0 + *(const f32x4*)(bout + c));
        *(f32x4*)(xnew + o + 4) = *(const f32x4*)(xold + o + 4) + *(const f32x4*)(g + c + 4) * (a1 + *(const f32x4*)(bout + c + 4));
        *(f32x4*)(xnew + o + 128) = *(const f32x4*)(xold + o + 128) + *(const f32x4*)(g + c + 128) * (b0 + *(const f32x4*)(bout + c + 128));
        *(f32x4*)(xnew + o + 132) = *(const f32x4*)(xold + o + 132) + *(const f32x4*)(g + c + 132) * (b1 + *(const f32x4*)(bout + c + 132));
    }
};
struct EpiQ {
    bf16* Q;
    __device__ __forceinline__ void apply(int row, int pn, int cl8, f32x4 a0, f32x4 a1, f32x4 b0, f32x4 b1) const {
        const size_t o = (size_t)row * DQ + 256 * pn + cl8; *(u32x4*)(Q + o) = pack8(a0, a1); *(u32x4*)(Q + o + 128) = pack8(b0, b1);
    }
};
struct EpiS {
    float* S;
    __device__ __forceinline__ void apply(int row, int pn, int cl8, f32x4 a0, f32x4 a1, f32x4 b0, f32x4 b1) const {
        const size_t o = (size_t)row * DQ + 256 * pn + cl8; *(f32x4*)(S + o) = a0; *(f32x4*)(S + o + 4) = a1; *(f32x4*)(S + o + 128) = b0; *(f32x4*)(S + o + 132) = b1;
    }
};

namespace pg8 {
#define PG8_LAS __attribute__((address_space(3)))
typedef unsigned short bf16_t;
typedef short bf16x8 __attribute__((ext_vector_type(8)));
typedef float f32x4 __attribute__((ext_vector_type(4)));
typedef unsigned u32x4 __attribute__((ext_vector_type(4)));
constexpr int BM = 256, BK = 64, HALF = 128, HTB = HALF * BK * 2  , STAGE_BYTES = 8 * HTB, NXCD = 8, WGM = 8;

__host__ __device__ __forceinline__ int lds_byte(int r, int c) { const int st = (r >> 4) * 2 + (c >> 5), rr = r & 15, cc = c & 31, ob = rr * 64 + cc * 2; return st * 1024 + (ob ^ (((ob >> 9) & 1) << 5)); }
__host__ __device__ __forceinline__ void stage_rc(int b, int& R, int& C) { const int st = b / 1024, sb = b % 1024, swz = sb ^ (((sb >> 9) & 1) << 5); R = (st >> 1) * 16 + swz / 64; C = (st & 1) * 32 + (swz % 64) / 2; }
__host__ __device__ __forceinline__ int perm32(int rho) { const int n = rho >> 4, i = rho & 15; return 8 * (i >> 2) + 4 * n + (i & 3); }

struct Unit { int pm, pn; };
struct Gemm { const bf16_t* A; const bf16_t* Bt; int M, N, K, lda, ldb, acol; };

struct StaticOrder {
    int nM, nN, nwg, G, c;
    __host__ __device__ void init(int M, int N, int G_, int c_) { nM = M / BM; nN = N / BM; nwg = nM * nN; G = G_; c = c_; }
    __host__ __device__ bool next(int i, Unit& u) const {
        const long L = (long)i * G + c; if (L >= nwg) return false;
        int wgid = (int)L; { const int q = nwg / NXCD, r = nwg % NXCD, xcd = wgid % NXCD, off = wgid / NXCD; wgid = (xcd < r ? xcd * (q + 1) : r * (q + 1) + (xcd - r) * q) + off; }
        const int nig = WGM * nN, gid = wgid / nig, fm = gid * WGM, gsz = (nM - fm) < WGM ? (nM - fm) : WGM;
        u.pm = fm + ((wgid % nig) % gsz); u.pn = (wgid % nig) / gsz; return true;
    }
    __device__ __forceinline__ void a_ready(const Unit&) const {}
    __device__ __forceinline__ void done(const Unit&) const {}
};


template <class Epi, class Sched, bool ALIGN_EPI = false, bool SP2 = false>
__device__ __forceinline__ void gemm_phase(PG8_LAS unsigned char* lds, const Gemm g, const Sched& S, const Epi& E) {
    const int tid = threadIdx.x, wid = __builtin_amdgcn_readfirstlane(tid >> 6), lane = tid & 63, wr = wid >> 2, wc = wid & 3, fr = lane & 15, fq = lane >> 4;
    const int K = g.K, nt = K / BK;
    unsigned voffA[2], voffB[2];
#pragma unroll
    for (int i = 0; i < 2; ++i) { int R, C; stage_rc(tid * 16 + i * 8192, R, C); const int Rb = Epi::PERM ? ((R & ~31) + perm32(R & 31)) : R;
        voffA[i] = (unsigned)(R * g.lda + C) * 2u; voffB[i] = (unsigned)(Rb * g.ldb + C) * 2u; }
    const size_t kstep = (size_t)(BK * 2);
    const size_t hstepA = (size_t)HALF * g.lda * 2, hstepB = (size_t)HALF * g.ldb * 2;
    const size_t tstepA = 2 * hstepA, tstepB = 2 * hstepB, acolb = (size_t)g.acol * 2;
    const unsigned ldsw = (unsigned)wid * 1024u;
    const int aoff = lds_byte(wr * 64 + fr, fq * 8), boff = lds_byte(wc * 32 + fr, fq * 8);
#define PG8_SA(b, h) (((b) * 2 + (h)) * HTB)
#define PG8_SB(b, h) ((4 + (b) * 2 + (h)) * HTB)
#define PG8_STAGE(bufoff, gbase, voff) do { _Pragma("unroll") for (int _i = 0; _i < 2; ++_i) \
        __builtin_amdgcn_global_load_lds((const unsigned*)((const char*)(gbase) + (voff)[_i]), (PG8_LAS unsigned*)(lds + (bufoff) + ldsw + _i * 8192), 16, 0, 0); } while (0)
#define PG8_LDA(dst, b, h) do { _Pragma("unroll") for (int m = 0; m < 4; ++m) _Pragma("unroll") for (int k = 0; k < 2; ++k) dst[m][k] = *(const PG8_LAS bf16x8*)(lds + PG8_SA(b, h) + aoff + m * 2048 + k * 1024); } while (0)
#define PG8_LDB(dst, b, h) do { _Pragma("unroll") for (int n = 0; n < 2; ++n) _Pragma("unroll") for (int k = 0; k < 2; ++k) dst[n][k] = *(const PG8_LAS bf16x8*)(lds + PG8_SB(b, h) + boff + n * 2048 + k * 1024); } while (0)
#define PG8_MMA(ai, bj, At, Bt) do { __builtin_amdgcn_s_setprio(1); _Pragma("unroll") for (int m = 0; m < 4; ++m) _Pragma("unroll") for (int n = 0; n < 2; ++n) _Pragma("unroll") for (int k = 0; k < 2; ++k) \
        acc[ai][bj][m][n] = __builtin_amdgcn_mfma_f32_16x16x32_bf16(Bt[n][k], At[m][k], acc[ai][bj][m][n], 0, 0, 0); __builtin_amdgcn_s_setprio(0); } while (0)
#define PG8_WAIT_V(n) asm volatile("s_waitcnt vmcnt(" #n ")" ::: "memory")
#define PG8_WAIT_L(n) asm volatile("s_waitcnt lgkmcnt(" #n ")" ::: "memory")
#define PG8_BAR __builtin_amdgcn_s_barrier()
#define PG8_SCHED __builtin_amdgcn_sched_barrier(0)
    Unit cur, nxt; int ui = 0;
    if (!S.next(0, cur)) return;
    f32x4 acc[2][2][4][2];
#pragma unroll
    for (int a = 0; a < 2; ++a)
#pragma unroll
        for (int b = 0; b < 2; ++b)
#pragma unroll
            for (int m = 0; m < 4; ++m)
#pragma unroll
                for (int n = 0; n < 2; ++n) acc[a][b][m][n] = (f32x4){0.f, 0.f, 0.f, 0.f};
    bf16x8 At[4][2], B0[2][2], B1[2][2];
    const char* cA = (const char*)g.A + (size_t)cur.pm * tstepA + (size_t)cur.pn * acolb; const char* cB = (const char*)g.Bt + (size_t)cur.pn * tstepB;
    S.a_ready(cur);
    if constexpr (SP2) {
        PG8_STAGE(PG8_SB(0, 0), cB, voffB); PG8_STAGE(PG8_SB(0, 1), cB + hstepB, voffB); PG8_STAGE(PG8_SA(0, 0), cA, voffA); PG8_STAGE(PG8_SA(0, 1), cA + hstepA, voffA);
        if (wr == 1) PG8_BAR;
        PG8_WAIT_V(2); PG8_BAR;
        PG8_STAGE(PG8_SB(1, 0), cB + kstep, voffB); PG8_STAGE(PG8_SA(1, 0), cA + kstep, voffA); PG8_STAGE(PG8_SB(1, 1), cB + hstepB + kstep, voffB);
        PG8_WAIT_V(6); PG8_BAR;
    } else {
        PG8_STAGE(PG8_SB(0, 0), cB, voffB); PG8_STAGE(PG8_SA(0, 0), cA, voffA); PG8_STAGE(PG8_SB(0, 1), cB + hstepB, voffB); PG8_STAGE(PG8_SA(0, 1), cA + hstepA, voffA);
        if (wr == 1) PG8_BAR;
        PG8_WAIT_V(4); PG8_BAR;
        PG8_STAGE(PG8_SB(1, 0), cB + kstep, voffB); PG8_STAGE(PG8_SA(1, 0), cA + kstep, voffA); PG8_STAGE(PG8_SB(1, 1), cB + hstepB + kstep, voffB);
        PG8_WAIT_V(6); PG8_BAR;
    }
    for (;;) {
        const bool has_next = S.next(ui + 1, nxt);
        const char* nA = has_next ? (const char*)g.A + (size_t)nxt.pm * tstepA + (size_t)nxt.pn * acolb : cA; const char* nB = has_next ? (const char*)g.Bt + (size_t)nxt.pn * tstepB : cB;
#pragma nounroll
        for (int t = 0; t < nt; t += 2) {
            const bool last = (t == nt - 2);
            const char* a1 = cA + (size_t)(t + 1) * kstep;
            const char* a2 = last ? nA : cA + (size_t)(t + 2) * kstep; const char* b2 = last ? nB : cB + (size_t)(t + 2) * kstep;
            const char* a3 = a2 + kstep; const char* b3 = b2 + kstep;
            if (last && has_next) S.a_ready(nxt);
            if constexpr (SP2) {
            PG8_LDB(B0, 0, 0); PG8_LDB(B1, 0, 1); PG8_SCHED; PG8_LDA(At, 0, 0); PG8_STAGE(PG8_SA(1, 1), a1 + hstepA, voffA);
            PG8_WAIT_V(8); PG8_WAIT_L(0); PG8_BAR; PG8_MMA(0, 0, At, B0); PG8_MMA(0, 1, At, B1); PG8_BAR; PG8_SCHED;
            PG8_LDA(At, 0, 1); PG8_STAGE(PG8_SB(0, 0), b2, voffB); PG8_STAGE(PG8_SB(0, 1), b2 + hstepB, voffB); PG8_STAGE(PG8_SA(0, 0), a2, voffA);
            PG8_WAIT_V(8); PG8_WAIT_L(0); PG8_BAR; PG8_MMA(1, 0, At, B0); PG8_MMA(1, 1, At, B1); PG8_BAR; PG8_SCHED;
            PG8_LDB(B0, 1, 0); PG8_LDB(B1, 1, 1); PG8_SCHED; PG8_LDA(At, 1, 0); PG8_STAGE(PG8_SA(0, 1), a2 + hstepA, voffA);
            PG8_WAIT_V(8); PG8_WAIT_L(0); PG8_BAR; PG8_MMA(0, 0, At, B0); PG8_MMA(0, 1, At, B1); PG8_BAR; PG8_SCHED;
            PG8_LDA(At, 1, 1); PG8_STAGE(PG8_SB(1, 0), b3, voffB); PG8_STAGE(PG8_SB(1, 1), b3 + hstepB, voffB); PG8_STAGE(PG8_SA(1, 0), a3, voffA);
            PG8_WAIT_V(8); PG8_WAIT_L(0); PG8_BAR; PG8_MMA(1, 0, At, B0); PG8_MMA(1, 1, At, B1); PG8_BAR; PG8_SCHED;
            } else {
            PG8_LDB(B0, 0, 0); PG8_SCHED; PG8_LDA(At, 0, 0); PG8_STAGE(PG8_SA(1, 1), a1 + hstepA, voffA);
            PG8_WAIT_L(8); PG8_BAR; PG8_WAIT_L(0); PG8_MMA(0, 0, At, B0); PG8_BAR; PG8_SCHED;
            PG8_LDB(B1, 0, 1); PG8_STAGE(PG8_SB(0, 0), b2, voffB);
            PG8_BAR; PG8_WAIT_L(0); PG8_MMA(0, 1, At, B1); PG8_BAR;
            PG8_LDA(At, 0, 1); PG8_STAGE(PG8_SA(0, 0), a2, voffA);
            PG8_BAR; PG8_WAIT_L(0); PG8_MMA(1, 0, At, B0); PG8_BAR; PG8_SCHED;
            PG8_STAGE(PG8_SB(0, 1), b2 + hstepB, voffB);
            PG8_WAIT_V(6); PG8_BAR; PG8_MMA(1, 1, At, B1); PG8_BAR;
            PG8_LDB(B0, 1, 0); PG8_SCHED; PG8_LDA(At, 1, 0); PG8_STAGE(PG8_SA(0, 1), a2 + hstepA, voffA);
            PG8_WAIT_L(8); PG8_BAR; PG8_WAIT_L(0); PG8_MMA(0, 0, At, B0); PG8_BAR; PG8_SCHED;
            PG8_LDB(B1, 1, 1); PG8_STAGE(PG8_SB(1, 0), b3, voffB);
            PG8_BAR; PG8_WAIT_L(0); PG8_MMA(0, 1, At, B1); PG8_BAR;
            PG8_LDA(At, 1, 1); PG8_STAGE(PG8_SA(1, 0), a3, voffA);
            PG8_BAR; PG8_WAIT_L(0); PG8_MMA(1, 0, At, B0); PG8_BAR; PG8_SCHED;
            PG8_STAGE(PG8_SB(1, 1), b3 + hstepB, voffB);
            PG8_WAIT_V(6); PG8_BAR; PG8_MMA(1, 1, At, B1); PG8_BAR;
            }
        }
        if constexpr (ALIGN_EPI) { if (wr == 0) PG8_BAR; }
        if constexpr (!Epi::AFTER_DRAIN) { E(acc, cur, wr, wc, fr, fq); S.done(cur); }
        if (!has_next) break;
#pragma unroll
        for (int a = 0; a < 2; ++a)
#pragma unroll
            for (int b = 0; b < 2; ++b)
#pragma unroll
                for (int m = 0; m < 4; ++m)
#pragma unroll
                    for (int n = 0; n < 2; ++n) acc[a][b][m][n] = (f32x4){0.f, 0.f, 0.f, 0.f};
        cur = nxt; cA = nA; cB = nB; ++ui;
        if constexpr (ALIGN_EPI) { if (wr == 1) PG8_BAR; }
    }
    PG8_WAIT_V(0);
    if constexpr (!ALIGN_EPI) { if (wr == 0) PG8_BAR; }
    PG8_BAR;
    if constexpr (Epi::AFTER_DRAIN) { E.fused(acc, cur, wr, wc, fr, fq, lds, wid, lane); S.done(cur); }
#undef PG8_SA
#undef PG8_SB
#undef PG8_STAGE
#undef PG8_LDA
#undef PG8_LDB
#undef PG8_MMA
#undef PG8_WAIT_V
#undef PG8_WAIT_L
#undef PG8_BAR
#undef PG8_SCHED
}

template <class F> struct EpiW {
    static constexpr bool PERM = true, AFTER_DRAIN = false; F f;
    __device__ __forceinline__ void operator()(const f32x4 (&acc)[2][2][4][2], const Unit& u, int wr, int wc, int fr, int fq) const {
#pragma unroll
        for (int ai = 0; ai < 2; ++ai)
#pragma unroll
            for (int m = 0; m < 4; ++m) { f.apply(u.pm * BM + ai * HALF + wr * 64 + m * 16 + fr, u.pn, wc * 32 + 8 * fq, acc[ai][0][m][0], acc[ai][0][m][1], acc[ai][1][m][0], acc[ai][1][m][1]);
                asm volatile("" ::: "memory"); }
    }
};
}

template <class F>
__device__ __forceinline__ void mfma_gemm(const Ctx& C, const bf16* A, int lda, int acol, const bf16* Bt, int ldb, int Mr, int N, int K, const F& f) {
    pg8::Gemm g{A, Bt, Mr, N, K, lda, ldb, acol}; pg8::StaticOrder S; S.init(Mr, N, C.nblk, C.blk); pg8::EpiW<F> E{f};
    pg8::gemm_phase<pg8::EpiW<F>, pg8::StaticOrder, true, true>(C.lds, g, S, E);
}

template <class F>
__device__ __forceinline__ void naive_gemm(const Ctx& C, const bf16* A, int lda, int acol, const bf16* Bt, int ldb, int Mr, int N, int K, const F& f) {
    LAS float* As = (LAS float*)C.lds;
    LAS float* Bs = (LAS float*)(C.lds + 8192);
    const int ntm = Mr / 128, ntn = N / 256, tid = C.tid, cg = tid & 15, r0 = tid >> 4;
    for (int tile = C.blk; tile < ntm * ntn; tile += C.nblk) {
        const int tm = tile / ntn, pn = tile % ntn;
        f32x4 acc[4][4];
#pragma unroll
        for (int i = 0; i < 4; ++i)
#pragma unroll
            for (int j = 0; j < 4; ++j) acc[i][j] = (f32x4){0.f, 0.f, 0.f, 0.f};
        const bf16* ap = A + (size_t)(tm * 128 + (tid >> 2)) * lda + pn * acol + (tid & 3) * 4;
        const bf16* bp = Bt + (size_t)(pn * 256 + (tid >> 1)) * ldb + (tid & 1) * 8;
        for (int k0 = 0; k0 < K; k0 += 16) {
            const u32x2 av = *(const u32x2*)(ap + k0); const u32x4 bv = *(const u32x4*)(bp + k0);
            __syncthreads();
            { const int r = tid >> 2, kq = (tid & 3) * 4; As[(kq + 0) * 128 + r] = bflo(av.x); As[(kq + 1) * 128 + r] = bfhi(av.x); As[(kq + 2) * 128 + r] = bflo(av.y); As[(kq + 3) * 128 + r] = bfhi(av.y); }
            { const int n = tid >> 1, kq = (tid & 1) * 8; Bs[(kq + 0) * 256 + n] = bflo(bv.x); Bs[(kq + 1) * 256 + n] = bfhi(bv.x); Bs[(kq + 2) * 256 + n] = bflo(bv.y); Bs[(kq + 3) * 256 + n] = bfhi(bv.y);
              Bs[(kq + 4) * 256 + n] = bflo(bv.z); Bs[(kq + 5) * 256 + n] = bfhi(bv.z); Bs[(kq + 6) * 256 + n] = bflo(bv.w); Bs[(kq + 7) * 256 + n] = bfhi(bv.w); }
            __syncthreads();
#pragma unroll
            for (int kk = 0; kk < 16; ++kk) {
                const f32x4 b0 = *(const LAS f32x4*)(Bs + kk * 256 + cg * 8), b1 = *(const LAS f32x4*)(Bs + kk * 256 + cg * 8 + 4), b2 = *(const LAS f32x4*)(Bs + kk * 256 + 128 + cg * 8), b3 = *(const LAS f32x4*)(Bs + kk * 256 + 128 + cg * 8 + 4);
#pragma unroll
                for (int i = 0; i < 4; ++i) { const float av1 = As[kk * 128 + r0 + 32 * i]; acc[i][0] += b0 * av1; acc[i][1] += b1 * av1; acc[i][2] += b2 * av1; acc[i][3] += b3 * av1; }
            }
        }
#pragma unroll
        for (int i = 0; i < 4; ++i) f.apply(tm * 128 + r0 + 32 * i, pn, cg * 8, acc[i][0], acc[i][1], acc[i][2], acc[i][3]);
    }
}

template <int W>
__device__ __forceinline__ void pool_item(const bf16* ZP, bf16* PL, int m0, int t0, int c0) {
    float p0[47], p1[47];
#pragma unroll
    for (int i = 0; i < 47; ++i) { const int r = t0 - 15 + i; unsigned w = 0u; if (i >= 15 - (W - 1)) { if (r >= 0) w = *(const unsigned*)(ZP + (size_t)(m0 - 15 + i) * D + c0); } p0[i] = bflo(w); p1[i] = bfhi(w); }
#pragma unroll
    for (int ti = 0; ti < 32; ++ti) {
        float s0 = 0.f, s1 = 0.f;
#pragma unroll
        for (int j = 0; j < W; ++j) { s0 += p0[ti + 15 - j]; s1 += p1[ti + 15 - j]; }
        const int cnt = (t0 + ti + 1) < W ? (t0 + ti + 1) : W; const float inv = 1.f / (float)cnt;
        *(unsigned*)(PL + (size_t)(m0 + ti) * D + c0) = pk2(s0 * inv - p0[ti + 15], s1 * inv - p1[ti + 15]);
    }
}
__device__ __forceinline__ void phase_convpool(const Ctx& C, const Args& a, int l) {
    const bf16* UG = (const bf16*)(a.ws + WS_UG); const bf16* ZP = (const bf16*)(a.ws + WS_ZP);
    bf16* AC = (bf16*)(a.ws + WS_AC); bf16* PL = (bf16*)(a.ws + WS_PL);
    const float* cw = a.in[I_CONVW] + (size_t)l * CONVK * D; const float* cb = a.in[I_CONVB] + (size_t)l * D;
    const float* lng = a.in[I_LNG] + (size_t)l * D; const float* lnb = a.in[I_LNB] + (size_t)l * D;
    LAS float* red = (LAS float*)C.lds;
    LAS float* stat = (LAS float*)(C.lds + 2048);
    int c0 = 2 * C.tid;
    asm volatile("" : "+v"(c0));
    float w0[31], w1[31];
#pragma unroll
    for (int k = 0; k < 31; ++k) { const f32x2 w = *(const f32x2*)(cw + (size_t)k * D + c0); w0[k] = w.x; w1[k] = w.y; }
    for (int item = C.blk; item < M / 32; item += C.nblk) {
        const int m0 = item * 32, t0 = m0 & (SEQ - 1);
        asm volatile("" : "+v"(c0));
        float a0[32], a1[32];
#pragma unroll
        for (int i = 0; i < 32; ++i) { a0[i] = 0.f; a1[i] = 0.f; }
#pragma unroll
        for (int ri = 0; ri < 62; ++ri) {
            unsigned w = 0u; if (t0 - 30 + ri >= 0) w = *(const unsigned*)(UG + (size_t)(m0 - 30 + ri) * D + c0);
            const float u0 = bflo(w), u1 = bfhi(w);
#pragma unroll
            for (int ti = 0; ti < 32; ++ti) { const int d = ti + 30 - ri; if (d >= 0 && d <= 30) { a0[ti] += w0[30 - d] * u0; a1[ti] += w1[30 - d] * u1; } }
            if ((ri & 7) == 7) asm volatile("" ::: "memory");
        }
        const f32x2 bb = *(const f32x2*)(cb + c0);
        __syncthreads();
#pragma unroll
        for (int ti = 0; ti < 32; ++ti) {
            a0[ti] += bb.x; a1[ti] += bb.y;
            const float s = wave_sum(a0[ti] + a1[ti]), q = wave_sum(a0[ti] * a0[ti] + a1[ti] * a1[ti]);
            if (C.lane == 0) { red[C.wave * 64 + ti] = s; red[C.wave * 64 + 32 + ti] = q; }
        }
        __syncthreads();
        if (C.tid < 32) { float s = 0.f, q = 0.f;
#pragma unroll
            for (int w = 0; w < 8; ++w) { s += red[w * 64 + C.tid]; q += red[w * 64 + 32 + C.tid]; }
            const float mean = s * (1.f / D), var = fmaxf(q * (1.f / D) - mean * mean, 0.f); stat[C.tid] = mean; stat[32 + C.tid] = 1.f / sqrtf(var + EPS); }
        __syncthreads();
        const f32x2 gg = *(const f32x2*)(lng + c0), be = *(const f32x2*)(lnb + c0);
#pragma unroll
        for (int ti = 0; ti < 32; ++ti) { const float mean = stat[ti], rstd = stat[32 + ti];
            const float y0 = (a0[ti] - mean) * rstd * gg.x + be.x, y1 = (a1[ti] - mean) * rstd * gg.y + be.y;
            *(unsigned*)(AC + (size_t)(m0 + ti) * D + c0) = pk2(y0 * sigm(y0), y1 * sigm(y1)); }
        asm volatile("" ::: "memory");
        const int g = C.tid >> 7;
        if (g == 0) pool_item<2>(ZP, PL, m0, t0, c0); else if (g == 1) pool_item<4>(ZP, PL, m0, t0, c0); else if (g == 2) pool_item<8>(ZP, PL, m0, t0, c0); else pool_item<16>(ZP, PL, m0, t0, c0);
    }
}

typedef unsigned u32;
template <int CTRL> __device__ __forceinline__ u32 dppu(u32 x) { return (u32)__builtin_amdgcn_update_dpp(0, (int)x, CTRL, 0xf, 0xf, true); }
constexpr int DPP_XOR1 = 0xB1, DPP_REV4 = 0x1B, DPP_DUPE = 0xA0, DPP_DUPO = 0xF5, DPP_HMIRROR = 0x141, DPP_MIRROR = 0x140;
__device__ __forceinline__ u32 umax_(u32 a, u32 b) { return a > b ? a : b; }
__device__ __forceinline__ u32 umin_(u32 a, u32 b) { return a < b ? a : b; }
#define TK_CE(x, i, j) do { const u32 hi_ = umax_(x[i], x[j]), lo_ = umin_(x[i], x[j]); x[i] = hi_; x[j] = lo_; } while (0)
__device__ __forceinline__ void tk_local_merge(u32 (&x)[8]) {
    TK_CE(x, 0, 4); TK_CE(x, 1, 5); TK_CE(x, 2, 6); TK_CE(x, 3, 7);
    TK_CE(x, 0, 2); TK_CE(x, 1, 3); TK_CE(x, 4, 6); TK_CE(x, 5, 7);
    TK_CE(x, 0, 1); TK_CE(x, 2, 3); TK_CE(x, 4, 5); TK_CE(x, 6, 7);
}
template <int CTRL> __device__ __forceinline__ void tk_level(u32 (&x)[8], bool even) {
    u32 t[8];
#pragma unroll
    for (int c = 0; c < 8; ++c) t[c] = dppu<CTRL>(x[7 - c]);
#pragma unroll
    for (int c = 0; c < 8; ++c) x[c] = umax_(x[c], t[c]);
#pragma unroll
    for (int c = 0; c < 8; ++c) { const u32 p = dppu<DPP_XOR1>(x[c]); x[c] = even ? umax_(x[c], p) : umin_(x[c], p); }
    tk_local_merge(x);
}
__device__ __forceinline__ void tk_top16(u32 (&x)[8], bool even) {
    TK_CE(x, 0, 1); TK_CE(x, 2, 3); TK_CE(x, 4, 5); TK_CE(x, 6, 7);
    TK_CE(x, 0, 2); TK_CE(x, 1, 3); TK_CE(x, 4, 6); TK_CE(x, 5, 7);
    TK_CE(x, 1, 2); TK_CE(x, 5, 6);
    TK_CE(x, 0, 4); TK_CE(x, 1, 5); TK_CE(x, 2, 6); TK_CE(x, 3, 7);
    TK_CE(x, 2, 4); TK_CE(x, 3, 5);
    TK_CE(x, 1, 2); TK_CE(x, 3, 4); TK_CE(x, 5, 6);
    { u32 t[8];
#pragma unroll
      for (int c = 0; c < 8; ++c) t[c] = dppu<DPP_XOR1>(x[7 - c]);
#pragma unroll
      for (int c = 0; c < 8; ++c) x[c] = even ? umax_(x[c], t[c]) : umin_(x[c], t[c]); }
    tk_local_merge(x);
    tk_level<DPP_REV4>(x, even); tk_level<DPP_HMIRROR>(x, even); tk_level<DPP_MIRROR>(x, even);
}
__device__ __forceinline__ u32 tk_f2key(float v, int slot) { const u32 u = __builtin_bit_cast(u32, v); const u32 k = u ^ ((u32)((int)u >> 31) | 0x80000000u); return (k & ~127u) | (u32)(127 - slot); }
__device__ __forceinline__ float tk_key2f(u32 k) { k &= ~127u; const u32 m = (u32)((int)k >> 31); return __builtin_bit_cast(float, k ^ (~m | 0x80000000u)); }
__device__ __forceinline__ u32 tk_sel8v(u32 r0, u32 r1, u32 r2, u32 r3, u32 r4, u32 r5, u32 r6, u32 r7, int idx) {
    const bool b0 = idx & 1, b1 = idx & 2, b2 = idx & 4;
    const u32 s01 = b0 ? r1 : r0, s23 = b0 ? r3 : r2, s45 = b0 ? r5 : r4, s67 = b0 ? r7 : r6;
    const u32 s03 = b1 ? s23 : s01, s47 = b1 ? s67 : s45;
    return b2 ? s47 : s03; }
#define tk_sel8(r, idx) tk_sel8v(r[0], r[1], r[2], r[3], r[4], r[5], r[6], r[7], idx)
__device__ __forceinline__ void phase_topk(const Ctx& C, const Args& a) {
    const float* S = (const float*)(a.ws + WS_S); int* EID = (int*)(a.ws + WS_EID); float* GW = (float*)(a.ws + WS_GW);
    const int lane = C.lane, r = lane & 15, q = lane >> 4; const bool even = (lane & 1) == 0;
    for (int it = C.gw; it < M * NHEAD / 4; it += C.ngw) {
        const int pair = it * 4 + q, tok = pair >> 3, h = pair & 7;
        u32 xa[8], xb[8];
        { const float* sp = S + (size_t)tok * DQ + h * 256 + 8 * r; const f32x4 v0 = *(const f32x4*)sp, v1 = *(const f32x4*)(sp + 4), w0 = *(const f32x4*)(sp + 128), w1 = *(const f32x4*)(sp + 132);
#pragma unroll
          for (int c = 0; c < 4; ++c) { xa[c] = tk_f2key(v0[c], 8 * r + c); xa[4 + c] = tk_f2key(v1[c], 8 * r + 4 + c); xb[c] = tk_f2key(w0[c], 8 * r + c); xb[4 + c] = tk_f2key(w1[c], 8 * r + 4 + c); } }
        tk_top16(xa, even); tk_top16(xb, even);
        u32 La[8], Ha[8], Lb[8], Hb[8];
#pragma unroll
        for (int c = 0; c < 8; ++c) { La[c] = dppu<DPP_DUPE>(xa[c]); Ha[c] = dppu<DPP_DUPO>(xa[c]); Lb[c] = dppu<DPP_DUPE>(xb[c]); Hb[c] = dppu<DPP_DUPO>(xb[c]); }
        const u32 a_lane = (r < 8) ? tk_sel8(La, r & 7) : tk_sel8(Ha, r & 7), b_lane = (r < 8) ? tk_sel8(Lb, r & 7) : tk_sel8(Hb, r & 7);
        const float va = tk_key2f(a_lane), vbl = tk_key2f(b_lane), va0 = tk_key2f(La[0]);
        u32 ck[8];
#pragma unroll
        for (int j = 0; j < 8; ++j) { constexpr int lim[8] = {15, 7, 4, 3, 2, 1, 1, 1};
            float v = va + tk_key2f(Lb[j]); bool valid = r <= lim[j];
            if (j == 1) { v = (r >= 8) ? va0 + vbl : v; valid = valid || (r >= 8); }
            ck[j] = valid ? tk_f2key(v, 8 * r + j) : 0u; }
        tk_top16(ck, even);
        const float mx = tk_key2f(dppu<DPP_DUPE>(ck[0]));
        float ex[8], sum = 0.f;
#pragma unroll
        for (int c = 0; c < 8; ++c) { ex[c] = __expf(tk_key2f(ck[c]) - mx); sum += ex[c]; }
        sum += __builtin_bit_cast(float, dppu<DPP_XOR1>(__builtin_bit_cast(u32, sum)));
        const float inv = 1.f / sum;
        int eo[8]; float go[8];
#pragma unroll
        for (int c = 0; c < 8; ++c) { const int slot = 127 - (int)(ck[c] & 127u), i = slot >> 3, j = slot & 7; const bool sp = (j == 1) && (i >= 8);
            const int i2 = sp ? 0 : i, j2 = sp ? i : j;
            const u32 ka = (u32)__builtin_amdgcn_ds_bpermute(((lane & ~15) + i2) << 2, (int)a_lane), kb = (u32)__builtin_amdgcn_ds_bpermute(((lane & ~15) + j2) << 2, (int)b_lane);
            eo[c] = (127 - (int)(ka & 127u)) * 128 + (127 - (int)(kb & 127u)); go[c] = ex[c] * inv; }
        if (r < 2) { int* ep = EID + (size_t)tok * 128 + h * 16 + r * 8; float* gp = GW + (size_t)tok * 128 + h * 16 + r * 8;
            *(u32x4*)ep = (u32x4){(u32)eo[0], (u32)eo[1], (u32)eo[2], (u32)eo[3]}; *(u32x4*)(ep + 4) = (u32x4){(u32)eo[4], (u32)eo[5], (u32)eo[6], (u32)eo[7]};
            *(f32x4*)gp = (f32x4){go[0], go[1], go[2], go[3]}; *(f32x4*)(gp + 4) = (f32x4){go[4], go[5], go[6], go[7]}; }
    }
}

__device__ __forceinline__ float dpp_sum63(float v) {
#define DPPF(x, ctrl, rm, bc) __builtin_bit_cast(float, __builtin_amdgcn_update_dpp(0, __builtin_bit_cast(int, x), ctrl, rm, 0xf, bc))
    v += DPPF(v, 0x111, 0xf, true); v += DPPF(v, 0x112, 0xf, true); v += DPPF(v, 0x114, 0xf, true); v += DPPF(v, 0x118, 0xf, true);
    v += DPPF(v, 0x142, 0xa, false); v += DPPF(v, 0x143, 0xc, false);
#undef DPPF
    return v;
}
__device__ __forceinline__ float dot2bf(unsigned w, unsigned x, float acc) { return __builtin_amdgcn_fdot2_f32_bf16(__builtin_bit_cast(bf16x2_t, w), __builtin_bit_cast(bf16x2_t, x), acc, false); }
constexpr int PNB = 8;
__device__ __forceinline__ void peer_load(u32x4 (&buf)[PNB], __amdgpu_buffer_rsrc_t T, int ev0, int ev1, int k0, int lane) {
    const int evs = (k0 < 64) ? ev0 : ev1;
#pragma unroll
    for (int i = 0; i < PNB; ++i) { const int e = __builtin_amdgcn_readlane(evs, (k0 & 63) + i); buf[i] = __builtin_bit_cast(u32x4, __builtin_amdgcn_raw_buffer_load_b128(T, 16 * lane, e * D, 0)); }
}
__device__ __forceinline__ void phase_peer(const Ctx& C, const Args& a, int l) {
    const __amdgpu_buffer_rsrc_t UB = __builtin_amdgcn_make_buffer_rsrc(a.ws + WS_UB + (size_t)l * NEXP * D, 0, NEXP * D, 0x00020000);
    const __amdgpu_buffer_rsrc_t VB = __builtin_amdgcn_make_buffer_rsrc(a.ws + WS_VB + (size_t)l * NEXP * D, 0, NEXP * D, 0x00020000);
    const float* USC = (const float*)(a.ws + WS_USC) + (size_t)l * NEXP; const float* VSC = (const float*)(a.ws + WS_VSC) + (size_t)l * NEXP;
    const int* EID = (const int*)(a.ws + WS_EID); const float* GW = (const float*)(a.ws + WS_GW);
    float* XW = a.out; bf16* H = (bf16*)(a.ws + WS_H);
    for (int m = C.gw; m < M; m += C.ngw) {
        int lane = C.lane; asm volatile("" : "+v"(lane));
        const int b = m >> 13; f32x4 x[4], h[4];
        const int ev0 = EID[(size_t)m * 128 + lane], ev1 = EID[(size_t)m * 128 + 64 + lane];
        const float gwv0 = GW[(size_t)m * 128 + lane], gwv1 = GW[(size_t)m * 128 + 64 + lane];
        const float su0 = USC[ev0], su1 = USC[ev1], sv0 = VSC[ev0], sv1 = VSC[ev1];
#pragma unroll
        for (int q = 0; q < 4; ++q) x[q] = *(const f32x4*)(XW + (size_t)m * D + 16 * lane + 4 * q);
        { float ss = 0.f;
#pragma unroll
          for (int q = 0; q < 4; ++q) ss += (x[q].x * x[q].x + x[q].y * x[q].y) + (x[q].z * x[q].z + x[q].w * x[q].w);
          const float rstd = 1.f / sqrtf(wave_sum(ss) * (1.f / D) + EPS);
          const float* g = a.in[I_N2G] + (size_t)l * D; const float* sh = modp(a, l, b, 3); const float* sc = modp(a, l, b, 4);
#pragma unroll
          for (int q = 0; q < 4; ++q) { const int c = 16 * lane + 4 * q; h[q] = (x[q] * rstd) * *(const f32x4*)(g + c) * (*(const f32x4*)(sc + c) + 1.f) + *(const f32x4*)(sh + c); } }
        float dv0 = 0.f, dv1 = 0.f;
        u32x4 A[PNB], Bf[PNB];
#define PEER_DOT(buf, kbase) do { _Pragma("unroll") for (int i = 0; i < PNB; ++i) { float d = 0.f; \
            _Pragma("unroll") for (int q = 0; q < 4; ++q) { const f32x2 lo = __builtin_amdgcn_cvt_pk_f32_fp8((int)buf[i][q], false), hi = __builtin_amdgcn_cvt_pk_f32_fp8((int)buf[i][q], true); \
                d += lo.x * h[q].x; d += lo.y * h[q].y; d += hi.x * h[q].z; d += hi.y * h[q].w; } \
            d = dpp_sum63(d); const float tot = __builtin_bit_cast(float, __builtin_amdgcn_readlane(__builtin_bit_cast(int, d), 63)); const int kk = (kbase) + i; \
            dv0 = (lane == kk) ? tot : dv0; dv1 = (lane + 64 == kk) ? tot : dv1; __builtin_amdgcn_sched_barrier(0); } } while (0)
        peer_load(A, UB, ev0, ev1, 0, lane);
#pragma nounroll
        for (int k = 0; k < 128; k += 2 * PNB) {
            peer_load(Bf, UB, ev0, ev1, k + PNB, lane);
            PEER_DOT(A, k);
            if (k + 2 * PNB < 128) peer_load(A, UB, ev0, ev1, k + 2 * PNB, lane);
            PEER_DOT(Bf, k + PNB);
        }
#undef PEER_DOT
        dv0 *= su0; dv1 *= su1;
        const float cf0 = sv0 * gwv0 * 0.5f * dv0 * (1.f + erff(dv0 * 0.70710678118654752f)), cf1 = sv1 * gwv1 * 0.5f * dv1 * (1.f + erff(dv1 * 0.70710678118654752f));
        f32x4 o[4];
#pragma unroll
        for (int q = 0; q < 4; ++q) o[q] = (f32x4){0.f, 0.f, 0.f, 0.f};
#define PEER_ACC(buf, i, c) do { _Pragma("unroll") for (int q = 0; q < 4; ++q) { const f32x2 lo = __builtin_amdgcn_cvt_pk_f32_fp8((int)buf[i][q], false), hi = __builtin_amdgcn_cvt_pk_f32_fp8((int)buf[i][q], true); \
            o[q].x += c * lo.x; o[q].y += c * lo.y; o[q].z += c * hi.x; o[q].w += c * hi.y; } __builtin_amdgcn_sched_barrier(0); } while (0)
        peer_load(A, VB, ev0, ev1, 0, lane);
#pragma nounroll
        for (int k = 0; k < 128; k += 2 * PNB) {
            peer_load(Bf, VB, ev0, ev1, k + PNB, lane);
            { const int cfs = __builtin_bit_cast(int, k < 64 ? cf0 : cf1);
#pragma unroll
              for (int i = 0; i < PNB; ++i) { const float c = __builtin_bit_cast(float, __builtin_amdgcn_readlane(cfs, (k & 63) + i)); PEER_ACC(A, i, c); } }
            if (k + 2 * PNB < 128) peer_load(A, VB, ev0, ev1, k + 2 * PNB, lane);
            { const int cfs = __builtin_bit_cast(int, k < 64 ? cf0 : cf1);
#pragma unroll
              for (int i = 0; i < PNB; ++i) { const float c = __builtin_bit_cast(float, __builtin_amdgcn_readlane(cfs, (k & 63) + PNB + i)); PEER_ACC(Bf, i, c); } }
        }
#undef PEER_ACC
        asm volatile("" : "+v"(lane));
        const float* g2 = modp(a, l, b, 5);
#pragma unroll
        for (int q = 0; q < 4; ++q) x[q] = *(const f32x4*)(XW + (size_t)m * D + 16 * lane + 4 * q) + *(const f32x4*)(g2 + 16 * lane + 4 * q) * o[q];
        float ss = 0.f;
#pragma unroll
        for (int q = 0; q < 4; ++q) ss += (x[q].x * x[q].x + x[q].y * x[q].y) + (x[q].z * x[q].z + x[q].w * x[q].w);
        const float rstd = 1.f / sqrtf(wave_sum(ss) * (1.f / D) + EPS);
        if (l + 1 < DEPTH) {
            const float* g = a.in[I_N1G] + (size_t)(l + 1) * D; const float* sh = modp(a, l + 1, b, 0); const float* sc = modp(a, l + 1, b, 1);
            f32x4 hv[4];
#pragma unroll
            for (int q = 0; q < 4; ++q) { const int c = 16 * lane + 4 * q; *(f32x4*)(XW + (size_t)m * D + c) = x[q];
                hv[q] = (x[q] * rstd) * *(const f32x4*)(g + c) * (*(const f32x4*)(sc + c) + 1.f) + *(const f32x4*)(sh + c); }
            *(u32x4*)(H + (size_t)m * D + 16 * lane) = pack8(hv[0], hv[1]); *(u32x4*)(H + (size_t)m * D + 16 * lane + 8) = pack8(hv[2], hv[3]);
        } else {
#pragma unroll
            for (int q = 0; q < 4; ++q) { const int c = 16 * lane + 4 * q; *(f32x4*)(a.out + (size_t)m * D + c) = x[q] * rstd * *(const f32x4*)(a.in[I_FG] + c); }
        }
    }
}

#ifndef USE_NAIVE
#define GEMM mfma_gemm
#else
#define GEMM naive_gemm
#endif
#define RLX_AGENT __ATOMIC_RELAXED, __HIP_MEMORY_SCOPE_AGENT
#define XB_TMO      128
#define XB_XCNT(j)  (256  + 64 * (j))
#define XB_XSUB(j)  (1280 + 64 * (j))
#define XB_XGEN(j)  (2304 + 64 * (j))
#define XB_TOP      3328
#define XB_TOPGEN   3392
#define XCD_BAR_WORDS 3456
#define XB_SPIN_CAP (1u << 18)

__device__ __forceinline__ unsigned xb_ld(unsigned* p)              { return __hip_atomic_load(p, __ATOMIC_RELAXED, __HIP_MEMORY_SCOPE_AGENT); }
__device__ __forceinline__ unsigned xb_add(unsigned* p, unsigned v) { return __hip_atomic_fetch_add(p, v, __ATOMIC_RELAXED, __HIP_MEMORY_SCOPE_AGENT); }
__device__ __forceinline__ unsigned xb_xcc_id() { return (unsigned)__builtin_amdgcn_s_getreg((3 << 11) | 20) & 0xFu; }
#define XB_SPIN(cond, bar) do { unsigned _sp = 0; while (cond) { __builtin_amdgcn_s_sleep(1); \
    if ((++_sp & 255u) == 0u) { if (xb_ld(&(bar)[XB_TMO])) break; if (_sp > XB_SPIN_CAP) { atomicAdd(&(bar)[XB_TMO], 1u); break; } } } } while (0)

struct XcdBarrier {
    unsigned* bar; unsigned x;
    volatile LAS unsigned* st;
};

__device__ __forceinline__ XcdBarrier xcd_barrier_post(unsigned* bar, volatile LAS unsigned* st) {
    XcdBarrier b; b.bar = bar; b.x = xb_xcc_id(); b.st = st;
    if (threadIdx.x == 0) (void)xb_add(&bar[XB_XCNT(b.x)], 1u);
    return b;
}
__device__ __forceinline__ void xcd_barrier_complete(unsigned* bar, unsigned x, unsigned& nloc, unsigned& nx) {
    const unsigned G = gridDim.x * gridDim.y * gridDim.z;
    unsigned sum, cnt, mine, sp = 0u;
    for (;;) {
        sum = 0u; cnt = 0u; mine = 0u;
#pragma unroll
        for (unsigned j = 0; j < 16; ++j) { const unsigned c = xb_ld(&bar[XB_XCNT(j)]); sum += c; cnt += (c > 0u) ? 1u : 0u; mine = (j == x) ? c : mine; }
        if (sum == G) break;
        __builtin_amdgcn_s_sleep(1);
        if ((++sp & 255u) == 0u) { if (xb_ld(&bar[XB_TMO])) break; if (sp > XB_SPIN_CAP) { atomicAdd(&bar[XB_TMO], 1u); break; } }
    }
    nloc = mine > 0u ? mine : 1u; nx = cnt > 0u ? cnt : 1u;
}

__device__ __forceinline__ void xcd_barrier(const XcdBarrier& b) {
    asm volatile("s_waitcnt vmcnt(0)" ::: "memory");
    __syncthreads();
    if (threadIdx.x == 0) {
        unsigned* bar = b.bar;
        __builtin_amdgcn_s_waitcnt(0);
        unsigned nloc = b.st[0], nx = b.st[1];
        if (nloc == 0u) { xcd_barrier_complete(bar, b.x, nloc, nx); b.st[0] = nloc; b.st[1] = nx; }
        const unsigned old = xb_add(&bar[XB_XSUB(b.x)], 1u);
        const unsigned gen = old / nloc;
        if (old + 1u == (gen + 1u) * nloc) {
            __builtin_amdgcn_fence(__ATOMIC_RELEASE, "agent");
            asm volatile("s_waitcnt vmcnt(0)" ::: "memory");
            const unsigned og = xb_add(&bar[XB_TOP], 1u);
            const unsigned tg = og / nx;
            if (og + 1u == (tg + 1u) * nx) xb_add(&bar[XB_TOPGEN], 1u);
            else XB_SPIN(xb_ld(&bar[XB_TOPGEN]) == tg, bar);
            __builtin_amdgcn_fence(__ATOMIC_ACQUIRE, "agent");
            xb_add(&bar[XB_XGEN(b.x)], 1u);
            asm volatile("s_waitcnt vmcnt(0)" ::: "memory");
        } else {
            XB_SPIN(xb_ld(&bar[XB_XGEN(b.x)]) == gen, bar);
            __builtin_amdgcn_fence(__ATOMIC_ACQUIRE, "agent");
            asm volatile("s_waitcnt vmcnt(0)" ::: "memory");
        }
    }
    __syncthreads();
}

constexpr int CW_BAR = 4096;
constexpr size_t CTL_ZERO_BYTES = 65536;
constexpr int LDSCTL_OFF = 131072, MISC_OFF = LDSCTL_OFF + 320;
constexpr int PH_PREP = 0, PH_MODR = 1, PH_N1 = 2, PH_L0 = 3, PH_PER_LAYER = 10, N_PHASES = PH_L0 + DEPTH * PH_PER_LAYER;
__device__ __forceinline__ Ctx make_ctx(LAS unsigned char* lds, int wave_s) {
    int tid_ = (wave_s << 6) | (int)__builtin_amdgcn_mbcnt_hi(~0u, __builtin_amdgcn_mbcnt_lo(~0u, 0u)); asm volatile("" : "+v"(tid_));
    Ctx C; C.tid = tid_; C.lane = C.tid & 63; C.wave = __builtin_amdgcn_readfirstlane(C.tid >> 6); C.nblk = gridDim.x; C.blk = blockIdx.x;
    C.gw = C.blk * NWAVES + C.wave; C.ngw = C.nblk * NWAVES; C.lds = lds; return C;
}
#ifndef ONLYPH
#define ONLYPH -1
#endif
constexpr unsigned long long REP_MASK = 0ull;
#define PH(k, ...) if ((ONLYPH < 0 || ONLYPH == (k)) && a.ph_lo <= (k) && (k) < a.ph_hi) { for (int r_ = 0; r_ < 1 + (int)((REP_MASK >> (k)) & 1ull); ++r_) { const Ctx C = make_ctx(lds, wave_s); __VA_ARGS__; } if ((k) + 1 < a.ph_hi) xcd_barrier(bar); }
template <int l>
__device__ __forceinline__ void run_layer(const Args& a, LAS unsigned char* lds, const XcdBarrier& bar, const int wave_s) {
    unsigned char* ws = a.ws; constexpr int B0 = PH_L0 + l * PH_PER_LAYER;
    PH(B0 + 0, EpiIn E{a.in[I_BIN] + (size_t)l * DIN, (bf16*)(ws + WS_UG), (bf16*)(ws + WS_ZP), (bf16*)(ws + WS_G)};
               GEMM(C, (const bf16*)(ws + WS_H), D, 0, (const bf16*)(ws + WS_WIN) + (size_t)l * DIN * D, D, M, DIN, D, E))
    PH(B0 + 1, phase_convpool(C, a, l))
    PH(B0 + 2, EpiPool E{(const bf16*)(ws + WS_G), a.in[I_POOLS] + (size_t)l * D, (bf16*)(ws + WS_TMP)};
               GEMM(C, (const bf16*)(ws + WS_PL), D, 256, (const bf16*)(ws + WS_POOL) + (size_t)l * 1024 * 256, 256, M, D, 256, E))
    PH(B0 + 3, EpiConv E{(const bf16*)(ws + WS_G), (const bf16*)(ws + WS_TMP), (bf16*)(ws + WS_Y)};
               GEMM(C, (const bf16*)(ws + WS_AC), D, 0, (const bf16*)(ws + WS_WCO) + (size_t)l * D * D, D, M, D, D, E))
    PH(B0 + 4, EpiOut E{l == 0 ? a.in[I_X] : a.out, a.out, modp(a, l, 0, 2), a.in[I_BOUT] + (size_t)l * D};
               GEMM(C, (const bf16*)(ws + WS_Y), D, 0, (const bf16*)(ws + WS_WOUT) + (size_t)l * D * D, D, M, D, D, E))
    PH(B0 + 5, phase_norm(C, a, a.out, a.in[I_N2G] + (size_t)l * D, l, 3, 4))
    PH(B0 + 6, EpiQ E{(bf16*)(ws + WS_Q)}; GEMM(C, (const bf16*)(ws + WS_H), D, 0, (const bf16*)(ws + WS_WQ) + (size_t)l * DQ * D, D, M, DQ, D, E))
    PH(B0 + 7, EpiS E{(float*)(ws + WS_S)}; GEMM(C, (const bf16*)(ws + WS_Q), DQ, 256, (const bf16*)(ws + WS_KEYS) + (size_t)l * 2048 * 256, 256, M, DQ, 256, E))
    PH(B0 + 8, phase_topk(C, a))
    PH(B0 + 9, phase_peer(C, a, l))
}
__global__ void __launch_bounds__(NTHREADS, 2) fwd_kernel(Args a) {
    extern __shared__ __attribute__((aligned(16))) unsigned char lds_raw[];
    LAS unsigned char* lds = (LAS unsigned char*)lds_raw;
    for (int u = threadIdx.x; u < (LDS_BYTES - LDSCTL_OFF) / 4; u += NTHREADS) ((LAS unsigned*)(lds + LDSCTL_OFF))[u] = 0u;
    __syncthreads();
    const int wave_s = __builtin_amdgcn_readfirstlane((int)threadIdx.x >> 6);
    const XcdBarrier bar = xcd_barrier_post((unsigned*)(a.ws + WS_CTL) + CW_BAR, (volatile LAS unsigned*)(lds + MISC_OFF) + 8);
    PH(PH_PREP, phase_prep(C, a))
    PH(PH_MODR, phase_modreduce(C, a))
    PH(PH_N1, phase_norm(C, a, a.in[I_X], a.in[I_N1G], 0, 0, 1))
    run_layer<0>(a, lds, bar, wave_s);
    run_layer<1>(a, lds, bar, wave_s);
}

extern "C" void kernel_launch(void* const* d_in, const int* in_sizes, int n_in, void* d_out, int out_size, void* d_ws, size_t ws_size, hipStream_t stream) {
    static int grid = 0;
    if (grid == 0) {
        if (n_in != 22 || out_size != M * D || ws_size < WS_END) { fprintf(stderr, "kernel_launch: unexpected shapes (n_in %d out %d ws %zu)\n", n_in, out_size, ws_size); grid = -1; return; }
        int dev = 0, cus = 0;
        if (hipGetDevice(&dev) != hipSuccess || hipDeviceGetAttribute(&cus, hipDeviceAttributeMultiprocessorCount, dev) != hipSuccess) { grid = -1; return; }
        if (hipFuncSetAttribute((const void*)fwd_kernel, hipFuncAttributeMaxDynamicSharedMemorySize, LDS_BYTES) != hipSuccess) { grid = -1; return; }
        grid = cus;
    }
    if (grid < 0) return;
    Args a{};
    for (int i = 0; i < 22; ++i) a.in[i] = (const float*)d_in[i];
    a.out = (float*)d_out; a.ws = (unsigned char*)d_ws;
    (void)hipMemsetAsync((char*)d_ws + WS_CTL, 0, CTL_ZERO_BYTES, stream);
#ifndef ONE_LAUNCH
    for (int ph = 0; ph < N_PHASES; ++ph) { a.ph_lo = ph; a.ph_hi = ph + 1; hipLaunchKernelGGL(fwd_kernel, dim3(grid), dim3(NTHREADS), LDS_BYTES, stream, a); }
#else
    a.ph_lo = 0; a.ph_hi = N_PHASES; hipLaunchKernelGGL(fwd_kernel, dim3(grid), dim3(NTHREADS), LDS_BYTES, stream, a);
#endif
}
```

```cpp
#define ONE_LAUNCH 1
#include <hip/hip_runtime.h>
#include <cstdint>
#include <cstdio>
#include <utility>

#define GAS __attribute__((address_space(1)))
#define LAS __attribute__((address_space(3)))
typedef unsigned short bf16;
typedef float f32x4 __attribute__((ext_vector_type(4)));
typedef float f32x2 __attribute__((ext_vector_type(2)));
typedef unsigned u32x4 __attribute__((ext_vector_type(4)));
typedef unsigned u32x2 __attribute__((ext_vector_type(2)));
typedef __bf16 bf16x2_t __attribute__((ext_vector_type(2)));

constexpr int BATCH = 2, SEQ = 8192, D = 1024, M = BATCH * SEQ, DEPTH = 2;
constexpr int DIN = 5120, NMODV = 6 * D, CONVK = 31, NHEAD = 8, NKEYS = 128, DQ = 2048, TOPK = 16, NEXP = 16384;
constexpr float EPS = 1e-6f;
constexpr int NWAVES = 8, NTHREADS = NWAVES * 64;

constexpr size_t MiB = 1u << 20;
constexpr size_t WS_CTL = 0;
constexpr size_t WS_MODP = 1 * MiB;
constexpr size_t WS_MOD = 4 * MiB;
constexpr size_t WS_WIN = 8 * MiB;
constexpr size_t WS_WCO = 28 * MiB;
constexpr size_t WS_WOUT = 32 * MiB;
constexpr size_t WS_WQ = 36 * MiB;
constexpr size_t WS_POOL = 44 * MiB;
constexpr size_t WS_KEYS = 45 * MiB;
constexpr size_t WS_UB = 48 * MiB;
constexpr size_t WS_USC = 80 * MiB;
constexpr size_t WS_VSC = 81 * MiB;
constexpr size_t WS_VB = 112 * MiB;
constexpr size_t WS_H = 176 * MiB;
constexpr size_t WS_UG = 208 * MiB;
constexpr size_t WS_Y = WS_UG;
constexpr size_t WS_ZP = 240 * MiB;
constexpr size_t WS_TMP = WS_ZP;
constexpr size_t WS_Q = WS_UG;
constexpr size_t WS_G = 272 * MiB;
constexpr size_t WS_AC = 336 * MiB;
constexpr size_t WS_PL = 368 * MiB;
constexpr size_t WS_S = WS_G;
constexpr size_t WS_EID = 400 * MiB;
constexpr size_t WS_GW = 408 * MiB;
constexpr size_t WS_END = 416 * MiB;

constexpr int LDS_BYTES = 147456;

__device__ __forceinline__ unsigned f2bf(float f) { unsigned u = __builtin_bit_cast(unsigned, f); return (u + 0x7fffu + ((u >> 16) & 1u)) >> 16; }
__device__ __forceinline__ unsigned pk2(float lo, float hi) { return f2bf(lo) | (f2bf(hi) << 16); }
__device__ __forceinline__ float bflo(unsigned w) { return __builtin_bit_cast(float, w << 16); }
__device__ __forceinline__ float bfhi(unsigned w) { return __builtin_bit_cast(float, w & 0xffff0000u); }
__device__ __forceinline__ float sigm(float x) { return 1.f / (1.f + __expf(-x)); }
__device__ __forceinline__ float wave_sum(float v) {
#pragma unroll
    for (int o = 1; o < 64; o <<= 1) v += __shfl_xor(v, o);
    return v;
}
__device__ __forceinline__ float wave_max(float v) {
#pragma unroll
    for (int o = 1; o < 64; o <<= 1) v = fmaxf(v, __shfl_xor(v, o));
    return v;
}
__device__ __forceinline__ float dpp_sum63(float v) {
#define DPPF(x, ctrl, rm, bc) __builtin_bit_cast(float, __builtin_amdgcn_update_dpp(0, __builtin_bit_cast(int, x), ctrl, rm, 0xf, bc))
    v += DPPF(v, 0x111, 0xf, true); v += DPPF(v, 0x112, 0xf, true); v += DPPF(v, 0x114, 0xf, true); v += DPPF(v, 0x118, 0xf, true);
    v += DPPF(v, 0x142, 0xa, false); v += DPPF(v, 0x143, 0xc, false);
#undef DPPF
    return v;
}
__device__ __forceinline__ u32x4 pack8(const f32x4& a, const f32x4& b) { u32x4 w; w.x = pk2(a.x, a.y); w.y = pk2(a.z, a.w); w.z = pk2(b.x, b.y); w.w = pk2(b.z, b.w); return w; }
__device__ __forceinline__ void unpack8(const u32x4& w, f32x4& a, f32x4& b) { a = (f32x4){bflo(w.x), bfhi(w.x), bflo(w.y), bfhi(w.y)}; b = (f32x4){bflo(w.z), bfhi(w.z), bflo(w.w), bfhi(w.w)}; }

struct Ctx { int tid, lane, wave, gw, ngw, nblk, blk; LAS unsigned char* lds; };

struct Args { const float* in[22]; float* out; unsigned char* ws; int ph_lo, ph_hi; };
enum { I_X = 0, I_C, I_ADAW, I_ADAB, I_N1G, I_WIN, I_BIN, I_CONVW, I_CONVB, I_LNG, I_LNB, I_WCO, I_POOLW, I_POOLS, I_WOUT, I_BOUT, I_N2G, I_WQ, I_KEYS, I_PU, I_PV, I_FG };

__device__ __forceinline__ void transpose_item(const float* W, int K, int N, int k0, int n0, bf16* WT, int dstrow0, LAS float* scr, int lane) {
#pragma unroll 8
    for (int i = 0; i < 32; ++i) { const int kk = 2 * i + (lane >> 5); scr[kk * 33 + (lane & 31)] = W[(size_t)(k0 + kk) * N + n0 + (lane & 31)]; }
    asm volatile("s_waitcnt lgkmcnt(0)" ::: "memory");
    const int c = lane & 7;
#pragma unroll
    for (int j = 0; j < 4; ++j) { const int n = (lane >> 3) + 8 * j; const LAS float* s = scr + (8 * c) * 33 + n;
        u32x4 o; o.x = pk2(s[0 * 33], s[1 * 33]); o.y = pk2(s[2 * 33], s[3 * 33]); o.z = pk2(s[4 * 33], s[5 * 33]); o.w = pk2(s[6 * 33], s[7 * 33]);
        *(u32x4*)(WT + (size_t)(dstrow0 + n) * K + k0 + 8 * c) = o; }
    asm volatile("s_waitcnt lgkmcnt(0)" ::: "memory");
}
__device__ __forceinline__ int win_dstrow(int n0) {
    if (n0 < 1024) return 256 * (n0 >> 7) + (n0 & 127);
    if (n0 < 2048) { const int c = n0 - 1024; return 256 * (c >> 7) + 128 + (c & 127); }
    return n0;
}
__device__ __forceinline__ void phase_prep(const Ctx& C, const Args& a) {
    unsigned char* ws = a.ws;
    LAS float* scr = (LAS float*)(C.lds + C.wave * 16384);
    constexpr int I_IN = 16 * 160, I_CO = 16 * 32, I_PO = 4 * (4 * 8), I_OUT = 16 * 32, I_Q = 16 * 64, I_L = I_IN + I_CO + I_PO + I_OUT + I_Q;
    for (int it = C.gw; it < DEPTH * I_L; it += C.ngw) {
        const int l = it / I_L; int r = it % I_L;
        if (r < I_IN) { const int kb = r / 160, nb = r % 160; transpose_item(a.in[I_WIN] + (size_t)l * D * DIN, D, DIN, 64 * kb, 32 * nb, (bf16*)(ws + WS_WIN) + (size_t)l * DIN * D, win_dstrow(32 * nb), scr, C.lane); continue; } r -= I_IN;
        if (r < I_CO) { const int kb = r / 32, nb = r % 32; transpose_item(a.in[I_WCO] + (size_t)l * D * D, D, D, 64 * kb, 32 * nb, (bf16*)(ws + WS_WCO) + (size_t)l * D * D, 32 * nb, scr, C.lane); continue; } r -= I_CO;
        if (r < I_PO) { const int g = r / 32, q = r % 32, kb = q / 8, nb = q % 8; transpose_item(a.in[I_POOLW] + ((size_t)l * 4 + g) * 256 * 256, 256, 256, 64 * kb, 32 * nb, (bf16*)(ws + WS_POOL) + ((size_t)l * 1024 + 256 * g) * 256, 32 * nb, scr, C.lane); continue; } r -= I_PO;
        if (r < I_OUT) { const int kb = r / 32, nb = r % 32; transpose_item(a.in[I_WOUT] + (size_t)l * D * D, D, D, 64 * kb, 32 * nb, (bf16*)(ws + WS_WOUT) + (size_t)l * D * D, 32 * nb, scr, C.lane); continue; } r -= I_OUT;
        { const int kb = r / 64, nb = r % 64; transpose_item(a.in[I_WQ] + (size_t)l * D * DQ, D, DQ, 64 * kb, 32 * nb, (bf16*)(ws + WS_WQ) + (size_t)l * DQ * D, 32 * nb, scr, C.lane); }
    }
    const int gt = C.blk * NTHREADS + C.tid, ngt = C.nblk * NTHREADS;
    for (int i = gt; i < DEPTH * 2048 * 32; i += ngt) {
        const int l = i / (2048 * 32), r = i % (2048 * 32), n = r / 32, k8 = (r % 32) * 8;
        const int h = n >> 8, p = (n >> 7) & 1, key = n & 127, pk = k8 >> 7, kk = k8 & 127;
        u32x4 o = (u32x4){0u, 0u, 0u, 0u};
        if (pk == p) { const float* s = a.in[I_KEYS] + ((((size_t)l * 8 + h) * 2 + p) * 128 + key) * 128 + kk; const f32x4 v0 = *(const f32x4*)s, v1 = *(const f32x4*)(s + 4); o = pack8(v0, v1); }
        *(u32x4*)((bf16*)(ws + WS_KEYS) + ((size_t)l * 2048 + n) * 256 + k8) = o;
    }
    for (int t = 0; t < 2; ++t) {
        const float* src = a.in[t == 0 ? I_PU : I_PV]; unsigned char* dst = ws + (t == 0 ? WS_UB : WS_VB); float* scl = (float*)(ws + (t == 0 ? WS_USC : WS_VSC));
        for (int row = C.gw; row < DEPTH * NEXP; row += C.ngw) {
            const float* sp = src + (size_t)row * D + 16 * C.lane; f32x4 v[4]; float am = 0.f;
#pragma unroll
            for (int q = 0; q < 4; ++q) { v[q] = *(const f32x4*)(sp + 4 * q); am = fmaxf(am, fmaxf(fmaxf(fabsf(v[q].x), fabsf(v[q].y)), fmaxf(fabsf(v[q].z), fabsf(v[q].w)))); }
            am = wave_max(am);
            const float inv = am > 0.f ? 440.f / am : 0.f; u32x4 w;
#pragma unroll
            for (int q = 0; q < 4; ++q) { int p = __builtin_amdgcn_cvt_pk_fp8_f32(v[q].x * inv, v[q].y * inv, 0, false); p = __builtin_amdgcn_cvt_pk_fp8_f32(v[q].z * inv, v[q].w * inv, p, true); w[q] = (unsigned)p; }
            *(u32x4*)(dst + (size_t)row * D + 16 * C.lane) = w;
            if (C.lane == 0) scl[row] = am * (1.f / 440.f);
        }
    }
    for (int it = gt; it < 32 * 3072; it += ngt) {
        const int ks = it / 3072, cg = it % 3072, l = cg / 1536, n4 = (cg % 1536) * 4;
        f32x4 a0 = (f32x4){0.f, 0.f, 0.f, 0.f}, a1 = a0;
        const float* wp = a.in[I_ADAW] + ((size_t)l * D + ks * 32) * NMODV + n4; const float* c0 = a.in[I_C] + ks * 32; const float* c1 = c0 + D;
#pragma unroll 8
        for (int kk = 0; kk < 32; ++kk) { const f32x4 w = *(const f32x4*)(wp + (size_t)kk * NMODV); const float x0 = c0[kk], x1 = c1[kk]; a0 += w * (x0 * sigm(x0)); a1 += w * (x1 * sigm(x1)); }
        float* mp = (float*)(ws + WS_MODP) + (((size_t)ks * 2 + l) * 2) * NMODV + n4;
        *(f32x4*)mp = a0; *(f32x4*)(mp + NMODV) = a1;
    }
}
__device__ __forceinline__ void phase_modreduce(const Ctx& C, const Args& a) {
    const int gt = C.blk * NTHREADS + C.tid, ngt = C.nblk * NTHREADS;
    for (int i = gt; i < 2 * 2 * NMODV; i += ngt) {
        const int l = i / (2 * NMODV), n = i % NMODV; float s = a.in[I_ADAB][(size_t)l * NMODV + n];
        const float* mp = (const float*)(a.ws + WS_MODP) + i;
        for (int ks = 0; ks < 32; ++ks) s += mp[(size_t)ks * 4 * NMODV];
        ((float*)(a.ws + WS_MOD))[i] = s;
    }
}
__device__ __forceinline__ const float* modp(const Args& a, int l, int b, int v) { return (const float*)(a.ws + WS_MOD) + ((size_t)l * 2 + b) * NMODV + v * D; }

__device__ __forceinline__ void normmod_row(const f32x4 (&x)[4], const float* g, const float* sh, const float* sc, int lane, f32x4 (&h)[4]) {
    float s = 0.f;
#pragma unroll
    for (int j = 0; j < 4; ++j) s += (x[j].x * x[j].x + x[j].y * x[j].y) + (x[j].z * x[j].z + x[j].w * x[j].w);
    const float rstd = 1.f / sqrtf(wave_sum(s) * (1.f / D) + EPS);
#pragma unroll
    for (int j = 0; j < 4; ++j) { const int c = 4 * lane + 256 * j; const f32x4 gv = *(const f32x4*)(g + c), shv = *(const f32x4*)(sh + c), scv = *(const f32x4*)(sc + c);
        h[j] = (x[j] * rstd) * gv * (scv + 1.f) + shv; }
}
__device__ __forceinline__ void store_row_bf16(bf16* row, const f32x4 (&h)[4], int lane) {
#pragma unroll
    for (int j = 0; j < 4; ++j) { u32x2 w; w.x = pk2(h[j].x, h[j].y); w.y = pk2(h[j].z, h[j].w); *(u32x2*)(row + 4 * lane + 256 * j) = w; }
}
__device__ __forceinline__ void phase_norm(const Ctx& C, const Args& a, const float* X, const float* g, int l, int vsh, int vsc) {
    bf16* H = (bf16*)(a.ws + WS_H);
    for (int m = C.gw; m < M; m += C.ngw) {
        const int b = m >> 13; f32x4 x[4], h[4];
#pragma unroll
        for (int j = 0; j < 4; ++j) x[j] = *(const f32x4*)(X + (size_t)m * D + 4 * C.lane + 256 * j);
        normmod_row(x, g, modp(a, l, b, vsh), modp(a, l, b, vsc), C.lane, h);
        store_row_bf16(H + (size_t)m * D, h, C.lane);
    }
}

struct EpiIn {
    const float* bin; bf16 *UG, *ZP, *G;
    __device__ __forceinline__ void apply(int row, int pn, int cl8, f32x4 a0, f32x4 a1, f32x4 b0, f32x4 b1) const {
        if (pn < 8) {
            const int c = 128 * pn + cl8;
            a0 += *(const f32x4*)(bin + c); a1 += *(const f32x4*)(bin + c + 4); b0 += *(const f32x4*)(bin + 1024 + c); b1 += *(const f32x4*)(bin + 1024 + c + 4);
            f32x4 u0, u1;
#pragma unroll
            for (int i = 0; i < 4; ++i) { u0[i] = a0[i] * sigm(b0[i]); u1[i] = a1[i] * sigm(b1[i]); }
            *(u32x4*)(UG + (size_t)row * D + c) = pack8(u0, u1);
        } else if (pn < 12) {
            const int c = 256 * (pn - 8) + cl8;
            a0 += *(const f32x4*)(bin + 2048 + c); a1 += *(const f32x4*)(bin + 2048 + c + 4); b0 += *(const f32x4*)(bin + 2048 + 128 + c); b1 += *(const f32x4*)(bin + 2048 + 128 + c + 4);
            *(u32x4*)(ZP + (size_t)row * D + c) = pack8(a0, a1); *(u32x4*)(ZP + (size_t)row * D + c + 128) = pack8(b0, b1);
        } else {
            const int c = 256 * (pn - 12) + cl8;
            a0 += *(const f32x4*)(bin + 3072 + c); a1 += *(const f32x4*)(bin + 3072 + c + 4); b0 += *(const f32x4*)(bin + 3072 + 128 + c); b1 += *(const f32x4*)(bin + 3072 + 128 + c + 4);
#pragma unroll
            for (int i = 0; i < 4; ++i) { a0[i] = sigm(a0[i]); a1[i] = sigm(a1[i]); b0[i] = sigm(b0[i]); b1[i] = sigm(b1[i]); }
            *(u32x4*)(G + (size_t)row * 2048 + c) = pack8(a0, a1); *(u32x4*)(G + (size_t)row * 2048 + c + 128) = pack8(b0, b1);
        }
    }
};
struct EpiPool {
    const bf16* G; const float* scale; bf16* TMP;
    __device__ __forceinline__ void apply(int row, int pn, int cl8, f32x4 a0, f32x4 a1, f32x4 b0, f32x4 b1) const {
        const int c = 256 * pn + cl8; f32x4 g0, g1;
        unpack8(*(const u32x4*)(G + (size_t)row * 2048 + 1024 + c), g0, g1);
        a0 = a0 * g0 * *(const f32x4*)(scale + c); a1 = a1 * g1 * *(const f32x4*)(scale + c + 4);
        *(u32x4*)(TMP + (size_t)row * D + c) = pack8(a0, a1);
        unpack8(*(const u32x4*)(G + (size_t)row * 2048 + 1024 + c + 128), g0, g1);
        b0 = b0 * g0 * *(const f32x4*)(scale + c + 128); b1 = b1 * g1 * *(const f32x4*)(scale + c + 132);
        *(u32x4*)(TMP + (size_t)row * D + c + 128) = pack8(b0, b1);
    }
};
struct EpiConv {
    const bf16* G; const bf16* TMP; bf16* Y;
    __device__ __forceinline__ void apply(int row, int pn, int cl8, f32x4 a0, f32x4 a1, f32x4 b0, f32x4 b1) const {
        const int c = 256 * pn + cl8; f32x4 g0, g1, t0, t1;
        unpack8(*(const u32x4*)(G + (size_t)row * 2048 + c), g0, g1); unpack8(*(const u32x4*)(TMP + (size_t)row * D + c), t0, t1);
        *(u32x4*)(Y + (size_t)row * D + c) = pack8(a0 * g0 + t0, a1 * g1 + t1);
        unpack8(*(const u32x4*)(G + (size_t)row * 2048 + c + 128), g0, g1); unpack8(*(const u32x4*)(TMP + (size_t)row * D + c + 128), t0, t1);
        *(u32x4*)(Y + (size_t)row * D + c + 128) = pack8(b0 * g0 + t0, b1 * g1 + t1);
    }
};
struct EpiOut {
    const float* xold; float* xnew; const float* g1;   const float* bout;
    __device__ __forceinline__ void apply(int row, int pn, int cl8, f32x4 a0, f32x4 a1, f32x4 b0, f32x4 b1) const {
        const int c = 256 * pn + cl8; const float* g = g1 + (size_t)(row >> 13) * NMODV; const size_t o = (size_t)row * D + c;
        *(f32x4*)(xnew + o) = *(const f32x4*)(xold + o) + *(const f32x4*)(g + c) * (a0 + *(const f32x4*)(bout + c));
        *(f32x4*)(xnew + o + 4) = *(const f32x4*)(xold + o + 4) + *(const f32x4*)(g + c + 4) * (a1 + *(const f32x4*)(bout + c + 4));
        *(f32x4*)(xnew + o + 128) = *(const f32x4*)(xold + o + 128) + *(const f32x4*)(g + c + 128) * (b0 + *(const f32x4*)(bout + c + 128));
        *(f32x4*)(xnew + o + 132) = *(const f32x4*)(xold + o + 132) + *(const f32x4*)(g + c + 132) * (b1 + *(const f32x4*)(bout + c + 132));
    }
};
struct EpiQ {
    bf16* Q;
    __device__ __forceinline__ void apply(int row, int pn, int cl8, f32x4 a0, f32x4 a1, f32x4 b0, f32x4 b1) const {
        const size_t o = (size_t)row * DQ + 256 * pn + cl8; *(u32x4*)(Q + o) = pack8(a0, a1); *(u32x4*)(Q + o + 128) = pack8(b0, b1);
    }
};
struct EpiS {
    float* S;
    __device__ __forceinline__ void apply(int row, int pn, int cl8, f32x4 a0, f32x4 a1, f32x4 b0, f32x4 b1) const {
        const size_t o = (size_t)row * DQ + 256 * pn + cl8; *(f32x4*)(S + o) = a0; *(f32x4*)(S + o + 4) = a1; *(f32x4*)(S + o + 128) = b0; *(f32x4*)(S + o + 132) = b1;
    }
};

namespace pg8 {
#define PG8_LAS __attribute__((address_space(3)))
typedef unsigned short bf16_t;
typedef short bf16x8 __attribute__((ext_vector_type(8)));
typedef float f32x4 __attribute__((ext_vector_type(4)));
typedef unsigned u32x4 __attribute__((ext_vector_type(4)));
constexpr int BM = 256, BK = 64, HALF = 128, HTB = HALF * BK * 2  , STAGE_BYTES = 8 * HTB, NXCD = 8, WGM = 8;

__host__ __device__ __forceinline__ int lds_byte(int r, int c) { const int st = (r >> 4) * 2 + (c >> 5), rr = r & 15, cc = c & 31, ob = rr * 64 + cc * 2; return st * 1024 + (ob ^ (((ob >> 9) & 1) << 5)); }
__host__ __device__ __forceinline__ void stage_rc(int b, int& R, int& C) { const int st = b / 1024, sb = b % 1024, swz = sb ^ (((sb >> 9) & 1) << 5); R = (st >> 1) * 16 + swz / 64; C = (st & 1) * 32 + (swz % 64) / 2; }
__host__ __device__ __forceinline__ int perm32(int rho) { const int n = rho >> 4, i = rho & 15; return 8 * (i >> 2) + 4 * n + (i & 3); }

struct Unit { int pm, pn; };
struct Gemm { const bf16_t* A; const bf16_t* Bt; int M, N, K, lda, ldb, acol; };

struct StaticOrder {
    int nM, nN, nwg, G, c;
    __host__ __device__ void init(int M, int N, int G_, int c_) { nM = M / BM; nN = N / BM; nwg = nM * nN; G = G_; c = c_; }
    __host__ __device__ bool next(int i, Unit& u) const {
        const long L = (long)i * G + c; if (L >= nwg) return false;
        int wgid = (int)L; { const int q = nwg / NXCD, r = nwg % NXCD, xcd = wgid % NXCD, off = wgid / NXCD; wgid = (xcd < r ? xcd * (q + 1) : r * (q + 1) + (xcd - r) * q) + off; }
        const int nig = WGM * nN, gid = wgid / nig, fm = gid * WGM, gsz = (nM - fm) < WGM ? (nM - fm) : WGM;
        u.pm = fm + ((wgid % nig) % gsz); u.pn = (wgid % nig) / gsz; return true;
    }
    __device__ __forceinline__ void a_ready(const Unit&) const {}
    __device__ __forceinline__ void done(const Unit&) const {}
};


template <class Epi, class Sched, bool ALIGN_EPI = false, bool SP2 = false>
__device__ __forceinline__ void gemm_phase(PG8_LAS unsigned char* lds, const Gemm g, const Sched& S, const Epi& E) {
    const int tid = threadIdx.x, wid = __builtin_amdgcn_readfirstlane(tid >> 6), lane = tid & 63, wr = wid >> 2, wc = wid & 3, fr = lane & 15, fq = lane >> 4;
    const int K = g.K, nt = K / BK;
    unsigned voffA[2], voffB[2];
#pragma unroll
    for (int i = 0; i < 2; ++i) { int R, C; stage_rc(tid * 16 + i * 8192, R, C); const int Rb = Epi::PERM ? ((R & ~31) + perm32(R & 31)) : R;
        voffA[i] = (unsigned)(R * g.lda + C) * 2u; voffB[i] = (unsigned)(Rb * g.ldb + C) * 2u; }
    const size_t kstep = (size_t)(BK * 2);
    const size_t hstepA = (size_t)HALF * g.lda * 2, hstepB = (size_t)HALF * g.ldb * 2;
    const size_t tstepA = 2 * hstepA, tstepB = 2 * hstepB, acolb = (size_t)g.acol * 2;
    const unsigned ldsw = (unsigned)wid * 1024u;
    const int aoff = lds_byte(wr * 64 + fr, fq * 8), boff = lds_byte(wc * 32 + fr, fq * 8);
#define PG8_SA(b, h) (((b) * 2 + (h)) * HTB)
#define PG8_SB(b, h) ((4 + (b) * 2 + (h)) * HTB)
#define PG8_STAGE(bufoff, gbase, voff) do { _Pragma("unroll") for (int _i = 0; _i < 2; ++_i) \
        __builtin_amdgcn_global_load_lds((const unsigned*)((const char*)(gbase) + (voff)[_i]), (PG8_LAS unsigned*)(lds + (bufoff) + ldsw + _i * 8192), 16, 0, 0); } while (0)
#define PG8_LDA(dst, b, h) do { _Pragma("unroll") for (int m = 0; m < 4; ++m) _Pragma("unroll") for (int k = 0; k < 2; ++k) dst[m][k] = *(const PG8_LAS bf16x8*)(lds + PG8_SA(b, h) + aoff + m * 2048 + k * 1024); } while (0)
#define PG8_LDB(dst, b, h) do { _Pragma("unroll") for (int n = 0; n < 2; ++n) _Pragma("unroll") for (int k = 0; k < 2; ++k) dst[n][k] = *(const PG8_LAS bf16x8*)(lds + PG8_SB(b, h) + boff + n * 2048 + k * 1024); } while (0)
#define PG8_MMA(ai, bj, At, Bt) do { __builtin_amdgcn_s_setprio(1); _Pragma("unroll") for (int m = 0; m < 4; ++m) _Pragma("unroll") for (int n = 0; n < 2; ++n) _Pragma("unroll") for (int k = 0; k < 2; ++k) \
        acc[ai][bj][m][n] = __builtin_amdgcn_mfma_f32_16x16x32_bf16(Bt[n][k], At[m][k], acc[ai][bj][m][n], 0, 0, 0); __builtin_amdgcn_s_setprio(0); } while (0)
#define PG8_WAIT_V(n) asm volatile("s_waitcnt vmcnt(" #n ")" ::: "memory")
#define PG8_WAIT_L(n) asm volatile("s_waitcnt lgkmcnt(" #n ")" ::: "memory")
#define PG8_BAR __builtin_amdgcn_s_barrier()
#define PG8_SCHED __builtin_amdgcn_sched_barrier(0)
    Unit cur, nxt; int ui = 0;
    if (!S.next(0, cur)) return;
    f32x4 acc[2][2][4][2];
#pragma unroll
    for (int a = 0; a < 2; ++a)
#pragma unroll
        for (int b = 0; b < 2; ++b)
#pragma unroll
            for (int m = 0; m < 4; ++m)
#pragma unroll
                for (int n = 0; n < 2; ++n) acc[a][b][m][n] = (f32x4){0.f, 0.f, 0.f, 0.f};
    bf16x8 At[4][2], B0[2][2], B1[2][2];
    const char* cA = (const char*)g.A + (size_t)cur.pm * tstepA + (size_t)cur.pn * acolb; const char* cB = (const char*)g.Bt + (size_t)cur.pn * tstepB;
    S.a_ready(cur);
    if constexpr (SP2) {
        PG8_STAGE(PG8_SB(0, 0), cB, voffB); PG8_STAGE(PG8_SB(0, 1), cB + hstepB, voffB); PG8_STAGE(PG8_SA(0, 0), cA, voffA); PG8_STAGE(PG8_SA(0, 1), cA + hstepA, voffA);
        if (wr == 1) PG8_BAR;
        PG8_WAIT_V(2); PG8_BAR;
        PG8_STAGE(PG8_SB(1, 0), cB + kstep, voffB); PG8_STAGE(PG8_SA(1, 0), cA + kstep, voffA); PG8_STAGE(PG8_SB(1, 1), cB + hstepB + kstep, voffB);
        PG8_WAIT_V(6); PG8_BAR;
    } else {
        PG8_STAGE(PG8_SB(0, 0), cB, voffB); PG8_STAGE(PG8_SA(0, 0), cA, voffA); PG8_STAGE(PG8_SB(0, 1), cB + hstepB, voffB); PG8_STAGE(PG8_SA(0, 1), cA + hstepA, voffA);
        if (wr == 1) PG8_BAR;
        PG8_WAIT_V(4); PG8_BAR;
        PG8_STAGE(PG8_SB(1, 0), cB + kstep, voffB); PG8_STAGE(PG8_SA(1, 0), cA + kstep, voffA); PG8_STAGE(PG8_SB(1, 1), cB + hstepB + kstep, voffB);
        PG8_WAIT_V(6); PG8_BAR;
    }
    for (;;) {
        const bool has_next = S.next(ui + 1, nxt);
        const char* nA = has_next ? (const char*)g.A + (size_t)nxt.pm * tstepA + (size_t)nxt.pn * acolb : cA; const char* nB = has_next ? (const char*)g.Bt + (size_t)nxt.pn * tstepB : cB;
#pragma nounroll
        for (int t = 0; t < nt; t += 2) {
            const bool last = (t == nt - 2);
            const char* a1 = cA + (size_t)(t + 1) * kstep;
            const char* a2 = last ? nA : cA + (size_t)(t + 2) * kstep; const char* b2 = last ? nB : cB + (size_t)(t + 2) * kstep;
            const char* a3 = a2 + kstep; const char* b3 = b2 + kstep;
            if (last && has_next) S.a_ready(nxt);
            if constexpr (SP2) {
            PG8_LDB(B0, 0, 0); PG8_LDB(B1, 0, 1); PG8_SCHED; PG8_LDA(At, 0, 0); PG8_STAGE(PG8_SA(1, 1), a1 + hstepA, voffA);
            PG8_WAIT_V(8); PG8_WAIT_L(0); PG8_BAR; PG8_MMA(0, 0, At, B0); PG8_MMA(0, 1, At, B1); PG8_BAR; PG8_SCHED;
            PG8_LDA(At, 0, 1); PG8_STAGE(PG8_SB(0, 0), b2, voffB); PG8_STAGE(PG8_SB(0, 1), b2 + hstepB, voffB); PG8_STAGE(PG8_SA(0, 0), a2, voffA);
            PG8_WAIT_V(8); PG8_WAIT_L(0); PG8_BAR; PG8_MMA(1, 0, At, B0); PG8_MMA(1, 1, At, B1); PG8_BAR; PG8_SCHED;
            PG8_LDB(B0, 1, 0); PG8_LDB(B1, 1, 1); PG8_SCHED; PG8_LDA(At, 1, 0); PG8_STAGE(PG8_SA(0, 1), a2 + hstepA, voffA);
            PG8_WAIT_V(8); PG8_WAIT_L(0); PG8_BAR; PG8_MMA(0, 0, At, B0); PG8_MMA(0, 1, At, B1); PG8_BAR; PG8_SCHED;
            PG8_LDA(At, 1, 1); PG8_STAGE(PG8_SB(1, 0), b3, voffB); PG8_STAGE(PG8_SB(1, 1), b3 + hstepB, voffB); PG8_STAGE(PG8_SA(1, 0), a3, voffA);
            PG8_WAIT_V(8); PG8_WAIT_L(0); PG8_BAR; PG8_MMA(1, 0, At, B0); PG8_MMA(1, 1, At, B1); PG8_BAR; PG8_SCHED;
            } else {
            PG8_LDB(B0, 0, 0); PG8_SCHED; PG8_LDA(At, 0, 0); PG8_STAGE(PG8_SA(1, 1), a1 + hstepA, voffA);
            PG8_WAIT_L(8); PG8_BAR; PG8_WAIT_L(0); PG8_MMA(0, 0, At, B0); PG8_BAR; PG8_SCHED;
            PG8_LDB(B1, 0, 1); PG8_STAGE(PG8_SB(0, 0), b2, voffB);
            PG8_BAR; PG8_WAIT_L(0); PG8_MMA(0, 1, At, B1); PG8_BAR;
            PG8_LDA(At, 0, 1); PG8_STAGE(PG8_SA(0, 0), a2, voffA);
            PG8_BAR; PG8_WAIT_L(0); PG8_MMA(1, 0, At, B0); PG8_BAR; PG8_SCHED;
            PG8_STAGE(PG8_SB(0, 1), b2 + hstepB, voffB);
            PG8_WAIT_V(6); PG8_BAR; PG8_MMA(1, 1, At, B1); PG8_BAR;
            PG8_LDB(B0, 1, 0); PG8_SCHED; PG8_LDA(At, 1, 0); PG8_STAGE(PG8_SA(0, 1), a2 + hstepA, voffA);
            PG8_WAIT_L(8); PG8_BAR; PG8_WAIT_L(0); PG8_MMA(0, 0, At, B0); PG8_BAR; PG8_SCHED;
            PG8_LDB(B1, 1, 1); PG8_STAGE(PG8_SB(1, 0), b3, voffB);
            PG8_BAR; PG8_WAIT_L(0); PG8_MMA(0, 1, At, B1); PG8_BAR;
            PG8_LDA(At, 1, 1); PG8_STAGE(PG8_SA(1, 0), a3, voffA);
            PG8_BAR; PG8_WAIT_L(0); PG8_MMA(1, 0, At, B0); PG8_BAR; PG8_SCHED;
            PG8_STAGE(PG8_SB(1, 1), b3 + hstepB, voffB);
            PG8_WAIT_V(6); PG8_BAR; PG8_MMA(1, 1, At, B1); PG8_BAR;
            }
        }
        if constexpr (ALIGN_EPI) { if (wr == 0) PG8_BAR; }
        if constexpr (!Epi::AFTER_DRAIN) { E(acc, cur, wr, wc, fr, fq); S.done(cur); }
        if (!has_next) break;
#pragma unroll
        for (int a = 0; a < 2; ++a)
#pragma unroll
            for (int b = 0; b < 2; ++b)
#pragma unroll
                for (int m = 0; m < 4; ++m)
#pragma unroll
                    for (int n = 0; n < 2; ++n) acc[a][b][m][n] = (f32x4){0.f, 0.f, 0.f, 0.f};
        cur = nxt; cA = nA; cB = nB; ++ui;
        if constexpr (ALIGN_EPI) { if (wr == 1) PG8_BAR; }
    }
    PG8_WAIT_V(0);
    if constexpr (!ALIGN_EPI) { if (wr == 0) PG8_BAR; }
    PG8_BAR;
    if constexpr (Epi::AFTER_DRAIN) { E.fused(acc, cur, wr, wc, fr, fq, lds, wid, lane); S.done(cur); }
#undef PG8_SA
#undef PG8_SB
#undef PG8_STAGE
#undef PG8_LDA
#undef PG8_LDB
#undef PG8_MMA
#undef PG8_WAIT_V
#undef PG8_WAIT_L
#undef PG8_BAR
#undef PG8_SCHED
}

template <class F> struct EpiW {
    static constexpr bool PERM = true, AFTER_DRAIN = false; F f;
    __device__ __forceinline__ void operator()(const f32x4 (&acc)[2][2][4][2], const Unit& u, int wr, int wc, int fr, int fq) const {
#pragma unroll
        for (int ai = 0; ai < 2; ++ai)
#pragma unroll
            for (int m = 0; m < 4; ++m) { f.apply(u.pm * BM + ai * HALF + wr * 64 + m * 16 + fr, u.pn, wc * 32 + 8 * fq, acc[ai][0][m][0], acc[ai][0][m][1], acc[ai][1][m][0], acc[ai][1][m][1]);
                asm volatile("" ::: "memory"); }
    }
};
}

template <class F>
__device__ __forceinline__ void mfma_gemm(const Ctx& C, const bf16* A, int lda, int acol, const bf16* Bt, int ldb, int Mr, int N, int K, const F& f) {
    pg8::Gemm g{A, Bt, Mr, N, K, lda, ldb, acol}; pg8::StaticOrder S; S.init(Mr, N, C.nblk, C.blk); pg8::EpiW<F> E{f};
    pg8::gemm_phase<pg8::EpiW<F>, pg8::StaticOrder, true, true>(C.lds, g, S, E);
}

template <class F>
__device__ __forceinline__ void naive_gemm(const Ctx& C, const bf16* A, int lda, int acol, const bf16* Bt, int ldb, int Mr, int N, int K, const F& f) {
    LAS float* As = (LAS float*)C.lds;
    LAS float* Bs = (LAS float*)(C.lds + 8192);
    const int ntm = Mr / 128, ntn = N / 256, tid = C.tid, cg = tid & 15, r0 = tid >> 4;
    for (int tile = C.blk; tile < ntm * ntn; tile += C.nblk) {
        const int tm = tile / ntn, pn = tile % ntn;
        f32x4 acc[4][4];
#pragma unroll
        for (int i = 0; i < 4; ++i)
#pragma unroll
            for (int j = 0; j < 4; ++j) acc[i][j] = (f32x4){0.f, 0.f, 0.f, 0.f};
        const bf16* ap = A + (size_t)(tm * 128 + (tid >> 2)) * lda + pn * acol + (tid & 3) * 4;
        const bf16* bp = Bt + (size_t)(pn * 256 + (tid >> 1)) * ldb + (tid & 1) * 8;
        for (int k0 = 0; k0 < K; k0 += 16) {
            const u32x2 av = *(const u32x2*)(ap + k0); const u32x4 bv = *(const u32x4*)(bp + k0);
            __syncthreads();
            { const int r = tid >> 2, kq = (tid & 3) * 4; As[(kq + 0) * 128 + r] = bflo(av.x); As[(kq + 1) * 128 + r] = bfhi(av.x); As[(kq + 2) * 128 + r] = bflo(av.y); As[(kq + 3) * 128 + r] = bfhi(av.y); }
            { const int n = tid >> 1, kq = (tid & 1) * 8; Bs[(kq + 0) * 256 + n] = bflo(bv.x); Bs[(kq + 1) * 256 + n] = bfhi(bv.x); Bs[(kq + 2) * 256 + n] = bflo(bv.y); Bs[(kq + 3) * 256 + n] = bfhi(bv.y);
              Bs[(kq + 4) * 256 + n] = bflo(bv.z); Bs[(kq + 5) * 256 + n] = bfhi(bv.z); Bs[(kq + 6) * 256 + n] = bflo(bv.w); Bs[(kq + 7) * 256 + n] = bfhi(bv.w); }
            __syncthreads();
#pragma unroll
            for (int kk = 0; kk < 16; ++kk) {
                const f32x4 b0 = *(const LAS f32x4*)(Bs + kk * 256 + cg * 8), b1 = *(const LAS f32x4*)(Bs + kk * 256 + cg * 8 + 4), b2 = *(const LAS f32x4*)(Bs + kk * 256 + 128 + cg * 8), b3 = *(const LAS f32x4*)(Bs + kk * 256 + 128 + cg * 8 + 4);
#pragma unroll
                for (int i = 0; i < 4; ++i) { const float av1 = As[kk * 128 + r0 + 32 * i]; acc[i][0] += b0 * av1; acc[i][1] += b1 * av1; acc[i][2] += b2 * av1; acc[i][3] += b3 * av1; }
            }
        }
#pragma unroll
        for (int i = 0; i < 4; ++i) f.apply(tm * 128 + r0 + 32 * i, pn, cg * 8, acc[i][0], acc[i][1], acc[i][2], acc[i][3]);
    }
}

template <int NROWS>
__device__ __forceinline__ void cp_stage(LAS unsigned char* tile, const bf16* src, int mrow0, int tfirst, int tid) {
    constexpr int NIT = (NROWS * 128 + NTHREADS - 1) / NTHREADS;
    asm volatile("" : "+v"(tid));
    u32x4 v[NIT];
#pragma unroll
    for (int i = 0; i < NIT; ++i) { const int ch = i * NTHREADS + tid, r = ch >> 7, c = ch & 127; v[i] = (u32x4){0u, 0u, 0u, 0u};
        if (ch < NROWS * 128 && tfirst + r >= 0) v[i] = *(const u32x4*)(src + (size_t)(mrow0 + r) * D + c * 8); }
#pragma unroll
    for (int i = 0; i < NIT; ++i) { const int ch = i * NTHREADS + tid; if (ch < NROWS * 128) *(LAS u32x4*)(tile + ch * 16) = v[i]; }
}
template <int W>
__device__ __forceinline__ void pool_item(const LAS unsigned char* tile, bf16* PL, int m0, int t0, int tid) {
    float p0[47], p1[47];
#pragma unroll
    for (int i = 0; i < 47; ++i) { unsigned w = 0u; if (i >= 15 - (W - 1)) w = *(const LAS unsigned*)(tile + i * 2048 + 4 * tid); p0[i] = bflo(w); p1[i] = bfhi(w); }
#pragma unroll
    for (int ti = 0; ti < 32; ++ti) {
        float s0 = 0.f, s1 = 0.f;
#pragma unroll
        for (int j = 0; j < W; ++j) { s0 += p0[ti + 15 - j]; s1 += p1[ti + 15 - j]; }
        const int cnt = (t0 + ti + 1) < W ? (t0 + ti + 1) : W; const float inv = 1.f / (float)cnt;
        *(unsigned*)(PL + (size_t)(m0 + ti) * D + 2 * tid) = pk2(s0 * inv - p0[ti + 15], s1 * inv - p1[ti + 15]);
    }
}
template <int RI>
__device__ __forceinline__ void conv_row(const LAS unsigned char* tile, int tid, const float (&w0)[31], const float (&w1)[31], float (&a0)[32], float (&a1)[32]) {
    const unsigned w = *(const LAS unsigned*)(tile + RI * 2048 + 4 * tid);
    const float u0 = bflo(w), u1 = bfhi(w);
#pragma unroll
    for (int ti = 0; ti < 32; ++ti) { constexpr int dbase = 30 - RI; const int d = ti + dbase; if (d >= 0 && d <= 30) { a0[ti] += w0[30 - d] * u0; a1[ti] += w1[30 - d] * u1; } }
    if constexpr ((RI & 7) == 7) asm volatile("" ::: "memory");
}
template <int... RI>
__device__ __forceinline__ void conv_rows(const LAS unsigned char* tile, int tid, const float (&w0)[31], const float (&w1)[31], float (&a0)[32], float (&a1)[32], std::integer_sequence<int, RI...>) {
    (conv_row<RI>(tile, tid, w0, w1, a0, a1), ...);
}
__device__ __forceinline__ void phase_convpool(const Ctx& C, const Args& a, int l) {
    const bf16* UG = (const bf16*)(a.ws + WS_UG); const bf16* ZP = (const bf16*)(a.ws + WS_ZP);
    bf16* AC = (bf16*)(a.ws + WS_AC); bf16* PL = (bf16*)(a.ws + WS_PL);
    const float* cw = a.in[I_CONVW] + (size_t)l * CONVK * D; const float* cb = a.in[I_CONVB] + (size_t)l * D;
    const float* lng = a.in[I_LNG] + (size_t)l * D; const float* lnb = a.in[I_LNB] + (size_t)l * D;
    LAS float* red = (LAS float*)C.lds;
    LAS float* stat = (LAS float*)(C.lds + 2048);
    LAS unsigned char* tile = C.lds + 4096;
    int tid = C.tid;
    asm volatile("" : "+v"(tid));
    const int c0 = 2 * tid;
    float w0[31], w1[31];
#pragma unroll
    for (int k = 0; k < 31; ++k) { const f32x2 w = *(const f32x2*)(cw + (size_t)k * D + c0); w0[k] = w.x; w1[k] = w.y; }
    const f32x2 bb = *(const f32x2*)(cb + c0), gg = *(const f32x2*)(lng + c0), be = *(const f32x2*)(lnb + c0);
    for (int item = C.blk; item < M / 32; item += C.nblk) {
        const int m0 = item * 32, t0 = m0 & (SEQ - 1);
        __syncthreads();
        cp_stage<62>(tile, UG, m0 - 30, t0 - 30, tid);
        __syncthreads();
        float a0[32], a1[32];
#pragma unroll
        for (int i = 0; i < 32; ++i) { a0[i] = bb.x; a1[i] = bb.y; }
        conv_rows(tile, tid, w0, w1, a0, a1, std::make_integer_sequence<int, 62>{});
#pragma unroll
        for (int ti = 0; ti < 32; ++ti) {
            const float s = dpp_sum63(a0[ti] + a1[ti]), q = dpp_sum63(a0[ti] * a0[ti] + a1[ti] * a1[ti]);
            if (C.lane == 63) { red[C.wave * 64 + ti] = s; red[C.wave * 64 + 32 + ti] = q; }
        }
        __syncthreads();
        if (tid < 32) { float s = 0.f, q = 0.f;
#pragma unroll
            for (int w = 0; w < 8; ++w) { s += red[w * 64 + tid]; q += red[w * 64 + 32 + tid]; }
            const float mean = s * (1.f / D), var = fmaxf(q * (1.f / D) - mean * mean, 0.f); stat[tid] = mean; stat[32 + tid] = 1.f / sqrtf(var + EPS); }
        __syncthreads();
#pragma unroll
        for (int ti = 0; ti < 32; ++ti) { const float mean = stat[ti], rstd = stat[32 + ti];
            const float y0 = (a0[ti] - mean) * rstd * gg.x + be.x, y1 = (a1[ti] - mean) * rstd * gg.y + be.y;
            *(unsigned*)(AC + (size_t)(m0 + ti) * D + c0) = pk2(y0 * sigm(y0), y1 * sigm(y1)); }
        asm volatile("" ::: "memory");
        cp_stage<47>(tile, ZP, m0 - 15, t0 - 15, tid);
        __syncthreads();
        const int g = tid >> 7;
        if (g == 0) pool_item<2>(tile, PL, m0, t0, tid); else if (g == 1) pool_item<4>(tile, PL, m0, t0, tid); else if (g == 2) pool_item<8>(tile, PL, m0, t0, tid); else pool_item<16>(tile, PL, m0, t0, tid);
    }
}

typedef unsigned u32;
template <int CTRL> __device__ __forceinline__ u32 dppu(u32 x) { return (u32)__builtin_amdgcn_update_dpp(0, (int)x, CTRL, 0xf, 0xf, true); }
constexpr int DPP_XOR1 = 0xB1, DPP_REV4 = 0x1B, DPP_DUPE = 0xA0, DPP_DUPO = 0xF5, DPP_HMIRROR = 0x141, DPP_MIRROR = 0x140;
__device__ __forceinline__ u32 umax_(u32 a, u32 b) { return a > b ? a : b; }
__device__ __forceinline__ u32 umin_(u32 a, u32 b) { return a < b ? a : b; }
#define TK_CE(x, i, j) do { const u32 hi_ = umax_(x[i], x[j]), lo_ = umin_(x[i], x[j]); x[i] = hi_; x[j] = lo_; } while (0)
__device__ __forceinline__ void tk_local_merge(u32 (&x)[8]) {
    TK_CE(x, 0, 4); TK_CE(x, 1, 5); TK_CE(x, 2, 6); TK_CE(x, 3, 7);
    TK_CE(x, 0, 2); TK_CE(x, 1, 3); TK_CE(x, 4, 6); TK_CE(x, 5, 7);
    TK_CE(x, 0, 1); TK_CE(x, 2, 3); TK_CE(x, 4, 5); TK_CE(x, 6, 7);
}
template <int CTRL> __device__ __forceinline__ void tk_level(u32 (&x)[8], bool even) {
    u32 t[8];
#pragma unroll
    for (int c = 0; c < 8; ++c) t[c] = dppu<CTRL>(x[7 - c]);
#pragma unroll
    for (int c = 0; c < 8; ++c) x[c] = umax_(x[c], t[c]);
#pragma unroll
    for (int c = 0; c < 8; ++c) { const u32 p = dppu<DPP_XOR1>(x[c]); x[c] = even ? umax_(x[c], p) : umin_(x[c], p); }
    tk_local_merge(x);
}
__device__ __forceinline__ void tk_top16(u32 (&x)[8], bool even) {
    TK_CE(x, 0, 1); TK_CE(x, 2, 3); TK_CE(x, 4, 5); TK_CE(x, 6, 7);
    TK_CE(x, 0, 2); TK_CE(x, 1, 3); TK_CE(x, 4, 6); TK_CE(x, 5, 7);
    TK_CE(x, 1, 2); TK_CE(x, 5, 6);
    TK_CE(x, 0, 4); TK_CE(x, 1, 5); TK_CE(x, 2, 6); TK_CE(x, 3, 7);
    TK_CE(x, 2, 4); TK_CE(x, 3, 5);
    TK_CE(x, 1, 2); TK_CE(x, 3, 4); TK_CE(x, 5, 6);
    { u32 t[8];
#pragma unroll
      for (int c = 0; c < 8; ++c) t[c] = dppu<DPP_XOR1>(x[7 - c]);
#pragma unroll
      for (int c = 0; c < 8; ++c) x[c] = even ? umax_(x[c], t[c]) : umin_(x[c], t[c]); }
    tk_local_merge(x);
    tk_level<DPP_REV4>(x, even); tk_level<DPP_HMIRROR>(x, even); tk_level<DPP_MIRROR>(x, even);
}
__device__ __forceinline__ u32 tk_f2key(float v, int slot) { const u32 u = __builtin_bit_cast(u32, v); const u32 k = u ^ ((u32)((int)u >> 31) | 0x80000000u); return (k & ~127u) | (u32)(127 - slot); }
__device__ __forceinline__ float tk_key2f(u32 k) { k &= ~127u; const u32 m = (u32)((int)k >> 31); return __builtin_bit_cast(float, k ^ (~m | 0x80000000u)); }
__device__ __forceinline__ u32 tk_sel8v(u32 r0, u32 r1, u32 r2, u32 r3, u32 r4, u32 r5, u32 r6, u32 r7, int idx) {
    const bool b0 = idx & 1, b1 = idx & 2, b2 = idx & 4;
    const u32 s01 = b0 ? r1 : r0, s23 = b0 ? r3 : r2, s45 = b0 ? r5 : r4, s67 = b0 ? r7 : r6;
    const u32 s03 = b1 ? s23 : s01, s47 = b1 ? s67 : s45;
    return b2 ? s47 : s03; }
#define tk_sel8(r, idx) tk_sel8v(r[0], r[1], r[2], r[3], r[4], r[5], r[6], r[7], idx)
__device__ __forceinline__ void phase_topk(const Ctx& C, const Args& a) {
    const float* S = (const float*)(a.ws + WS_S); int* EID = (int*)(a.ws + WS_EID); float* GW = (float*)(a.ws + WS_GW);
    const int lane = C.lane, r = lane & 15, q = lane >> 4; const bool even = (lane & 1) == 0;
    for (int it = C.gw; it < M * NHEAD / 4; it += C.ngw) {
        const int pair = it * 4 + q, tok = pair >> 3, h = pair & 7;
        u32 xa[8], xb[8];
        { const float* sp = S + (size_t)tok * DQ + h * 256 + 8 * r; const f32x4 v0 = *(const f32x4*)sp, v1 = *(const f32x4*)(sp + 4), w0 = *(const f32x4*)(sp + 128), w1 = *(const f32x4*)(sp + 132);
#pragma unroll
          for (int c = 0; c < 4; ++c) { xa[c] = tk_f2key(v0[c], 8 * r + c); xa[4 + c] = tk_f2key(v1[c], 8 * r + 4 + c); xb[c] = tk_f2key(w0[c], 8 * r + c); xb[4 + c] = tk_f2key(w1[c], 8 * r + 4 + c); } }
        tk_top16(xa, even); tk_top16(xb, even);
        u32 La[8], Ha[8], Lb[8], Hb[8];
#pragma unroll
        for (int c = 0; c < 8; ++c) { La[c] = dppu<DPP_DUPE>(xa[c]); Ha[c] = dppu<DPP_DUPO>(xa[c]); Lb[c] = dppu<DPP_DUPE>(xb[c]); Hb[c] = dppu<DPP_DUPO>(xb[c]); }
        const u32 a_lane = (r < 8) ? tk_sel8(La, r & 7) : tk_sel8(Ha, r & 7), b_lane = (r < 8) ? tk_sel8(Lb, r & 7) : tk_sel8(Hb, r & 7);
        const float va = tk_key2f(a_lane), vbl = tk_key2f(b_lane), va0 = tk_key2f(La[0]);
        u32 ck[8];
#pragma unroll
        for (int j = 0; j < 8; ++j) { constexpr int lim[8] = {15, 7, 4, 3, 2, 1, 1, 1};
            float v = va + tk_key2f(Lb[j]); bool valid = r <= lim[j];
            if (j == 1) { v = (r >= 8) ? va0 + vbl : v; valid = valid || (r >= 8); }
            ck[j] = valid ? tk_f2key(v, 8 * r + j) : 0u; }
        tk_top16(ck, even);
        const float mx = tk_key2f(dppu<DPP_DUPE>(ck[0]));
        float ex[8], sum = 0.f;
#pragma unroll
        for (int c = 0; c < 8; ++c) { ex[c] = __expf(tk_key2f(ck[c]) - mx); sum += ex[c]; }
        sum += __builtin_bit_cast(float, dppu<DPP_XOR1>(__builtin_bit_cast(u32, sum)));
        const float inv = 1.f / sum;
        int eo[8]; float go[8];
#pragma unroll
        for (int c = 0; c < 8; ++c) { const int slot = 127 - (int)(ck[c] & 127u), i = slot >> 3, j = slot & 7; const bool sp = (j == 1) && (i >= 8);
            const int i2 = sp ? 0 : i, j2 = sp ? i : j;
            const u32 ka = (u32)__builtin_amdgcn_ds_bpermute(((lane & ~15) + i2) << 2, (int)a_lane), kb = (u32)__builtin_amdgcn_ds_bpermute(((lane & ~15) + j2) << 2, (int)b_lane);
            eo[c] = (127 - (int)(ka & 127u)) * 128 + (127 - (int)(kb & 127u)); go[c] = ex[c] * inv; }
        if (r < 2) { int* ep = EID + (size_t)tok * 128 + h * 16 + r * 8; float* gp = GW + (size_t)tok * 128 + h * 16 + r * 8;
            *(u32x4*)ep = (u32x4){(u32)eo[0], (u32)eo[1], (u32)eo[2], (u32)eo[3]}; *(u32x4*)(ep + 4) = (u32x4){(u32)eo[4], (u32)eo[5], (u32)eo[6], (u32)eo[7]};
            *(f32x4*)gp = (f32x4){go[0], go[1], go[2], go[3]}; *(f32x4*)(gp + 4) = (f32x4){go[4], go[5], go[6], go[7]}; }
    }
}

__device__ __forceinline__ float dot2bf(unsigned w, unsigned x, float acc) { return __builtin_amdgcn_fdot2_f32_bf16(__builtin_bit_cast(bf16x2_t, w), __builtin_bit_cast(bf16x2_t, x), acc, false); }
constexpr int PNB = 8;
__device__ __forceinline__ void peer_load(u32x4 (&buf)[PNB], __amdgpu_buffer_rsrc_t T, int ev0, int ev1, int k0, int lane) {
    const int evs = (k0 < 64) ? ev0 : ev1;
#pragma unroll
    for (int i = 0; i < PNB; ++i) { const int e = __builtin_amdgcn_readlane(evs, (k0 & 63) + i); buf[i] = __builtin_bit_cast(u32x4, __builtin_amdgcn_raw_buffer_load_b128(T, 16 * lane, e * D, 0)); }
}
__device__ __forceinline__ void phase_peer(const Ctx& C, const Args& a, int l) {
    const __amdgpu_buffer_rsrc_t UB = __builtin_amdgcn_make_buffer_rsrc(a.ws + WS_UB + (size_t)l * NEXP * D, 0, NEXP * D, 0x00020000);
    const __amdgpu_buffer_rsrc_t VB = __builtin_amdgcn_make_buffer_rsrc(a.ws + WS_VB + (size_t)l * NEXP * D, 0, NEXP * D, 0x00020000);
    const float* USC = (const float*)(a.ws + WS_USC) + (size_t)l * NEXP; const float* VSC = (const float*)(a.ws + WS_VSC) + (size_t)l * NEXP;
    const int* EID = (const int*)(a.ws + WS_EID); const float* GW = (const float*)(a.ws + WS_GW);
    float* XW = a.out; bf16* H = (bf16*)(a.ws + WS_H);
    for (int m = C.gw; m < M; m += C.ngw) {
        int lane = C.lane; asm volatile("" : "+v"(lane));
        const int b = m >> 13; f32x4 x[4], h[4];
        const int ev0 = EID[(size_t)m * 128 + lane], ev1 = EID[(size_t)m * 128 + 64 + lane];
        const float gwv0 = GW[(size_t)m * 128 + lane], gwv1 = GW[(size_t)m * 128 + 64 + lane];
        const float su0 = USC[ev0], su1 = USC[ev1], sv0 = VSC[ev0], sv1 = VSC[ev1];
#pragma unroll
        for (int q = 0; q < 4; ++q) x[q] = *(const f32x4*)(XW + (size_t)m * D + 16 * lane + 4 * q);
        { float ss = 0.f;
#pragma unroll
          for (int q = 0; q < 4; ++q) ss += (x[q].x * x[q].x + x[q].y * x[q].y) + (x[q].z * x[q].z + x[q].w * x[q].w);
          const float rstd = 1.f / sqrtf(wave_sum(ss) * (1.f / D) + EPS);
          const float* g = a.in[I_N2G] + (size_t)l * D; const float* sh = modp(a, l, b, 3); const float* sc = modp(a, l, b, 4);
#pragma unroll
          for (int q = 0; q < 4; ++q) { const int c = 16 * lane + 4 * q; h[q] = (x[q] * rstd) * *(const f32x4*)(g + c) * (*(const f32x4*)(sc + c) + 1.f) + *(const f32x4*)(sh + c); } }
        float dv0 = 0.f, dv1 = 0.f;
        u32x4 A[PNB], Bf[PNB];
#define PEER_DOT(buf, kbase) do { _Pragma("unroll") for (int i = 0; i < PNB; ++i) { float d = 0.f; \
            _Pragma("unroll") for (int q = 0; q < 4; ++q) { const f32x2 lo = __builtin_amdgcn_cvt_pk_f32_fp8((int)buf[i][q], false), hi = __builtin_amdgcn_cvt_pk_f32_fp8((int)buf[i][q], true); \
                d += lo.x * h[q].x; d += lo.y * h[q].y; d += hi.x * h[q].z; d += hi.y * h[q].w; } \
            d = dpp_sum63(d); const float tot = __builtin_bit_cast(float, __builtin_amdgcn_readlane(__builtin_bit_cast(int, d), 63)); const int kk = (kbase) + i; \
            dv0 = (lane == kk) ? tot : dv0; dv1 = (lane + 64 == kk) ? tot : dv1; __builtin_amdgcn_sched_barrier(0); } } while (0)
        peer_load(A, UB, ev0, ev1, 0, lane);
#pragma nounroll
        for (int k = 0; k < 128; k += 2 * PNB) {
            peer_load(Bf, UB, ev0, ev1, k + PNB, lane);
            PEER_DOT(A, k);
            if (k + 2 * PNB < 128) peer_load(A, UB, ev0, ev1, k + 2 * PNB, lane);
            PEER_DOT(Bf, k + PNB);
        }
#undef PEER_DOT
        dv0 *= su0; dv1 *= su1;
        const float cf0 = sv0 * gwv0 * 0.5f * dv0 * (1.f + erff(dv0 * 0.70710678118654752f)), cf1 = sv1 * gwv1 * 0.5f * dv1 * (1.f + erff(dv1 * 0.70710678118654752f));
        f32x4 o[4];
#pragma unroll
        for (int q = 0; q < 4; ++q) o[q] = (f32x4){0.f, 0.f, 0.f, 0.f};
#define PEER_ACC(buf, i, c) do { _Pragma("unroll") for (int q = 0; q < 4; ++q) { const f32x2 lo = __builtin_amdgcn_cvt_pk_f32_fp8((int)buf[i][q], false), hi = __builtin_amdgcn_cvt_pk_f32_fp8((int)buf[i][q], true); \
            o[q].x += c * lo.x; o[q].y += c * lo.y; o[q].z += c * hi.x; o[q].w += c * hi.y; } __builtin_amdgcn_sched_barrier(0); } while (0)
        peer_load(A, VB, ev0, ev1, 0, lane);
#pragma nounroll
        for (int k = 0; k < 128; k += 2 * PNB) {
            peer_load(Bf, VB, ev0, ev1, k + PNB, lane);
            { const int cfs = __builtin_bit_cast(int, k < 64 ? cf0 : cf1);
#pragma unroll
              for (int i = 0; i < PNB; ++i) { const float c = __builtin_bit_cast(float, __builtin_amdgcn_readlane(cfs, (k & 63) + i)); PEER_ACC(A, i, c); } }
            if (k + 2 * PNB < 128) peer_load(A, VB, ev0, ev1, k + 2 * PNB, lane);
            { const int cfs = __builtin_bit_cast(int, k < 64 ? cf0 : cf1);
#pragma unroll
              for (int i = 0; i < PNB; ++i) { const float c = __builtin_bit_cast(float, __builtin_amdgcn_readlane(cfs, (k & 63) + PNB + i)); PEER_ACC(Bf, i, c); } }
        }
#undef PEER_ACC
        asm volatile("" : "+v"(lane));
        const float* g2 = modp(a, l, b, 5);
#pragma unroll
        for (int q = 0; q < 4; ++q) x[q] = *(const f32x4*)(XW + (size_t)m * D + 16 * lane + 4 * q) + *(const f32x4*)(g2 + 16 * lane + 4 * q) * o[q];
        float ss = 0.f;
#pragma unroll
        for (int q = 0; q < 4; ++q) ss += (x[q].x * x[q].x + x[q].y * x[q].y) + (x[q].z * x[q].z + x[q].w * x[q].w);
        const float rstd = 1.f / sqrtf(wave_sum(ss) * (1.f / D) + EPS);
        if (l + 1 < DEPTH) {
            const float* g = a.in[I_N1G] + (size_t)(l + 1) * D; const float* sh = modp(a, l + 1, b, 0); const float* sc = modp(a, l + 1, b, 1);
            f32x4 hv[4];
#pragma unroll
            for (int q = 0; q < 4; ++q) { const int c = 16 * lane + 4 * q; *(f32x4*)(XW + (size_t)m * D + c) = x[q];
                hv[q] = (x[q] * rstd) * *(const f32x4*)(g + c) * (*(const f32x4*)(sc + c) + 1.f) + *(const f32x4*)(sh + c); }
            *(u32x4*)(H + (size_t)m * D + 16 * lane) = pack8(hv[0], hv[1]); *(u32x4*)(H + (size_t)m * D + 16 * lane + 8) = pack8(hv[2], hv[3]);
        } else {
#pragma unroll
            for (int q = 0; q < 4; ++q) { const int c = 16 * lane + 4 * q; *(f32x4*)(a.out + (size_t)m * D + c) = x[q] * rstd * *(const f32x4*)(a.in[I_FG] + c); }
        }
    }
}

#ifndef USE_NAIVE
#define GEMM mfma_gemm
#else
#define GEMM naive_gemm
#endif
#define RLX_AGENT __ATOMIC_RELAXED, __HIP_MEMORY_SCOPE_AGENT
#define XB_TMO      128
#define XB_XCNT(j)  (256  + 64 * (j))
#define XB_XSUB(j)  (1280 + 64 * (j))
#define XB_XGEN(j)  (2304 + 64 * (j))
#define XB_TOP      3328
#define XB_TOPGEN   3392
#define XCD_BAR_WORDS 3456
#define XB_SPIN_CAP (1u << 18)

__device__ __forceinline__ unsigned xb_ld(unsigned* p)              { return __hip_atomic_load(p, __ATOMIC_RELAXED, __HIP_MEMORY_SCOPE_AGENT); }
__device__ __forceinline__ unsigned xb_add(unsigned* p, unsigned v) { return __hip_atomic_fetch_add(p, v, __ATOMIC_RELAXED, __HIP_MEMORY_SCOPE_AGENT); }
__device__ __forceinline__ unsigned xb_xcc_id() { return (unsigned)__builtin_amdgcn_s_getreg((3 << 11) | 20) & 0xFu; }
#define XB_SPIN(cond, bar) do { unsigned _sp = 0; while (cond) { __builtin_amdgcn_s_sleep(1); \
    if ((++_sp & 255u) == 0u) { if (xb_ld(&(bar)[XB_TMO])) break; if (_sp > XB_SPIN_CAP) { atomicAdd(&(bar)[XB_TMO], 1u); break; } } } } while (0)

struct XcdBarrier {
    unsigned* bar; unsigned x;
    volatile LAS unsigned* st;
};

__device__ __forceinline__ XcdBarrier xcd_barrier_post(unsigned* bar, volatile LAS unsigned* st) {
    XcdBarrier b; b.bar = bar; b.x = xb_xcc_id(); b.st = st;
    if (threadIdx.x == 0) (void)xb_add(&bar[XB_XCNT(b.x)], 1u);
    return b;
}
__device__ __forceinline__ void xcd_barrier_complete(unsigned* bar, unsigned x, unsigned& nloc, unsigned& nx) {
    const unsigned G = gridDim.x * gridDim.y * gridDim.z;
    unsigned sum, cnt, mine, sp = 0u;
    for (;;) {
        sum = 0u; cnt = 0u; mine = 0u;
#pragma unroll
        for (unsigned j = 0; j < 16; ++j) { const unsigned c = xb_ld(&bar[XB_XCNT(j)]); sum += c; cnt += (c > 0u) ? 1u : 0u; mine = (j == x) ? c : mine; }
        if (sum == G) break;
        __builtin_amdgcn_s_sleep(1);
        if ((++sp & 255u) == 0u) { if (xb_ld(&bar[XB_TMO])) break; if (sp > XB_SPIN_CAP) { atomicAdd(&bar[XB_TMO], 1u); break; } }
    }
    nloc = mine > 0u ? mine : 1u; nx = cnt > 0u ? cnt : 1u;
}

__device__ __forceinline__ void xcd_barrier(const XcdBarrier& b) {
    asm volatile("s_waitcnt vmcnt(0)" ::: "memory");
    __syncthreads();
    if (threadIdx.x == 0) {
        unsigned* bar = b.bar;
        __builtin_amdgcn_s_waitcnt(0);
        unsigned nloc = b.st[0], nx = b.st[1];
        if (nloc == 0u) { xcd_barrier_complete(bar, b.x, nloc, nx); b.st[0] = nloc; b.st[1] = nx; }
        const unsigned old = xb_add(&bar[XB_XSUB(b.x)], 1u);
        const unsigned gen = old / nloc;
        if (old + 1u == (gen + 1u) * nloc) {
            __builtin_amdgcn_fence(__ATOMIC_RELEASE, "agent");
            asm volatile("s_waitcnt vmcnt(0)" ::: "memory");
            const unsigned og = xb_add(&bar[XB_TOP], 1u);
            const unsigned tg = og / nx;
            if (og + 1u == (tg + 1u) * nx) xb_add(&bar[XB_TOPGEN], 1u);
            else XB_SPIN(xb_ld(&bar[XB_TOPGEN]) == tg, bar);
            __builtin_amdgcn_fence(__ATOMIC_ACQUIRE, "agent");
            xb_add(&bar[XB_XGEN(b.x)], 1u);
            asm volatile("s_waitcnt vmcnt(0)" ::: "memory");
        } else {
            XB_SPIN(xb_ld(&bar[XB_XGEN(b.x)]) == gen, bar);
            __builtin_amdgcn_fence(__ATOMIC_ACQUIRE, "agent");
            asm volatile("s_waitcnt vmcnt(0)" ::: "memory");
        }
    }
    __syncthreads();
}

constexpr int CW_BAR = 4096;
constexpr size_t CTL_ZERO_BYTES = 65536;
constexpr int LDSCTL_OFF = 131072, MISC_OFF = LDSCTL_OFF + 320;
constexpr int PH_PREP = 0, PH_MODR = 1, PH_N1 = 2, PH_L0 = 3, PH_PER_LAYER = 10, N_PHASES = PH_L0 + DEPTH * PH_PER_LAYER;
__device__ __forceinline__ Ctx make_ctx(LAS unsigned char* lds, int wave_s) {
    int tid_ = (wave_s << 6) | (int)__builtin_amdgcn_mbcnt_hi(~0u, __builtin_amdgcn_mbcnt_lo(~0u, 0u)); asm volatile("" : "+v"(tid_));
    Ctx C; C.tid = tid_; C.lane = C.tid & 63; C.wave = __builtin_amdgcn_readfirstlane(C.tid >> 6); C.nblk = gridDim.x; C.blk = blockIdx.x;
    C.gw = C.blk * NWAVES + C.wave; C.ngw = C.nblk * NWAVES; C.lds = lds; return C;
}
#ifndef ONLYPH
#define ONLYPH -1
#endif
constexpr unsigned long long REP_MASK = 0ull;
#define PH(k, ...) if ((ONLYPH < 0 || ONLYPH == (k)) && a.ph_lo <= (k) && (k) < a.ph_hi) { for (int r_ = 0; r_ < 1 + (int)((REP_MASK >> (k)) & 1ull); ++r_) { const Ctx C = make_ctx(lds, wave_s); __VA_ARGS__; } if ((k) + 1 < a.ph_hi) xcd_barrier(bar); }
template <int l>
__device__ __forceinline__ void run_layer(const Args& a, LAS unsigned char* lds, const XcdBarrier& bar, const int wave_s) {
    unsigned char* ws = a.ws; constexpr int B0 = PH_L0 + l * PH_PER_LAYER;
    PH(B0 + 0, EpiIn E{a.in[I_BIN] + (size_t)l * DIN, (bf16*)(ws + WS_UG), (bf16*)(ws + WS_ZP), (bf16*)(ws + WS_G)};
               GEMM(C, (const bf16*)(ws + WS_H), D, 0, (const bf16*)(ws + WS_WIN) + (size_t)l * DIN * D, D, M, DIN, D, E))
    PH(B0 + 1, phase_convpool(C, a, l))
    PH(B0 + 2, EpiPool E{(const bf16*)(ws + WS_G), a.in[I_POOLS] + (size_t)l * D, (bf16*)(ws + WS_TMP)};
               GEMM(C, (const bf16*)(ws + WS_PL), D, 256, (const bf16*)(ws + WS_POOL) + (size_t)l * 1024 * 256, 256, M, D, 256, E))
    PH(B0 + 3, EpiConv E{(const bf16*)(ws + WS_G), (const bf16*)(ws + WS_TMP), (bf16*)(ws + WS_Y)};
               GEMM(C, (const bf16*)(ws + WS_AC), D, 0, (const bf16*)(ws + WS_WCO) + (size_t)l * D * D, D, M, D, D, E))
    PH(B0 + 4, EpiOut E{l == 0 ? a.in[I_X] : a.out, a.out, modp(a, l, 0, 2), a.in[I_BOUT] + (size_t)l * D};
               GEMM(C, (const bf16*)(ws + WS_Y), D, 0, (const bf16*)(ws + WS_WOUT) + (size_t)l * D * D, D, M, D, D, E))
    PH(B0 + 5, phase_norm(C, a, a.out, a.in[I_N2G] + (size_t)l * D, l, 3, 4))
    PH(B0 + 6, EpiQ E{(bf16*)(ws + WS_Q)}; GEMM(C, (const bf16*)(ws + WS_H), D, 0, (const bf16*)(ws + WS_WQ) + (size_t)l * DQ * D, D, M, DQ, D, E))
    PH(B0 + 7, EpiS E{(float*)(ws + WS_S)}; GEMM(C, (const bf16*)(ws + WS_Q), DQ, 256, (const bf16*)(ws + WS_KEYS) + (size_t)l * 2048 * 256, 256, M, DQ, 256, E))
    PH(B0 + 8, phase_topk(C, a))
    PH(B0 + 9, phase_peer(C, a, l))
}
__global__ void __launch_bounds__(NTHREADS, 2) fwd_kernel(Args a) {
    extern __shared__ __attribute__((aligned(16))) unsigned char lds_raw[];
    LAS unsigned char* lds = (LAS unsigned char*)lds_raw;
    for (int u = threadIdx.x; u < (LDS_BYTES - LDSCTL_OFF) / 4; u += NTHREADS) ((LAS unsigned*)(lds + LDSCTL_OFF))[u] = 0u;
    __syncthreads();
    const int wave_s = __builtin_amdgcn_readfirstlane((int)threadIdx.x >> 6);
    const XcdBarrier bar = xcd_barrier_post((unsigned*)(a.ws + WS_CTL) + CW_BAR, (volatile LAS unsigned*)(lds + MISC_OFF) + 8);
    PH(PH_PREP, phase_prep(C, a))
    PH(PH_MODR, phase_modreduce(C, a))
    PH(PH_N1, phase_norm(C, a, a.in[I_X], a.in[I_N1G], 0, 0, 1))
    run_layer<0>(a, lds, bar, wave_s);
    run_layer<1>(a, lds, bar, wave_s);
}

extern "C" void kernel_launch(void* const* d_in, const int* in_sizes, int n_in, void* d_out, int out_size, void* d_ws, size_t ws_size, hipStream_t stream) {
    static int grid = 0;
    if (grid == 0) {
        if (n_in != 22 || out_size != M * D || ws_size < WS_END) { fprintf(stderr, "kernel_launch: unexpected shapes (n_in %d out %d ws %zu)\n", n_in, out_size, ws_size); grid = -1; return; }
        int dev = 0, cus = 0;
        if (hipGetDevice(&dev) != hipSuccess || hipDeviceGetAttribute(&cus, hipDeviceAttributeMultiprocessorCount, dev) != hipSuccess) { grid = -1; return; }
        if (hipFuncSetAttribute((const void*)fwd_kernel, hipFuncAttributeMaxDynamicSharedMemorySize, LDS_BYTES) != hipSuccess) { grid = -1; return; }
        grid = cus;
    }
    if (grid < 0) return;
    Args a{};
    for (int i = 0; i < 22; ++i) a.in[i] = (const float*)d_in[i];
    a.out = (float*)d_out; a.ws = (unsigned char*)d_ws;
    (void)hipMemsetAsync((char*)d_ws + WS_CTL, 0, CTL_ZERO_BYTES, stream);
#ifndef ONE_LAUNCH
    for (int ph = 0; ph < N_PHASES; ++ph) { a.ph_lo = ph; a.ph_hi = ph + 1; hipLaunchKernelGGL(fwd_kernel, dim3(grid), dim3(NTHREADS), LDS_BYTES, stream, a); }
#else
    a.ph_lo = 0; a.ph_hi = N_PHASES; hipLaunchKernelGGL(fwd_kernel, dim3(grid), dim3(NTHREADS), LDS_BYTES, stream, a);
#endif
}
```

```cpp
#define ONE_LAUNCH 1
#include <hip/hip_runtime.h>
#include <cstdint>
#include <cstdio>
#include <utility>

#define GAS __attribute__((address_space(1)))
#define LAS __attribute__((address_space(3)))
typedef unsigned short bf16;
typedef float f32x4 __attribute__((ext_vector_type(4)));
typedef float f32x2 __attribute__((ext_vector_type(2)));
typedef unsigned u32x4 __attribute__((ext_vector_type(4)));
typedef unsigned u32x2 __attribute__((ext_vector_type(2)));
typedef __bf16 bf16x2_t __attribute__((ext_vector_type(2)));

constexpr int BATCH = 2, SEQ = 8192, D = 1024, M = BATCH * SEQ, DEPTH = 2;
constexpr int DIN = 5120, NMODV = 6 * D, CONVK = 31, NHEAD = 8, NKEYS = 128, DQ = 2048, TOPK = 16, NEXP = 16384;
constexpr float EPS = 1e-6f;
constexpr int NWAVES = 8, NTHREADS = NWAVES * 64;

constexpr size_t MiB = 1u << 20;
constexpr size_t WS_CTL = 0;
constexpr size_t WS_MODP = 1 * MiB;
constexpr size_t WS_MOD = 4 * MiB;
constexpr size_t WS_WIN = 8 * MiB;
constexpr size_t WS_WCO = 28 * MiB;
constexpr size_t WS_WOUT = 32 * MiB;
constexpr size_t WS_WQ = 36 * MiB;
constexpr size_t WS_POOL = 44 * MiB;
constexpr size_t WS_KEYS = 45 * MiB;
constexpr size_t WS_UB = 48 * MiB;
constexpr size_t WS_USC = 80 * MiB;
constexpr size_t WS_VSC = 81 * MiB;
constexpr size_t WS_VB = 112 * MiB;
constexpr size_t WS_H = 176 * MiB;
constexpr size_t WS_UG = 208 * MiB;
constexpr size_t WS_Y = WS_UG;
constexpr size_t WS_ZP = 240 * MiB;
constexpr size_t WS_TMP = WS_ZP;
constexpr size_t WS_Q = WS_UG;
constexpr size_t WS_G = 272 * MiB;
constexpr size_t WS_AC = 336 * MiB;
constexpr size_t WS_PL = 368 * MiB;
constexpr size_t WS_S = WS_G;
constexpr size_t WS_EID = 400 * MiB;
constexpr size_t WS_GW = 408 * MiB;
constexpr size_t WS_END = 416 * MiB;

constexpr int LDS_BYTES = 147456;

__device__ __forceinline__ unsigned f2bf(float f) { unsigned u = __builtin_bit_cast(unsigned, f); return (u + 0x7fffu + ((u >> 16) & 1u)) >> 16; }
__device__ __forceinline__ unsigned pk2(float lo, float hi) { return f2bf(lo) | (f2bf(hi) << 16); }
__device__ __forceinline__ float bflo(unsigned w) { return __builtin_bit_cast(float, w << 16); }
__device__ __forceinline__ float bfhi(unsigned w) { return __builtin_bit_cast(float, w & 0xffff0000u); }
__device__ __forceinline__ float sigm(float x) { return __builtin_amdgcn_rcpf(1.f + __expf(-x)); }
__device__ __forceinline__ float wave_sum(float v) {
#pragma unroll
    for (int o = 1; o < 64; o <<= 1) v += __shfl_xor(v, o);
    return v;
}
__device__ __forceinline__ float wave_max(float v) {
#pragma unroll
    for (int o = 1; o < 64; o <<= 1) v = fmaxf(v, __shfl_xor(v, o));
    return v;
}
__device__ __forceinline__ float dpp_sum63(float v) {
#define DPPF(x, ctrl, rm, bc) __builtin_bit_cast(float, __builtin_amdgcn_update_dpp(0, __builtin_bit_cast(int, x), ctrl, rm, 0xf, bc))
    v += DPPF(v, 0x111, 0xf, true); v += DPPF(v, 0x112, 0xf, true); v += DPPF(v, 0x114, 0xf, true); v += DPPF(v, 0x118, 0xf, true);
    v += DPPF(v, 0x142, 0xa, false); v += DPPF(v, 0x143, 0xc, false);
#undef DPPF
    return v;
}
__device__ __forceinline__ u32x4 pack8(const f32x4& a, const f32x4& b) { u32x4 w; w.x = pk2(a.x, a.y); w.y = pk2(a.z, a.w); w.z = pk2(b.x, b.y); w.w = pk2(b.z, b.w); return w; }
__device__ __forceinline__ void unpack8(const u32x4& w, f32x4& a, f32x4& b) { a = (f32x4){bflo(w.x), bfhi(w.x), bflo(w.y), bfhi(w.y)}; b = (f32x4){bflo(w.z), bfhi(w.z), bflo(w.w), bfhi(w.w)}; }

struct Ctx { int tid, lane, wave, gw, ngw, nblk, blk; LAS unsigned char* lds; };

struct Args { const float* in[22]; float* out; unsigned char* ws; int ph_lo, ph_hi; };
enum { I_X = 0, I_C, I_ADAW, I_ADAB, I_N1G, I_WIN, I_BIN, I_CONVW, I_CONVB, I_LNG, I_LNB, I_WCO, I_POOLW, I_POOLS, I_WOUT, I_BOUT, I_N2G, I_WQ, I_KEYS, I_PU, I_PV, I_FG };

__device__ __forceinline__ void transpose_item(const float* W, int K, int N, int k0, int n0, bf16* WT, int dstrow0, LAS float* scr, int lane) {
#pragma unroll 8
    for (int i = 0; i < 32; ++i) { const int kk = 2 * i + (lane >> 5); scr[kk * 33 + (lane & 31)] = W[(size_t)(k0 + kk) * N + n0 + (lane & 31)]; }
    asm volatile("s_waitcnt lgkmcnt(0)" ::: "memory");
    const int c = lane & 7;
#pragma unroll
    for (int j = 0; j < 4; ++j) { const int n = (lane >> 3) + 8 * j; const LAS float* s = scr + (8 * c) * 33 + n;
        u32x4 o; o.x = pk2(s[0 * 33], s[1 * 33]); o.y = pk2(s[2 * 33], s[3 * 33]); o.z = pk2(s[4 * 33], s[5 * 33]); o.w = pk2(s[6 * 33], s[7 * 33]);
        *(u32x4*)(WT + (size_t)(dstrow0 + n) * K + k0 + 8 * c) = o; }
    asm volatile("s_waitcnt lgkmcnt(0)" ::: "memory");
}
__device__ __forceinline__ int win_dstrow(int n0) {
    if (n0 < 1024) return 256 * (n0 >> 7) + (n0 & 127);
    if (n0 < 2048) { const int c = n0 - 1024; return 256 * (c >> 7) + 128 + (c & 127); }
    return n0;
}
__device__ __forceinline__ void phase_prep(const Ctx& C, const Args& a) {
    unsigned char* ws = a.ws;
    LAS float* scr = (LAS float*)(C.lds + C.wave * 16384);
    constexpr int I_IN = 16 * 160, I_CO = 16 * 32, I_PO = 4 * (4 * 8), I_OUT = 16 * 32, I_Q = 16 * 64, I_L = I_IN + I_CO + I_PO + I_OUT + I_Q;
    for (int it = C.gw; it < DEPTH * I_L; it += C.ngw) {
        const int l = it / I_L; int r = it % I_L;
        if (r < I_IN) { const int kb = r / 160, nb = r % 160; transpose_item(a.in[I_WIN] + (size_t)l * D * DIN, D, DIN, 64 * kb, 32 * nb, (bf16*)(ws + WS_WIN) + (size_t)l * DIN * D, win_dstrow(32 * nb), scr, C.lane); continue; } r -= I_IN;
        if (r < I_CO) { const int kb = r / 32, nb = r % 32; transpose_item(a.in[I_WCO] + (size_t)l * D * D, D, D, 64 * kb, 32 * nb, (bf16*)(ws + WS_WCO) + (size_t)l * D * D, 32 * nb, scr, C.lane); continue; } r -= I_CO;
        if (r < I_PO) { const int g = r / 32, q = r % 32, kb = q / 8, nb = q % 8; transpose_item(a.in[I_POOLW] + ((size_t)l * 4 + g) * 256 * 256, 256, 256, 64 * kb, 32 * nb, (bf16*)(ws + WS_POOL) + ((size_t)l * 1024 + 256 * g) * 256, 32 * nb, scr, C.lane); continue; } r -= I_PO;
        if (r < I_OUT) { const int kb = r / 32, nb = r % 32; transpose_item(a.in[I_WOUT] + (size_t)l * D * D, D, D, 64 * kb, 32 * nb, (bf16*)(ws + WS_WOUT) + (size_t)l * D * D, 32 * nb, scr, C.lane); continue; } r -= I_OUT;
        { const int kb = r / 64, nb = r % 64; transpose_item(a.in[I_WQ] + (size_t)l * D * DQ, D, DQ, 64 * kb, 32 * nb, (bf16*)(ws + WS_WQ) + (size_t)l * DQ * D, 32 * nb, scr, C.lane); }
    }
    const int gt = C.blk * NTHREADS + C.tid, ngt = C.nblk * NTHREADS;
    for (int i = gt; i < DEPTH * 2048 * 32; i += ngt) {
        const int l = i / (2048 * 32), r = i % (2048 * 32), n = r / 32, k8 = (r % 32) * 8;
        const int h = n >> 8, p = (n >> 7) & 1, key = n & 127, pk = k8 >> 7, kk = k8 & 127;
        u32x4 o = (u32x4){0u, 0u, 0u, 0u};
        if (pk == p) { const float* s = a.in[I_KEYS] + ((((size_t)l * 8 + h) * 2 + p) * 128 + key) * 128 + kk; const f32x4 v0 = *(const f32x4*)s, v1 = *(const f32x4*)(s + 4); o = pack8(v0, v1); }
        *(u32x4*)((bf16*)(ws + WS_KEYS) + ((size_t)l * 2048 + n) * 256 + k8) = o;
    }
    for (int t = 0; t < 2; ++t) {
        const float* src = a.in[t == 0 ? I_PU : I_PV]; unsigned char* dst = ws + (t == 0 ? WS_UB : WS_VB); float* scl = (float*)(ws + (t == 0 ? WS_USC : WS_VSC));
        for (int row = C.gw; row < DEPTH * NEXP; row += C.ngw) {
            const float* sp = src + (size_t)row * D + 16 * C.lane; f32x4 v[4]; float am = 0.f;
#pragma unroll
            for (int q = 0; q < 4; ++q) { v[q] = *(const f32x4*)(sp + 4 * q); am = fmaxf(am, fmaxf(fmaxf(fabsf(v[q].x), fabsf(v[q].y)), fmaxf(fabsf(v[q].z), fabsf(v[q].w)))); }
            am = wave_max(am);
            const float inv = am > 0.f ? 440.f / am : 0.f; u32x4 w;
#pragma unroll
            for (int q = 0; q < 4; ++q) { int p = __builtin_amdgcn_cvt_pk_fp8_f32(v[q].x * inv, v[q].y * inv, 0, false); p = __builtin_amdgcn_cvt_pk_fp8_f32(v[q].z * inv, v[q].w * inv, p, true); w[q] = (unsigned)p; }
            *(u32x4*)(dst + (size_t)row * D + 16 * C.lane) = w;
            if (C.lane == 0) scl[row] = am * (1.f / 440.f);
        }
    }
    for (int it = gt; it < 32 * 3072; it += ngt) {
        const int ks = it / 3072, cg = it % 3072, l = cg / 1536, n4 = (cg % 1536) * 4;
        f32x4 a0 = (f32x4){0.f, 0.f, 0.f, 0.f}, a1 = a0;
        const float* wp = a.in[I_ADAW] + ((size_t)l * D + ks * 32) * NMODV + n4; const float* c0 = a.in[I_C] + ks * 32; const float* c1 = c0 + D;
#pragma unroll 8
        for (int kk = 0; kk < 32; ++kk) { const f32x4 w = *(const f32x4*)(wp + (size_t)kk * NMODV); const float x0 = c0[kk], x1 = c1[kk]; a0 += w * (x0 * sigm(x0)); a1 += w * (x1 * sigm(x1)); }
        float* mp = (float*)(ws + WS_MODP) + (((size_t)ks * 2 + l) * 2) * NMODV + n4;
        *(f32x4*)mp = a0; *(f32x4*)(mp + NMODV) = a1;
    }
}
__device__ __forceinline__ void phase_modreduce(const Ctx& C, const Args& a) {
    const int gt = C.blk * NTHREADS + C.tid, ngt = C.nblk * NTHREADS;
    for (int i = gt; i < 2 * 2 * NMODV; i += ngt) {
        const int l = i / (2 * NMODV), n = i % NMODV; float s = a.in[I_ADAB][(size_t)l * NMODV + n];
        const float* mp = (const float*)(a.ws + WS_MODP) + i;
        for (int ks = 0; ks < 32; ++ks) s += mp[(size_t)ks * 4 * NMODV];
        ((float*)(a.ws + WS_MOD))[i] = s;
    }
}
__device__ __forceinline__ const float* modp(const Args& a, int l, int b, int v) { return (const float*)(a.ws + WS_MOD) + ((size_t)l * 2 + b) * NMODV + v * D; }

__device__ __forceinline__ void normmod_row(const f32x4 (&x)[4], const float* g, const float* sh, const float* sc, int lane, f32x4 (&h)[4]) {
    float s = 0.f;
#pragma unroll
    for (int j = 0; j < 4; ++j) s += (x[j].x * x[j].x + x[j].y * x[j].y) + (x[j].z * x[j].z + x[j].w * x[j].w);
    const float rstd = 1.f / sqrtf(wave_sum(s) * (1.f / D) + EPS);
#pragma unroll
    for (int j = 0; j < 4; ++j) { const int c = 4 * lane + 256 * j; const f32x4 gv = *(const f32x4*)(g + c), shv = *(const f32x4*)(sh + c), scv = *(const f32x4*)(sc + c);
        h[j] = (x[j] * rstd) * gv * (scv + 1.f) + shv; }
}
__device__ __forceinline__ void store_row_bf16(bf16* row, const f32x4 (&h)[4], int lane) {
#pragma unroll
    for (int j = 0; j < 4; ++j) { u32x2 w; w.x = pk2(h[j].x, h[j].y); w.y = pk2(h[j].z, h[j].w); *(u32x2*)(row + 4 * lane + 256 * j) = w; }
}
__device__ __forceinline__ void phase_norm(const Ctx& C, const Args& a, const float* X, const float* g, int l, int vsh, int vsc) {
    bf16* H = (bf16*)(a.ws + WS_H);
    for (int m = C.gw; m < M; m += C.ngw) {
        const int b = m >> 13; f32x4 x[4], h[4];
#pragma unroll
        for (int j = 0; j < 4; ++j) x[j] = *(const f32x4*)(X + (size_t)m * D + 4 * C.lane + 256 * j);
        normmod_row(x, g, modp(a, l, b, vsh), modp(a, l, b, vsc), C.lane, h);
        store_row_bf16(H + (size_t)m * D, h, C.lane);
    }
}

struct EpiIn {
    const float* bin; bf16 *UG, *ZP, *G;
    __device__ __forceinline__ void apply(int row, int pn, int cl8, f32x4 a0, f32x4 a1, f32x4 b0, f32x4 b1) const {
        if (pn < 8) {
            const int c = 128 * pn + cl8;
            a0 += *(const f32x4*)(bin + c); a1 += *(const f32x4*)(bin + c + 4); b0 += *(const f32x4*)(bin + 1024 + c); b1 += *(const f32x4*)(bin + 1024 + c + 4);
            f32x4 u0, u1;
#pragma unroll
            for (int i = 0; i < 4; ++i) { u0[i] = a0[i] * sigm(b0[i]); u1[i] = a1[i] * sigm(b1[i]); }
            *(u32x4*)(UG + (size_t)row * D + c) = pack8(u0, u1);
        } else if (pn < 12) {
            const int c = 256 * (pn - 8) + cl8;
            a0 += *(const f32x4*)(bin + 2048 + c); a1 += *(const f32x4*)(bin + 2048 + c + 4); b0 += *(const f32x4*)(bin + 2048 + 128 + c); b1 += *(const f32x4*)(bin + 2048 + 128 + c + 4);
            *(u32x4*)(ZP + (size_t)row * D + c) = pack8(a0, a1); *(u32x4*)(ZP + (size_t)row * D + c + 128) = pack8(b0, b1);
        } else {
            const int c = 256 * (pn - 12) + cl8;
            a0 += *(const f32x4*)(bin + 3072 + c); a1 += *(const f32x4*)(bin + 3072 + c + 4); b0 += *(const f32x4*)(bin + 3072 + 128 + c); b1 += *(const f32x4*)(bin + 3072 + 128 + c + 4);
#pragma unroll
            for (int i = 0; i < 4; ++i) { a0[i] = sigm(a0[i]); a1[i] = sigm(a1[i]); b0[i] = sigm(b0[i]); b1[i] = sigm(b1[i]); }
            *(u32x4*)(G + (size_t)row * 2048 + c) = pack8(a0, a1); *(u32x4*)(G + (size_t)row * 2048 + c + 128) = pack8(b0, b1);
        }
    }
};
struct EpiPool {
    const bf16* G; const float* scale; bf16* TMP;
    __device__ __forceinline__ void apply(int row, int pn, int cl8, f32x4 a0, f32x4 a1, f32x4 b0, f32x4 b1) const {
        const int c = 256 * pn + cl8; f32x4 g0, g1;
        unpack8(*(const u32x4*)(G + (size_t)row * 2048 + 1024 + c), g0, g1);
        a0 = a0 * g0 * *(const f32x4*)(scale + c); a1 = a1 * g1 * *(const f32x4*)(scale + c + 4);
        *(u32x4*)(TMP + (size_t)row * D + c) = pack8(a0, a1);
        unpack8(*(const u32x4*)(G + (size_t)row * 2048 + 1024 + c + 128), g0, g1);
        b0 = b0 * g0 * *(const f32x4*)(scale + c + 128); b1 = b1 * g1 * *(const f32x4*)(scale + c + 132);
        *(u32x4*)(TMP + (size_t)row * D + c + 128) = pack8(b0, b1);
    }
};
struct EpiConv {
    const bf16* G; const bf16* TMP; bf16* Y;
    __device__ __forceinline__ void apply(int row, int pn, int cl8, f32x4 a0, f32x4 a1, f32x4 b0, f32x4 b1) const {
        const int c = 256 * pn + cl8; f32x4 g0, g1, t0, t1;
        unpack8(*(const u32x4*)(G + (size_t)row * 2048 + c), g0, g1); unpack8(*(const u32x4*)(TMP + (size_t)row * D + c), t0, t1);
        *(u32x4*)(Y + (size_t)row * D + c) = pack8(a0 * g0 + t0, a1 * g1 + t1);
        unpack8(*(const u32x4*)(G + (size_t)row * 2048 + c + 128), g0, g1); unpack8(*(const u32x4*)(TMP + (size_t)row * D + c + 128), t0, t1);
        *(u32x4*)(Y + (size_t)row * D + c + 128) = pack8(b0 * g0 + t0, b1 * g1 + t1);
    }
};
struct EpiOut {
    const float* xold; float* xnew; const float* g1;   const float* bout;
    __device__ __forceinline__ void apply(int row, int pn, int cl8, f32x4 a0, f32x4 a1, f32x4 b0, f32x4 b1) const {
        const int c = 256 * pn + cl8; const float* g = g1 + (size_t)(row >> 13) * NMODV; const size_t o = (size_t)row * D + c;
        *(f32x4*)(xnew + o) = *(const f32x4*)(xold + o) + *(const f32x4*)(g + c) * (a0 + *(const f32x4*)(bout + c));
        *(f32x4*)(xnew + o + 4) = *(const f32x4*)(xold + o + 4) + *(const f32x4*)(g + c + 4) * (a1 + *(const f32x4*)(bout + c + 4));
        *(f32x4*)(xnew + o + 128) = *(const f32x4*)(xold + o + 128) + *(const f32x4*)(g + c + 128) * (b0 + *(const f32x4*)(bout + c + 128));
        *(f32x4*)(xnew + o + 132) = *(const f32x4*)(xold + o + 132) + *(const f32x4*)(g + c + 132) * (b1 + *(const f32x4*)(bout + c + 132));
    }
};
struct EpiQ {
    bf16* Q;
    __device__ __forceinline__ void apply(int row, int pn, int cl8, f32x4 a0, f32x4 a1, f32x4 b0, f32x4 b1) const {
        const size_t o = (size_t)row * DQ + 256 * pn + cl8; *(u32x4*)(Q + o) = pack8(a0, a1); *(u32x4*)(Q + o + 128) = pack8(b0, b1);
    }
};
struct EpiS {
    float* S;
    __device__ __forceinline__ void apply(int row, int pn, int cl8, f32x4 a0, f32x4 a1, f32x4 b0, f32x4 b1) const {
        const size_t o = (size_t)row * DQ + 256 * pn + cl8; *(f32x4*)(S + o) = a0; *(f32x4*)(S + o + 4) = a1; *(f32x4*)(S + o + 128) = b0; *(f32x4*)(S + o + 132) = b1;
    }
};

namespace pg8 {
#define PG8_LAS __attribute__((address_space(3)))
typedef unsigned short bf16_t;
typedef short bf16x8 __attribute__((ext_vector_type(8)));
typedef float f32x4 __attribute__((ext_vector_type(4)));
typedef unsigned u32x4 __attribute__((ext_vector_type(4)));
constexpr int BM = 256, BK = 64, HALF = 128, HTB = HALF * BK * 2  , STAGE_BYTES = 8 * HTB, NXCD = 8, WGM = 8;

__host__ __device__ __forceinline__ int lds_byte(int r, int c) { const int st = (r >> 4) * 2 + (c >> 5), rr = r & 15, cc = c & 31, ob = rr * 64 + cc * 2; return st * 1024 + (ob ^ (((ob >> 9) & 1) << 5)); }
__host__ __device__ __forceinline__ void stage_rc(int b, int& R, int& C) { const int st = b / 1024, sb = b % 1024, swz = sb ^ (((sb >> 9) & 1) << 5); R = (st >> 1) * 16 + swz / 64; C = (st & 1) * 32 + (swz % 64) / 2; }
__host__ __device__ __forceinline__ int perm32(int rho) { const int n = rho >> 4, i = rho & 15; return 8 * (i >> 2) + 4 * n + (i & 3); }

struct Unit { int pm, pn; };
struct Gemm { const bf16_t* A; const bf16_t* Bt; int M, N, K, lda, ldb, acol; };

struct StaticOrder {
    int nM, nN, nwg, G, c;
    __host__ __device__ void init(int M, int N, int G_, int c_) { nM = M / BM; nN = N / BM; nwg = nM * nN; G = G_; c = c_; }
    __host__ __device__ bool next(int i, Unit& u) const {
        const long L = (long)i * G + c; if (L >= nwg) return false;
        int wgid = (int)L; { const int q = nwg / NXCD, r = nwg % NXCD, xcd = wgid % NXCD, off = wgid / NXCD; wgid = (xcd < r ? xcd * (q + 1) : r * (q + 1) + (xcd - r) * q) + off; }
        const int nig = WGM * nN, gid = wgid / nig, fm = gid * WGM, gsz = (nM - fm) < WGM ? (nM - fm) : WGM;
        u.pm = fm + ((wgid % nig) % gsz); u.pn = (wgid % nig) / gsz; return true;
    }
    __device__ __forceinline__ void a_ready(const Unit&) const {}
    __device__ __forceinline__ void done(const Unit&) const {}
};


template <class Epi, class Sched, bool ALIGN_EPI = false, bool SP2 = false>
__device__ __forceinline__ void gemm_phase(PG8_LAS unsigned char* lds, const Gemm g, const Sched& S, const Epi& E, const int tid) {
    const int wid = __builtin_amdgcn_readfirstlane(tid >> 6), lane = tid & 63, wr = wid >> 2, wc = wid & 3, fr = lane & 15, fq = lane >> 4;
    const int K = g.K, nt = K / BK;
    unsigned voffA[2], voffB[2];
#pragma unroll
    for (int i = 0; i < 2; ++i) { int R, C; stage_rc(tid * 16 + i * 8192, R, C); const int Rb = Epi::PERM ? ((R & ~31) + perm32(R & 31)) : R;
        voffA[i] = (unsigned)(R * g.lda + C) * 2u; voffB[i] = (unsigned)(Rb * g.ldb + C) * 2u; }
    const size_t kstep = (size_t)(BK * 2);
    const size_t hstepA = (size_t)HALF * g.lda * 2, hstepB = (size_t)HALF * g.ldb * 2;
    const size_t tstepA = 2 * hstepA, tstepB = 2 * hstepB, acolb = (size_t)g.acol * 2;
    const unsigned ldsw = (unsigned)wid * 1024u;
    const int aoff = lds_byte(wr * 64 + fr, fq * 8), boff = lds_byte(wc * 32 + fr, fq * 8);
#define PG8_SA(b, h) (((b) * 2 + (h)) * HTB)
#define PG8_SB(b, h) ((4 + (b) * 2 + (h)) * HTB)
#define PG8_STAGE(bufoff, gbase, voff) do { _Pragma("unroll") for (int _i = 0; _i < 2; ++_i) \
        __builtin_amdgcn_global_load_lds((const unsigned*)((const char*)(gbase) + (voff)[_i]), (PG8_LAS unsigned*)(lds + (bufoff) + ldsw + _i * 8192), 16, 0, 0); } while (0)
#define PG8_LDA(dst, b, h) do { _Pragma("unroll") for (int m = 0; m < 4; ++m) _Pragma("unroll") for (int k = 0; k < 2; ++k) dst[m][k] = *(const PG8_LAS bf16x8*)(lds + PG8_SA(b, h) + aoff + m * 2048 + k * 1024); } while (0)
#define PG8_LDB(dst, b, h) do { _Pragma("unroll") for (int n = 0; n < 2; ++n) _Pragma("unroll") for (int k = 0; k < 2; ++k) dst[n][k] = *(const PG8_LAS bf16x8*)(lds + PG8_SB(b, h) + boff + n * 2048 + k * 1024); } while (0)
#define PG8_MMA(ai, bj, At, Bt) do { __builtin_amdgcn_s_setprio(1); _Pragma("unroll") for (int m = 0; m < 4; ++m) _Pragma("unroll") for (int n = 0; n < 2; ++n) _Pragma("unroll") for (int k = 0; k < 2; ++k) \
        acc[ai][bj][m][n] = __builtin_amdgcn_mfma_f32_16x16x32_bf16(Bt[n][k], At[m][k], acc[ai][bj][m][n], 0, 0, 0); __builtin_amdgcn_s_setprio(0); } while (0)
#define PG8_WAIT_V(n) asm volatile("s_waitcnt vmcnt(" #n ")" ::: "memory")
#define PG8_WAIT_L(n) asm volatile("s_waitcnt lgkmcnt(" #n ")" ::: "memory")
#define PG8_BAR __builtin_amdgcn_s_barrier()
#define PG8_SCHED __builtin_amdgcn_sched_barrier(0)
    Unit cur, nxt; int ui = 0;
    if (!S.next(0, cur)) return;
    f32x4 acc[2][2][4][2];
#pragma unroll
    for (int a = 0; a < 2; ++a)
#pragma unroll
        for (int b = 0; b < 2; ++b)
#pragma unroll
            for (int m = 0; m < 4; ++m)
#pragma unroll
                for (int n = 0; n < 2; ++n) acc[a][b][m][n] = (f32x4){0.f, 0.f, 0.f, 0.f};
    bf16x8 At[4][2], B0[2][2], B1[2][2];
    const char* cA = (const char*)g.A + (size_t)cur.pm * tstepA + (size_t)cur.pn * acolb; const char* cB = (const char*)g.Bt + (size_t)cur.pn * tstepB;
    S.a_ready(cur);
    if constexpr (SP2) {
        PG8_STAGE(PG8_SB(0, 0), cB, voffB); PG8_STAGE(PG8_SB(0, 1), cB + hstepB, voffB); PG8_STAGE(PG8_SA(0, 0), cA, voffA); PG8_STAGE(PG8_SA(0, 1), cA + hstepA, voffA);
        if (wr == 1) PG8_BAR;
        PG8_WAIT_V(2); PG8_BAR;
        PG8_STAGE(PG8_SB(1, 0), cB + kstep, voffB); PG8_STAGE(PG8_SA(1, 0), cA + kstep, voffA); PG8_STAGE(PG8_SB(1, 1), cB + hstepB + kstep, voffB);
        PG8_WAIT_V(6); PG8_BAR;
    } else {
        PG8_STAGE(PG8_SB(0, 0), cB, voffB); PG8_STAGE(PG8_SA(0, 0), cA, voffA); PG8_STAGE(PG8_SB(0, 1), cB + hstepB, voffB); PG8_STAGE(PG8_SA(0, 1), cA + hstepA, voffA);
        if (wr == 1) PG8_BAR;
        PG8_WAIT_V(4); PG8_BAR;
        PG8_STAGE(PG8_SB(1, 0), cB + kstep, voffB); PG8_STAGE(PG8_SA(1, 0), cA + kstep, voffA); PG8_STAGE(PG8_SB(1, 1), cB + hstepB + kstep, voffB);
        PG8_WAIT_V(6); PG8_BAR;
    }
    for (;;) {
        const bool has_next = S.next(ui + 1, nxt);
        const char* nA = has_next ? (const char*)g.A + (size_t)nxt.pm * tstepA + (size_t)nxt.pn * acolb : cA; const char* nB = has_next ? (const char*)g.Bt + (size_t)nxt.pn * tstepB : cB;
#pragma nounroll
        for (int t = 0; t < nt; t += 2) {
            const bool last = (t == nt - 2);
            const char* a1 = cA + (size_t)(t + 1) * kstep;
            const char* a2 = last ? nA : cA + (size_t)(t + 2) * kstep; const char* b2 = last ? nB : cB + (size_t)(t + 2) * kstep;
            const char* a3 = a2 + kstep; const char* b3 = b2 + kstep;
            if (last && has_next) S.a_ready(nxt);
            if constexpr (SP2) {
            PG8_LDB(B0, 0, 0); PG8_LDB(B1, 0, 1); PG8_SCHED; PG8_LDA(At, 0, 0); PG8_STAGE(PG8_SA(1, 1), a1 + hstepA, voffA);
            PG8_WAIT_V(8); PG8_WAIT_L(0); PG8_BAR; PG8_MMA(0, 0, At, B0); PG8_MMA(0, 1, At, B1); PG8_BAR; PG8_SCHED;
            PG8_LDA(At, 0, 1); PG8_STAGE(PG8_SB(0, 0), b2, voffB); PG8_STAGE(PG8_SB(0, 1), b2 + hstepB, voffB); PG8_STAGE(PG8_SA(0, 0), a2, voffA);
            PG8_WAIT_V(8); PG8_WAIT_L(0); PG8_BAR; PG8_MMA(1, 0, At, B0); PG8_MMA(1, 1, At, B1); PG8_BAR; PG8_SCHED;
            PG8_LDB(B0, 1, 0); PG8_LDB(B1, 1, 1); PG8_SCHED; PG8_LDA(At, 1, 0); PG8_STAGE(PG8_SA(0, 1), a2 + hstepA, voffA);
            PG8_WAIT_V(8); PG8_WAIT_L(0); PG8_BAR; PG8_MMA(0, 0, At, B0); PG8_MMA(0, 1, At, B1); PG8_BAR; PG8_SCHED;
            PG8_LDA(At, 1, 1); PG8_STAGE(PG8_SB(1, 0), b3, voffB); PG8_STAGE(PG8_SB(1, 1), b3 + hstepB, voffB); PG8_STAGE(PG8_SA(1, 0), a3, voffA);
            PG8_WAIT_V(8); PG8_WAIT_L(0); PG8_BAR; PG8_MMA(1, 0, At, B0); PG8_MMA(1, 1, At, B1); PG8_BAR; PG8_SCHED;
            } else {
            PG8_LDB(B0, 0, 0); PG8_SCHED; PG8_LDA(At, 0, 0); PG8_STAGE(PG8_SA(1, 1), a1 + hstepA, voffA);
            PG8_WAIT_L(8); PG8_BAR; PG8_WAIT_L(0); PG8_MMA(0, 0, At, B0); PG8_BAR; PG8_SCHED;
            PG8_LDB(B1, 0, 1); PG8_STAGE(PG8_SB(0, 0), b2, voffB);
            PG8_BAR; PG8_WAIT_L(0); PG8_MMA(0, 1, At, B1); PG8_BAR;
            PG8_LDA(At, 0, 1); PG8_STAGE(PG8_SA(0, 0), a2, voffA);
            PG8_BAR; PG8_WAIT_L(0); PG8_MMA(1, 0, At, B0); PG8_BAR; PG8_SCHED;
            PG8_STAGE(PG8_SB(0, 1), b2 + hstepB, voffB);
            PG8_WAIT_V(6); PG8_BAR; PG8_MMA(1, 1, At, B1); PG8_BAR;
            PG8_LDB(B0, 1, 0); PG8_SCHED; PG8_LDA(At, 1, 0); PG8_STAGE(PG8_SA(0, 1), a2 + hstepA, voffA);
            PG8_WAIT_L(8); PG8_BAR; PG8_WAIT_L(0); PG8_MMA(0, 0, At, B0); PG8_BAR; PG8_SCHED;
            PG8_LDB(B1, 1, 1); PG8_STAGE(PG8_SB(1, 0), b3, voffB);
            PG8_BAR; PG8_WAIT_L(0); PG8_MMA(0, 1, At, B1); PG8_BAR;
            PG8_LDA(At, 1, 1); PG8_STAGE(PG8_SA(1, 0), a3, voffA);
            PG8_BAR; PG8_WAIT_L(0); PG8_MMA(1, 0, At, B0); PG8_BAR; PG8_SCHED;
            PG8_STAGE(PG8_SB(1, 1), b3 + hstepB, voffB);
            PG8_WAIT_V(6); PG8_BAR; PG8_MMA(1, 1, At, B1); PG8_BAR;
            }
        }
        if constexpr (ALIGN_EPI) { if (wr == 0) PG8_BAR; }
        if constexpr (!Epi::AFTER_DRAIN) { E(acc, cur, wr, wc, fr, fq); S.done(cur); }
        if (!has_next) break;
#pragma unroll
        for (int a = 0; a < 2; ++a)
#pragma unroll
            for (int b = 0; b < 2; ++b)
#pragma unroll
                for (int m = 0; m < 4; ++m)
#pragma unroll
                    for (int n = 0; n < 2; ++n) acc[a][b][m][n] = (f32x4){0.f, 0.f, 0.f, 0.f};
        cur = nxt; cA = nA; cB = nB; ++ui;
        if constexpr (ALIGN_EPI) { if (wr == 1) PG8_BAR; }
    }
    PG8_WAIT_V(0);
    if constexpr (!ALIGN_EPI) { if (wr == 0) PG8_BAR; }
    PG8_BAR;
    if constexpr (Epi::AFTER_DRAIN) { E.fused(acc, cur, wr, wc, fr, fq, lds, wid, lane); S.done(cur); }
#undef PG8_SA
#undef PG8_SB
#undef PG8_STAGE
#undef PG8_LDA
#undef PG8_LDB
#undef PG8_MMA
#undef PG8_WAIT_V
#undef PG8_WAIT_L
#undef PG8_BAR
#undef PG8_SCHED
}

template <class F> struct EpiW {
    static constexpr bool PERM = true, AFTER_DRAIN = false; F f;
    __device__ __forceinline__ void operator()(const f32x4 (&acc)[2][2][4][2], const Unit& u, int wr, int wc, int fr, int fq) const {
#pragma unroll
        for (int ai = 0; ai < 2; ++ai)
#pragma unroll
            for (int m = 0; m < 4; ++m) { f.apply(u.pm * BM + ai * HALF + wr * 64 + m * 16 + fr, u.pn, wc * 32 + 8 * fq, acc[ai][0][m][0], acc[ai][0][m][1], acc[ai][1][m][0], acc[ai][1][m][1]);
                asm volatile("" ::: "memory"); }
    }
};
}

template <class F>
__device__ __forceinline__ void mfma_gemm(const Ctx& C, const bf16* A, int lda, int acol, const bf16* Bt, int ldb, int Mr, int N, int K, const F& f) {
    pg8::Gemm g{A, Bt, Mr, N, K, lda, ldb, acol}; pg8::StaticOrder S; S.init(Mr, N, C.nblk, C.blk); pg8::EpiW<F> E{f};
    pg8::gemm_phase<pg8::EpiW<F>, pg8::StaticOrder, true, true>(C.lds, g, S, E, C.tid);
}

template <class F>
__device__ __forceinline__ void naive_gemm(const Ctx& C, const bf16* A, int lda, int acol, const bf16* Bt, int ldb, int Mr, int N, int K, const F& f) {
    LAS float* As = (LAS float*)C.lds;
    LAS float* Bs = (LAS float*)(C.lds + 8192);
    const int ntm = Mr / 128, ntn = N / 256, tid = C.tid, cg = tid & 15, r0 = tid >> 4;
    for (int tile = C.blk; tile < ntm * ntn; tile += C.nblk) {
        const int tm = tile / ntn, pn = tile % ntn;
        f32x4 acc[4][4];
#pragma unroll
        for (int i = 0; i < 4; ++i)
#pragma unroll
            for (int j = 0; j < 4; ++j) acc[i][j] = (f32x4){0.f, 0.f, 0.f, 0.f};
        const bf16* ap = A + (size_t)(tm * 128 + (tid >> 2)) * lda + pn * acol + (tid & 3) * 4;
        const bf16* bp = Bt + (size_t)(pn * 256 + (tid >> 1)) * ldb + (tid & 1) * 8;
        for (int k0 = 0; k0 < K; k0 += 16) {
            const u32x2 av = *(const u32x2*)(ap + k0); const u32x4 bv = *(const u32x4*)(bp + k0);
            __syncthreads();
            { const int r = tid >> 2, kq = (tid & 3) * 4; As[(kq + 0) * 128 + r] = bflo(av.x); As[(kq + 1) * 128 + r] = bfhi(av.x); As[(kq + 2) * 128 + r] = bflo(av.y); As[(kq + 3) * 128 + r] = bfhi(av.y); }
            { const int n = tid >> 1, kq = (tid & 1) * 8; Bs[(kq + 0) * 256 + n] = bflo(bv.x); Bs[(kq + 1) * 256 + n] = bfhi(bv.x); Bs[(kq + 2) * 256 + n] = bflo(bv.y); Bs[(kq + 3) * 256 + n] = bfhi(bv.y);
              Bs[(kq + 4) * 256 + n] = bflo(bv.z); Bs[(kq + 5) * 256 + n] = bfhi(bv.z); Bs[(kq + 6) * 256 + n] = bflo(bv.w); Bs[(kq + 7) * 256 + n] = bfhi(bv.w); }
            __syncthreads();
#pragma unroll
            for (int kk = 0; kk < 16; ++kk) {
                const f32x4 b0 = *(const LAS f32x4*)(Bs + kk * 256 + cg * 8), b1 = *(const LAS f32x4*)(Bs + kk * 256 + cg * 8 + 4), b2 = *(const LAS f32x4*)(Bs + kk * 256 + 128 + cg * 8), b3 = *(const LAS f32x4*)(Bs + kk * 256 + 128 + cg * 8 + 4);
#pragma unroll
                for (int i = 0; i < 4; ++i) { const float av1 = As[kk * 128 + r0 + 32 * i]; acc[i][0] += b0 * av1; acc[i][1] += b1 * av1; acc[i][2] += b2 * av1; acc[i][3] += b3 * av1; }
            }
        }
#pragma unroll
        for (int i = 0; i < 4; ++i) f.apply(tm * 128 + r0 + 32 * i, pn, cg * 8, acc[i][0], acc[i][1], acc[i][2], acc[i][3]);
    }
}

template <int NROWS>
__device__ __forceinline__ void cp_stage(LAS unsigned char* tile, const bf16* src, int mrow0, int tfirst, int tid) {
    constexpr int NIT = (NROWS * 128 + NTHREADS - 1) / NTHREADS;
    asm volatile("" : "+v"(tid));
    u32x4 v[NIT];
#pragma unroll
    for (int i = 0; i < NIT; ++i) { const int ch = i * NTHREADS + tid, r = ch >> 7, c = ch & 127; v[i] = (u32x4){0u, 0u, 0u, 0u};
        if (ch < NROWS * 128 && tfirst + r >= 0) v[i] = *(const u32x4*)(src + (size_t)(mrow0 + r) * D + c * 8); }
#pragma unroll
    for (int i = 0; i < NIT; ++i) { const int ch = i * NTHREADS + tid; if (ch < NROWS * 128) *(LAS u32x4*)(tile + ch * 16) = v[i]; }
}
template <int W>
__device__ __forceinline__ void pool_item(const LAS unsigned char* tile, bf16* PL, int m0, int t0, int tid) {
    float p0[47], p1[47];
#pragma unroll
    for (int i = 0; i < 47; ++i) { unsigned w = 0u; if (i >= 15 - (W - 1)) w = *(const LAS unsigned*)(tile + i * 2048 + 4 * tid); p0[i] = bflo(w); p1[i] = bfhi(w); }
#pragma unroll
    for (int ti = 0; ti < 32; ++ti) {
        float s0 = 0.f, s1 = 0.f;
#pragma unroll
        for (int j = 0; j < W; ++j) { s0 += p0[ti + 15 - j]; s1 += p1[ti + 15 - j]; }
        const int cnt = (t0 + ti + 1) < W ? (t0 + ti + 1) : W; const float inv = 1.f / (float)cnt;
        *(unsigned*)(PL + (size_t)(m0 + ti) * D + 2 * tid) = pk2(s0 * inv - p0[ti + 15], s1 * inv - p1[ti + 15]);
    }
}
template <int RI>
__device__ __forceinline__ void conv_row(const LAS unsigned char* tile, int tid, const float (&w0)[31], const float (&w1)[31], float (&a0)[32], float (&a1)[32]) {
    const unsigned w = *(const LAS unsigned*)(tile + RI * 2048 + 4 * tid);
    const float u0 = bflo(w), u1 = bfhi(w);
#pragma unroll
    for (int ti = 0; ti < 32; ++ti) { constexpr int dbase = 30 - RI; const int d = ti + dbase; if (d >= 0 && d <= 30) { a0[ti] += w0[30 - d] * u0; a1[ti] += w1[30 - d] * u1; } }
    if constexpr ((RI & 7) == 7) asm volatile("" ::: "memory");
}
template <int... RI>
__device__ __forceinline__ void conv_rows(const LAS unsigned char* tile, int tid, const float (&w0)[31], const float (&w1)[31], float (&a0)[32], float (&a1)[32], std::integer_sequence<int, RI...>) {
    (conv_row<RI>(tile, tid, w0, w1, a0, a1), ...);
}
__device__ __forceinline__ void phase_convpool(const Ctx& C, const Args& a, int l) {
    const bf16* UG = (const bf16*)(a.ws + WS_UG); const bf16* ZP = (const bf16*)(a.ws + WS_ZP);
    bf16* AC = (bf16*)(a.ws + WS_AC); bf16* PL = (bf16*)(a.ws + WS_PL);
    const float* cw = a.in[I_CONVW] + (size_t)l * CONVK * D; const float* cb = a.in[I_CONVB] + (size_t)l * D;
    const float* lng = a.in[I_LNG] + (size_t)l * D; const float* lnb = a.in[I_LNB] + (size_t)l * D;
    LAS float* red = (LAS float*)C.lds;
    LAS float* stat = (LAS float*)(C.lds + 2048);
    LAS unsigned char* tile = C.lds + 4096;
    int tid = C.tid;
    asm volatile("" : "+v"(tid));
    const int c0 = 2 * tid;
    float w0[31], w1[31];
#pragma unroll
    for (int k = 0; k < 31; ++k) { const f32x2 w = *(const f32x2*)(cw + (size_t)k * D + c0); w0[k] = w.x; w1[k] = w.y; }
    const f32x2 bb = *(const f32x2*)(cb + c0), gg = *(const f32x2*)(lng + c0), be = *(const f32x2*)(lnb + c0);
    for (int item = C.blk; item < M / 32; item += C.nblk) {
        const int m0 = item * 32, t0 = m0 & (SEQ - 1);
        __syncthreads();
        cp_stage<62>(tile, UG, m0 - 30, t0 - 30, tid);
        __syncthreads();
        float a0[32], a1[32];
#pragma unroll
        for (int i = 0; i < 32; ++i) { a0[i] = bb.x; a1[i] = bb.y; }
        conv_rows(tile, tid, w0, w1, a0, a1, std::make_integer_sequence<int, 62>{});
#pragma unroll
        for (int ti = 0; ti < 32; ++ti) {
            const float s = dpp_sum63(a0[ti] + a1[ti]), q = dpp_sum63(a0[ti] * a0[ti] + a1[ti] * a1[ti]);
            if (C.lane == 63) { red[C.wave * 64 + ti] = s; red[C.wave * 64 + 32 + ti] = q; }
        }
        __syncthreads();
        if (tid < 32) { float s = 0.f, q = 0.f;
#pragma unroll
            for (int w = 0; w < 8; ++w) { s += red[w * 64 + tid]; q += red[w * 64 + 32 + tid]; }
            const float mean = s * (1.f / D), var = fmaxf(q * (1.f / D) - mean * mean, 0.f); stat[tid] = mean; stat[32 + tid] = 1.f / sqrtf(var + EPS); }
        __syncthreads();
#pragma unroll
        for (int ti = 0; ti < 32; ++ti) { const float mean = stat[ti], rstd = stat[32 + ti];
            const float y0 = (a0[ti] - mean) * rstd * gg.x + be.x, y1 = (a1[ti] - mean) * rstd * gg.y + be.y;
            *(unsigned*)(AC + (size_t)(m0 + ti) * D + c0) = pk2(y0 * sigm(y0), y1 * sigm(y1)); }
        asm volatile("" ::: "memory");
        cp_stage<47>(tile, ZP, m0 - 15, t0 - 15, tid);
        __syncthreads();
        const int g = tid >> 7;
        if (g == 0) pool_item<2>(tile, PL, m0, t0, tid); else if (g == 1) pool_item<4>(tile, PL, m0, t0, tid); else if (g == 2) pool_item<8>(tile, PL, m0, t0, tid); else pool_item<16>(tile, PL, m0, t0, tid);
    }
}

typedef unsigned u32;
template <int CTRL> __device__ __forceinline__ u32 dppu(u32 x) { return (u32)__builtin_amdgcn_update_dpp(0, (int)x, CTRL, 0xf, 0xf, true); }
constexpr int DPP_XOR1 = 0xB1, DPP_REV4 = 0x1B, DPP_DUPE = 0xA0, DPP_DUPO = 0xF5, DPP_HMIRROR = 0x141, DPP_MIRROR = 0x140;
__device__ __forceinline__ u32 umax_(u32 a, u32 b) { return a > b ? a : b; }
__device__ __forceinline__ u32 umin_(u32 a, u32 b) { return a < b ? a : b; }
#define TK_CE(x, i, j) do { const u32 hi_ = umax_(x[i], x[j]), lo_ = umin_(x[i], x[j]); x[i] = hi_; x[j] = lo_; } while (0)
__device__ __forceinline__ void tk_local_merge(u32 (&x)[8]) {
    TK_CE(x, 0, 4); TK_CE(x, 1, 5); TK_CE(x, 2, 6); TK_CE(x, 3, 7);
    TK_CE(x, 0, 2); TK_CE(x, 1, 3); TK_CE(x, 4, 6); TK_CE(x, 5, 7);
    TK_CE(x, 0, 1); TK_CE(x, 2, 3); TK_CE(x, 4, 5); TK_CE(x, 6, 7);
}
template <int CTRL> __device__ __forceinline__ void tk_level(u32 (&x)[8], bool even) {
    u32 t[8];
#pragma unroll
    for (int c = 0; c < 8; ++c) t[c] = dppu<CTRL>(x[7 - c]);
#pragma unroll
    for (int c = 0; c < 8; ++c) x[c] = umax_(x[c], t[c]);
#pragma unroll
    for (int c = 0; c < 8; ++c) { const u32 p = dppu<DPP_XOR1>(x[c]); x[c] = even ? umax_(x[c], p) : umin_(x[c], p); }
    tk_local_merge(x);
}
__device__ __forceinline__ void tk_top16(u32 (&x)[8], bool even) {
    TK_CE(x, 0, 1); TK_CE(x, 2, 3); TK_CE(x, 4, 5); TK_CE(x, 6, 7);
    TK_CE(x, 0, 2); TK_CE(x, 1, 3); TK_CE(x, 4, 6); TK_CE(x, 5, 7);
    TK_CE(x, 1, 2); TK_CE(x, 5, 6);
    TK_CE(x, 0, 4); TK_CE(x, 1, 5); TK_CE(x, 2, 6); TK_CE(x, 3, 7);
    TK_CE(x, 2, 4); TK_CE(x, 3, 5);
    TK_CE(x, 1, 2); TK_CE(x, 3, 4); TK_CE(x, 5, 6);
    { u32 t[8];
#pragma unroll
      for (int c = 0; c < 8; ++c) t[c] = dppu<DPP_XOR1>(x[7 - c]);
#pragma unroll
      for (int c = 0; c < 8; ++c) x[c] = even ? umax_(x[c], t[c]) : umin_(x[c], t[c]); }
    tk_local_merge(x);
    tk_level<DPP_REV4>(x, even); tk_level<DPP_HMIRROR>(x, even); tk_level<DPP_MIRROR>(x, even);
}
__device__ __forceinline__ u32 tk_f2key(float v, int slot) { const u32 u = __builtin_bit_cast(u32, v); const u32 k = u ^ ((u32)((int)u >> 31) | 0x80000000u); return (k & ~127u) | (u32)(127 - slot); }
__device__ __forceinline__ float tk_key2f(u32 k) { k &= ~127u; const u32 m = (u32)((int)k >> 31); return __builtin_bit_cast(float, k ^ (~m | 0x80000000u)); }
__device__ __forceinline__ u32 tk_sel8v(u32 r0, u32 r1, u32 r2, u32 r3, u32 r4, u32 r5, u32 r6, u32 r7, int idx) {
    const bool b0 = idx & 1, b1 = idx & 2, b2 = idx & 4;
    const u32 s01 = b0 ? r1 : r0, s23 = b0 ? r3 : r2, s45 = b0 ? r5 : r4, s67 = b0 ? r7 : r6;
    const u32 s03 = b1 ? s23 : s01, s47 = b1 ? s67 : s45;
    return b2 ? s47 : s03; }
#define tk_sel8(r, idx) tk_sel8v(r[0], r[1], r[2], r[3], r[4], r[5], r[6], r[7], idx)
__device__ __forceinline__ void phase_topk(const Ctx& C, const Args& a) {
    const float* S = (const float*)(a.ws + WS_S); int* EID = (int*)(a.ws + WS_EID); float* GW = (float*)(a.ws + WS_GW);
    const int lane = C.lane, r = lane & 15, q = lane >> 4; const bool even = (lane & 1) == 0;
    pg8::StaticOrder SO; SO.init(M, DQ, C.nblk, C.blk); pg8::Unit un;
    for (int ui = 0; SO.next(ui, un); ++ui)
    for (int wi = C.wave; wi < 64; wi += NWAVES) {
        const int tok = un.pm * 256 + wi * 4 + q, h = un.pn;
        u32 xa[8], xb[8];
        { const float* sp = S + (size_t)tok * DQ + h * 256 + 8 * r; const f32x4 v0 = *(const f32x4*)sp, v1 = *(const f32x4*)(sp + 4), w0 = *(const f32x4*)(sp + 128), w1 = *(const f32x4*)(sp + 132);
#pragma unroll
          for (int c = 0; c < 4; ++c) { xa[c] = tk_f2key(v0[c], 8 * r + c); xa[4 + c] = tk_f2key(v1[c], 8 * r + 4 + c); xb[c] = tk_f2key(w0[c], 8 * r + c); xb[4 + c] = tk_f2key(w1[c], 8 * r + 4 + c); } }
        tk_top16(xa, even); tk_top16(xb, even);
        u32 La[8], Ha[8], Lb[8], Hb[8];
#pragma unroll
        for (int c = 0; c < 8; ++c) { La[c] = dppu<DPP_DUPE>(xa[c]); Ha[c] = dppu<DPP_DUPO>(xa[c]); Lb[c] = dppu<DPP_DUPE>(xb[c]); Hb[c] = dppu<DPP_DUPO>(xb[c]); }
        const u32 a_lane = (r < 8) ? tk_sel8(La, r & 7) : tk_sel8(Ha, r & 7), b_lane = (r < 8) ? tk_sel8(Lb, r & 7) : tk_sel8(Hb, r & 7);
        const float va = tk_key2f(a_lane), vbl = tk_key2f(b_lane), va0 = tk_key2f(La[0]);
        u32 ck[8];
#pragma unroll
        for (int j = 0; j < 8; ++j) { constexpr int lim[8] = {15, 7, 4, 3, 2, 1, 1, 1};
            float v = va + tk_key2f(Lb[j]); bool valid = r <= lim[j];
            if (j == 1) { v = (r >= 8) ? va0 + vbl : v; valid = valid || (r >= 8); }
            ck[j] = valid ? tk_f2key(v, 8 * r + j) : 0u; }
        tk_top16(ck, even);
        const float mx = tk_key2f(dppu<DPP_DUPE>(ck[0]));
        float ex[8], sum = 0.f;
#pragma unroll
        for (int c = 0; c < 8; ++c) { ex[c] = __expf(tk_key2f(ck[c]) - mx); sum += ex[c]; }
        sum += __builtin_bit_cast(float, dppu<DPP_XOR1>(__builtin_bit_cast(u32, sum)));
        const float inv = 1.f / sum;
        int eo[8]; float go[8];
#pragma unroll
        for (int c = 0; c < 8; ++c) { const int slot = 127 - (int)(ck[c] & 127u), i = slot >> 3, j = slot & 7; const bool sp = (j == 1) && (i >= 8);
            const int i2 = sp ? 0 : i, j2 = sp ? i : j;
            const u32 ka = (u32)__builtin_amdgcn_ds_bpermute(((lane & ~15) + i2) << 2, (int)a_lane), kb = (u32)__builtin_amdgcn_ds_bpermute(((lane & ~15) + j2) << 2, (int)b_lane);
            eo[c] = (127 - (int)(ka & 127u)) * 128 + (127 - (int)(kb & 127u)); go[c] = ex[c] * inv; }
        if (r < 2) { int* ep = EID + (size_t)tok * 128 + h * 16 + r * 8; float* gp = GW + (size_t)tok * 128 + h * 16 + r * 8;
            *(u32x4*)ep = (u32x4){(u32)eo[0], (u32)eo[1], (u32)eo[2], (u32)eo[3]}; *(u32x4*)(ep + 4) = (u32x4){(u32)eo[4], (u32)eo[5], (u32)eo[6], (u32)eo[7]};
            *(f32x4*)gp = (f32x4){go[0], go[1], go[2], go[3]}; *(f32x4*)(gp + 4) = (f32x4){go[4], go[5], go[6], go[7]}; }
    }
}

__device__ __forceinline__ float dot2bf(unsigned w, unsigned x, float acc) { return __builtin_amdgcn_fdot2_f32_bf16(__builtin_bit_cast(bf16x2_t, w), __builtin_bit_cast(bf16x2_t, x), acc, false); }
constexpr int PNB = 8;
__device__ __forceinline__ void peer_load(u32x4 (&buf)[PNB], __amdgpu_buffer_rsrc_t T, int ev0, int ev1, int k0, int lane) {
    const int evs = (k0 < 64) ? ev0 : ev1;
#pragma unroll
    for (int i = 0; i < PNB; ++i) { const int e = __builtin_amdgcn_readlane(evs, (k0 & 63) + i); buf[i] = __builtin_bit_cast(u32x4, __builtin_amdgcn_raw_buffer_load_b128(T, 16 * lane, e * D, 0)); }
}
__device__ __forceinline__ void phase_peer(const Ctx& C, const Args& a, int l) {
    const __amdgpu_buffer_rsrc_t UB = __builtin_amdgcn_make_buffer_rsrc(a.ws + WS_UB + (size_t)l * NEXP * D, 0, NEXP * D, 0x00020000);
    const __amdgpu_buffer_rsrc_t VB = __builtin_amdgcn_make_buffer_rsrc(a.ws + WS_VB + (size_t)l * NEXP * D, 0, NEXP * D, 0x00020000);
    const float* USC = (const float*)(a.ws + WS_USC) + (size_t)l * NEXP; const float* VSC = (const float*)(a.ws + WS_VSC) + (size_t)l * NEXP;
    const int* EID = (const int*)(a.ws + WS_EID); const float* GW = (const float*)(a.ws + WS_GW);
    float* XW = a.out; bf16* H = (bf16*)(a.ws + WS_H);
    for (int m = C.gw; m < M; m += C.ngw) {
        unsigned z_ = 0u; asm volatile("" : "+v"(z_));
        int lane = (int)__builtin_amdgcn_mbcnt_hi(~0u, __builtin_amdgcn_mbcnt_lo(~0u, z_));
        const int b = m >> 13; f32x4 x[4], h[4];
        const int ev0 = EID[(size_t)m * 128 + lane], ev1 = EID[(size_t)m * 128 + 64 + lane];
        const float gwv0 = GW[(size_t)m * 128 + lane], gwv1 = GW[(size_t)m * 128 + 64 + lane];
        const float su0 = USC[ev0], su1 = USC[ev1], sv0 = VSC[ev0], sv1 = VSC[ev1];
#pragma unroll
        for (int q = 0; q < 4; ++q) x[q] = *(const f32x4*)(XW + (size_t)m * D + 16 * lane + 4 * q);
        { float ss = 0.f;
#pragma unroll
          for (int q = 0; q < 4; ++q) ss += (x[q].x * x[q].x + x[q].y * x[q].y) + (x[q].z * x[q].z + x[q].w * x[q].w);
          const float rstd = 1.f / sqrtf(wave_sum(ss) * (1.f / D) + EPS);
          const float* g = a.in[I_N2G] + (size_t)l * D; const float* sh = modp(a, l, b, 3); const float* sc = modp(a, l, b, 4);
#pragma unroll
          for (int q = 0; q < 4; ++q) { const int c = 16 * lane + 4 * q; h[q] = (x[q] * rstd) * *(const f32x4*)(g + c) * (*(const f32x4*)(sc + c) + 1.f) + *(const f32x4*)(sh + c); } }
        float dv0 = 0.f, dv1 = 0.f;
        u32x4 A[PNB], Bf[PNB];
#define PEER_DOT(buf, kbase) do { _Pragma("unroll") for (int i = 0; i < PNB; ++i) { float d = 0.f; \
            _Pragma("unroll") for (int q = 0; q < 4; ++q) { const f32x2 lo = __builtin_amdgcn_cvt_pk_f32_fp8((int)buf[i][q], false), hi = __builtin_amdgcn_cvt_pk_f32_fp8((int)buf[i][q], true); \
                d += lo.x * h[q].x; d += lo.y * h[q].y; d += hi.x * h[q].z; d += hi.y * h[q].w; } \
            d = dpp_sum63(d); const float tot = __builtin_bit_cast(float, __builtin_amdgcn_readlane(__builtin_bit_cast(int, d), 63)); const int kk = (kbase) + i; \
            dv0 = (lane == kk) ? tot : dv0; dv1 = (lane + 64 == kk) ? tot : dv1; __builtin_amdgcn_sched_barrier(0); } } while (0)
        peer_load(A, UB, ev0, ev1, 0, lane);
#pragma nounroll
        for (int k = 0; k < 128; k += 2 * PNB) {
            peer_load(Bf, UB, ev0, ev1, k + PNB, lane);
            PEER_DOT(A, k);
            if (k + 2 * PNB < 128) peer_load(A, UB, ev0, ev1, k + 2 * PNB, lane);
            PEER_DOT(Bf, k + PNB);
        }
#undef PEER_DOT
        dv0 *= su0; dv1 *= su1;
        const float cf0 = sv0 * gwv0 * 0.5f * dv0 * (1.f + erff(dv0 * 0.70710678118654752f)), cf1 = sv1 * gwv1 * 0.5f * dv1 * (1.f + erff(dv1 * 0.70710678118654752f));
        f32x4 o[4];
#pragma unroll
        for (int q = 0; q < 4; ++q) o[q] = (f32x4){0.f, 0.f, 0.f, 0.f};
#define PEER_ACC(buf, i, c) do { _Pragma("unroll") for (int q = 0; q < 4; ++q) { const f32x2 lo = __builtin_amdgcn_cvt_pk_f32_fp8((int)buf[i][q], false), hi = __builtin_amdgcn_cvt_pk_f32_fp8((int)buf[i][q], true); \
            o[q].x += c * lo.x; o[q].y += c * lo.y; o[q].z += c * hi.x; o[q].w += c * hi.y; } __builtin_amdgcn_sched_barrier(0); } while (0)
        peer_load(A, VB, ev0, ev1, 0, lane);
#pragma nounroll
        for (int k = 0; k < 128; k += 2 * PNB) {
            peer_load(Bf, VB, ev0, ev1, k + PNB, lane);
            { const int cfs = __builtin_bit_cast(int, k < 64 ? cf0 : cf1);
#pragma unroll
              for (int i = 0; i < PNB; ++i) { const float c = __builtin_bit_cast(float, __builtin_amdgcn_readlane(cfs, (k & 63) + i)); PEER_ACC(A, i, c); } }
            if (k + 2 * PNB < 128) peer_load(A, VB, ev0, ev1, k + 2 * PNB, lane);
            { const int cfs = __builtin_bit_cast(int, k < 64 ? cf0 : cf1);
#pragma unroll
              for (int i = 0; i < PNB; ++i) { const float c = __builtin_bit_cast(float, __builtin_amdgcn_readlane(cfs, (k & 63) + PNB + i)); PEER_ACC(Bf, i, c); } }
        }
#undef PEER_ACC
        asm volatile("" : "+v"(lane));
        const float* g2 = modp(a, l, b, 5);
#pragma unroll
        for (int q = 0; q < 4; ++q) x[q] = *(const f32x4*)(XW + (size_t)m * D + 16 * lane + 4 * q) + *(const f32x4*)(g2 + 16 * lane + 4 * q) * o[q];
        float ss = 0.f;
#pragma unroll
        for (int q = 0; q < 4; ++q) ss += (x[q].x * x[q].x + x[q].y * x[q].y) + (x[q].z * x[q].z + x[q].w * x[q].w);
        const float rstd = 1.f / sqrtf(wave_sum(ss) * (1.f / D) + EPS);
        if (l + 1 < DEPTH) {
            const float* g = a.in[I_N1G] + (size_t)(l + 1) * D; const float* sh = modp(a, l + 1, b, 0); const float* sc = modp(a, l + 1, b, 1);
            f32x4 hv[4];
#pragma unroll
            for (int q = 0; q < 4; ++q) { const int c = 16 * lane + 4 * q; *(f32x4*)(XW + (size_t)m * D + c) = x[q];
                hv[q] = (x[q] * rstd) * *(const f32x4*)(g + c) * (*(const f32x4*)(sc + c) + 1.f) + *(const f32x4*)(sh + c); }
            *(u32x4*)(H + (size_t)m * D + 16 * lane) = pack8(hv[0], hv[1]); *(u32x4*)(H + (size_t)m * D + 16 * lane + 8) = pack8(hv[2], hv[3]);
        } else {
#pragma unroll
            for (int q = 0; q < 4; ++q) { const int c = 16 * lane + 4 * q; *(f32x4*)(a.out + (size_t)m * D + c) = x[q] * rstd * *(const f32x4*)(a.in[I_FG] + c); }
        }
    }
}

#ifndef USE_NAIVE
#define GEMM mfma_gemm
#else
#define GEMM naive_gemm
#endif
#define RLX_AGENT __ATOMIC_RELAXED, __HIP_MEMORY_SCOPE_AGENT
#define XB_TMO      128
#define XB_XCNT(j)  (256  + 64 * (j))
#define XB_XSUB(j)  (1280 + 64 * (j))
#define XB_XGEN(j)  (2304 + 64 * (j))
#define XB_TOP      3328
#define XB_TOPGEN   3392
#define XCD_BAR_WORDS 3456
#define XB_SPIN_CAP (1u << 18)

__device__ __forceinline__ unsigned xb_ld(unsigned* p)              { return __hip_atomic_load(p, __ATOMIC_RELAXED, __HIP_MEMORY_SCOPE_AGENT); }
__device__ __forceinline__ unsigned xb_add(unsigned* p, unsigned v) { return __hip_atomic_fetch_add(p, v, __ATOMIC_RELAXED, __HIP_MEMORY_SCOPE_AGENT); }
__device__ __forceinline__ unsigned xb_xcc_id() { return (unsigned)__builtin_amdgcn_s_getreg((3 << 11) | 20) & 0xFu; }
#define XB_SPIN(cond, bar) do { unsigned _sp = 0; while (cond) { __builtin_amdgcn_s_sleep(1); \
    if ((++_sp & 255u) == 0u) { if (xb_ld(&(bar)[XB_TMO])) break; if (_sp > XB_SPIN_CAP) { atomicAdd(&(bar)[XB_TMO], 1u); break; } } } } while (0)

struct XcdBarrier {
    unsigned* bar; unsigned x;
    volatile LAS unsigned* st;
};

__device__ __forceinline__ XcdBarrier xcd_barrier_post(unsigned* bar, volatile LAS unsigned* st) {
    XcdBarrier b; b.bar = bar; b.x = xb_xcc_id(); b.st = st;
    if (threadIdx.x == 0) (void)xb_add(&bar[XB_XCNT(b.x)], 1u);
    return b;
}
__device__ __forceinline__ void xcd_barrier_complete(unsigned* bar, unsigned x, unsigned& nloc, unsigned& nx) {
    const unsigned G = gridDim.x * gridDim.y * gridDim.z;
    unsigned sum, cnt, mine, sp = 0u;
    for (;;) {
        sum = 0u; cnt = 0u; mine = 0u;
#pragma unroll
        for (unsigned j = 0; j < 16; ++j) { const unsigned c = xb_ld(&bar[XB_XCNT(j)]); sum += c; cnt += (c > 0u) ? 1u : 0u; mine = (j == x) ? c : mine; }
        if (sum == G) break;
        __builtin_amdgcn_s_sleep(1);
        if ((++sp & 255u) == 0u) { if (xb_ld(&bar[XB_TMO])) break; if (sp > XB_SPIN_CAP) { atomicAdd(&bar[XB_TMO], 1u); break; } }
    }
    nloc = mine > 0u ? mine : 1u; nx = cnt > 0u ? cnt : 1u;
}

__device__ __forceinline__ void xcd_barrier(const XcdBarrier& b, const int tid_) {
    asm volatile("s_waitcnt vmcnt(0)" ::: "memory");
    __syncthreads();
    if (tid_ == 0) {
        unsigned* bar = b.bar;
        __builtin_amdgcn_s_waitcnt(0);
        unsigned nloc = b.st[0], nx = b.st[1];
        if (nloc == 0u) { xcd_barrier_complete(bar, b.x, nloc, nx); b.st[0] = nloc; b.st[1] = nx; }
        const unsigned old = xb_add(&bar[XB_XSUB(b.x)], 1u);
        const unsigned gen = old / nloc;
        if (old + 1u == (gen + 1u) * nloc) {
            __builtin_amdgcn_fence(__ATOMIC_RELEASE, "agent");
            asm volatile("s_waitcnt vmcnt(0)" ::: "memory");
            const unsigned og = xb_add(&bar[XB_TOP], 1u);
            const unsigned tg = og / nx;
            if (og + 1u == (tg + 1u) * nx) xb_add(&bar[XB_TOPGEN], 1u);
            else XB_SPIN(xb_ld(&bar[XB_TOPGEN]) == tg, bar);
            __builtin_amdgcn_fence(__ATOMIC_ACQUIRE, "agent");
            xb_add(&bar[XB_XGEN(b.x)], 1u);
            asm volatile("s_waitcnt vmcnt(0)" ::: "memory");
        } else {
            XB_SPIN(xb_ld(&bar[XB_XGEN(b.x)]) == gen, bar);
            __builtin_amdgcn_fence(__ATOMIC_ACQUIRE, "agent");
            asm volatile("s_waitcnt vmcnt(0)" ::: "memory");
        }
    }
    __syncthreads();
}

constexpr int CW_BAR = 4096;
constexpr size_t CTL_ZERO_BYTES = 65536;
constexpr int LDSCTL_OFF = 131072, MISC_OFF = LDSCTL_OFF + 320;
constexpr int PH_PREP = 0, PH_MODR = 1, PH_N1 = 2, PH_L0 = 3, PH_PER_LAYER = 7, N_PHASES = PH_L0 + DEPTH * PH_PER_LAYER;
__device__ __forceinline__ Ctx make_ctx(LAS unsigned char* lds, int wave_s) {
    unsigned z_ = 0u; asm volatile("" : "+v"(z_));
    int tid_ = (wave_s << 6) | (int)__builtin_amdgcn_mbcnt_hi(~0u, __builtin_amdgcn_mbcnt_lo(~0u, z_)); asm volatile("" : "+v"(tid_));
    Ctx C; C.tid = tid_; C.lane = C.tid & 63; C.wave = __builtin_amdgcn_readfirstlane(C.tid >> 6); C.nblk = gridDim.x; C.blk = blockIdx.x;
    C.gw = C.blk * NWAVES + C.wave; C.ngw = C.nblk * NWAVES; C.lds = lds; return C;
}
#ifndef ONLYPH
#define ONLYPH -1
#endif
constexpr unsigned long long REP_MASK = 0ull;
#define PH(k, ...) if ((ONLYPH < 0 || ONLYPH == (k)) && a.ph_lo <= (k) && (k) < a.ph_hi) { for (int r_ = 0; r_ < 1 + (int)((REP_MASK >> (k)) & 1ull); ++r_) { const Ctx C = make_ctx(lds, wave_s); __VA_ARGS__; } if ((k) + 1 < a.ph_hi) xcd_barrier(bar, make_ctx(lds, wave_s).tid); }
template <int l>
__device__ __forceinline__ void run_layer(const Args& a, LAS unsigned char* lds, const XcdBarrier& bar, const int wave_s) {
    unsigned char* ws = a.ws; constexpr int B0 = PH_L0 + l * PH_PER_LAYER;
    PH(B0 + 0, EpiIn E{a.in[I_BIN] + (size_t)l * DIN, (bf16*)(ws + WS_UG), (bf16*)(ws + WS_ZP), (bf16*)(ws + WS_G)};
               GEMM(C, (const bf16*)(ws + WS_H), D, 0, (const bf16*)(ws + WS_WIN) + (size_t)l * DIN * D, D, M, DIN, D, E))
    PH(B0 + 1, phase_convpool(C, a, l))
    PH(B0 + 2, { EpiPool E{(const bf16*)(ws + WS_G), a.in[I_POOLS] + (size_t)l * D, (bf16*)(ws + WS_TMP)};
                 GEMM(C, (const bf16*)(ws + WS_PL), D, 256, (const bf16*)(ws + WS_POOL) + (size_t)l * 1024 * 256, 256, M, D, 256, E); }
               { const Ctx C2 = make_ctx(lds, wave_s); EpiConv E{(const bf16*)(ws + WS_G), (const bf16*)(ws + WS_TMP), (bf16*)(ws + WS_Y)};
                 GEMM(C2, (const bf16*)(ws + WS_AC), D, 0, (const bf16*)(ws + WS_WCO) + (size_t)l * D * D, D, M, D, D, E); })
    PH(B0 + 3, EpiOut E{l == 0 ? a.in[I_X] : a.out, a.out, modp(a, l, 0, 2), a.in[I_BOUT] + (size_t)l * D};
               GEMM(C, (const bf16*)(ws + WS_Y), D, 0, (const bf16*)(ws + WS_WOUT) + (size_t)l * D * D, D, M, D, D, E))
    PH(B0 + 4, phase_norm(C, a, a.out, a.in[I_N2G] + (size_t)l * D, l, 3, 4))
    PH(B0 + 5, { EpiQ E{(bf16*)(ws + WS_Q)}; GEMM(C, (const bf16*)(ws + WS_H), D, 0, (const bf16*)(ws + WS_WQ) + (size_t)l * DQ * D, D, M, DQ, D, E); }
               asm volatile("s_waitcnt vmcnt(0)" ::: "memory"); __syncthreads();
               { const Ctx C2 = make_ctx(lds, wave_s); EpiS E{(float*)(ws + WS_S)}; GEMM(C2, (const bf16*)(ws + WS_Q), DQ, 256, (const bf16*)(ws + WS_KEYS) + (size_t)l * 2048 * 256, 256, M, DQ, 256, E); }
               asm volatile("s_waitcnt vmcnt(0)" ::: "memory"); __syncthreads();
               { const Ctx C3 = make_ctx(lds, wave_s); phase_topk(C3, a); })
    PH(B0 + 6, phase_peer(C, a, l))
}
__global__ void __launch_bounds__(NTHREADS, 2) fwd_kernel(Args a) {
    extern __shared__ __attribute__((aligned(16))) unsigned char lds_raw[];
    LAS unsigned char* lds = (LAS unsigned char*)lds_raw;
    for (int u = threadIdx.x; u < (LDS_BYTES - LDSCTL_OFF) / 4; u += NTHREADS) ((LAS unsigned*)(lds + LDSCTL_OFF))[u] = 0u;
    __syncthreads();
    const int wave_s = __builtin_amdgcn_readfirstlane((int)threadIdx.x >> 6);
    const XcdBarrier bar = xcd_barrier_post((unsigned*)(a.ws + WS_CTL) + CW_BAR, (volatile LAS unsigned*)(lds + MISC_OFF) + 8);
    PH(PH_PREP, phase_prep(C, a))
    PH(PH_MODR, phase_modreduce(C, a))
    PH(PH_N1, phase_norm(C, a, a.in[I_X], a.in[I_N1G], 0, 0, 1))
    run_layer<0>(a, lds, bar, wave_s);
    run_layer<1>(a, lds, bar, wave_s);
}

extern "C" void kernel_launch(void* const* d_in, const int* in_sizes, int n_in, void* d_out, int out_size, void* d_ws, size_t ws_size, hipStream_t stream) {
    static int grid = 0;
    if (grid == 0) {
        if (n_in != 22 || out_size != M * D || ws_size < WS_END) { fprintf(stderr, "kernel_launch: unexpected shapes (n_in %d out %d ws %zu)\n", n_in, out_size, ws_size); grid = -1; return; }
        int dev = 0, cus = 0;
        if (hipGetDevice(&dev) != hipSuccess || hipDeviceGetAttribute(&cus, hipDeviceAttributeMultiprocessorCount, dev) != hipSuccess) { grid = -1; return; }
        if (hipFuncSetAttribute((const void*)fwd_kernel, hipFuncAttributeMaxDynamicSharedMemorySize, LDS_BYTES) != hipSuccess) { grid = -1; return; }
        grid = cus;
    }
    if (grid < 0) return;
    Args a{};
    for (int i = 0; i < 22; ++i) a.in[i] = (const float*)d_in[i];
    a.out = (float*)d_out; a.ws = (unsigned char*)d_ws;
    (void)hipMemsetAsync((char*)d_ws + WS_CTL, 0, CTL_ZERO_BYTES, stream);
#ifndef ONE_LAUNCH
    for (int ph = 0; ph < N_PHASES; ++ph) { a.ph_lo = ph; a.ph_hi = ph + 1; hipLaunchKernelGGL(fwd_kernel, dim3(grid), dim3(NTHREADS), LDS_BYTES, stream, a); }
#else
    a.ph_lo = 0; a.ph_hi = N_PHASES; hipLaunchKernelGGL(fwd_kernel, dim3(grid), dim3(NTHREADS), LDS_BYTES, stream, a);
#endif
}
```

```cpp
#define ONE_LAUNCH 1
#include <hip/hip_runtime.h>
#include <cstdint>
#include <cstdio>
#include <utility>

#define GAS __attribute__((address_space(1)))
#define LAS __attribute__((address_space(3)))
typedef unsigned short bf16;
typedef float f32x4 __attribute__((ext_vector_type(4)));
typedef float f32x2 __attribute__((ext_vector_type(2)));
typedef unsigned u32x4 __attribute__((ext_vector_type(4)));
typedef unsigned u32x2 __attribute__((ext_vector_type(2)));
typedef __bf16 bf16x2_t __attribute__((ext_vector_type(2)));

constexpr int BATCH = 2, SEQ = 8192, D = 1024, M = BATCH * SEQ, DEPTH = 2;
constexpr int DIN = 5120, NMODV = 6 * D, CONVK = 31, NHEAD = 8, NKEYS = 128, DQ = 2048, TOPK = 16, NEXP = 16384;
constexpr float EPS = 1e-6f;
constexpr int NWAVES = 8, NTHREADS = NWAVES * 64;

constexpr size_t MiB = 1u << 20;
constexpr size_t WS_CTL = 0;
constexpr size_t WS_MODP = 1 * MiB;
constexpr size_t WS_MOD = 4 * MiB;
constexpr size_t WS_WIN = 8 * MiB;
constexpr size_t WS_WCO = 28 * MiB;
constexpr size_t WS_WOUT = 32 * MiB;
constexpr size_t WS_WQ = 36 * MiB;
constexpr size_t WS_POOL = 44 * MiB;
constexpr size_t WS_KEYS = 45 * MiB;
constexpr size_t WS_UB = 48 * MiB;
constexpr size_t WS_USC = 80 * MiB;
constexpr size_t WS_VSC = 81 * MiB;
constexpr size_t WS_VB = 112 * MiB;
constexpr size_t WS_H = 176 * MiB;
constexpr size_t WS_UG = 208 * MiB;
constexpr size_t WS_Y = WS_UG;
constexpr size_t WS_ZP = 240 * MiB;
constexpr size_t WS_TMP = WS_ZP;
constexpr size_t WS_Q = WS_UG;
constexpr size_t WS_G = 272 * MiB;
constexpr size_t WS_AC = 336 * MiB;
constexpr size_t WS_PL = 368 * MiB;
constexpr size_t WS_S = WS_G;
constexpr size_t WS_EID = 400 * MiB;
constexpr size_t WS_GW = 408 * MiB;
constexpr size_t WS_COEF = 416 * MiB;
constexpr size_t WS_HSC = 424 * MiB;
constexpr size_t WS_PD = WS_S;
constexpr size_t WS_END = 425 * MiB;

constexpr int LDS_BYTES = 147456;

__device__ __forceinline__ unsigned f2bf(float f) { unsigned u = __builtin_bit_cast(unsigned, f); return (u + 0x7fffu + ((u >> 16) & 1u)) >> 16; }
__device__ __forceinline__ unsigned pk2(float lo, float hi) { return f2bf(lo) | (f2bf(hi) << 16); }
__device__ __forceinline__ float bflo(unsigned w) { return __builtin_bit_cast(float, w << 16); }
__device__ __forceinline__ float bfhi(unsigned w) { return __builtin_bit_cast(float, w & 0xffff0000u); }
__device__ __forceinline__ float sigm(float x) { return __builtin_amdgcn_rcpf(1.f + __expf(-x)); }
__device__ __forceinline__ float wave_sum(float v) {
#pragma unroll
    for (int o = 1; o < 64; o <<= 1) v += __shfl_xor(v, o);
    return v;
}
__device__ __forceinline__ float wave_max(float v) {
#pragma unroll
    for (int o = 1; o < 64; o <<= 1) v = fmaxf(v, __shfl_xor(v, o));
    return v;
}
__device__ __forceinline__ float dpp_sum63(float v) {
#define DPPF(x, ctrl, rm, bc) __builtin_bit_cast(float, __builtin_amdgcn_update_dpp(0, __builtin_bit_cast(int, x), ctrl, rm, 0xf, bc))
    v += DPPF(v, 0x111, 0xf, true); v += DPPF(v, 0x112, 0xf, true); v += DPPF(v, 0x114, 0xf, true); v += DPPF(v, 0x118, 0xf, true);
    v += DPPF(v, 0x142, 0xa, false); v += DPPF(v, 0x143, 0xc, false);
#undef DPPF
    return v;
}
__device__ __forceinline__ u32x4 pack8(const f32x4& a, const f32x4& b) { u32x4 w; w.x = pk2(a.x, a.y); w.y = pk2(a.z, a.w); w.z = pk2(b.x, b.y); w.w = pk2(b.z, b.w); return w; }
__device__ __forceinline__ void unpack8(const u32x4& w, f32x4& a, f32x4& b) { a = (f32x4){bflo(w.x), bfhi(w.x), bflo(w.y), bfhi(w.y)}; b = (f32x4){bflo(w.z), bfhi(w.z), bflo(w.w), bfhi(w.w)}; }

struct Ctx { int tid, lane, wave, gw, ngw, nblk, blk; LAS unsigned char* lds; };

struct Args { const float* in[22]; float* out; unsigned char* ws; int ph_lo, ph_hi; };
enum { I_X = 0, I_C, I_ADAW, I_ADAB, I_N1G, I_WIN, I_BIN, I_CONVW, I_CONVB, I_LNG, I_LNB, I_WCO, I_POOLW, I_POOLS, I_WOUT, I_BOUT, I_N2G, I_WQ, I_KEYS, I_PU, I_PV, I_FG };

__device__ __forceinline__ void transpose_item(const float* W, int K, int N, int k0, int n0, bf16* WT, int dstrow0, LAS float* scr, int lane) {
#pragma unroll 8
    for (int i = 0; i < 32; ++i) { const int kk = 2 * i + (lane >> 5); scr[kk * 33 + (lane & 31)] = W[(size_t)(k0 + kk) * N + n0 + (lane & 31)]; }
    asm volatile("s_waitcnt lgkmcnt(0)" ::: "memory");
    const int c = lane & 7;
#pragma unroll
    for (int j = 0; j < 4; ++j) { const int n = (lane >> 3) + 8 * j; const LAS float* s = scr + (8 * c) * 33 + n;
        u32x4 o; o.x = pk2(s[0 * 33], s[1 * 33]); o.y = pk2(s[2 * 33], s[3 * 33]); o.z = pk2(s[4 * 33], s[5 * 33]); o.w = pk2(s[6 * 33], s[7 * 33]);
        *(u32x4*)(WT + (size_t)(dstrow0 + n) * K + k0 + 8 * c) = o; }
    asm volatile("s_waitcnt lgkmcnt(0)" ::: "memory");
}
__device__ __forceinline__ int win_dstrow(int n0) {
    if (n0 < 1024) return 256 * (n0 >> 7) + (n0 & 127);
    if (n0 < 2048) { const int c = n0 - 1024; return 256 * (c >> 7) + 128 + (c & 127); }
    return n0;
}
__device__ __forceinline__ void phase_prep(const Ctx& C, const Args& a) {
    unsigned char* ws = a.ws;
    LAS float* scr = (LAS float*)(C.lds + C.wave * 16384);
    constexpr int I_IN = 16 * 160, I_CO = 16 * 32, I_PO = 4 * (4 * 8), I_OUT = 16 * 32, I_Q = 16 * 64, I_L = I_IN + I_CO + I_PO + I_OUT + I_Q;
    for (int it = C.gw; it < DEPTH * I_L; it += C.ngw) {
        const int l = it / I_L; int r = it % I_L;
        if (r < I_IN) { const int kb = r / 160, nb = r % 160; transpose_item(a.in[I_WIN] + (size_t)l * D * DIN, D, DIN, 64 * kb, 32 * nb, (bf16*)(ws + WS_WIN) + (size_t)l * DIN * D, win_dstrow(32 * nb), scr, C.lane); continue; } r -= I_IN;
        if (r < I_CO) { const int kb = r / 32, nb = r % 32; transpose_item(a.in[I_WCO] + (size_t)l * D * D, D, D, 64 * kb, 32 * nb, (bf16*)(ws + WS_WCO) + (size_t)l * D * D, 32 * nb, scr, C.lane); continue; } r -= I_CO;
        if (r < I_PO) { const int g = r / 32, q = r % 32, kb = q / 8, nb = q % 8; transpose_item(a.in[I_POOLW] + ((size_t)l * 4 + g) * 256 * 256, 256, 256, 64 * kb, 32 * nb, (bf16*)(ws + WS_POOL) + ((size_t)l * 1024 + 256 * g) * 256, 32 * nb, scr, C.lane); continue; } r -= I_PO;
        if (r < I_OUT) { const int kb = r / 32, nb = r % 32; transpose_item(a.in[I_WOUT] + (size_t)l * D * D, D, D, 64 * kb, 32 * nb, (bf16*)(ws + WS_WOUT) + (size_t)l * D * D, 32 * nb, scr, C.lane); continue; } r -= I_OUT;
        { const int kb = r / 64, nb = r % 64; transpose_item(a.in[I_WQ] + (size_t)l * D * DQ, D, DQ, 64 * kb, 32 * nb, (bf16*)(ws + WS_WQ) + (size_t)l * DQ * D, 32 * nb, scr, C.lane); }
    }
    const int gt = C.blk * NTHREADS + C.tid, ngt = C.nblk * NTHREADS;
    for (int i = gt; i < DEPTH * 2048 * 32; i += ngt) {
        const int l = i / (2048 * 32), r = i % (2048 * 32), n = r / 32, k8 = (r % 32) * 8;
        const int h = n >> 8, p = (n >> 7) & 1, key = n & 127, pk = k8 >> 7, kk = k8 & 127;
        u32x4 o = (u32x4){0u, 0u, 0u, 0u};
        if (pk == p) { const float* s = a.in[I_KEYS] + ((((size_t)l * 8 + h) * 2 + p) * 128 + key) * 128 + kk; const f32x4 v0 = *(const f32x4*)s, v1 = *(const f32x4*)(s + 4); o = pack8(v0, v1); }
        *(u32x4*)((bf16*)(ws + WS_KEYS) + ((size_t)l * 2048 + n) * 256 + k8) = o;
    }
    for (int t = 0; t < 2; ++t) {
        const float* src = a.in[t == 0 ? I_PU : I_PV]; unsigned char* dst = ws + (t == 0 ? WS_UB : WS_VB); float* scl = (float*)(ws + (t == 0 ? WS_USC : WS_VSC));
        const float qmax = t == 0 ? 127.f : 440.f;
        for (int row = C.gw; row < DEPTH * NEXP; row += C.ngw) {
            const float* sp = src + (size_t)row * D + 16 * C.lane; f32x4 v[4]; float am = 0.f;
#pragma unroll
            for (int q = 0; q < 4; ++q) { v[q] = *(const f32x4*)(sp + 4 * q); am = fmaxf(am, fmaxf(fmaxf(fabsf(v[q].x), fabsf(v[q].y)), fmaxf(fabsf(v[q].z), fabsf(v[q].w)))); }
            am = wave_max(am);
            const float inv = am > 0.f ? qmax / am : 0.f; u32x4 w;
            if (t == 0) {
#pragma unroll
                for (int q = 0; q < 4; ++q) w[q] = ((unsigned)(int)rintf(v[q].x * inv) & 255u) | (((unsigned)(int)rintf(v[q].y * inv) & 255u) << 8) | (((unsigned)(int)rintf(v[q].z * inv) & 255u) << 16) | ((unsigned)(int)rintf(v[q].w * inv) << 24);
                const int lyr = row / NEXP, e = row % NEXP;
                *(u32x4*)(dst + (((size_t)lyr * 8 + (C.lane >> 3)) * NEXP + e) * 128 + 16 * (C.lane & 7)) = w;
            } else {
#pragma unroll
                for (int q = 0; q < 4; ++q) { int p = __builtin_amdgcn_cvt_pk_fp8_f32(v[q].x * inv, v[q].y * inv, 0, false); p = __builtin_amdgcn_cvt_pk_fp8_f32(v[q].z * inv, v[q].w * inv, p, true); w[q] = (unsigned)p; }
                *(u32x4*)(dst + (size_t)row * D + 16 * C.lane) = w;
            }
            if (C.lane == 0) scl[row] = am / qmax;
        }
    }
    for (int it = gt; it < 32 * 3072; it += ngt) {
        const int ks = it / 3072, cg = it % 3072, l = cg / 1536, n4 = (cg % 1536) * 4;
        f32x4 a0 = (f32x4){0.f, 0.f, 0.f, 0.f}, a1 = a0;
        const float* wp = a.in[I_ADAW] + ((size_t)l * D + ks * 32) * NMODV + n4; const float* c0 = a.in[I_C] + ks * 32; const float* c1 = c0 + D;
#pragma unroll 8
        for (int kk = 0; kk < 32; ++kk) { const f32x4 w = *(const f32x4*)(wp + (size_t)kk * NMODV); const float x0 = c0[kk], x1 = c1[kk]; a0 += w * (x0 * sigm(x0)); a1 += w * (x1 * sigm(x1)); }
        float* mp = (float*)(ws + WS_MODP) + (((size_t)ks * 2 + l) * 2) * NMODV + n4;
        *(f32x4*)mp = a0; *(f32x4*)(mp + NMODV) = a1;
    }
}
__device__ __forceinline__ void phase_modreduce(const Ctx& C, const Args& a) {
    const int gt = C.blk * NTHREADS + C.tid, ngt = C.nblk * NTHREADS;
    for (int i = gt; i < 2 * 2 * NMODV; i += ngt) {
        const int l = i / (2 * NMODV), n = i % NMODV; float s = a.in[I_ADAB][(size_t)l * NMODV + n];
        const float* mp = (const float*)(a.ws + WS_MODP) + i;
        for (int ks = 0; ks < 32; ++ks) s += mp[(size_t)ks * 4 * NMODV];
        ((float*)(a.ws + WS_MOD))[i] = s;
    }
}
__device__ __forceinline__ const float* modp(const Args& a, int l, int b, int v) { return (const float*)(a.ws + WS_MOD) + ((size_t)l * 2 + b) * NMODV + v * D; }

__device__ __forceinline__ void normmod_row(const f32x4 (&x)[4], const float* g, const float* sh, const float* sc, int lane, f32x4 (&h)[4]) {
    float s = 0.f;
#pragma unroll
    for (int j = 0; j < 4; ++j) s += (x[j].x * x[j].x + x[j].y * x[j].y) + (x[j].z * x[j].z + x[j].w * x[j].w);
    const float rstd = 1.f / sqrtf(wave_sum(s) * (1.f / D) + EPS);
#pragma unroll
    for (int j = 0; j < 4; ++j) { const int c = 4 * lane + 256 * j; const f32x4 gv = *(const f32x4*)(g + c), shv = *(const f32x4*)(sh + c), scv = *(const f32x4*)(sc + c);
        h[j] = (x[j] * rstd) * gv * (scv + 1.f) + shv; }
}
__device__ __forceinline__ void store_row_bf16(bf16* row, const f32x4 (&h)[4], int lane) {
#pragma unroll
    for (int j = 0; j < 4; ++j) { u32x2 w; w.x = pk2(h[j].x, h[j].y); w.y = pk2(h[j].z, h[j].w); *(u32x2*)(row + 4 * lane + 256 * j) = w; }
}
__device__ __forceinline__ void phase_norm(const Ctx& C, const Args& a, const float* X, const float* g, int l, int vsh, int vsc, float* hsc) {
    bf16* H = (bf16*)(a.ws + WS_H);
    for (int m = C.gw; m < M; m += C.ngw) {
        const int b = m >> 13; f32x4 x[4], h[4];
#pragma unroll
        for (int j = 0; j < 4; ++j) x[j] = *(const f32x4*)(X + (size_t)m * D + 4 * C.lane + 256 * j);
        normmod_row(x, g, modp(a, l, b, vsh), modp(a, l, b, vsc), C.lane, h);
        store_row_bf16(H + (size_t)m * D, h, C.lane);
        if (hsc) { float am = 0.f;
#pragma unroll
            for (int j = 0; j < 4; ++j) { const unsigned w0 = pk2(h[j].x, h[j].y), w1 = pk2(h[j].z, h[j].w); am = fmaxf(am, fmaxf(fmaxf(fabsf(bflo(w0)), fabsf(bfhi(w0))), fmaxf(fabsf(bflo(w1)), fabsf(bfhi(w1))))); }
            am = wave_max(am); if (C.lane == 0) hsc[m] = am * (1.f / 127.f); }
    }
}

struct EpiIn {
    const float* bin; bf16 *UG, *ZP, *G;
    __device__ __forceinline__ void apply(int row, int pn, int cl8, f32x4 a0, f32x4 a1, f32x4 b0, f32x4 b1) const {
        if (pn < 8) {
            const int c = 128 * pn + cl8;
            a0 += *(const f32x4*)(bin + c); a1 += *(const f32x4*)(bin + c + 4); b0 += *(const f32x4*)(bin + 1024 + c); b1 += *(const f32x4*)(bin + 1024 + c + 4);
            f32x4 u0, u1;
#pragma unroll
            for (int i = 0; i < 4; ++i) { u0[i] = a0[i] * sigm(b0[i]); u1[i] = a1[i] * sigm(b1[i]); }
            *(u32x4*)(UG + (size_t)row * D + c) = pack8(u0, u1);
        } else if (pn < 12) {
            const int c = 256 * (pn - 8) + cl8;
            a0 += *(const f32x4*)(bin + 2048 + c); a1 += *(const f32x4*)(bin + 2048 + c + 4); b0 += *(const f32x4*)(bin + 2048 + 128 + c); b1 += *(const f32x4*)(bin + 2048 + 128 + c + 4);
            *(u32x4*)(ZP + (size_t)row * D + c) = pack8(a0, a1); *(u32x4*)(ZP + (size_t)row * D + c + 128) = pack8(b0, b1);
        } else {
            const int c = 256 * (pn - 12) + cl8;
            a0 += *(const f32x4*)(bin + 3072 + c); a1 += *(const f32x4*)(bin + 3072 + c + 4); b0 += *(const f32x4*)(bin + 3072 + 128 + c); b1 += *(const f32x4*)(bin + 3072 + 128 + c + 4);
#pragma unroll
            for (int i = 0; i < 4; ++i) { a0[i] = sigm(a0[i]); a1[i] = sigm(a1[i]); b0[i] = sigm(b0[i]); b1[i] = sigm(b1[i]); }
            *(u32x4*)(G + (size_t)row * 2048 + c) = pack8(a0, a1); *(u32x4*)(G + (size_t)row * 2048 + c + 128) = pack8(b0, b1);
        }
    }
};
struct EpiPool {
    const bf16* G; const float* scale; bf16* TMP;
    __device__ __forceinline__ void apply(int row, int pn, int cl8, f32x4 a0, f32x4 a1, f32x4 b0, f32x4 b1) const {
        const int c = 256 * pn + cl8; f32x4 g0, g1;
        unpack8(*(const u32x4*)(G + (size_t)row * 2048 + 1024 + c), g0, g1);
        a0 = a0 * g0 * *(const f32x4*)(scale + c); a1 = a1 * g1 * *(const f32x4*)(scale + c + 4);
        *(u32x4*)(TMP + (size_t)row * D + c) = pack8(a0, a1);
        unpack8(*(const u32x4*)(G + (size_t)row * 2048 + 1024 + c + 128), g0, g1);
        b0 = b0 * g0 * *(const f32x4*)(scale + c + 128); b1 = b1 * g1 * *(const f32x4*)(scale + c + 132);
        *(u32x4*)(TMP + (size_t)row * D + c + 128) = pack8(b0, b1);
    }
};
struct EpiConv {
    const bf16* G; const bf16* TMP; bf16* Y;
    __device__ __forceinline__ void apply(int row, int pn, int cl8, f32x4 a0, f32x4 a1, f32x4 b0, f32x4 b1) const {
        const int c = 256 * pn + cl8; f32x4 g0, g1, t0, t1;
        unpack8(*(const u32x4*)(G + (size_t)row * 2048 + c), g0, g1); unpack8(*(const u32x4*)(TMP + (size_t)row * D + c), t0, t1);
        *(u32x4*)(Y + (size_t)row * D + c) = pack8(a0 * g0 + t0, a1 * g1 + t1);
        unpack8(*(const u32x4*)(G + (size_t)row * 2048 + c + 128), g0, g1); unpack8(*(const u32x4*)(TMP + (size_t)row * D + c + 128), t0, t1);
        *(u32x4*)(Y + (size_t)row * D + c + 128) = pack8(b0 * g0 + t0, b1 * g1 + t1);
    }
};
struct EpiOut {
    const float* xold; float* xnew; const float* g1;   const float* bout;
    __device__ __forceinline__ void apply(int row, int pn, int cl8, f32x4 a0, f32x4 a1, f32x4 b0, f32x4 b1) const {
        const int c = 256 * pn + cl8; const float* g = g1 + (size_t)(row >> 13) * NMODV; const size_t o = (size_t)row * D + c;
        *(f32x4*)(xnew + o) = *(const f32x4*)(xold + o) + *(const f32x4*)(g + c) * (a0 + *(const f32x4*)(bout + c));
        *(f32x4*)(xnew + o + 4) = *(const f32x4*)(xold + o + 4) + *(const f32x4*)(g + c + 4) * (a1 + *(const f32x4*)(bout + c + 4));
        *(f32x4*)(xnew + o + 128) = *(const f32x4*)(xold + o + 128) + *(const f32x4*)(g + c + 128) * (b0 + *(const f32x4*)(bout + c + 128));
        *(f32x4*)(xnew + o + 132) = *(const f32x4*)(xold + o + 132) + *(const f32x4*)(g + c + 132) * (b1 + *(const f32x4*)(bout + c + 132));
    }
};
struct EpiQ {
    bf16* Q;
    __device__ __forceinline__ void apply(int row, int pn, int cl8, f32x4 a0, f32x4 a1, f32x4 b0, f32x4 b1) const {
        const size_t o = (size_t)row * DQ + 256 * pn + cl8; *(u32x4*)(Q + o) = pack8(a0, a1); *(u32x4*)(Q + o + 128) = pack8(b0, b1);
    }
};
struct EpiS {
    float* S;
    __device__ __forceinline__ void apply(int row, int pn, int cl8, f32x4 a0, f32x4 a1, f32x4 b0, f32x4 b1) const {
        const size_t o = (size_t)row * DQ + 256 * pn + cl8; *(f32x4*)(S + o) = a0; *(f32x4*)(S + o + 4) = a1; *(f32x4*)(S + o + 128) = b0; *(f32x4*)(S + o + 132) = b1;
    }
};

namespace pg8 {
#define PG8_LAS __attribute__((address_space(3)))
typedef unsigned short bf16_t;
typedef short bf16x8 __attribute__((ext_vector_type(8)));
typedef float f32x4 __attribute__((ext_vector_type(4)));
typedef unsigned u32x4 __attribute__((ext_vector_type(4)));
constexpr int BM = 256, BK = 64, HALF = 128, HTB = HALF * BK * 2  , STAGE_BYTES = 8 * HTB, NXCD = 8, WGM = 8;

__host__ __device__ __forceinline__ int lds_byte(int r, int c) { const int st = (r >> 4) * 2 + (c >> 5), rr = r & 15, cc = c & 31, ob = rr * 64 + cc * 2; return st * 1024 + (ob ^ (((ob >> 9) & 1) << 5)); }
__host__ __device__ __forceinline__ void stage_rc(int b, int& R, int& C) { const int st = b / 1024, sb = b % 1024, swz = sb ^ (((sb >> 9) & 1) << 5); R = (st >> 1) * 16 + swz / 64; C = (st & 1) * 32 + (swz % 64) / 2; }
__host__ __device__ __forceinline__ int perm32(int rho) { const int n = rho >> 4, i = rho & 15; return 8 * (i >> 2) + 4 * n + (i & 3); }

struct Unit { int pm, pn; };
struct Gemm { const bf16_t* A; const bf16_t* Bt; int M, N, K, lda, ldb, acol; };

struct StaticOrder {
    int nM, nN, nwg, G, c;
    __host__ __device__ void init(int M, int N, int G_, int c_) { nM = M / BM; nN = N / BM; nwg = nM * nN; G = G_; c = c_; }
    __host__ __device__ bool next(int i, Unit& u) const {
        const long L = (long)i * G + c; if (L >= nwg) return false;
        int wgid = (int)L; { const int q = nwg / NXCD, r = nwg % NXCD, xcd = wgid % NXCD, off = wgid / NXCD; wgid = (xcd < r ? xcd * (q + 1) : r * (q + 1) + (xcd - r) * q) + off; }
        const int nig = WGM * nN, gid = wgid / nig, fm = gid * WGM, gsz = (nM - fm) < WGM ? (nM - fm) : WGM;
        u.pm = fm + ((wgid % nig) % gsz); u.pn = (wgid % nig) / gsz; return true;
    }
    __device__ __forceinline__ void a_ready(const Unit&) const {}
    __device__ __forceinline__ void done(const Unit&) const {}
};


template <class Epi, class Sched, bool ALIGN_EPI = false, bool SP2 = false>
__device__ __forceinline__ void gemm_phase(PG8_LAS unsigned char* lds, const Gemm g, const Sched& S, const Epi& E, const int tid) {
    const int wid = __builtin_amdgcn_readfirstlane(tid >> 6), lane = tid & 63, wr = wid >> 2, wc = wid & 3, fr = lane & 15, fq = lane >> 4;
    const int K = g.K, nt = K / BK;
    unsigned voffA[2], voffB[2];
#pragma unroll
    for (int i = 0; i < 2; ++i) { int R, C; stage_rc(tid * 16 + i * 8192, R, C); const int Rb = Epi::PERM ? ((R & ~31) + perm32(R & 31)) : R;
        voffA[i] = (unsigned)(R * g.lda + C) * 2u; voffB[i] = (unsigned)(Rb * g.ldb + C) * 2u; }
    const size_t kstep = (size_t)(BK * 2);
    const size_t hstepA = (size_t)HALF * g.lda * 2, hstepB = (size_t)HALF * g.ldb * 2;
    const size_t tstepA = 2 * hstepA, tstepB = 2 * hstepB, acolb = (size_t)g.acol * 2;
    const unsigned ldsw = (unsigned)wid * 1024u;
    const int aoff = lds_byte(wr * 64 + fr, fq * 8), boff = lds_byte(wc * 32 + fr, fq * 8);
#define PG8_SA(b, h) (((b) * 2 + (h)) * HTB)
#define PG8_SB(b, h) ((4 + (b) * 2 + (h)) * HTB)
#define PG8_STAGE(bufoff, gbase, voff) do { _Pragma("unroll") for (int _i = 0; _i < 2; ++_i) \
        __builtin_amdgcn_global_load_lds((const unsigned*)((const char*)(gbase) + (voff)[_i]), (PG8_LAS unsigned*)(lds + (bufoff) + ldsw + _i * 8192), 16, 0, 0); } while (0)
#define PG8_LDA(dst, b, h) do { _Pragma("unroll") for (int m = 0; m < 4; ++m) _Pragma("unroll") for (int k = 0; k < 2; ++k) dst[m][k] = *(const PG8_LAS bf16x8*)(lds + PG8_SA(b, h) + aoff + m * 2048 + k * 1024); } while (0)
#define PG8_LDB(dst, b, h) do { _Pragma("unroll") for (int n = 0; n < 2; ++n) _Pragma("unroll") for (int k = 0; k < 2; ++k) dst[n][k] = *(const PG8_LAS bf16x8*)(lds + PG8_SB(b, h) + boff + n * 2048 + k * 1024); } while (0)
#define PG8_MMA(ai, bj, At, Bt) do { __builtin_amdgcn_s_setprio(1); _Pragma("unroll") for (int m = 0; m < 4; ++m) _Pragma("unroll") for (int n = 0; n < 2; ++n) _Pragma("unroll") for (int k = 0; k < 2; ++k) \
        acc[ai][bj][m][n] = __builtin_amdgcn_mfma_f32_16x16x32_bf16(Bt[n][k], At[m][k], acc[ai][bj][m][n], 0, 0, 0); __builtin_amdgcn_s_setprio(0); } while (0)
#define PG8_WAIT_V(n) asm volatile("s_waitcnt vmcnt(" #n ")" ::: "memory")
#define PG8_WAIT_L(n) asm volatile("s_waitcnt lgkmcnt(" #n ")" ::: "memory")
#define PG8_BAR __builtin_amdgcn_s_barrier()
#define PG8_SCHED __builtin_amdgcn_sched_barrier(0)
    Unit cur, nxt; int ui = 0;
    if (!S.next(0, cur)) return;
    f32x4 acc[2][2][4][2];
#pragma unroll
    for (int a = 0; a < 2; ++a)
#pragma unroll
        for (int b = 0; b < 2; ++b)
#pragma unroll
            for (int m = 0; m < 4; ++m)
#pragma unroll
                for (int n = 0; n < 2; ++n) acc[a][b][m][n] = (f32x4){0.f, 0.f, 0.f, 0.f};
    bf16x8 At[4][2], B0[2][2], B1[2][2];
    const char* cA = (const char*)g.A + (size_t)cur.pm * tstepA + (size_t)cur.pn * acolb; const char* cB = (const char*)g.Bt + (size_t)cur.pn * tstepB;
    S.a_ready(cur);
    if constexpr (SP2) {
        PG8_STAGE(PG8_SB(0, 0), cB, voffB); PG8_STAGE(PG8_SB(0, 1), cB + hstepB, voffB); PG8_STAGE(PG8_SA(0, 0), cA, voffA); PG8_STAGE(PG8_SA(0, 1), cA + hstepA, voffA);
        if (wr == 1) PG8_BAR;
        PG8_WAIT_V(2); PG8_BAR;
        PG8_STAGE(PG8_SB(1, 0), cB + kstep, voffB); PG8_STAGE(PG8_SA(1, 0), cA + kstep, voffA); PG8_STAGE(PG8_SB(1, 1), cB + hstepB + kstep, voffB);
        PG8_WAIT_V(6); PG8_BAR;
    } else {
        PG8_STAGE(PG8_SB(0, 0), cB, voffB); PG8_STAGE(PG8_SA(0, 0), cA, voffA); PG8_STAGE(PG8_SB(0, 1), cB + hstepB, voffB); PG8_STAGE(PG8_SA(0, 1), cA + hstepA, voffA);
        if (wr == 1) PG8_BAR;
        PG8_WAIT_V(4); PG8_BAR;
        PG8_STAGE(PG8_SB(1, 0), cB + kstep, voffB); PG8_STAGE(PG8_SA(1, 0), cA + kstep, voffA); PG8_STAGE(PG8_SB(1, 1), cB + hstepB + kstep, voffB);
        PG8_WAIT_V(6); PG8_BAR;
    }
    for (;;) {
        const bool has_next = S.next(ui + 1, nxt);
        const char* nA = has_next ? (const char*)g.A + (size_t)nxt.pm * tstepA + (size_t)nxt.pn * acolb : cA; const char* nB = has_next ? (const char*)g.Bt + (size_t)nxt.pn * tstepB : cB;
#pragma nounroll
        for (int t = 0; t < nt; t += 2) {
            const bool last = (t == nt - 2);
            const char* a1 = cA + (size_t)(t + 1) * kstep;
            const char* a2 = last ? nA : cA + (size_t)(t + 2) * kstep; const char* b2 = last ? nB : cB + (size_t)(t + 2) * kstep;
            const char* a3 = a2 + kstep; const char* b3 = b2 + kstep;
            if (last && has_next) S.a_ready(nxt);
            if constexpr (SP2) {
            PG8_LDB(B0, 0, 0); PG8_LDB(B1, 0, 1); PG8_SCHED; PG8_LDA(At, 0, 0); PG8_STAGE(PG8_SA(1, 1), a1 + hstepA, voffA);
            PG8_WAIT_V(8); PG8_WAIT_L(0); PG8_BAR; PG8_MMA(0, 0, At, B0); PG8_MMA(0, 1, At, B1); PG8_BAR; PG8_SCHED;
            PG8_LDA(At, 0, 1); PG8_STAGE(PG8_SB(0, 0), b2, voffB); PG8_STAGE(PG8_SB(0, 1), b2 + hstepB, voffB); PG8_STAGE(PG8_SA(0, 0), a2, voffA);
            PG8_WAIT_V(8); PG8_WAIT_L(0); PG8_BAR; PG8_MMA(1, 0, At, B0); PG8_MMA(1, 1, At, B1); PG8_BAR; PG8_SCHED;
            PG8_LDB(B0, 1, 0); PG8_LDB(B1, 1, 1); PG8_SCHED; PG8_LDA(At, 1, 0); PG8_STAGE(PG8_SA(0, 1), a2 + hstepA, voffA);
            PG8_WAIT_V(8); PG8_WAIT_L(0); PG8_BAR; PG8_MMA(0, 0, At, B0); PG8_MMA(0, 1, At, B1); PG8_BAR; PG8_SCHED;
            PG8_LDA(At, 1, 1); PG8_STAGE(PG8_SB(1, 0), b3, voffB); PG8_STAGE(PG8_SB(1, 1), b3 + hstepB, voffB); PG8_STAGE(PG8_SA(1, 0), a3, voffA);
            PG8_WAIT_V(8); PG8_WAIT_L(0); PG8_BAR; PG8_MMA(1, 0, At, B0); PG8_MMA(1, 1, At, B1); PG8_BAR; PG8_SCHED;
            } else {
            PG8_LDB(B0, 0, 0); PG8_SCHED; PG8_LDA(At, 0, 0); PG8_STAGE(PG8_SA(1, 1), a1 + hstepA, voffA);
            PG8_WAIT_L(8); PG8_BAR; PG8_WAIT_L(0); PG8_MMA(0, 0, At, B0); PG8_BAR; PG8_SCHED;
            PG8_LDB(B1, 0, 1); PG8_STAGE(PG8_SB(0, 0), b2, voffB);
            PG8_BAR; PG8_WAIT_L(0); PG8_MMA(0, 1, At, B1); PG8_BAR;
            PG8_LDA(At, 0, 1); PG8_STAGE(PG8_SA(0, 0), a2, voffA);
            PG8_BAR; PG8_WAIT_L(0); PG8_MMA(1, 0, At, B0); PG8_BAR; PG8_SCHED;
            PG8_STAGE(PG8_SB(0, 1), b2 + hstepB, voffB);
            PG8_WAIT_V(6); PG8_BAR; PG8_MMA(1, 1, At, B1); PG8_BAR;
            PG8_LDB(B0, 1, 0); PG8_SCHED; PG8_LDA(At, 1, 0); PG8_STAGE(PG8_SA(0, 1), a2 + hstepA, voffA);
            PG8_WAIT_L(8); PG8_BAR; PG8_WAIT_L(0); PG8_MMA(0, 0, At, B0); PG8_BAR; PG8_SCHED;
            PG8_LDB(B1, 1, 1); PG8_STAGE(PG8_SB(1, 0), b3, voffB);
            PG8_BAR; PG8_WAIT_L(0); PG8_MMA(0, 1, At, B1); PG8_BAR;
            PG8_LDA(At, 1, 1); PG8_STAGE(PG8_SA(1, 0), a3, voffA);
            PG8_BAR; PG8_WAIT_L(0); PG8_MMA(1, 0, At, B0); PG8_BAR; PG8_SCHED;
            PG8_STAGE(PG8_SB(1, 1), b3 + hstepB, voffB);
            PG8_WAIT_V(6); PG8_BAR; PG8_MMA(1, 1, At, B1); PG8_BAR;
            }
        }
        if constexpr (ALIGN_EPI) { if (wr == 0) PG8_BAR; }
        if constexpr (!Epi::AFTER_DRAIN) { E(acc, cur, wr, wc, fr, fq); S.done(cur); }
        if (!has_next) break;
#pragma unroll
        for (int a = 0; a < 2; ++a)
#pragma unroll
            for (int b = 0; b < 2; ++b)
#pragma unroll
                for (int m = 0; m < 4; ++m)
#pragma unroll
                    for (int n = 0; n < 2; ++n) acc[a][b][m][n] = (f32x4){0.f, 0.f, 0.f, 0.f};
        cur = nxt; cA = nA; cB = nB; ++ui;
        if constexpr (ALIGN_EPI) { if (wr == 1) PG8_BAR; }
    }
    PG8_WAIT_V(0);
    if constexpr (!ALIGN_EPI) { if (wr == 0) PG8_BAR; }
    PG8_BAR;
    if constexpr (Epi::AFTER_DRAIN) { E.fused(acc, cur, wr, wc, fr, fq, lds, wid, lane); S.done(cur); }
#undef PG8_SA
#undef PG8_SB
#undef PG8_STAGE
#undef PG8_LDA
#undef PG8_LDB
#undef PG8_MMA
#undef PG8_WAIT_V
#undef PG8_WAIT_L
#undef PG8_BAR
#undef PG8_SCHED
}

template <class F> struct EpiW {
    static constexpr bool PERM = true, AFTER_DRAIN = false; F f;
    __device__ __forceinline__ void operator()(const f32x4 (&acc)[2][2][4][2], const Unit& u, int wr, int wc, int fr, int fq) const {
#pragma unroll
        for (int ai = 0; ai < 2; ++ai)
#pragma unroll
            for (int m = 0; m < 4; ++m) { f.apply(u.pm * BM + ai * HALF + wr * 64 + m * 16 + fr, u.pn, wc * 32 + 8 * fq, acc[ai][0][m][0], acc[ai][0][m][1], acc[ai][1][m][0], acc[ai][1][m][1]);
                asm volatile("" ::: "memory"); }
    }
};
}

template <class F>
__device__ __forceinline__ void mfma_gemm(const Ctx& C, const bf16* A, int lda, int acol, const bf16* Bt, int ldb, int Mr, int N, int K, const F& f) {
    pg8::Gemm g{A, Bt, Mr, N, K, lda, ldb, acol}; pg8::StaticOrder S; S.init(Mr, N, C.nblk, C.blk); pg8::EpiW<F> E{f};
    pg8::gemm_phase<pg8::EpiW<F>, pg8::StaticOrder, true, true>(C.lds, g, S, E, C.tid);
}

template <class F>
__device__ __forceinline__ void naive_gemm(const Ctx& C, const bf16* A, int lda, int acol, const bf16* Bt, int ldb, int Mr, int N, int K, const F& f) {
    LAS float* As = (LAS float*)C.lds;
    LAS float* Bs = (LAS float*)(C.lds + 8192);
    const int ntm = Mr / 128, ntn = N / 256, tid = C.tid, cg = tid & 15, r0 = tid >> 4;
    for (int tile = C.blk; tile < ntm * ntn; tile += C.nblk) {
        const int tm = tile / ntn, pn = tile % ntn;
        f32x4 acc[4][4];
#pragma unroll
        for (int i = 0; i < 4; ++i)
#pragma unroll
            for (int j = 0; j < 4; ++j) acc[i][j] = (f32x4){0.f, 0.f, 0.f, 0.f};
        const bf16* ap = A + (size_t)(tm * 128 + (tid >> 2)) * lda + pn * acol + (tid & 3) * 4;
        const bf16* bp = Bt + (size_t)(pn * 256 + (tid >> 1)) * ldb + (tid & 1) * 8;
        for (int k0 = 0; k0 < K; k0 += 16) {
            const u32x2 av = *(const u32x2*)(ap + k0); const u32x4 bv = *(const u32x4*)(bp + k0);
            __syncthreads();
            { const int r = tid >> 2, kq = (tid & 3) * 4; As[(kq + 0) * 128 + r] = bflo(av.x); As[(kq + 1) * 128 + r] = bfhi(av.x); As[(kq + 2) * 128 + r] = bflo(av.y); As[(kq + 3) * 128 + r] = bfhi(av.y); }
            { const int n = tid >> 1, kq = (tid & 1) * 8; Bs[(kq + 0) * 256 + n] = bflo(bv.x); Bs[(kq + 1) * 256 + n] = bfhi(bv.x); Bs[(kq + 2) * 256 + n] = bflo(bv.y); Bs[(kq + 3) * 256 + n] = bfhi(bv.y);
              Bs[(kq + 4) * 256 + n] = bflo(bv.z); Bs[(kq + 5) * 256 + n] = bfhi(bv.z); Bs[(kq + 6) * 256 + n] = bflo(bv.w); Bs[(kq + 7) * 256 + n] = bfhi(bv.w); }
            __syncthreads();
#pragma unroll
            for (int kk = 0; kk < 16; ++kk) {
                const f32x4 b0 = *(const LAS f32x4*)(Bs + kk * 256 + cg * 8), b1 = *(const LAS f32x4*)(Bs + kk * 256 + cg * 8 + 4), b2 = *(const LAS f32x4*)(Bs + kk * 256 + 128 + cg * 8), b3 = *(const LAS f32x4*)(Bs + kk * 256 + 128 + cg * 8 + 4);
#pragma unroll
                for (int i = 0; i < 4; ++i) { const float av1 = As[kk * 128 + r0 + 32 * i]; acc[i][0] += b0 * av1; acc[i][1] += b1 * av1; acc[i][2] += b2 * av1; acc[i][3] += b3 * av1; }
            }
        }
#pragma unroll
        for (int i = 0; i < 4; ++i) f.apply(tm * 128 + r0 + 32 * i, pn, cg * 8, acc[i][0], acc[i][1], acc[i][2], acc[i][3]);
    }
}

template <int NROWS>
__device__ __forceinline__ void cp_stage(LAS unsigned char* tile, const bf16* src, int mrow0, int tfirst, int tid) {
    constexpr int NIT = (NROWS * 128 + NTHREADS - 1) / NTHREADS;
    asm volatile("" : "+v"(tid));
    u32x4 v[NIT];
#pragma unroll
    for (int i = 0; i < NIT; ++i) { const int ch = i * NTHREADS + tid, r = ch >> 7, c = ch & 127; v[i] = (u32x4){0u, 0u, 0u, 0u};
        if (ch < NROWS * 128 && tfirst + r >= 0) v[i] = *(const u32x4*)(src + (size_t)(mrow0 + r) * D + c * 8); }
#pragma unroll
    for (int i = 0; i < NIT; ++i) { const int ch = i * NTHREADS + tid; if (ch < NROWS * 128) *(LAS u32x4*)(tile + ch * 16) = v[i]; }
}
template <int W>
__device__ __forceinline__ void pool_item(const LAS unsigned char* tile, bf16* PL, int m0, int t0, int tid) {
    float p0[47], p1[47];
#pragma unroll
    for (int i = 0; i < 47; ++i) { unsigned w = 0u; if (i >= 15 - (W - 1)) w = *(const LAS unsigned*)(tile + i * 2048 + 4 * tid); p0[i] = bflo(w); p1[i] = bfhi(w); }
#pragma unroll
    for (int ti = 0; ti < 32; ++ti) {
        float s0 = 0.f, s1 = 0.f;
#pragma unroll
        for (int j = 0; j < W; ++j) { s0 += p0[ti + 15 - j]; s1 += p1[ti + 15 - j]; }
        const int cnt = (t0 + ti + 1) < W ? (t0 + ti + 1) : W; const float inv = 1.f / (float)cnt;
        *(unsigned*)(PL + (size_t)(m0 + ti) * D + 2 * tid) = pk2(s0 * inv - p0[ti + 15], s1 * inv - p1[ti + 15]);
    }
}
template <int RI>
__device__ __forceinline__ void conv_row(const LAS unsigned char* tile, int tid, const float (&w0)[31], const float (&w1)[31], float (&a0)[32], float (&a1)[32]) {
    const unsigned w = *(const LAS unsigned*)(tile + RI * 2048 + 4 * tid);
    const float u0 = bflo(w), u1 = bfhi(w);
#pragma unroll
    for (int ti = 0; ti < 32; ++ti) { constexpr int dbase = 30 - RI; const int d = ti + dbase; if (d >= 0 && d <= 30) { a0[ti] += w0[30 - d] * u0; a1[ti] += w1[30 - d] * u1; } }
    if constexpr ((RI & 7) == 7) asm volatile("" ::: "memory");
}
template <int... RI>
__device__ __forceinline__ void conv_rows(const LAS unsigned char* tile, int tid, const float (&w0)[31], const float (&w1)[31], float (&a0)[32], float (&a1)[32], std::integer_sequence<int, RI...>) {
    (conv_row<RI>(tile, tid, w0, w1, a0, a1), ...);
}
__device__ __forceinline__ void phase_convpool(const Ctx& C, const Args& a, int l) {
    const bf16* UG = (const bf16*)(a.ws + WS_UG); const bf16* ZP = (const bf16*)(a.ws + WS_ZP);
    bf16* AC = (bf16*)(a.ws + WS_AC); bf16* PL = (bf16*)(a.ws + WS_PL);
    const float* cw = a.in[I_CONVW] + (size_t)l * CONVK * D; const float* cb = a.in[I_CONVB] + (size_t)l * D;
    const float* lng = a.in[I_LNG] + (size_t)l * D; const float* lnb = a.in[I_LNB] + (size_t)l * D;
    LAS float* red = (LAS float*)C.lds;
    LAS float* stat = (LAS float*)(C.lds + 2048);
    LAS unsigned char* tile = C.lds + 4096;
    int tid = C.tid;
    asm volatile("" : "+v"(tid));
    const int c0 = 2 * tid;
    float w0[31], w1[31];
#pragma unroll
    for (int k = 0; k < 31; ++k) { const f32x2 w = *(const f32x2*)(cw + (size_t)k * D + c0); w0[k] = w.x; w1[k] = w.y; }
    const f32x2 bb = *(const f32x2*)(cb + c0), gg = *(const f32x2*)(lng + c0), be = *(const f32x2*)(lnb + c0);
    for (int item = C.blk; item < M / 32; item += C.nblk) {
        const int m0 = item * 32, t0 = m0 & (SEQ - 1);
        __syncthreads();
        cp_stage<62>(tile, UG, m0 - 30, t0 - 30, tid);
        __syncthreads();
        float a0[32], a1[32];
#pragma unroll
        for (int i = 0; i < 32; ++i) { a0[i] = bb.x; a1[i] = bb.y; }
        conv_rows(tile, tid, w0, w1, a0, a1, std::make_integer_sequence<int, 62>{});
#pragma unroll
        for (int ti = 0; ti < 32; ++ti) {
            const float s = dpp_sum63(a0[ti] + a1[ti]), q = dpp_sum63(a0[ti] * a0[ti] + a1[ti] * a1[ti]);
            if (C.lane == 63) { red[C.wave * 64 + ti] = s; red[C.wave * 64 + 32 + ti] = q; }
        }
        __syncthreads();
        if (tid < 32) { float s = 0.f, q = 0.f;
#pragma unroll
            for (int w = 0; w < 8; ++w) { s += red[w * 64 + tid]; q += red[w * 64 + 32 + tid]; }
            const float mean = s * (1.f / D), var = fmaxf(q * (1.f / D) - mean * mean, 0.f); stat[tid] = mean; stat[32 + tid] = 1.f / sqrtf(var + EPS); }
        __syncthreads();
#pragma unroll
        for (int ti = 0; ti < 32; ++ti) { const float mean = stat[ti], rstd = stat[32 + ti];
            const float y0 = (a0[ti] - mean) * rstd * gg.x + be.x, y1 = (a1[ti] - mean) * rstd * gg.y + be.y;
            *(unsigned*)(AC + (size_t)(m0 + ti) * D + c0) = pk2(y0 * sigm(y0), y1 * sigm(y1)); }
        asm volatile("" ::: "memory");
        cp_stage<47>(tile, ZP, m0 - 15, t0 - 15, tid);
        __syncthreads();
        const int g = tid >> 7;
        if (g == 0) pool_item<2>(tile, PL, m0, t0, tid); else if (g == 1) pool_item<4>(tile, PL, m0, t0, tid); else if (g == 2) pool_item<8>(tile, PL, m0, t0, tid); else pool_item<16>(tile, PL, m0, t0, tid);
    }
}

typedef unsigned u32;
template <int CTRL> __device__ __forceinline__ u32 dppu(u32 x) { return (u32)__builtin_amdgcn_update_dpp(0, (int)x, CTRL, 0xf, 0xf, true); }
constexpr int DPP_XOR1 = 0xB1, DPP_REV4 = 0x1B, DPP_DUPE = 0xA0, DPP_DUPO = 0xF5, DPP_HMIRROR = 0x141, DPP_MIRROR = 0x140;
__device__ __forceinline__ u32 umax_(u32 a, u32 b) { return a > b ? a : b; }
__device__ __forceinline__ u32 umin_(u32 a, u32 b) { return a < b ? a : b; }
#define TK_CE(x, i, j) do { const u32 hi_ = umax_(x[i], x[j]), lo_ = umin_(x[i], x[j]); x[i] = hi_; x[j] = lo_; } while (0)
__device__ __forceinline__ void tk_local_merge(u32 (&x)[8]) {
    TK_CE(x, 0, 4); TK_CE(x, 1, 5); TK_CE(x, 2, 6); TK_CE(x, 3, 7);
    TK_CE(x, 0, 2); TK_CE(x, 1, 3); TK_CE(x, 4, 6); TK_CE(x, 5, 7);
    TK_CE(x, 0, 1); TK_CE(x, 2, 3); TK_CE(x, 4, 5); TK_CE(x, 6, 7);
}
template <int CTRL> __device__ __forceinline__ void tk_level(u32 (&x)[8], bool even) {
    u32 t[8];
#pragma unroll
    for (int c = 0; c < 8; ++c) t[c] = dppu<CTRL>(x[7 - c]);
#pragma unroll
    for (int c = 0; c < 8; ++c) x[c] = umax_(x[c], t[c]);
#pragma unroll
    for (int c = 0; c < 8; ++c) { const u32 p = dppu<DPP_XOR1>(x[c]); x[c] = even ? umax_(x[c], p) : umin_(x[c], p); }
    tk_local_merge(x);
}
__device__ __forceinline__ void tk_top16(u32 (&x)[8], bool even) {
    TK_CE(x, 0, 1); TK_CE(x, 2, 3); TK_CE(x, 4, 5); TK_CE(x, 6, 7);
    TK_CE(x, 0, 2); TK_CE(x, 1, 3); TK_CE(x, 4, 6); TK_CE(x, 5, 7);
    TK_CE(x, 1, 2); TK_CE(x, 5, 6);
    TK_CE(x, 0, 4); TK_CE(x, 1, 5); TK_CE(x, 2, 6); TK_CE(x, 3, 7);
    TK_CE(x, 2, 4); TK_CE(x, 3, 5);
    TK_CE(x, 1, 2); TK_CE(x, 3, 4); TK_CE(x, 5, 6);
    { u32 t[8];
#pragma unroll
      for (int c = 0; c < 8; ++c) t[c] = dppu<DPP_XOR1>(x[7 - c]);
#pragma unroll
      for (int c = 0; c < 8; ++c) x[c] = even ? umax_(x[c], t[c]) : umin_(x[c], t[c]); }
    tk_local_merge(x);
    tk_level<DPP_REV4>(x, even); tk_level<DPP_HMIRROR>(x, even); tk_level<DPP_MIRROR>(x, even);
}
__device__ __forceinline__ u32 tk_f2key(float v, int slot) { const u32 u = __builtin_bit_cast(u32, v); const u32 k = u ^ ((u32)((int)u >> 31) | 0x80000000u); return (k & ~127u) | (u32)(127 - slot); }
__device__ __forceinline__ float tk_key2f(u32 k) { k &= ~127u; const u32 m = (u32)((int)k >> 31); return __builtin_bit_cast(float, k ^ (~m | 0x80000000u)); }
__device__ __forceinline__ u32 tk_sel8v(u32 r0, u32 r1, u32 r2, u32 r3, u32 r4, u32 r5, u32 r6, u32 r7, int idx) {
    const bool b0 = idx & 1, b1 = idx & 2, b2 = idx & 4;
    const u32 s01 = b0 ? r1 : r0, s23 = b0 ? r3 : r2, s45 = b0 ? r5 : r4, s67 = b0 ? r7 : r6;
    const u32 s03 = b1 ? s23 : s01, s47 = b1 ? s67 : s45;
    return b2 ? s47 : s03; }
#define tk_sel8(r, idx) tk_sel8v(r[0], r[1], r[2], r[3], r[4], r[5], r[6], r[7], idx)
__device__ __forceinline__ void phase_topk(const Ctx& C, const Args& a) {
    const float* S = (const float*)(a.ws + WS_S); int* EID = (int*)(a.ws + WS_EID); float* GW = (float*)(a.ws + WS_GW);
    const int lane = C.lane, r = lane & 15, q = lane >> 4; const bool even = (lane & 1) == 0;
    pg8::StaticOrder SO; SO.init(M, DQ, C.nblk, C.blk); pg8::Unit un;
    for (int ui = 0; SO.next(ui, un); ++ui)
    for (int wi = C.wave; wi < 64; wi += NWAVES) {
        const int tok = un.pm * 256 + wi * 4 + q, h = un.pn;
        u32 xa[8], xb[8];
        { const float* sp = S + (size_t)tok * DQ + h * 256 + 8 * r; const f32x4 v0 = *(const f32x4*)sp, v1 = *(const f32x4*)(sp + 4), w0 = *(const f32x4*)(sp + 128), w1 = *(const f32x4*)(sp + 132);
#pragma unroll
          for (int c = 0; c < 4; ++c) { xa[c] = tk_f2key(v0[c], 8 * r + c); xa[4 + c] = tk_f2key(v1[c], 8 * r + 4 + c); xb[c] = tk_f2key(w0[c], 8 * r + c); xb[4 + c] = tk_f2key(w1[c], 8 * r + 4 + c); } }
        tk_top16(xa, even); tk_top16(xb, even);
        u32 La[8], Ha[8], Lb[8], Hb[8];
#pragma unroll
        for (int c = 0; c < 8; ++c) { La[c] = dppu<DPP_DUPE>(xa[c]); Ha[c] = dppu<DPP_DUPO>(xa[c]); Lb[c] = dppu<DPP_DUPE>(xb[c]); Hb[c] = dppu<DPP_DUPO>(xb[c]); }
        const u32 a_lane = (r < 8) ? tk_sel8(La, r & 7) : tk_sel8(Ha, r & 7), b_lane = (r < 8) ? tk_sel8(Lb, r & 7) : tk_sel8(Hb, r & 7);
        const float va = tk_key2f(a_lane), vbl = tk_key2f(b_lane), va0 = tk_key2f(La[0]);
        u32 ck[8];
#pragma unroll
        for (int j = 0; j < 8; ++j) { constexpr int lim[8] = {15, 7, 4, 3, 2, 1, 1, 1};
            float v = va + tk_key2f(Lb[j]); bool valid = r <= lim[j];
            if (j == 1) { v = (r >= 8) ? va0 + vbl : v; valid = valid || (r >= 8); }
            ck[j] = valid ? tk_f2key(v, 8 * r + j) : 0u; }
        tk_top16(ck, even);
        const float mx = tk_key2f(dppu<DPP_DUPE>(ck[0]));
        float ex[8], sum = 0.f;
#pragma unroll
        for (int c = 0; c < 8; ++c) { ex[c] = __expf(tk_key2f(ck[c]) - mx); sum += ex[c]; }
        sum += __builtin_bit_cast(float, dppu<DPP_XOR1>(__builtin_bit_cast(u32, sum)));
        const float inv = 1.f / sum;
        int eo[8]; float go[8];
#pragma unroll
        for (int c = 0; c < 8; ++c) { const int slot = 127 - (int)(ck[c] & 127u), i = slot >> 3, j = slot & 7; const bool sp = (j == 1) && (i >= 8);
            const int i2 = sp ? 0 : i, j2 = sp ? i : j;
            const u32 ka = (u32)__builtin_amdgcn_ds_bpermute(((lane & ~15) + i2) << 2, (int)a_lane), kb = (u32)__builtin_amdgcn_ds_bpermute(((lane & ~15) + j2) << 2, (int)b_lane);
            eo[c] = (127 - (int)(ka & 127u)) * 128 + (127 - (int)(kb & 127u)); go[c] = ex[c] * inv; }
        if (r < 2) { int* ep = EID + (size_t)tok * 128 + h * 16 + r * 8; float* gp = GW + (size_t)tok * 128 + h * 16 + r * 8;
            *(u32x4*)ep = (u32x4){(u32)eo[0], (u32)eo[1], (u32)eo[2], (u32)eo[3]}; *(u32x4*)(ep + 4) = (u32x4){(u32)eo[4], (u32)eo[5], (u32)eo[6], (u32)eo[7]};
            *(f32x4*)gp = (f32x4){go[0], go[1], go[2], go[3]}; *(f32x4*)(gp + 4) = (f32x4){go[4], go[5], go[6], go[7]}; }
    }
}

__device__ __forceinline__ float dot2bf(unsigned w, unsigned x, float acc) { return __builtin_amdgcn_fdot2_f32_bf16(__builtin_bit_cast(bf16x2_t, w), __builtin_bit_cast(bf16x2_t, x), acc, false); }
constexpr int PNB = 8;
__device__ __forceinline__ void phase_peer_a(const Ctx& C, const Args& a, int l) {
    const int x = C.blk & 7, wg = (C.blk >> 3) * NWAVES + C.wave, nwg = ((C.nblk + 7 - x) >> 3) * NWAVES;
    const __amdgpu_buffer_rsrc_t UC = __builtin_amdgcn_make_buffer_rsrc(a.ws + WS_UB + ((size_t)l * 8 + x) * NEXP * 128, 0, NEXP * 128, 0x00020000);
    const int* EID = (const int*)(a.ws + WS_EID); const bf16* H = (const bf16*)(a.ws + WS_H); const float* HSC = (const float*)(a.ws + WS_HSC); float* PD = (float*)(a.ws + WS_PD);
    LAS float* dl = (LAS float*)(C.lds + C.wave * 1024);
    for (int t = wg; t < M; t += nwg) {
        unsigned z_ = 0u; asm volatile("" : "+v"(z_));
        const int lane = (int)__builtin_amdgcn_mbcnt_hi(~0u, __builtin_amdgcn_mbcnt_lo(~0u, z_)), p = lane & 7, g = lane >> 3;
        const int ev0 = EID[(size_t)t * 128 + lane], ev1 = EID[(size_t)t * 128 + 64 + lane];
        const float hs = HSC[t], inv = hs > 0.f ? 1.f / hs : 0.f;
        const u32x4 r0 = *(const u32x4*)(H + (size_t)t * D + 128 * x + 16 * p), r1 = *(const u32x4*)(H + (size_t)t * D + 128 * x + 16 * p + 8);
        u32x4 rows[16];
#pragma unroll
        for (int j = 0; j < 16; ++j) { const int e = __builtin_amdgcn_ds_bpermute(((8 * j + g) & 63) << 2, j < 8 ? ev0 : ev1);
            rows[j] = __builtin_bit_cast(u32x4, __builtin_amdgcn_raw_buffer_load_b128(UC, e * 128 + 16 * p, 0, 0)); }
        u32x4 hq; { f32x4 f[4]; unpack8(r0, f[0], f[1]); unpack8(r1, f[2], f[3]);
#pragma unroll
            for (int q = 0; q < 4; ++q) hq[q] = ((unsigned)(int)rintf(f[q].x * inv) & 255u) | (((unsigned)(int)rintf(f[q].y * inv) & 255u) << 8) | (((unsigned)(int)rintf(f[q].z * inv) & 255u) << 16) | ((unsigned)(int)rintf(f[q].w * inv) << 24); }
        float tot[16];
#pragma unroll
        for (int j = 0; j < 16; ++j) {
            int acc = __builtin_amdgcn_sdot4((int)rows[j].x, (int)hq.x, 0, false); acc = __builtin_amdgcn_sdot4((int)rows[j].y, (int)hq.y, acc, false);
            acc = __builtin_amdgcn_sdot4((int)rows[j].z, (int)hq.z, acc, false); acc = __builtin_amdgcn_sdot4((int)rows[j].w, (int)hq.w, acc, false);
            acc += __builtin_amdgcn_update_dpp(0, acc, 0xB1, 0xf, 0xf, true); acc += __builtin_amdgcn_update_dpp(0, acc, 0x4E, 0xf, 0xf, true); acc += __builtin_amdgcn_update_dpp(0, acc, 0x141, 0xf, 0xf, true);
            tot[j] = (float)acc; }
        if (p == 0) {
#pragma unroll
            for (int j = 0; j < 16; ++j) dl[8 * j + g] = tot[j]; }
        asm volatile("s_waitcnt lgkmcnt(0)" ::: "memory");
        const float d0 = dl[lane], d1 = dl[64 + lane];
        PD[((size_t)t * 8 + x) * 128 + lane] = d0; PD[((size_t)t * 8 + x) * 128 + 64 + lane] = d1;
        asm volatile("s_waitcnt lgkmcnt(0)" ::: "memory");
    }
}
__device__ __forceinline__ void phase_peer_c(const Ctx& C, const Args& a, int l) {
    const float* USC = (const float*)(a.ws + WS_USC) + (size_t)l * NEXP; const float* VSC = (const float*)(a.ws + WS_VSC) + (size_t)l * NEXP;
    const int* EID = (const int*)(a.ws + WS_EID); const float* GW = (const float*)(a.ws + WS_GW); const float* HSC = (const float*)(a.ws + WS_HSC); const float* PD = (const float*)(a.ws + WS_PD);
    float* COEF = (float*)(a.ws + WS_COEF);
    const int gt = C.blk * NTHREADS + C.tid, ngt = C.nblk * NTHREADS;
    for (int i = gt; i < M * 128; i += ngt) { const int t = i >> 7, k = i & 127, e = EID[i]; float d = 0.f;
#pragma unroll
        for (int xx = 0; xx < 8; ++xx) d += PD[((size_t)t * 8 + xx) * 128 + k];
        const float dd = d * USC[e] * HSC[t];
        COEF[i] = VSC[e] * GW[i] * 0.5f * dd * (1.f + erff(dd * 0.70710678118654752f)); }
}
__device__ __forceinline__ void peerB_load(u32x4 (&buf)[PNB], __amdgpu_buffer_rsrc_t T, int ev0, int ev1, int k0, int lane) {
    const int evs = (k0 < 64) ? ev0 : ev1;
#pragma unroll
    for (int i = 0; i < PNB; ++i) { const int e = __builtin_amdgcn_readlane(evs, (k0 & 63) + i); buf[i] = __builtin_bit_cast(u32x4, __builtin_amdgcn_raw_buffer_load_b128(T, 16 * lane, e * D, 0)); }
}
__device__ __forceinline__ void phase_peer_b(const Ctx& C, const Args& a, int l) {
    const __amdgpu_buffer_rsrc_t VB = __builtin_amdgcn_make_buffer_rsrc(a.ws + WS_VB + (size_t)l * NEXP * D, 0, NEXP * D, 0x00020000);
    const int* EID = (const int*)(a.ws + WS_EID); const float* COEF = (const float*)(a.ws + WS_COEF);
    float* XW = a.out; bf16* H = (bf16*)(a.ws + WS_H);
    for (int m = C.gw; m < M; m += C.ngw) {
        unsigned z_ = 0u; asm volatile("" : "+v"(z_));
        int lane = (int)__builtin_amdgcn_mbcnt_hi(~0u, __builtin_amdgcn_mbcnt_lo(~0u, z_));
        const int b = m >> 13;
        const int ev0 = EID[(size_t)m * 128 + lane], ev1 = EID[(size_t)m * 128 + 64 + lane];
        const float cf0 = COEF[(size_t)m * 128 + lane], cf1 = COEF[(size_t)m * 128 + 64 + lane];
        f32x4 o[4];
#pragma unroll
        for (int q = 0; q < 4; ++q) o[q] = (f32x4){0.f, 0.f, 0.f, 0.f};
        u32x4 A[PNB], Bf[PNB];
#define PEER_ACC(buf, i, c) do { _Pragma("unroll") for (int q = 0; q < 4; ++q) { const f32x2 lo = __builtin_amdgcn_cvt_pk_f32_fp8((int)buf[i][q], false), hi = __builtin_amdgcn_cvt_pk_f32_fp8((int)buf[i][q], true); \
            o[q].x += c * lo.x; o[q].y += c * lo.y; o[q].z += c * hi.x; o[q].w += c * hi.y; } } while (0)
        peerB_load(A, VB, ev0, ev1, 0, lane);
#pragma nounroll
        for (int k = 0; k < 128; k += 2 * PNB) {
            peerB_load(Bf, VB, ev0, ev1, k + PNB, lane);
            { const int cfs = __builtin_bit_cast(int, k < 64 ? cf0 : cf1);
#pragma unroll
              for (int i = 0; i < PNB; ++i) { const float c = __builtin_bit_cast(float, __builtin_amdgcn_readlane(cfs, (k & 63) + i)); PEER_ACC(A, i, c); } }
            if (k + 2 * PNB < 128) peerB_load(A, VB, ev0, ev1, k + 2 * PNB, lane);
            { const int cfs = __builtin_bit_cast(int, k < 64 ? cf0 : cf1);
#pragma unroll
              for (int i = 0; i < PNB; ++i) { const float c = __builtin_bit_cast(float, __builtin_amdgcn_readlane(cfs, (k & 63) + PNB + i)); PEER_ACC(Bf, i, c); } }
        }
#undef PEER_ACC
        asm volatile("" : "+v"(lane));
        const float* g2 = modp(a, l, b, 5); const size_t ro = (size_t)m * D; f32x4 x[4]; float ss = 0.f;
#pragma unroll
        for (int q = 0; q < 4; ++q) { x[q] = *(const f32x4*)(XW + ro + 16 * lane + 4 * q) + *(const f32x4*)(g2 + 16 * lane + 4 * q) * o[q]; ss += (x[q].x * x[q].x + x[q].y * x[q].y) + (x[q].z * x[q].z + x[q].w * x[q].w); }
        const float rstd = 1.f / sqrtf(wave_sum(ss) * (1.f / D) + EPS);
        if (l + 1 < DEPTH) {
            const float* g = a.in[I_N1G] + (size_t)(l + 1) * D; const float* sh = modp(a, l + 1, b, 0); const float* sc = modp(a, l + 1, b, 1);
            f32x4 hv[4];
#pragma unroll
            for (int q = 0; q < 4; ++q) { const int c = 16 * lane + 4 * q; *(f32x4*)(XW + ro + c) = x[q];
                hv[q] = (x[q] * rstd) * *(const f32x4*)(g + c) * (*(const f32x4*)(sc + c) + 1.f) + *(const f32x4*)(sh + c); }
            *(u32x4*)(H + ro + 16 * lane) = pack8(hv[0], hv[1]); *(u32x4*)(H + ro + 16 * lane + 8) = pack8(hv[2], hv[3]);
        } else {
#pragma unroll
            for (int q = 0; q < 4; ++q) { const int c = 16 * lane + 4 * q; *(f32x4*)(a.out + ro + c) = x[q] * rstd * *(const f32x4*)(a.in[I_FG] + c); }
        }
    }
}

#ifndef USE_NAIVE
#define GEMM mfma_gemm
#else
#define GEMM naive_gemm
#endif
#define RLX_AGENT __ATOMIC_RELAXED, __HIP_MEMORY_SCOPE_AGENT
#define XB_TMO      128
#define XB_XCNT(j)  (256  + 64 * (j))
#define XB_XSUB(j)  (1280 + 64 * (j))
#define XB_XGEN(j)  (2304 + 64 * (j))
#define XB_TOP      3328
#define XB_TOPGEN   3392
#define XCD_BAR_WORDS 3456
#define XB_SPIN_CAP (1u << 18)

__device__ __forceinline__ unsigned xb_ld(unsigned* p)              { return __hip_atomic_load(p, __ATOMIC_RELAXED, __HIP_MEMORY_SCOPE_AGENT); }
__device__ __forceinline__ unsigned xb_add(unsigned* p, unsigned v) { return __hip_atomic_fetch_add(p, v, __ATOMIC_RELAXED, __HIP_MEMORY_SCOPE_AGENT); }
__device__ __forceinline__ unsigned xb_xcc_id() { return (unsigned)__builtin_amdgcn_s_getreg((3 << 11) | 20) & 0xFu; }
#define XB_SPIN(cond, bar) do { unsigned _sp = 0; while (cond) { __builtin_amdgcn_s_sleep(1); \
    if ((++_sp & 255u) == 0u) { if (xb_ld(&(bar)[XB_TMO])) break; if (_sp > XB_SPIN_CAP) { atomicAdd(&(bar)[XB_TMO], 1u); break; } } } } while (0)

struct XcdBarrier {
    unsigned* bar; unsigned x;
    volatile LAS unsigned* st;
};

__device__ __forceinline__ XcdBarrier xcd_barrier_post(unsigned* bar, volatile LAS unsigned* st) {
    XcdBarrier b; b.bar = bar; b.x = xb_xcc_id(); b.st = st;
    if (threadIdx.x == 0) (void)xb_add(&bar[XB_XCNT(b.x)], 1u);
    return b;
}
__device__ __forceinline__ void xcd_barrier_complete(unsigned* bar, unsigned x, unsigned& nloc, unsigned& nx) {
    const unsigned G = gridDim.x * gridDim.y * gridDim.z;
    unsigned sum, cnt, mine, sp = 0u;
    for (;;) {
        sum = 0u; cnt = 0u; mine = 0u;
#pragma unroll
        for (unsigned j = 0; j < 16; ++j) { const unsigned c = xb_ld(&bar[XB_XCNT(j)]); sum += c; cnt += (c > 0u) ? 1u : 0u; mine = (j == x) ? c : mine; }
        if (sum == G) break;
        __builtin_amdgcn_s_sleep(1);
        if ((++sp & 255u) == 0u) { if (xb_ld(&bar[XB_TMO])) break; if (sp > XB_SPIN_CAP) { atomicAdd(&bar[XB_TMO], 1u); break; } }
    }
    nloc = mine > 0u ? mine : 1u; nx = cnt > 0u ? cnt : 1u;
}

__device__ __forceinline__ void xcd_barrier(const XcdBarrier& b, const int tid_) {
    asm volatile("s_waitcnt vmcnt(0)" ::: "memory");
    __syncthreads();
    if (tid_ == 0) {
        unsigned* bar = b.bar;
        __builtin_amdgcn_s_waitcnt(0);
        unsigned nloc = b.st[0], nx = b.st[1];
        if (nloc == 0u) { xcd_barrier_complete(bar, b.x, nloc, nx); b.st[0] = nloc; b.st[1] = nx; }
        const unsigned old = xb_add(&bar[XB_XSUB(b.x)], 1u);
        const unsigned gen = old / nloc;
        if (old + 1u == (gen + 1u) * nloc) {
            __builtin_amdgcn_fence(__ATOMIC_RELEASE, "agent");
            asm volatile("s_waitcnt vmcnt(0)" ::: "memory");
            const unsigned og = xb_add(&bar[XB_TOP], 1u);
            const unsigned tg = og / nx;
            if (og + 1u == (tg + 1u) * nx) xb_add(&bar[XB_TOPGEN], 1u);
            else XB_SPIN(xb_ld(&bar[XB_TOPGEN]) == tg, bar);
            __builtin_amdgcn_fence(__ATOMIC_ACQUIRE, "agent");
            xb_add(&bar[XB_XGEN(b.x)], 1u);
            asm volatile("s_waitcnt vmcnt(0)" ::: "memory");
        } else {
            XB_SPIN(xb_ld(&bar[XB_XGEN(b.x)]) == gen, bar);
            __builtin_amdgcn_fence(__ATOMIC_ACQUIRE, "agent");
            asm volatile("s_waitcnt vmcnt(0)" ::: "memory");
        }
    }
    __syncthreads();
}

constexpr int CW_BAR = 4096;
constexpr size_t CTL_ZERO_BYTES = 65536;
constexpr int LDSCTL_OFF = 131072, MISC_OFF = LDSCTL_OFF + 320;
constexpr int PH_PREP = 0, PH_MODR = 1, PH_N1 = 2, PH_L0 = 3, PH_PER_LAYER = 9, N_PHASES = PH_L0 + DEPTH * PH_PER_LAYER;
__device__ __forceinline__ Ctx make_ctx(LAS unsigned char* lds, int wave_s) {
    unsigned z_ = 0u; asm volatile("" : "+v"(z_));
    int tid_ = (wave_s << 6) | (int)__builtin_amdgcn_mbcnt_hi(~0u, __builtin_amdgcn_mbcnt_lo(~0u, z_)); asm volatile("" : "+v"(tid_));
    Ctx C; C.tid = tid_; C.lane = C.tid & 63; C.wave = __builtin_amdgcn_readfirstlane(C.tid >> 6); C.nblk = gridDim.x; C.blk = blockIdx.x;
    C.gw = C.blk * NWAVES + C.wave; C.ngw = C.nblk * NWAVES; C.lds = lds; return C;
}
#ifndef ONLYPH
#define ONLYPH -1
#endif
constexpr unsigned long long REP_MASK = 0ull;
#define PH(k, ...) if ((ONLYPH < 0 || ONLYPH == (k)) && a.ph_lo <= (k) && (k) < a.ph_hi) { for (int r_ = 0; r_ < 1 + (int)((REP_MASK >> (k)) & 1ull); ++r_) { const Ctx C = make_ctx(lds, wave_s); __VA_ARGS__; } if ((k) + 1 < a.ph_hi) xcd_barrier(bar, make_ctx(lds, wave_s).tid); }
template <int l>
__device__ __forceinline__ void run_layer(const Args& a, LAS unsigned char* lds, const XcdBarrier& bar, const int wave_s) {
    unsigned char* ws = a.ws; constexpr int B0 = PH_L0 + l * PH_PER_LAYER;
    PH(B0 + 0, EpiIn E{a.in[I_BIN] + (size_t)l * DIN, (bf16*)(ws + WS_UG), (bf16*)(ws + WS_ZP), (bf16*)(ws + WS_G)};
               GEMM(C, (const bf16*)(ws + WS_H), D, 0, (const bf16*)(ws + WS_WIN) + (size_t)l * DIN * D, D, M, DIN, D, E))
    PH(B0 + 1, phase_convpool(C, a, l))
    PH(B0 + 2, { EpiPool E{(const bf16*)(ws + WS_G), a.in[I_POOLS] + (size_t)l * D, (bf16*)(ws + WS_TMP)};
                 GEMM(C, (const bf16*)(ws + WS_PL), D, 256, (const bf16*)(ws + WS_POOL) + (size_t)l * 1024 * 256, 256, M, D, 256, E); }
               { const Ctx C2 = make_ctx(lds, wave_s); EpiConv E{(const bf16*)(ws + WS_G), (const bf16*)(ws + WS_TMP), (bf16*)(ws + WS_Y)};
                 GEMM(C2, (const bf16*)(ws + WS_AC), D, 0, (const bf16*)(ws + WS_WCO) + (size_t)l * D * D, D, M, D, D, E); })
    PH(B0 + 3, EpiOut E{l == 0 ? a.in[I_X] : a.out, a.out, modp(a, l, 0, 2), a.in[I_BOUT] + (size_t)l * D};
               GEMM(C, (const bf16*)(ws + WS_Y), D, 0, (const bf16*)(ws + WS_WOUT) + (size_t)l * D * D, D, M, D, D, E))
    PH(B0 + 4, phase_norm(C, a, a.out, a.in[I_N2G] + (size_t)l * D, l, 3, 4, (float*)(ws + WS_HSC)))
    PH(B0 + 5, { EpiQ E{(bf16*)(ws + WS_Q)}; GEMM(C, (const bf16*)(ws + WS_H), D, 0, (const bf16*)(ws + WS_WQ) + (size_t)l * DQ * D, D, M, DQ, D, E); }
               asm volatile("s_waitcnt vmcnt(0)" ::: "memory"); __syncthreads();
               { const Ctx C2 = make_ctx(lds, wave_s); EpiS E{(float*)(ws + WS_S)}; GEMM(C2, (const bf16*)(ws + WS_Q), DQ, 256, (const bf16*)(ws + WS_KEYS) + (size_t)l * 2048 * 256, 256, M, DQ, 256, E); }
               asm volatile("s_waitcnt vmcnt(0)" ::: "memory"); __syncthreads();
               { const Ctx C3 = make_ctx(lds, wave_s); phase_topk(C3, a); })
    PH(B0 + 6, phase_peer_a(C, a, l))
    PH(B0 + 7, phase_peer_c(C, a, l))
    PH(B0 + 8, phase_peer_b(C, a, l))
}
__global__ void __launch_bounds__(NTHREADS, 2) fwd_kernel(Args a) {
    extern __shared__ __attribute__((aligned(16))) unsigned char lds_raw[];
    LAS unsigned char* lds = (LAS unsigned char*)lds_raw;
    for (int u = threadIdx.x; u < (LDS_BYTES - LDSCTL_OFF) / 4; u += NTHREADS) ((LAS unsigned*)(lds + LDSCTL_OFF))[u] = 0u;
    __syncthreads();
    const int wave_s = __builtin_amdgcn_readfirstlane((int)threadIdx.x >> 6);
    const XcdBarrier bar = xcd_barrier_post((unsigned*)(a.ws + WS_CTL) + CW_BAR, (volatile LAS unsigned*)(lds + MISC_OFF) + 8);
    PH(PH_PREP, phase_prep(C, a))
    PH(PH_MODR, phase_modreduce(C, a))
    PH(PH_N1, phase_norm(C, a, a.in[I_X], a.in[I_N1G], 0, 0, 1, nullptr))
    run_layer<0>(a, lds, bar, wave_s);
    run_layer<1>(a, lds, bar, wave_s);
}

extern "C" void kernel_launch(void* const* d_in, const int* in_sizes, int n_in, void* d_out, int out_size, void* d_ws, size_t ws_size, hipStream_t stream) {
    static int grid = 0;
    if (grid == 0) {
        if (n_in != 22 || out_size != M * D || ws_size < WS_END) { fprintf(stderr, "kernel_launch: unexpected shapes (n_in %d out %d ws %zu)\n", n_in, out_size, ws_size); grid = -1; return; }
        int dev = 0, cus = 0;
        if (hipGetDevice(&dev) != hipSuccess || hipDeviceGetAttribute(&cus, hipDeviceAttributeMultiprocessorCount, dev) != hipSuccess) { grid = -1; return; }
        if (hipFuncSetAttribute((const void*)fwd_kernel, hipFuncAttributeMaxDynamicSharedMemorySize, LDS_BYTES) != hipSuccess) { grid = -1; return; }
        grid = cus;
    }
    if (grid < 0) return;
    Args a{};
    for (int i = 0; i < 22; ++i) a.in[i] = (const float*)d_in[i];
    a.out = (float*)d_out; a.ws = (unsigned char*)d_ws;
    (void)hipMemsetAsync((char*)d_ws + WS_CTL, 0, CTL_ZERO_BYTES, stream);
#ifndef ONE_LAUNCH
    for (int ph = 0; ph < N_PHASES; ++ph) { a.ph_lo = ph; a.ph_hi = ph + 1; hipLaunchKernelGGL(fwd_kernel, dim3(grid), dim3(NTHREADS), LDS_BYTES, stream, a); }
#else
    a.ph_lo = 0; a.ph_hi = N_PHASES; hipLaunchKernelGGL(fwd_kernel, dim3(grid), dim3(NTHREADS), LDS_BYTES, stream, a);
#endif
}
```

```cpp
#define ONE_LAUNCH 1
#include <hip/hip_runtime.h>
#include <cstdint>
#include <cstdio>
#include <utility>

#define GAS __attribute__((address_space(1)))
#define LAS __attribute__((address_space(3)))
typedef unsigned short bf16;
typedef float f32x4 __attribute__((ext_vector_type(4)));
typedef float f32x2 __attribute__((ext_vector_type(2)));
typedef unsigned u32x4 __attribute__((ext_vector_type(4)));
typedef unsigned u32x2 __attribute__((ext_vector_type(2)));
typedef __bf16 bf16x2_t __attribute__((ext_vector_type(2)));

constexpr int BATCH = 2, SEQ = 8192, D = 1024, M = BATCH * SEQ, DEPTH = 2;
constexpr int DIN = 5120, NMODV = 6 * D, CONVK = 31, NHEAD = 8, NKEYS = 128, DQ = 2048, TOPK = 16, NEXP = 16384;
constexpr float EPS = 1e-6f;
constexpr int NWAVES = 8, NTHREADS = NWAVES * 64;

constexpr size_t MiB = 1u << 20;
constexpr size_t WS_CTL = 0;
constexpr size_t WS_MODP = 1 * MiB;
constexpr size_t WS_MOD = 4 * MiB;
constexpr size_t WS_WIN = 8 * MiB;
constexpr size_t WS_WCO = 28 * MiB;
constexpr size_t WS_WOUT = 32 * MiB;
constexpr size_t WS_WQ = 36 * MiB;
constexpr size_t WS_POOL = 44 * MiB;
constexpr size_t WS_KEYS = 45 * MiB;
constexpr size_t WS_UB = 48 * MiB;
constexpr size_t WS_USC = 80 * MiB;
constexpr size_t WS_VSC = 81 * MiB;
constexpr size_t WS_VB = 112 * MiB;
constexpr size_t WS_H = 176 * MiB;
constexpr size_t WS_UG = 208 * MiB;
constexpr size_t WS_Y = WS_UG;
constexpr size_t WS_ZP = 240 * MiB;
constexpr size_t WS_TMP = WS_ZP;
constexpr size_t WS_Q = WS_UG;
constexpr size_t WS_G = 272 * MiB;
constexpr size_t WS_AC = 336 * MiB;
constexpr size_t WS_PL = 368 * MiB;
constexpr size_t WS_S = WS_G;
constexpr size_t WS_EID = 400 * MiB;
constexpr size_t WS_GW = 408 * MiB;
constexpr size_t WS_COEF = 416 * MiB;
constexpr size_t WS_CSC = 424 * MiB + 65536;
constexpr size_t WS_HSC = 424 * MiB;
constexpr size_t WS_PD = WS_S;
constexpr size_t WS_END = 425 * MiB;

constexpr int LDS_BYTES = 147456;

__device__ __forceinline__ unsigned f2bf(float f) { unsigned u = __builtin_bit_cast(unsigned, f); return (u + 0x7fffu + ((u >> 16) & 1u)) >> 16; }
__device__ __forceinline__ unsigned pk2(float lo, float hi) { return f2bf(lo) | (f2bf(hi) << 16); }
__device__ __forceinline__ float bflo(unsigned w) { return __builtin_bit_cast(float, w << 16); }
__device__ __forceinline__ float bfhi(unsigned w) { return __builtin_bit_cast(float, w & 0xffff0000u); }
__device__ __forceinline__ float sigm(float x) { return __builtin_amdgcn_rcpf(1.f + __expf(-x)); }
__device__ __forceinline__ float wave_sum(float v) {
#pragma unroll
    for (int o = 1; o < 64; o <<= 1) v += __shfl_xor(v, o);
    return v;
}
__device__ __forceinline__ float wave_max(float v) {
#pragma unroll
    for (int o = 1; o < 64; o <<= 1) v = fmaxf(v, __shfl_xor(v, o));
    return v;
}
__device__ __forceinline__ float dpp_sum63(float v) {
#define DPPF(x, ctrl, rm, bc) __builtin_bit_cast(float, __builtin_amdgcn_update_dpp(0, __builtin_bit_cast(int, x), ctrl, rm, 0xf, bc))
    v += DPPF(v, 0x111, 0xf, true); v += DPPF(v, 0x112, 0xf, true); v += DPPF(v, 0x114, 0xf, true); v += DPPF(v, 0x118, 0xf, true);
    v += DPPF(v, 0x142, 0xa, false); v += DPPF(v, 0x143, 0xc, false);
#undef DPPF
    return v;
}
__device__ __forceinline__ u32x4 pack8(const f32x4& a, const f32x4& b) { u32x4 w; w.x = pk2(a.x, a.y); w.y = pk2(a.z, a.w); w.z = pk2(b.x, b.y); w.w = pk2(b.z, b.w); return w; }
__device__ __forceinline__ void unpack8(const u32x4& w, f32x4& a, f32x4& b) { a = (f32x4){bflo(w.x), bfhi(w.x), bflo(w.y), bfhi(w.y)}; b = (f32x4){bflo(w.z), bfhi(w.z), bflo(w.w), bfhi(w.w)}; }

struct Ctx { int tid, lane, wave, gw, ngw, nblk, blk; LAS unsigned char* lds; };

struct Args { const float* in[22]; float* out; unsigned char* ws; int ph_lo, ph_hi; };
enum { I_X = 0, I_C, I_ADAW, I_ADAB, I_N1G, I_WIN, I_BIN, I_CONVW, I_CONVB, I_LNG, I_LNB, I_WCO, I_POOLW, I_POOLS, I_WOUT, I_BOUT, I_N2G, I_WQ, I_KEYS, I_PU, I_PV, I_FG };

__device__ __forceinline__ void transpose_item(const float* W, int K, int N, int k0, int n0, bf16* WT, int dstrow0, LAS float* scr, int lane) {
#pragma unroll 8
    for (int i = 0; i < 32; ++i) { const int kk = 2 * i + (lane >> 5); scr[kk * 33 + (lane & 31)] = W[(size_t)(k0 + kk) * N + n0 + (lane & 31)]; }
    asm volatile("s_waitcnt lgkmcnt(0)" ::: "memory");
    const int c = lane & 7;
#pragma unroll
    for (int j = 0; j < 4; ++j) { const int n = (lane >> 3) + 8 * j; const LAS float* s = scr + (8 * c) * 33 + n;
        u32x4 o; o.x = pk2(s[0 * 33], s[1 * 33]); o.y = pk2(s[2 * 33], s[3 * 33]); o.z = pk2(s[4 * 33], s[5 * 33]); o.w = pk2(s[6 * 33], s[7 * 33]);
        *(u32x4*)(WT + (size_t)(dstrow0 + n) * K + k0 + 8 * c) = o; }
    asm volatile("s_waitcnt lgkmcnt(0)" ::: "memory");
}
__device__ __forceinline__ int win_dstrow(int n0) {
    if (n0 < 1024) return 256 * (n0 >> 7) + (n0 & 127);
    if (n0 < 2048) { const int c = n0 - 1024; return 256 * (c >> 7) + 128 + (c & 127); }
    return n0;
}
__device__ __forceinline__ void phase_prep(const Ctx& C, const Args& a) {
    unsigned char* ws = a.ws;
    LAS float* scr = (LAS float*)(C.lds + C.wave * 16384);
    constexpr int I_IN = 16 * 160, I_CO = 16 * 32, I_PO = 4 * (4 * 8), I_OUT = 16 * 32, I_Q = 16 * 64, I_L = I_IN + I_CO + I_PO + I_OUT + I_Q;
    for (int it = C.gw; it < DEPTH * I_L; it += C.ngw) {
        const int l = it / I_L; int r = it % I_L;
        if (r < I_IN) { const int kb = r / 160, nb = r % 160; transpose_item(a.in[I_WIN] + (size_t)l * D * DIN, D, DIN, 64 * kb, 32 * nb, (bf16*)(ws + WS_WIN) + (size_t)l * DIN * D, win_dstrow(32 * nb), scr, C.lane); continue; } r -= I_IN;
        if (r < I_CO) { const int kb = r / 32, nb = r % 32; transpose_item(a.in[I_WCO] + (size_t)l * D * D, D, D, 64 * kb, 32 * nb, (bf16*)(ws + WS_WCO) + (size_t)l * D * D, 32 * nb, scr, C.lane); continue; } r -= I_CO;
        if (r < I_PO) { const int g = r / 32, q = r % 32, kb = q / 8, nb = q % 8; transpose_item(a.in[I_POOLW] + ((size_t)l * 4 + g) * 256 * 256, 256, 256, 64 * kb, 32 * nb, (bf16*)(ws + WS_POOL) + ((size_t)l * 1024 + 256 * g) * 256, 32 * nb, scr, C.lane); continue; } r -= I_PO;
        if (r < I_OUT) { const int kb = r / 32, nb = r % 32; transpose_item(a.in[I_WOUT] + (size_t)l * D * D, D, D, 64 * kb, 32 * nb, (bf16*)(ws + WS_WOUT) + (size_t)l * D * D, 32 * nb, scr, C.lane); continue; } r -= I_OUT;
        { const int kb = r / 64, nb = r % 64; transpose_item(a.in[I_WQ] + (size_t)l * D * DQ, D, DQ, 64 * kb, 32 * nb, (bf16*)(ws + WS_WQ) + (size_t)l * DQ * D, 32 * nb, scr, C.lane); }
    }
    const int gt = C.blk * NTHREADS + C.tid, ngt = C.nblk * NTHREADS;
    for (int i = gt; i < DEPTH * 2048 * 32; i += ngt) {
        const int l = i / (2048 * 32), r = i % (2048 * 32), n = r / 32, k8 = (r % 32) * 8;
        const int h = n >> 8, p = (n >> 7) & 1, key = n & 127, pk = k8 >> 7, kk = k8 & 127;
        u32x4 o = (u32x4){0u, 0u, 0u, 0u};
        if (pk == p) { const float* s = a.in[I_KEYS] + ((((size_t)l * 8 + h) * 2 + p) * 128 + key) * 128 + kk; const f32x4 v0 = *(const f32x4*)s, v1 = *(const f32x4*)(s + 4); o = pack8(v0, v1); }
        *(u32x4*)((bf16*)(ws + WS_KEYS) + ((size_t)l * 2048 + n) * 256 + k8) = o;
    }
    for (int t = 0; t < 2; ++t) {
        const float* src = a.in[t == 0 ? I_PU : I_PV]; unsigned char* dst = ws + (t == 0 ? WS_UB : WS_VB); float* scl = (float*)(ws + (t == 0 ? WS_USC : WS_VSC));
        for (int row0 = 4 * C.gw; row0 < DEPTH * NEXP; row0 += 4 * C.ngw) {
            f32x4 v[4][4]; float am[4];
#pragma unroll
            for (int r = 0; r < 4; ++r)
#pragma unroll
                for (int q = 0; q < 4; ++q) v[r][q] = *(const f32x4*)(src + (size_t)(row0 + r) * D + 16 * C.lane + 4 * q);
#pragma unroll
            for (int r = 0; r < 4; ++r) { float m = 0.f;
#pragma unroll
                for (int q = 0; q < 4; ++q) m = fmaxf(m, fmaxf(fmaxf(fabsf(v[r][q].x), fabsf(v[r][q].y)), fmaxf(fabsf(v[r][q].z), fabsf(v[r][q].w))));
                am[r] = wave_max(m); }
#pragma unroll
            for (int r = 0; r < 4; ++r) { const float inv = am[r] > 0.f ? 127.f / am[r] : 0.f; u32x4 w; const int row = row0 + r;
#pragma unroll
                for (int q = 0; q < 4; ++q) w[q] = ((unsigned)(int)rintf(v[r][q].x * inv) & 255u) | (((unsigned)(int)rintf(v[r][q].y * inv) & 255u) << 8) | (((unsigned)(int)rintf(v[r][q].z * inv) & 255u) << 16) | ((unsigned)(int)rintf(v[r][q].w * inv) << 24);
                { const int lyr = row / NEXP, e = row % NEXP; *(u32x4*)(dst + (((size_t)lyr * 8 + (C.lane >> 3)) * NEXP + e) * 128 + 16 * (C.lane & 7)) = w; }
                if (C.lane == 0) scl[row] = am[r] * (1.f / 127.f); }
        }
    }
    for (int it = gt; it < 32 * 3072; it += ngt) {
        const int ks = it / 3072, cg = it % 3072, l = cg / 1536, n4 = (cg % 1536) * 4;
        f32x4 a0 = (f32x4){0.f, 0.f, 0.f, 0.f}, a1 = a0;
        const float* wp = a.in[I_ADAW] + ((size_t)l * D + ks * 32) * NMODV + n4; const float* c0 = a.in[I_C] + ks * 32; const float* c1 = c0 + D;
#pragma unroll 8
        for (int kk = 0; kk < 32; ++kk) { const f32x4 w = *(const f32x4*)(wp + (size_t)kk * NMODV); const float x0 = c0[kk], x1 = c1[kk]; a0 += w * (x0 * sigm(x0)); a1 += w * (x1 * sigm(x1)); }
        float* mp = (float*)(ws + WS_MODP) + (((size_t)ks * 2 + l) * 2) * NMODV + n4;
        *(f32x4*)mp = a0; *(f32x4*)(mp + NMODV) = a1;
    }
}
__device__ __forceinline__ void phase_modreduce(const Ctx& C, const Args& a) {
    const int gt = C.blk * NTHREADS + C.tid, ngt = C.nblk * NTHREADS;
    for (int i = gt; i < 2 * 2 * NMODV; i += ngt) {
        const int l = i / (2 * NMODV), n = i % NMODV; float s = a.in[I_ADAB][(size_t)l * NMODV + n];
        const float* mp = (const float*)(a.ws + WS_MODP) + i;
        for (int ks = 0; ks < 32; ++ks) s += mp[(size_t)ks * 4 * NMODV];
        ((float*)(a.ws + WS_MOD))[i] = s;
    }
}
__device__ __forceinline__ const float* modp(const Args& a, int l, int b, int v) { return (const float*)(a.ws + WS_MOD) + ((size_t)l * 2 + b) * NMODV + v * D; }

__device__ __forceinline__ void normmod_row(const f32x4 (&x)[4], const float* g, const float* sh, const float* sc, int lane, f32x4 (&h)[4]) {
    float s = 0.f;
#pragma unroll
    for (int j = 0; j < 4; ++j) s += (x[j].x * x[j].x + x[j].y * x[j].y) + (x[j].z * x[j].z + x[j].w * x[j].w);
    const float rstd = 1.f / sqrtf(wave_sum(s) * (1.f / D) + EPS);
#pragma unroll
    for (int j = 0; j < 4; ++j) { const int c = 4 * lane + 256 * j; const f32x4 gv = *(const f32x4*)(g + c), shv = *(const f32x4*)(sh + c), scv = *(const f32x4*)(sc + c);
        h[j] = (x[j] * rstd) * gv * (scv + 1.f) + shv; }
}
__device__ __forceinline__ void store_row_bf16(bf16* row, const f32x4 (&h)[4], int lane) {
#pragma unroll
    for (int j = 0; j < 4; ++j) { u32x2 w; w.x = pk2(h[j].x, h[j].y); w.y = pk2(h[j].z, h[j].w); *(u32x2*)(row + 4 * lane + 256 * j) = w; }
}
__device__ __forceinline__ void phase_norm(const Ctx& C, const Args& a, const float* X, const float* g, int l, int vsh, int vsc, float* hsc) {
    bf16* H = (bf16*)(a.ws + WS_H);
    for (int m = C.gw; m < M; m += C.ngw) {
        const int b = m >> 13; f32x4 x[4], h[4];
#pragma unroll
        for (int j = 0; j < 4; ++j) x[j] = *(const f32x4*)(X + (size_t)m * D + 4 * C.lane + 256 * j);
        normmod_row(x, g, modp(a, l, b, vsh), modp(a, l, b, vsc), C.lane, h);
        store_row_bf16(H + (size_t)m * D, h, C.lane);
        if (hsc) { float am = 0.f;
#pragma unroll
            for (int j = 0; j < 4; ++j) { const unsigned w0 = pk2(h[j].x, h[j].y), w1 = pk2(h[j].z, h[j].w); am = fmaxf(am, fmaxf(fmaxf(fabsf(bflo(w0)), fabsf(bfhi(w0))), fmaxf(fabsf(bflo(w1)), fabsf(bfhi(w1))))); }
            am = wave_max(am); if (C.lane == 0) hsc[m] = am * (1.f / 127.f); }
    }
}

struct EpiIn {
    const float* bin; bf16 *UG, *ZP, *G;
    __device__ __forceinline__ void apply(int row, int pn, int cl8, f32x4 a0, f32x4 a1, f32x4 b0, f32x4 b1) const {
        if (pn < 8) {
            const int c = 128 * pn + cl8;
            a0 += *(const f32x4*)(bin + c); a1 += *(const f32x4*)(bin + c + 4); b0 += *(const f32x4*)(bin + 1024 + c); b1 += *(const f32x4*)(bin + 1024 + c + 4);
            f32x4 u0, u1;
#pragma unroll
            for (int i = 0; i < 4; ++i) { u0[i] = a0[i] * sigm(b0[i]); u1[i] = a1[i] * sigm(b1[i]); }
            *(u32x4*)(UG + (size_t)row * D + c) = pack8(u0, u1);
        } else if (pn < 12) {
            const int c = 256 * (pn - 8) + cl8;
            a0 += *(const f32x4*)(bin + 2048 + c); a1 += *(const f32x4*)(bin + 2048 + c + 4); b0 += *(const f32x4*)(bin + 2048 + 128 + c); b1 += *(const f32x4*)(bin + 2048 + 128 + c + 4);
            *(u32x4*)(ZP + (size_t)row * D + c) = pack8(a0, a1); *(u32x4*)(ZP + (size_t)row * D + c + 128) = pack8(b0, b1);
        } else {
            const int c = 256 * (pn - 12) + cl8;
            a0 += *(const f32x4*)(bin + 3072 + c); a1 += *(const f32x4*)(bin + 3072 + c + 4); b0 += *(const f32x4*)(bin + 3072 + 128 + c); b1 += *(const f32x4*)(bin + 3072 + 128 + c + 4);
#pragma unroll
            for (int i = 0; i < 4; ++i) { a0[i] = sigm(a0[i]); a1[i] = sigm(a1[i]); b0[i] = sigm(b0[i]); b1[i] = sigm(b1[i]); }
            *(u32x4*)(G + (size_t)row * 2048 + c) = pack8(a0, a1); *(u32x4*)(G + (size_t)row * 2048 + c + 128) = pack8(b0, b1);
        }
    }
};
struct EpiPool {
    const bf16* G; const float* scale; bf16* TMP;
    __device__ __forceinline__ void apply(int row, int pn, int cl8, f32x4 a0, f32x4 a1, f32x4 b0, f32x4 b1) const {
        const int c = 256 * pn + cl8; f32x4 g0, g1;
        unpack8(*(const u32x4*)(G + (size_t)row * 2048 + 1024 + c), g0, g1);
        a0 = a0 * g0 * *(const f32x4*)(scale + c); a1 = a1 * g1 * *(const f32x4*)(scale + c + 4);
        *(u32x4*)(TMP + (size_t)row * D + c) = pack8(a0, a1);
        unpack8(*(const u32x4*)(G + (size_t)row * 2048 + 1024 + c + 128), g0, g1);
        b0 = b0 * g0 * *(const f32x4*)(scale + c + 128); b1 = b1 * g1 * *(const f32x4*)(scale + c + 132);
        *(u32x4*)(TMP + (size_t)row * D + c + 128) = pack8(b0, b1);
    }
};
struct EpiConv {
    const bf16* G; const bf16* TMP; bf16* Y;
    __device__ __forceinline__ void apply(int row, int pn, int cl8, f32x4 a0, f32x4 a1, f32x4 b0, f32x4 b1) const {
        const int c = 256 * pn + cl8; f32x4 g0, g1, t0, t1;
        unpack8(*(const u32x4*)(G + (size_t)row * 2048 + c), g0, g1); unpack8(*(const u32x4*)(TMP + (size_t)row * D + c), t0, t1);
        *(u32x4*)(Y + (size_t)row * D + c) = pack8(a0 * g0 + t0, a1 * g1 + t1);
        unpack8(*(const u32x4*)(G + (size_t)row * 2048 + c + 128), g0, g1); unpack8(*(const u32x4*)(TMP + (size_t)row * D + c + 128), t0, t1);
        *(u32x4*)(Y + (size_t)row * D + c + 128) = pack8(b0 * g0 + t0, b1 * g1 + t1);
    }
};
struct EpiOut {
    const float* xold; float* xnew; const float* g1;   const float* bout;
    __device__ __forceinline__ void apply(int row, int pn, int cl8, f32x4 a0, f32x4 a1, f32x4 b0, f32x4 b1) const {
        const int c = 256 * pn + cl8; const float* g = g1 + (size_t)(row >> 13) * NMODV; const size_t o = (size_t)row * D + c;
        *(f32x4*)(xnew + o) = *(const f32x4*)(xold + o) + *(const f32x4*)(g + c) * (a0 + *(const f32x4*)(bout + c));
        *(f32x4*)(xnew + o + 4) = *(const f32x4*)(xold + o + 4) + *(const f32x4*)(g + c + 4) * (a1 + *(const f32x4*)(bout + c + 4));
        *(f32x4*)(xnew + o + 128) = *(const f32x4*)(xold + o + 128) + *(const f32x4*)(g + c + 128) * (b0 + *(const f32x4*)(bout + c + 128));
        *(f32x4*)(xnew + o + 132) = *(const f32x4*)(xold + o + 132) + *(const f32x4*)(g + c + 132) * (b1 + *(const f32x4*)(bout + c + 132));
    }
};
struct EpiQ {
    bf16* Q;
    __device__ __forceinline__ void apply(int row, int pn, int cl8, f32x4 a0, f32x4 a1, f32x4 b0, f32x4 b1) const {
        const size_t o = (size_t)row * DQ + 256 * pn + cl8; *(u32x4*)(Q + o) = pack8(a0, a1); *(u32x4*)(Q + o + 128) = pack8(b0, b1);
    }
};
struct EpiS {
    float* S;
    __device__ __forceinline__ void apply(int row, int pn, int cl8, f32x4 a0, f32x4 a1, f32x4 b0, f32x4 b1) const {
        const size_t o = (size_t)row * DQ + 256 * pn + cl8; *(f32x4*)(S + o) = a0; *(f32x4*)(S + o + 4) = a1; *(f32x4*)(S + o + 128) = b0; *(f32x4*)(S + o + 132) = b1;
    }
};

namespace pg8 {
#define PG8_LAS __attribute__((address_space(3)))
typedef unsigned short bf16_t;
typedef short bf16x8 __attribute__((ext_vector_type(8)));
typedef float f32x4 __attribute__((ext_vector_type(4)));
typedef unsigned u32x4 __attribute__((ext_vector_type(4)));
constexpr int BM = 256, BK = 64, HALF = 128, HTB = HALF * BK * 2  , STAGE_BYTES = 8 * HTB, NXCD = 8, WGM = 8;

__host__ __device__ __forceinline__ int lds_byte(int r, int c) { const int st = (r >> 4) * 2 + (c >> 5), rr = r & 15, cc = c & 31, ob = rr * 64 + cc * 2; return st * 1024 + (ob ^ (((ob >> 9) & 1) << 5)); }
__host__ __device__ __forceinline__ void stage_rc(int b, int& R, int& C) { const int st = b / 1024, sb = b % 1024, swz = sb ^ (((sb >> 9) & 1) << 5); R = (st >> 1) * 16 + swz / 64; C = (st & 1) * 32 + (swz % 64) / 2; }
__host__ __device__ __forceinline__ int perm32(int rho) { const int n = rho >> 4, i = rho & 15; return 8 * (i >> 2) + 4 * n + (i & 3); }

struct Unit { int pm, pn; };
struct Gemm { const bf16_t* A; const bf16_t* Bt; int M, N, K, lda, ldb, acol; };

struct StaticOrder {
    int nM, nN, nwg, G, c;
    __host__ __device__ void init(int M, int N, int G_, int c_) { nM = M / BM; nN = N / BM; nwg = nM * nN; G = G_; c = c_; }
    __host__ __device__ bool next(int i, Unit& u) const {
        const long L = (long)i * G + c; if (L >= nwg) return false;
        int wgid = (int)L; { const int q = nwg / NXCD, r = nwg % NXCD, xcd = wgid % NXCD, off = wgid / NXCD; wgid = (xcd < r ? xcd * (q + 1) : r * (q + 1) + (xcd - r) * q) + off; }
        const int nig = WGM * nN, gid = wgid / nig, fm = gid * WGM, gsz = (nM - fm) < WGM ? (nM - fm) : WGM;
        u.pm = fm + ((wgid % nig) % gsz); u.pn = (wgid % nig) / gsz; return true;
    }
    __device__ __forceinline__ void a_ready(const Unit&) const {}
    __device__ __forceinline__ void done(const Unit&) const {}
};


template <class Epi, class Sched, bool ALIGN_EPI = false, bool SP2 = false>
__device__ __forceinline__ void gemm_phase(PG8_LAS unsigned char* lds, const Gemm g, const Sched& S, const Epi& E, const int tid) {
    const int wid = __builtin_amdgcn_readfirstlane(tid >> 6), lane = tid & 63, wr = wid >> 2, wc = wid & 3, fr = lane & 15, fq = lane >> 4;
    const int K = g.K, nt = K / BK;
    unsigned voffA[2], voffB[2];
#pragma unroll
    for (int i = 0; i < 2; ++i) { int R, C; stage_rc(tid * 16 + i * 8192, R, C); const int Rb = Epi::PERM ? ((R & ~31) + perm32(R & 31)) : R;
        voffA[i] = (unsigned)(R * g.lda + C) * 2u; voffB[i] = (unsigned)(Rb * g.ldb + C) * 2u; }
    const size_t kstep = (size_t)(BK * 2);
    const size_t hstepA = (size_t)HALF * g.lda * 2, hstepB = (size_t)HALF * g.ldb * 2;
    const size_t tstepA = 2 * hstepA, tstepB = 2 * hstepB, acolb = (size_t)g.acol * 2;
    const unsigned ldsw = (unsigned)wid * 1024u;
    const int aoff = lds_byte(wr * 64 + fr, fq * 8), boff = lds_byte(wc * 32 + fr, fq * 8);
#define PG8_SA(b, h) (((b) * 2 + (h)) * HTB)
#define PG8_SB(b, h) ((4 + (b) * 2 + (h)) * HTB)
#define PG8_STAGE(bufoff, gbase, voff) do { _Pragma("unroll") for (int _i = 0; _i < 2; ++_i) \
        __builtin_amdgcn_global_load_lds((const unsigned*)((const char*)(gbase) + (voff)[_i]), (PG8_LAS unsigned*)(lds + (bufoff) + ldsw + _i * 8192), 16, 0, 0); } while (0)
#define PG8_LDA(dst, b, h) do { _Pragma("unroll") for (int m = 0; m < 4; ++m) _Pragma("unroll") for (int k = 0; k < 2; ++k) dst[m][k] = *(const PG8_LAS bf16x8*)(lds + PG8_SA(b, h) + aoff + m * 2048 + k * 1024); } while (0)
#define PG8_LDB(dst, b, h) do { _Pragma("unroll") for (int n = 0; n < 2; ++n) _Pragma("unroll") for (int k = 0; k < 2; ++k) dst[n][k] = *(const PG8_LAS bf16x8*)(lds + PG8_SB(b, h) + boff + n * 2048 + k * 1024); } while (0)
#define PG8_MMA(ai, bj, At, Bt) do { __builtin_amdgcn_s_setprio(1); _Pragma("unroll") for (int m = 0; m < 4; ++m) _Pragma("unroll") for (int n = 0; n < 2; ++n) _Pragma("unroll") for (int k = 0; k < 2; ++k) \
        acc[ai][bj][m][n] = __builtin_amdgcn_mfma_f32_16x16x32_bf16(Bt[n][k], At[m][k], acc[ai][bj][m][n], 0, 0, 0); __builtin_amdgcn_s_setprio(0); } while (0)
#define PG8_WAIT_V(n) asm volatile("s_waitcnt vmcnt(" #n ")" ::: "memory")
#define PG8_WAIT_L(n) asm volatile("s_waitcnt lgkmcnt(" #n ")" ::: "memory")
#define PG8_BAR __builtin_amdgcn_s_barrier()
#define PG8_SCHED __builtin_amdgcn_sched_barrier(0)
    Unit cur, nxt; int ui = 0;
    if (!S.next(0, cur)) return;
    f32x4 acc[2][2][4][2];
#pragma unroll
    for (int a = 0; a < 2; ++a)
#pragma unroll
        for (int b = 0; b < 2; ++b)
#pragma unroll
            for (int m = 0; m < 4; ++m)
#pragma unroll
                for (int n = 0; n < 2; ++n) acc[a][b][m][n] = (f32x4){0.f, 0.f, 0.f, 0.f};
    bf16x8 At[4][2], B0[2][2], B1[2][2];
    const char* cA = (const char*)g.A + (size_t)cur.pm * tstepA + (size_t)cur.pn * acolb; const char* cB = (const char*)g.Bt + (size_t)cur.pn * tstepB;
    S.a_ready(cur);
    if constexpr (SP2) {
        PG8_STAGE(PG8_SB(0, 0), cB, voffB); PG8_STAGE(PG8_SB(0, 1), cB + hstepB, voffB); PG8_STAGE(PG8_SA(0, 0), cA, voffA); PG8_STAGE(PG8_SA(0, 1), cA + hstepA, voffA);
        if (wr == 1) PG8_BAR;
        PG8_WAIT_V(2); PG8_BAR;
        PG8_STAGE(PG8_SB(1, 0), cB + kstep, voffB); PG8_STAGE(PG8_SA(1, 0), cA + kstep, voffA); PG8_STAGE(PG8_SB(1, 1), cB + hstepB + kstep, voffB);
        PG8_WAIT_V(6); PG8_BAR;
    } else {
        PG8_STAGE(PG8_SB(0, 0), cB, voffB); PG8_STAGE(PG8_SA(0, 0), cA, voffA); PG8_STAGE(PG8_SB(0, 1), cB + hstepB, voffB); PG8_STAGE(PG8_SA(0, 1), cA + hstepA, voffA);
        if (wr == 1) PG8_BAR;
        PG8_WAIT_V(4); PG8_BAR;
        PG8_STAGE(PG8_SB(1, 0), cB + kstep, voffB); PG8_STAGE(PG8_SA(1, 0), cA + kstep, voffA); PG8_STAGE(PG8_SB(1, 1), cB + hstepB + kstep, voffB);
        PG8_WAIT_V(6); PG8_BAR;
    }
    for (;;) {
        const bool has_next = S.next(ui + 1, nxt);
        const char* nA = has_next ? (const char*)g.A + (size_t)nxt.pm * tstepA + (size_t)nxt.pn * acolb : cA; const char* nB = has_next ? (const char*)g.Bt + (size_t)nxt.pn * tstepB : cB;
#pragma nounroll
        for (int t = 0; t < nt; t += 2) {
            const bool last = (t == nt - 2);
            const char* a1 = cA + (size_t)(t + 1) * kstep;
            const char* a2 = last ? nA : cA + (size_t)(t + 2) * kstep; const char* b2 = last ? nB : cB + (size_t)(t + 2) * kstep;
            const char* a3 = a2 + kstep; const char* b3 = b2 + kstep;
            if (last && has_next) S.a_ready(nxt);
            if constexpr (SP2) {
            PG8_LDB(B0, 0, 0); PG8_LDB(B1, 0, 1); PG8_SCHED; PG8_LDA(At, 0, 0); PG8_STAGE(PG8_SA(1, 1), a1 + hstepA, voffA);
            PG8_WAIT_V(8); PG8_WAIT_L(0); PG8_BAR; PG8_MMA(0, 0, At, B0); PG8_MMA(0, 1, At, B1); PG8_BAR; PG8_SCHED;
            PG8_LDA(At, 0, 1); PG8_STAGE(PG8_SB(0, 0), b2, voffB); PG8_STAGE(PG8_SB(0, 1), b2 + hstepB, voffB); PG8_STAGE(PG8_SA(0, 0), a2, voffA);
            PG8_WAIT_V(8); PG8_WAIT_L(0); PG8_BAR; PG8_MMA(1, 0, At, B0); PG8_MMA(1, 1, At, B1); PG8_BAR; PG8_SCHED;
            PG8_LDB(B0, 1, 0); PG8_LDB(B1, 1, 1); PG8_SCHED; PG8_LDA(At, 1, 0); PG8_STAGE(PG8_SA(0, 1), a2 + hstepA, voffA);
            PG8_WAIT_V(8); PG8_WAIT_L(0); PG8_BAR; PG8_MMA(0, 0, At, B0); PG8_MMA(0, 1, At, B1); PG8_BAR; PG8_SCHED;
            PG8_LDA(At, 1, 1); PG8_STAGE(PG8_SB(1, 0), b3, voffB); PG8_STAGE(PG8_SB(1, 1), b3 + hstepB, voffB); PG8_STAGE(PG8_SA(1, 0), a3, voffA);
            PG8_WAIT_V(8); PG8_WAIT_L(0); PG8_BAR; PG8_MMA(1, 0, At, B0); PG8_MMA(1, 1, At, B1); PG8_BAR; PG8_SCHED;
            } else {
            PG8_LDB(B0, 0, 0); PG8_SCHED; PG8_LDA(At, 0, 0); PG8_STAGE(PG8_SA(1, 1), a1 + hstepA, voffA);
            PG8_WAIT_L(8); PG8_BAR; PG8_WAIT_L(0); PG8_MMA(0, 0, At, B0); PG8_BAR; PG8_SCHED;
            PG8_LDB(B1, 0, 1); PG8_STAGE(PG8_SB(0, 0), b2, voffB);
            PG8_BAR; PG8_WAIT_L(0); PG8_MMA(0, 1, At, B1); PG8_BAR;
            PG8_LDA(At, 0, 1); PG8_STAGE(PG8_SA(0, 0), a2, voffA);
            PG8_BAR; PG8_WAIT_L(0); PG8_MMA(1, 0, At, B0); PG8_BAR; PG8_SCHED;
            PG8_STAGE(PG8_SB(0, 1), b2 + hstepB, voffB);
            PG8_WAIT_V(6); PG8_BAR; PG8_MMA(1, 1, At, B1); PG8_BAR;
            PG8_LDB(B0, 1, 0); PG8_SCHED; PG8_LDA(At, 1, 0); PG8_STAGE(PG8_SA(0, 1), a2 + hstepA, voffA);
            PG8_WAIT_L(8); PG8_BAR; PG8_WAIT_L(0); PG8_MMA(0, 0, At, B0); PG8_BAR; PG8_SCHED;
            PG8_LDB(B1, 1, 1); PG8_STAGE(PG8_SB(1, 0), b3, voffB);
            PG8_BAR; PG8_WAIT_L(0); PG8_MMA(0, 1, At, B1); PG8_BAR;
            PG8_LDA(At, 1, 1); PG8_STAGE(PG8_SA(1, 0), a3, voffA);
            PG8_BAR; PG8_WAIT_L(0); PG8_MMA(1, 0, At, B0); PG8_BAR; PG8_SCHED;
            PG8_STAGE(PG8_SB(1, 1), b3 + hstepB, voffB);
            PG8_WAIT_V(6); PG8_BAR; PG8_MMA(1, 1, At, B1); PG8_BAR;
            }
        }
        if constexpr (ALIGN_EPI) { if (wr == 0) PG8_BAR; }
        if constexpr (!Epi::AFTER_DRAIN) { E(acc, cur, wr, wc, fr, fq); S.done(cur); }
        if (!has_next) break;
#pragma unroll
        for (int a = 0; a < 2; ++a)
#pragma unroll
            for (int b = 0; b < 2; ++b)
#pragma unroll
                for (int m = 0; m < 4; ++m)
#pragma unroll
                    for (int n = 0; n < 2; ++n) acc[a][b][m][n] = (f32x4){0.f, 0.f, 0.f, 0.f};
        cur = nxt; cA = nA; cB = nB; ++ui;
        if constexpr (ALIGN_EPI) { if (wr == 1) PG8_BAR; }
    }
    PG8_WAIT_V(0);
    if constexpr (!ALIGN_EPI) { if (wr == 0) PG8_BAR; }
    PG8_BAR;
    if constexpr (Epi::AFTER_DRAIN) { E.fused(acc, cur, wr, wc, fr, fq, lds, wid, lane); S.done(cur); }
#undef PG8_SA
#undef PG8_SB
#undef PG8_STAGE
#undef PG8_LDA
#undef PG8_LDB
#undef PG8_MMA
#undef PG8_WAIT_V
#undef PG8_WAIT_L
#undef PG8_BAR
#undef PG8_SCHED
}

template <class F> struct EpiW {
    static constexpr bool PERM = true, AFTER_DRAIN = false; F f;
    __device__ __forceinline__ void operator()(const f32x4 (&acc)[2][2][4][2], const Unit& u, int wr, int wc, int fr, int fq) const {
#pragma unroll
        for (int ai = 0; ai < 2; ++ai)
#pragma unroll
            for (int m = 0; m < 4; ++m) { f.apply(u.pm * BM + ai * HALF + wr * 64 + m * 16 + fr, u.pn, wc * 32 + 8 * fq, acc[ai][0][m][0], acc[ai][0][m][1], acc[ai][1][m][0], acc[ai][1][m][1]);
                asm volatile("" ::: "memory"); }
    }
};
}

template <class F>
__device__ __forceinline__ void mfma_gemm(const Ctx& C, const bf16* A, int lda, int acol, const bf16* Bt, int ldb, int Mr, int N, int K, const F& f) {
    pg8::Gemm g{A, Bt, Mr, N, K, lda, ldb, acol}; pg8::StaticOrder S; S.init(Mr, N, C.nblk, C.blk); pg8::EpiW<F> E{f};
    pg8::gemm_phase<pg8::EpiW<F>, pg8::StaticOrder, true, true>(C.lds, g, S, E, C.tid);
}

template <class F>
__device__ __forceinline__ void naive_gemm(const Ctx& C, const bf16* A, int lda, int acol, const bf16* Bt, int ldb, int Mr, int N, int K, const F& f) {
    LAS float* As = (LAS float*)C.lds;
    LAS float* Bs = (LAS float*)(C.lds + 8192);
    const int ntm = Mr / 128, ntn = N / 256, tid = C.tid, cg = tid & 15, r0 = tid >> 4;
    for (int tile = C.blk; tile < ntm * ntn; tile += C.nblk) {
        const int tm = tile / ntn, pn = tile % ntn;
        f32x4 acc[4][4];
#pragma unroll
        for (int i = 0; i < 4; ++i)
#pragma unroll
            for (int j = 0; j < 4; ++j) acc[i][j] = (f32x4){0.f, 0.f, 0.f, 0.f};
        const bf16* ap = A + (size_t)(tm * 128 + (tid >> 2)) * lda + pn * acol + (tid & 3) * 4;
        const bf16* bp = Bt + (size_t)(pn * 256 + (tid >> 1)) * ldb + (tid & 1) * 8;
        for (int k0 = 0; k0 < K; k0 += 16) {
            const u32x2 av = *(const u32x2*)(ap + k0); const u32x4 bv = *(const u32x4*)(bp + k0);
            __syncthreads();
            { const int r = tid >> 2, kq = (tid & 3) * 4; As[(kq + 0) * 128 + r] = bflo(av.x); As[(kq + 1) * 128 + r] = bfhi(av.x); As[(kq + 2) * 128 + r] = bflo(av.y); As[(kq + 3) * 128 + r] = bfhi(av.y); }
            { const int n = tid >> 1, kq = (tid & 1) * 8; Bs[(kq + 0) * 256 + n] = bflo(bv.x); Bs[(kq + 1) * 256 + n] = bfhi(bv.x); Bs[(kq + 2) * 256 + n] = bflo(bv.y); Bs[(kq + 3) * 256 + n] = bfhi(bv.y);
              Bs[(kq + 4) * 256 + n] = bflo(bv.z); Bs[(kq + 5) * 256 + n] = bfhi(bv.z); Bs[(kq + 6) * 256 + n] = bflo(bv.w); Bs[(kq + 7) * 256 + n] = bfhi(bv.w); }
            __syncthreads();
#pragma unroll
            for (int kk = 0; kk < 16; ++kk) {
                const f32x4 b0 = *(const LAS f32x4*)(Bs + kk * 256 + cg * 8), b1 = *(const LAS f32x4*)(Bs + kk * 256 + cg * 8 + 4), b2 = *(const LAS f32x4*)(Bs + kk * 256 + 128 + cg * 8), b3 = *(const LAS f32x4*)(Bs + kk * 256 + 128 + cg * 8 + 4);
#pragma unroll
                for (int i = 0; i < 4; ++i) { const float av1 = As[kk * 128 + r0 + 32 * i]; acc[i][0] += b0 * av1; acc[i][1] += b1 * av1; acc[i][2] += b2 * av1; acc[i][3] += b3 * av1; }
            }
        }
#pragma unroll
        for (int i = 0; i < 4; ++i) f.apply(tm * 128 + r0 + 32 * i, pn, cg * 8, acc[i][0], acc[i][1], acc[i][2], acc[i][3]);
    }
}

template <int NROWS>
__device__ __forceinline__ void cp_stage(LAS unsigned char* tile, const bf16* src, int mrow0, int tfirst, int tid) {
    constexpr int NIT = (NROWS * 128 + NTHREADS - 1) / NTHREADS;
    asm volatile("" : "+v"(tid));
    u32x4 v[NIT];
#pragma unroll
    for (int i = 0; i < NIT; ++i) { const int ch = i * NTHREADS + tid, r = ch >> 7, c = ch & 127; v[i] = (u32x4){0u, 0u, 0u, 0u};
        if (ch < NROWS * 128 && tfirst + r >= 0) v[i] = *(const u32x4*)(src + (size_t)(mrow0 + r) * D + c * 8); }
#pragma unroll
    for (int i = 0; i < NIT; ++i) { const int ch = i * NTHREADS + tid; if (ch < NROWS * 128) *(LAS u32x4*)(tile + ch * 16) = v[i]; }
}
template <int W>
__device__ __forceinline__ void pool_item(const LAS unsigned char* tile, bf16* PL, int m0, int t0, int tid) {
    float p0[47], p1[47];
#pragma unroll
    for (int i = 0; i < 47; ++i) { unsigned w = 0u; if (i >= 15 - (W - 1)) w = *(const LAS unsigned*)(tile + i * 2048 + 4 * tid); p0[i] = bflo(w); p1[i] = bfhi(w); }
#pragma unroll
    for (int ti = 0; ti < 32; ++ti) {
        float s0 = 0.f, s1 = 0.f;
#pragma unroll
        for (int j = 0; j < W; ++j) { s0 += p0[ti + 15 - j]; s1 += p1[ti + 15 - j]; }
        const int cnt = (t0 + ti + 1) < W ? (t0 + ti + 1) : W; const float inv = 1.f / (float)cnt;
        *(unsigned*)(PL + (size_t)(m0 + ti) * D + 2 * tid) = pk2(s0 * inv - p0[ti + 15], s1 * inv - p1[ti + 15]);
    }
}
template <int RI>
__device__ __forceinline__ void conv_row(const LAS unsigned char* tile, int tid, const float (&w0)[31], const float (&w1)[31], float (&a0)[32], float (&a1)[32]) {
    const unsigned w = *(const LAS unsigned*)(tile + RI * 2048 + 4 * tid);
    const float u0 = bflo(w), u1 = bfhi(w);
#pragma unroll
    for (int ti = 0; ti < 32; ++ti) { constexpr int dbase = 30 - RI; const int d = ti + dbase; if (d >= 0 && d <= 30) { a0[ti] += w0[30 - d] * u0; a1[ti] += w1[30 - d] * u1; } }
    if constexpr ((RI & 7) == 7) asm volatile("" ::: "memory");
}
template <int... RI>
__device__ __forceinline__ void conv_rows(const LAS unsigned char* tile, int tid, const float (&w0)[31], const float (&w1)[31], float (&a0)[32], float (&a1)[32], std::integer_sequence<int, RI...>) {
    (conv_row<RI>(tile, tid, w0, w1, a0, a1), ...);
}
__device__ __forceinline__ void phase_convpool(const Ctx& C, const Args& a, int l) {
    const bf16* UG = (const bf16*)(a.ws + WS_UG); const bf16* ZP = (const bf16*)(a.ws + WS_ZP);
    bf16* AC = (bf16*)(a.ws + WS_AC); bf16* PL = (bf16*)(a.ws + WS_PL);
    const float* cw = a.in[I_CONVW] + (size_t)l * CONVK * D; const float* cb = a.in[I_CONVB] + (size_t)l * D;
    const float* lng = a.in[I_LNG] + (size_t)l * D; const float* lnb = a.in[I_LNB] + (size_t)l * D;
    LAS float* red = (LAS float*)C.lds;
    LAS float* stat = (LAS float*)(C.lds + 2048);
    LAS unsigned char* tile = C.lds + 4096;
    int tid = C.tid;
    asm volatile("" : "+v"(tid));
    const int c0 = 2 * tid;
    float w0[31], w1[31];
#pragma unroll
    for (int k = 0; k < 31; ++k) { const f32x2 w = *(const f32x2*)(cw + (size_t)k * D + c0); w0[k] = w.x; w1[k] = w.y; }
    const f32x2 bb = *(const f32x2*)(cb + c0), gg = *(const f32x2*)(lng + c0), be = *(const f32x2*)(lnb + c0);
    for (int item = C.blk; item < M / 32; item += C.nblk) {
        const int m0 = item * 32, t0 = m0 & (SEQ - 1);
        __syncthreads();
        cp_stage<62>(tile, UG, m0 - 30, t0 - 30, tid);
        __syncthreads();
        float a0[32], a1[32];
#pragma unroll
        for (int i = 0; i < 32; ++i) { a0[i] = bb.x; a1[i] = bb.y; }
        conv_rows(tile, tid, w0, w1, a0, a1, std::make_integer_sequence<int, 62>{});
#pragma unroll
        for (int ti = 0; ti < 32; ++ti) {
            const float s = dpp_sum63(a0[ti] + a1[ti]), q = dpp_sum63(a0[ti] * a0[ti] + a1[ti] * a1[ti]);
            if (C.lane == 63) { red[C.wave * 64 + ti] = s; red[C.wave * 64 + 32 + ti] = q; }
        }
        __syncthreads();
        if (tid < 32) { float s = 0.f, q = 0.f;
#pragma unroll
            for (int w = 0; w < 8; ++w) { s += red[w * 64 + tid]; q += red[w * 64 + 32 + tid]; }
            const float mean = s * (1.f / D), var = fmaxf(q * (1.f / D) - mean * mean, 0.f); stat[tid] = mean; stat[32 + tid] = 1.f / sqrtf(var + EPS); }
        __syncthreads();
#pragma unroll
        for (int ti = 0; ti < 32; ++ti) { const float mean = stat[ti], rstd = stat[32 + ti];
            const float y0 = (a0[ti] - mean) * rstd * gg.x + be.x, y1 = (a1[ti] - mean) * rstd * gg.y + be.y;
            *(unsigned*)(AC + (size_t)(m0 + ti) * D + c0) = pk2(y0 * sigm(y0), y1 * sigm(y1)); }
        asm volatile("" ::: "memory");
        cp_stage<47>(tile, ZP, m0 - 15, t0 - 15, tid);
        __syncthreads();
        const int g = tid >> 7;
        if (g == 0) pool_item<2>(tile, PL, m0, t0, tid); else if (g == 1) pool_item<4>(tile, PL, m0, t0, tid); else if (g == 2) pool_item<8>(tile, PL, m0, t0, tid); else pool_item<16>(tile, PL, m0, t0, tid);
    }
}

typedef unsigned u32;
template <int CTRL> __device__ __forceinline__ u32 dppu(u32 x) { return (u32)__builtin_amdgcn_update_dpp(0, (int)x, CTRL, 0xf, 0xf, true); }
constexpr int DPP_XOR1 = 0xB1, DPP_REV4 = 0x1B, DPP_DUPE = 0xA0, DPP_DUPO = 0xF5, DPP_HMIRROR = 0x141, DPP_MIRROR = 0x140;
__device__ __forceinline__ u32 umax_(u32 a, u32 b) { return a > b ? a : b; }
__device__ __forceinline__ u32 umin_(u32 a, u32 b) { return a < b ? a : b; }
#define TK_CE(x, i, j) do { const u32 hi_ = umax_(x[i], x[j]), lo_ = umin_(x[i], x[j]); x[i] = hi_; x[j] = lo_; } while (0)
__device__ __forceinline__ void tk_local_merge(u32 (&x)[8]) {
    TK_CE(x, 0, 4); TK_CE(x, 1, 5); TK_CE(x, 2, 6); TK_CE(x, 3, 7);
    TK_CE(x, 0, 2); TK_CE(x, 1, 3); TK_CE(x, 4, 6); TK_CE(x, 5, 7);
    TK_CE(x, 0, 1); TK_CE(x, 2, 3); TK_CE(x, 4, 5); TK_CE(x, 6, 7);
}
template <int CTRL> __device__ __forceinline__ void tk_level(u32 (&x)[8], bool even) {
    u32 t[8];
#pragma unroll
    for (int c = 0; c < 8; ++c) t[c] = dppu<CTRL>(x[7 - c]);
#pragma unroll
    for (int c = 0; c < 8; ++c) x[c] = umax_(x[c], t[c]);
#pragma unroll
    for (int c = 0; c < 8; ++c) { const u32 p = dppu<DPP_XOR1>(x[c]); x[c] = even ? umax_(x[c], p) : umin_(x[c], p); }
    tk_local_merge(x);
}
__device__ __forceinline__ void tk_top16(u32 (&x)[8], bool even) {
    TK_CE(x, 0, 1); TK_CE(x, 2, 3); TK_CE(x, 4, 5); TK_CE(x, 6, 7);
    TK_CE(x, 0, 2); TK_CE(x, 1, 3); TK_CE(x, 4, 6); TK_CE(x, 5, 7);
    TK_CE(x, 1, 2); TK_CE(x, 5, 6);
    TK_CE(x, 0, 4); TK_CE(x, 1, 5); TK_CE(x, 2, 6); TK_CE(x, 3, 7);
    TK_CE(x, 2, 4); TK_CE(x, 3, 5);
    TK_CE(x, 1, 2); TK_CE(x, 3, 4); TK_CE(x, 5, 6);
    { u32 t[8];
#pragma unroll
      for (int c = 0; c < 8; ++c) t[c] = dppu<DPP_XOR1>(x[7 - c]);
#pragma unroll
      for (int c = 0; c < 8; ++c) x[c] = even ? umax_(x[c], t[c]) : umin_(x[c], t[c]); }
    tk_local_merge(x);
    tk_level<DPP_REV4>(x, even); tk_level<DPP_HMIRROR>(x, even); tk_level<DPP_MIRROR>(x, even);
}
__device__ __forceinline__ u32 tk_f2key(float v, int slot) { const u32 u = __builtin_bit_cast(u32, v); const u32 k = u ^ ((u32)((int)u >> 31) | 0x80000000u); return (k & ~127u) | (u32)(127 - slot); }
__device__ __forceinline__ float tk_key2f(u32 k) { k &= ~127u; const u32 m = (u32)((int)k >> 31); return __builtin_bit_cast(float, k ^ (~m | 0x80000000u)); }
__device__ __forceinline__ u32 tk_sel8v(u32 r0, u32 r1, u32 r2, u32 r3, u32 r4, u32 r5, u32 r6, u32 r7, int idx) {
    const bool b0 = idx & 1, b1 = idx & 2, b2 = idx & 4;
    const u32 s01 = b0 ? r1 : r0, s23 = b0 ? r3 : r2, s45 = b0 ? r5 : r4, s67 = b0 ? r7 : r6;
    const u32 s03 = b1 ? s23 : s01, s47 = b1 ? s67 : s45;
    return b2 ? s47 : s03; }
#define tk_sel8(r, idx) tk_sel8v(r[0], r[1], r[2], r[3], r[4], r[5], r[6], r[7], idx)
__device__ __forceinline__ void phase_topk(const Ctx& C, const Args& a) {
    const float* S = (const float*)(a.ws + WS_S); int* EID = (int*)(a.ws + WS_EID); float* GW = (float*)(a.ws + WS_GW);
    const int lane = C.lane, r = lane & 15, q = lane >> 4; const bool even = (lane & 1) == 0;
    pg8::StaticOrder SO; SO.init(M, DQ, C.nblk, C.blk); pg8::Unit un;
    for (int ui = 0; SO.next(ui, un); ++ui)
    for (int wi = C.wave; wi < 64; wi += NWAVES) {
        const int tok = un.pm * 256 + wi * 4 + q, h = un.pn;
        u32 xa[8], xb[8];
        { const float* sp = S + (size_t)tok * DQ + h * 256 + 8 * r; const f32x4 v0 = *(const f32x4*)sp, v1 = *(const f32x4*)(sp + 4), w0 = *(const f32x4*)(sp + 128), w1 = *(const f32x4*)(sp + 132);
#pragma unroll
          for (int c = 0; c < 4; ++c) { xa[c] = tk_f2key(v0[c], 8 * r + c); xa[4 + c] = tk_f2key(v1[c], 8 * r + 4 + c); xb[c] = tk_f2key(w0[c], 8 * r + c); xb[4 + c] = tk_f2key(w1[c], 8 * r + 4 + c); } }
        tk_top16(xa, even); tk_top16(xb, even);
        u32 La[8], Ha[8], Lb[8], Hb[8];
#pragma unroll
        for (int c = 0; c < 8; ++c) { La[c] = dppu<DPP_DUPE>(xa[c]); Ha[c] = dppu<DPP_DUPO>(xa[c]); Lb[c] = dppu<DPP_DUPE>(xb[c]); Hb[c] = dppu<DPP_DUPO>(xb[c]); }
        const u32 a_lane = (r < 8) ? tk_sel8(La, r & 7) : tk_sel8(Ha, r & 7), b_lane = (r < 8) ? tk_sel8(Lb, r & 7) : tk_sel8(Hb, r & 7);
        const float va = tk_key2f(a_lane), vbl = tk_key2f(b_lane), va0 = tk_key2f(La[0]);
        u32 ck[8];
#pragma unroll
        for (int j = 0; j < 8; ++j) { constexpr int lim[8] = {15, 7, 4, 3, 2, 1, 1, 1};
            float v = va + tk_key2f(Lb[j]); bool valid = r <= lim[j];
            if (j == 1) { v = (r >= 8) ? va0 + vbl : v; valid = valid || (r >= 8); }
            ck[j] = valid ? tk_f2key(v, 8 * r + j) : 0u; }
        tk_top16(ck, even);
        const float mx = tk_key2f(dppu<DPP_DUPE>(ck[0]));
        float ex[8], sum = 0.f;
#pragma unroll
        for (int c = 0; c < 8; ++c) { ex[c] = __expf(tk_key2f(ck[c]) - mx); sum += ex[c]; }
        sum += __builtin_bit_cast(float, dppu<DPP_XOR1>(__builtin_bit_cast(u32, sum)));
        const float inv = 1.f / sum;
        int eo[8]; float go[8];
#pragma unroll
        for (int c = 0; c < 8; ++c) { const int slot = 127 - (int)(ck[c] & 127u), i = slot >> 3, j = slot & 7; const bool sp = (j == 1) && (i >= 8);
            const int i2 = sp ? 0 : i, j2 = sp ? i : j;
            const u32 ka = (u32)__builtin_amdgcn_ds_bpermute(((lane & ~15) + i2) << 2, (int)a_lane), kb = (u32)__builtin_amdgcn_ds_bpermute(((lane & ~15) + j2) << 2, (int)b_lane);
            eo[c] = (127 - (int)(ka & 127u)) * 128 + (127 - (int)(kb & 127u)); go[c] = ex[c] * inv; }
        if (r < 2) { int* ep = EID + (size_t)tok * 128 + h * 16 + r * 8; float* gp = GW + (size_t)tok * 128 + h * 16 + r * 8;
            *(u32x4*)ep = (u32x4){(u32)eo[0], (u32)eo[1], (u32)eo[2], (u32)eo[3]}; *(u32x4*)(ep + 4) = (u32x4){(u32)eo[4], (u32)eo[5], (u32)eo[6], (u32)eo[7]};
            *(f32x4*)gp = (f32x4){go[0], go[1], go[2], go[3]}; *(f32x4*)(gp + 4) = (f32x4){go[4], go[5], go[6], go[7]}; }
    }
}

__device__ __forceinline__ float dot2bf(unsigned w, unsigned x, float acc) { return __builtin_amdgcn_fdot2_f32_bf16(__builtin_bit_cast(bf16x2_t, w), __builtin_bit_cast(bf16x2_t, x), acc, false); }
constexpr int PNB = 8;
__device__ __forceinline__ void phase_peer_a(const Ctx& C, const Args& a, int l) {
    const int x = C.blk & 7, wg = (C.blk >> 3) * NWAVES + C.wave, nwg = ((C.nblk + 7 - x) >> 3) * NWAVES;
    const __amdgpu_buffer_rsrc_t UC = __builtin_amdgcn_make_buffer_rsrc(a.ws + WS_UB + ((size_t)l * 8 + x) * NEXP * 128, 0, NEXP * 128, 0x00020000);
    const int* EID = (const int*)(a.ws + WS_EID); const bf16* H = (const bf16*)(a.ws + WS_H); const float* HSC = (const float*)(a.ws + WS_HSC); float* PD = (float*)(a.ws + WS_PD);
    LAS float* dl = (LAS float*)(C.lds + C.wave * 1024);
    for (int t = wg; t < M; t += nwg) {
        unsigned z_ = 0u; asm volatile("" : "+v"(z_));
        const int lane = (int)__builtin_amdgcn_mbcnt_hi(~0u, __builtin_amdgcn_mbcnt_lo(~0u, z_)), p = lane & 7, g = lane >> 3;
        const int ev0 = EID[(size_t)t * 128 + lane], ev1 = EID[(size_t)t * 128 + 64 + lane];
        const float hs = HSC[t], inv = hs > 0.f ? 1.f / hs : 0.f;
        const u32x4 r0 = *(const u32x4*)(H + (size_t)t * D + 128 * x + 16 * p), r1 = *(const u32x4*)(H + (size_t)t * D + 128 * x + 16 * p + 8);
        u32x4 rows[16];
#pragma unroll
        for (int j = 0; j < 16; ++j) { const int e = __builtin_amdgcn_ds_bpermute(((8 * j + g) & 63) << 2, j < 8 ? ev0 : ev1);
            rows[j] = __builtin_bit_cast(u32x4, __builtin_amdgcn_raw_buffer_load_b128(UC, e * 128 + 16 * p, 0, 0)); }
        u32x4 hq; { f32x4 f[4]; unpack8(r0, f[0], f[1]); unpack8(r1, f[2], f[3]);
#pragma unroll
            for (int q = 0; q < 4; ++q) hq[q] = ((unsigned)(int)rintf(f[q].x * inv) & 255u) | (((unsigned)(int)rintf(f[q].y * inv) & 255u) << 8) | (((unsigned)(int)rintf(f[q].z * inv) & 255u) << 16) | ((unsigned)(int)rintf(f[q].w * inv) << 24); }
        float tot[16];
#pragma unroll
        for (int j = 0; j < 16; ++j) {
            int acc = __builtin_amdgcn_sdot4((int)rows[j].x, (int)hq.x, 0, false); acc = __builtin_amdgcn_sdot4((int)rows[j].y, (int)hq.y, acc, false);
            acc = __builtin_amdgcn_sdot4((int)rows[j].z, (int)hq.z, acc, false); acc = __builtin_amdgcn_sdot4((int)rows[j].w, (int)hq.w, acc, false);
            acc += __builtin_amdgcn_update_dpp(0, acc, 0xB1, 0xf, 0xf, true); acc += __builtin_amdgcn_update_dpp(0, acc, 0x4E, 0xf, 0xf, true); acc += __builtin_amdgcn_update_dpp(0, acc, 0x141, 0xf, 0xf, true);
            tot[j] = (float)acc; }
        if (p == 0) {
#pragma unroll
            for (int j = 0; j < 16; ++j) dl[8 * j + g] = tot[j]; }
        asm volatile("s_waitcnt lgkmcnt(0)" ::: "memory");
        const float d0 = dl[lane], d1 = dl[64 + lane];
        PD[((size_t)t * 8 + x) * 128 + lane] = d0; PD[((size_t)t * 8 + x) * 128 + 64 + lane] = d1;
        asm volatile("s_waitcnt lgkmcnt(0)" ::: "memory");
    }
}
__device__ __forceinline__ void phase_peer_c(const Ctx& C, const Args& a, int l) {
    const float* USC = (const float*)(a.ws + WS_USC) + (size_t)l * NEXP; const float* VSC = (const float*)(a.ws + WS_VSC) + (size_t)l * NEXP;
    const int* EID = (const int*)(a.ws + WS_EID); const float* GW = (const float*)(a.ws + WS_GW); const float* HSC = (const float*)(a.ws + WS_HSC); const float* PD = (const float*)(a.ws + WS_PD);
    int* C8 = (int*)(a.ws + WS_COEF); float* CSC = (float*)(a.ws + WS_CSC);
    for (int t = C.gw; t < M; t += C.ngw) { float cf[2]; const float hs = HSC[t];
#pragma unroll
        for (int u = 0; u < 2; ++u) { const int k = 64 * u + C.lane, e = EID[(size_t)t * 128 + k]; float d = 0.f;
#pragma unroll
            for (int xx = 0; xx < 8; ++xx) d += PD[((size_t)t * 8 + xx) * 128 + k];
            const float dd = d * USC[e] * hs; cf[u] = VSC[e] * GW[(size_t)t * 128 + k] * 0.5f * dd * (1.f + erff(dd * 0.70710678118654752f)); }
        const float am = wave_max(fmaxf(fabsf(cf[0]), fabsf(cf[1]))), inv = am > 0.f ? 127.f / am : 0.f;
        C8[(size_t)t * 128 + C.lane] = (int)rintf(cf[0] * inv) & 255; C8[(size_t)t * 128 + 64 + C.lane] = (int)rintf(cf[1] * inv) & 255;
        if (C.lane == 0) CSC[t] = am * (1.f / 127.f); }
}
__device__ __forceinline__ void phase_peer_b(const Ctx& C, const Args& a, int l) {
    const int x = C.blk & 7, wg = (C.blk >> 3) * NWAVES + C.wave, nwg = ((C.nblk + 7 - x) >> 3) * NWAVES;
    const __amdgpu_buffer_rsrc_t VC = __builtin_amdgcn_make_buffer_rsrc(a.ws + WS_VB + ((size_t)l * 8 + x) * NEXP * 128, 0, NEXP * 128, 0x00020000);
    const int* EID = (const int*)(a.ws + WS_EID); const int* C8 = (const int*)(a.ws + WS_COEF); const float* CSC = (const float*)(a.ws + WS_CSC); float* XW = a.out;
    LAS int* ol = (LAS int*)(C.lds + C.wave * 4096);
    unsigned z_ = 0u; asm volatile("" : "+v"(z_));
    const int lane = (int)__builtin_amdgcn_mbcnt_hi(~0u, __builtin_amdgcn_mbcnt_lo(~0u, z_)), p = lane & 7, g = lane >> 3;
#define PB_META(t_, ev0_, ev1_, cf0_, cf1_) do { ev0_ = EID[(size_t)(t_) * 128 + lane]; ev1_ = EID[(size_t)(t_) * 128 + 64 + lane]; cf0_ = C8[(size_t)(t_) * 128 + lane]; cf1_ = C8[(size_t)(t_) * 128 + 64 + lane]; } while (0)
#define PB_ISSUE(rows_, ev_) do { _Pragma("unroll") for (int j = 0; j < 8; ++j) { const int e = __builtin_amdgcn_ds_bpermute((8 * j + g) << 2, ev_); \
        rows_[j] = __builtin_bit_cast(u32x4, __builtin_amdgcn_raw_buffer_load_b128(VC, e * 128 + 16 * p, 0, 0)); } } while (0)
#define PB_HALF(rows_, cf_) do { _Pragma("unroll") for (int j = 0; j < 8; ++j) { const int c0_ = __builtin_amdgcn_ds_bpermute((8 * j + g) << 2, cf_), c1_ = c0_ << 8, c2_ = c0_ << 16, c3_ = c0_ << 24; \
            _Pragma("unroll") for (int q = 0; q < 4; ++q) { const int w_ = (int)rows_[j][q];   \
                o[4 * q + 0] = __builtin_amdgcn_sdot4(w_, c0_, o[4 * q + 0], false); o[4 * q + 1] = __builtin_amdgcn_sdot4(w_, c1_, o[4 * q + 1], false); \
                o[4 * q + 2] = __builtin_amdgcn_sdot4(w_, c2_, o[4 * q + 2], false); o[4 * q + 3] = __builtin_amdgcn_sdot4(w_, c3_, o[4 * q + 3], false); } } } while (0)
    int evA0, evA1, evB0, evB1, cfA0, cfA1, cfB0, cfB1; u32x4 rows0[8], rows1[8];
    const f32x2 g2b0 = *(const f32x2*)(modp(a, l, 0, 5) + 128 * x + 2 * lane), g2b1 = *(const f32x2*)(modp(a, l, 1, 5) + 128 * x + 2 * lane);
    int t = wg;
    { const int tc = t < M ? t : 0; PB_META(tc, evA0, evA1, cfA0, cfA1); }
    { const int tc = t + nwg < M ? t + nwg : 0; PB_META(tc, evB0, evB1, cfB0, cfB1); }
    PB_ISSUE(rows0, evA0);
    f32x2 xvn; float csn; { const int tc = t < M ? t : 0; xvn = *(const f32x2*)(XW + (size_t)tc * D + 128 * x + 2 * lane); csn = CSC[tc]; }
#pragma nounroll
    for (; t < M; t += nwg) {
        const int t2 = t + 2 * nwg, c2 = t2 < M ? t2 : t;
        const int k0 = cfA0, k1 = cfA1;
        const f32x2 xv = xvn; const float cs = csn;
        PB_ISSUE(rows1, evA1);
        evA0 = evB0; evA1 = evB1; cfA0 = cfB0; cfA1 = cfB1;
        PB_META(c2, evB0, evB1, cfB0, cfB1);
        { const int c1 = t + nwg < M ? t + nwg : t; xvn = *(const f32x2*)(XW + (size_t)c1 * D + 128 * x + 2 * lane); csn = CSC[c1]; }
        __builtin_amdgcn_sched_barrier(0);
        int o[16];
#pragma unroll
        for (int i = 0; i < 16; ++i) o[i] = 0;
        PB_HALF(rows0, k0);
        __builtin_amdgcn_sched_barrier(0);
        PB_ISSUE(rows0, evA0);
        __builtin_amdgcn_sched_barrier(0);
        PB_HALF(rows1, k1);
        __builtin_amdgcn_sched_barrier(0);
#pragma unroll
        for (int q = 0; q < 4; ++q) *(LAS u32x4*)(ol + lane * 16 + 4 * q) = (u32x4){(unsigned)o[4 * q], (unsigned)o[4 * q + 1], (unsigned)o[4 * q + 2], (unsigned)o[4 * q + 3]};
        asm volatile("s_waitcnt lgkmcnt(0)" ::: "memory");
        int s0 = 0, s1 = 0;
#pragma unroll
        for (int gg = 0; gg < 8; ++gg) { const u32x2 v = *(const LAS u32x2*)(ol + (gg * 8 + (lane >> 3)) * 16 + 2 * (lane & 7)); s0 += (int)v.x; s1 += (int)v.y; }
        asm volatile("s_waitcnt lgkmcnt(0)" ::: "memory");
        const int c = 128 * x + 2 * lane; const f32x2 g2 = (t >> 13) ? g2b1 : g2b0;
        *(f32x2*)(XW + (size_t)t * D + c) = xv + g2 * (f32x2){(float)s0 * cs, (float)s1 * cs};
    }
#undef PB_META
#undef PB_ISSUE
#undef PB_HALF
}
__device__ __forceinline__ void phase_final(const Ctx& C, const Args& a) {
    for (int m = C.gw; m < M; m += C.ngw) { f32x4 x[4]; float ss = 0.f;
#pragma unroll
        for (int j = 0; j < 4; ++j) { x[j] = *(const f32x4*)(a.out + (size_t)m * D + 4 * C.lane + 256 * j); ss += (x[j].x * x[j].x + x[j].y * x[j].y) + (x[j].z * x[j].z + x[j].w * x[j].w); }
        const float rstd = 1.f / sqrtf(wave_sum(ss) * (1.f / D) + EPS);
#pragma unroll
        for (int j = 0; j < 4; ++j) *(f32x4*)(a.out + (size_t)m * D + 4 * C.lane + 256 * j) = x[j] * rstd * *(const f32x4*)(a.in[I_FG] + 4 * C.lane + 256 * j); }
}

#ifndef USE_NAIVE
#define GEMM mfma_gemm
#else
#define GEMM naive_gemm
#endif
#define RLX_AGENT __ATOMIC_RELAXED, __HIP_MEMORY_SCOPE_AGENT
#define XB_TMO      128
#define XB_XCNT(j)  (256  + 64 * (j))
#define XB_XSUB(j)  (1280 + 64 * (j))
#define XB_XGEN(j)  (2304 + 64 * (j))
#define XB_TOP      3328
#define XB_TOPGEN   3392
#define XCD_BAR_WORDS 3456
#define XB_SPIN_CAP (1u << 18)

__device__ __forceinline__ unsigned xb_ld(unsigned* p)              { return __hip_atomic_load(p, __ATOMIC_RELAXED, __HIP_MEMORY_SCOPE_AGENT); }
__device__ __forceinline__ unsigned xb_add(unsigned* p, unsigned v) { return __hip_atomic_fetch_add(p, v, __ATOMIC_RELAXED, __HIP_MEMORY_SCOPE_AGENT); }
__device__ __forceinline__ unsigned xb_xcc_id() { return (unsigned)__builtin_amdgcn_s_getreg((3 << 11) | 20) & 0xFu; }
#define XB_SPIN(cond, bar) do { unsigned _sp = 0; while (cond) { __builtin_amdgcn_s_sleep(1); \
    if ((++_sp & 255u) == 0u) { if (xb_ld(&(bar)[XB_TMO])) break; if (_sp > XB_SPIN_CAP) { atomicAdd(&(bar)[XB_TMO], 1u); break; } } } } while (0)

struct XcdBarrier {
    unsigned* bar; unsigned x;
    volatile LAS unsigned* st;
};

__device__ __forceinline__ XcdBarrier xcd_barrier_post(unsigned* bar, volatile LAS unsigned* st) {
    XcdBarrier b; b.bar = bar; b.x = xb_xcc_id(); b.st = st;
    if (threadIdx.x == 0) (void)xb_add(&bar[XB_XCNT(b.x)], 1u);
    return b;
}
__device__ __forceinline__ void xcd_barrier_complete(unsigned* bar, unsigned x, unsigned& nloc, unsigned& nx) {
    const unsigned G = gridDim.x * gridDim.y * gridDim.z;
    unsigned sum, cnt, mine, sp = 0u;
    for (;;) {
        sum = 0u; cnt = 0u; mine = 0u;
#pragma unroll
        for (unsigned j = 0; j < 16; ++j) { const unsigned c = xb_ld(&bar[XB_XCNT(j)]); sum += c; cnt += (c > 0u) ? 1u : 0u; mine = (j == x) ? c : mine; }
        if (sum == G) break;
        __builtin_amdgcn_s_sleep(1);
        if ((++sp & 255u) == 0u) { if (xb_ld(&bar[XB_TMO])) break; if (sp > XB_SPIN_CAP) { atomicAdd(&bar[XB_TMO], 1u); break; } }
    }
    nloc = mine > 0u ? mine : 1u; nx = cnt > 0u ? cnt : 1u;
}

__device__ __forceinline__ void xcd_barrier(const XcdBarrier& b, const int tid_) {
    asm volatile("s_waitcnt vmcnt(0)" ::: "memory");
    __syncthreads();
    if (tid_ == 0) {
        unsigned* bar = b.bar;
        __builtin_amdgcn_s_waitcnt(0);
        unsigned nloc = b.st[0], nx = b.st[1];
        if (nloc == 0u) { xcd_barrier_complete(bar, b.x, nloc, nx); b.st[0] = nloc; b.st[1] = nx; }
        const unsigned old = xb_add(&bar[XB_XSUB(b.x)], 1u);
        const unsigned gen = old / nloc;
        if (old + 1u == (gen + 1u) * nloc) {
            __builtin_amdgcn_fence(__ATOMIC_RELEASE, "agent");
            asm volatile("s_waitcnt vmcnt(0)" ::: "memory");
            const unsigned og = xb_add(&bar[XB_TOP], 1u);
            const unsigned tg = og / nx;
            if (og + 1u == (tg + 1u) * nx) xb_add(&bar[XB_TOPGEN], 1u);
            else XB_SPIN(xb_ld(&bar[XB_TOPGEN]) == tg, bar);
            __builtin_amdgcn_fence(__ATOMIC_ACQUIRE, "agent");
            xb_add(&bar[XB_XGEN(b.x)], 1u);
            asm volatile("s_waitcnt vmcnt(0)" ::: "memory");
        } else {
            XB_SPIN(xb_ld(&bar[XB_XGEN(b.x)]) == gen, bar);
            __builtin_amdgcn_fence(__ATOMIC_ACQUIRE, "agent");
            asm volatile("s_waitcnt vmcnt(0)" ::: "memory");
        }
    }
    __syncthreads();
}

constexpr int CW_BAR = 4096;
constexpr size_t CTL_ZERO_BYTES = 65536;
constexpr int LDSCTL_OFF = 131072, MISC_OFF = LDSCTL_OFF + 320;
constexpr int PH_PREP = 0, PH_MODR = 1, PH_N1 = 2, PH_L0 = 3, PH_PER_LAYER = 10, N_PHASES = PH_L0 + DEPTH * PH_PER_LAYER;
__device__ __forceinline__ Ctx make_ctx(LAS unsigned char* lds, int wave_s) {
    unsigned z_ = 0u; asm volatile("" : "+v"(z_));
    int tid_ = (wave_s << 6) | (int)__builtin_amdgcn_mbcnt_hi(~0u, __builtin_amdgcn_mbcnt_lo(~0u, z_)); asm volatile("" : "+v"(tid_));
    Ctx C; C.tid = tid_; C.lane = C.tid & 63; C.wave = __builtin_amdgcn_readfirstlane(C.tid >> 6); C.nblk = gridDim.x; C.blk = blockIdx.x;
    C.gw = C.blk * NWAVES + C.wave; C.ngw = C.nblk * NWAVES; C.lds = lds; return C;
}
#ifndef ONLYPH
#define ONLYPH -1
#endif
constexpr unsigned long long REP_MASK = 0ull;
#define PH(k, ...) if ((ONLYPH < 0 || ONLYPH == (k)) && a.ph_lo <= (k) && (k) < a.ph_hi) { for (int r_ = 0; r_ < 1 + (int)((REP_MASK >> (k)) & 1ull); ++r_) { const Ctx C = make_ctx(lds, wave_s); __VA_ARGS__; } if ((k) + 1 < a.ph_hi) xcd_barrier(bar, make_ctx(lds, wave_s).tid); }
template <int l>
__device__ __forceinline__ void run_layer(const Args& a, LAS unsigned char* lds, const XcdBarrier& bar, const int wave_s) {
    unsigned char* ws = a.ws; constexpr int B0 = PH_L0 + l * PH_PER_LAYER;
    PH(B0 + 0, EpiIn E{a.in[I_BIN] + (size_t)l * DIN, (bf16*)(ws + WS_UG), (bf16*)(ws + WS_ZP), (bf16*)(ws + WS_G)};
               GEMM(C, (const bf16*)(ws + WS_H), D, 0, (const bf16*)(ws + WS_WIN) + (size_t)l * DIN * D, D, M, DIN, D, E))
    PH(B0 + 1, phase_convpool(C, a, l))
    PH(B0 + 2, { EpiPool E{(const bf16*)(ws + WS_G), a.in[I_POOLS] + (size_t)l * D, (bf16*)(ws + WS_TMP)};
                 GEMM(C, (const bf16*)(ws + WS_PL), D, 256, (const bf16*)(ws + WS_POOL) + (size_t)l * 1024 * 256, 256, M, D, 256, E); }
               { const Ctx C2 = make_ctx(lds, wave_s); EpiConv E{(const bf16*)(ws + WS_G), (const bf16*)(ws + WS_TMP), (bf16*)(ws + WS_Y)};
                 GEMM(C2, (const bf16*)(ws + WS_AC), D, 0, (const bf16*)(ws + WS_WCO) + (size_t)l * D * D, D, M, D, D, E); })
    PH(B0 + 3, EpiOut E{l == 0 ? a.in[I_X] : a.out, a.out, modp(a, l, 0, 2), a.in[I_BOUT] + (size_t)l * D};
               GEMM(C, (const bf16*)(ws + WS_Y), D, 0, (const bf16*)(ws + WS_WOUT) + (size_t)l * D * D, D, M, D, D, E))
    PH(B0 + 4, phase_norm(C, a, a.out, a.in[I_N2G] + (size_t)l * D, l, 3, 4, (float*)(ws + WS_HSC)))
    PH(B0 + 5, { EpiQ E{(bf16*)(ws + WS_Q)}; GEMM(C, (const bf16*)(ws + WS_H), D, 0, (const bf16*)(ws + WS_WQ) + (size_t)l * DQ * D, D, M, DQ, D, E); }
               asm volatile("s_waitcnt vmcnt(0)" ::: "memory"); __syncthreads();
               { const Ctx C2 = make_ctx(lds, wave_s); EpiS E{(float*)(ws + WS_S)}; GEMM(C2, (const bf16*)(ws + WS_Q), DQ, 256, (const bf16*)(ws + WS_KEYS) + (size_t)l * 2048 * 256, 256, M, DQ, 256, E); }
               asm volatile("s_waitcnt vmcnt(0)" ::: "memory"); __syncthreads();
               { const Ctx C3 = make_ctx(lds, wave_s); phase_topk(C3, a); })
    PH(B0 + 6, phase_peer_a(C, a, l))
    PH(B0 + 7, phase_peer_c(C, a, l))
    PH(B0 + 8, phase_peer_b(C, a, l))
    PH(B0 + 9, if (l + 1 < DEPTH) phase_norm(C, a, a.out, a.in[I_N1G] + (size_t)(l + 1) * D, l + 1, 0, 1, nullptr); else phase_final(C, a))
}
__global__ void __launch_bounds__(NTHREADS, 2) fwd_kernel(Args a) {
    extern __shared__ __attribute__((aligned(16))) unsigned char lds_raw[];
    LAS unsigned char* lds = (LAS unsigned char*)lds_raw;
    for (int u = threadIdx.x; u < (LDS_BYTES - LDSCTL_OFF) / 4; u += NTHREADS) ((LAS unsigned*)(lds + LDSCTL_OFF))[u] = 0u;
    __syncthreads();
    const int wave_s = __builtin_amdgcn_readfirstlane((int)threadIdx.x >> 6);
    const XcdBarrier bar = xcd_barrier_post((unsigned*)(a.ws + WS_CTL) + CW_BAR, (volatile LAS unsigned*)(lds + MISC_OFF) + 8);
    PH(PH_PREP, phase_prep(C, a))
    PH(PH_MODR, phase_modreduce(C, a))
    PH(PH_N1, phase_norm(C, a, a.in[I_X], a.in[I_N1G], 0, 0, 1, nullptr))
    run_layer<0>(a, lds, bar, wave_s);
    run_layer<1>(a, lds, bar, wave_s);
}

extern "C" void kernel_launch(void* const* d_in, const int* in_sizes, int n_in, void* d_out, int out_size, void* d_ws, size_t ws_size, hipStream_t stream) {
    static int grid = 0;
    if (grid == 0) {
        if (n_in != 22 || out_size != M * D || ws_size < WS_END) { fprintf(stderr, "kernel_launch: unexpected shapes (n_in %d out %d ws %zu)\n", n_in, out_size, ws_size); grid = -1; return; }
        int dev = 0, cus = 0;
        if (hipGetDevice(&dev) != hipSuccess || hipDeviceGetAttribute(&cus, hipDeviceAttributeMultiprocessorCount, dev) != hipSuccess) { grid = -1; return; }
        if (hipFuncSetAttribute((const void*)fwd_kernel, hipFuncAttributeMaxDynamicSharedMemorySize, LDS_BYTES) != hipSuccess) { grid = -1; return; }
        grid = cus;
    }
    if (grid < 0) return;
    Args a{};
    for (int i = 0; i < 22; ++i) a.in[i] = (const float*)d_in[i];
    a.out = (float*)d_out; a.ws = (unsigned char*)d_ws;
    (void)hipMemsetAsync((char*)d_ws + WS_CTL, 0, CTL_ZERO_BYTES, stream);
#ifndef ONE_LAUNCH
    for (int ph = 0; ph < N_PHASES; ++ph) { a.ph_lo = ph; a.ph_hi = ph + 1; hipLaunchKernelGGL(fwd_kernel, dim3(grid), dim3(NTHREADS), LDS_BYTES, stream, a); }
#else
    a.ph_lo = 0; a.ph_hi = N_PHASES; hipLaunchKernelGGL(fwd_kernel, dim3(grid), dim3(NTHREADS), LDS_BYTES, stream, a);
#endif
}
```

```cpp
#define ONE_LAUNCH 1
#include <hip/hip_runtime.h>
#include <cstdint>
#include <cstdio>
#include <utility>

#define GAS __attribute__((address_space(1)))
#define LAS __attribute__((address_space(3)))
typedef unsigned short bf16;
typedef float f32x4 __attribute__((ext_vector_type(4)));
typedef float f32x2 __attribute__((ext_vector_type(2)));
typedef unsigned u32x4 __attribute__((ext_vector_type(4)));
typedef unsigned u32x2 __attribute__((ext_vector_type(2)));
typedef __bf16 bf16x2_t __attribute__((ext_vector_type(2)));

constexpr int BATCH = 2, SEQ = 8192, D = 1024, M = BATCH * SEQ, DEPTH = 2;
constexpr int DIN = 5120, NMODV = 6 * D, CONVK = 31, NHEAD = 8, NKEYS = 128, DQ = 2048, TOPK = 16, NEXP = 16384;
constexpr float EPS = 1e-6f;
constexpr int NWAVES = 8, NTHREADS = NWAVES * 64;

constexpr size_t MiB = 1u << 20;
constexpr size_t WS_CTL = 0;
constexpr size_t WS_MODP = 1 * MiB;
constexpr size_t WS_MOD = 4 * MiB;
constexpr size_t WS_WIN = 8 * MiB;
constexpr size_t WS_WCO = 28 * MiB;
constexpr size_t WS_WOUT = 32 * MiB;
constexpr size_t WS_WQ = 36 * MiB;
constexpr size_t WS_POOL = 44 * MiB;
constexpr size_t WS_KEYS = 45 * MiB;
constexpr size_t WS_UB = 48 * MiB;
constexpr size_t WS_USC = 80 * MiB;
constexpr size_t WS_VSC = 81 * MiB;
constexpr size_t WS_VB = 112 * MiB;
constexpr size_t WS_H = 176 * MiB;
constexpr size_t WS_UG = 208 * MiB;
constexpr size_t WS_Y = WS_UG;
constexpr size_t WS_ZP = 240 * MiB;
constexpr size_t WS_TMP = WS_ZP;
constexpr size_t WS_Q = WS_UG;
constexpr size_t WS_G = 272 * MiB;
constexpr size_t WS_AC = 336 * MiB;
constexpr size_t WS_PL = 368 * MiB;
constexpr size_t WS_S = WS_G;
constexpr size_t WS_EID = 400 * MiB;
constexpr size_t WS_GW = 408 * MiB;
constexpr size_t WS_COEF = 416 * MiB;
constexpr size_t WS_CSC = 424 * MiB + 65536;
constexpr size_t WS_HSC = 424 * MiB;
constexpr size_t WS_PD = WS_S;
constexpr size_t WS_WQB = 426 * MiB;
constexpr size_t WS_END = 434 * MiB;

constexpr int LDS_BYTES = 147456;

__device__ __forceinline__ unsigned f2bf(float f) { unsigned u = __builtin_bit_cast(unsigned, f); return (u + 0x7fffu + ((u >> 16) & 1u)) >> 16; }
__device__ __forceinline__ unsigned pk2(float lo, float hi) { return f2bf(lo) | (f2bf(hi) << 16); }
__device__ __forceinline__ float bflo(unsigned w) { return __builtin_bit_cast(float, w << 16); }
__device__ __forceinline__ float bfhi(unsigned w) { return __builtin_bit_cast(float, w & 0xffff0000u); }
__device__ __forceinline__ float sigm(float x) { return __builtin_amdgcn_rcpf(1.f + __expf(-x)); }
__device__ __forceinline__ float wave_sum(float v) {
#pragma unroll
    for (int o = 1; o < 64; o <<= 1) v += __shfl_xor(v, o);
    return v;
}
__device__ __forceinline__ float wave_max(float v) {
#pragma unroll
    for (int o = 1; o < 64; o <<= 1) v = fmaxf(v, __shfl_xor(v, o));
    return v;
}
__device__ __forceinline__ float dpp_sum63(float v) {
#define DPPF(x, ctrl, rm, bc) __builtin_bit_cast(float, __builtin_amdgcn_update_dpp(0, __builtin_bit_cast(int, x), ctrl, rm, 0xf, bc))
    v += DPPF(v, 0x111, 0xf, true); v += DPPF(v, 0x112, 0xf, true); v += DPPF(v, 0x114, 0xf, true); v += DPPF(v, 0x118, 0xf, true);
    v += DPPF(v, 0x142, 0xa, false); v += DPPF(v, 0x143, 0xc, false);
#undef DPPF
    return v;
}
__device__ __forceinline__ u32x4 pack8(const f32x4& a, const f32x4& b) { u32x4 w; w.x = pk2(a.x, a.y); w.y = pk2(a.z, a.w); w.z = pk2(b.x, b.y); w.w = pk2(b.z, b.w); return w; }
__device__ __forceinline__ void unpack8(const u32x4& w, f32x4& a, f32x4& b) { a = (f32x4){bflo(w.x), bfhi(w.x), bflo(w.y), bfhi(w.y)}; b = (f32x4){bflo(w.z), bfhi(w.z), bflo(w.w), bfhi(w.w)}; }

struct Ctx { int tid, lane, wave, gw, ngw, nblk, blk; LAS unsigned char* lds; };

struct Args { const float* in[22]; float* out; unsigned char* ws; int ph_lo, ph_hi; };
enum { I_X = 0, I_C, I_ADAW, I_ADAB, I_N1G, I_WIN, I_BIN, I_CONVW, I_CONVB, I_LNG, I_LNB, I_WCO, I_POOLW, I_POOLS, I_WOUT, I_BOUT, I_N2G, I_WQ, I_KEYS, I_PU, I_PV, I_FG };

__device__ __forceinline__ void transpose_item(const float* W, int K, int N, int k0, int n0, bf16* WT, int dstrow0, LAS float* scr, int lane) {
#pragma unroll 8
    for (int i = 0; i < 32; ++i) { const int kk = 2 * i + (lane >> 5); scr[kk * 33 + (lane & 31)] = W[(size_t)(k0 + kk) * N + n0 + (lane & 31)]; }
    asm volatile("s_waitcnt lgkmcnt(0)" ::: "memory");
    const int c = lane & 7;
#pragma unroll
    for (int j = 0; j < 4; ++j) { const int n = (lane >> 3) + 8 * j; const LAS float* s = scr + (8 * c) * 33 + n;
        u32x4 o; o.x = pk2(s[0 * 33], s[1 * 33]); o.y = pk2(s[2 * 33], s[3 * 33]); o.z = pk2(s[4 * 33], s[5 * 33]); o.w = pk2(s[6 * 33], s[7 * 33]);
        *(u32x4*)(WT + (size_t)(dstrow0 + n) * K + k0 + 8 * c) = o; }
    asm volatile("s_waitcnt lgkmcnt(0)" ::: "memory");
}
__device__ __forceinline__ int win_dstrow(int n0) {
    if (n0 < 1024) return 256 * (n0 >> 7) + (n0 & 127);
    if (n0 < 2048) { const int c = n0 - 1024; return 256 * (c >> 7) + 128 + (c & 127); }
    return n0;
}
__device__ __forceinline__ void phase_prep(const Ctx& C, const Args& a) {
    unsigned char* ws = a.ws;
    LAS float* scr = (LAS float*)(C.lds + C.wave * 16384);
    constexpr int I_IN = 16 * 160, I_CO = 16 * 32, I_PO = 4 * (4 * 8), I_OUT = 16 * 32, I_L = I_IN + I_CO + I_PO + I_OUT;
    for (int it = C.gw; it < DEPTH * I_L; it += C.ngw) {
        const int l = it / I_L; int r = it % I_L;
        if (r < I_IN) { const int kb = r / 160, nb = r % 160; transpose_item(a.in[I_WIN] + (size_t)l * D * DIN, D, DIN, 64 * kb, 32 * nb, (bf16*)(ws + WS_WIN) + (size_t)l * DIN * D, win_dstrow(32 * nb), scr, C.lane); continue; } r -= I_IN;
        if (r < I_CO) { const int kb = r / 32, nb = r % 32; transpose_item(a.in[I_WCO] + (size_t)l * D * D, D, D, 64 * kb, 32 * nb, (bf16*)(ws + WS_WCO) + (size_t)l * D * D, 32 * nb, scr, C.lane); continue; } r -= I_CO;
        if (r < I_PO) { const int g = r / 32, q = r % 32, kb = q / 8, nb = q % 8; transpose_item(a.in[I_POOLW] + ((size_t)l * 4 + g) * 256 * 256, 256, 256, 64 * kb, 32 * nb, (bf16*)(ws + WS_POOL) + ((size_t)l * 1024 + 256 * g) * 256, 32 * nb, scr, C.lane); continue; } r -= I_PO;
        { const int kb = r / 32, nb = r % 32; transpose_item(a.in[I_WOUT] + (size_t)l * D * D, D, D, 64 * kb, 32 * nb, (bf16*)(ws + WS_WOUT) + (size_t)l * D * D, 32 * nb, scr, C.lane); }
    }
    const int gt = C.blk * NTHREADS + C.tid, ngt = C.nblk * NTHREADS;
    for (size_t i = gt; i < (size_t)DEPTH * D * DQ / 8; i += ngt) { const f32x4 v0 = *(const f32x4*)(a.in[I_WQ] + i * 8), v1 = *(const f32x4*)(a.in[I_WQ] + i * 8 + 4); *(u32x4*)((bf16*)(ws + WS_WQB) + i * 8) = pack8(v0, v1); }
    for (int i = gt; i < DEPTH * 2048 * 32; i += ngt) {
        const int l = i / (2048 * 32), r = i % (2048 * 32), n = r / 32, k8 = (r % 32) * 8;
        const int h = n >> 8, p = (n >> 7) & 1, key = n & 127, pk = k8 >> 7, kk = k8 & 127;
        u32x4 o = (u32x4){0u, 0u, 0u, 0u};
        if (pk == p) { const float* s = a.in[I_KEYS] + ((((size_t)l * 8 + h) * 2 + p) * 128 + key) * 128 + kk; const f32x4 v0 = *(const f32x4*)s, v1 = *(const f32x4*)(s + 4); o = pack8(v0, v1); }
        *(u32x4*)((bf16*)(ws + WS_KEYS) + ((size_t)l * 2048 + n) * 256 + k8) = o;
    }
    for (int t = 0; t < 2; ++t) {
        const float* src = a.in[t == 0 ? I_PU : I_PV]; unsigned char* dst = ws + (t == 0 ? WS_UB : WS_VB); float* scl = (float*)(ws + (t == 0 ? WS_USC : WS_VSC));
        for (int row0 = 4 * C.gw; row0 < DEPTH * NEXP; row0 += 4 * C.ngw) {
            f32x4 v[4][4]; float am[4];
#pragma unroll
            for (int r = 0; r < 4; ++r)
#pragma unroll
                for (int q = 0; q < 4; ++q) v[r][q] = *(const f32x4*)(src + (size_t)(row0 + r) * D + 16 * C.lane + 4 * q);
#pragma unroll
            for (int r = 0; r < 4; ++r) { float m = 0.f;
#pragma unroll
                for (int q = 0; q < 4; ++q) m = fmaxf(m, fmaxf(fmaxf(fabsf(v[r][q].x), fabsf(v[r][q].y)), fmaxf(fabsf(v[r][q].z), fabsf(v[r][q].w))));
                am[r] = wave_max(m); }
#pragma unroll
            for (int r = 0; r < 4; ++r) { const float inv = am[r] > 0.f ? 127.f / am[r] : 0.f; u32x4 w; const int row = row0 + r;
#pragma unroll
                for (int q = 0; q < 4; ++q) w[q] = ((unsigned)(int)rintf(v[r][q].x * inv) & 255u) | (((unsigned)(int)rintf(v[r][q].y * inv) & 255u) << 8) | (((unsigned)(int)rintf(v[r][q].z * inv) & 255u) << 16) | ((unsigned)(int)rintf(v[r][q].w * inv) << 24);
                { const int lyr = row / NEXP, e = row % NEXP; *(u32x4*)(dst + (((size_t)lyr * 8 + (C.lane >> 3)) * NEXP + e) * 128 + 16 * (C.lane & 7)) = w; }
                if (C.lane == 0) scl[row] = am[r] * (1.f / 127.f); }
        }
    }
    for (int it = gt; it < 32 * 3072; it += ngt) {
        const int ks = it / 3072, cg = it % 3072, l = cg / 1536, n4 = (cg % 1536) * 4;
        f32x4 a0 = (f32x4){0.f, 0.f, 0.f, 0.f}, a1 = a0;
        const float* wp = a.in[I_ADAW] + ((size_t)l * D + ks * 32) * NMODV + n4; const float* c0 = a.in[I_C] + ks * 32; const float* c1 = c0 + D;
#pragma unroll 8
        for (int kk = 0; kk < 32; ++kk) { const f32x4 w = *(const f32x4*)(wp + (size_t)kk * NMODV); const float x0 = c0[kk], x1 = c1[kk]; a0 += w * (x0 * sigm(x0)); a1 += w * (x1 * sigm(x1)); }
        float* mp = (float*)(ws + WS_MODP) + (((size_t)ks * 2 + l) * 2) * NMODV + n4;
        *(f32x4*)mp = a0; *(f32x4*)(mp + NMODV) = a1;
    }
}
__device__ __forceinline__ void phase_modreduce(const Ctx& C, const Args& a) {
    const int gt = C.blk * NTHREADS + C.tid, ngt = C.nblk * NTHREADS;
    for (int i = gt; i < 2 * 2 * NMODV; i += ngt) {
        const int l = i / (2 * NMODV), n = i % NMODV; float s = a.in[I_ADAB][(size_t)l * NMODV + n];
        const float* mp = (const float*)(a.ws + WS_MODP) + i;
        for (int ks = 0; ks < 32; ++ks) s += mp[(size_t)ks * 4 * NMODV];
        ((float*)(a.ws + WS_MOD))[i] = s;
    }
}
__device__ __forceinline__ const float* modp(const Args& a, int l, int b, int v) { return (const float*)(a.ws + WS_MOD) + ((size_t)l * 2 + b) * NMODV + v * D; }

__device__ __forceinline__ void normmod_row(const f32x4 (&x)[4], const float* g, const float* sh, const float* sc, int lane, f32x4 (&h)[4]) {
    float s = 0.f;
#pragma unroll
    for (int j = 0; j < 4; ++j) s += (x[j].x * x[j].x + x[j].y * x[j].y) + (x[j].z * x[j].z + x[j].w * x[j].w);
    const float rstd = 1.f / sqrtf(wave_sum(s) * (1.f / D) + EPS);
#pragma unroll
    for (int j = 0; j < 4; ++j) { const int c = 4 * lane + 256 * j; const f32x4 gv = *(const f32x4*)(g + c), shv = *(const f32x4*)(sh + c), scv = *(const f32x4*)(sc + c);
        h[j] = (x[j] * rstd) * gv * (scv + 1.f) + shv; }
}
__device__ __forceinline__ void store_row_bf16(bf16* row, const f32x4 (&h)[4], int lane) {
#pragma unroll
    for (int j = 0; j < 4; ++j) { u32x2 w; w.x = pk2(h[j].x, h[j].y); w.y = pk2(h[j].z, h[j].w); *(u32x2*)(row + 4 * lane + 256 * j) = w; }
}
__device__ __forceinline__ void phase_norm(const Ctx& C, const Args& a, const float* X, const float* g, int l, int vsh, int vsc, float* hsc) {
    bf16* H = (bf16*)(a.ws + WS_H);
    for (int m = C.gw; m < M; m += C.ngw) {
        const int b = m >> 13; f32x4 x[4], h[4];
#pragma unroll
        for (int j = 0; j < 4; ++j) x[j] = *(const f32x4*)(X + (size_t)m * D + 4 * C.lane + 256 * j);
        normmod_row(x, g, modp(a, l, b, vsh), modp(a, l, b, vsc), C.lane, h);
        store_row_bf16(H + (size_t)m * D, h, C.lane);
        if (hsc) { float am = 0.f;
#pragma unroll
            for (int j = 0; j < 4; ++j) { const unsigned w0 = pk2(h[j].x, h[j].y), w1 = pk2(h[j].z, h[j].w); am = fmaxf(am, fmaxf(fmaxf(fabsf(bflo(w0)), fabsf(bfhi(w0))), fmaxf(fabsf(bflo(w1)), fabsf(bfhi(w1))))); }
            am = wave_max(am); if (C.lane == 0) hsc[m] = am * (1.f / 127.f); }
    }
}

struct EpiIn {
    const float* bin; bf16 *UG, *ZP, *G;
    __device__ __forceinline__ void apply(int row, int pn, int cl8, f32x4 a0, f32x4 a1, f32x4 b0, f32x4 b1) const {
        if (pn < 8) {
            const int c = 128 * pn + cl8;
            a0 += *(const f32x4*)(bin + c); a1 += *(const f32x4*)(bin + c + 4); b0 += *(const f32x4*)(bin + 1024 + c); b1 += *(const f32x4*)(bin + 1024 + c + 4);
            f32x4 u0, u1;
#pragma unroll
            for (int i = 0; i < 4; ++i) { u0[i] = a0[i] * sigm(b0[i]); u1[i] = a1[i] * sigm(b1[i]); }
            *(u32x4*)(UG + (size_t)row * D + c) = pack8(u0, u1);
        } else if (pn < 12) {
            const int c = 256 * (pn - 8) + cl8;
            a0 += *(const f32x4*)(bin + 2048 + c); a1 += *(const f32x4*)(bin + 2048 + c + 4); b0 += *(const f32x4*)(bin + 2048 + 128 + c); b1 += *(const f32x4*)(bin + 2048 + 128 + c + 4);
            *(u32x4*)(ZP + (size_t)row * D + c) = pack8(a0, a1); *(u32x4*)(ZP + (size_t)row * D + c + 128) = pack8(b0, b1);
        } else {
            const int c = 256 * (pn - 12) + cl8;
            a0 += *(const f32x4*)(bin + 3072 + c); a1 += *(const f32x4*)(bin + 3072 + c + 4); b0 += *(const f32x4*)(bin + 3072 + 128 + c); b1 += *(const f32x4*)(bin + 3072 + 128 + c + 4);
#pragma unroll
            for (int i = 0; i < 4; ++i) { a0[i] = sigm(a0[i]); a1[i] = sigm(a1[i]); b0[i] = sigm(b0[i]); b1[i] = sigm(b1[i]); }
            *(u32x4*)(G + (size_t)row * 2048 + c) = pack8(a0, a1); *(u32x4*)(G + (size_t)row * 2048 + c + 128) = pack8(b0, b1);
        }
    }
};
struct EpiPool {
    const bf16* G; const float* scale; bf16* TMP;
    __device__ __forceinline__ void apply(int row, int pn, int cl8, f32x4 a0, f32x4 a1, f32x4 b0, f32x4 b1) const {
        const int c = 256 * pn + cl8; f32x4 g0, g1;
        unpack8(*(const u32x4*)(G + (size_t)row * 2048 + 1024 + c), g0, g1);
        a0 = a0 * g0 * *(const f32x4*)(scale + c); a1 = a1 * g1 * *(const f32x4*)(scale + c + 4);
        *(u32x4*)(TMP + (size_t)row * D + c) = pack8(a0, a1);
        unpack8(*(const u32x4*)(G + (size_t)row * 2048 + 1024 + c + 128), g0, g1);
        b0 = b0 * g0 * *(const f32x4*)(scale + c + 128); b1 = b1 * g1 * *(const f32x4*)(scale + c + 132);
        *(u32x4*)(TMP + (size_t)row * D + c + 128) = pack8(b0, b1);
    }
};
struct EpiConv {
    const bf16* G; const bf16* TMP; bf16* Y;
    __device__ __forceinline__ void apply(int row, int pn, int cl8, f32x4 a0, f32x4 a1, f32x4 b0, f32x4 b1) const {
        const int c = 256 * pn + cl8; f32x4 g0, g1, t0, t1;
        unpack8(*(const u32x4*)(G + (size_t)row * 2048 + c), g0, g1); unpack8(*(const u32x4*)(TMP + (size_t)row * D + c), t0, t1);
        *(u32x4*)(Y + (size_t)row * D + c) = pack8(a0 * g0 + t0, a1 * g1 + t1);
        unpack8(*(const u32x4*)(G + (size_t)row * 2048 + c + 128), g0, g1); unpack8(*(const u32x4*)(TMP + (size_t)row * D + c + 128), t0, t1);
        *(u32x4*)(Y + (size_t)row * D + c + 128) = pack8(b0 * g0 + t0, b1 * g1 + t1);
    }
};
struct EpiOut {
    const float* xold; float* xnew; const float* g1;   const float* bout;
    __device__ __forceinline__ void apply(int row, int pn, int cl8, f32x4 a0, f32x4 a1, f32x4 b0, f32x4 b1) const {
        const int c = 256 * pn + cl8; const float* g = g1 + (size_t)(row >> 13) * NMODV; const size_t o = (size_t)row * D + c;
        *(f32x4*)(xnew + o) = *(const f32x4*)(xold + o) + *(const f32x4*)(g + c) * (a0 + *(const f32x4*)(bout + c));
        *(f32x4*)(xnew + o + 4) = *(const f32x4*)(xold + o + 4) + *(const f32x4*)(g + c + 4) * (a1 + *(const f32x4*)(bout + c + 4));
        *(f32x4*)(xnew + o + 128) = *(const f32x4*)(xold + o + 128) + *(const f32x4*)(g + c + 128) * (b0 + *(const f32x4*)(bout + c + 128));
        *(f32x4*)(xnew + o + 132) = *(const f32x4*)(xold + o + 132) + *(const f32x4*)(g + c + 132) * (b1 + *(const f32x4*)(bout + c + 132));
    }
};
struct EpiQ {
    bf16* Q;
    __device__ __forceinline__ void apply(int row, int pn, int cl8, f32x4 a0, f32x4 a1, f32x4 b0, f32x4 b1) const {
        const size_t o = (size_t)row * DQ + 256 * pn + cl8; *(u32x4*)(Q + o) = pack8(a0, a1); *(u32x4*)(Q + o + 128) = pack8(b0, b1);
    }
};
struct EpiWT {
    bf16* W;
    __device__ __forceinline__ void apply(int row, int pn, int cl8, f32x4 a0, f32x4 a1, f32x4 b0, f32x4 b1) const {
        const size_t o = (size_t)row * D + 256 * pn + cl8; *(u32x4*)(W + o) = pack8(a0, a1); *(u32x4*)(W + o + 128) = pack8(b0, b1);
    }
};
struct EpiS {
    float* S;
    __device__ __forceinline__ void apply(int row, int pn, int cl8, f32x4 a0, f32x4 a1, f32x4 b0, f32x4 b1) const {
        const size_t o = (size_t)row * DQ + 256 * pn + cl8; *(f32x4*)(S + o) = a0; *(f32x4*)(S + o + 4) = a1; *(f32x4*)(S + o + 128) = b0; *(f32x4*)(S + o + 132) = b1;
    }
};

namespace pg8 {
#define PG8_LAS __attribute__((address_space(3)))
typedef unsigned short bf16_t;
typedef short bf16x8 __attribute__((ext_vector_type(8)));
typedef float f32x4 __attribute__((ext_vector_type(4)));
typedef unsigned u32x4 __attribute__((ext_vector_type(4)));
constexpr int BM = 256, BK = 64, HALF = 128, HTB = HALF * BK * 2  , STAGE_BYTES = 8 * HTB, NXCD = 8, WGM = 8;

__host__ __device__ __forceinline__ int lds_byte(int r, int c) { const int st = (r >> 4) * 2 + (c >> 5), rr = r & 15, cc = c & 31, ob = rr * 64 + cc * 2; return st * 1024 + (ob ^ (((ob >> 9) & 1) << 5)); }
__host__ __device__ __forceinline__ void stage_rc(int b, int& R, int& C) { const int st = b / 1024, sb = b % 1024, swz = sb ^ (((sb >> 9) & 1) << 5); R = (st >> 1) * 16 + swz / 64; C = (st & 1) * 32 + (swz % 64) / 2; }
__host__ __device__ __forceinline__ int perm32(int rho) { const int n = rho >> 4, i = rho & 15; return 8 * (i >> 2) + 4 * n + (i & 3); }

struct Unit { int pm, pn; };
struct Gemm { const bf16_t* A; const bf16_t* Bt; int M, N, K, lda, ldb, acol, bcol; };

struct StaticOrder {
    int nM, nN, nwg, G, c;
    __host__ __device__ void init(int M, int N, int G_, int c_) { nM = M / BM; nN = N / BM; nwg = nM * nN; G = G_; c = c_; }
    __host__ __device__ bool next(int i, Unit& u) const {
        const long L = (long)i * G + c; if (L >= nwg) return false;
        int wgid = (int)L; { const int q = nwg / NXCD, r = nwg % NXCD, xcd = wgid % NXCD, off = wgid / NXCD; wgid = (xcd < r ? xcd * (q + 1) : r * (q + 1) + (xcd - r) * q) + off; }
        const int nig = WGM * nN, gid = wgid / nig, fm = gid * WGM, gsz = (nM - fm) < WGM ? (nM - fm) : WGM;
        u.pm = fm + ((wgid % nig) % gsz); u.pn = (wgid % nig) / gsz; return true;
    }
    __device__ __forceinline__ void a_ready(const Unit&) const {}
    __device__ __forceinline__ void done(const Unit&) const {}
};


template <class Epi, class Sched, bool ALIGN_EPI = false, bool SP2 = false>
__device__ __forceinline__ void gemm_phase(PG8_LAS unsigned char* lds, const Gemm g, const Sched& S, const Epi& E, const int tid) {
    const int wid = __builtin_amdgcn_readfirstlane(tid >> 6), lane = tid & 63, wr = wid >> 2, wc = wid & 3, fr = lane & 15, fq = lane >> 4;
    const int K = g.K, nt = K / BK;
    unsigned voffA[2], voffB[2];
#pragma unroll
    for (int i = 0; i < 2; ++i) { int R, C; stage_rc(tid * 16 + i * 8192, R, C); const int Rb = Epi::PERM ? ((R & ~31) + perm32(R & 31)) : R;
        voffA[i] = (unsigned)(R * g.lda + C) * 2u; voffB[i] = (unsigned)(Rb * g.ldb + C) * 2u; }
    const size_t kstep = (size_t)(BK * 2);
    const size_t hstepA = (size_t)HALF * g.lda * 2, hstepB = (size_t)HALF * g.ldb * 2;
    const size_t tstepA = 2 * hstepA, tstepB = 2 * hstepB, acolb = (size_t)g.acol * 2, bcolb = (size_t)g.bcol * 2;
    const unsigned ldsw = (unsigned)wid * 1024u;
    const int aoff = lds_byte(wr * 64 + fr, fq * 8), boff = lds_byte(wc * 32 + fr, fq * 8);
#define PG8_SA(b, h) (((b) * 2 + (h)) * HTB)
#define PG8_SB(b, h) ((4 + (b) * 2 + (h)) * HTB)
#define PG8_STAGE(bufoff, gbase, voff) do { _Pragma("unroll") for (int _i = 0; _i < 2; ++_i) \
        __builtin_amdgcn_global_load_lds((const unsigned*)((const char*)(gbase) + (voff)[_i]), (PG8_LAS unsigned*)(lds + (bufoff) + ldsw + _i * 8192), 16, 0, 0); } while (0)
#define PG8_LDA(dst, b, h) do { _Pragma("unroll") for (int m = 0; m < 4; ++m) _Pragma("unroll") for (int k = 0; k < 2; ++k) dst[m][k] = *(const PG8_LAS bf16x8*)(lds + PG8_SA(b, h) + aoff + m * 2048 + k * 1024); } while (0)
#define PG8_LDB(dst, b, h) do { _Pragma("unroll") for (int n = 0; n < 2; ++n) _Pragma("unroll") for (int k = 0; k < 2; ++k) dst[n][k] = *(const PG8_LAS bf16x8*)(lds + PG8_SB(b, h) + boff + n * 2048 + k * 1024); } while (0)
#define PG8_MMA(ai, bj, At, Bt) do { __builtin_amdgcn_s_setprio(1); _Pragma("unroll") for (int m = 0; m < 4; ++m) _Pragma("unroll") for (int n = 0; n < 2; ++n) _Pragma("unroll") for (int k = 0; k < 2; ++k) \
        acc[ai][bj][m][n] = __builtin_amdgcn_mfma_f32_16x16x32_bf16(Bt[n][k], At[m][k], acc[ai][bj][m][n], 0, 0, 0); __builtin_amdgcn_s_setprio(0); } while (0)
#define PG8_WAIT_V(n) asm volatile("s_waitcnt vmcnt(" #n ")" ::: "memory")
#define PG8_WAIT_L(n) asm volatile("s_waitcnt lgkmcnt(" #n ")" ::: "memory")
#define PG8_BAR __builtin_amdgcn_s_barrier()
#define PG8_SCHED __builtin_amdgcn_sched_barrier(0)
    Unit cur, nxt; int ui = 0;
    if (!S.next(0, cur)) return;
    f32x4 acc[2][2][4][2];
#pragma unroll
    for (int a = 0; a < 2; ++a)
#pragma unroll
        for (int b = 0; b < 2; ++b)
#pragma unroll
            for (int m = 0; m < 4; ++m)
#pragma unroll
                for (int n = 0; n < 2; ++n) acc[a][b][m][n] = (f32x4){0.f, 0.f, 0.f, 0.f};
    bf16x8 At[4][2], B0[2][2], B1[2][2];
    const char* cA = (const char*)g.A + (size_t)cur.pm * tstepA + (size_t)cur.pn * acolb; const char* cB = (const char*)g.Bt + (size_t)cur.pn * tstepB + (size_t)cur.pm * bcolb;
    S.a_ready(cur);
    if constexpr (SP2) {
        PG8_STAGE(PG8_SB(0, 0), cB, voffB); PG8_STAGE(PG8_SB(0, 1), cB + hstepB, voffB); PG8_STAGE(PG8_SA(0, 0), cA, voffA); PG8_STAGE(PG8_SA(0, 1), cA + hstepA, voffA);
        if (wr == 1) PG8_BAR;
        PG8_WAIT_V(2); PG8_BAR;
        PG8_STAGE(PG8_SB(1, 0), cB + kstep, voffB); PG8_STAGE(PG8_SA(1, 0), cA + kstep, voffA); PG8_STAGE(PG8_SB(1, 1), cB + hstepB + kstep, voffB);
        PG8_WAIT_V(6); PG8_BAR;
    } else {
        PG8_STAGE(PG8_SB(0, 0), cB, voffB); PG8_STAGE(PG8_SA(0, 0), cA, voffA); PG8_STAGE(PG8_SB(0, 1), cB + hstepB, voffB); PG8_STAGE(PG8_SA(0, 1), cA + hstepA, voffA);
        if (wr == 1) PG8_BAR;
        PG8_WAIT_V(4); PG8_BAR;
        PG8_STAGE(PG8_SB(1, 0), cB + kstep, voffB); PG8_STAGE(PG8_SA(1, 0), cA + kstep, voffA); PG8_STAGE(PG8_SB(1, 1), cB + hstepB + kstep, voffB);
        PG8_WAIT_V(6); PG8_BAR;
    }
    for (;;) {
        const bool has_next = S.next(ui + 1, nxt);
        const char* nA = has_next ? (const char*)g.A + (size_t)nxt.pm * tstepA + (size_t)nxt.pn * acolb : cA; const char* nB = has_next ? (const char*)g.Bt + (size_t)nxt.pn * tstepB + (size_t)nxt.pm * bcolb : cB;
#pragma nounroll
        for (int t = 0; t < nt; t += 2) {
            const bool last = (t == nt - 2);
            const char* a1 = cA + (size_t)(t + 1) * kstep;
            const char* a2 = last ? nA : cA + (size_t)(t + 2) * kstep; const char* b2 = last ? nB : cB + (size_t)(t + 2) * kstep;
            const char* a3 = a2 + kstep; const char* b3 = b2 + kstep;
            if (last && has_next) S.a_ready(nxt);
            if constexpr (SP2) {
            PG8_LDB(B0, 0, 0); PG8_LDB(B1, 0, 1); PG8_SCHED; PG8_LDA(At, 0, 0); PG8_STAGE(PG8_SA(1, 1), a1 + hstepA, voffA);
            PG8_WAIT_V(8); PG8_WAIT_L(0); PG8_BAR; PG8_MMA(0, 0, At, B0); PG8_MMA(0, 1, At, B1); PG8_BAR; PG8_SCHED;
            PG8_LDA(At, 0, 1); PG8_STAGE(PG8_SB(0, 0), b2, voffB); PG8_STAGE(PG8_SB(0, 1), b2 + hstepB, voffB); PG8_STAGE(PG8_SA(0, 0), a2, voffA);
            PG8_WAIT_V(8); PG8_WAIT_L(0); PG8_BAR; PG8_MMA(1, 0, At, B0); PG8_MMA(1, 1, At, B1); PG8_BAR; PG8_SCHED;
            PG8_LDB(B0, 1, 0); PG8_LDB(B1, 1, 1); PG8_SCHED; PG8_LDA(At, 1, 0); PG8_STAGE(PG8_SA(0, 1), a2 + hstepA, voffA);
            PG8_WAIT_V(8); PG8_WAIT_L(0); PG8_BAR; PG8_MMA(0, 0, At, B0); PG8_MMA(0, 1, At, B1); PG8_BAR; PG8_SCHED;
            PG8_LDA(At, 1, 1); PG8_STAGE(PG8_SB(1, 0), b3, voffB); PG8_STAGE(PG8_SB(1, 1), b3 + hstepB, voffB); PG8_STAGE(PG8_SA(1, 0), a3, voffA);
            PG8_WAIT_V(8); PG8_WAIT_L(0); PG8_BAR; PG8_MMA(1, 0, At, B0); PG8_MMA(1, 1, At, B1); PG8_BAR; PG8_SCHED;
            } else {
            PG8_LDB(B0, 0, 0); PG8_SCHED; PG8_LDA(At, 0, 0); PG8_STAGE(PG8_SA(1, 1), a1 + hstepA, voffA);
            PG8_WAIT_L(8); PG8_BAR; PG8_WAIT_L(0); PG8_MMA(0, 0, At, B0); PG8_BAR; PG8_SCHED;
            PG8_LDB(B1, 0, 1); PG8_STAGE(PG8_SB(0, 0), b2, voffB);
            PG8_BAR; PG8_WAIT_L(0); PG8_MMA(0, 1, At, B1); PG8_BAR;
            PG8_LDA(At, 0, 1); PG8_STAGE(PG8_SA(0, 0), a2, voffA);
            PG8_BAR; PG8_WAIT_L(0); PG8_MMA(1, 0, At, B0); PG8_BAR; PG8_SCHED;
            PG8_STAGE(PG8_SB(0, 1), b2 + hstepB, voffB);
            PG8_WAIT_V(6); PG8_BAR; PG8_MMA(1, 1, At, B1); PG8_BAR;
            PG8_LDB(B0, 1, 0); PG8_SCHED; PG8_LDA(At, 1, 0); PG8_STAGE(PG8_SA(0, 1), a2 + hstepA, voffA);
            PG8_WAIT_L(8); PG8_BAR; PG8_WAIT_L(0); PG8_MMA(0, 0, At, B0); PG8_BAR; PG8_SCHED;
            PG8_LDB(B1, 1, 1); PG8_STAGE(PG8_SB(1, 0), b3, voffB);
            PG8_BAR; PG8_WAIT_L(0); PG8_MMA(0, 1, At, B1); PG8_BAR;
            PG8_LDA(At, 1, 1); PG8_STAGE(PG8_SA(1, 0), a3, voffA);
            PG8_BAR; PG8_WAIT_L(0); PG8_MMA(1, 0, At, B0); PG8_BAR; PG8_SCHED;
            PG8_STAGE(PG8_SB(1, 1), b3 + hstepB, voffB);
            PG8_WAIT_V(6); PG8_BAR; PG8_MMA(1, 1, At, B1); PG8_BAR;
            }
        }
        if constexpr (ALIGN_EPI) { if (wr == 0) PG8_BAR; }
        if constexpr (!Epi::AFTER_DRAIN) { E(acc, cur, wr, wc, fr, fq); S.done(cur); }
        if (!has_next) break;
#pragma unroll
        for (int a = 0; a < 2; ++a)
#pragma unroll
            for (int b = 0; b < 2; ++b)
#pragma unroll
                for (int m = 0; m < 4; ++m)
#pragma unroll
                    for (int n = 0; n < 2; ++n) acc[a][b][m][n] = (f32x4){0.f, 0.f, 0.f, 0.f};
        cur = nxt; cA = nA; cB = nB; ++ui;
        if constexpr (ALIGN_EPI) { if (wr == 1) PG8_BAR; }
    }
    PG8_WAIT_V(0);
    if constexpr (!ALIGN_EPI) { if (wr == 0) PG8_BAR; }
    PG8_BAR;
    if constexpr (Epi::AFTER_DRAIN) { E.fused(acc, cur, wr, wc, fr, fq, lds, wid, lane); S.done(cur); }
#undef PG8_SA
#undef PG8_SB
#undef PG8_STAGE
#undef PG8_LDA
#undef PG8_LDB
#undef PG8_MMA
#undef PG8_WAIT_V
#undef PG8_WAIT_L
#undef PG8_BAR
#undef PG8_SCHED
}

template <class F> struct EpiW {
    static constexpr bool PERM = true, AFTER_DRAIN = false; F f;
    __device__ __forceinline__ void operator()(const f32x4 (&acc)[2][2][4][2], const Unit& u, int wr, int wc, int fr, int fq) const {
#pragma unroll
        for (int ai = 0; ai < 2; ++ai)
#pragma unroll
            for (int m = 0; m < 4; ++m) { f.apply(u.pm * BM + ai * HALF + wr * 64 + m * 16 + fr, u.pn, wc * 32 + 8 * fq, acc[ai][0][m][0], acc[ai][0][m][1], acc[ai][1][m][0], acc[ai][1][m][1]);
                asm volatile("" ::: "memory"); }
    }
};
}

template <class F>
__device__ __forceinline__ void mfma_gemm(const Ctx& C, const bf16* A, int lda, int acol, const bf16* Bt, int ldb, int Mr, int N, int K, const F& f, int bcol = 0) {
    pg8::Gemm g{A, Bt, Mr, N, K, lda, ldb, acol, bcol}; pg8::StaticOrder S; S.init(Mr, N, C.nblk, C.blk); pg8::EpiW<F> E{f};
    pg8::gemm_phase<pg8::EpiW<F>, pg8::StaticOrder, true, true>(C.lds, g, S, E, C.tid);
}

template <class F>
__device__ __forceinline__ void naive_gemm(const Ctx& C, const bf16* A, int lda, int acol, const bf16* Bt, int ldb, int Mr, int N, int K, const F& f) {
    LAS float* As = (LAS float*)C.lds;
    LAS float* Bs = (LAS float*)(C.lds + 8192);
    const int ntm = Mr / 128, ntn = N / 256, tid = C.tid, cg = tid & 15, r0 = tid >> 4;
    for (int tile = C.blk; tile < ntm * ntn; tile += C.nblk) {
        const int tm = tile / ntn, pn = tile % ntn;
        f32x4 acc[4][4];
#pragma unroll
        for (int i = 0; i < 4; ++i)
#pragma unroll
            for (int j = 0; j < 4; ++j) acc[i][j] = (f32x4){0.f, 0.f, 0.f, 0.f};
        const bf16* ap = A + (size_t)(tm * 128 + (tid >> 2)) * lda + pn * acol + (tid & 3) * 4;
        const bf16* bp = Bt + (size_t)(pn * 256 + (tid >> 1)) * ldb + (tid & 1) * 8;
        for (int k0 = 0; k0 < K; k0 += 16) {
            const u32x2 av = *(const u32x2*)(ap + k0); const u32x4 bv = *(const u32x4*)(bp + k0);
            __syncthreads();
            { const int r = tid >> 2, kq = (tid & 3) * 4; As[(kq + 0) * 128 + r] = bflo(av.x); As[(kq + 1) * 128 + r] = bfhi(av.x); As[(kq + 2) * 128 + r] = bflo(av.y); As[(kq + 3) * 128 + r] = bfhi(av.y); }
            { const int n = tid >> 1, kq = (tid & 1) * 8; Bs[(kq + 0) * 256 + n] = bflo(bv.x); Bs[(kq + 1) * 256 + n] = bfhi(bv.x); Bs[(kq + 2) * 256 + n] = bflo(bv.y); Bs[(kq + 3) * 256 + n] = bfhi(bv.y);
              Bs[(kq + 4) * 256 + n] = bflo(bv.z); Bs[(kq + 5) * 256 + n] = bfhi(bv.z); Bs[(kq + 6) * 256 + n] = bflo(bv.w); Bs[(kq + 7) * 256 + n] = bfhi(bv.w); }
            __syncthreads();
#pragma unroll
            for (int kk = 0; kk < 16; ++kk) {
                const f32x4 b0 = *(const LAS f32x4*)(Bs + kk * 256 + cg * 8), b1 = *(const LAS f32x4*)(Bs + kk * 256 + cg * 8 + 4), b2 = *(const LAS f32x4*)(Bs + kk * 256 + 128 + cg * 8), b3 = *(const LAS f32x4*)(Bs + kk * 256 + 128 + cg * 8 + 4);
#pragma unroll
                for (int i = 0; i < 4; ++i) { const float av1 = As[kk * 128 + r0 + 32 * i]; acc[i][0] += b0 * av1; acc[i][1] += b1 * av1; acc[i][2] += b2 * av1; acc[i][3] += b3 * av1; }
            }
        }
#pragma unroll
        for (int i = 0; i < 4; ++i) f.apply(tm * 128 + r0 + 32 * i, pn, cg * 8, acc[i][0], acc[i][1], acc[i][2], acc[i][3]);
    }
}

template <int NROWS>
__device__ __forceinline__ void cp_stage(LAS unsigned char* tile, const bf16* src, int mrow0, int tfirst, int tid) {
    constexpr int NIT = (NROWS * 128 + NTHREADS - 1) / NTHREADS;
    asm volatile("" : "+v"(tid));
    u32x4 v[NIT];
#pragma unroll
    for (int i = 0; i < NIT; ++i) { const int ch = i * NTHREADS + tid, r = ch >> 7, c = ch & 127; v[i] = (u32x4){0u, 0u, 0u, 0u};
        if (ch < NROWS * 128 && tfirst + r >= 0) v[i] = *(const u32x4*)(src + (size_t)(mrow0 + r) * D + c * 8); }
#pragma unroll
    for (int i = 0; i < NIT; ++i) { const int ch = i * NTHREADS + tid; if (ch < NROWS * 128) *(LAS u32x4*)(tile + ch * 16) = v[i]; }
}
template <int W>
__device__ __forceinline__ void pool_item(const LAS unsigned char* tile, bf16* PL, int m0, int t0, int tid) {
    float p0[47], p1[47];
#pragma unroll
    for (int i = 0; i < 47; ++i) { unsigned w = 0u; if (i >= 15 - (W - 1)) w = *(const LAS unsigned*)(tile + i * 2048 + 4 * tid); p0[i] = bflo(w); p1[i] = bfhi(w); }
#pragma unroll
    for (int ti = 0; ti < 32; ++ti) {
        float s0 = 0.f, s1 = 0.f;
#pragma unroll
        for (int j = 0; j < W; ++j) { s0 += p0[ti + 15 - j]; s1 += p1[ti + 15 - j]; }
        const int cnt = (t0 + ti + 1) < W ? (t0 + ti + 1) : W; const float inv = 1.f / (float)cnt;
        *(unsigned*)(PL + (size_t)(m0 + ti) * D + 2 * tid) = pk2(s0 * inv - p0[ti + 15], s1 * inv - p1[ti + 15]);
    }
}
template <int RI>
__device__ __forceinline__ void conv_row(const LAS unsigned char* tile, int tid, const float (&w0)[31], const float (&w1)[31], float (&a0)[32], float (&a1)[32]) {
    const unsigned w = *(const LAS unsigned*)(tile + RI * 2048 + 4 * tid);
    const float u0 = bflo(w), u1 = bfhi(w);
#pragma unroll
    for (int ti = 0; ti < 32; ++ti) { constexpr int dbase = 30 - RI; const int d = ti + dbase; if (d >= 0 && d <= 30) { a0[ti] += w0[30 - d] * u0; a1[ti] += w1[30 - d] * u1; } }
    if constexpr ((RI & 7) == 7) asm volatile("" ::: "memory");
}
template <int... RI>
__device__ __forceinline__ void conv_rows(const LAS unsigned char* tile, int tid, const float (&w0)[31], const float (&w1)[31], float (&a0)[32], float (&a1)[32], std::integer_sequence<int, RI...>) {
    (conv_row<RI>(tile, tid, w0, w1, a0, a1), ...);
}
__device__ __forceinline__ void phase_convpool(const Ctx& C, const Args& a, int l) {
    const bf16* UG = (const bf16*)(a.ws + WS_UG); const bf16* ZP = (const bf16*)(a.ws + WS_ZP);
    bf16* AC = (bf16*)(a.ws + WS_AC); bf16* PL = (bf16*)(a.ws + WS_PL);
    const float* cw = a.in[I_CONVW] + (size_t)l * CONVK * D; const float* cb = a.in[I_CONVB] + (size_t)l * D;
    const float* lng = a.in[I_LNG] + (size_t)l * D; const float* lnb = a.in[I_LNB] + (size_t)l * D;
    LAS float* red = (LAS float*)C.lds;
    LAS float* stat = (LAS float*)(C.lds + 2048);
    LAS unsigned char* tile = C.lds + 4096;
    int tid = C.tid;
    asm volatile("" : "+v"(tid));
    const int c0 = 2 * tid;
    float w0[31], w1[31];
#pragma unroll
    for (int k = 0; k < 31; ++k) { const f32x2 w = *(const f32x2*)(cw + (size_t)k * D + c0); w0[k] = w.x; w1[k] = w.y; }
    const f32x2 bb = *(const f32x2*)(cb + c0), gg = *(const f32x2*)(lng + c0), be = *(const f32x2*)(lnb + c0);
    for (int item = C.blk; item < M / 32; item += C.nblk) {
        const int m0 = item * 32, t0 = m0 & (SEQ - 1);
        __syncthreads();
        cp_stage<62>(tile, UG, m0 - 30, t0 - 30, tid);
        __syncthreads();
        float a0[32], a1[32];
#pragma unroll
        for (int i = 0; i < 32; ++i) { a0[i] = bb.x; a1[i] = bb.y; }
        conv_rows(tile, tid, w0, w1, a0, a1, std::make_integer_sequence<int, 62>{});
#pragma unroll
        for (int ti = 0; ti < 32; ++ti) {
            const float s = dpp_sum63(a0[ti] + a1[ti]), q = dpp_sum63(a0[ti] * a0[ti] + a1[ti] * a1[ti]);
            if (C.lane == 63) { red[C.wave * 64 + ti] = s; red[C.wave * 64 + 32 + ti] = q; }
        }
        __syncthreads();
        if (tid < 32) { float s = 0.f, q = 0.f;
#pragma unroll
            for (int w = 0; w < 8; ++w) { s += red[w * 64 + tid]; q += red[w * 64 + 32 + tid]; }
            const float mean = s * (1.f / D), var = fmaxf(q * (1.f / D) - mean * mean, 0.f); stat[tid] = mean; stat[32 + tid] = 1.f / sqrtf(var + EPS); }
        __syncthreads();
#pragma unroll
        for (int ti = 0; ti < 32; ++ti) { const float mean = stat[ti], rstd = stat[32 + ti];
            const float y0 = (a0[ti] - mean) * rstd * gg.x + be.x, y1 = (a1[ti] - mean) * rstd * gg.y + be.y;
            *(unsigned*)(AC + (size_t)(m0 + ti) * D + c0) = pk2(y0 * sigm(y0), y1 * sigm(y1)); }
        asm volatile("" ::: "memory");
        cp_stage<47>(tile, ZP, m0 - 15, t0 - 15, tid);
        __syncthreads();
        const int g = tid >> 7;
        if (g == 0) pool_item<2>(tile, PL, m0, t0, tid); else if (g == 1) pool_item<4>(tile, PL, m0, t0, tid); else if (g == 2) pool_item<8>(tile, PL, m0, t0, tid); else pool_item<16>(tile, PL, m0, t0, tid);
    }
}

typedef unsigned u32;
template <int CTRL> __device__ __forceinline__ u32 dppu(u32 x) { return (u32)__builtin_amdgcn_update_dpp(0, (int)x, CTRL, 0xf, 0xf, true); }
constexpr int DPP_XOR1 = 0xB1, DPP_REV4 = 0x1B, DPP_DUPE = 0xA0, DPP_DUPO = 0xF5, DPP_HMIRROR = 0x141, DPP_MIRROR = 0x140;
__device__ __forceinline__ u32 umax_(u32 a, u32 b) { return a > b ? a : b; }
__device__ __forceinline__ u32 umin_(u32 a, u32 b) { return a < b ? a : b; }
#define TK_CE(x, i, j) do { const u32 hi_ = umax_(x[i], x[j]), lo_ = umin_(x[i], x[j]); x[i] = hi_; x[j] = lo_; } while (0)
__device__ __forceinline__ void tk_local_merge(u32 (&x)[8]) {
    TK_CE(x, 0, 4); TK_CE(x, 1, 5); TK_CE(x, 2, 6); TK_CE(x, 3, 7);
    TK_CE(x, 0, 2); TK_CE(x, 1, 3); TK_CE(x, 4, 6); TK_CE(x, 5, 7);
    TK_CE(x, 0, 1); TK_CE(x, 2, 3); TK_CE(x, 4, 5); TK_CE(x, 6, 7);
}
template <int CTRL> __device__ __forceinline__ void tk_level(u32 (&x)[8], bool even) {
    u32 t[8];
#pragma unroll
    for (int c = 0; c < 8; ++c) t[c] = dppu<CTRL>(x[7 - c]);
#pragma unroll
    for (int c = 0; c < 8; ++c) x[c] = umax_(x[c], t[c]);
#pragma unroll
    for (int c = 0; c < 8; ++c) { const u32 p = dppu<DPP_XOR1>(x[c]); x[c] = even ? umax_(x[c], p) : umin_(x[c], p); }
    tk_local_merge(x);
}
__device__ __forceinline__ void tk_top16(u32 (&x)[8], bool even) {
    TK_CE(x, 0, 1); TK_CE(x, 2, 3); TK_CE(x, 4, 5); TK_CE(x, 6, 7);
    TK_CE(x, 0, 2); TK_CE(x, 1, 3); TK_CE(x, 4, 6); TK_CE(x, 5, 7);
    TK_CE(x, 1, 2); TK_CE(x, 5, 6);
    TK_CE(x, 0, 4); TK_CE(x, 1, 5); TK_CE(x, 2, 6); TK_CE(x, 3, 7);
    TK_CE(x, 2, 4); TK_CE(x, 3, 5);
    TK_CE(x, 1, 2); TK_CE(x, 3, 4); TK_CE(x, 5, 6);
    { u32 t[8];
#pragma unroll
      for (int c = 0; c < 8; ++c) t[c] = dppu<DPP_XOR1>(x[7 - c]);
#pragma unroll
      for (int c = 0; c < 8; ++c) x[c] = even ? umax_(x[c], t[c]) : umin_(x[c], t[c]); }
    tk_local_merge(x);
    tk_level<DPP_REV4>(x, even); tk_level<DPP_HMIRROR>(x, even); tk_level<DPP_MIRROR>(x, even);
}
__device__ __forceinline__ u32 tk_f2key(float v, int slot) { const u32 u = __builtin_bit_cast(u32, v); const u32 k = u ^ ((u32)((int)u >> 31) | 0x80000000u); return (k & ~127u) | (u32)(127 - slot); }
__device__ __forceinline__ float tk_key2f(u32 k) { k &= ~127u; const u32 m = (u32)((int)k >> 31); return __builtin_bit_cast(float, k ^ (~m | 0x80000000u)); }
__device__ __forceinline__ u32 tk_sel8v(u32 r0, u32 r1, u32 r2, u32 r3, u32 r4, u32 r5, u32 r6, u32 r7, int idx) {
    const bool b0 = idx & 1, b1 = idx & 2, b2 = idx & 4;
    const u32 s01 = b0 ? r1 : r0, s23 = b0 ? r3 : r2, s45 = b0 ? r5 : r4, s67 = b0 ? r7 : r6;
    const u32 s03 = b1 ? s23 : s01, s47 = b1 ? s67 : s45;
    return b2 ? s47 : s03; }
#define tk_sel8(r, idx) tk_sel8v(r[0], r[1], r[2], r[3], r[4], r[5], r[6], r[7], idx)
__device__ __forceinline__ void phase_topk(const Ctx& C, const Args& a) {
    const float* S = (const float*)(a.ws + WS_S); int* EID = (int*)(a.ws + WS_EID); float* GW = (float*)(a.ws + WS_GW);
    const int lane = C.lane, r = lane & 15, q = lane >> 4; const bool even = (lane & 1) == 0;
    pg8::StaticOrder SO; SO.init(M, DQ, C.nblk, C.blk); pg8::Unit un;
    for (int ui = 0; SO.next(ui, un); ++ui)
    for (int wi = C.wave; wi < 64; wi += NWAVES) {
        const int tok = un.pm * 256 + wi * 4 + q, h = un.pn;
        u32 xa[8], xb[8];
        { const float* sp = S + (size_t)tok * DQ + h * 256 + 8 * r; const f32x4 v0 = *(const f32x4*)sp, v1 = *(const f32x4*)(sp + 4), w0 = *(const f32x4*)(sp + 128), w1 = *(const f32x4*)(sp + 132);
#pragma unroll
          for (int c = 0; c < 4; ++c) { xa[c] = tk_f2key(v0[c], 8 * r + c); xa[4 + c] = tk_f2key(v1[c], 8 * r + 4 + c); xb[c] = tk_f2key(w0[c], 8 * r + c); xb[4 + c] = tk_f2key(w1[c], 8 * r + 4 + c); } }
        tk_top16(xa, even); tk_top16(xb, even);
        u32 La[8], Ha[8], Lb[8], Hb[8];
#pragma unroll
        for (int c = 0; c < 8; ++c) { La[c] = dppu<DPP_DUPE>(xa[c]); Ha[c] = dppu<DPP_DUPO>(xa[c]); Lb[c] = dppu<DPP_DUPE>(xb[c]); Hb[c] = dppu<DPP_DUPO>(xb[c]); }
        const u32 a_lane = (r < 8) ? tk_sel8(La, r & 7) : tk_sel8(Ha, r & 7), b_lane = (r < 8) ? tk_sel8(Lb, r & 7) : tk_sel8(Hb, r & 7);
        const float va = tk_key2f(a_lane), vbl = tk_key2f(b_lane), va0 = tk_key2f(La[0]);
        u32 ck[8];
#pragma unroll
        for (int j = 0; j < 8; ++j) { constexpr int lim[8] = {15, 7, 4, 3, 2, 1, 1, 1};
            float v = va + tk_key2f(Lb[j]); bool valid = r <= lim[j];
            if (j == 1) { v = (r >= 8) ? va0 + vbl : v; valid = valid || (r >= 8); }
            ck[j] = valid ? tk_f2key(v, 8 * r + j) : 0u; }
        tk_top16(ck, even);
        const float mx = tk_key2f(dppu<DPP_DUPE>(ck[0]));
        float ex[8], sum = 0.f;
#pragma unroll
        for (int c = 0; c < 8; ++c) { ex[c] = __expf(tk_key2f(ck[c]) - mx); sum += ex[c]; }
        sum += __builtin_bit_cast(float, dppu<DPP_XOR1>(__builtin_bit_cast(u32, sum)));
        const float inv = 1.f / sum;
        int eo[8]; float go[8];
#pragma unroll
        for (int c = 0; c < 8; ++c) { const int slot = 127 - (int)(ck[c] & 127u), i = slot >> 3, j = slot & 7; const bool sp = (j == 1) && (i >= 8);
            const int i2 = sp ? 0 : i, j2 = sp ? i : j;
            const u32 ka = (u32)__builtin_amdgcn_ds_bpermute(((lane & ~15) + i2) << 2, (int)a_lane), kb = (u32)__builtin_amdgcn_ds_bpermute(((lane & ~15) + j2) << 2, (int)b_lane);
            eo[c] = (127 - (int)(ka & 127u)) * 128 + (127 - (int)(kb & 127u)); go[c] = ex[c] * inv; }
        if (r < 2) { int* ep = EID + (size_t)tok * 128 + h * 16 + r * 8; float* gp = GW + (size_t)tok * 128 + h * 16 + r * 8;
            *(u32x4*)ep = (u32x4){(u32)eo[0], (u32)eo[1], (u32)eo[2], (u32)eo[3]}; *(u32x4*)(ep + 4) = (u32x4){(u32)eo[4], (u32)eo[5], (u32)eo[6], (u32)eo[7]};
            *(f32x4*)gp = (f32x4){go[0], go[1], go[2], go[3]}; *(f32x4*)(gp + 4) = (f32x4){go[4], go[5], go[6], go[7]}; }
    }
}

__device__ __forceinline__ float dot2bf(unsigned w, unsigned x, float acc) { return __builtin_amdgcn_fdot2_f32_bf16(__builtin_bit_cast(bf16x2_t, w), __builtin_bit_cast(bf16x2_t, x), acc, false); }
constexpr int PNB = 8;
__device__ __forceinline__ void phase_peer_a(const Ctx& C, const Args& a, int l) {
    const int x = C.blk & 7, wg = (C.blk >> 3) * NWAVES + C.wave, nwg = ((C.nblk + 7 - x) >> 3) * NWAVES;
    const __amdgpu_buffer_rsrc_t UC = __builtin_amdgcn_make_buffer_rsrc(a.ws + WS_UB + ((size_t)l * 8 + x) * NEXP * 128, 0, NEXP * 128, 0x00020000);
    const int* EID = (const int*)(a.ws + WS_EID); const bf16* H = (const bf16*)(a.ws + WS_H); const float* HSC = (const float*)(a.ws + WS_HSC); float* PD = (float*)(a.ws + WS_PD);
    LAS float* dl = (LAS float*)(C.lds + C.wave * 1024);
    for (int t = wg; t < M; t += nwg) {
        unsigned z_ = 0u; asm volatile("" : "+v"(z_));
        const int lane = (int)__builtin_amdgcn_mbcnt_hi(~0u, __builtin_amdgcn_mbcnt_lo(~0u, z_)), p = lane & 7, g = lane >> 3;
        const int ev0 = EID[(size_t)t * 128 + lane], ev1 = EID[(size_t)t * 128 + 64 + lane];
        const float hs = HSC[t], inv = hs > 0.f ? 1.f / hs : 0.f;
        const u32x4 r0 = *(const u32x4*)(H + (size_t)t * D + 128 * x + 16 * p), r1 = *(const u32x4*)(H + (size_t)t * D + 128 * x + 16 * p + 8);
        u32x4 rows[16];
#pragma unroll
        for (int j = 0; j < 16; ++j) { const int e = __builtin_amdgcn_ds_bpermute(((8 * j + g) & 63) << 2, j < 8 ? ev0 : ev1);
            rows[j] = __builtin_bit_cast(u32x4, __builtin_amdgcn_raw_buffer_load_b128(UC, e * 128 + 16 * p, 0, 0)); }
        u32x4 hq; { f32x4 f[4]; unpack8(r0, f[0], f[1]); unpack8(r1, f[2], f[3]);
#pragma unroll
            for (int q = 0; q < 4; ++q) hq[q] = ((unsigned)(int)rintf(f[q].x * inv) & 255u) | (((unsigned)(int)rintf(f[q].y * inv) & 255u) << 8) | (((unsigned)(int)rintf(f[q].z * inv) & 255u) << 16) | ((unsigned)(int)rintf(f[q].w * inv) << 24); }
        float tot[16];
#pragma unroll
        for (int j = 0; j < 16; ++j) {
            int acc = __builtin_amdgcn_sdot4((int)rows[j].x, (int)hq.x, 0, false); acc = __builtin_amdgcn_sdot4((int)rows[j].y, (int)hq.y, acc, false);
            acc = __builtin_amdgcn_sdot4((int)rows[j].z, (int)hq.z, acc, false); acc = __builtin_amdgcn_sdot4((int)rows[j].w, (int)hq.w, acc, false);
            acc += __builtin_amdgcn_update_dpp(0, acc, 0xB1, 0xf, 0xf, true); acc += __builtin_amdgcn_update_dpp(0, acc, 0x4E, 0xf, 0xf, true); acc += __builtin_amdgcn_update_dpp(0, acc, 0x141, 0xf, 0xf, true);
            tot[j] = (float)acc; }
        if (p == 0) {
#pragma unroll
            for (int j = 0; j < 16; ++j) dl[8 * j + g] = tot[j]; }
        asm volatile("s_waitcnt lgkmcnt(0)" ::: "memory");
        const float d0 = dl[lane], d1 = dl[64 + lane];
        PD[((size_t)t * 8 + x) * 128 + lane] = d0; PD[((size_t)t * 8 + x) * 128 + 64 + lane] = d1;
        asm volatile("s_waitcnt lgkmcnt(0)" ::: "memory");
    }
}
__device__ __forceinline__ void phase_peer_c(const Ctx& C, const Args& a, int l) {
    const float* USC = (const float*)(a.ws + WS_USC) + (size_t)l * NEXP; const float* VSC = (const float*)(a.ws + WS_VSC) + (size_t)l * NEXP;
    const int* EID = (const int*)(a.ws + WS_EID); const float* GW = (const float*)(a.ws + WS_GW); const float* HSC = (const float*)(a.ws + WS_HSC); const float* PD = (const float*)(a.ws + WS_PD);
    int* C8 = (int*)(a.ws + WS_COEF); float* CSC = (float*)(a.ws + WS_CSC);
    for (int t = C.gw; t < M; t += C.ngw) { float cf[2]; const float hs = HSC[t];
#pragma unroll
        for (int u = 0; u < 2; ++u) { const int k = 64 * u + C.lane, e = EID[(size_t)t * 128 + k]; float d = 0.f;
#pragma unroll
            for (int xx = 0; xx < 8; ++xx) d += PD[((size_t)t * 8 + xx) * 128 + k];
            const float dd = d * USC[e] * hs; cf[u] = VSC[e] * GW[(size_t)t * 128 + k] * 0.5f * dd * (1.f + erff(dd * 0.70710678118654752f)); }
        const float am = wave_max(fmaxf(fabsf(cf[0]), fabsf(cf[1]))), inv = am > 0.f ? 127.f / am : 0.f;
        C8[(size_t)t * 128 + C.lane] = (int)rintf(cf[0] * inv) & 255; C8[(size_t)t * 128 + 64 + C.lane] = (int)rintf(cf[1] * inv) & 255;
        if (C.lane == 0) CSC[t] = am * (1.f / 127.f); }
}
__device__ __forceinline__ void phase_peer_b(const Ctx& C, const Args& a, int l) {
    const int x = C.blk & 7, wg = (C.blk >> 3) * NWAVES + C.wave, nwg = ((C.nblk + 7 - x) >> 3) * NWAVES;
    const __amdgpu_buffer_rsrc_t VC = __builtin_amdgcn_make_buffer_rsrc(a.ws + WS_VB + ((size_t)l * 8 + x) * NEXP * 128, 0, NEXP * 128, 0x00020000);
    const int* EID = (const int*)(a.ws + WS_EID); const int* C8 = (const int*)(a.ws + WS_COEF); const float* CSC = (const float*)(a.ws + WS_CSC); float* XW = a.out;
    LAS int* ol = (LAS int*)(C.lds + C.wave * 4096);
    unsigned z_ = 0u; asm volatile("" : "+v"(z_));
    const int lane = (int)__builtin_amdgcn_mbcnt_hi(~0u, __builtin_amdgcn_mbcnt_lo(~0u, z_)), p = lane & 7, g = lane >> 3;
#define PB_META(t_, ev0_, ev1_, cf0_, cf1_) do { ev0_ = EID[(size_t)(t_) * 128 + lane]; ev1_ = EID[(size_t)(t_) * 128 + 64 + lane]; cf0_ = C8[(size_t)(t_) * 128 + lane]; cf1_ = C8[(size_t)(t_) * 128 + 64 + lane]; } while (0)
#define PB_ISSUE(rows_, ev_) do { _Pragma("unroll") for (int j = 0; j < 8; ++j) { const int e = __builtin_amdgcn_ds_bpermute((8 * j + g) << 2, ev_); \
        rows_[j] = __builtin_bit_cast(u32x4, __builtin_amdgcn_raw_buffer_load_b128(VC, e * 128 + 16 * p, 0, 0)); } } while (0)
#define PB_HALF(rows_, cf_) do { _Pragma("unroll") for (int j = 0; j < 8; ++j) { const int c0_ = __builtin_amdgcn_ds_bpermute((8 * j + g) << 2, cf_), c1_ = c0_ << 8, c2_ = c0_ << 16, c3_ = c0_ << 24; \
            _Pragma("unroll") for (int q = 0; q < 4; ++q) { const int w_ = (int)rows_[j][q];   \
                o[4 * q + 0] = __builtin_amdgcn_sdot4(w_, c0_, o[4 * q + 0], false); o[4 * q + 1] = __builtin_amdgcn_sdot4(w_, c1_, o[4 * q + 1], false); \
                o[4 * q + 2] = __builtin_amdgcn_sdot4(w_, c2_, o[4 * q + 2], false); o[4 * q + 3] = __builtin_amdgcn_sdot4(w_, c3_, o[4 * q + 3], false); } } } while (0)
    int evA0, evA1, evB0, evB1, cfA0, cfA1, cfB0, cfB1; u32x4 rows0[8], rows1[8];
    const f32x2 g2b0 = *(const f32x2*)(modp(a, l, 0, 5) + 128 * x + 2 * lane), g2b1 = *(const f32x2*)(modp(a, l, 1, 5) + 128 * x + 2 * lane);
    int t = wg;
    { const int tc = t < M ? t : 0; PB_META(tc, evA0, evA1, cfA0, cfA1); }
    { const int tc = t + nwg < M ? t + nwg : 0; PB_META(tc, evB0, evB1, cfB0, cfB1); }
    PB_ISSUE(rows0, evA0);
    f32x2 xvn; float csn; { const int tc = t < M ? t : 0; xvn = *(const f32x2*)(XW + (size_t)tc * D + 128 * x + 2 * lane); csn = CSC[tc]; }
#pragma nounroll
    for (; t < M; t += nwg) {
        const int t2 = t + 2 * nwg, c2 = t2 < M ? t2 : t;
        const int k0 = cfA0, k1 = cfA1;
        const f32x2 xv = xvn; const float cs = csn;
        PB_ISSUE(rows1, evA1);
        evA0 = evB0; evA1 = evB1; cfA0 = cfB0; cfA1 = cfB1;
        PB_META(c2, evB0, evB1, cfB0, cfB1);
        { const int c1 = t + nwg < M ? t + nwg : t; xvn = *(const f32x2*)(XW + (size_t)c1 * D + 128 * x + 2 * lane); csn = CSC[c1]; }
        __builtin_amdgcn_sched_barrier(0);
        int o[16];
#pragma unroll
        for (int i = 0; i < 16; ++i) o[i] = 0;
        PB_HALF(rows0, k0);
        __builtin_amdgcn_sched_barrier(0);
        PB_ISSUE(rows0, evA0);
        __builtin_amdgcn_sched_barrier(0);
        PB_HALF(rows1, k1);
        __builtin_amdgcn_sched_barrier(0);
#pragma unroll
        for (int q = 0; q < 4; ++q) *(LAS u32x4*)(ol + lane * 16 + 4 * q) = (u32x4){(unsigned)o[4 * q], (unsigned)o[4 * q + 1], (unsigned)o[4 * q + 2], (unsigned)o[4 * q + 3]};
        asm volatile("s_waitcnt lgkmcnt(0)" ::: "memory");
        int s0 = 0, s1 = 0;
#pragma unroll
        for (int gg = 0; gg < 8; ++gg) { const u32x2 v = *(const LAS u32x2*)(ol + (gg * 8 + (lane >> 3)) * 16 + 2 * (lane & 7)); s0 += (int)v.x; s1 += (int)v.y; }
        asm volatile("s_waitcnt lgkmcnt(0)" ::: "memory");
        const int c = 128 * x + 2 * lane; const f32x2 g2 = (t >> 13) ? g2b1 : g2b0;
        *(f32x2*)(XW + (size_t)t * D + c) = xv + g2 * (f32x2){(float)s0 * cs, (float)s1 * cs};
    }
#undef PB_META
#undef PB_ISSUE
#undef PB_HALF
}
__device__ __forceinline__ void phase_final(const Ctx& C, const Args& a) {
    for (int m = C.gw; m < M; m += C.ngw) { f32x4 x[4]; float ss = 0.f;
#pragma unroll
        for (int j = 0; j < 4; ++j) { x[j] = *(const f32x4*)(a.out + (size_t)m * D + 4 * C.lane + 256 * j); ss += (x[j].x * x[j].x + x[j].y * x[j].y) + (x[j].z * x[j].z + x[j].w * x[j].w); }
        const float rstd = 1.f / sqrtf(wave_sum(ss) * (1.f / D) + EPS);
#pragma unroll
        for (int j = 0; j < 4; ++j) *(f32x4*)(a.out + (size_t)m * D + 4 * C.lane + 256 * j) = x[j] * rstd * *(const f32x4*)(a.in[I_FG] + 4 * C.lane + 256 * j); }
}

#ifndef USE_NAIVE
#define GEMM mfma_gemm
#else
#define GEMM naive_gemm
#endif
#define RLX_AGENT __ATOMIC_RELAXED, __HIP_MEMORY_SCOPE_AGENT
#define XB_TMO      128
#define XB_XCNT(j)  (256  + 64 * (j))
#define XB_XSUB(j)  (1280 + 64 * (j))
#define XB_XGEN(j)  (2304 + 64 * (j))
#define XB_TOP      3328
#define XB_TOPGEN   3392
#define XCD_BAR_WORDS 3456
#define XB_SPIN_CAP (1u << 18)

__device__ __forceinline__ unsigned xb_ld(unsigned* p)              { return __hip_atomic_load(p, __ATOMIC_RELAXED, __HIP_MEMORY_SCOPE_AGENT); }
__device__ __forceinline__ unsigned xb_add(unsigned* p, unsigned v) { return __hip_atomic_fetch_add(p, v, __ATOMIC_RELAXED, __HIP_MEMORY_SCOPE_AGENT); }
__device__ __forceinline__ unsigned xb_xcc_id() { return (unsigned)__builtin_amdgcn_s_getreg((3 << 11) | 20) & 0xFu; }
#define XB_SPIN(cond, bar) do { unsigned _sp = 0; while (cond) { __builtin_amdgcn_s_sleep(1); \
    if ((++_sp & 255u) == 0u) { if (xb_ld(&(bar)[XB_TMO])) break; if (_sp > XB_SPIN_CAP) { atomicAdd(&(bar)[XB_TMO], 1u); break; } } } } while (0)

struct XcdBarrier {
    unsigned* bar; unsigned x;
    volatile LAS unsigned* st;
};

__device__ __forceinline__ XcdBarrier xcd_barrier_post(unsigned* bar, volatile LAS unsigned* st) {
    XcdBarrier b; b.bar = bar; b.x = xb_xcc_id(); b.st = st;
    if (threadIdx.x == 0) (void)xb_add(&bar[XB_XCNT(b.x)], 1u);
    return b;
}
__device__ __forceinline__ void xcd_barrier_complete(unsigned* bar, unsigned x, unsigned& nloc, unsigned& nx) {
    const unsigned G = gridDim.x * gridDim.y * gridDim.z;
    unsigned sum, cnt, mine, sp = 0u;
    for (;;) {
        sum = 0u; cnt = 0u; mine = 0u;
#pragma unroll
        for (unsigned j = 0; j < 16; ++j) { const unsigned c = xb_ld(&bar[XB_XCNT(j)]); sum += c; cnt += (c > 0u) ? 1u : 0u; mine = (j == x) ? c : mine; }
        if (sum == G) break;
        __builtin_amdgcn_s_sleep(1);
        if ((++sp & 255u) == 0u) { if (xb_ld(&bar[XB_TMO])) break; if (sp > XB_SPIN_CAP) { atomicAdd(&bar[XB_TMO], 1u); break; } }
    }
    nloc = mine > 0u ? mine : 1u; nx = cnt > 0u ? cnt : 1u;
}

__device__ __forceinline__ void xcd_barrier(const XcdBarrier& b, const int tid_) {
    asm volatile("s_waitcnt vmcnt(0)" ::: "memory");
    __syncthreads();
    if (tid_ == 0) {
        unsigned* bar = b.bar;
        __builtin_amdgcn_s_waitcnt(0);
        unsigned nloc = b.st[0], nx = b.st[1];
        if (nloc == 0u) { xcd_barrier_complete(bar, b.x, nloc, nx); b.st[0] = nloc; b.st[1] = nx; }
        const unsigned old = xb_add(&bar[XB_XSUB(b.x)], 1u);
        const unsigned gen = old / nloc;
        if (old + 1u == (gen + 1u) * nloc) {
            __builtin_amdgcn_fence(__ATOMIC_RELEASE, "agent");
            asm volatile("s_waitcnt vmcnt(0)" ::: "memory");
            const unsigned og = xb_add(&bar[XB_TOP], 1u);
            const unsigned tg = og / nx;
            if (og + 1u == (tg + 1u) * nx) xb_add(&bar[XB_TOPGEN], 1u);
            else XB_SPIN(xb_ld(&bar[XB_TOPGEN]) == tg, bar);
            __builtin_amdgcn_fence(__ATOMIC_ACQUIRE, "agent");
            xb_add(&bar[XB_XGEN(b.x)], 1u);
            asm volatile("s_waitcnt vmcnt(0)" ::: "memory");
        } else {
            XB_SPIN(xb_ld(&bar[XB_XGEN(b.x)]) == gen, bar);
            __builtin_amdgcn_fence(__ATOMIC_ACQUIRE, "agent");
            asm volatile("s_waitcnt vmcnt(0)" ::: "memory");
        }
    }
    __syncthreads();
}

constexpr int CW_BAR = 4096;
constexpr size_t CTL_ZERO_BYTES = 65536;
constexpr int LDSCTL_OFF = 131072, MISC_OFF = LDSCTL_OFF + 320;
constexpr int PH_PREP = 0, PH_MODR = 1, PH_N1 = 2, PH_L0 = 3, PH_PER_LAYER = 10, N_PHASES = PH_L0 + DEPTH * PH_PER_LAYER;
__device__ __forceinline__ Ctx make_ctx(LAS unsigned char* lds, int wave_s) {
    unsigned z_ = 0u; asm volatile("" : "+v"(z_));
    int tid_ = (wave_s << 6) | (int)__builtin_amdgcn_mbcnt_hi(~0u, __builtin_amdgcn_mbcnt_lo(~0u, z_)); asm volatile("" : "+v"(tid_));
    Ctx C; C.tid = tid_; C.lane = C.tid & 63; C.wave = __builtin_amdgcn_readfirstlane(C.tid >> 6); C.nblk = gridDim.x; C.blk = blockIdx.x;
    C.gw = C.blk * NWAVES + C.wave; C.ngw = C.nblk * NWAVES; C.lds = lds; return C;
}
#ifndef ONLYPH
#define ONLYPH -1
#endif
constexpr unsigned long long REP_MASK = 0ull;
#define PH(k, ...) if ((ONLYPH < 0 || ONLYPH == (k)) && a.ph_lo <= (k) && (k) < a.ph_hi) { for (int r_ = 0; r_ < 1 + (int)((REP_MASK >> (k)) & 1ull); ++r_) { const Ctx C = make_ctx(lds, wave_s); __VA_ARGS__; } if ((k) + 1 < a.ph_hi) xcd_barrier(bar, make_ctx(lds, wave_s).tid); }
template <int l>
__device__ __forceinline__ void run_layer(const Args& a, LAS unsigned char* lds, const XcdBarrier& bar, const int wave_s) {
    unsigned char* ws = a.ws; constexpr int B0 = PH_L0 + l * PH_PER_LAYER;
    PH(B0 + 0, EpiIn E{a.in[I_BIN] + (size_t)l * DIN, (bf16*)(ws + WS_UG), (bf16*)(ws + WS_ZP), (bf16*)(ws + WS_G)};
               GEMM(C, (const bf16*)(ws + WS_H), D, 0, (const bf16*)(ws + WS_WIN) + (size_t)l * DIN * D, D, M, DIN, D, E))
    PH(B0 + 1, phase_convpool(C, a, l))
    PH(B0 + 2, { EpiPool E{(const bf16*)(ws + WS_G), a.in[I_POOLS] + (size_t)l * D, (bf16*)(ws + WS_TMP)};
                 GEMM(C, (const bf16*)(ws + WS_PL), D, 256, (const bf16*)(ws + WS_POOL) + (size_t)l * 1024 * 256, 256, M, D, 256, E); }
               { const Ctx C2 = make_ctx(lds, wave_s); EpiConv E{(const bf16*)(ws + WS_G), (const bf16*)(ws + WS_TMP), (bf16*)(ws + WS_Y)};
                 GEMM(C2, (const bf16*)(ws + WS_AC), D, 0, (const bf16*)(ws + WS_WCO) + (size_t)l * D * D, D, M, D, D, E); })
    PH(B0 + 3, EpiOut E{l == 0 ? a.in[I_X] : a.out, a.out, modp(a, l, 0, 2), a.in[I_BOUT] + (size_t)l * D};
               GEMM(C, (const bf16*)(ws + WS_Y), D, 0, (const bf16*)(ws + WS_WOUT) + (size_t)l * D * D, D, M, D, D, E))
    PH(B0 + 4, phase_norm(C, a, a.out, a.in[I_N2G] + (size_t)l * D, l, 3, 4, (float*)(ws + WS_HSC)))
    PH(B0 + 5, { EpiS E{(float*)(ws + WS_S)}; GEMM(C, (const bf16*)(ws + WS_H), D, 0, (const bf16*)(ws + WS_WQ) + (size_t)l * DQ * D, D, M, DQ, D, E); }
               asm volatile("s_waitcnt vmcnt(0)" ::: "memory"); __syncthreads();
               { const Ctx C3 = make_ctx(lds, wave_s); phase_topk(C3, a); })
    PH(B0 + 6, phase_peer_a(C, a, l))
    PH(B0 + 7, phase_peer_c(C, a, l))
    PH(B0 + 8, phase_peer_b(C, a, l))
    PH(B0 + 9, if (l + 1 < DEPTH) phase_norm(C, a, a.out, a.in[I_N1G] + (size_t)(l + 1) * D, l + 1, 0, 1, nullptr); else phase_final(C, a))
}
__global__ void __launch_bounds__(NTHREADS, 2) fwd_kernel(Args a) {
    extern __shared__ __attribute__((aligned(16))) unsigned char lds_raw[];
    LAS unsigned char* lds = (LAS unsigned char*)lds_raw;
    for (int u = threadIdx.x; u < (LDS_BYTES - LDSCTL_OFF) / 4; u += NTHREADS) ((LAS unsigned*)(lds + LDSCTL_OFF))[u] = 0u;
    __syncthreads();
    const int wave_s = __builtin_amdgcn_readfirstlane((int)threadIdx.x >> 6);
    const XcdBarrier bar = xcd_barrier_post((unsigned*)(a.ws + WS_CTL) + CW_BAR, (volatile LAS unsigned*)(lds + MISC_OFF) + 8);
    PH(PH_PREP, phase_prep(C, a))
    PH(PH_MODR, phase_modreduce(C, a))
    PH(PH_N1, phase_norm(C, a, a.in[I_X], a.in[I_N1G], 0, 0, 1, nullptr);
              for (int lf = 0; lf < DEPTH; ++lf) { const Ctx C2 = make_ctx(lds, wave_s); EpiWT E{(bf16*)(a.ws + WS_WQ) + (size_t)lf * DQ * D};
                  GEMM(C2, (const bf16*)(a.ws + WS_KEYS) + (size_t)lf * 2048 * 256, 256, 0, (const bf16*)(a.ws + WS_WQB) + (size_t)lf * D * DQ, DQ, DQ, D, 256, E, 256); })
    run_layer<0>(a, lds, bar, wave_s);
    run_layer<1>(a, lds, bar, wave_s);
}

extern "C" void kernel_launch(void* const* d_in, const int* in_sizes, int n_in, void* d_out, int out_size, void* d_ws, size_t ws_size, hipStream_t stream) {
    static int grid = 0;
    if (grid == 0) {
        if (n_in != 22 || out_size != M * D || ws_size < WS_END) { fprintf(stderr, "kernel_launch: unexpected shapes (n_in %d out %d ws %zu)\n", n_in, out_size, ws_size); grid = -1; return; }
        int dev = 0, cus = 0;
        if (hipGetDevice(&dev) != hipSuccess || hipDeviceGetAttribute(&cus, hipDeviceAttributeMultiprocessorCount, dev) != hipSuccess) { grid = -1; return; }
        if (hipFuncSetAttribute((const void*)fwd_kernel, hipFuncAttributeMaxDynamicSharedMemorySize, LDS_BYTES) != hipSuccess) { grid = -1; return; }
        grid = cus;
    }
    if (grid < 0) return;
    Args a{};
    for (int i = 0; i < 22; ++i) a.in[i] = (const float*)d_in[i];
    a.out = (float*)d_out; a.ws = (unsigned char*)d_ws;
    (void)hipMemsetAsync((char*)d_ws + WS_CTL, 0, CTL_ZERO_BYTES, stream);
#ifndef ONE_LAUNCH
    for (int ph = 0; ph < N_PHASES; ++ph) { a.ph_lo = ph; a.ph_hi = ph + 1; hipLaunchKernelGGL(fwd_kernel, dim3(grid), dim3(NTHREADS), LDS_BYTES, stream, a); }
#else
    a.ph_lo = 0; a.ph_hi = N_PHASES; hipLaunchKernelGGL(fwd_kernel, dim3(grid), dim3(NTHREADS), LDS_BYTES, stream, a);
#endif
}
```

```cpp
#define ONE_LAUNCH 1
#include <hip/hip_runtime.h>
#include <cstdint>
#include <cstdio>
#include <utility>

#define GAS __attribute__((address_space(1)))
#define LAS __attribute__((address_space(3)))
typedef unsigned short bf16;
typedef float f32x4 __attribute__((ext_vector_type(4)));
typedef float f32x2 __attribute__((ext_vector_type(2)));
typedef unsigned u32x4 __attribute__((ext_vector_type(4)));
typedef unsigned u32x2 __attribute__((ext_vector_type(2)));
typedef __bf16 bf16x2_t __attribute__((ext_vector_type(2)));

constexpr int BATCH = 2, SEQ = 8192, D = 1024, M = BATCH * SEQ, DEPTH = 2;
constexpr int DIN = 5120, NMODV = 6 * D, CONVK = 31, NHEAD = 8, NKEYS = 128, DQ = 2048, TOPK = 16, NEXP = 16384;
constexpr float EPS = 1e-6f;
constexpr int NWAVES = 8, NTHREADS = NWAVES * 64;

constexpr size_t MiB = 1u << 20;
constexpr size_t WS_CTL = 0;
constexpr size_t WS_MODP = 1 * MiB;
constexpr size_t WS_MOD = 4 * MiB;
constexpr size_t WS_WIN = 8 * MiB;
constexpr size_t WS_WCO = 28 * MiB;
constexpr size_t WS_WOUT = 32 * MiB;
constexpr size_t WS_WQ = 36 * MiB;
constexpr size_t WS_POOL = 44 * MiB;
constexpr size_t WS_KEYS = 45 * MiB;
constexpr size_t WS_UB = 48 * MiB;
constexpr size_t WS_USC = 80 * MiB;
constexpr size_t WS_VSC = 81 * MiB;
constexpr size_t WS_VB = 112 * MiB;
constexpr size_t WS_H = 176 * MiB;
constexpr size_t WS_UG = 208 * MiB;
constexpr size_t WS_Y = WS_UG;
constexpr size_t WS_ZP = 240 * MiB;
constexpr size_t WS_TMP = WS_ZP;
constexpr size_t WS_Q = WS_UG;
constexpr size_t WS_G = 272 * MiB;
constexpr size_t WS_AC = 336 * MiB;
constexpr size_t WS_PL = 368 * MiB;
constexpr size_t WS_S = WS_G;
constexpr size_t WS_EID = 400 * MiB;
constexpr size_t WS_GW = 408 * MiB;
constexpr size_t WS_COEF = 416 * MiB;
constexpr size_t WS_CSC = 424 * MiB + 65536;
constexpr size_t WS_HSC = 424 * MiB;
constexpr size_t WS_PD = WS_S;
constexpr size_t WS_WQB = 426 * MiB;
constexpr size_t WS_END = 434 * MiB;

constexpr int LDS_BYTES = 147456;

__device__ __forceinline__ unsigned f2bf(float f) { unsigned u = __builtin_bit_cast(unsigned, f); return (u + 0x7fffu + ((u >> 16) & 1u)) >> 16; }
__device__ __forceinline__ unsigned pk2(float lo, float hi) { return f2bf(lo) | (f2bf(hi) << 16); }
__device__ __forceinline__ float bflo(unsigned w) { return __builtin_bit_cast(float, w << 16); }
__device__ __forceinline__ float bfhi(unsigned w) { return __builtin_bit_cast(float, w & 0xffff0000u); }
__device__ __forceinline__ float sigm(float x) { return __builtin_amdgcn_rcpf(1.f + __expf(-x)); }
__device__ __forceinline__ float wave_sum(float v) {
#pragma unroll
    for (int o = 1; o < 64; o <<= 1) v += __shfl_xor(v, o);
    return v;
}
__device__ __forceinline__ float wave_max(float v) {
#pragma unroll
    for (int o = 1; o < 64; o <<= 1) v = fmaxf(v, __shfl_xor(v, o));
    return v;
}
__device__ __forceinline__ float dpp_sum63(float v) {
#define DPPF(x, ctrl, rm, bc) __builtin_bit_cast(float, __builtin_amdgcn_update_dpp(0, __builtin_bit_cast(int, x), ctrl, rm, 0xf, bc))
    v += DPPF(v, 0x111, 0xf, true); v += DPPF(v, 0x112, 0xf, true); v += DPPF(v, 0x114, 0xf, true); v += DPPF(v, 0x118, 0xf, true);
    v += DPPF(v, 0x142, 0xa, false); v += DPPF(v, 0x143, 0xc, false);
#undef DPPF
    return v;
}
__device__ __forceinline__ u32x4 pack8(const f32x4& a, const f32x4& b) { u32x4 w; w.x = pk2(a.x, a.y); w.y = pk2(a.z, a.w); w.z = pk2(b.x, b.y); w.w = pk2(b.z, b.w); return w; }
__device__ __forceinline__ void unpack8(const u32x4& w, f32x4& a, f32x4& b) { a = (f32x4){bflo(w.x), bfhi(w.x), bflo(w.y), bfhi(w.y)}; b = (f32x4){bflo(w.z), bfhi(w.z), bflo(w.w), bfhi(w.w)}; }

struct Ctx { int tid, lane, wave, gw, ngw, nblk, blk; LAS unsigned char* lds; };

struct Args { const float* in[22]; float* out; unsigned char* ws; int ph_lo, ph_hi; };
enum { I_X = 0, I_C, I_ADAW, I_ADAB, I_N1G, I_WIN, I_BIN, I_CONVW, I_CONVB, I_LNG, I_LNB, I_WCO, I_POOLW, I_POOLS, I_WOUT, I_BOUT, I_N2G, I_WQ, I_KEYS, I_PU, I_PV, I_FG };

__device__ __forceinline__ void transpose_item(const float* W, int K, int N, int k0, int n0, bf16* WT, int dstrow0, LAS float* scr, int lane) {
#pragma unroll 8
    for (int i = 0; i < 32; ++i) { const int kk = 2 * i + (lane >> 5); scr[kk * 33 + (lane & 31)] = W[(size_t)(k0 + kk) * N + n0 + (lane & 31)]; }
    asm volatile("s_waitcnt lgkmcnt(0)" ::: "memory");
    const int c = lane & 7;
#pragma unroll
    for (int j = 0; j < 4; ++j) { const int n = (lane >> 3) + 8 * j; const LAS float* s = scr + (8 * c) * 33 + n;
        u32x4 o; o.x = pk2(s[0 * 33], s[1 * 33]); o.y = pk2(s[2 * 33], s[3 * 33]); o.z = pk2(s[4 * 33], s[5 * 33]); o.w = pk2(s[6 * 33], s[7 * 33]);
        *(u32x4*)(WT + (size_t)(dstrow0 + n) * K + k0 + 8 * c) = o; }
    asm volatile("s_waitcnt lgkmcnt(0)" ::: "memory");
}
__device__ __forceinline__ int win_dstrow(int n0) {
    if (n0 < 1024) return 256 * (n0 >> 7) + (n0 & 127);
    if (n0 < 2048) { const int c = n0 - 1024; return 256 * (c >> 7) + 128 + (c & 127); }
    return n0;
}
__device__ __forceinline__ void phase_prep(const Ctx& C, const Args& a) {
    unsigned char* ws = a.ws;
    LAS float* scr = (LAS float*)(C.lds + C.wave * 16384);
    constexpr int I_IN = 16 * 160, I_CO = 16 * 32, I_PO = 4 * (4 * 8), I_OUT = 16 * 32, I_L = I_IN + I_CO + I_PO + I_OUT;
    for (int it = C.gw; it < DEPTH * I_L; it += C.ngw) {
        const int l = it / I_L; int r = it % I_L;
        if (r < I_IN) { const int kb = r / 160, nb = r % 160; transpose_item(a.in[I_WIN] + (size_t)l * D * DIN, D, DIN, 64 * kb, 32 * nb, (bf16*)(ws + WS_WIN) + (size_t)l * DIN * D, win_dstrow(32 * nb), scr, C.lane); continue; } r -= I_IN;
        if (r < I_CO) { const int kb = r / 32, nb = r % 32; transpose_item(a.in[I_WCO] + (size_t)l * D * D, D, D, 64 * kb, 32 * nb, (bf16*)(ws + WS_WCO) + (size_t)l * D * D, 32 * nb, scr, C.lane); continue; } r -= I_CO;
        if (r < I_PO) { const int g = r / 32, q = r % 32, kb = q / 8, nb = q % 8; transpose_item(a.in[I_POOLW] + ((size_t)l * 4 + g) * 256 * 256, 256, 256, 64 * kb, 32 * nb, (bf16*)(ws + WS_POOL) + ((size_t)l * 1024 + 256 * g) * 256, 32 * nb, scr, C.lane); continue; } r -= I_PO;
        { const int kb = r / 32, nb = r % 32; transpose_item(a.in[I_WOUT] + (size_t)l * D * D, D, D, 64 * kb, 32 * nb, (bf16*)(ws + WS_WOUT) + (size_t)l * D * D, 32 * nb, scr, C.lane); }
    }
    const int gt = C.blk * NTHREADS + C.tid, ngt = C.nblk * NTHREADS;
    for (size_t i = gt; i < (size_t)DEPTH * D * DQ / 8; i += ngt) { const f32x4 v0 = *(const f32x4*)(a.in[I_WQ] + i * 8), v1 = *(const f32x4*)(a.in[I_WQ] + i * 8 + 4); *(u32x4*)((bf16*)(ws + WS_WQB) + i * 8) = pack8(v0, v1); }
    for (int i = gt; i < DEPTH * 2048 * 32; i += ngt) {
        const int l = i / (2048 * 32), r = i % (2048 * 32), n = r / 32, k8 = (r % 32) * 8;
        const int h = n >> 8, p = (n >> 7) & 1, key = n & 127, pk = k8 >> 7, kk = k8 & 127;
        u32x4 o = (u32x4){0u, 0u, 0u, 0u};
        if (pk == p) { const float* s = a.in[I_KEYS] + ((((size_t)l * 8 + h) * 2 + p) * 128 + key) * 128 + kk; const f32x4 v0 = *(const f32x4*)s, v1 = *(const f32x4*)(s + 4); o = pack8(v0, v1); }
        *(u32x4*)((bf16*)(ws + WS_KEYS) + ((size_t)l * 2048 + n) * 256 + k8) = o;
    }
    for (int t = 0; t < 2; ++t) {
        const float* src = a.in[t == 0 ? I_PU : I_PV]; unsigned char* dst = ws + (t == 0 ? WS_UB : WS_VB); float* scl = (float*)(ws + (t == 0 ? WS_USC : WS_VSC));
        for (int row0 = 4 * C.gw; row0 < DEPTH * NEXP; row0 += 4 * C.ngw) {
            f32x4 v[4][4]; float am[4];
#pragma unroll
            for (int r = 0; r < 4; ++r)
#pragma unroll
                for (int q = 0; q < 4; ++q) v[r][q] = *(const f32x4*)(src + (size_t)(row0 + r) * D + 16 * C.lane + 4 * q);
#pragma unroll
            for (int r = 0; r < 4; ++r) { float m = 0.f;
#pragma unroll
                for (int q = 0; q < 4; ++q) m = fmaxf(m, fmaxf(fmaxf(fabsf(v[r][q].x), fabsf(v[r][q].y)), fmaxf(fabsf(v[r][q].z), fabsf(v[r][q].w))));
                am[r] = wave_max(m); }
#pragma unroll
            for (int r = 0; r < 4; ++r) { const float inv = am[r] > 0.f ? 127.f / am[r] : 0.f; u32x4 w; const int row = row0 + r;
#pragma unroll
                for (int q = 0; q < 4; ++q) w[q] = ((unsigned)(int)rintf(v[r][q].x * inv) & 255u) | (((unsigned)(int)rintf(v[r][q].y * inv) & 255u) << 8) | (((unsigned)(int)rintf(v[r][q].z * inv) & 255u) << 16) | ((unsigned)(int)rintf(v[r][q].w * inv) << 24);
                { const int lyr = row / NEXP, e = row % NEXP; *(u32x4*)(dst + (((size_t)lyr * 8 + (C.lane >> 3)) * NEXP + e) * 128 + 16 * (C.lane & 7)) = w; }
                if (C.lane == 0) scl[row] = am[r] * (1.f / 127.f); }
        }
    }
    for (int it = gt; it < 32 * 3072; it += ngt) {
        const int ks = it / 3072, cg = it % 3072, l = cg / 1536, n4 = (cg % 1536) * 4;
        f32x4 a0 = (f32x4){0.f, 0.f, 0.f, 0.f}, a1 = a0;
        const float* wp = a.in[I_ADAW] + ((size_t)l * D + ks * 32) * NMODV + n4; const float* c0 = a.in[I_C] + ks * 32; const float* c1 = c0 + D;
#pragma unroll 8
        for (int kk = 0; kk < 32; ++kk) { const f32x4 w = *(const f32x4*)(wp + (size_t)kk * NMODV); const float x0 = c0[kk], x1 = c1[kk]; a0 += w * (x0 * sigm(x0)); a1 += w * (x1 * sigm(x1)); }
        float* mp = (float*)(ws + WS_MODP) + (((size_t)ks * 2 + l) * 2) * NMODV + n4;
        *(f32x4*)mp = a0; *(f32x4*)(mp + NMODV) = a1;
    }
}
__device__ __forceinline__ void phase_modreduce(const Ctx& C, const Args& a) {
    const int gt = C.blk * NTHREADS + C.tid, ngt = C.nblk * NTHREADS;
    for (int i = gt; i < 2 * 2 * NMODV; i += ngt) {
        const int l = i / (2 * NMODV), n = i % NMODV; float s = a.in[I_ADAB][(size_t)l * NMODV + n];
        const float* mp = (const float*)(a.ws + WS_MODP) + i;
        for (int ks = 0; ks < 32; ++ks) s += mp[(size_t)ks * 4 * NMODV];
        ((float*)(a.ws + WS_MOD))[i] = s;
    }
}
__device__ __forceinline__ const float* modp(const Args& a, int l, int b, int v) { return (const float*)(a.ws + WS_MOD) + ((size_t)l * 2 + b) * NMODV + v * D; }

__device__ __forceinline__ void normmod_row(const f32x4 (&x)[4], const float* g, const float* sh, const float* sc, int lane, f32x4 (&h)[4]) {
    float s = 0.f;
#pragma unroll
    for (int j = 0; j < 4; ++j) s += (x[j].x * x[j].x + x[j].y * x[j].y) + (x[j].z * x[j].z + x[j].w * x[j].w);
    const float rstd = 1.f / sqrtf(wave_sum(s) * (1.f / D) + EPS);
#pragma unroll
    for (int j = 0; j < 4; ++j) { const int c = 4 * lane + 256 * j; const f32x4 gv = *(const f32x4*)(g + c), shv = *(const f32x4*)(sh + c), scv = *(const f32x4*)(sc + c);
        h[j] = (x[j] * rstd) * gv * (scv + 1.f) + shv; }
}
__device__ __forceinline__ void store_row_bf16(bf16* row, const f32x4 (&h)[4], int lane) {
#pragma unroll
    for (int j = 0; j < 4; ++j) { u32x2 w; w.x = pk2(h[j].x, h[j].y); w.y = pk2(h[j].z, h[j].w); *(u32x2*)(row + 4 * lane + 256 * j) = w; }
}
__device__ __forceinline__ void phase_norm(const Ctx& C, const Args& a, const float* X, const float* g, int l, int vsh, int vsc, float* hsc) {
    bf16* H = (bf16*)(a.ws + WS_H);
    for (int m = C.gw; m < M; m += C.ngw) {
        const int b = m >> 13; f32x4 x[4], h[4];
#pragma unroll
        for (int j = 0; j < 4; ++j) x[j] = *(const f32x4*)(X + (size_t)m * D + 4 * C.lane + 256 * j);
        normmod_row(x, g, modp(a, l, b, vsh), modp(a, l, b, vsc), C.lane, h);
        store_row_bf16(H + (size_t)m * D, h, C.lane);
        if (hsc) { float am = 0.f;
#pragma unroll
            for (int j = 0; j < 4; ++j) { const unsigned w0 = pk2(h[j].x, h[j].y), w1 = pk2(h[j].z, h[j].w); am = fmaxf(am, fmaxf(fmaxf(fabsf(bflo(w0)), fabsf(bfhi(w0))), fmaxf(fabsf(bflo(w1)), fabsf(bfhi(w1))))); }
            am = wave_max(am); if (C.lane == 0) hsc[m] = am * (1.f / 127.f); }
    }
}

struct EpiIn {
    const float* bin; bf16 *UG, *ZP, *G;
    __device__ __forceinline__ void apply(int row, int pn, int cl8, f32x4 a0, f32x4 a1, f32x4 b0, f32x4 b1) const {
        if (pn < 8) {
            const int c = 128 * pn + cl8;
            a0 += *(const f32x4*)(bin + c); a1 += *(const f32x4*)(bin + c + 4); b0 += *(const f32x4*)(bin + 1024 + c); b1 += *(const f32x4*)(bin + 1024 + c + 4);
            f32x4 u0, u1;
#pragma unroll
            for (int i = 0; i < 4; ++i) { u0[i] = a0[i] * sigm(b0[i]); u1[i] = a1[i] * sigm(b1[i]); }
            *(u32x4*)(UG + (size_t)row * D + c) = pack8(u0, u1);
        } else if (pn < 12) {
            const int c = 256 * (pn - 8) + cl8;
            a0 += *(const f32x4*)(bin + 2048 + c); a1 += *(const f32x4*)(bin + 2048 + c + 4); b0 += *(const f32x4*)(bin + 2048 + 128 + c); b1 += *(const f32x4*)(bin + 2048 + 128 + c + 4);
            *(u32x4*)(ZP + (size_t)row * D + c) = pack8(a0, a1); *(u32x4*)(ZP + (size_t)row * D + c + 128) = pack8(b0, b1);
        } else {
            const int c = 256 * (pn - 12) + cl8;
            a0 += *(const f32x4*)(bin + 3072 + c); a1 += *(const f32x4*)(bin + 3072 + c + 4); b0 += *(const f32x4*)(bin + 3072 + 128 + c); b1 += *(const f32x4*)(bin + 3072 + 128 + c + 4);
#pragma unroll
            for (int i = 0; i < 4; ++i) { a0[i] = sigm(a0[i]); a1[i] = sigm(a1[i]); b0[i] = sigm(b0[i]); b1[i] = sigm(b1[i]); }
            *(u32x4*)(G + (size_t)row * 2048 + c) = pack8(a0, a1); *(u32x4*)(G + (size_t)row * 2048 + c + 128) = pack8(b0, b1);
        }
    }
};
struct EpiPool {
    const bf16* G; const float* scale; bf16* TMP;
    __device__ __forceinline__ void apply(int row, int pn, int cl8, f32x4 a0, f32x4 a1, f32x4 b0, f32x4 b1) const {
        const int c = 256 * pn + cl8; f32x4 g0, g1;
        unpack8(*(const u32x4*)(G + (size_t)row * 2048 + 1024 + c), g0, g1);
        a0 = a0 * g0 * *(const f32x4*)(scale + c); a1 = a1 * g1 * *(const f32x4*)(scale + c + 4);
        *(u32x4*)(TMP + (size_t)row * D + c) = pack8(a0, a1);
        unpack8(*(const u32x4*)(G + (size_t)row * 2048 + 1024 + c + 128), g0, g1);
        b0 = b0 * g0 * *(const f32x4*)(scale + c + 128); b1 = b1 * g1 * *(const f32x4*)(scale + c + 132);
        *(u32x4*)(TMP + (size_t)row * D + c + 128) = pack8(b0, b1);
    }
};
struct EpiConv {
    const bf16* G; const bf16* TMP; bf16* Y;
    __device__ __forceinline__ void apply(int row, int pn, int cl8, f32x4 a0, f32x4 a1, f32x4 b0, f32x4 b1) const {
        const int c = 256 * pn + cl8; f32x4 g0, g1, t0, t1;
        unpack8(*(const u32x4*)(G + (size_t)row * 2048 + c), g0, g1); unpack8(*(const u32x4*)(TMP + (size_t)row * D + c), t0, t1);
        *(u32x4*)(Y + (size_t)row * D + c) = pack8(a0 * g0 + t0, a1 * g1 + t1);
        unpack8(*(const u32x4*)(G + (size_t)row * 2048 + c + 128), g0, g1); unpack8(*(const u32x4*)(TMP + (size_t)row * D + c + 128), t0, t1);
        *(u32x4*)(Y + (size_t)row * D + c + 128) = pack8(b0 * g0 + t0, b1 * g1 + t1);
    }
};
struct EpiOut {
    const float* xold; float* xnew; const float* g1;   const float* bout;
    __device__ __forceinline__ void apply(int row, int pn, int cl8, f32x4 a0, f32x4 a1, f32x4 b0, f32x4 b1) const {
        const int c = 256 * pn + cl8; const float* g = g1 + (size_t)(row >> 13) * NMODV; const size_t o = (size_t)row * D + c;
        *(f32x4*)(xnew + o) = *(const f32x4*)(xold + o) + *(const f32x4*)(g + c) * (a0 + *(const f32x4*)(bout + c));
        *(f32x4*)(xnew + o + 4) = *(const f32x4*)(xold + o + 4) + *(const f32x4*)(g + c + 4) * (a1 + *(const f32x4*)(bout + c + 4));
        *(f32x4*)(xnew + o + 128) = *(const f32x4*)(xold + o + 128) + *(const f32x4*)(g + c + 128) * (b0 + *(const f32x4*)(bout + c + 128));
        *(f32x4*)(xnew + o + 132) = *(const f32x4*)(xold + o + 132) + *(const f32x4*)(g + c + 132) * (b1 + *(const f32x4*)(bout + c + 132));
    }
};
struct EpiQ {
    bf16* Q;
    __device__ __forceinline__ void apply(int row, int pn, int cl8, f32x4 a0, f32x4 a1, f32x4 b0, f32x4 b1) const {
        const size_t o = (size_t)row * DQ + 256 * pn + cl8; *(u32x4*)(Q + o) = pack8(a0, a1); *(u32x4*)(Q + o + 128) = pack8(b0, b1);
    }
};
struct EpiWT {
    bf16* W;
    __device__ __forceinline__ void apply(int row, int pn, int cl8, f32x4 a0, f32x4 a1, f32x4 b0, f32x4 b1) const {
        const size_t o = (size_t)row * D + 256 * pn + cl8; *(u32x4*)(W + o) = pack8(a0, a1); *(u32x4*)(W + o + 128) = pack8(b0, b1);
    }
};
struct EpiS {
    float* S;
    __device__ __forceinline__ void apply(int row, int pn, int cl8, f32x4 a0, f32x4 a1, f32x4 b0, f32x4 b1) const {
        const size_t o = (size_t)row * DQ + 256 * pn + cl8; *(f32x4*)(S + o) = a0; *(f32x4*)(S + o + 4) = a1; *(f32x4*)(S + o + 128) = b0; *(f32x4*)(S + o + 132) = b1;
    }
};

namespace pg8 {
#define PG8_LAS __attribute__((address_space(3)))
typedef unsigned short bf16_t;
typedef short bf16x8 __attribute__((ext_vector_type(8)));
typedef float f32x4 __attribute__((ext_vector_type(4)));
typedef unsigned u32x4 __attribute__((ext_vector_type(4)));
constexpr int BM = 256, BK = 64, HALF = 128, HTB = HALF * BK * 2  , STAGE_BYTES = 8 * HTB, NXCD = 8, WGM = 8;

__host__ __device__ __forceinline__ int lds_byte(int r, int c) { const int st = (r >> 4) * 2 + (c >> 5), rr = r & 15, cc = c & 31, ob = rr * 64 + cc * 2; return st * 1024 + (ob ^ (((ob >> 9) & 1) << 5)); }
__host__ __device__ __forceinline__ void stage_rc(int b, int& R, int& C) { const int st = b / 1024, sb = b % 1024, swz = sb ^ (((sb >> 9) & 1) << 5); R = (st >> 1) * 16 + swz / 64; C = (st & 1) * 32 + (swz % 64) / 2; }
__host__ __device__ __forceinline__ int perm32(int rho) { const int n = rho >> 4, i = rho & 15; return 8 * (i >> 2) + 4 * n + (i & 3); }

struct Unit { int pm, pn; };
struct Gemm { const bf16_t* A; const bf16_t* Bt; int M, N, K, lda, ldb, acol, bcol; };

struct StaticOrder {
    int nM, nN, nwg, G, c;
    __host__ __device__ void init(int M, int N, int G_, int c_) { nM = M / BM; nN = N / BM; nwg = nM * nN; G = G_; c = c_; }
    __host__ __device__ bool next(int i, Unit& u) const {
        const long L = (long)i * G + c; if (L >= nwg) return false;
        int wgid = (int)L; { const int q = nwg / NXCD, r = nwg % NXCD, xcd = wgid % NXCD, off = wgid / NXCD; wgid = (xcd < r ? xcd * (q + 1) : r * (q + 1) + (xcd - r) * q) + off; }
        const int nig = WGM * nN, gid = wgid / nig, fm = gid * WGM, gsz = (nM - fm) < WGM ? (nM - fm) : WGM;
        u.pm = fm + ((wgid % nig) % gsz); u.pn = (wgid % nig) / gsz; return true;
    }
    __device__ __forceinline__ void a_ready(const Unit&) const {}
    __device__ __forceinline__ void done(const Unit&) const {}
};


template <class Epi, class Sched, bool ALIGN_EPI = false, bool SP2 = false>
__device__ __forceinline__ void gemm_phase(PG8_LAS unsigned char* lds, const Gemm g, const Sched& S, const Epi& E, const int tid) {
    const int wid = __builtin_amdgcn_readfirstlane(tid >> 6), lane = tid & 63, wr = wid >> 2, wc = wid & 3, fr = lane & 15, fq = lane >> 4;
    const int K = g.K, nt = K / BK;
    unsigned voffA[2], voffB[2];
#pragma unroll
    for (int i = 0; i < 2; ++i) { int R, C; stage_rc(tid * 16 + i * 8192, R, C); const int Rb = Epi::PERM ? ((R & ~31) + perm32(R & 31)) : R;
        voffA[i] = (unsigned)(R * g.lda + C) * 2u; voffB[i] = (unsigned)(Rb * g.ldb + C) * 2u; }
    const size_t kstep = (size_t)(BK * 2);
    const size_t hstepA = (size_t)HALF * g.lda * 2, hstepB = (size_t)HALF * g.ldb * 2;
    const size_t tstepA = 2 * hstepA, tstepB = 2 * hstepB, acolb = (size_t)g.acol * 2, bcolb = (size_t)g.bcol * 2;
    const unsigned ldsw = (unsigned)wid * 1024u;
    const int aoff = lds_byte(wr * 64 + fr, fq * 8), boff = lds_byte(wc * 32 + fr, fq * 8);
#define PG8_SA(b, h) (((b) * 2 + (h)) * HTB)
#define PG8_SB(b, h) ((4 + (b) * 2 + (h)) * HTB)
#define PG8_STAGE(bufoff, gbase, voff) do { _Pragma("unroll") for (int _i = 0; _i < 2; ++_i) \
        __builtin_amdgcn_global_load_lds((const unsigned*)((const char*)(gbase) + (voff)[_i]), (PG8_LAS unsigned*)(lds + (bufoff) + ldsw + _i * 8192), 16, 0, 0); } while (0)
#define PG8_LDA(dst, b, h) do { _Pragma("unroll") for (int m = 0; m < 4; ++m) _Pragma("unroll") for (int k = 0; k < 2; ++k) dst[m][k] = *(const PG8_LAS bf16x8*)(lds + PG8_SA(b, h) + aoff + m * 2048 + k * 1024); } while (0)
#define PG8_LDB(dst, b, h) do { _Pragma("unroll") for (int n = 0; n < 2; ++n) _Pragma("unroll") for (int k = 0; k < 2; ++k) dst[n][k] = *(const PG8_LAS bf16x8*)(lds + PG8_SB(b, h) + boff + n * 2048 + k * 1024); } while (0)
#define PG8_MMA(ai, bj, At, Bt) do { __builtin_amdgcn_s_setprio(1); _Pragma("unroll") for (int m = 0; m < 4; ++m) _Pragma("unroll") for (int n = 0; n < 2; ++n) _Pragma("unroll") for (int k = 0; k < 2; ++k) \
        acc[ai][bj][m][n] = __builtin_amdgcn_mfma_f32_16x16x32_bf16(Bt[n][k], At[m][k], acc[ai][bj][m][n], 0, 0, 0); __builtin_amdgcn_s_setprio(0); } while (0)
#define PG8_WAIT_V(n) asm volatile("s_waitcnt vmcnt(" #n ")" ::: "memory")
#define PG8_WAIT_L(n) asm volatile("s_waitcnt lgkmcnt(" #n ")" ::: "memory")
#define PG8_BAR __builtin_amdgcn_s_barrier()
#define PG8_SCHED __builtin_amdgcn_sched_barrier(0)
    Unit cur, nxt; int ui = 0;
    if (!S.next(0, cur)) return;
    f32x4 acc[2][2][4][2];
#pragma unroll
    for (int a = 0; a < 2; ++a)
#pragma unroll
        for (int b = 0; b < 2; ++b)
#pragma unroll
            for (int m = 0; m < 4; ++m)
#pragma unroll
                for (int n = 0; n < 2; ++n) acc[a][b][m][n] = (f32x4){0.f, 0.f, 0.f, 0.f};
    bf16x8 At[4][2], B0[2][2], B1[2][2];
    const char* cA = (const char*)g.A + (size_t)cur.pm * tstepA + (size_t)cur.pn * acolb; const char* cB = (const char*)g.Bt + (size_t)cur.pn * tstepB + (size_t)cur.pm * bcolb;
    S.a_ready(cur);
    if constexpr (SP2) {
        PG8_STAGE(PG8_SB(0, 0), cB, voffB); PG8_STAGE(PG8_SB(0, 1), cB + hstepB, voffB); PG8_STAGE(PG8_SA(0, 0), cA, voffA); PG8_STAGE(PG8_SA(0, 1), cA + hstepA, voffA);
        if (wr == 1) PG8_BAR;
        PG8_WAIT_V(2); PG8_BAR;
        PG8_STAGE(PG8_SB(1, 0), cB + kstep, voffB); PG8_STAGE(PG8_SA(1, 0), cA + kstep, voffA); PG8_STAGE(PG8_SB(1, 1), cB + hstepB + kstep, voffB);
        PG8_WAIT_V(6); PG8_BAR;
    } else {
        PG8_STAGE(PG8_SB(0, 0), cB, voffB); PG8_STAGE(PG8_SA(0, 0), cA, voffA); PG8_STAGE(PG8_SB(0, 1), cB + hstepB, voffB); PG8_STAGE(PG8_SA(0, 1), cA + hstepA, voffA);
        if (wr == 1) PG8_BAR;
        PG8_WAIT_V(4); PG8_BAR;
        PG8_STAGE(PG8_SB(1, 0), cB + kstep, voffB); PG8_STAGE(PG8_SA(1, 0), cA + kstep, voffA); PG8_STAGE(PG8_SB(1, 1), cB + hstepB + kstep, voffB);
        PG8_WAIT_V(6); PG8_BAR;
    }
    for (;;) {
        const bool has_next = S.next(ui + 1, nxt);
        const char* nA = has_next ? (const char*)g.A + (size_t)nxt.pm * tstepA + (size_t)nxt.pn * acolb : cA; const char* nB = has_next ? (const char*)g.Bt + (size_t)nxt.pn * tstepB + (size_t)nxt.pm * bcolb : cB;
#pragma nounroll
        for (int t = 0; t < nt; t += 2) {
            const bool last = (t == nt - 2);
            const char* a1 = cA + (size_t)(t + 1) * kstep;
            const char* a2 = last ? nA : cA + (size_t)(t + 2) * kstep; const char* b2 = last ? nB : cB + (size_t)(t + 2) * kstep;
            const char* a3 = a2 + kstep; const char* b3 = b2 + kstep;
            if (last && has_next) S.a_ready(nxt);
            if constexpr (SP2) {
            PG8_LDB(B0, 0, 0); PG8_LDB(B1, 0, 1); PG8_SCHED; PG8_LDA(At, 0, 0); PG8_STAGE(PG8_SA(1, 1), a1 + hstepA, voffA);
            PG8_WAIT_V(8); PG8_WAIT_L(0); PG8_BAR; PG8_MMA(0, 0, At, B0); PG8_MMA(0, 1, At, B1); PG8_BAR; PG8_SCHED;
            PG8_LDA(At, 0, 1); PG8_STAGE(PG8_SB(0, 0), b2, voffB); PG8_STAGE(PG8_SB(0, 1), b2 + hstepB, voffB); PG8_STAGE(PG8_SA(0, 0), a2, voffA);
            PG8_WAIT_V(8); PG8_WAIT_L(0); PG8_BAR; PG8_MMA(1, 0, At, B0); PG8_MMA(1, 1, At, B1); PG8_BAR; PG8_SCHED;
            PG8_LDB(B0, 1, 0); PG8_LDB(B1, 1, 1); PG8_SCHED; PG8_LDA(At, 1, 0); PG8_STAGE(PG8_SA(0, 1), a2 + hstepA, voffA);
            PG8_WAIT_V(8); PG8_WAIT_L(0); PG8_BAR; PG8_MMA(0, 0, At, B0); PG8_MMA(0, 1, At, B1); PG8_BAR; PG8_SCHED;
            PG8_LDA(At, 1, 1); PG8_STAGE(PG8_SB(1, 0), b3, voffB); PG8_STAGE(PG8_SB(1, 1), b3 + hstepB, voffB); PG8_STAGE(PG8_SA(1, 0), a3, voffA);
            PG8_WAIT_V(8); PG8_WAIT_L(0); PG8_BAR; PG8_MMA(1, 0, At, B0); PG8_MMA(1, 1, At, B1); PG8_BAR; PG8_SCHED;
            } else {
            PG8_LDB(B0, 0, 0); PG8_SCHED; PG8_LDA(At, 0, 0); PG8_STAGE(PG8_SA(1, 1), a1 + hstepA, voffA);
            PG8_WAIT_L(8); PG8_BAR; PG8_WAIT_L(0); PG8_MMA(0, 0, At, B0); PG8_BAR; PG8_SCHED;
            PG8_LDB(B1, 0, 1); PG8_STAGE(PG8_SB(0, 0), b2, voffB);
            PG8_BAR; PG8_WAIT_L(0); PG8_MMA(0, 1, At, B1); PG8_BAR;
            PG8_LDA(At, 0, 1); PG8_STAGE(PG8_SA(0, 0), a2, voffA);
            PG8_BAR; PG8_WAIT_L(0); PG8_MMA(1, 0, At, B0); PG8_BAR; PG8_SCHED;
            PG8_STAGE(PG8_SB(0, 1), b2 + hstepB, voffB);
            PG8_WAIT_V(6); PG8_BAR; PG8_MMA(1, 1, At, B1); PG8_BAR;
            PG8_LDB(B0, 1, 0); PG8_SCHED; PG8_LDA(At, 1, 0); PG8_STAGE(PG8_SA(0, 1), a2 + hstepA, voffA);
            PG8_WAIT_L(8); PG8_BAR; PG8_WAIT_L(0); PG8_MMA(0, 0, At, B0); PG8_BAR; PG8_SCHED;
            PG8_LDB(B1, 1, 1); PG8_STAGE(PG8_SB(1, 0), b3, voffB);
            PG8_BAR; PG8_WAIT_L(0); PG8_MMA(0, 1, At, B1); PG8_BAR;
            PG8_LDA(At, 1, 1); PG8_STAGE(PG8_SA(1, 0), a3, voffA);
            PG8_BAR; PG8_WAIT_L(0); PG8_MMA(1, 0, At, B0); PG8_BAR; PG8_SCHED;
            PG8_STAGE(PG8_SB(1, 1), b3 + hstepB, voffB);
            PG8_WAIT_V(6); PG8_BAR; PG8_MMA(1, 1, At, B1); PG8_BAR;
            }
        }
        if constexpr (ALIGN_EPI) { if (wr == 0) PG8_BAR; }
        if constexpr (!Epi::AFTER_DRAIN) { E(acc, cur, wr, wc, fr, fq); S.done(cur); }
        if (!has_next) break;
#pragma unroll
        for (int a = 0; a < 2; ++a)
#pragma unroll
            for (int b = 0; b < 2; ++b)
#pragma unroll
                for (int m = 0; m < 4; ++m)
#pragma unroll
                    for (int n = 0; n < 2; ++n) acc[a][b][m][n] = (f32x4){0.f, 0.f, 0.f, 0.f};
        cur = nxt; cA = nA; cB = nB; ++ui;
        if constexpr (ALIGN_EPI) { if (wr == 1) PG8_BAR; }
    }
    PG8_WAIT_V(0);
    if constexpr (!ALIGN_EPI) { if (wr == 0) PG8_BAR; }
    PG8_BAR;
    if constexpr (Epi::AFTER_DRAIN) { E.fused(acc, cur, wr, wc, fr, fq, lds, wid, lane); S.done(cur); }
#undef PG8_SA
#undef PG8_SB
#undef PG8_STAGE
#undef PG8_LDA
#undef PG8_LDB
#undef PG8_MMA
#undef PG8_WAIT_V
#undef PG8_WAIT_L
#undef PG8_BAR
#undef PG8_SCHED
}

template <class F> struct EpiW {
    static constexpr bool PERM = true, AFTER_DRAIN = false; F f;
    __device__ __forceinline__ void operator()(const f32x4 (&acc)[2][2][4][2], const Unit& u, int wr, int wc, int fr, int fq) const {
#pragma unroll
        for (int ai = 0; ai < 2; ++ai)
#pragma unroll
            for (int m = 0; m < 4; ++m) { f.apply(u.pm * BM + ai * HALF + wr * 64 + m * 16 + fr, u.pn, wc * 32 + 8 * fq, acc[ai][0][m][0], acc[ai][0][m][1], acc[ai][1][m][0], acc[ai][1][m][1]);
                asm volatile("" ::: "memory"); }
    }
};
}

template <class F>
__device__ __forceinline__ void mfma_gemm(const Ctx& C, const bf16* A, int lda, int acol, const bf16* Bt, int ldb, int Mr, int N, int K, const F& f, int bcol = 0) {
    pg8::Gemm g{A, Bt, Mr, N, K, lda, ldb, acol, bcol}; pg8::StaticOrder S; S.init(Mr, N, C.nblk, C.blk); pg8::EpiW<F> E{f};
    pg8::gemm_phase<pg8::EpiW<F>, pg8::StaticOrder, true, true>(C.lds, g, S, E, C.tid);
}

template <class F>
__device__ __forceinline__ void naive_gemm(const Ctx& C, const bf16* A, int lda, int acol, const bf16* Bt, int ldb, int Mr, int N, int K, const F& f) {
    LAS float* As = (LAS float*)C.lds;
    LAS float* Bs = (LAS float*)(C.lds + 8192);
    const int ntm = Mr / 128, ntn = N / 256, tid = C.tid, cg = tid & 15, r0 = tid >> 4;
    for (int tile = C.blk; tile < ntm * ntn; tile += C.nblk) {
        const int tm = tile / ntn, pn = tile % ntn;
        f32x4 acc[4][4];
#pragma unroll
        for (int i = 0; i < 4; ++i)
#pragma unroll
            for (int j = 0; j < 4; ++j) acc[i][j] = (f32x4){0.f, 0.f, 0.f, 0.f};
        const bf16* ap = A + (size_t)(tm * 128 + (tid >> 2)) * lda + pn * acol + (tid & 3) * 4;
        const bf16* bp = Bt + (size_t)(pn * 256 + (tid >> 1)) * ldb + (tid & 1) * 8;
        for (int k0 = 0; k0 < K; k0 += 16) {
            const u32x2 av = *(const u32x2*)(ap + k0); const u32x4 bv = *(const u32x4*)(bp + k0);
            __syncthreads();
            { const int r = tid >> 2, kq = (tid & 3) * 4; As[(kq + 0) * 128 + r] = bflo(av.x); As[(kq + 1) * 128 + r] = bfhi(av.x); As[(kq + 2) * 128 + r] = bflo(av.y); As[(kq + 3) * 128 + r] = bfhi(av.y); }
            { const int n = tid >> 1, kq = (tid & 1) * 8; Bs[(kq + 0) * 256 + n] = bflo(bv.x); Bs[(kq + 1) * 256 + n] = bfhi(bv.x); Bs[(kq + 2) * 256 + n] = bflo(bv.y); Bs[(kq + 3) * 256 + n] = bfhi(bv.y);
              Bs[(kq + 4) * 256 + n] = bflo(bv.z); Bs[(kq + 5) * 256 + n] = bfhi(bv.z); Bs[(kq + 6) * 256 + n] = bflo(bv.w); Bs[(kq + 7) * 256 + n] = bfhi(bv.w); }
            __syncthreads();
#pragma unroll
            for (int kk = 0; kk < 16; ++kk) {
                const f32x4 b0 = *(const LAS f32x4*)(Bs + kk * 256 + cg * 8), b1 = *(const LAS f32x4*)(Bs + kk * 256 + cg * 8 + 4), b2 = *(const LAS f32x4*)(Bs + kk * 256 + 128 + cg * 8), b3 = *(const LAS f32x4*)(Bs + kk * 256 + 128 + cg * 8 + 4);
#pragma unroll
                for (int i = 0; i < 4; ++i) { const float av1 = As[kk * 128 + r0 + 32 * i]; acc[i][0] += b0 * av1; acc[i][1] += b1 * av1; acc[i][2] += b2 * av1; acc[i][3] += b3 * av1; }
            }
        }
#pragma unroll
        for (int i = 0; i < 4; ++i) f.apply(tm * 128 + r0 + 32 * i, pn, cg * 8, acc[i][0], acc[i][1], acc[i][2], acc[i][3]);
    }
}

template <int NROWS>
__device__ __forceinline__ void cp_stage(LAS unsigned char* tile, const bf16* src, int mrow0, int tfirst, int tid) {
    constexpr int NIT = (NROWS * 128 + NTHREADS - 1) / NTHREADS;
    asm volatile("" : "+v"(tid));
    u32x4 v[NIT];
#pragma unroll
    for (int i = 0; i < NIT; ++i) { const int ch = i * NTHREADS + tid, r = ch >> 7, c = ch & 127; v[i] = (u32x4){0u, 0u, 0u, 0u};
        if (ch < NROWS * 128 && tfirst + r >= 0) v[i] = *(const u32x4*)(src + (size_t)(mrow0 + r) * D + c * 8); }
#pragma unroll
    for (int i = 0; i < NIT; ++i) { const int ch = i * NTHREADS + tid; if (ch < NROWS * 128) *(LAS u32x4*)(tile + ch * 16) = v[i]; }
}
template <int W>
__device__ __forceinline__ void pool_item(const LAS unsigned char* tile, bf16* PL, int m0, int t0, int tid) {
    float p0[47], p1[47];
#pragma unroll
    for (int i = 0; i < 47; ++i) { unsigned w = 0u; if (i >= 15 - (W - 1)) w = *(const LAS unsigned*)(tile + i * 2048 + 4 * tid); p0[i] = bflo(w); p1[i] = bfhi(w); }
#pragma unroll
    for (int ti = 0; ti < 32; ++ti) {
        float s0 = 0.f, s1 = 0.f;
#pragma unroll
        for (int j = 0; j < W; ++j) { s0 += p0[ti + 15 - j]; s1 += p1[ti + 15 - j]; }
        const int cnt = (t0 + ti + 1) < W ? (t0 + ti + 1) : W; const float inv = 1.f / (float)cnt;
        *(unsigned*)(PL + (size_t)(m0 + ti) * D + 2 * tid) = pk2(s0 * inv - p0[ti + 15], s1 * inv - p1[ti + 15]);
    }
}
template <int RI>
__device__ __forceinline__ void conv_row(const LAS unsigned char* tile, int tid, const float (&w0)[31], const float (&w1)[31], float (&a0)[32], float (&a1)[32]) {
    const unsigned w = *(const LAS unsigned*)(tile + RI * 2048 + 4 * tid);
    const float u0 = bflo(w), u1 = bfhi(w);
#pragma unroll
    for (int ti = 0; ti < 32; ++ti) { constexpr int dbase = 30 - RI; const int d = ti + dbase; if (d >= 0 && d <= 30) { a0[ti] += w0[30 - d] * u0; a1[ti] += w1[30 - d] * u1; } }
    if constexpr ((RI & 7) == 7) asm volatile("" ::: "memory");
}
template <int... RI>
__device__ __forceinline__ void conv_rows(const LAS unsigned char* tile, int tid, const float (&w0)[31], const float (&w1)[31], float (&a0)[32], float (&a1)[32], std::integer_sequence<int, RI...>) {
    (conv_row<RI>(tile, tid, w0, w1, a0, a1), ...);
}
__device__ __forceinline__ void phase_convpool(const Ctx& C, const Args& a, int l) {
    const bf16* UG = (const bf16*)(a.ws + WS_UG); const bf16* ZP = (const bf16*)(a.ws + WS_ZP);
    bf16* AC = (bf16*)(a.ws + WS_AC); bf16* PL = (bf16*)(a.ws + WS_PL);
    const float* cw = a.in[I_CONVW] + (size_t)l * CONVK * D; const float* cb = a.in[I_CONVB] + (size_t)l * D;
    const float* lng = a.in[I_LNG] + (size_t)l * D; const float* lnb = a.in[I_LNB] + (size_t)l * D;
    LAS float* red = (LAS float*)C.lds;
    LAS float* stat = (LAS float*)(C.lds + 2048);
    LAS unsigned char* tile = C.lds + 4096;
    int tid = C.tid;
    asm volatile("" : "+v"(tid));
    const int c0 = 2 * tid;
    float w0[31], w1[31];
#pragma unroll
    for (int k = 0; k < 31; ++k) { const f32x2 w = *(const f32x2*)(cw + (size_t)k * D + c0); w0[k] = w.x; w1[k] = w.y; }
    const f32x2 bb = *(const f32x2*)(cb + c0), gg = *(const f32x2*)(lng + c0), be = *(const f32x2*)(lnb + c0);
    for (int item = C.blk; item < M / 32; item += C.nblk) {
        const int m0 = item * 32, t0 = m0 & (SEQ - 1);
        __syncthreads();
        cp_stage<62>(tile, UG, m0 - 30, t0 - 30, tid);
        __syncthreads();
        float a0[32], a1[32];
#pragma unroll
        for (int i = 0; i < 32; ++i) { a0[i] = bb.x; a1[i] = bb.y; }
        conv_rows(tile, tid, w0, w1, a0, a1, std::make_integer_sequence<int, 62>{});
#pragma unroll
        for (int ti = 0; ti < 32; ++ti) {
            const float s = dpp_sum63(a0[ti] + a1[ti]), q = dpp_sum63(a0[ti] * a0[ti] + a1[ti] * a1[ti]);
            if (C.lane == 63) { red[C.wave * 64 + ti] = s; red[C.wave * 64 + 32 + ti] = q; }
        }
        __syncthreads();
        if (tid < 32) { float s = 0.f, q = 0.f;
#pragma unroll
            for (int w = 0; w < 8; ++w) { s += red[w * 64 + tid]; q += red[w * 64 + 32 + tid]; }
            const float mean = s * (1.f / D), var = fmaxf(q * (1.f / D) - mean * mean, 0.f); stat[tid] = mean; stat[32 + tid] = 1.f / sqrtf(var + EPS); }
        __syncthreads();
#pragma unroll
        for (int ti = 0; ti < 32; ++ti) { const float mean = stat[ti], rstd = stat[32 + ti];
            const float y0 = (a0[ti] - mean) * rstd * gg.x + be.x, y1 = (a1[ti] - mean) * rstd * gg.y + be.y;
            *(unsigned*)(AC + (size_t)(m0 + ti) * D + c0) = pk2(y0 * sigm(y0), y1 * sigm(y1)); }
        asm volatile("" ::: "memory");
        cp_stage<47>(tile, ZP, m0 - 15, t0 - 15, tid);
        __syncthreads();
        const int g = tid >> 7;
        if (g == 0) pool_item<2>(tile, PL, m0, t0, tid); else if (g == 1) pool_item<4>(tile, PL, m0, t0, tid); else if (g == 2) pool_item<8>(tile, PL, m0, t0, tid); else pool_item<16>(tile, PL, m0, t0, tid);
    }
}

typedef unsigned u32;
template <int CTRL> __device__ __forceinline__ u32 dppu(u32 x) { return (u32)__builtin_amdgcn_update_dpp(0, (int)x, CTRL, 0xf, 0xf, true); }
constexpr int DPP_XOR1 = 0xB1, DPP_REV4 = 0x1B, DPP_DUPE = 0xA0, DPP_DUPO = 0xF5, DPP_HMIRROR = 0x141, DPP_MIRROR = 0x140;
__device__ __forceinline__ u32 umax_(u32 a, u32 b) { return a > b ? a : b; }
__device__ __forceinline__ u32 umin_(u32 a, u32 b) { return a < b ? a : b; }
#define TK_CE(x, i, j) do { const u32 hi_ = umax_(x[i], x[j]), lo_ = umin_(x[i], x[j]); x[i] = hi_; x[j] = lo_; } while (0)
__device__ __forceinline__ void tk_local_merge(u32 (&x)[8]) {
    TK_CE(x, 0, 4); TK_CE(x, 1, 5); TK_CE(x, 2, 6); TK_CE(x, 3, 7);
    TK_CE(x, 0, 2); TK_CE(x, 1, 3); TK_CE(x, 4, 6); TK_CE(x, 5, 7);
    TK_CE(x, 0, 1); TK_CE(x, 2, 3); TK_CE(x, 4, 5); TK_CE(x, 6, 7);
}
template <int CTRL> __device__ __forceinline__ void tk_level(u32 (&x)[8], bool even) {
    u32 t[8];
#pragma unroll
    for (int c = 0; c < 8; ++c) t[c] = dppu<CTRL>(x[7 - c]);
#pragma unroll
    for (int c = 0; c < 8; ++c) x[c] = umax_(x[c], t[c]);
#pragma unroll
    for (int c = 0; c < 8; ++c) { const u32 p = dppu<DPP_XOR1>(x[c]); x[c] = even ? umax_(x[c], p) : umin_(x[c], p); }
    tk_local_merge(x);
}
__device__ __forceinline__ void tk_top16(u32 (&x)[8], bool even) {
    TK_CE(x, 0, 1); TK_CE(x, 2, 3); TK_CE(x, 4, 5); TK_CE(x, 6, 7);
    TK_CE(x, 0, 2); TK_CE(x, 1, 3); TK_CE(x, 4, 6); TK_CE(x, 5, 7);
    TK_CE(x, 1, 2); TK_CE(x, 5, 6);
    TK_CE(x, 0, 4); TK_CE(x, 1, 5); TK_CE(x, 2, 6); TK_CE(x, 3, 7);
    TK_CE(x, 2, 4); TK_CE(x, 3, 5);
    TK_CE(x, 1, 2); TK_CE(x, 3, 4); TK_CE(x, 5, 6);
    { u32 t[8];
#pragma unroll
      for (int c = 0; c < 8; ++c) t[c] = dppu<DPP_XOR1>(x[7 - c]);
#pragma unroll
      for (int c = 0; c < 8; ++c) x[c] = even ? umax_(x[c], t[c]) : umin_(x[c], t[c]); }
    tk_local_merge(x);
    tk_level<DPP_REV4>(x, even); tk_level<DPP_HMIRROR>(x, even); tk_level<DPP_MIRROR>(x, even);
}
__device__ __forceinline__ u32 tk_f2key(float v, int slot) { const u32 u = __builtin_bit_cast(u32, v); const u32 k = u ^ ((u32)((int)u >> 31) | 0x80000000u); return (k & ~127u) | (u32)(127 - slot); }
__device__ __forceinline__ float tk_key2f(u32 k) { k &= ~127u; const u32 m = (u32)((int)k >> 31); return __builtin_bit_cast(float, k ^ (~m | 0x80000000u)); }
__device__ __forceinline__ u32 tk_sel8v(u32 r0, u32 r1, u32 r2, u32 r3, u32 r4, u32 r5, u32 r6, u32 r7, int idx) {
    const bool b0 = idx & 1, b1 = idx & 2, b2 = idx & 4;
    const u32 s01 = b0 ? r1 : r0, s23 = b0 ? r3 : r2, s45 = b0 ? r5 : r4, s67 = b0 ? r7 : r6;
    const u32 s03 = b1 ? s23 : s01, s47 = b1 ? s67 : s45;
    return b2 ? s47 : s03; }
#define tk_sel8(r, idx) tk_sel8v(r[0], r[1], r[2], r[3], r[4], r[5], r[6], r[7], idx)
__device__ __forceinline__ void phase_topk(const Ctx& C, const Args& a) {
    const float* S = (const float*)(a.ws + WS_S); int* EID = (int*)(a.ws + WS_EID); float* GW = (float*)(a.ws + WS_GW);
    const int lane = C.lane, r = lane & 15, q = lane >> 4; const bool even = (lane & 1) == 0;
    pg8::StaticOrder SO; SO.init(M, DQ, C.nblk, C.blk); pg8::Unit un;
    for (int ui = 0; SO.next(ui, un); ++ui)
    for (int wi = C.wave; wi < 64; wi += NWAVES) {
        const int tok = un.pm * 256 + wi * 4 + q, h = un.pn;
        u32 xa[8], xb[8];
        { const float* sp = S + (size_t)tok * DQ + h * 256 + 8 * r; const f32x4 v0 = *(const f32x4*)sp, v1 = *(const f32x4*)(sp + 4), w0 = *(const f32x4*)(sp + 128), w1 = *(const f32x4*)(sp + 132);
#pragma unroll
          for (int c = 0; c < 4; ++c) { xa[c] = tk_f2key(v0[c], 8 * r + c); xa[4 + c] = tk_f2key(v1[c], 8 * r + 4 + c); xb[c] = tk_f2key(w0[c], 8 * r + c); xb[4 + c] = tk_f2key(w1[c], 8 * r + 4 + c); } }
        tk_top16(xa, even); tk_top16(xb, even);
        u32 La[8], Ha[8], Lb[8], Hb[8];
#pragma unroll
        for (int c = 0; c < 8; ++c) { La[c] = dppu<DPP_DUPE>(xa[c]); Ha[c] = dppu<DPP_DUPO>(xa[c]); Lb[c] = dppu<DPP_DUPE>(xb[c]); Hb[c] = dppu<DPP_DUPO>(xb[c]); }
        const u32 a_lane = (r < 8) ? tk_sel8(La, r & 7) : tk_sel8(Ha, r & 7), b_lane = (r < 8) ? tk_sel8(Lb, r & 7) : tk_sel8(Hb, r & 7);
        const float va = tk_key2f(a_lane), vbl = tk_key2f(b_lane), va0 = tk_key2f(La[0]);
        u32 ck[8];
#pragma unroll
        for (int j = 0; j < 8; ++j) { constexpr int lim[8] = {15, 7, 4, 3, 2, 1, 1, 1};
            float v = va + tk_key2f(Lb[j]); bool valid = r <= lim[j];
            if (j == 1) { v = (r >= 8) ? va0 + vbl : v; valid = valid || (r >= 8); }
            ck[j] = valid ? tk_f2key(v, 8 * r + j) : 0u; }
        tk_top16(ck, even);
        const float mx = tk_key2f(dppu<DPP_DUPE>(ck[0]));
        float ex[8], sum = 0.f;
#pragma unroll
        for (int c = 0; c < 8; ++c) { ex[c] = __expf(tk_key2f(ck[c]) - mx); sum += ex[c]; }
        sum += __builtin_bit_cast(float, dppu<DPP_XOR1>(__builtin_bit_cast(u32, sum)));
        const float inv = 1.f / sum;
        int eo[8]; float go[8];
#pragma unroll
        for (int c = 0; c < 8; ++c) { const int slot = 127 - (int)(ck[c] & 127u), i = slot >> 3, j = slot & 7; const bool sp = (j == 1) && (i >= 8);
            const int i2 = sp ? 0 : i, j2 = sp ? i : j;
            const u32 ka = (u32)__builtin_amdgcn_ds_bpermute(((lane & ~15) + i2) << 2, (int)a_lane), kb = (u32)__builtin_amdgcn_ds_bpermute(((lane & ~15) + j2) << 2, (int)b_lane);
            eo[c] = (127 - (int)(ka & 127u)) * 128 + (127 - (int)(kb & 127u)); go[c] = ex[c] * inv; }
        if (r < 2) { int* ep = EID + (size_t)tok * 128 + h * 16 + r * 8; float* gp = GW + (size_t)tok * 128 + h * 16 + r * 8;
            *(u32x4*)ep = (u32x4){(u32)eo[0], (u32)eo[1], (u32)eo[2], (u32)eo[3]}; *(u32x4*)(ep + 4) = (u32x4){(u32)eo[4], (u32)eo[5], (u32)eo[6], (u32)eo[7]};
            *(f32x4*)gp = (f32x4){go[0], go[1], go[2], go[3]}; *(f32x4*)(gp + 4) = (f32x4){go[4], go[5], go[6], go[7]}; }
    }
}

__device__ __forceinline__ float dot2bf(unsigned w, unsigned x, float acc) { return __builtin_amdgcn_fdot2_f32_bf16(__builtin_bit_cast(bf16x2_t, w), __builtin_bit_cast(bf16x2_t, x), acc, false); }
constexpr int PNB = 8;
__device__ __forceinline__ void phase_peer_a(const Ctx& C, const Args& a, int l) {
    const int x = C.blk & 7, wg = (C.blk >> 3) * NWAVES + C.wave, nwg = ((C.nblk + 7 - x) >> 3) * NWAVES;
    const __amdgpu_buffer_rsrc_t UC = __builtin_amdgcn_make_buffer_rsrc(a.ws + WS_UB + ((size_t)l * 8 + x) * NEXP * 128, 0, NEXP * 128, 0x00020000);
    const int* EID = (const int*)(a.ws + WS_EID); const bf16* H = (const bf16*)(a.ws + WS_H); const float* HSC = (const float*)(a.ws + WS_HSC); float* PD = (float*)(a.ws + WS_PD);
    LAS float* dl = (LAS float*)(C.lds + C.wave * 1024);
    unsigned z_ = 0u; asm volatile("" : "+v"(z_));
    const int lane = (int)__builtin_amdgcn_mbcnt_hi(~0u, __builtin_amdgcn_mbcnt_lo(~0u, z_)), p = lane & 7, g = lane >> 3;
#define PA_META(t_, ev0_, ev1_, r0_, r1_, hs_) do { ev0_ = EID[(size_t)(t_) * 128 + lane]; ev1_ = EID[(size_t)(t_) * 128 + 64 + lane]; hs_ = HSC[t_]; \
        r0_ = *(const u32x4*)(H + (size_t)(t_) * D + 128 * x + 16 * p); r1_ = *(const u32x4*)(H + (size_t)(t_) * D + 128 * x + 16 * p + 8); } while (0)
#define PA_ISSUE(rows_, ev_) do { _Pragma("unroll") for (int j = 0; j < 8; ++j) { const int e = __builtin_amdgcn_ds_bpermute((8 * j + g) << 2, ev_); \
        rows_[j] = __builtin_bit_cast(u32x4, __builtin_amdgcn_raw_buffer_load_b128(UC, e * 128 + 16 * p, 0, 0)); } } while (0)
#define PA_HALF(rows_, off_) do { _Pragma("unroll") for (int j = 0; j < 8; ++j) { \
            int acc = __builtin_amdgcn_sdot4((int)rows_[j].x, (int)hq.x, 0, false); acc = __builtin_amdgcn_sdot4((int)rows_[j].y, (int)hq.y, acc, false); \
            acc = __builtin_amdgcn_sdot4((int)rows_[j].z, (int)hq.z, acc, false); acc = __builtin_amdgcn_sdot4((int)rows_[j].w, (int)hq.w, acc, false); \
            acc += __builtin_amdgcn_update_dpp(0, acc, 0xB1, 0xf, 0xf, true); acc += __builtin_amdgcn_update_dpp(0, acc, 0x4E, 0xf, 0xf, true); acc += __builtin_amdgcn_update_dpp(0, acc, 0x141, 0xf, 0xf, true);   \
            tot[(off_) + j] = (float)acc; } } while (0)
    int evA0, evA1, evB0, evB1; float hsA, hsB; u32x4 hA0, hA1, hB0, hB1, rows0[8], rows1[8];
#define PA_TOKEN(ev0_, ev1_, h0_, h1_, hs_, tcur_, tload_, evn0_) do { \
        u32x4 hq; { const float inv = hs_ > 0.f ? 1.f / hs_ : 0.f; f32x4 f[4]; unpack8(h0_, f[0], f[1]); unpack8(h1_, f[2], f[3]);   \
            _Pragma("unroll") for (int q = 0; q < 4; ++q) hq[q] = ((unsigned)(int)rintf(f[q].x * inv) & 255u) | (((unsigned)(int)rintf(f[q].y * inv) & 255u) << 8) | (((unsigned)(int)rintf(f[q].z * inv) & 255u) << 16) | ((unsigned)(int)rintf(f[q].w * inv) << 24); } \
        PA_ISSUE(rows1, ev1_);                        \
        PA_META(tload_, ev0_, ev1_, h0_, h1_, hs_);   \
        __builtin_amdgcn_sched_barrier(0);            \
        float tot[16]; \
        PA_HALF(rows0, 0); \
        __builtin_amdgcn_sched_barrier(0); \
        PA_ISSUE(rows0, evn0_);                       \
        __builtin_amdgcn_sched_barrier(0); \
        PA_HALF(rows1, 8); \
        __builtin_amdgcn_sched_barrier(0); \
        if (p == 0) { _Pragma("unroll") for (int j = 0; j < 16; ++j) dl[8 * j + g] = tot[j]; } \
        asm volatile("s_waitcnt lgkmcnt(0)" ::: "memory"); \
        const float d0 = dl[lane], d1 = dl[64 + lane]; \
        if ((tcur_) < M) { PD[((size_t)(tcur_) * 8 + x) * 128 + lane] = d0; PD[((size_t)(tcur_) * 8 + x) * 128 + 64 + lane] = d1; } \
        asm volatile("s_waitcnt lgkmcnt(0)" ::: "memory");   } while (0)
    int t = wg;
    { const int tc = t < M ? t : 0; PA_META(tc, evA0, evA1, hA0, hA1, hsA); }
    { const int tc = t + nwg < M ? t + nwg : 0; PA_META(tc, evB0, evB1, hB0, hB1, hsB); }
    PA_ISSUE(rows0, evA0);
#pragma nounroll
    for (; t < M; t += 2 * nwg) {
        const int t1 = t + nwg, t2 = t + 2 * nwg, t3 = t + 3 * nwg, c2 = t2 < M ? t2 : t, c3 = t3 < M ? t3 : t;
        PA_TOKEN(evA0, evA1, hA0, hA1, hsA, t, c2, evB0);
        PA_TOKEN(evB0, evB1, hB0, hB1, hsB, t1, c3, evA0);
    }
#undef PA_TOKEN
#undef PA_META
#undef PA_ISSUE
#undef PA_HALF
}
__device__ __forceinline__ void phase_peer_c(const Ctx& C, const Args& a, int l) {
    const float* USC = (const float*)(a.ws + WS_USC) + (size_t)l * NEXP; const float* VSC = (const float*)(a.ws + WS_VSC) + (size_t)l * NEXP;
    const int* EID = (const int*)(a.ws + WS_EID); const float* GW = (const float*)(a.ws + WS_GW); const float* HSC = (const float*)(a.ws + WS_HSC); const float* PD = (const float*)(a.ws + WS_PD);
    int* C8 = (int*)(a.ws + WS_COEF); float* CSC = (float*)(a.ws + WS_CSC);
    for (int t = C.gw; t < M; t += C.ngw) { float cf[2]; const float hs = HSC[t];
#pragma unroll
        for (int u = 0; u < 2; ++u) { const int k = 64 * u + C.lane, e = EID[(size_t)t * 128 + k]; float d = 0.f;
#pragma unroll
            for (int xx = 0; xx < 8; ++xx) d += PD[((size_t)t * 8 + xx) * 128 + k];
            const float dd = d * USC[e] * hs; cf[u] = VSC[e] * GW[(size_t)t * 128 + k] * 0.5f * dd * (1.f + erff(dd * 0.70710678118654752f)); }
        const float am = wave_max(fmaxf(fabsf(cf[0]), fabsf(cf[1]))), inv = am > 0.f ? 127.f / am : 0.f;
        const int q0 = (int)rintf(cf[0] * inv) & 255, q1 = (int)rintf(cf[1] * inv) & 255;
        { const int L = C.lane & 31, m = L >> 3, g = L & 7, src = 32 * (m & 1) + g; unsigned w = 0u;
#pragma unroll
          for (int i = 0; i < 4; ++i) { const int b0 = __builtin_amdgcn_ds_bpermute((src + 8 * i) << 2, q0), b1 = __builtin_amdgcn_ds_bpermute((src + 8 * i) << 2, q1); w |= (unsigned)((m >> 1) ? b1 : b0) << (8 * i); }
          if (C.lane < 32) C8[(size_t)t * 32 + L] = (int)w; }
        if (C.lane == 0) CSC[t] = am * (1.f / 127.f); }
}
__device__ __forceinline__ void phase_peer_b(const Ctx& C, const Args& a, int l) {
    const int x = C.blk & 7, wg = (C.blk >> 3) * NWAVES + C.wave, nwg = ((C.nblk + 7 - x) >> 3) * NWAVES;
    const __amdgpu_buffer_rsrc_t VC = __builtin_amdgcn_make_buffer_rsrc(a.ws + WS_VB + ((size_t)l * 8 + x) * NEXP * 128, 0, NEXP * 128, 0x00020000);
    const int* EID = (const int*)(a.ws + WS_EID); const int* C8 = (const int*)(a.ws + WS_COEF); const float* CSC = (const float*)(a.ws + WS_CSC); float* XW = a.out;
    LAS int* ol = (LAS int*)(C.lds + C.wave * 4096);
    unsigned z_ = 0u; asm volatile("" : "+v"(z_));
    const int lane = (int)__builtin_amdgcn_mbcnt_hi(~0u, __builtin_amdgcn_mbcnt_lo(~0u, z_)), p = lane & 7, g = lane >> 3;
#define PB_META(t_, ev0_, ev1_, cf0_, cf1_, cf2_, cf3_) do { ev0_ = EID[(size_t)(t_) * 128 + lane]; ev1_ = EID[(size_t)(t_) * 128 + 64 + lane]; cf0_ = C8[(size_t)(t_) * 32 + g]; cf1_ = C8[(size_t)(t_) * 32 + 8 + g]; cf2_ = C8[(size_t)(t_) * 32 + 16 + g]; cf3_ = C8[(size_t)(t_) * 32 + 24 + g]; } while (0)
#define PB_ISSUE(rows_, ev_) do { _Pragma("unroll") for (int j = 0; j < 8; ++j) { const int e = __builtin_amdgcn_ds_bpermute((8 * j + g) << 2, ev_); \
        rows_[j] = __builtin_bit_cast(u32x4, __builtin_amdgcn_raw_buffer_load_b128(VC, e * 128 + 16 * p, 0, 0)); } } while (0)
#define PB_GROUP(rows_, j0_, ck_) do { _Pragma("unroll") for (int q = 0; q < 4; ++q) { const unsigned a_ = rows_[(j0_)][q], b_ = rows_[(j0_) + 1][q], c_ = rows_[(j0_) + 2][q], d_ = rows_[(j0_) + 3][q]; \
            const unsigned ablo = __builtin_amdgcn_perm(b_, a_, 0x05010400u), abhi = __builtin_amdgcn_perm(b_, a_, 0x07030602u), cdlo = __builtin_amdgcn_perm(d_, c_, 0x05010400u), cdhi = __builtin_amdgcn_perm(d_, c_, 0x07030602u); \
            o[4 * q + 0] = __builtin_amdgcn_sdot4((int)__builtin_amdgcn_perm(cdlo, ablo, 0x05040100u), ck_, o[4 * q + 0], false); o[4 * q + 1] = __builtin_amdgcn_sdot4((int)__builtin_amdgcn_perm(cdlo, ablo, 0x07060302u), ck_, o[4 * q + 1], false); \
            o[4 * q + 2] = __builtin_amdgcn_sdot4((int)__builtin_amdgcn_perm(cdhi, abhi, 0x05040100u), ck_, o[4 * q + 2], false); o[4 * q + 3] = __builtin_amdgcn_sdot4((int)__builtin_amdgcn_perm(cdhi, abhi, 0x07060302u), ck_, o[4 * q + 3], false); } } while (0)
#define PB_HALF(rows_, ck0_, ck1_) do { PB_GROUP(rows_, 0, ck0_); PB_GROUP(rows_, 4, ck1_); } while (0)
    int evA0, evA1, evB0, evB1, cfA0, cfA1, cfA2, cfA3, cfB0, cfB1, cfB2, cfB3; u32x4 rows0[8], rows1[8];
    const f32x2 g2b0 = *(const f32x2*)(modp(a, l, 0, 5) + 128 * x + 2 * lane), g2b1 = *(const f32x2*)(modp(a, l, 1, 5) + 128 * x + 2 * lane);
    int t = wg;
    { const int tc = t < M ? t : 0; PB_META(tc, evA0, evA1, cfA0, cfA1, cfA2, cfA3); }
    { const int tc = t + nwg < M ? t + nwg : 0; PB_META(tc, evB0, evB1, cfB0, cfB1, cfB2, cfB3); }
    PB_ISSUE(rows0, evA0);
    f32x2 xvn; float csn; { const int tc = t < M ? t : 0; xvn = *(const f32x2*)(XW + (size_t)tc * D + 128 * x + 2 * lane); csn = CSC[tc]; }
#pragma nounroll
    for (; t < M; t += nwg) {
        const int t2 = t + 2 * nwg, c2 = t2 < M ? t2 : t;
        const int k0 = cfA0, k1 = cfA1, k2 = cfA2, k3 = cfA3;
        const f32x2 xv = xvn; const float cs = csn;
        PB_ISSUE(rows1, evA1);
        evA0 = evB0; evA1 = evB1; cfA0 = cfB0; cfA1 = cfB1; cfA2 = cfB2; cfA3 = cfB3;
        PB_META(c2, evB0, evB1, cfB0, cfB1, cfB2, cfB3);
        { const int c1 = t + nwg < M ? t + nwg : t; xvn = *(const f32x2*)(XW + (size_t)c1 * D + 128 * x + 2 * lane); csn = CSC[c1]; }
        __builtin_amdgcn_sched_barrier(0);
        int o[16];
#pragma unroll
        for (int i = 0; i < 16; ++i) o[i] = 0;
        PB_HALF(rows0, k0, k1);
        __builtin_amdgcn_sched_barrier(0);
        PB_ISSUE(rows0, evA0);
        __builtin_amdgcn_sched_barrier(0);
        PB_HALF(rows1, k2, k3);
        __builtin_amdgcn_sched_barrier(0);
#pragma unroll
        for (int q = 0; q < 4; ++q) *(LAS u32x4*)(ol + lane * 16 + 4 * q) = (u32x4){(unsigned)o[4 * q], (unsigned)o[4 * q + 1], (unsigned)o[4 * q + 2], (unsigned)o[4 * q + 3]};
        asm volatile("s_waitcnt lgkmcnt(0)" ::: "memory");
        int s0 = 0, s1 = 0;
#pragma unroll
        for (int gg = 0; gg < 8; ++gg) { const u32x2 v = *(const LAS u32x2*)(ol + (gg * 8 + (lane >> 3)) * 16 + 2 * (lane & 7)); s0 += (int)v.x; s1 += (int)v.y; }
        asm volatile("s_waitcnt lgkmcnt(0)" ::: "memory");
        const int c = 128 * x + 2 * lane; const f32x2 g2 = (t >> 13) ? g2b1 : g2b0;
        *(f32x2*)(XW + (size_t)t * D + c) = xv + g2 * (f32x2){(float)s0 * cs, (float)s1 * cs};
    }
#undef PB_META
#undef PB_ISSUE
#undef PB_HALF
}
__device__ __forceinline__ void phase_final(const Ctx& C, const Args& a) {
    for (int m = C.gw; m < M; m += C.ngw) { f32x4 x[4]; float ss = 0.f;
#pragma unroll
        for (int j = 0; j < 4; ++j) { x[j] = *(const f32x4*)(a.out + (size_t)m * D + 4 * C.lane + 256 * j); ss += (x[j].x * x[j].x + x[j].y * x[j].y) + (x[j].z * x[j].z + x[j].w * x[j].w); }
        const float rstd = 1.f / sqrtf(wave_sum(ss) * (1.f / D) + EPS);
#pragma unroll
        for (int j = 0; j < 4; ++j) *(f32x4*)(a.out + (size_t)m * D + 4 * C.lane + 256 * j) = x[j] * rstd * *(const f32x4*)(a.in[I_FG] + 4 * C.lane + 256 * j); }
}

#ifndef USE_NAIVE
#define GEMM mfma_gemm
#else
#define GEMM naive_gemm
#endif
#define RLX_AGENT __ATOMIC_RELAXED, __HIP_MEMORY_SCOPE_AGENT
#define XB_TMO      128
#define XB_XCNT(j)  (256  + 64 * (j))
#define XB_XSUB(j)  (1280 + 64 * (j))
#define XB_XGEN(j)  (2304 + 64 * (j))
#define XB_TOP      3328
#define XB_TOPGEN   3392
#define XCD_BAR_WORDS 3456
#define XB_SPIN_CAP (1u << 18)

__device__ __forceinline__ unsigned xb_ld(unsigned* p)              { return __hip_atomic_load(p, __ATOMIC_RELAXED, __HIP_MEMORY_SCOPE_AGENT); }
__device__ __forceinline__ unsigned xb_add(unsigned* p, unsigned v) { return __hip_atomic_fetch_add(p, v, __ATOMIC_RELAXED, __HIP_MEMORY_SCOPE_AGENT); }
__device__ __forceinline__ unsigned xb_xcc_id() { return (unsigned)__builtin_amdgcn_s_getreg((3 << 11) | 20) & 0xFu; }
#define XB_SPIN(cond, bar) do { unsigned _sp = 0; while (cond) { __builtin_amdgcn_s_sleep(1); \
    if ((++_sp & 255u) == 0u) { if (xb_ld(&(bar)[XB_TMO])) break; if (_sp > XB_SPIN_CAP) { atomicAdd(&(bar)[XB_TMO], 1u); break; } } } } while (0)

struct XcdBarrier {
    unsigned* bar; unsigned x;
    volatile LAS unsigned* st;
};

__device__ __forceinline__ XcdBarrier xcd_barrier_post(unsigned* bar, volatile LAS unsigned* st) {
    XcdBarrier b; b.bar = bar; b.x = xb_xcc_id(); b.st = st;
    if (threadIdx.x == 0) (void)xb_add(&bar[XB_XCNT(b.x)], 1u);
    return b;
}
__device__ __forceinline__ void xcd_barrier_complete(unsigned* bar, unsigned x, unsigned& nloc, unsigned& nx) {
    const unsigned G = gridDim.x * gridDim.y * gridDim.z;
    unsigned sum, cnt, mine, sp = 0u;
    for (;;) {
        sum = 0u; cnt = 0u; mine = 0u;
#pragma unroll
        for (unsigned j = 0; j < 16; ++j) { const unsigned c = xb_ld(&bar[XB_XCNT(j)]); sum += c; cnt += (c > 0u) ? 1u : 0u; mine = (j == x) ? c : mine; }
        if (sum == G) break;
        __builtin_amdgcn_s_sleep(1);
        if ((++sp & 255u) == 0u) { if (xb_ld(&bar[XB_TMO])) break; if (sp > XB_SPIN_CAP) { atomicAdd(&bar[XB_TMO], 1u); break; } }
    }
    nloc = mine > 0u ? mine : 1u; nx = cnt > 0u ? cnt : 1u;
}

__device__ __forceinline__ void xcd_barrier(const XcdBarrier& b, const int tid_) {
    asm volatile("s_waitcnt vmcnt(0)" ::: "memory");
    __syncthreads();
    if (tid_ == 0) {
        unsigned* bar = b.bar;
        __builtin_amdgcn_s_waitcnt(0);
        unsigned nloc = b.st[0], nx = b.st[1];
        if (nloc == 0u) { xcd_barrier_complete(bar, b.x, nloc, nx); b.st[0] = nloc; b.st[1] = nx; }
        const unsigned old = xb_add(&bar[XB_XSUB(b.x)], 1u);
        const unsigned gen = old / nloc;
        if (old + 1u == (gen + 1u) * nloc) {
            __builtin_amdgcn_fence(__ATOMIC_RELEASE, "agent");
            asm volatile("s_waitcnt vmcnt(0)" ::: "memory");
            const unsigned og = xb_add(&bar[XB_TOP], 1u);
            const unsigned tg = og / nx;
            if (og + 1u == (tg + 1u) * nx) xb_add(&bar[XB_TOPGEN], 1u);
            else XB_SPIN(xb_ld(&bar[XB_TOPGEN]) == tg, bar);
            __builtin_amdgcn_fence(__ATOMIC_ACQUIRE, "agent");
            xb_add(&bar[XB_XGEN(b.x)], 1u);
            asm volatile("s_waitcnt vmcnt(0)" ::: "memory");
        } else {
            XB_SPIN(xb_ld(&bar[XB_XGEN(b.x)]) == gen, bar);
            __builtin_amdgcn_fence(__ATOMIC_ACQUIRE, "agent");
            asm volatile("s_waitcnt vmcnt(0)" ::: "memory");
        }
    }
    __syncthreads();
}

constexpr int CW_BAR = 4096;
constexpr size_t CTL_ZERO_BYTES = 65536;
constexpr int LDSCTL_OFF = 131072, MISC_OFF = LDSCTL_OFF + 320;
constexpr int PH_PREP = 0, PH_MODR = 1, PH_N1 = 2, PH_L0 = 3, PH_PER_LAYER = 10, N_PHASES = PH_L0 + DEPTH * PH_PER_LAYER;
__device__ __forceinline__ Ctx make_ctx(LAS unsigned char* lds, int wave_s) {
    unsigned z_ = 0u; asm volatile("" : "+v"(z_));
    int tid_ = (wave_s << 6) | (int)__builtin_amdgcn_mbcnt_hi(~0u, __builtin_amdgcn_mbcnt_lo(~0u, z_)); asm volatile("" : "+v"(tid_));
    Ctx C; C.tid = tid_; C.lane = C.tid & 63; C.wave = __builtin_amdgcn_readfirstlane(C.tid >> 6); C.nblk = gridDim.x; C.blk = blockIdx.x;
    C.gw = C.blk * NWAVES + C.wave; C.ngw = C.nblk * NWAVES; C.lds = lds; return C;
}
#ifndef ONLYPH
#define ONLYPH -1
#endif
constexpr unsigned long long REP_MASK = 0ull;
#define PH(k, ...) if ((ONLYPH < 0 || ONLYPH == (k)) && a.ph_lo <= (k) && (k) < a.ph_hi) { for (int r_ = 0; r_ < 1 + (int)((REP_MASK >> (k)) & 1ull); ++r_) { const Ctx C = make_ctx(lds, wave_s); __VA_ARGS__; } if ((k) + 1 < a.ph_hi) xcd_barrier(bar, make_ctx(lds, wave_s).tid); }
template <int l>
__device__ __forceinline__ void run_layer(const Args& a, LAS unsigned char* lds, const XcdBarrier& bar, const int wave_s) {
    unsigned char* ws = a.ws; constexpr int B0 = PH_L0 + l * PH_PER_LAYER;
    PH(B0 + 0, EpiIn E{a.in[I_BIN] + (size_t)l * DIN, (bf16*)(ws + WS_UG), (bf16*)(ws + WS_ZP), (bf16*)(ws + WS_G)};
               GEMM(C, (const bf16*)(ws + WS_H), D, 0, (const bf16*)(ws + WS_WIN) + (size_t)l * DIN * D, D, M, DIN, D, E))
    PH(B0 + 1, phase_convpool(C, a, l))
    PH(B0 + 2, { EpiPool E{(const bf16*)(ws + WS_G), a.in[I_POOLS] + (size_t)l * D, (bf16*)(ws + WS_TMP)};
                 GEMM(C, (const bf16*)(ws + WS_PL), D, 256, (const bf16*)(ws + WS_POOL) + (size_t)l * 1024 * 256, 256, M, D, 256, E); }
               { const Ctx C2 = make_ctx(lds, wave_s); EpiConv E{(const bf16*)(ws + WS_G), (const bf16*)(ws + WS_TMP), (bf16*)(ws + WS_Y)};
                 GEMM(C2, (const bf16*)(ws + WS_AC), D, 0, (const bf16*)(ws + WS_WCO) + (size_t)l * D * D, D, M, D, D, E); })
    PH(B0 + 3, EpiOut E{l == 0 ? a.in[I_X] : a.out, a.out, modp(a, l, 0, 2), a.in[I_BOUT] + (size_t)l * D};
               GEMM(C, (const bf16*)(ws + WS_Y), D, 0, (const bf16*)(ws + WS_WOUT) + (size_t)l * D * D, D, M, D, D, E))
    PH(B0 + 4, phase_norm(C, a, a.out, a.in[I_N2G] + (size_t)l * D, l, 3, 4, (float*)(ws + WS_HSC)))
    PH(B0 + 5, { EpiS E{(float*)(ws + WS_S)}; GEMM(C, (const bf16*)(ws + WS_H), D, 0, (const bf16*)(ws + WS_WQ) + (size_t)l * DQ * D, D, M, DQ, D, E); }
               asm volatile("s_waitcnt vmcnt(0)" ::: "memory"); __syncthreads();
               { const Ctx C3 = make_ctx(lds, wave_s); phase_topk(C3, a); })
    PH(B0 + 6, phase_peer_a(C, a, l))
    PH(B0 + 7, phase_peer_c(C, a, l))
    PH(B0 + 8, phase_peer_b(C, a, l))
    PH(B0 + 9, if (l + 1 < DEPTH) phase_norm(C, a, a.out, a.in[I_N1G] + (size_t)(l + 1) * D, l + 1, 0, 1, nullptr); else phase_final(C, a))
}
__global__ void __launch_bounds__(NTHREADS, 2) fwd_kernel(Args a) {
    extern __shared__ __attribute__((aligned(16))) unsigned char lds_raw[];
    LAS unsigned char* lds = (LAS unsigned char*)lds_raw;
    for (int u = threadIdx.x; u < (LDS_BYTES - LDSCTL_OFF) / 4; u += NTHREADS) ((LAS unsigned*)(lds + LDSCTL_OFF))[u] = 0u;
    __syncthreads();
    const int wave_s = __builtin_amdgcn_readfirstlane((int)threadIdx.x >> 6);
    const XcdBarrier bar = xcd_barrier_post((unsigned*)(a.ws + WS_CTL) + CW_BAR, (volatile LAS unsigned*)(lds + MISC_OFF) + 8);
    PH(PH_PREP, phase_prep(C, a))
    PH(PH_MODR, phase_modreduce(C, a))
    PH(PH_N1, phase_norm(C, a, a.in[I_X], a.in[I_N1G], 0, 0, 1, nullptr);
              for (int lf = 0; lf < DEPTH; ++lf) { const Ctx C2 = make_ctx(lds, wave_s); EpiWT E{(bf16*)(a.ws + WS_WQ) + (size_t)lf * DQ * D};
                  GEMM(C2, (const bf16*)(a.ws + WS_KEYS) + (size_t)lf * 2048 * 256, 256, 0, (const bf16*)(a.ws + WS_WQB) + (size_t)lf * D * DQ, DQ, DQ, D, 256, E, 256); })
    run_layer<0>(a, lds, bar, wave_s);
    run_layer<1>(a, lds, bar, wave_s);
}

extern "C" void kernel_launch(void* const* d_in, const int* in_sizes, int n_in, void* d_out, int out_size, void* d_ws, size_t ws_size, hipStream_t stream) {
    static int grid = 0;
    if (grid == 0) {
        if (n_in != 22 || out_size != M * D || ws_size < WS_END) { fprintf(stderr, "kernel_launch: unexpected shapes (n_in %d out %d ws %zu)\n", n_in, out_size, ws_size); grid = -1; return; }
        int dev = 0, cus = 0;
        if (hipGetDevice(&dev) != hipSuccess || hipDeviceGetAttribute(&cus, hipDeviceAttributeMultiprocessorCount, dev) != hipSuccess) { grid = -1; return; }
        if (hipFuncSetAttribute((const void*)fwd_kernel, hipFuncAttributeMaxDynamicSharedMemorySize, LDS_BYTES) != hipSuccess) { grid = -1; return; }
        grid = cus;
    }
    if (grid < 0) return;
    Args a{};
    for (int i = 0; i < 22; ++i) a.in[i] = (const float*)d_in[i];
    a.out = (float*)d_out; a.ws = (unsigned char*)d_ws;
    (void)hipMemsetAsync((char*)d_ws + WS_CTL, 0, CTL_ZERO_BYTES, stream);
#ifndef ONE_LAUNCH
    for (int ph = 0; ph < N_PHASES; ++ph) { a.ph_lo = ph; a.ph_hi = ph + 1; hipLaunchKernelGGL(fwd_kernel, dim3(grid), dim3(NTHREADS), LDS_BYTES, stream, a); }
#else
    a.ph_lo = 0; a.ph_hi = N_PHASES; hipLaunchKernelGGL(fwd_kernel, dim3(grid), dim3(NTHREADS), LDS_BYTES, stream, a);
#endif
}
```

```cpp
#define ONE_LAUNCH 1
#include <hip/hip_runtime.h>
#include <cstdint>
#include <cstdio>
#include <utility>

#define GAS __attribute__((address_space(1)))
#define LAS __attribute__((address_space(3)))
typedef unsigned short bf16;
typedef float f32x4 __attribute__((ext_vector_type(4)));
typedef float f32x2 __attribute__((ext_vector_type(2)));
typedef unsigned u32x4 __attribute__((ext_vector_type(4)));
typedef unsigned u32x2 __attribute__((ext_vector_type(2)));
typedef __bf16 bf16x2_t __attribute__((ext_vector_type(2)));

constexpr int BATCH = 2, SEQ = 8192, D = 1024, M = BATCH * SEQ, DEPTH = 2;
constexpr int DIN = 5120, NMODV = 6 * D, CONVK = 31, NHEAD = 8, NKEYS = 128, DQ = 2048, TOPK = 16, NEXP = 16384;
constexpr float EPS = 1e-6f;
constexpr int NWAVES = 8, NTHREADS = NWAVES * 64;

constexpr size_t MiB = 1u << 20;
constexpr size_t WS_CTL = 0;
constexpr size_t WS_MODP = 1 * MiB;
constexpr size_t WS_MOD = 4 * MiB;
constexpr size_t WS_WIN = 8 * MiB;
constexpr size_t WS_WCO = 28 * MiB;
constexpr size_t WS_WOUT = 32 * MiB;
constexpr size_t WS_WQ = 36 * MiB;
constexpr size_t WS_POOL = 44 * MiB;
constexpr size_t WS_KEYS = 45 * MiB;
constexpr size_t WS_UB = 48 * MiB;
constexpr size_t WS_USC = 80 * MiB;
constexpr size_t WS_VSC = 81 * MiB;
constexpr size_t WS_VB = 112 * MiB;
constexpr size_t WS_H = 176 * MiB;
constexpr size_t WS_UG = 208 * MiB;
constexpr size_t WS_Y = WS_UG;
constexpr size_t WS_ZP = 240 * MiB;
constexpr size_t WS_TMP = WS_ZP;
constexpr size_t WS_Q = WS_UG;
constexpr size_t WS_G = 272 * MiB;
constexpr size_t WS_AC = 336 * MiB;
constexpr size_t WS_PL = 368 * MiB;
constexpr size_t WS_S = WS_G;
constexpr size_t WS_EID = 400 * MiB;
constexpr size_t WS_GW = 408 * MiB;
constexpr size_t WS_COEF = 416 * MiB;
constexpr size_t WS_CSC = 424 * MiB + 65536;
constexpr size_t WS_HSC = 424 * MiB;
constexpr size_t WS_PD = WS_S;
constexpr size_t WS_WQB = 426 * MiB;
constexpr size_t WS_END = 434 * MiB;

constexpr int LDS_BYTES = 147456;

__device__ __forceinline__ unsigned f2bf(float f) { unsigned u = __builtin_bit_cast(unsigned, f); return (u + 0x7fffu + ((u >> 16) & 1u)) >> 16; }
__device__ __forceinline__ unsigned pk2(float lo, float hi) { return f2bf(lo) | (f2bf(hi) << 16); }
__device__ __forceinline__ float bflo(unsigned w) { return __builtin_bit_cast(float, w << 16); }
__device__ __forceinline__ float bfhi(unsigned w) { return __builtin_bit_cast(float, w & 0xffff0000u); }
__device__ __forceinline__ float sigm(float x) { return __builtin_amdgcn_rcpf(1.f + __expf(-x)); }
__device__ __forceinline__ float wave_sum(float v) {
#pragma unroll
    for (int o = 1; o < 64; o <<= 1) v += __shfl_xor(v, o);
    return v;
}
__device__ __forceinline__ float wave_max(float v) {
#pragma unroll
    for (int o = 1; o < 64; o <<= 1) v = fmaxf(v, __shfl_xor(v, o));
    return v;
}
__device__ __forceinline__ float dpp_sum63(float v) {
#define DPPF(x, ctrl, rm, bc) __builtin_bit_cast(float, __builtin_amdgcn_update_dpp(0, __builtin_bit_cast(int, x), ctrl, rm, 0xf, bc))
    v += DPPF(v, 0x111, 0xf, true); v += DPPF(v, 0x112, 0xf, true); v += DPPF(v, 0x114, 0xf, true); v += DPPF(v, 0x118, 0xf, true);
    v += DPPF(v, 0x142, 0xa, false); v += DPPF(v, 0x143, 0xc, false);
#undef DPPF
    return v;
}
__device__ __forceinline__ u32x4 pack8(const f32x4& a, const f32x4& b) { u32x4 w; w.x = pk2(a.x, a.y); w.y = pk2(a.z, a.w); w.z = pk2(b.x, b.y); w.w = pk2(b.z, b.w); return w; }
__device__ __forceinline__ void unpack8(const u32x4& w, f32x4& a, f32x4& b) { a = (f32x4){bflo(w.x), bfhi(w.x), bflo(w.y), bfhi(w.y)}; b = (f32x4){bflo(w.z), bfhi(w.z), bflo(w.w), bfhi(w.w)}; }

struct Ctx { int tid, lane, wave, gw, ngw, nblk, blk; LAS unsigned char* lds; };

struct Args { const float* in[22]; float* out; unsigned char* ws; int ph_lo, ph_hi; };
enum { I_X = 0, I_C, I_ADAW, I_ADAB, I_N1G, I_WIN, I_BIN, I_CONVW, I_CONVB, I_LNG, I_LNB, I_WCO, I_POOLW, I_POOLS, I_WOUT, I_BOUT, I_N2G, I_WQ, I_KEYS, I_PU, I_PV, I_FG };

__device__ __forceinline__ void transpose_item(const float* W, int K, int N, int k0, int n0, bf16* WT, int dstrow0, LAS float* scr, int lane) {
#pragma unroll 8
    for (int i = 0; i < 32; ++i) { const int kk = 2 * i + (lane >> 5); scr[kk * 33 + (lane & 31)] = W[(size_t)(k0 + kk) * N + n0 + (lane & 31)]; }
    asm volatile("s_waitcnt lgkmcnt(0)" ::: "memory");
    const int c = lane & 7;
#pragma unroll
    for (int j = 0; j < 4; ++j) { const int n = (lane >> 3) + 8 * j; const LAS float* s = scr + (8 * c) * 33 + n;
        u32x4 o; o.x = pk2(s[0 * 33], s[1 * 33]); o.y = pk2(s[2 * 33], s[3 * 33]); o.z = pk2(s[4 * 33], s[5 * 33]); o.w = pk2(s[6 * 33], s[7 * 33]);
        *(u32x4*)(WT + (size_t)(dstrow0 + n) * K + k0 + 8 * c) = o; }
    asm volatile("s_waitcnt lgkmcnt(0)" ::: "memory");
}
__device__ __forceinline__ int win_dstrow(int n0) {
    if (n0 < 1024) return 256 * (n0 >> 7) + (n0 & 127);
    if (n0 < 2048) { const int c = n0 - 1024; return 256 * (c >> 7) + 128 + (c & 127); }
    return n0;
}
__device__ __forceinline__ void phase_prep(const Ctx& C, const Args& a) {
    unsigned char* ws = a.ws;
    LAS float* scr = (LAS float*)(C.lds + C.wave * 16384);
    constexpr int I_IN = 16 * 160, I_CO = 16 * 32, I_PO = 4 * (4 * 8), I_OUT = 16 * 32, I_L = I_IN + I_CO + I_PO + I_OUT;
    for (int it = C.gw; it < DEPTH * I_L; it += C.ngw) {
        const int l = it / I_L; int r = it % I_L;
        if (r < I_IN) { const int kb = r / 160, nb = r % 160; transpose_item(a.in[I_WIN] + (size_t)l * D * DIN, D, DIN, 64 * kb, 32 * nb, (bf16*)(ws + WS_WIN) + (size_t)l * DIN * D, win_dstrow(32 * nb), scr, C.lane); continue; } r -= I_IN;
        if (r < I_CO) { const int kb = r / 32, nb = r % 32; transpose_item(a.in[I_WCO] + (size_t)l * D * D, D, D, 64 * kb, 32 * nb, (bf16*)(ws + WS_WCO) + (size_t)l * D * D, 32 * nb, scr, C.lane); continue; } r -= I_CO;
        if (r < I_PO) { const int g = r / 32, q = r % 32, kb = q / 8, nb = q % 8; transpose_item(a.in[I_POOLW] + ((size_t)l * 4 + g) * 256 * 256, 256, 256, 64 * kb, 32 * nb, (bf16*)(ws + WS_POOL) + ((size_t)l * 1024 + 256 * g) * 256, 32 * nb, scr, C.lane); continue; } r -= I_PO;
        { const int kb = r / 32, nb = r % 32; transpose_item(a.in[I_WOUT] + (size_t)l * D * D, D, D, 64 * kb, 32 * nb, (bf16*)(ws + WS_WOUT) + (size_t)l * D * D, 32 * nb, scr, C.lane); }
    }
    const int gt = C.blk * NTHREADS + C.tid, ngt = C.nblk * NTHREADS;
    for (size_t i = gt; i < (size_t)DEPTH * D * DQ / 8; i += ngt) { const f32x4 v0 = *(const f32x4*)(a.in[I_WQ] + i * 8), v1 = *(const f32x4*)(a.in[I_WQ] + i * 8 + 4); *(u32x4*)((bf16*)(ws + WS_WQB) + i * 8) = pack8(v0, v1); }
    for (int i = gt; i < DEPTH * 2048 * 32; i += ngt) {
        const int l = i / (2048 * 32), r = i % (2048 * 32), n = r / 32, k8 = (r % 32) * 8;
        const int h = n >> 8, p = (n >> 7) & 1, key = n & 127, pk = k8 >> 7, kk = k8 & 127;
        u32x4 o = (u32x4){0u, 0u, 0u, 0u};
        if (pk == p) { const float* s = a.in[I_KEYS] + ((((size_t)l * 8 + h) * 2 + p) * 128 + key) * 128 + kk; const f32x4 v0 = *(const f32x4*)s, v1 = *(const f32x4*)(s + 4); o = pack8(v0, v1); }
        *(u32x4*)((bf16*)(ws + WS_KEYS) + ((size_t)l * 2048 + n) * 256 + k8) = o;
    }
    for (int t = 0; t < 2; ++t) {
        const float* src = a.in[t == 0 ? I_PU : I_PV]; unsigned char* dst = ws + (t == 0 ? WS_UB : WS_VB); float* scl = (float*)(ws + (t == 0 ? WS_USC : WS_VSC));
        for (int row0 = 4 * C.gw; row0 < DEPTH * NEXP; row0 += 4 * C.ngw) {
            f32x4 v[4][4]; float am[4];
#pragma unroll
            for (int r = 0; r < 4; ++r)
#pragma unroll
                for (int q = 0; q < 4; ++q) v[r][q] = *(const f32x4*)(src + (size_t)(row0 + r) * D + 16 * C.lane + 4 * q);
#pragma unroll
            for (int r = 0; r < 4; ++r) { float m = 0.f;
#pragma unroll
                for (int q = 0; q < 4; ++q) m = fmaxf(m, fmaxf(fmaxf(fabsf(v[r][q].x), fabsf(v[r][q].y)), fmaxf(fabsf(v[r][q].z), fabsf(v[r][q].w))));
                am[r] = wave_max(m); }
#pragma unroll
            for (int r = 0; r < 4; ++r) { const float inv = am[r] > 0.f ? 127.f / am[r] : 0.f; u32x4 w; const int row = row0 + r;
#pragma unroll
                for (int q = 0; q < 4; ++q) w[q] = ((unsigned)(int)rintf(v[r][q].x * inv) & 255u) | (((unsigned)(int)rintf(v[r][q].y * inv) & 255u) << 8) | (((unsigned)(int)rintf(v[r][q].z * inv) & 255u) << 16) | ((unsigned)(int)rintf(v[r][q].w * inv) << 24);
                { const int lyr = row / NEXP, e = row % NEXP; *(u32x4*)(dst + (((size_t)lyr * 8 + (C.lane >> 3)) * NEXP + e) * 128 + 16 * (C.lane & 7)) = w; }
                if (C.lane == 0) scl[row] = am[r] * (1.f / 127.f); }
        }
    }
    for (int it = gt; it < 32 * 3072; it += ngt) {
        const int ks = it / 3072, cg = it % 3072, l = cg / 1536, n4 = (cg % 1536) * 4;
        f32x4 a0 = (f32x4){0.f, 0.f, 0.f, 0.f}, a1 = a0;
        const float* wp = a.in[I_ADAW] + ((size_t)l * D + ks * 32) * NMODV + n4; const float* c0 = a.in[I_C] + ks * 32; const float* c1 = c0 + D;
#pragma unroll 8
        for (int kk = 0; kk < 32; ++kk) { const f32x4 w = *(const f32x4*)(wp + (size_t)kk * NMODV); const float x0 = c0[kk], x1 = c1[kk]; a0 += w * (x0 * sigm(x0)); a1 += w * (x1 * sigm(x1)); }
        float* mp = (float*)(ws + WS_MODP) + (((size_t)ks * 2 + l) * 2) * NMODV + n4;
        *(f32x4*)mp = a0; *(f32x4*)(mp + NMODV) = a1;
    }
}
__device__ __forceinline__ void phase_modreduce(const Ctx& C, const Args& a) {
    const int gt = C.blk * NTHREADS + C.tid, ngt = C.nblk * NTHREADS;
    for (int i = gt; i < 2 * 2 * NMODV; i += ngt) {
        const int l = i / (2 * NMODV), n = i % NMODV; float s = a.in[I_ADAB][(size_t)l * NMODV + n];
        const float* mp = (const float*)(a.ws + WS_MODP) + i;
        for (int ks = 0; ks < 32; ++ks) s += mp[(size_t)ks * 4 * NMODV];
        ((float*)(a.ws + WS_MOD))[i] = s;
    }
}
__device__ __forceinline__ const float* modp(const Args& a, int l, int b, int v) { return (const float*)(a.ws + WS_MOD) + ((size_t)l * 2 + b) * NMODV + v * D; }

__device__ __forceinline__ void normmod_row(const f32x4 (&x)[4], const float* g, const float* sh, const float* sc, int lane, f32x4 (&h)[4]) {
    float s = 0.f;
#pragma unroll
    for (int j = 0; j < 4; ++j) s += (x[j].x * x[j].x + x[j].y * x[j].y) + (x[j].z * x[j].z + x[j].w * x[j].w);
    const float rstd = 1.f / sqrtf(wave_sum(s) * (1.f / D) + EPS);
#pragma unroll
    for (int j = 0; j < 4; ++j) { const int c = 4 * lane + 256 * j; const f32x4 gv = *(const f32x4*)(g + c), shv = *(const f32x4*)(sh + c), scv = *(const f32x4*)(sc + c);
        h[j] = (x[j] * rstd) * gv * (scv + 1.f) + shv; }
}
__device__ __forceinline__ void store_row_bf16(bf16* row, const f32x4 (&h)[4], int lane) {
#pragma unroll
    for (int j = 0; j < 4; ++j) { u32x2 w; w.x = pk2(h[j].x, h[j].y); w.y = pk2(h[j].z, h[j].w); *(u32x2*)(row + 4 * lane + 256 * j) = w; }
}
__device__ __forceinline__ void phase_norm(const Ctx& C, const Args& a, const float* X, const float* g, int l, int vsh, int vsc, float* hsc) {
    bf16* H = (bf16*)(a.ws + WS_H);
    for (int m = C.gw; m < M; m += C.ngw) {
        const int b = m >> 13; f32x4 x[4], h[4];
#pragma unroll
        for (int j = 0; j < 4; ++j) x[j] = *(const f32x4*)(X + (size_t)m * D + 4 * C.lane + 256 * j);
        normmod_row(x, g, modp(a, l, b, vsh), modp(a, l, b, vsc), C.lane, h);
        store_row_bf16(H + (size_t)m * D, h, C.lane);
        if (hsc) { float am = 0.f;
#pragma unroll
            for (int j = 0; j < 4; ++j) { const unsigned w0 = pk2(h[j].x, h[j].y), w1 = pk2(h[j].z, h[j].w); am = fmaxf(am, fmaxf(fmaxf(fabsf(bflo(w0)), fabsf(bfhi(w0))), fmaxf(fabsf(bflo(w1)), fabsf(bfhi(w1))))); }
            am = wave_max(am); if (C.lane == 0) hsc[m] = am * (1.f / 127.f); }
    }
}

struct EpiIn {
    const float* bin; bf16 *UG, *ZP, *G;
    __device__ __forceinline__ void apply(int row, int pn, int cl8, f32x4 a0, f32x4 a1, f32x4 b0, f32x4 b1) const {
        if (pn < 8) {
            const int c = 128 * pn + cl8;
            a0 += *(const f32x4*)(bin + c); a1 += *(const f32x4*)(bin + c + 4); b0 += *(const f32x4*)(bin + 1024 + c); b1 += *(const f32x4*)(bin + 1024 + c + 4);
            f32x4 u0, u1;
#pragma unroll
            for (int i = 0; i < 4; ++i) { u0[i] = a0[i] * sigm(b0[i]); u1[i] = a1[i] * sigm(b1[i]); }
            *(u32x4*)(UG + (size_t)row * D + c) = pack8(u0, u1);
        } else if (pn < 12) {
            const int c = 256 * (pn - 8) + cl8;
            a0 += *(const f32x4*)(bin + 2048 + c); a1 += *(const f32x4*)(bin + 2048 + c + 4); b0 += *(const f32x4*)(bin + 2048 + 128 + c); b1 += *(const f32x4*)(bin + 2048 + 128 + c + 4);
            *(u32x4*)(ZP + (size_t)row * D + c) = pack8(a0, a1); *(u32x4*)(ZP + (size_t)row * D + c + 128) = pack8(b0, b1);
        } else {
            const int c = 256 * (pn - 12) + cl8;
            a0 += *(const f32x4*)(bin + 3072 + c); a1 += *(const f32x4*)(bin + 3072 + c + 4); b0 += *(const f32x4*)(bin + 3072 + 128 + c); b1 += *(const f32x4*)(bin + 3072 + 128 + c + 4);
#pragma unroll
            for (int i = 0; i < 4; ++i) { a0[i] = sigm(a0[i]); a1[i] = sigm(a1[i]); b0[i] = sigm(b0[i]); b1[i] = sigm(b1[i]); }
            *(u32x4*)(G + (size_t)row * 2048 + c) = pack8(a0, a1); *(u32x4*)(G + (size_t)row * 2048 + c + 128) = pack8(b0, b1);
        }
    }
};
struct EpiPool {
    const bf16* G; const float* scale; bf16* TMP;
    __device__ __forceinline__ void apply(int row, int pn, int cl8, f32x4 a0, f32x4 a1, f32x4 b0, f32x4 b1) const {
        const int c = 256 * pn + cl8; f32x4 g0, g1;
        unpack8(*(const u32x4*)(G + (size_t)row * 2048 + 1024 + c), g0, g1);
        a0 = a0 * g0 * *(const f32x4*)(scale + c); a1 = a1 * g1 * *(const f32x4*)(scale + c + 4);
        *(u32x4*)(TMP + (size_t)row * D + c) = pack8(a0, a1);
        unpack8(*(const u32x4*)(G + (size_t)row * 2048 + 1024 + c + 128), g0, g1);
        b0 = b0 * g0 * *(const f32x4*)(scale + c + 128); b1 = b1 * g1 * *(const f32x4*)(scale + c + 132);
        *(u32x4*)(TMP + (size_t)row * D + c + 128) = pack8(b0, b1);
    }
};
struct EpiConv {
    const bf16* G; const bf16* TMP; bf16* Y;
    __device__ __forceinline__ void apply(int row, int pn, int cl8, f32x4 a0, f32x4 a1, f32x4 b0, f32x4 b1) const {
        const int c = 256 * pn + cl8; f32x4 g0, g1, t0, t1;
        unpack8(*(const u32x4*)(G + (size_t)row * 2048 + c), g0, g1); unpack8(*(const u32x4*)(TMP + (size_t)row * D + c), t0, t1);
        *(u32x4*)(Y + (size_t)row * D + c) = pack8(a0 * g0 + t0, a1 * g1 + t1);
        unpack8(*(const u32x4*)(G + (size_t)row * 2048 + c + 128), g0, g1); unpack8(*(const u32x4*)(TMP + (size_t)row * D + c + 128), t0, t1);
        *(u32x4*)(Y + (size_t)row * D + c + 128) = pack8(b0 * g0 + t0, b1 * g1 + t1);
    }
};
struct EpiOut {
    const float* xold; float* xnew; const float* g1;   const float* bout;
    __device__ __forceinline__ void apply(int row, int pn, int cl8, f32x4 a0, f32x4 a1, f32x4 b0, f32x4 b1) const {
        const int c = 256 * pn + cl8; const float* g = g1 + (size_t)(row >> 13) * NMODV; const size_t o = (size_t)row * D + c;
        *(f32x4*)(xnew + o) = *(const f32x4*)(xold + o) + *(const f32x4*)(g + c) * (a0 + *(const f32x4*)(bout + c));
        *(f32x4*)(xnew + o + 4) = *(const f32x4*)(xold + o + 4) + *(const f32x4*)(g + c + 4) * (a1 + *(const f32x4*)(bout + c + 4));
        *(f32x4*)(xnew + o + 128) = *(const f32x4*)(xold + o + 128) + *(const f32x4*)(g + c + 128) * (b0 + *(const f32x4*)(bout + c + 128));
        *(f32x4*)(xnew + o + 132) = *(const f32x4*)(xold + o + 132) + *(const f32x4*)(g + c + 132) * (b1 + *(const f32x4*)(bout + c + 132));
    }
};
struct EpiQ {
    bf16* Q;
    __device__ __forceinline__ void apply(int row, int pn, int cl8, f32x4 a0, f32x4 a1, f32x4 b0, f32x4 b1) const {
        const size_t o = (size_t)row * DQ + 256 * pn + cl8; *(u32x4*)(Q + o) = pack8(a0, a1); *(u32x4*)(Q + o + 128) = pack8(b0, b1);
    }
};
struct EpiWT {
    bf16* W;
    __device__ __forceinline__ void apply(int row, int pn, int cl8, f32x4 a0, f32x4 a1, f32x4 b0, f32x4 b1) const {
        const size_t o = (size_t)row * D + 256 * pn + cl8; *(u32x4*)(W + o) = pack8(a0, a1); *(u32x4*)(W + o + 128) = pack8(b0, b1);
    }
};
struct EpiS {
    float* S;
    __device__ __forceinline__ void apply(int row, int pn, int cl8, f32x4 a0, f32x4 a1, f32x4 b0, f32x4 b1) const {
        const size_t o = (size_t)row * DQ + 256 * pn + cl8; *(f32x4*)(S + o) = a0; *(f32x4*)(S + o + 4) = a1; *(f32x4*)(S + o + 128) = b0; *(f32x4*)(S + o + 132) = b1;
    }
};

namespace pg8 {
#define PG8_LAS __attribute__((address_space(3)))
typedef unsigned short bf16_t;
typedef short bf16x8 __attribute__((ext_vector_type(8)));
typedef float f32x4 __attribute__((ext_vector_type(4)));
typedef unsigned u32x4 __attribute__((ext_vector_type(4)));
constexpr int BM = 256, BK = 64, HALF = 128, HTB = HALF * BK * 2  , STAGE_BYTES = 8 * HTB, NXCD = 8, WGM = 8;

__host__ __device__ __forceinline__ int lds_byte(int r, int c) { const int st = (r >> 4) * 2 + (c >> 5), rr = r & 15, cc = c & 31, ob = rr * 64 + cc * 2; return st * 1024 + (ob ^ (((ob >> 9) & 1) << 5)); }
__host__ __device__ __forceinline__ void stage_rc(int b, int& R, int& C) { const int st = b / 1024, sb = b % 1024, swz = sb ^ (((sb >> 9) & 1) << 5); R = (st >> 1) * 16 + swz / 64; C = (st & 1) * 32 + (swz % 64) / 2; }
__host__ __device__ __forceinline__ int perm32(int rho) { const int n = rho >> 4, i = rho & 15; return 8 * (i >> 2) + 4 * n + (i & 3); }

struct Unit { int pm, pn; };
struct Gemm { const bf16_t* A; const bf16_t* Bt; int M, N, K, lda, ldb, acol, bcol; };

struct StaticOrder {
    int nM, nN, nwg, G, c;
    __host__ __device__ void init(int M, int N, int G_, int c_) { nM = M / BM; nN = N / BM; nwg = nM * nN; G = G_; c = c_; }
    __host__ __device__ bool next(int i, Unit& u) const {
        const long L = (long)i * G + c; if (L >= nwg) return false;
        int wgid = (int)L; { const int q = nwg / NXCD, r = nwg % NXCD, xcd = wgid % NXCD, off = wgid / NXCD; wgid = (xcd < r ? xcd * (q + 1) : r * (q + 1) + (xcd - r) * q) + off; }
        const int nig = WGM * nN, gid = wgid / nig, fm = gid * WGM, gsz = (nM - fm) < WGM ? (nM - fm) : WGM;
        u.pm = fm + ((wgid % nig) % gsz); u.pn = (wgid % nig) / gsz; return true;
    }
    __device__ __forceinline__ void a_ready(const Unit&) const {}
    __device__ __forceinline__ void done(const Unit&) const {}
};


template <class Epi, class Sched, bool ALIGN_EPI = false, bool SP2 = false>
__device__ __forceinline__ void gemm_phase(PG8_LAS unsigned char* lds, const Gemm g, const Sched& S, const Epi& E, const int tid) {
    const int wid = __builtin_amdgcn_readfirstlane(tid >> 6), lane = tid & 63, wr = wid >> 2, wc = wid & 3, fr = lane & 15, fq = lane >> 4;
    const int K = g.K, nt = K / BK;
    unsigned voffA[2], voffB[2];
#pragma unroll
    for (int i = 0; i < 2; ++i) { int R, C; stage_rc(tid * 16 + i * 8192, R, C); const int Rb = Epi::PERM ? ((R & ~31) + perm32(R & 31)) : R;
        voffA[i] = (unsigned)(R * g.lda + C) * 2u; voffB[i] = (unsigned)(Rb * g.ldb + C) * 2u; }
    const size_t kstep = (size_t)(BK * 2);
    const size_t hstepA = (size_t)HALF * g.lda * 2, hstepB = (size_t)HALF * g.ldb * 2;
    const size_t tstepA = 2 * hstepA, tstepB = 2 * hstepB, acolb = (size_t)g.acol * 2, bcolb = (size_t)g.bcol * 2;
    const unsigned ldsw = (unsigned)wid * 1024u;
    const int aoff = lds_byte(wr * 64 + fr, fq * 8), boff = lds_byte(wc * 32 + fr, fq * 8);
#define PG8_SA(b, h) (((b) * 2 + (h)) * HTB)
#define PG8_SB(b, h) ((4 + (b) * 2 + (h)) * HTB)
#define PG8_STAGE(bufoff, gbase, voff) do { _Pragma("unroll") for (int _i = 0; _i < 2; ++_i) \
        __builtin_amdgcn_global_load_lds((const unsigned*)((const char*)(gbase) + (voff)[_i]), (PG8_LAS unsigned*)(lds + (bufoff) + ldsw + _i * 8192), 16, 0, 0); } while (0)
#define PG8_LDA(dst, b, h) do { _Pragma("unroll") for (int m = 0; m < 4; ++m) _Pragma("unroll") for (int k = 0; k < 2; ++k) dst[m][k] = *(const PG8_LAS bf16x8*)(lds + PG8_SA(b, h) + aoff + m * 2048 + k * 1024); } while (0)
#define PG8_LDB(dst, b, h) do { _Pragma("unroll") for (int n = 0; n < 2; ++n) _Pragma("unroll") for (int k = 0; k < 2; ++k) dst[n][k] = *(const PG8_LAS bf16x8*)(lds + PG8_SB(b, h) + boff + n * 2048 + k * 1024); } while (0)
#define PG8_MMA(ai, bj, At, Bt) do { __builtin_amdgcn_s_setprio(1); _Pragma("unroll") for (int m = 0; m < 4; ++m) _Pragma("unroll") for (int n = 0; n < 2; ++n) _Pragma("unroll") for (int k = 0; k < 2; ++k) \
        acc[ai][bj][m][n] = __builtin_amdgcn_mfma_f32_16x16x32_bf16(Bt[n][k], At[m][k], acc[ai][bj][m][n], 0, 0, 0); __builtin_amdgcn_s_setprio(0); } while (0)
#define PG8_WAIT_V(n) asm volatile("s_waitcnt vmcnt(" #n ")" ::: "memory")
#define PG8_WAIT_L(n) asm volatile("s_waitcnt lgkmcnt(" #n ")" ::: "memory")
#define PG8_BAR __builtin_amdgcn_s_barrier()
#define PG8_SCHED __builtin_amdgcn_sched_barrier(0)
    Unit cur, nxt; int ui = 0;
    if (!S.next(0, cur)) return;
    f32x4 acc[2][2][4][2];
#pragma unroll
    for (int a = 0; a < 2; ++a)
#pragma unroll
        for (int b = 0; b < 2; ++b)
#pragma unroll
            for (int m = 0; m < 4; ++m)
#pragma unroll
                for (int n = 0; n < 2; ++n) acc[a][b][m][n] = (f32x4){0.f, 0.f, 0.f, 0.f};
    bf16x8 At[4][2], B0[2][2], B1[2][2];
    const char* cA = (const char*)g.A + (size_t)cur.pm * tstepA + (size_t)cur.pn * acolb; const char* cB = (const char*)g.Bt + (size_t)cur.pn * tstepB + (size_t)cur.pm * bcolb;
    S.a_ready(cur);
    if constexpr (SP2) {
        PG8_STAGE(PG8_SB(0, 0), cB, voffB); PG8_STAGE(PG8_SB(0, 1), cB + hstepB, voffB); PG8_STAGE(PG8_SA(0, 0), cA, voffA); PG8_STAGE(PG8_SA(0, 1), cA + hstepA, voffA);
        if (wr == 1) PG8_BAR;
        PG8_WAIT_V(2); PG8_BAR;
        PG8_STAGE(PG8_SB(1, 0), cB + kstep, voffB); PG8_STAGE(PG8_SA(1, 0), cA + kstep, voffA); PG8_STAGE(PG8_SB(1, 1), cB + hstepB + kstep, voffB);
        PG8_WAIT_V(6); PG8_BAR;
    } else {
        PG8_STAGE(PG8_SB(0, 0), cB, voffB); PG8_STAGE(PG8_SA(0, 0), cA, voffA); PG8_STAGE(PG8_SB(0, 1), cB + hstepB, voffB); PG8_STAGE(PG8_SA(0, 1), cA + hstepA, voffA);
        if (wr == 1) PG8_BAR;
        PG8_WAIT_V(4); PG8_BAR;
        PG8_STAGE(PG8_SB(1, 0), cB + kstep, voffB); PG8_STAGE(PG8_SA(1, 0), cA + kstep, voffA); PG8_STAGE(PG8_SB(1, 1), cB + hstepB + kstep, voffB);
        PG8_WAIT_V(6); PG8_BAR;
    }
    for (;;) {
        const bool has_next = S.next(ui + 1, nxt);
        const char* nA = has_next ? (const char*)g.A + (size_t)nxt.pm * tstepA + (size_t)nxt.pn * acolb : cA; const char* nB = has_next ? (const char*)g.Bt + (size_t)nxt.pn * tstepB + (size_t)nxt.pm * bcolb : cB;
#pragma nounroll
        for (int t = 0; t < nt; t += 2) {
            const bool last = (t == nt - 2);
            const char* a1 = cA + (size_t)(t + 1) * kstep;
            const char* a2 = last ? nA : cA + (size_t)(t + 2) * kstep; const char* b2 = last ? nB : cB + (size_t)(t + 2) * kstep;
            const char* a3 = a2 + kstep; const char* b3 = b2 + kstep;
            if (last && has_next) S.a_ready(nxt);
            if constexpr (SP2) {
            PG8_LDB(B0, 0, 0); PG8_LDB(B1, 0, 1); PG8_SCHED; PG8_LDA(At, 0, 0); PG8_STAGE(PG8_SA(1, 1), a1 + hstepA, voffA);
            PG8_WAIT_V(8); PG8_WAIT_L(0); PG8_BAR; PG8_MMA(0, 0, At, B0); PG8_MMA(0, 1, At, B1); PG8_BAR; PG8_SCHED;
            PG8_LDA(At, 0, 1); PG8_STAGE(PG8_SB(0, 0), b2, voffB); PG8_STAGE(PG8_SB(0, 1), b2 + hstepB, voffB); PG8_STAGE(PG8_SA(0, 0), a2, voffA);
            PG8_WAIT_V(8); PG8_WAIT_L(0); PG8_BAR; PG8_MMA(1, 0, At, B0); PG8_MMA(1, 1, At, B1); PG8_BAR; PG8_SCHED;
            PG8_LDB(B0, 1, 0); PG8_LDB(B1, 1, 1); PG8_SCHED; PG8_LDA(At, 1, 0); PG8_STAGE(PG8_SA(0, 1), a2 + hstepA, voffA);
            PG8_WAIT_V(8); PG8_WAIT_L(0); PG8_BAR; PG8_MMA(0, 0, At, B0); PG8_MMA(0, 1, At, B1); PG8_BAR; PG8_SCHED;
            PG8_LDA(At, 1, 1); PG8_STAGE(PG8_SB(1, 0), b3, voffB); PG8_STAGE(PG8_SB(1, 1), b3 + hstepB, voffB); PG8_STAGE(PG8_SA(1, 0), a3, voffA);
            PG8_WAIT_V(8); PG8_WAIT_L(0); PG8_BAR; PG8_MMA(1, 0, At, B0); PG8_MMA(1, 1, At, B1); PG8_BAR; PG8_SCHED;
            } else {
            PG8_LDB(B0, 0, 0); PG8_SCHED; PG8_LDA(At, 0, 0); PG8_STAGE(PG8_SA(1, 1), a1 + hstepA, voffA);
            PG8_WAIT_L(8); PG8_BAR; PG8_WAIT_L(0); PG8_MMA(0, 0, At, B0); PG8_BAR; PG8_SCHED;
            PG8_LDB(B1, 0, 1); PG8_STAGE(PG8_SB(0, 0), b2, voffB);
            PG8_BAR; PG8_WAIT_L(0); PG8_MMA(0, 1, At, B1); PG8_BAR;
            PG8_LDA(At, 0, 1); PG8_STAGE(PG8_SA(0, 0), a2, voffA);
            PG8_BAR; PG8_WAIT_L(0); PG8_MMA(1, 0, At, B0); PG8_BAR; PG8_SCHED;
            PG8_STAGE(PG8_SB(0, 1), b2 + hstepB, voffB);
            PG8_WAIT_V(6); PG8_BAR; PG8_MMA(1, 1, At, B1); PG8_BAR;
            PG8_LDB(B0, 1, 0); PG8_SCHED; PG8_LDA(At, 1, 0); PG8_STAGE(PG8_SA(0, 1), a2 + hstepA, voffA);
            PG8_WAIT_L(8); PG8_BAR; PG8_WAIT_L(0); PG8_MMA(0, 0, At, B0); PG8_BAR; PG8_SCHED;
            PG8_LDB(B1, 1, 1); PG8_STAGE(PG8_SB(1, 0), b3, voffB);
            PG8_BAR; PG8_WAIT_L(0); PG8_MMA(0, 1, At, B1); PG8_BAR;
            PG8_LDA(At, 1, 1); PG8_STAGE(PG8_SA(1, 0), a3, voffA);
            PG8_BAR; PG8_WAIT_L(0); PG8_MMA(1, 0, At, B0); PG8_BAR; PG8_SCHED;
            PG8_STAGE(PG8_SB(1, 1), b3 + hstepB, voffB);
            PG8_WAIT_V(6); PG8_BAR; PG8_MMA(1, 1, At, B1); PG8_BAR;
            }
        }
        if constexpr (ALIGN_EPI) { if (wr == 0) PG8_BAR; }
        if constexpr (!Epi::AFTER_DRAIN) { E(acc, cur, wr, wc, fr, fq); S.done(cur); }
        if (!has_next) break;
#pragma unroll
        for (int a = 0; a < 2; ++a)
#pragma unroll
            for (int b = 0; b < 2; ++b)
#pragma unroll
                for (int m = 0; m < 4; ++m)
#pragma unroll
                    for (int n = 0; n < 2; ++n) acc[a][b][m][n] = (f32x4){0.f, 0.f, 0.f, 0.f};
        cur = nxt; cA = nA; cB = nB; ++ui;
        if constexpr (ALIGN_EPI) { if (wr == 1) PG8_BAR; }
    }
    PG8_WAIT_V(0);
    if constexpr (!ALIGN_EPI) { if (wr == 0) PG8_BAR; }
    PG8_BAR;
    if constexpr (Epi::AFTER_DRAIN) { E.fused(acc, cur, wr, wc, fr, fq, lds, wid, lane); S.done(cur); }
#undef PG8_SA
#undef PG8_SB
#undef PG8_STAGE
#undef PG8_LDA
#undef PG8_LDB
#undef PG8_MMA
#undef PG8_WAIT_V
#undef PG8_WAIT_L
#undef PG8_BAR
#undef PG8_SCHED
}

template <class F> struct EpiW {
    static constexpr bool PERM = true, AFTER_DRAIN = false; F f;
    __device__ __forceinline__ void operator()(const f32x4 (&acc)[2][2][4][2], const Unit& u, int wr, int wc, int fr, int fq) const {
#pragma unroll
        for (int ai = 0; ai < 2; ++ai)
#pragma unroll
            for (int m = 0; m < 4; ++m) { f.apply(u.pm * BM + ai * HALF + wr * 64 + m * 16 + fr, u.pn, wc * 32 + 8 * fq, acc[ai][0][m][0], acc[ai][0][m][1], acc[ai][1][m][0], acc[ai][1][m][1]);
                asm volatile("" ::: "memory"); }
    }
};
}

template <class F>
__device__ __forceinline__ void mfma_gemm(const Ctx& C, const bf16* A, int lda, int acol, const bf16* Bt, int ldb, int Mr, int N, int K, const F& f, int bcol = 0) {
    pg8::Gemm g{A, Bt, Mr, N, K, lda, ldb, acol, bcol}; pg8::StaticOrder S; S.init(Mr, N, C.nblk, C.blk); pg8::EpiW<F> E{f};
    pg8::gemm_phase<pg8::EpiW<F>, pg8::StaticOrder, true, true>(C.lds, g, S, E, C.tid);
}

template <class F>
__device__ __forceinline__ void naive_gemm(const Ctx& C, const bf16* A, int lda, int acol, const bf16* Bt, int ldb, int Mr, int N, int K, const F& f) {
    LAS float* As = (LAS float*)C.lds;
    LAS float* Bs = (LAS float*)(C.lds + 8192);
    const int ntm = Mr / 128, ntn = N / 256, tid = C.tid, cg = tid & 15, r0 = tid >> 4;
    for (int tile = C.blk; tile < ntm * ntn; tile += C.nblk) {
        const int tm = tile / ntn, pn = tile % ntn;
        f32x4 acc[4][4];
#pragma unroll
        for (int i = 0; i < 4; ++i)
#pragma unroll
            for (int j = 0; j < 4; ++j) acc[i][j] = (f32x4){0.f, 0.f, 0.f, 0.f};
        const bf16* ap = A + (size_t)(tm * 128 + (tid >> 2)) * lda + pn * acol + (tid & 3) * 4;
        const bf16* bp = Bt + (size_t)(pn * 256 + (tid >> 1)) * ldb + (tid & 1) * 8;
        for (int k0 = 0; k0 < K; k0 += 16) {
            const u32x2 av = *(const u32x2*)(ap + k0); const u32x4 bv = *(const u32x4*)(bp + k0);
            __syncthreads();
            { const int r = tid >> 2, kq = (tid & 3) * 4; As[(kq + 0) * 128 + r] = bflo(av.x); As[(kq + 1) * 128 + r] = bfhi(av.x); As[(kq + 2) * 128 + r] = bflo(av.y); As[(kq + 3) * 128 + r] = bfhi(av.y); }
            { const int n = tid >> 1, kq = (tid & 1) * 8; Bs[(kq + 0) * 256 + n] = bflo(bv.x); Bs[(kq + 1) * 256 + n] = bfhi(bv.x); Bs[(kq + 2) * 256 + n] = bflo(bv.y); Bs[(kq + 3) * 256 + n] = bfhi(bv.y);
              Bs[(kq + 4) * 256 + n] = bflo(bv.z); Bs[(kq + 5) * 256 + n] = bfhi(bv.z); Bs[(kq + 6) * 256 + n] = bflo(bv.w); Bs[(kq + 7) * 256 + n] = bfhi(bv.w); }
            __syncthreads();
#pragma unroll
            for (int kk = 0; kk < 16; ++kk) {
                const f32x4 b0 = *(const LAS f32x4*)(Bs + kk * 256 + cg * 8), b1 = *(const LAS f32x4*)(Bs + kk * 256 + cg * 8 + 4), b2 = *(const LAS f32x4*)(Bs + kk * 256 + 128 + cg * 8), b3 = *(const LAS f32x4*)(Bs + kk * 256 + 128 + cg * 8 + 4);
#pragma unroll
                for (int i = 0; i < 4; ++i) { const float av1 = As[kk * 128 + r0 + 32 * i]; acc[i][0] += b0 * av1; acc[i][1] += b1 * av1; acc[i][2] += b2 * av1; acc[i][3] += b3 * av1; }
            }
        }
#pragma unroll
        for (int i = 0; i < 4; ++i) f.apply(tm * 128 + r0 + 32 * i, pn, cg * 8, acc[i][0], acc[i][1], acc[i][2], acc[i][3]);
    }
}

template <int NROWS>
__device__ __forceinline__ void cp_stage(LAS unsigned char* tile, const bf16* src, int mrow0, int tfirst, int tid) {
    constexpr int NIT = (NROWS * 128 + NTHREADS - 1) / NTHREADS;
    asm volatile("" : "+v"(tid));
    u32x4 v[NIT];
#pragma unroll
    for (int i = 0; i < NIT; ++i) { const int ch = i * NTHREADS + tid, r = ch >> 7, c = ch & 127; v[i] = (u32x4){0u, 0u, 0u, 0u};
        if (ch < NROWS * 128 && tfirst + r >= 0) v[i] = *(const u32x4*)(src + (size_t)(mrow0 + r) * D + c * 8); }
#pragma unroll
    for (int i = 0; i < NIT; ++i) { const int ch = i * NTHREADS + tid; if (ch < NROWS * 128) *(LAS u32x4*)(tile + ch * 16) = v[i]; }
}
template <int W>
__device__ __forceinline__ void pool_item(const LAS unsigned char* tile, bf16* PL, int m0, int t0, int tid) {
    float p0[47], p1[47];
#pragma unroll
    for (int i = 0; i < 47; ++i) { unsigned w = 0u; if (i >= 15 - (W - 1)) w = *(const LAS unsigned*)(tile + i * 2048 + 4 * tid); p0[i] = bflo(w); p1[i] = bfhi(w); }
#pragma unroll
    for (int ti = 0; ti < 32; ++ti) {
        float s0 = 0.f, s1 = 0.f;
#pragma unroll
        for (int j = 0; j < W; ++j) { s0 += p0[ti + 15 - j]; s1 += p1[ti + 15 - j]; }
        const int cnt = (t0 + ti + 1) < W ? (t0 + ti + 1) : W; const float inv = 1.f / (float)cnt;
        *(unsigned*)(PL + (size_t)(m0 + ti) * D + 2 * tid) = pk2(s0 * inv - p0[ti + 15], s1 * inv - p1[ti + 15]);
    }
}
template <int RI>
__device__ __forceinline__ void conv_row(const LAS unsigned char* tile, int tid, const float (&w0)[31], const float (&w1)[31], float (&a0)[32], float (&a1)[32]) {
    const unsigned w = *(const LAS unsigned*)(tile + RI * 2048 + 4 * tid);
    const float u0 = bflo(w), u1 = bfhi(w);
#pragma unroll
    for (int ti = 0; ti < 32; ++ti) { constexpr int dbase = 30 - RI; const int d = ti + dbase; if (d >= 0 && d <= 30) { a0[ti] += w0[30 - d] * u0; a1[ti] += w1[30 - d] * u1; } }
    if constexpr ((RI & 7) == 7) asm volatile("" ::: "memory");
}
template <int... RI>
__device__ __forceinline__ void conv_rows(const LAS unsigned char* tile, int tid, const float (&w0)[31], const float (&w1)[31], float (&a0)[32], float (&a1)[32], std::integer_sequence<int, RI...>) {
    (conv_row<RI>(tile, tid, w0, w1, a0, a1), ...);
}
__device__ __forceinline__ void phase_convpool(const Ctx& C, const Args& a, int l) {
    const bf16* UG = (const bf16*)(a.ws + WS_UG); const bf16* ZP = (const bf16*)(a.ws + WS_ZP);
    bf16* AC = (bf16*)(a.ws + WS_AC); bf16* PL = (bf16*)(a.ws + WS_PL);
    const float* cw = a.in[I_CONVW] + (size_t)l * CONVK * D; const float* cb = a.in[I_CONVB] + (size_t)l * D;
    const float* lng = a.in[I_LNG] + (size_t)l * D; const float* lnb = a.in[I_LNB] + (size_t)l * D;
    LAS float* red = (LAS float*)C.lds;
    LAS float* stat = (LAS float*)(C.lds + 2048);
    LAS unsigned char* tile = C.lds + 4096;
    int tid = C.tid;
    asm volatile("" : "+v"(tid));
    const int c0 = 2 * tid;
    float w0[31], w1[31];
#pragma unroll
    for (int k = 0; k < 31; ++k) { const f32x2 w = *(const f32x2*)(cw + (size_t)k * D + c0); w0[k] = w.x; w1[k] = w.y; }
    const f32x2 bb = *(const f32x2*)(cb + c0), gg = *(const f32x2*)(lng + c0), be = *(const f32x2*)(lnb + c0);
    for (int item = C.blk; item < M / 32; item += C.nblk) {
        const int m0 = item * 32, t0 = m0 & (SEQ - 1);
        __syncthreads();
        cp_stage<62>(tile, UG, m0 - 30, t0 - 30, tid);
        __syncthreads();
        float a0[32], a1[32];
#pragma unroll
        for (int i = 0; i < 32; ++i) { a0[i] = bb.x; a1[i] = bb.y; }
        conv_rows(tile, tid, w0, w1, a0, a1, std::make_integer_sequence<int, 62>{});
#pragma unroll
        for (int ti = 0; ti < 32; ++ti) {
            const float s = dpp_sum63(a0[ti] + a1[ti]), q = dpp_sum63(a0[ti] * a0[ti] + a1[ti] * a1[ti]);
            if (C.lane == 63) { red[C.wave * 64 + ti] = s; red[C.wave * 64 + 32 + ti] = q; }
        }
        __syncthreads();
        if (tid < 32) { float s = 0.f, q = 0.f;
#pragma unroll
            for (int w = 0; w < 8; ++w) { s += red[w * 64 + tid]; q += red[w * 64 + 32 + tid]; }
            const float mean = s * (1.f / D), var = fmaxf(q * (1.f / D) - mean * mean, 0.f); stat[tid] = mean; stat[32 + tid] = 1.f / sqrtf(var + EPS); }
        __syncthreads();
#pragma unroll
        for (int ti = 0; ti < 32; ++ti) { const float mean = stat[ti], rstd = stat[32 + ti];
            const float y0 = (a0[ti] - mean) * rstd * gg.x + be.x, y1 = (a1[ti] - mean) * rstd * gg.y + be.y;
            *(unsigned*)(AC + (size_t)(m0 + ti) * D + c0) = pk2(y0 * sigm(y0), y1 * sigm(y1)); }
        asm volatile("" ::: "memory");
        cp_stage<47>(tile, ZP, m0 - 15, t0 - 15, tid);
        __syncthreads();
        const int g = tid >> 7;
        if (g == 0) pool_item<2>(tile, PL, m0, t0, tid); else if (g == 1) pool_item<4>(tile, PL, m0, t0, tid); else if (g == 2) pool_item<8>(tile, PL, m0, t0, tid); else pool_item<16>(tile, PL, m0, t0, tid);
    }
}

typedef unsigned u32;
template <int CTRL> __device__ __forceinline__ u32 dppu(u32 x) { return (u32)__builtin_amdgcn_update_dpp(0, (int)x, CTRL, 0xf, 0xf, true); }
constexpr int DPP_XOR1 = 0xB1, DPP_REV4 = 0x1B, DPP_DUPE = 0xA0, DPP_DUPO = 0xF5, DPP_HMIRROR = 0x141, DPP_MIRROR = 0x140;
__device__ __forceinline__ u32 umax_(u32 a, u32 b) { return a > b ? a : b; }
__device__ __forceinline__ u32 umin_(u32 a, u32 b) { return a < b ? a : b; }
#define TK_CE(x, i, j) do { const u32 hi_ = umax_(x[i], x[j]), lo_ = umin_(x[i], x[j]); x[i] = hi_; x[j] = lo_; } while (0)
__device__ __forceinline__ void tk_local_merge(u32 (&x)[8]) {
    TK_CE(x, 0, 4); TK_CE(x, 1, 5); TK_CE(x, 2, 6); TK_CE(x, 3, 7);
    TK_CE(x, 0, 2); TK_CE(x, 1, 3); TK_CE(x, 4, 6); TK_CE(x, 5, 7);
    TK_CE(x, 0, 1); TK_CE(x, 2, 3); TK_CE(x, 4, 5); TK_CE(x, 6, 7);
}
template <int CTRL> __device__ __forceinline__ void tk_level(u32 (&x)[8], bool even) {
    u32 t[8];
#pragma unroll
    for (int c = 0; c < 8; ++c) t[c] = dppu<CTRL>(x[7 - c]);
#pragma unroll
    for (int c = 0; c < 8; ++c) x[c] = umax_(x[c], t[c]);
#pragma unroll
    for (int c = 0; c < 8; ++c) { const u32 p = dppu<DPP_XOR1>(x[c]); x[c] = even ? umax_(x[c], p) : umin_(x[c], p); }
    tk_local_merge(x);
}
__device__ __forceinline__ void tk_top16(u32 (&x)[8], bool even) {
    TK_CE(x, 0, 1); TK_CE(x, 2, 3); TK_CE(x, 4, 5); TK_CE(x, 6, 7);
    TK_CE(x, 0, 2); TK_CE(x, 1, 3); TK_CE(x, 4, 6); TK_CE(x, 5, 7);
    TK_CE(x, 1, 2); TK_CE(x, 5, 6);
    TK_CE(x, 0, 4); TK_CE(x, 1, 5); TK_CE(x, 2, 6); TK_CE(x, 3, 7);
    TK_CE(x, 2, 4); TK_CE(x, 3, 5);
    TK_CE(x, 1, 2); TK_CE(x, 3, 4); TK_CE(x, 5, 6);
    { u32 t[8];
#pragma unroll
      for (int c = 0; c < 8; ++c) t[c] = dppu<DPP_XOR1>(x[7 - c]);
#pragma unroll
      for (int c = 0; c < 8; ++c) x[c] = even ? umax_(x[c], t[c]) : umin_(x[c], t[c]); }
    tk_local_merge(x);
    tk_level<DPP_REV4>(x, even); tk_level<DPP_HMIRROR>(x, even); tk_level<DPP_MIRROR>(x, even);
}
__device__ __forceinline__ u32 tk_f2key(float v, int slot) { const u32 u = __builtin_bit_cast(u32, v); const u32 k = u ^ ((u32)((int)u >> 31) | 0x80000000u); return (k & ~127u) | (u32)(127 - slot); }
__device__ __forceinline__ float tk_key2f(u32 k) { k &= ~127u; const u32 m = (u32)((int)k >> 31); return __builtin_bit_cast(float, k ^ (~m | 0x80000000u)); }
__device__ __forceinline__ u32 tk_sel8v(u32 r0, u32 r1, u32 r2, u32 r3, u32 r4, u32 r5, u32 r6, u32 r7, int idx) {
    const bool b0 = idx & 1, b1 = idx & 2, b2 = idx & 4;
    const u32 s01 = b0 ? r1 : r0, s23 = b0 ? r3 : r2, s45 = b0 ? r5 : r4, s67 = b0 ? r7 : r6;
    const u32 s03 = b1 ? s23 : s01, s47 = b1 ? s67 : s45;
    return b2 ? s47 : s03; }
#define tk_sel8(r, idx) tk_sel8v(r[0], r[1], r[2], r[3], r[4], r[5], r[6], r[7], idx)
__device__ __forceinline__ void tk2_sort16(u32 (&x)[16]) { TK_CE(x, 0, 1); TK_CE(x, 2, 3); TK_CE(x, 0, 2); TK_CE(x, 1, 3); TK_CE(x, 1, 2); TK_CE(x, 4, 5); TK_CE(x, 6, 7); TK_CE(x, 4, 6); TK_CE(x, 5, 7); TK_CE(x, 5, 6); TK_CE(x, 0, 4); TK_CE(x, 2, 6); TK_CE(x, 2, 4); TK_CE(x, 1, 5); TK_CE(x, 3, 7); TK_CE(x, 3, 5); TK_CE(x, 1, 2); TK_CE(x, 3, 4); TK_CE(x, 5, 6); TK_CE(x, 8, 9); TK_CE(x, 10, 11); TK_CE(x, 8, 10); TK_CE(x, 9, 11); TK_CE(x, 9, 10); TK_CE(x, 12, 13); TK_CE(x, 14, 15); TK_CE(x, 12, 14); TK_CE(x, 13, 15); TK_CE(x, 13, 14); TK_CE(x, 8, 12); TK_CE(x, 10, 14); TK_CE(x, 10, 12); TK_CE(x, 9, 13); TK_CE(x, 11, 15); TK_CE(x, 11, 13); TK_CE(x, 9, 10); TK_CE(x, 11, 12); TK_CE(x, 13, 14); TK_CE(x, 0, 8); TK_CE(x, 4, 12); TK_CE(x, 4, 8); TK_CE(x, 2, 10); TK_CE(x, 6, 14); TK_CE(x, 6, 10); TK_CE(x, 2, 4); TK_CE(x, 6, 8); TK_CE(x, 10, 12); TK_CE(x, 1, 9); TK_CE(x, 5, 13); TK_CE(x, 5, 9); TK_CE(x, 3, 11); TK_CE(x, 7, 15); TK_CE(x, 7, 11); TK_CE(x, 3, 5); TK_CE(x, 7, 9); TK_CE(x, 11, 13); TK_CE(x, 1, 2); TK_CE(x, 3, 4); TK_CE(x, 5, 6); TK_CE(x, 7, 8); TK_CE(x, 9, 10); TK_CE(x, 11, 12); TK_CE(x, 13, 14); }
__device__ __forceinline__ void tk2_merge16(u32 (&x)[16]) { TK_CE(x, 0, 8); TK_CE(x, 1, 9); TK_CE(x, 2, 10); TK_CE(x, 3, 11); TK_CE(x, 4, 12); TK_CE(x, 5, 13); TK_CE(x, 6, 14); TK_CE(x, 7, 15); TK_CE(x, 0, 4); TK_CE(x, 1, 5); TK_CE(x, 2, 6); TK_CE(x, 3, 7); TK_CE(x, 8, 12); TK_CE(x, 9, 13); TK_CE(x, 10, 14); TK_CE(x, 11, 15); TK_CE(x, 0, 2); TK_CE(x, 1, 3); TK_CE(x, 4, 6); TK_CE(x, 5, 7); TK_CE(x, 8, 10); TK_CE(x, 9, 11); TK_CE(x, 12, 14); TK_CE(x, 13, 15); TK_CE(x, 0, 1); TK_CE(x, 2, 3); TK_CE(x, 4, 5); TK_CE(x, 6, 7); TK_CE(x, 8, 9); TK_CE(x, 10, 11); TK_CE(x, 12, 13); TK_CE(x, 14, 15); }
template <int CTRL> __device__ __forceinline__ void tk2_level(u32 (&x)[16]) {
    u32 t[16];
#pragma unroll
    for (int c = 0; c < 16; ++c) t[c] = dppu<CTRL>(x[15 - c]);
#pragma unroll
    for (int c = 0; c < 16; ++c) x[c] = umax_(x[c], t[c]);
    tk2_merge16(x);
}
__device__ __forceinline__ void tk2_top16(u32 (&x)[16]) { tk2_sort16(x); tk2_level<DPP_XOR1>(x); tk2_level<DPP_REV4>(x); tk2_level<DPP_HMIRROR>(x); }
__device__ __forceinline__ u32 tk_sel16v(u32 r0, u32 r1, u32 r2, u32 r3, u32 r4, u32 r5, u32 r6, u32 r7, u32 r8, u32 r9, u32 r10, u32 r11, u32 r12, u32 r13, u32 r14, u32 r15, int idx) {
    const u32 lo = tk_sel8v(r0, r1, r2, r3, r4, r5, r6, r7, idx & 7), hi = tk_sel8v(r8, r9, r10, r11, r12, r13, r14, r15, idx & 7); return (idx & 8) ? hi : lo; }
__device__ __forceinline__ void phase_topk(const Ctx& C, const Args& a) {
    const float* S = (const float*)(a.ws + WS_S); int* EID = (int*)(a.ws + WS_EID); float* GW = (float*)(a.ws + WS_GW);
    const int lane = C.lane, r = lane & 7, q = lane >> 3;
    pg8::StaticOrder SO; SO.init(M, DQ, C.nblk, C.blk); pg8::Unit un;
    for (int ui = 0; SO.next(ui, un); ++ui)
    for (int wi = C.wave; wi < 32; wi += NWAVES) {
        const int tok = un.pm * 256 + wi * 8 + q, h = un.pn;
        u32 xa[16], xb[16];
        { const float* sp = S + (size_t)tok * DQ + h * 256 + 16 * r;
#pragma unroll
          for (int c4 = 0; c4 < 4; ++c4) { const f32x4 v = *(const f32x4*)(sp + 4 * c4), w = *(const f32x4*)(sp + 128 + 4 * c4);
#pragma unroll
            for (int c = 0; c < 4; ++c) { xa[4 * c4 + c] = tk_f2key(v[c], 16 * r + 4 * c4 + c); xb[4 * c4 + c] = tk_f2key(w[c], 16 * r + 4 * c4 + c); } } }
        tk2_top16(xa); tk2_top16(xb);
        float va[16], vb[16];
#pragma unroll
        for (int c = 0; c < 16; ++c) { va[c] = tk_key2f(xa[c]); vb[c] = tk_key2f(xb[c]); }
        const float b_lane = __builtin_bit_cast(float, tk_sel8v(__builtin_bit_cast(u32, vb[0]), __builtin_bit_cast(u32, vb[1]), __builtin_bit_cast(u32, vb[2]), __builtin_bit_cast(u32, vb[3]),
                                                               __builtin_bit_cast(u32, vb[4]), __builtin_bit_cast(u32, vb[5]), __builtin_bit_cast(u32, vb[6]), __builtin_bit_cast(u32, vb[7]), r));
        u32 ck[16];
#pragma unroll
        for (int c = 0; c < 16; ++c) { constexpr int lim[8] = {7, 7, 4, 3, 2, 1, 1, 1};
            float v; bool valid;
            if (c < 8) { v = va[c] + b_lane; valid = r <= lim[c & 7]; } else { v = (r == 0) ? va[c] + vb[0] : va[0] + vb[c]; valid = r <= 1; }
            ck[c] = valid ? tk_f2key(v, 8 * c + r) : 0u; }
        tk2_top16(ck);
        const u32 a_l0 = tk_sel8v(xa[0], xa[1], xa[2], xa[3], xa[4], xa[5], xa[6], xa[7], r), a_l1 = tk_sel8v(xa[8], xa[9], xa[10], xa[11], xa[12], xa[13], xa[14], xa[15], r);
        const u32 b_l0 = tk_sel8v(xb[0], xb[1], xb[2], xb[3], xb[4], xb[5], xb[6], xb[7], r), b_l1 = tk_sel8v(xb[8], xb[9], xb[10], xb[11], xb[12], xb[13], xb[14], xb[15], r);
        const float mx = tk_key2f(ck[0]);
        int eo[2]; float ex[2];
#pragma unroll
        for (int u = 0; u < 2; ++u) { const u32 x = tk_sel16v(ck[0], ck[1], ck[2], ck[3], ck[4], ck[5], ck[6], ck[7], ck[8], ck[9], ck[10], ck[11], ck[12], ck[13], ck[14], ck[15], 2 * r + u);
            const int slot = 127 - (int)(x & 127u), c = slot >> 3, rr = slot & 7;
            const int i = (c < 8) ? c : (rr == 0 ? c : 0), j = (c < 8) ? rr : (rr == 0 ? 0 : c);
            const int sa = ((lane & ~7) + (i & 7)) << 2, sb = ((lane & ~7) + (j & 7)) << 2;
            const u32 ka0 = (u32)__builtin_amdgcn_ds_bpermute(sa, (int)a_l0), ka1 = (u32)__builtin_amdgcn_ds_bpermute(sa, (int)a_l1), kb0 = (u32)__builtin_amdgcn_ds_bpermute(sb, (int)b_l0), kb1 = (u32)__builtin_amdgcn_ds_bpermute(sb, (int)b_l1);
            const u32 ka = (i >= 8) ? ka1 : ka0, kb = (j >= 8) ? kb1 : kb0;
            eo[u] = (127 - (int)(ka & 127u)) * 128 + (127 - (int)(kb & 127u)); ex[u] = __expf(tk_key2f(x) - mx); }
        float sum = ex[0] + ex[1];
        sum += __builtin_bit_cast(float, dppu<DPP_XOR1>(__builtin_bit_cast(u32, sum))); sum += __builtin_bit_cast(float, dppu<0x4E>(__builtin_bit_cast(u32, sum))); sum += __builtin_bit_cast(float, dppu<DPP_HMIRROR>(__builtin_bit_cast(u32, sum)));
        const float inv = 1.f / sum;
        *(u32x2*)(EID + (size_t)tok * 128 + h * 16 + 2 * r) = (u32x2){(u32)eo[0], (u32)eo[1]};
        *(f32x2*)(GW + (size_t)tok * 128 + h * 16 + 2 * r) = (f32x2){ex[0] * inv, ex[1] * inv};
    }
}

__device__ __forceinline__ float dot2bf(unsigned w, unsigned x, float acc) { return __builtin_amdgcn_fdot2_f32_bf16(__builtin_bit_cast(bf16x2_t, w), __builtin_bit_cast(bf16x2_t, x), acc, false); }
constexpr int PNB = 8;
__device__ __forceinline__ void phase_peer_a(const Ctx& C, const Args& a, int l) {
    const int x = C.blk & 7, wg = (C.blk >> 3) * NWAVES + C.wave, nwg = ((C.nblk + 7 - x) >> 3) * NWAVES;
    const __amdgpu_buffer_rsrc_t UC = __builtin_amdgcn_make_buffer_rsrc(a.ws + WS_UB + ((size_t)l * 8 + x) * NEXP * 128, 0, NEXP * 128, 0x00020000);
    const int* EID = (const int*)(a.ws + WS_EID); const bf16* H = (const bf16*)(a.ws + WS_H); const float* HSC = (const float*)(a.ws + WS_HSC); float* PD = (float*)(a.ws + WS_PD);
    LAS float* dl = (LAS float*)(C.lds + C.wave * 1024);
    unsigned z_ = 0u; asm volatile("" : "+v"(z_));
    const int lane = (int)__builtin_amdgcn_mbcnt_hi(~0u, __builtin_amdgcn_mbcnt_lo(~0u, z_)), p = lane & 7, g = lane >> 3;
#define PA_META(t_, ev0_, ev1_, r0_, r1_, hs_) do { ev0_ = EID[(size_t)(t_) * 128 + lane]; ev1_ = EID[(size_t)(t_) * 128 + 64 + lane]; hs_ = HSC[t_]; \
        r0_ = *(const u32x4*)(H + (size_t)(t_) * D + 128 * x + 16 * p); r1_ = *(const u32x4*)(H + (size_t)(t_) * D + 128 * x + 16 * p + 8); } while (0)
#define PA_ISSUE(rows_, ev_) do { _Pragma("unroll") for (int j = 0; j < 8; ++j) { const int e = __builtin_amdgcn_ds_bpermute((8 * j + g) << 2, ev_); \
        rows_[j] = __builtin_bit_cast(u32x4, __builtin_amdgcn_raw_buffer_load_b128(UC, e * 128 + 16 * p, 0, 0)); } } while (0)
#define PA_HALF(rows_, off_) do { _Pragma("unroll") for (int j = 0; j < 8; ++j) { \
            int acc = __builtin_amdgcn_sdot4((int)rows_[j].x, (int)hq.x, 0, false); acc = __builtin_amdgcn_sdot4((int)rows_[j].y, (int)hq.y, acc, false); \
            acc = __builtin_amdgcn_sdot4((int)rows_[j].z, (int)hq.z, acc, false); acc = __builtin_amdgcn_sdot4((int)rows_[j].w, (int)hq.w, acc, false); \
            acc += __builtin_amdgcn_update_dpp(0, acc, 0xB1, 0xf, 0xf, true); acc += __builtin_amdgcn_update_dpp(0, acc, 0x4E, 0xf, 0xf, true); acc += __builtin_amdgcn_update_dpp(0, acc, 0x141, 0xf, 0xf, true);   \
            tot[(off_) + j] = (float)acc; } } while (0)
    int evA0, evA1, evB0, evB1; float hsA, hsB; u32x4 hA0, hA1, hB0, hB1, rows0[8], rows1[8];
#define PA_TOKEN(ev0_, ev1_, h0_, h1_, hs_, tcur_, tload_, evn0_) do { \
        u32x4 hq; { const float inv = hs_ > 0.f ? 1.f / hs_ : 0.f; f32x4 f[4]; unpack8(h0_, f[0], f[1]); unpack8(h1_, f[2], f[3]);   \
            _Pragma("unroll") for (int q = 0; q < 4; ++q) hq[q] = ((unsigned)(int)rintf(f[q].x * inv) & 255u) | (((unsigned)(int)rintf(f[q].y * inv) & 255u) << 8) | (((unsigned)(int)rintf(f[q].z * inv) & 255u) << 16) | ((unsigned)(int)rintf(f[q].w * inv) << 24); } \
        PA_ISSUE(rows1, ev1_);                        \
        PA_META(tload_, ev0_, ev1_, h0_, h1_, hs_);   \
        __builtin_amdgcn_sched_barrier(0);            \
        float tot[16]; \
        PA_HALF(rows0, 0); \
        __builtin_amdgcn_sched_barrier(0); \
        PA_ISSUE(rows0, evn0_);                       \
        __builtin_amdgcn_sched_barrier(0); \
        PA_HALF(rows1, 8); \
        __builtin_amdgcn_sched_barrier(0); \
        if (p == 0) { _Pragma("unroll") for (int j = 0; j < 16; ++j) dl[8 * j + g] = tot[j]; } \
        asm volatile("s_waitcnt lgkmcnt(0)" ::: "memory"); \
        const float d0 = dl[lane], d1 = dl[64 + lane]; \
        if ((tcur_) < M) { PD[((size_t)(tcur_) * 8 + x) * 128 + lane] = d0; PD[((size_t)(tcur_) * 8 + x) * 128 + 64 + lane] = d1; } \
        asm volatile("s_waitcnt lgkmcnt(0)" ::: "memory");   } while (0)
    int t = wg;
    { const int tc = t < M ? t : 0; PA_META(tc, evA0, evA1, hA0, hA1, hsA); }
    { const int tc = t + nwg < M ? t + nwg : 0; PA_META(tc, evB0, evB1, hB0, hB1, hsB); }
    PA_ISSUE(rows0, evA0);
#pragma nounroll
    for (; t < M; t += 2 * nwg) {
        const int t1 = t + nwg, t2 = t + 2 * nwg, t3 = t + 3 * nwg, c2 = t2 < M ? t2 : t, c3 = t3 < M ? t3 : t;
        PA_TOKEN(evA0, evA1, hA0, hA1, hsA, t, c2, evB0);
        PA_TOKEN(evB0, evB1, hB0, hB1, hsB, t1, c3, evA0);
    }
#undef PA_TOKEN
#undef PA_META
#undef PA_ISSUE
#undef PA_HALF
}
__device__ __forceinline__ void phase_peer_c(const Ctx& C, const Args& a, int l) {
    const float* USC = (const float*)(a.ws + WS_USC) + (size_t)l * NEXP; const float* VSC = (const float*)(a.ws + WS_VSC) + (size_t)l * NEXP;
    const int* EID = (const int*)(a.ws + WS_EID); const float* GW = (const float*)(a.ws + WS_GW); const float* HSC = (const float*)(a.ws + WS_HSC); const float* PD = (const float*)(a.ws + WS_PD);
    int* C8 = (int*)(a.ws + WS_COEF); float* CSC = (float*)(a.ws + WS_CSC);
    for (int t = C.gw; t < M; t += C.ngw) { float cf[2]; const float hs = HSC[t];
#pragma unroll
        for (int u = 0; u < 2; ++u) { const int k = 64 * u + C.lane, e = EID[(size_t)t * 128 + k]; float d = 0.f;
#pragma unroll
            for (int xx = 0; xx < 8; ++xx) d += PD[((size_t)t * 8 + xx) * 128 + k];
            const float dd = d * USC[e] * hs; cf[u] = VSC[e] * GW[(size_t)t * 128 + k] * 0.5f * dd * (1.f + erff(dd * 0.70710678118654752f)); }
        const float am = wave_max(fmaxf(fabsf(cf[0]), fabsf(cf[1]))), inv = am > 0.f ? 127.f / am : 0.f;
        const int q0 = (int)rintf(cf[0] * inv) & 255, q1 = (int)rintf(cf[1] * inv) & 255;
        { const int L = C.lane & 31, m = L >> 3, g = L & 7, src = 32 * (m & 1) + g; unsigned w = 0u;
#pragma unroll
          for (int i = 0; i < 4; ++i) { const int b0 = __builtin_amdgcn_ds_bpermute((src + 8 * i) << 2, q0), b1 = __builtin_amdgcn_ds_bpermute((src + 8 * i) << 2, q1); w |= (unsigned)((m >> 1) ? b1 : b0) << (8 * i); }
          if (C.lane < 32) C8[(size_t)t * 32 + L] = (int)w; }
        if (C.lane == 0) CSC[t] = am * (1.f / 127.f); }
}
__device__ __forceinline__ void phase_peer_b(const Ctx& C, const Args& a, int l) {
    const int x = C.blk & 7, wg = (C.blk >> 3) * NWAVES + C.wave, nwg = ((C.nblk + 7 - x) >> 3) * NWAVES;
    const __amdgpu_buffer_rsrc_t VC = __builtin_amdgcn_make_buffer_rsrc(a.ws + WS_VB + ((size_t)l * 8 + x) * NEXP * 128, 0, NEXP * 128, 0x00020000);
    const int* EID = (const int*)(a.ws + WS_EID); const int* C8 = (const int*)(a.ws + WS_COEF); const float* CSC = (const float*)(a.ws + WS_CSC); float* XW = a.out;
    LAS int* ol = (LAS int*)(C.lds + C.wave * 4096);
    unsigned z_ = 0u; asm volatile("" : "+v"(z_));
    const int lane = (int)__builtin_amdgcn_mbcnt_hi(~0u, __builtin_amdgcn_mbcnt_lo(~0u, z_)), p = lane & 7, g = lane >> 3;
#define PB_META(t_, ev0_, ev1_, cf0_, cf1_, cf2_, cf3_) do { ev0_ = EID[(size_t)(t_) * 128 + lane]; ev1_ = EID[(size_t)(t_) * 128 + 64 + lane]; cf0_ = C8[(size_t)(t_) * 32 + g]; cf1_ = C8[(size_t)(t_) * 32 + 8 + g]; cf2_ = C8[(size_t)(t_) * 32 + 16 + g]; cf3_ = C8[(size_t)(t_) * 32 + 24 + g]; } while (0)
#define PB_ISSUE(rows_, ev_) do { _Pragma("unroll") for (int j = 0; j < 8; ++j) { const int e = __builtin_amdgcn_ds_bpermute((8 * j + g) << 2, ev_); \
        rows_[j] = __builtin_bit_cast(u32x4, __builtin_amdgcn_raw_buffer_load_b128(VC, e * 128 + 16 * p, 0, 0)); } } while (0)
#define PB_GROUP(rows_, j0_, ck_) do { _Pragma("unroll") for (int q = 0; q < 4; ++q) { const unsigned a_ = rows_[(j0_)][q], b_ = rows_[(j0_) + 1][q], c_ = rows_[(j0_) + 2][q], d_ = rows_[(j0_) + 3][q]; \
            const unsigned ablo = __builtin_amdgcn_perm(b_, a_, 0x05010400u), abhi = __builtin_amdgcn_perm(b_, a_, 0x07030602u), cdlo = __builtin_amdgcn_perm(d_, c_, 0x05010400u), cdhi = __builtin_amdgcn_perm(d_, c_, 0x07030602u); \
            o[4 * q + 0] = __builtin_amdgcn_sdot4((int)__builtin_amdgcn_perm(cdlo, ablo, 0x05040100u), ck_, o[4 * q + 0], false); o[4 * q + 1] = __builtin_amdgcn_sdot4((int)__builtin_amdgcn_perm(cdlo, ablo, 0x07060302u), ck_, o[4 * q + 1], false); \
            o[4 * q + 2] = __builtin_amdgcn_sdot4((int)__builtin_amdgcn_perm(cdhi, abhi, 0x05040100u), ck_, o[4 * q + 2], false); o[4 * q + 3] = __builtin_amdgcn_sdot4((int)__builtin_amdgcn_perm(cdhi, abhi, 0x07060302u), ck_, o[4 * q + 3], false); } } while (0)
#define PB_HALF(rows_, ck0_, ck1_) do { PB_GROUP(rows_, 0, ck0_); PB_GROUP(rows_, 4, ck1_); } while (0)
    int evA0, evA1, evB0, evB1, cfA0, cfA1, cfA2, cfA3, cfB0, cfB1, cfB2, cfB3; u32x4 rows0[8], rows1[8];
    const f32x2 g2b0 = *(const f32x2*)(modp(a, l, 0, 5) + 128 * x + 2 * lane), g2b1 = *(const f32x2*)(modp(a, l, 1, 5) + 128 * x + 2 * lane);
    int t = wg;
    { const int tc = t < M ? t : 0; PB_META(tc, evA0, evA1, cfA0, cfA1, cfA2, cfA3); }
    { const int tc = t + nwg < M ? t + nwg : 0; PB_META(tc, evB0, evB1, cfB0, cfB1, cfB2, cfB3); }
    PB_ISSUE(rows0, evA0);
    f32x2 xvn; float csn; { const int tc = t < M ? t : 0; xvn = *(const f32x2*)(XW + (size_t)tc * D + 128 * x + 2 * lane); csn = CSC[tc]; }
#pragma nounroll
    for (; t < M; t += nwg) {
        const int t2 = t + 2 * nwg, c2 = t2 < M ? t2 : t;
        const int k0 = cfA0, k1 = cfA1, k2 = cfA2, k3 = cfA3;
        const f32x2 xv = xvn; const float cs = csn;
        PB_ISSUE(rows1, evA1);
        evA0 = evB0; evA1 = evB1; cfA0 = cfB0; cfA1 = cfB1; cfA2 = cfB2; cfA3 = cfB3;
        PB_META(c2, evB0, evB1, cfB0, cfB1, cfB2, cfB3);
        { const int c1 = t + nwg < M ? t + nwg : t; xvn = *(const f32x2*)(XW + (size_t)c1 * D + 128 * x + 2 * lane); csn = CSC[c1]; }
        __builtin_amdgcn_sched_barrier(0);
        int o[16];
#pragma unroll
        for (int i = 0; i < 16; ++i) o[i] = 0;
        PB_HALF(rows0, k0, k1);
        __builtin_amdgcn_sched_barrier(0);
        PB_ISSUE(rows0, evA0);
        __builtin_amdgcn_sched_barrier(0);
        PB_HALF(rows1, k2, k3);
        __builtin_amdgcn_sched_barrier(0);
#pragma unroll
        for (int q = 0; q < 4; ++q) *(LAS u32x4*)(ol + lane * 16 + 4 * q) = (u32x4){(unsigned)o[4 * q], (unsigned)o[4 * q + 1], (unsigned)o[4 * q + 2], (unsigned)o[4 * q + 3]};
        asm volatile("s_waitcnt lgkmcnt(0)" ::: "memory");
        int s0 = 0, s1 = 0;
#pragma unroll
        for (int gg = 0; gg < 8; ++gg) { const u32x2 v = *(const LAS u32x2*)(ol + (gg * 8 + (lane >> 3)) * 16 + 2 * (lane & 7)); s0 += (int)v.x; s1 += (int)v.y; }
        asm volatile("s_waitcnt lgkmcnt(0)" ::: "memory");
        const int c = 128 * x + 2 * lane; const f32x2 g2 = (t >> 13) ? g2b1 : g2b0;
        *(f32x2*)(XW + (size_t)t * D + c) = xv + g2 * (f32x2){(float)s0 * cs, (float)s1 * cs};
    }
#undef PB_META
#undef PB_ISSUE
#undef PB_HALF
}
__device__ __forceinline__ void phase_final(const Ctx& C, const Args& a) {
    for (int m = C.gw; m < M; m += C.ngw) { f32x4 x[4]; float ss = 0.f;
#pragma unroll
        for (int j = 0; j < 4; ++j) { x[j] = *(const f32x4*)(a.out + (size_t)m * D + 4 * C.lane + 256 * j); ss += (x[j].x * x[j].x + x[j].y * x[j].y) + (x[j].z * x[j].z + x[j].w * x[j].w); }
        const float rstd = 1.f / sqrtf(wave_sum(ss) * (1.f / D) + EPS);
#pragma unroll
        for (int j = 0; j < 4; ++j) *(f32x4*)(a.out + (size_t)m * D + 4 * C.lane + 256 * j) = x[j] * rstd * *(const f32x4*)(a.in[I_FG] + 4 * C.lane + 256 * j); }
}

#ifndef USE_NAIVE
#define GEMM mfma_gemm
#else
#define GEMM naive_gemm
#endif
#define RLX_AGENT __ATOMIC_RELAXED, __HIP_MEMORY_SCOPE_AGENT
#define XB_TMO      128
#define XB_XCNT(j)  (256  + 64 * (j))
#define XB_XSUB(j)  (1280 + 64 * (j))
#define XB_XGEN(j)  (2304 + 64 * (j))
#define XB_TOP      3328
#define XB_TOPGEN   3392
#define XCD_BAR_WORDS 3456
#define XB_SPIN_CAP (1u << 18)

__device__ __forceinline__ unsigned xb_ld(unsigned* p)              { return __hip_atomic_load(p, __ATOMIC_RELAXED, __HIP_MEMORY_SCOPE_AGENT); }
__device__ __forceinline__ unsigned xb_add(unsigned* p, unsigned v) { return __hip_atomic_fetch_add(p, v, __ATOMIC_RELAXED, __HIP_MEMORY_SCOPE_AGENT); }
__device__ __forceinline__ unsigned xb_xcc_id() { return (unsigned)__builtin_amdgcn_s_getreg((3 << 11) | 20) & 0xFu; }
#define XB_SPIN(cond, bar) do { unsigned _sp = 0; while (cond) { __builtin_amdgcn_s_sleep(1); \
    if ((++_sp & 255u) == 0u) { if (xb_ld(&(bar)[XB_TMO])) break; if (_sp > XB_SPIN_CAP) { atomicAdd(&(bar)[XB_TMO], 1u); break; } } } } while (0)

struct XcdBarrier {
    unsigned* bar; unsigned x;
    volatile LAS unsigned* st;
};

__device__ __forceinline__ XcdBarrier xcd_barrier_post(unsigned* bar, volatile LAS unsigned* st) {
    XcdBarrier b; b.bar = bar; b.x = xb_xcc_id(); b.st = st;
    if (threadIdx.x == 0) (void)xb_add(&bar[XB_XCNT(b.x)], 1u);
    return b;
}
__device__ __forceinline__ void xcd_barrier_complete(unsigned* bar, unsigned x, unsigned& nloc, unsigned& nx) {
    const unsigned G = gridDim.x * gridDim.y * gridDim.z;
    unsigned sum, cnt, mine, sp = 0u;
    for (;;) {
        sum = 0u; cnt = 0u; mine = 0u;
#pragma unroll
        for (unsigned j = 0; j < 16; ++j) { const unsigned c = xb_ld(&bar[XB_XCNT(j)]); sum += c; cnt += (c > 0u) ? 1u : 0u; mine = (j == x) ? c : mine; }
        if (sum == G) break;
        __builtin_amdgcn_s_sleep(1);
        if ((++sp & 255u) == 0u) { if (xb_ld(&bar[XB_TMO])) break; if (sp > XB_SPIN_CAP) { atomicAdd(&bar[XB_TMO], 1u); break; } }
    }
    nloc = mine > 0u ? mine : 1u; nx = cnt > 0u ? cnt : 1u;
}

__device__ __forceinline__ void xcd_barrier(const XcdBarrier& b, const int tid_) {
    asm volatile("s_waitcnt vmcnt(0)" ::: "memory");
    __syncthreads();
    if (tid_ == 0) {
        unsigned* bar = b.bar;
        __builtin_amdgcn_s_waitcnt(0);
        unsigned nloc = b.st[0], nx = b.st[1];
        if (nloc == 0u) { xcd_barrier_complete(bar, b.x, nloc, nx); b.st[0] = nloc; b.st[1] = nx; }
        const unsigned old = xb_add(&bar[XB_XSUB(b.x)], 1u);
        const unsigned gen = old / nloc;
        if (old + 1u == (gen + 1u) * nloc) {
            __builtin_amdgcn_fence(__ATOMIC_RELEASE, "agent");
            asm volatile("s_waitcnt vmcnt(0)" ::: "memory");
            const unsigned og = xb_add(&bar[XB_TOP], 1u);
            const unsigned tg = og / nx;
            if (og + 1u == (tg + 1u) * nx) xb_add(&bar[XB_TOPGEN], 1u);
            else XB_SPIN(xb_ld(&bar[XB_TOPGEN]) == tg, bar);
            __builtin_amdgcn_fence(__ATOMIC_ACQUIRE, "agent");
            xb_add(&bar[XB_XGEN(b.x)], 1u);
            asm volatile("s_waitcnt vmcnt(0)" ::: "memory");
        } else {
            XB_SPIN(xb_ld(&bar[XB_XGEN(b.x)]) == gen, bar);
            __builtin_amdgcn_fence(__ATOMIC_ACQUIRE, "agent");
            asm volatile("s_waitcnt vmcnt(0)" ::: "memory");
        }
    }
    __syncthreads();
}

constexpr int CW_BAR = 4096;
constexpr size_t CTL_ZERO_BYTES = 65536;
constexpr int LDSCTL_OFF = 131072, MISC_OFF = LDSCTL_OFF + 320;
constexpr int PH_PREP = 0, PH_MODR = 1, PH_N1 = 2, PH_L0 = 3, PH_PER_LAYER = 10, N_PHASES = PH_L0 + DEPTH * PH_PER_LAYER;
__device__ __forceinline__ Ctx make_ctx(LAS unsigned char* lds, int wave_s) {
    unsigned z_ = 0u; asm volatile("" : "+v"(z_));
    int tid_ = (wave_s << 6) | (int)__builtin_amdgcn_mbcnt_hi(~0u, __builtin_amdgcn_mbcnt_lo(~0u, z_)); asm volatile("" : "+v"(tid_));
    Ctx C; C.tid = tid_; C.lane = C.tid & 63; C.wave = __builtin_amdgcn_readfirstlane(C.tid >> 6); C.nblk = gridDim.x; C.blk = blockIdx.x;
    C.gw = C.blk * NWAVES + C.wave; C.ngw = C.nblk * NWAVES; C.lds = lds; return C;
}
#ifndef ONLYPH
#define ONLYPH -1
#endif
constexpr unsigned long long REP_MASK = 0ull;
#define PH(k, ...) if ((ONLYPH < 0 || ONLYPH == (k)) && a.ph_lo <= (k) && (k) < a.ph_hi) { for (int r_ = 0; r_ < 1 + (int)((REP_MASK >> (k)) & 1ull); ++r_) { const Ctx C = make_ctx(lds, wave_s); __VA_ARGS__; } if ((k) + 1 < a.ph_hi) xcd_barrier(bar, make_ctx(lds, wave_s).tid); }
template <int l>
__device__ __forceinline__ void run_layer(const Args& a, LAS unsigned char* lds, const XcdBarrier& bar, const int wave_s) {
    unsigned char* ws = a.ws; constexpr int B0 = PH_L0 + l * PH_PER_LAYER;
    PH(B0 + 0, EpiIn E{a.in[I_BIN] + (size_t)l * DIN, (bf16*)(ws + WS_UG), (bf16*)(ws + WS_ZP), (bf16*)(ws + WS_G)};
               GEMM(C, (const bf16*)(ws + WS_H), D, 0, (const bf16*)(ws + WS_WIN) + (size_t)l * DIN * D, D, M, DIN, D, E))
    PH(B0 + 1, phase_convpool(C, a, l))
    PH(B0 + 2, { EpiPool E{(const bf16*)(ws + WS_G), a.in[I_POOLS] + (size_t)l * D, (bf16*)(ws + WS_TMP)};
                 GEMM(C, (const bf16*)(ws + WS_PL), D, 256, (const bf16*)(ws + WS_POOL) + (size_t)l * 1024 * 256, 256, M, D, 256, E); }
               { const Ctx C2 = make_ctx(lds, wave_s); EpiConv E{(const bf16*)(ws + WS_G), (const bf16*)(ws + WS_TMP), (bf16*)(ws + WS_Y)};
                 GEMM(C2, (const bf16*)(ws + WS_AC), D, 0, (const bf16*)(ws + WS_WCO) + (size_t)l * D * D, D, M, D, D, E); })
    PH(B0 + 3, EpiOut E{l == 0 ? a.in[I_X] : a.out, a.out, modp(a, l, 0, 2), a.in[I_BOUT] + (size_t)l * D};
               GEMM(C, (const bf16*)(ws + WS_Y), D, 0, (const bf16*)(ws + WS_WOUT) + (size_t)l * D * D, D, M, D, D, E))
    PH(B0 + 4, phase_norm(C, a, a.out, a.in[I_N2G] + (size_t)l * D, l, 3, 4, (float*)(ws + WS_HSC)))
    PH(B0 + 5, { EpiS E{(float*)(ws + WS_S)}; GEMM(C, (const bf16*)(ws + WS_H), D, 0, (const bf16*)(ws + WS_WQ) + (size_t)l * DQ * D, D, M, DQ, D, E); }
               asm volatile("s_waitcnt vmcnt(0)" ::: "memory"); __syncthreads();
               { const Ctx C3 = make_ctx(lds, wave_s); phase_topk(C3, a); })
    PH(B0 + 6, phase_peer_a(C, a, l))
    PH(B0 + 7, phase_peer_c(C, a, l))
    PH(B0 + 8, phase_peer_b(C, a, l))
    PH(B0 + 9, if (l + 1 < DEPTH) phase_norm(C, a, a.out, a.in[I_N1G] + (size_t)(l + 1) * D, l + 1, 0, 1, nullptr); else phase_final(C, a))
}
__global__ void __launch_bounds__(NTHREADS, 2) fwd_kernel(Args a) {
    extern __shared__ __attribute__((aligned(16))) unsigned char lds_raw[];
    LAS unsigned char* lds = (LAS unsigned char*)lds_raw;
    for (int u = threadIdx.x; u < (LDS_BYTES - LDSCTL_OFF) / 4; u += NTHREADS) ((LAS unsigned*)(lds + LDSCTL_OFF))[u] = 0u;
    __syncthreads();
    const int wave_s = __builtin_amdgcn_readfirstlane((int)threadIdx.x >> 6);
    const XcdBarrier bar = xcd_barrier_post((unsigned*)(a.ws + WS_CTL) + CW_BAR, (volatile LAS unsigned*)(lds + MISC_OFF) + 8);
    PH(PH_PREP, phase_prep(C, a))
    PH(PH_MODR, phase_modreduce(C, a))
    PH(PH_N1, phase_norm(C, a, a.in[I_X], a.in[I_N1G], 0, 0, 1, nullptr);
              for (int lf = 0; lf < DEPTH; ++lf) { const Ctx C2 = make_ctx(lds, wave_s); EpiWT E{(bf16*)(a.ws + WS_WQ) + (size_t)lf * DQ * D};
                  GEMM(C2, (const bf16*)(a.ws + WS_KEYS) + (size_t)lf * 2048 * 256, 256, 0, (const bf16*)(a.ws + WS_WQB) + (size_t)lf * D * DQ, DQ, DQ, D, 256, E, 256); })
    run_layer<0>(a, lds, bar, wave_s);
    run_layer<1>(a, lds, bar, wave_s);
}

extern "C" void kernel_launch(void* const* d_in, const int* in_sizes, int n_in, void* d_out, int out_size, void* d_ws, size_t ws_size, hipStream_t stream) {
    static int grid = 0;
    if (grid == 0) {
        if (n_in != 22 || out_size != M * D || ws_size < WS_END) { fprintf(stderr, "kernel_launch: unexpected shapes (n_in %d out %d ws %zu)\n", n_in, out_size, ws_size); grid = -1; return; }
        int dev = 0, cus = 0;
        if (hipGetDevice(&dev) != hipSuccess || hipDeviceGetAttribute(&cus, hipDeviceAttributeMultiprocessorCount, dev) != hipSuccess) { grid = -1; return; }
        if (hipFuncSetAttribute((const void*)fwd_kernel, hipFuncAttributeMaxDynamicSharedMemorySize, LDS_BYTES) != hipSuccess) { grid = -1; return; }
        grid = cus;
    }
    if (grid < 0) return;
    Args a{};
    for (int i = 0; i < 22; ++i) a.in[i] = (const float*)d_in[i];
    a.out = (float*)d_out; a.ws = (unsigned char*)d_ws;
    (void)hipMemsetAsync((char*)d_ws + WS_CTL, 0, CTL_ZERO_BYTES, stream);
#ifndef ONE_LAUNCH
    for (int ph = 0; ph < N_PHASES; ++ph) { a.ph_lo = ph; a.ph_hi = ph + 1; hipLaunchKernelGGL(fwd_kernel, dim3(grid), dim3(NTHREADS), LDS_BYTES, stream, a); }
#else
    a.ph_lo = 0; a.ph_hi = N_PHASES; hipLaunchKernelGGL(fwd_kernel, dim3(grid), dim3(NTHREADS), LDS_BYTES, stream, a);
#endif
}
```

```cpp
#define ONE_LAUNCH 1
#include <hip/hip_runtime.h>
#include <cstdint>
#include <cstdio>
#include <utility>

#define GAS __attribute__((address_space(1)))
#define LAS __attribute__((address_space(3)))
typedef unsigned short bf16;
typedef float f32x4 __attribute__((ext_vector_type(4)));
typedef float f32x2 __attribute__((ext_vector_type(2)));
typedef unsigned u32x4 __attribute__((ext_vector_type(4)));
typedef unsigned u32x2 __attribute__((ext_vector_type(2)));
typedef __bf16 bf16x2_t __attribute__((ext_vector_type(2)));

constexpr int BATCH = 2, SEQ = 8192, D = 1024, M = BATCH * SEQ, DEPTH = 2;
constexpr int DIN = 5120, NMODV = 6 * D, CONVK = 31, NHEAD = 8, NKEYS = 128, DQ = 2048, TOPK = 16, NEXP = 16384;
constexpr float EPS = 1e-6f;
constexpr int NWAVES = 8, NTHREADS = NWAVES * 64;

constexpr size_t MiB = 1u << 20;
constexpr size_t WS_CTL = 0;
constexpr size_t WS_MODP = 1 * MiB;
constexpr size_t WS_MOD = 4 * MiB;
constexpr size_t WS_WIN = 8 * MiB;
constexpr size_t WS_WCO = 28 * MiB;
constexpr size_t WS_WOUT = 32 * MiB;
constexpr size_t WS_WQ = 36 * MiB;
constexpr size_t WS_POOL = 44 * MiB;
constexpr size_t WS_KEYS = 45 * MiB;
constexpr size_t WS_UB = 48 * MiB;
constexpr size_t WS_USC = 80 * MiB;
constexpr size_t WS_VSC = 81 * MiB;
constexpr size_t WS_VB = 112 * MiB;
constexpr size_t WS_H = 176 * MiB;
constexpr size_t WS_UG = 208 * MiB;
constexpr size_t WS_Y = WS_UG;
constexpr size_t WS_ZP = 240 * MiB;
constexpr size_t WS_TMP = WS_ZP;
constexpr size_t WS_Q = WS_UG;
constexpr size_t WS_G = 272 * MiB;
constexpr size_t WS_AC = 336 * MiB;
constexpr size_t WS_PL = 368 * MiB;
constexpr size_t WS_S = WS_G;
constexpr size_t WS_EID = 400 * MiB;
constexpr size_t WS_GW = 408 * MiB;
constexpr size_t WS_COEF = 416 * MiB;
constexpr size_t WS_CSC = 424 * MiB + 65536;
constexpr size_t WS_HSC = 424 * MiB;
constexpr size_t WS_PD = WS_S;
constexpr size_t WS_WQB = 426 * MiB;
constexpr size_t WS_WPB = 434 * MiB;
constexpr size_t WS_BP = 4 * MiB + 262144;
constexpr size_t WS_END = 438 * MiB;

constexpr int LDS_BYTES = 147456;

__device__ __forceinline__ unsigned f2bf(float f) { unsigned u = __builtin_bit_cast(unsigned, f); return (u + 0x7fffu + ((u >> 16) & 1u)) >> 16; }
__device__ __forceinline__ unsigned pk2(float lo, float hi) { return f2bf(lo) | (f2bf(hi) << 16); }
__device__ __forceinline__ float bflo(unsigned w) { return __builtin_bit_cast(float, w << 16); }
__device__ __forceinline__ float bfhi(unsigned w) { return __builtin_bit_cast(float, w & 0xffff0000u); }
__device__ __forceinline__ float sigm(float x) { return __builtin_amdgcn_rcpf(1.f + __expf(-x)); }
__device__ __forceinline__ float wave_sum(float v) {
#pragma unroll
    for (int o = 1; o < 64; o <<= 1) v += __shfl_xor(v, o);
    return v;
}
__device__ __forceinline__ float wave_max(float v) {
#pragma unroll
    for (int o = 1; o < 64; o <<= 1) v = fmaxf(v, __shfl_xor(v, o));
    return v;
}
__device__ __forceinline__ float dpp_sum63(float v) {
#define DPPF(x, ctrl, rm, bc) __builtin_bit_cast(float, __builtin_amdgcn_update_dpp(0, __builtin_bit_cast(int, x), ctrl, rm, 0xf, bc))
    v += DPPF(v, 0x111, 0xf, true); v += DPPF(v, 0x112, 0xf, true); v += DPPF(v, 0x114, 0xf, true); v += DPPF(v, 0x118, 0xf, true);
    v += DPPF(v, 0x142, 0xa, false); v += DPPF(v, 0x143, 0xc, false);
#undef DPPF
    return v;
}
__device__ __forceinline__ u32x4 pack8(const f32x4& a, const f32x4& b) { u32x4 w; w.x = pk2(a.x, a.y); w.y = pk2(a.z, a.w); w.z = pk2(b.x, b.y); w.w = pk2(b.z, b.w); return w; }
__device__ __forceinline__ void unpack8(const u32x4& w, f32x4& a, f32x4& b) { a = (f32x4){bflo(w.x), bfhi(w.x), bflo(w.y), bfhi(w.y)}; b = (f32x4){bflo(w.z), bfhi(w.z), bflo(w.w), bfhi(w.w)}; }

struct Ctx { int tid, lane, wave, gw, ngw, nblk, blk; LAS unsigned char* lds; };

struct Args { const float* in[22]; float* out; unsigned char* ws; int ph_lo, ph_hi; };
enum { I_X = 0, I_C, I_ADAW, I_ADAB, I_N1G, I_WIN, I_BIN, I_CONVW, I_CONVB, I_LNG, I_LNB, I_WCO, I_POOLW, I_POOLS, I_WOUT, I_BOUT, I_N2G, I_WQ, I_KEYS, I_PU, I_PV, I_FG };

__device__ __forceinline__ void transpose_item(const float* W, int K, int N, int k0, int n0, bf16* WT, int dstrow0, LAS float* scr, int lane) {
#pragma unroll 8
    for (int i = 0; i < 32; ++i) { const int kk = 2 * i + (lane >> 5); scr[kk * 33 + (lane & 31)] = W[(size_t)(k0 + kk) * N + n0 + (lane & 31)]; }
    asm volatile("s_waitcnt lgkmcnt(0)" ::: "memory");
    const int c = lane & 7;
#pragma unroll
    for (int j = 0; j < 4; ++j) { const int n = (lane >> 3) + 8 * j; const LAS float* s = scr + (8 * c) * 33 + n;
        u32x4 o; o.x = pk2(s[0 * 33], s[1 * 33]); o.y = pk2(s[2 * 33], s[3 * 33]); o.z = pk2(s[4 * 33], s[5 * 33]); o.w = pk2(s[6 * 33], s[7 * 33]);
        *(u32x4*)(WT + (size_t)(dstrow0 + n) * K + k0 + 8 * c) = o; }
    asm volatile("s_waitcnt lgkmcnt(0)" ::: "memory");
}
__device__ __forceinline__ int win_dstrow(int n0) {
    if (n0 < 1024) return 256 * (n0 >> 7) + (n0 & 127);
    if (n0 < 2048) { const int c = n0 - 1024; return 256 * (c >> 7) + 128 + (c & 127); }
    return n0;
}
__device__ __forceinline__ void phase_prep(const Ctx& C, const Args& a) {
    unsigned char* ws = a.ws;
    LAS float* scr = (LAS float*)(C.lds + C.wave * 16384);
    constexpr int I_IN = 16 * 160, I_CO = 16 * 32, I_PO = 4 * (4 * 8), I_OUT = 16 * 32, I_L = I_IN + I_CO + I_PO + I_OUT;
    for (int it = C.gw; it < DEPTH * I_L; it += C.ngw) {
        const int l = it / I_L; int r = it % I_L;
        if (r < I_IN) { const int kb = r / 160, nb = r % 160; if (nb < 64 || nb >= 96) transpose_item(a.in[I_WIN] + (size_t)l * D * DIN, D, DIN, 64 * kb, 32 * nb, (bf16*)(ws + WS_WIN) + (size_t)l * DIN * D, win_dstrow(32 * nb), scr, C.lane); continue; } r -= I_IN;
        if (r < I_CO) { const int kb = r / 32, nb = r % 32; transpose_item(a.in[I_WCO] + (size_t)l * D * D, D, D, 64 * kb, 32 * nb, (bf16*)(ws + WS_WCO) + (size_t)l * D * D, 32 * nb, scr, C.lane); continue; } r -= I_CO;
        if (r < I_PO) { const int g = r / 32, q = r % 32, kb = q / 8, nb = q % 8; transpose_item(a.in[I_POOLW] + ((size_t)l * 4 + g) * 256 * 256, 256, 256, 64 * kb, 32 * nb, (bf16*)(ws + WS_POOL) + ((size_t)l * 1024 + 256 * g) * 256, 32 * nb, scr, C.lane); continue; } r -= I_PO;
        { const int kb = r / 32, nb = r % 32; transpose_item(a.in[I_WOUT] + (size_t)l * D * D, D, D, 64 * kb, 32 * nb, (bf16*)(ws + WS_WOUT) + (size_t)l * D * D, 32 * nb, scr, C.lane); }
    }
    const int gt = C.blk * NTHREADS + C.tid, ngt = C.nblk * NTHREADS;
    for (int i = gt; i < DEPTH * D * 1024 / 8; i += ngt) { const int l = i / (D * 128), rr = i % (D * 128), k = rr / 128, c8 = (rr % 128) * 8; const float* sp = a.in[I_WIN] + ((size_t)l * D + k) * DIN + 2048 + c8;
        const f32x4 v0 = *(const f32x4*)sp, v1 = *(const f32x4*)(sp + 4); *(u32x4*)((bf16*)(ws + WS_WPB) + ((size_t)l * D + k) * 1024 + c8) = pack8(v0, v1); }
    for (size_t i = gt; i < (size_t)DEPTH * D * DQ / 8; i += ngt) { const f32x4 v0 = *(const f32x4*)(a.in[I_WQ] + i * 8), v1 = *(const f32x4*)(a.in[I_WQ] + i * 8 + 4); *(u32x4*)((bf16*)(ws + WS_WQB) + i * 8) = pack8(v0, v1); }
    for (int i = gt; i < DEPTH * 2048 * 32; i += ngt) {
        const int l = i / (2048 * 32), r = i % (2048 * 32), n = r / 32, k8 = (r % 32) * 8;
        const int h = n >> 8, p = (n >> 7) & 1, key = n & 127, pk = k8 >> 7, kk = k8 & 127;
        u32x4 o = (u32x4){0u, 0u, 0u, 0u};
        if (pk == p) { const float* s = a.in[I_KEYS] + ((((size_t)l * 8 + h) * 2 + p) * 128 + key) * 128 + kk; const f32x4 v0 = *(const f32x4*)s, v1 = *(const f32x4*)(s + 4); o = pack8(v0, v1); }
        *(u32x4*)((bf16*)(ws + WS_KEYS) + ((size_t)l * 2048 + n) * 256 + k8) = o;
    }
    for (int t = 0; t < 2; ++t) {
        const float* src = a.in[t == 0 ? I_PU : I_PV]; unsigned char* dst = ws + (t == 0 ? WS_UB : WS_VB); float* scl = (float*)(ws + (t == 0 ? WS_USC : WS_VSC));
        for (int row0 = 4 * C.gw; row0 < DEPTH * NEXP; row0 += 4 * C.ngw) {
            f32x4 v[4][4]; float am[4];
#pragma unroll
            for (int r = 0; r < 4; ++r)
#pragma unroll
                for (int q = 0; q < 4; ++q) v[r][q] = *(const f32x4*)(src + (size_t)(row0 + r) * D + 16 * C.lane + 4 * q);
#pragma unroll
            for (int r = 0; r < 4; ++r) { float m = 0.f;
#pragma unroll
                for (int q = 0; q < 4; ++q) m = fmaxf(m, fmaxf(fmaxf(fabsf(v[r][q].x), fabsf(v[r][q].y)), fmaxf(fabsf(v[r][q].z), fabsf(v[r][q].w))));
                am[r] = wave_max(m); }
#pragma unroll
            for (int r = 0; r < 4; ++r) { const float inv = am[r] > 0.f ? 127.f / am[r] : 0.f; u32x4 w; const int row = row0 + r;
#pragma unroll
                for (int q = 0; q < 4; ++q) w[q] = ((unsigned)(int)rintf(v[r][q].x * inv) & 255u) | (((unsigned)(int)rintf(v[r][q].y * inv) & 255u) << 8) | (((unsigned)(int)rintf(v[r][q].z * inv) & 255u) << 16) | ((unsigned)(int)rintf(v[r][q].w * inv) << 24);
                { const int lyr = row / NEXP, e = row % NEXP; *(u32x4*)(dst + (((size_t)lyr * 8 + (C.lane >> 3)) * NEXP + e) * 128 + 16 * (C.lane & 7)) = w; }
                if (C.lane == 0) scl[row] = am[r] * (1.f / 127.f); }
        }
    }
    for (int it = gt; it < 32 * 3072; it += ngt) {
        const int ks = it / 3072, cg = it % 3072, l = cg / 1536, n4 = (cg % 1536) * 4;
        f32x4 a0 = (f32x4){0.f, 0.f, 0.f, 0.f}, a1 = a0;
        const float* wp = a.in[I_ADAW] + ((size_t)l * D + ks * 32) * NMODV + n4; const float* c0 = a.in[I_C] + ks * 32; const float* c1 = c0 + D;
#pragma unroll 8
        for (int kk = 0; kk < 32; ++kk) { const f32x4 w = *(const f32x4*)(wp + (size_t)kk * NMODV); const float x0 = c0[kk], x1 = c1[kk]; a0 += w * (x0 * sigm(x0)); a1 += w * (x1 * sigm(x1)); }
        float* mp = (float*)(ws + WS_MODP) + (((size_t)ks * 2 + l) * 2) * NMODV + n4;
        *(f32x4*)mp = a0; *(f32x4*)(mp + NMODV) = a1;
    }
}
__device__ __forceinline__ void phase_modreduce(const Ctx& C, const Args& a) {
    const int gt = C.blk * NTHREADS + C.tid, ngt = C.nblk * NTHREADS;
    for (int i = gt; i < 2 * 2 * NMODV; i += ngt) {
        const int l = i / (2 * NMODV), n = i % NMODV; float s = a.in[I_ADAB][(size_t)l * NMODV + n];
        const float* mp = (const float*)(a.ws + WS_MODP) + i;
        for (int ks = 0; ks < 32; ++ks) s += mp[(size_t)ks * 4 * NMODV];
        ((float*)(a.ws + WS_MOD))[i] = s;
    }
}
__device__ __forceinline__ const float* modp(const Args& a, int l, int b, int v) { return (const float*)(a.ws + WS_MOD) + ((size_t)l * 2 + b) * NMODV + v * D; }

__device__ __forceinline__ void normmod_row(const f32x4 (&x)[4], const float* g, const float* sh, const float* sc, int lane, f32x4 (&h)[4]) {
    float s = 0.f;
#pragma unroll
    for (int j = 0; j < 4; ++j) s += (x[j].x * x[j].x + x[j].y * x[j].y) + (x[j].z * x[j].z + x[j].w * x[j].w);
    const float rstd = 1.f / sqrtf(wave_sum(s) * (1.f / D) + EPS);
#pragma unroll
    for (int j = 0; j < 4; ++j) { const int c = 4 * lane + 256 * j; const f32x4 gv = *(const f32x4*)(g + c), shv = *(const f32x4*)(sh + c), scv = *(const f32x4*)(sc + c);
        h[j] = (x[j] * rstd) * gv * (scv + 1.f) + shv; }
}
__device__ __forceinline__ void store_row_bf16(bf16* row, const f32x4 (&h)[4], int lane) {
#pragma unroll
    for (int j = 0; j < 4; ++j) { u32x2 w; w.x = pk2(h[j].x, h[j].y); w.y = pk2(h[j].z, h[j].w); *(u32x2*)(row + 4 * lane + 256 * j) = w; }
}
__device__ __forceinline__ void phase_norm(const Ctx& C, const Args& a, const float* X, const float* g, int l, int vsh, int vsc, float* hsc) {
    bf16* H = (bf16*)(a.ws + WS_H);
    for (int m = C.gw; m < M; m += C.ngw) {
        const int b = m >> 13; f32x4 x[4], h[4];
#pragma unroll
        for (int j = 0; j < 4; ++j) x[j] = *(const f32x4*)(X + (size_t)m * D + 4 * C.lane + 256 * j);
        normmod_row(x, g, modp(a, l, b, vsh), modp(a, l, b, vsc), C.lane, h);
        store_row_bf16(H + (size_t)m * D, h, C.lane);
        if (hsc) { float am = 0.f;
#pragma unroll
            for (int j = 0; j < 4; ++j) { const unsigned w0 = pk2(h[j].x, h[j].y), w1 = pk2(h[j].z, h[j].w); am = fmaxf(am, fmaxf(fmaxf(fabsf(bflo(w0)), fabsf(bfhi(w0))), fmaxf(fabsf(bflo(w1)), fabsf(bfhi(w1))))); }
            am = wave_max(am); if (C.lane == 0) hsc[m] = am * (1.f / 127.f); }
    }
}

struct EpiIn {
    const float* bin; const float* bp; bf16 *UG, *ZP, *G;
    __device__ __forceinline__ void apply(int row, int pn, int cl8, f32x4 a0, f32x4 a1, f32x4 b0, f32x4 b1) const {
        if (pn < 8) {
            const int c = 128 * pn + cl8;
            a0 += *(const f32x4*)(bin + c); a1 += *(const f32x4*)(bin + c + 4); b0 += *(const f32x4*)(bin + 1024 + c); b1 += *(const f32x4*)(bin + 1024 + c + 4);
            f32x4 u0, u1;
#pragma unroll
            for (int i = 0; i < 4; ++i) { u0[i] = a0[i] * sigm(b0[i]); u1[i] = a1[i] * sigm(b1[i]); }
            *(u32x4*)(UG + (size_t)row * D + c) = pack8(u0, u1);
        } else if (pn < 12) {
            const int c = 256 * (pn - 8) + cl8;
            a0 += *(const f32x4*)(bp + c); a1 += *(const f32x4*)(bp + c + 4); b0 += *(const f32x4*)(bp + 128 + c); b1 += *(const f32x4*)(bp + 128 + c + 4);
            *(u32x4*)(ZP + (size_t)row * D + c) = pack8(a0, a1); *(u32x4*)(ZP + (size_t)row * D + c + 128) = pack8(b0, b1);
        } else {
            const int c = 256 * (pn - 12) + cl8;
            a0 += *(const f32x4*)(bin + 3072 + c); a1 += *(const f32x4*)(bin + 3072 + c + 4); b0 += *(const f32x4*)(bin + 3072 + 128 + c); b1 += *(const f32x4*)(bin + 3072 + 128 + c + 4);
#pragma unroll
            for (int i = 0; i < 4; ++i) { a0[i] = sigm(a0[i]); a1[i] = sigm(a1[i]); b0[i] = sigm(b0[i]); b1[i] = sigm(b1[i]); }
            *(u32x4*)(G + (size_t)row * 2048 + c) = pack8(a0, a1); *(u32x4*)(G + (size_t)row * 2048 + c + 128) = pack8(b0, b1);
        }
    }
};
struct EpiConv {
    const bf16* G; const bf16* PLp; const float* scale; bf16* Y;
    __device__ __forceinline__ void apply(int row, int pn, int cl8, f32x4 a0, f32x4 a1, f32x4 b0, f32x4 b1) const {
        const int c = 256 * pn + cl8; f32x4 g0, g1, h0, h1, t0, t1;
        unpack8(*(const u32x4*)(G + (size_t)row * 2048 + c), g0, g1); unpack8(*(const u32x4*)(G + (size_t)row * 2048 + 1024 + c), h0, h1); unpack8(*(const u32x4*)(PLp + (size_t)row * D + c), t0, t1);
        *(u32x4*)(Y + (size_t)row * D + c) = pack8(a0 * g0 + h0 * *(const f32x4*)(scale + c) * t0, a1 * g1 + h1 * *(const f32x4*)(scale + c + 4) * t1);
        unpack8(*(const u32x4*)(G + (size_t)row * 2048 + c + 128), g0, g1); unpack8(*(const u32x4*)(G + (size_t)row * 2048 + 1024 + c + 128), h0, h1); unpack8(*(const u32x4*)(PLp + (size_t)row * D + c + 128), t0, t1);
        *(u32x4*)(Y + (size_t)row * D + c + 128) = pack8(b0 * g0 + h0 * *(const f32x4*)(scale + c + 128) * t0, b1 * g1 + h1 * *(const f32x4*)(scale + c + 132) * t1);
    }
};
struct EpiOut {
    const float* xold; float* xnew; const float* g1;   const float* bout;
    __device__ __forceinline__ void apply(int row, int pn, int cl8, f32x4 a0, f32x4 a1, f32x4 b0, f32x4 b1) const {
        const int c = 256 * pn + cl8; const float* g = g1 + (size_t)(row >> 13) * NMODV; const size_t o = (size_t)row * D + c;
        *(f32x4*)(xnew + o) = *(const f32x4*)(xold + o) + *(const f32x4*)(g + c) * (a0 + *(const f32x4*)(bout + c));
        *(f32x4*)(xnew + o + 4) = *(const f32x4*)(xold + o + 4) + *(const f32x4*)(g + c + 4) * (a1 + *(const f32x4*)(bout + c + 4));
        *(f32x4*)(xnew + o + 128) = *(const f32x4*)(xold + o + 128) + *(const f32x4*)(g + c + 128) * (b0 + *(const f32x4*)(bout + c + 128));
        *(f32x4*)(xnew + o + 132) = *(const f32x4*)(xold + o + 132) + *(const f32x4*)(g + c + 132) * (b1 + *(const f32x4*)(bout + c + 132));
    }
};
struct EpiQ {
    bf16* Q;
    __device__ __forceinline__ void apply(int row, int pn, int cl8, f32x4 a0, f32x4 a1, f32x4 b0, f32x4 b1) const {
        const size_t o = (size_t)row * DQ + 256 * pn + cl8; *(u32x4*)(Q + o) = pack8(a0, a1); *(u32x4*)(Q + o + 128) = pack8(b0, b1);
    }
};
struct EpiWT {
    bf16* W;
    __device__ __forceinline__ void apply(int row, int pn, int cl8, f32x4 a0, f32x4 a1, f32x4 b0, f32x4 b1) const {
        const size_t o = (size_t)row * D + 256 * pn + cl8; *(u32x4*)(W + o) = pack8(a0, a1); *(u32x4*)(W + o + 128) = pack8(b0, b1);
    }
};
struct EpiS {
    float* S;
    __device__ __forceinline__ void apply(int row, int pn, int cl8, f32x4 a0, f32x4 a1, f32x4 b0, f32x4 b1) const {
        const size_t o = (size_t)row * DQ + 256 * pn + cl8; *(f32x4*)(S + o) = a0; *(f32x4*)(S + o + 4) = a1; *(f32x4*)(S + o + 128) = b0; *(f32x4*)(S + o + 132) = b1;
    }
};

namespace pg8 {
#define PG8_LAS __attribute__((address_space(3)))
typedef unsigned short bf16_t;
typedef short bf16x8 __attribute__((ext_vector_type(8)));
typedef float f32x4 __attribute__((ext_vector_type(4)));
typedef unsigned u32x4 __attribute__((ext_vector_type(4)));
constexpr int BM = 256, BK = 64, HALF = 128, HTB = HALF * BK * 2  , STAGE_BYTES = 8 * HTB, NXCD = 8, WGM = 8;

__host__ __device__ __forceinline__ int lds_byte(int r, int c) { const int st = (r >> 4) * 2 + (c >> 5), rr = r & 15, cc = c & 31, ob = rr * 64 + cc * 2; return st * 1024 + (ob ^ (((ob >> 9) & 1) << 5)); }
__host__ __device__ __forceinline__ void stage_rc(int b, int& R, int& C) { const int st = b / 1024, sb = b % 1024, swz = sb ^ (((sb >> 9) & 1) << 5); R = (st >> 1) * 16 + swz / 64; C = (st & 1) * 32 + (swz % 64) / 2; }
__host__ __device__ __forceinline__ int perm32(int rho) { const int n = rho >> 4, i = rho & 15; return 8 * (i >> 2) + 4 * n + (i & 3); }

struct Unit { int pm, pn; };
struct Gemm { const bf16_t* A; const bf16_t* Bt; int M, N, K, lda, ldb, acol, bcol; };

struct StaticOrder {
    int nM, nN, nwg, G, c;
    __host__ __device__ void init(int M, int N, int G_, int c_) { nM = M / BM; nN = N / BM; nwg = nM * nN; G = G_; c = c_; }
    __host__ __device__ bool next(int i, Unit& u) const {
        const long L = (long)i * G + c; if (L >= nwg) return false;
        int wgid = (int)L; { const int q = nwg / NXCD, r = nwg % NXCD, xcd = wgid % NXCD, off = wgid / NXCD; wgid = (xcd < r ? xcd * (q + 1) : r * (q + 1) + (xcd - r) * q) + off; }
        const int nig = WGM * nN, gid = wgid / nig, fm = gid * WGM, gsz = (nM - fm) < WGM ? (nM - fm) : WGM;
        u.pm = fm + ((wgid % nig) % gsz); u.pn = (wgid % nig) / gsz; return true;
    }
    __device__ __forceinline__ void a_ready(const Unit&) const {}
    __device__ __forceinline__ void done(const Unit&) const {}
};


template <class Epi, class Sched, bool ALIGN_EPI = false, bool SP2 = false>
__device__ __forceinline__ void gemm_phase(PG8_LAS unsigned char* lds, const Gemm g, const Sched& S, const Epi& E, const int tid) {
    const int wid = __builtin_amdgcn_readfirstlane(tid >> 6), lane = tid & 63, wr = wid >> 2, wc = wid & 3, fr = lane & 15, fq = lane >> 4;
    const int K = g.K, nt = K / BK;
    unsigned voffA[2], voffB[2];
#pragma unroll
    for (int i = 0; i < 2; ++i) { int R, C; stage_rc(tid * 16 + i * 8192, R, C); const int Rb = Epi::PERM ? ((R & ~31) + perm32(R & 31)) : R;
        voffA[i] = (unsigned)(R * g.lda + C) * 2u; voffB[i] = (unsigned)(Rb * g.ldb + C) * 2u; }
    const size_t kstep = (size_t)(BK * 2);
    const size_t hstepA = (size_t)HALF * g.lda * 2, hstepB = (size_t)HALF * g.ldb * 2;
    const size_t tstepA = 2 * hstepA, tstepB = 2 * hstepB, acolb = (size_t)g.acol * 2, bcolb = (size_t)g.bcol * 2;
    const unsigned ldsw = (unsigned)wid * 1024u;
    const int aoff = lds_byte(wr * 64 + fr, fq * 8), boff = lds_byte(wc * 32 + fr, fq * 8);
#define PG8_SA(b, h) (((b) * 2 + (h)) * HTB)
#define PG8_SB(b, h) ((4 + (b) * 2 + (h)) * HTB)
#define PG8_STAGE(bufoff, gbase, voff) do { _Pragma("unroll") for (int _i = 0; _i < 2; ++_i) \
        __builtin_amdgcn_global_load_lds((const unsigned*)((const char*)(gbase) + (voff)[_i]), (PG8_LAS unsigned*)(lds + (bufoff) + ldsw + _i * 8192), 16, 0, 0); } while (0)
#define PG8_LDA(dst, b, h) do { _Pragma("unroll") for (int m = 0; m < 4; ++m) _Pragma("unroll") for (int k = 0; k < 2; ++k) dst[m][k] = *(const PG8_LAS bf16x8*)(lds + PG8_SA(b, h) + aoff + m * 2048 + k * 1024); } while (0)
#define PG8_LDB(dst, b, h) do { _Pragma("unroll") for (int n = 0; n < 2; ++n) _Pragma("unroll") for (int k = 0; k < 2; ++k) dst[n][k] = *(const PG8_LAS bf16x8*)(lds + PG8_SB(b, h) + boff + n * 2048 + k * 1024); } while (0)
#define PG8_MMA(ai, bj, At, Bt) do { __builtin_amdgcn_s_setprio(1); _Pragma("unroll") for (int m = 0; m < 4; ++m) _Pragma("unroll") for (int n = 0; n < 2; ++n) _Pragma("unroll") for (int k = 0; k < 2; ++k) \
        acc[ai][bj][m][n] = __builtin_amdgcn_mfma_f32_16x16x32_bf16(Bt[n][k], At[m][k], acc[ai][bj][m][n], 0, 0, 0); __builtin_amdgcn_s_setprio(0); } while (0)
#define PG8_WAIT_V(n) asm volatile("s_waitcnt vmcnt(" #n ")" ::: "memory")
#define PG8_WAIT_L(n) asm volatile("s_waitcnt lgkmcnt(" #n ")" ::: "memory")
#define PG8_BAR __builtin_amdgcn_s_barrier()
#define PG8_SCHED __builtin_amdgcn_sched_barrier(0)
    Unit cur, nxt; int ui = 0;
    if (!S.next(0, cur)) return;
    f32x4 acc[2][2][4][2];
#pragma unroll
    for (int a = 0; a < 2; ++a)
#pragma unroll
        for (int b = 0; b < 2; ++b)
#pragma unroll
            for (int m = 0; m < 4; ++m)
#pragma unroll
                for (int n = 0; n < 2; ++n) acc[a][b][m][n] = (f32x4){0.f, 0.f, 0.f, 0.f};
    bf16x8 At[4][2], B0[2][2], B1[2][2];
    const char* cA = (const char*)g.A + (size_t)cur.pm * tstepA + (size_t)cur.pn * acolb; const char* cB = (const char*)g.Bt + (size_t)cur.pn * tstepB + (size_t)cur.pm * bcolb;
    S.a_ready(cur);
    if constexpr (SP2) {
        PG8_STAGE(PG8_SB(0, 0), cB, voffB); PG8_STAGE(PG8_SB(0, 1), cB + hstepB, voffB); PG8_STAGE(PG8_SA(0, 0), cA, voffA); PG8_STAGE(PG8_SA(0, 1), cA + hstepA, voffA);
        if (wr == 1) PG8_BAR;
        PG8_WAIT_V(2); PG8_BAR;
        PG8_STAGE(PG8_SB(1, 0), cB + kstep, voffB); PG8_STAGE(PG8_SA(1, 0), cA + kstep, voffA); PG8_STAGE(PG8_SB(1, 1), cB + hstepB + kstep, voffB);
        PG8_WAIT_V(6); PG8_BAR;
    } else {
        PG8_STAGE(PG8_SB(0, 0), cB, voffB); PG8_STAGE(PG8_SA(0, 0), cA, voffA); PG8_STAGE(PG8_SB(0, 1), cB + hstepB, voffB); PG8_STAGE(PG8_SA(0, 1), cA + hstepA, voffA);
        if (wr == 1) PG8_BAR;
        PG8_WAIT_V(4); PG8_BAR;
        PG8_STAGE(PG8_SB(1, 0), cB + kstep, voffB); PG8_STAGE(PG8_SA(1, 0), cA + kstep, voffA); PG8_STAGE(PG8_SB(1, 1), cB + hstepB + kstep, voffB);
        PG8_WAIT_V(6); PG8_BAR;
    }
    for (;;) {
        const bool has_next = S.next(ui + 1, nxt);
        const char* nA = has_next ? (const char*)g.A + (size_t)nxt.pm * tstepA + (size_t)nxt.pn * acolb : cA; const char* nB = has_next ? (const char*)g.Bt + (size_t)nxt.pn * tstepB + (size_t)nxt.pm * bcolb : cB;
#pragma nounroll
        for (int t = 0; t < nt; t += 2) {
            const bool last = (t == nt - 2);
            const char* a1 = cA + (size_t)(t + 1) * kstep;
            const char* a2 = last ? nA : cA + (size_t)(t + 2) * kstep; const char* b2 = last ? nB : cB + (size_t)(t + 2) * kstep;
            const char* a3 = a2 + kstep; const char* b3 = b2 + kstep;
            if (last && has_next) S.a_ready(nxt);
            if constexpr (SP2) {
            PG8_LDB(B0, 0, 0); PG8_LDB(B1, 0, 1); PG8_SCHED; PG8_LDA(At, 0, 0); PG8_STAGE(PG8_SA(1, 1), a1 + hstepA, voffA);
            PG8_WAIT_V(8); PG8_WAIT_L(0); PG8_BAR; PG8_MMA(0, 0, At, B0); PG8_MMA(0, 1, At, B1); PG8_BAR; PG8_SCHED;
            PG8_LDA(At, 0, 1); PG8_STAGE(PG8_SB(0, 0), b2, voffB); PG8_STAGE(PG8_SB(0, 1), b2 + hstepB, voffB); PG8_STAGE(PG8_SA(0, 0), a2, voffA);
            PG8_WAIT_V(8); PG8_WAIT_L(0); PG8_BAR; PG8_MMA(1, 0, At, B0); PG8_MMA(1, 1, At, B1); PG8_BAR; PG8_SCHED;
            PG8_LDB(B0, 1, 0); PG8_LDB(B1, 1, 1); PG8_SCHED; PG8_LDA(At, 1, 0); PG8_STAGE(PG8_SA(0, 1), a2 + hstepA, voffA);
            PG8_WAIT_V(8); PG8_WAIT_L(0); PG8_BAR; PG8_MMA(0, 0, At, B0); PG8_MMA(0, 1, At, B1); PG8_BAR; PG8_SCHED;
            PG8_LDA(At, 1, 1); PG8_STAGE(PG8_SB(1, 0), b3, voffB); PG8_STAGE(PG8_SB(1, 1), b3 + hstepB, voffB); PG8_STAGE(PG8_SA(1, 0), a3, voffA);
            PG8_WAIT_V(8); PG8_WAIT_L(0); PG8_BAR; PG8_MMA(1, 0, At, B0); PG8_MMA(1, 1, At, B1); PG8_BAR; PG8_SCHED;
            } else {
            PG8_LDB(B0, 0, 0); PG8_SCHED; PG8_LDA(At, 0, 0); PG8_STAGE(PG8_SA(1, 1), a1 + hstepA, voffA);
            PG8_WAIT_L(8); PG8_BAR; PG8_WAIT_L(0); PG8_MMA(0, 0, At, B0); PG8_BAR; PG8_SCHED;
            PG8_LDB(B1, 0, 1); PG8_STAGE(PG8_SB(0, 0), b2, voffB);
            PG8_BAR; PG8_WAIT_L(0); PG8_MMA(0, 1, At, B1); PG8_BAR;
            PG8_LDA(At, 0, 1); PG8_STAGE(PG8_SA(0, 0), a2, voffA);
            PG8_BAR; PG8_WAIT_L(0); PG8_MMA(1, 0, At, B0); PG8_BAR; PG8_SCHED;
            PG8_STAGE(PG8_SB(0, 1), b2 + hstepB, voffB);
            PG8_WAIT_V(6); PG8_BAR; PG8_MMA(1, 1, At, B1); PG8_BAR;
            PG8_LDB(B0, 1, 0); PG8_SCHED; PG8_LDA(At, 1, 0); PG8_STAGE(PG8_SA(0, 1), a2 + hstepA, voffA);
            PG8_WAIT_L(8); PG8_BAR; PG8_WAIT_L(0); PG8_MMA(0, 0, At, B0); PG8_BAR; PG8_SCHED;
            PG8_LDB(B1, 1, 1); PG8_STAGE(PG8_SB(1, 0), b3, voffB);
            PG8_BAR; PG8_WAIT_L(0); PG8_MMA(0, 1, At, B1); PG8_BAR;
            PG8_LDA(At, 1, 1); PG8_STAGE(PG8_SA(1, 0), a3, voffA);
            PG8_BAR; PG8_WAIT_L(0); PG8_MMA(1, 0, At, B0); PG8_BAR; PG8_SCHED;
            PG8_STAGE(PG8_SB(1, 1), b3 + hstepB, voffB);
            PG8_WAIT_V(6); PG8_BAR; PG8_MMA(1, 1, At, B1); PG8_BAR;
            }
        }
        if constexpr (ALIGN_EPI) { if (wr == 0) PG8_BAR; }
        if constexpr (!Epi::AFTER_DRAIN) { E(acc, cur, wr, wc, fr, fq); S.done(cur); }
        if (!has_next) break;
#pragma unroll
        for (int a = 0; a < 2; ++a)
#pragma unroll
            for (int b = 0; b < 2; ++b)
#pragma unroll
                for (int m = 0; m < 4; ++m)
#pragma unroll
                    for (int n = 0; n < 2; ++n) acc[a][b][m][n] = (f32x4){0.f, 0.f, 0.f, 0.f};
        cur = nxt; cA = nA; cB = nB; ++ui;
        if constexpr (ALIGN_EPI) { if (wr == 1) PG8_BAR; }
    }
    PG8_WAIT_V(0);
    if constexpr (!ALIGN_EPI) { if (wr == 0) PG8_BAR; }
    PG8_BAR;
    if constexpr (Epi::AFTER_DRAIN) { E.fused(acc, cur, wr, wc, fr, fq, lds, wid, lane); S.done(cur); }
#undef PG8_SA
#undef PG8_SB
#undef PG8_STAGE
#undef PG8_LDA
#undef PG8_LDB
#undef PG8_MMA
#undef PG8_WAIT_V
#undef PG8_WAIT_L
#undef PG8_BAR
#undef PG8_SCHED
}

template <class F> struct EpiW {
    static constexpr bool PERM = true, AFTER_DRAIN = false; F f;
    __device__ __forceinline__ void operator()(const f32x4 (&acc)[2][2][4][2], const Unit& u, int wr, int wc, int fr, int fq) const {
#pragma unroll
        for (int ai = 0; ai < 2; ++ai)
#pragma unroll
            for (int m = 0; m < 4; ++m) { f.apply(u.pm * BM + ai * HALF + wr * 64 + m * 16 + fr, u.pn, wc * 32 + 8 * fq, acc[ai][0][m][0], acc[ai][0][m][1], acc[ai][1][m][0], acc[ai][1][m][1]);
                asm volatile("" ::: "memory"); }
    }
};
}

template <class F>
__device__ __forceinline__ void mfma_gemm(const Ctx& C, const bf16* A, int lda, int acol, const bf16* Bt, int ldb, int Mr, int N, int K, const F& f, int bcol = 0, int blk_off = 0) {
    pg8::Gemm g{A, Bt, Mr, N, K, lda, ldb, acol, bcol}; pg8::StaticOrder S; S.init(Mr, N, C.nblk, (C.blk + C.nblk - blk_off) % C.nblk); pg8::EpiW<F> E{f};
    pg8::gemm_phase<pg8::EpiW<F>, pg8::StaticOrder, true, true>(C.lds, g, S, E, C.tid);
}

template <class F>
__device__ __forceinline__ void naive_gemm(const Ctx& C, const bf16* A, int lda, int acol, const bf16* Bt, int ldb, int Mr, int N, int K, const F& f) {
    LAS float* As = (LAS float*)C.lds;
    LAS float* Bs = (LAS float*)(C.lds + 8192);
    const int ntm = Mr / 128, ntn = N / 256, tid = C.tid, cg = tid & 15, r0 = tid >> 4;
    for (int tile = C.blk; tile < ntm * ntn; tile += C.nblk) {
        const int tm = tile / ntn, pn = tile % ntn;
        f32x4 acc[4][4];
#pragma unroll
        for (int i = 0; i < 4; ++i)
#pragma unroll
            for (int j = 0; j < 4; ++j) acc[i][j] = (f32x4){0.f, 0.f, 0.f, 0.f};
        const bf16* ap = A + (size_t)(tm * 128 + (tid >> 2)) * lda + pn * acol + (tid & 3) * 4;
        const bf16* bp = Bt + (size_t)(pn * 256 + (tid >> 1)) * ldb + (tid & 1) * 8;
        for (int k0 = 0; k0 < K; k0 += 16) {
            const u32x2 av = *(const u32x2*)(ap + k0); const u32x4 bv = *(const u32x4*)(bp + k0);
            __syncthreads();
            { const int r = tid >> 2, kq = (tid & 3) * 4; As[(kq + 0) * 128 + r] = bflo(av.x); As[(kq + 1) * 128 + r] = bfhi(av.x); As[(kq + 2) * 128 + r] = bflo(av.y); As[(kq + 3) * 128 + r] = bfhi(av.y); }
            { const int n = tid >> 1, kq = (tid & 1) * 8; Bs[(kq + 0) * 256 + n] = bflo(bv.x); Bs[(kq + 1) * 256 + n] = bfhi(bv.x); Bs[(kq + 2) * 256 + n] = bflo(bv.y); Bs[(kq + 3) * 256 + n] = bfhi(bv.y);
              Bs[(kq + 4) * 256 + n] = bflo(bv.z); Bs[(kq + 5) * 256 + n] = bfhi(bv.z); Bs[(kq + 6) * 256 + n] = bflo(bv.w); Bs[(kq + 7) * 256 + n] = bfhi(bv.w); }
            __syncthreads();
#pragma unroll
            for (int kk = 0; kk < 16; ++kk) {
                const f32x4 b0 = *(const LAS f32x4*)(Bs + kk * 256 + cg * 8), b1 = *(const LAS f32x4*)(Bs + kk * 256 + cg * 8 + 4), b2 = *(const LAS f32x4*)(Bs + kk * 256 + 128 + cg * 8), b3 = *(const LAS f32x4*)(Bs + kk * 256 + 128 + cg * 8 + 4);
#pragma unroll
                for (int i = 0; i < 4; ++i) { const float av1 = As[kk * 128 + r0 + 32 * i]; acc[i][0] += b0 * av1; acc[i][1] += b1 * av1; acc[i][2] += b2 * av1; acc[i][3] += b3 * av1; }
            }
        }
#pragma unroll
        for (int i = 0; i < 4; ++i) f.apply(tm * 128 + r0 + 32 * i, pn, cg * 8, acc[i][0], acc[i][1], acc[i][2], acc[i][3]);
    }
}

template <int NROWS>
__device__ __forceinline__ void cp_stage(LAS unsigned char* tile, const bf16* src, int mrow0, int tfirst, int tid) {
    constexpr int NIT = (NROWS * 128 + NTHREADS - 1) / NTHREADS;
    asm volatile("" : "+v"(tid));
    u32x4 v[NIT];
#pragma unroll
    for (int i = 0; i < NIT; ++i) { const int ch = i * NTHREADS + tid, r = ch >> 7, c = ch & 127; v[i] = (u32x4){0u, 0u, 0u, 0u};
        if (ch < NROWS * 128 && tfirst + r >= 0) v[i] = *(const u32x4*)(src + (size_t)(mrow0 + r) * D + c * 8); }
#pragma unroll
    for (int i = 0; i < NIT; ++i) { const int ch = i * NTHREADS + tid; if (ch < NROWS * 128) *(LAS u32x4*)(tile + ch * 16) = v[i]; }
}
template <int W>
__device__ __forceinline__ void pool_item(const LAS unsigned char* tile, bf16* PL, int m0, int t0, int tid) {
    float p0[47], p1[47];
#pragma unroll
    for (int i = 0; i < 47; ++i) { unsigned w = 0u; if (i >= 15 - (W - 1)) w = *(const LAS unsigned*)(tile + i * 2048 + 4 * tid); p0[i] = bflo(w); p1[i] = bfhi(w); }
#pragma unroll
    for (int ti = 0; ti < 32; ++ti) {
        float s0 = 0.f, s1 = 0.f;
#pragma unroll
        for (int j = 0; j < W; ++j) { s0 += p0[ti + 15 - j]; s1 += p1[ti + 15 - j]; }
        const int cnt = (t0 + ti + 1) < W ? (t0 + ti + 1) : W; const float inv = 1.f / (float)cnt;
        *(unsigned*)(PL + (size_t)(m0 + ti) * D + 2 * tid) = pk2(s0 * inv - p0[ti + 15], s1 * inv - p1[ti + 15]);
    }
}
template <int RI>
__device__ __forceinline__ void conv_row(const LAS unsigned char* tile, int tid, const float (&w0)[31], const float (&w1)[31], float (&a0)[32], float (&a1)[32]) {
    const unsigned w = *(const LAS unsigned*)(tile + RI * 2048 + 4 * tid);
    const float u0 = bflo(w), u1 = bfhi(w);
#pragma unroll
    for (int ti = 0; ti < 32; ++ti) { constexpr int dbase = 30 - RI; const int d = ti + dbase; if (d >= 0 && d <= 30) { a0[ti] += w0[30 - d] * u0; a1[ti] += w1[30 - d] * u1; } }
    if constexpr ((RI & 7) == 7) asm volatile("" ::: "memory");
}
template <int... RI>
__device__ __forceinline__ void conv_rows(const LAS unsigned char* tile, int tid, const float (&w0)[31], const float (&w1)[31], float (&a0)[32], float (&a1)[32], std::integer_sequence<int, RI...>) {
    (conv_row<RI>(tile, tid, w0, w1, a0, a1), ...);
}
__device__ __forceinline__ void phase_convpool(const Ctx& C, const Args& a, int l) {
    const bf16* UG = (const bf16*)(a.ws + WS_UG); const bf16* ZP = (const bf16*)(a.ws + WS_ZP);
    bf16* AC = (bf16*)(a.ws + WS_AC); bf16* PL = (bf16*)(a.ws + WS_PL);
    const float* cw = a.in[I_CONVW] + (size_t)l * CONVK * D; const float* cb = a.in[I_CONVB] + (size_t)l * D;
    const float* lng = a.in[I_LNG] + (size_t)l * D; const float* lnb = a.in[I_LNB] + (size_t)l * D;
    LAS float* red = (LAS float*)C.lds;
    LAS float* stat = (LAS float*)(C.lds + 2048);
    LAS unsigned char* tile = C.lds + 4096;
    int tid = C.tid;
    asm volatile("" : "+v"(tid));
    const int c0 = 2 * tid;
    float w0[31], w1[31];
#pragma unroll
    for (int k = 0; k < 31; ++k) { const f32x2 w = *(const f32x2*)(cw + (size_t)k * D + c0); w0[k] = w.x; w1[k] = w.y; }
    const f32x2 bb = *(const f32x2*)(cb + c0), gg = *(const f32x2*)(lng + c0), be = *(const f32x2*)(lnb + c0);
    for (int item = C.blk; item < M / 32; item += C.nblk) {
        const int m0 = item * 32, t0 = m0 & (SEQ - 1);
        __syncthreads();
        cp_stage<62>(tile, UG, m0 - 30, t0 - 30, tid);
        __syncthreads();
        float a0[32], a1[32];
#pragma unroll
        for (int i = 0; i < 32; ++i) { a0[i] = bb.x; a1[i] = bb.y; }
        conv_rows(tile, tid, w0, w1, a0, a1, std::make_integer_sequence<int, 62>{});
#pragma unroll
        for (int ti = 0; ti < 32; ++ti) {
            const float s = dpp_sum63(a0[ti] + a1[ti]), q = dpp_sum63(a0[ti] * a0[ti] + a1[ti] * a1[ti]);
            if (C.lane == 63) { red[C.wave * 64 + ti] = s; red[C.wave * 64 + 32 + ti] = q; }
        }
        __syncthreads();
        if (tid < 32) { float s = 0.f, q = 0.f;
#pragma unroll
            for (int w = 0; w < 8; ++w) { s += red[w * 64 + tid]; q += red[w * 64 + 32 + tid]; }
            const float mean = s * (1.f / D), var = fmaxf(q * (1.f / D) - mean * mean, 0.f); stat[tid] = mean; stat[32 + tid] = 1.f / sqrtf(var + EPS); }
        __syncthreads();
#pragma unroll
        for (int ti = 0; ti < 32; ++ti) { const float mean = stat[ti], rstd = stat[32 + ti];
            const float y0 = (a0[ti] - mean) * rstd * gg.x + be.x, y1 = (a1[ti] - mean) * rstd * gg.y + be.y;
            *(unsigned*)(AC + (size_t)(m0 + ti) * D + c0) = pk2(y0 * sigm(y0), y1 * sigm(y1)); }
        asm volatile("" ::: "memory");
        cp_stage<47>(tile, ZP, m0 - 15, t0 - 15, tid);
        __syncthreads();
        const int g = tid >> 7;
        if (g == 0) pool_item<2>(tile, PL, m0, t0, tid); else if (g == 1) pool_item<4>(tile, PL, m0, t0, tid); else if (g == 2) pool_item<8>(tile, PL, m0, t0, tid); else pool_item<16>(tile, PL, m0, t0, tid);
    }
}

typedef unsigned u32;
template <int CTRL> __device__ __forceinline__ u32 dppu(u32 x) { return (u32)__builtin_amdgcn_update_dpp(0, (int)x, CTRL, 0xf, 0xf, true); }
constexpr int DPP_XOR1 = 0xB1, DPP_REV4 = 0x1B, DPP_DUPE = 0xA0, DPP_DUPO = 0xF5, DPP_HMIRROR = 0x141, DPP_MIRROR = 0x140;
__device__ __forceinline__ u32 umax_(u32 a, u32 b) { return a > b ? a : b; }
__device__ __forceinline__ u32 umin_(u32 a, u32 b) { return a < b ? a : b; }
#define TK_CE(x, i, j) do { const u32 hi_ = umax_(x[i], x[j]), lo_ = umin_(x[i], x[j]); x[i] = hi_; x[j] = lo_; } while (0)
__device__ __forceinline__ void tk_local_merge(u32 (&x)[8]) {
    TK_CE(x, 0, 4); TK_CE(x, 1, 5); TK_CE(x, 2, 6); TK_CE(x, 3, 7);
    TK_CE(x, 0, 2); TK_CE(x, 1, 3); TK_CE(x, 4, 6); TK_CE(x, 5, 7);
    TK_CE(x, 0, 1); TK_CE(x, 2, 3); TK_CE(x, 4, 5); TK_CE(x, 6, 7);
}
template <int CTRL> __device__ __forceinline__ void tk_level(u32 (&x)[8], bool even) {
    u32 t[8];
#pragma unroll
    for (int c = 0; c < 8; ++c) t[c] = dppu<CTRL>(x[7 - c]);
#pragma unroll
    for (int c = 0; c < 8; ++c) x[c] = umax_(x[c], t[c]);
#pragma unroll
    for (int c = 0; c < 8; ++c) { const u32 p = dppu<DPP_XOR1>(x[c]); x[c] = even ? umax_(x[c], p) : umin_(x[c], p); }
    tk_local_merge(x);
}
__device__ __forceinline__ void tk_top16(u32 (&x)[8], bool even) {
    TK_CE(x, 0, 1); TK_CE(x, 2, 3); TK_CE(x, 4, 5); TK_CE(x, 6, 7);
    TK_CE(x, 0, 2); TK_CE(x, 1, 3); TK_CE(x, 4, 6); TK_CE(x, 5, 7);
    TK_CE(x, 1, 2); TK_CE(x, 5, 6);
    TK_CE(x, 0, 4); TK_CE(x, 1, 5); TK_CE(x, 2, 6); TK_CE(x, 3, 7);
    TK_CE(x, 2, 4); TK_CE(x, 3, 5);
    TK_CE(x, 1, 2); TK_CE(x, 3, 4); TK_CE(x, 5, 6);
    { u32 t[8];
#pragma unroll
      for (int c = 0; c < 8; ++c) t[c] = dppu<DPP_XOR1>(x[7 - c]);
#pragma unroll
      for (int c = 0; c < 8; ++c) x[c] = even ? umax_(x[c], t[c]) : umin_(x[c], t[c]); }
    tk_local_merge(x);
    tk_level<DPP_REV4>(x, even); tk_level<DPP_HMIRROR>(x, even); tk_level<DPP_MIRROR>(x, even);
}
__device__ __forceinline__ u32 tk_f2key(float v, int slot) { const u32 u = __builtin_bit_cast(u32, v); const u32 k = u ^ ((u32)((int)u >> 31) | 0x80000000u); return (k & ~127u) | (u32)(127 - slot); }
__device__ __forceinline__ float tk_key2f(u32 k) { k &= ~127u; const u32 m = (u32)((int)k >> 31); return __builtin_bit_cast(float, k ^ (~m | 0x80000000u)); }
__device__ __forceinline__ u32 tk_sel8v(u32 r0, u32 r1, u32 r2, u32 r3, u32 r4, u32 r5, u32 r6, u32 r7, int idx) {
    const bool b0 = idx & 1, b1 = idx & 2, b2 = idx & 4;
    const u32 s01 = b0 ? r1 : r0, s23 = b0 ? r3 : r2, s45 = b0 ? r5 : r4, s67 = b0 ? r7 : r6;
    const u32 s03 = b1 ? s23 : s01, s47 = b1 ? s67 : s45;
    return b2 ? s47 : s03; }
#define tk_sel8(r, idx) tk_sel8v(r[0], r[1], r[2], r[3], r[4], r[5], r[6], r[7], idx)
__device__ __forceinline__ void tk2_sort16(u32 (&x)[16]) { TK_CE(x, 0, 1); TK_CE(x, 2, 3); TK_CE(x, 0, 2); TK_CE(x, 1, 3); TK_CE(x, 1, 2); TK_CE(x, 4, 5); TK_CE(x, 6, 7); TK_CE(x, 4, 6); TK_CE(x, 5, 7); TK_CE(x, 5, 6); TK_CE(x, 0, 4); TK_CE(x, 2, 6); TK_CE(x, 2, 4); TK_CE(x, 1, 5); TK_CE(x, 3, 7); TK_CE(x, 3, 5); TK_CE(x, 1, 2); TK_CE(x, 3, 4); TK_CE(x, 5, 6); TK_CE(x, 8, 9); TK_CE(x, 10, 11); TK_CE(x, 8, 10); TK_CE(x, 9, 11); TK_CE(x, 9, 10); TK_CE(x, 12, 13); TK_CE(x, 14, 15); TK_CE(x, 12, 14); TK_CE(x, 13, 15); TK_CE(x, 13, 14); TK_CE(x, 8, 12); TK_CE(x, 10, 14); TK_CE(x, 10, 12); TK_CE(x, 9, 13); TK_CE(x, 11, 15); TK_CE(x, 11, 13); TK_CE(x, 9, 10); TK_CE(x, 11, 12); TK_CE(x, 13, 14); TK_CE(x, 0, 8); TK_CE(x, 4, 12); TK_CE(x, 4, 8); TK_CE(x, 2, 10); TK_CE(x, 6, 14); TK_CE(x, 6, 10); TK_CE(x, 2, 4); TK_CE(x, 6, 8); TK_CE(x, 10, 12); TK_CE(x, 1, 9); TK_CE(x, 5, 13); TK_CE(x, 5, 9); TK_CE(x, 3, 11); TK_CE(x, 7, 15); TK_CE(x, 7, 11); TK_CE(x, 3, 5); TK_CE(x, 7, 9); TK_CE(x, 11, 13); TK_CE(x, 1, 2); TK_CE(x, 3, 4); TK_CE(x, 5, 6); TK_CE(x, 7, 8); TK_CE(x, 9, 10); TK_CE(x, 11, 12); TK_CE(x, 13, 14); }
__device__ __forceinline__ void tk2_merge16(u32 (&x)[16]) { TK_CE(x, 0, 8); TK_CE(x, 1, 9); TK_CE(x, 2, 10); TK_CE(x, 3, 11); TK_CE(x, 4, 12); TK_CE(x, 5, 13); TK_CE(x, 6, 14); TK_CE(x, 7, 15); TK_CE(x, 0, 4); TK_CE(x, 1, 5); TK_CE(x, 2, 6); TK_CE(x, 3, 7); TK_CE(x, 8, 12); TK_CE(x, 9, 13); TK_CE(x, 10, 14); TK_CE(x, 11, 15); TK_CE(x, 0, 2); TK_CE(x, 1, 3); TK_CE(x, 4, 6); TK_CE(x, 5, 7); TK_CE(x, 8, 10); TK_CE(x, 9, 11); TK_CE(x, 12, 14); TK_CE(x, 13, 15); TK_CE(x, 0, 1); TK_CE(x, 2, 3); TK_CE(x, 4, 5); TK_CE(x, 6, 7); TK_CE(x, 8, 9); TK_CE(x, 10, 11); TK_CE(x, 12, 13); TK_CE(x, 14, 15); }
template <int CTRL> __device__ __forceinline__ void tk2_level(u32 (&x)[16]) {
    u32 t[16];
#pragma unroll
    for (int c = 0; c < 16; ++c) t[c] = dppu<CTRL>(x[15 - c]);
#pragma unroll
    for (int c = 0; c < 16; ++c) x[c] = umax_(x[c], t[c]);
    tk2_merge16(x);
}
__device__ __forceinline__ void tk2_top16(u32 (&x)[16]) { tk2_sort16(x); tk2_level<DPP_XOR1>(x); tk2_level<DPP_REV4>(x); tk2_level<DPP_HMIRROR>(x); }
__device__ __forceinline__ u32 tk_sel16v(u32 r0, u32 r1, u32 r2, u32 r3, u32 r4, u32 r5, u32 r6, u32 r7, u32 r8, u32 r9, u32 r10, u32 r11, u32 r12, u32 r13, u32 r14, u32 r15, int idx) {
    const u32 lo = tk_sel8v(r0, r1, r2, r3, r4, r5, r6, r7, idx & 7), hi = tk_sel8v(r8, r9, r10, r11, r12, r13, r14, r15, idx & 7); return (idx & 8) ? hi : lo; }
__device__ __forceinline__ void phase_topk(const Ctx& C, const Args& a) {
    const float* S = (const float*)(a.ws + WS_S); int* EID = (int*)(a.ws + WS_EID); float* GW = (float*)(a.ws + WS_GW);
    const int lane = C.lane, r = lane & 7, q = lane >> 3;
    pg8::StaticOrder SO; SO.init(M, DQ, C.nblk, C.blk); pg8::Unit un;
    for (int ui = 0; SO.next(ui, un); ++ui)
    for (int wi = C.wave; wi < 32; wi += NWAVES) {
        const int tok = un.pm * 256 + wi * 8 + q, h = un.pn;
        u32 xa[16], xb[16];
        { const float* sp = S + (size_t)tok * DQ + h * 256 + 16 * r;
#pragma unroll
          for (int c4 = 0; c4 < 4; ++c4) { const f32x4 v = *(const f32x4*)(sp + 4 * c4), w = *(const f32x4*)(sp + 128 + 4 * c4);
#pragma unroll
            for (int c = 0; c < 4; ++c) { xa[4 * c4 + c] = tk_f2key(v[c], 16 * r + 4 * c4 + c); xb[4 * c4 + c] = tk_f2key(w[c], 16 * r + 4 * c4 + c); } } }
        tk2_top16(xa); tk2_top16(xb);
        float va[16], vb[16];
#pragma unroll
        for (int c = 0; c < 16; ++c) { va[c] = tk_key2f(xa[c]); vb[c] = tk_key2f(xb[c]); }
        const float b_lane = __builtin_bit_cast(float, tk_sel8v(__builtin_bit_cast(u32, vb[0]), __builtin_bit_cast(u32, vb[1]), __builtin_bit_cast(u32, vb[2]), __builtin_bit_cast(u32, vb[3]),
                                                               __builtin_bit_cast(u32, vb[4]), __builtin_bit_cast(u32, vb[5]), __builtin_bit_cast(u32, vb[6]), __builtin_bit_cast(u32, vb[7]), r));
        u32 ck[16];
#pragma unroll
        for (int c = 0; c < 16; ++c) { constexpr int lim[8] = {7, 7, 4, 3, 2, 1, 1, 1};
            float v; bool valid;
            if (c < 8) { v = va[c] + b_lane; valid = r <= lim[c & 7]; } else { v = (r == 0) ? va[c] + vb[0] : va[0] + vb[c]; valid = r <= 1; }
            ck[c] = valid ? tk_f2key(v, 8 * c + r) : 0u; }
        tk2_top16(ck);
        const u32 a_l0 = tk_sel8v(xa[0], xa[1], xa[2], xa[3], xa[4], xa[5], xa[6], xa[7], r), a_l1 = tk_sel8v(xa[8], xa[9], xa[10], xa[11], xa[12], xa[13], xa[14], xa[15], r);
        const u32 b_l0 = tk_sel8v(xb[0], xb[1], xb[2], xb[3], xb[4], xb[5], xb[6], xb[7], r), b_l1 = tk_sel8v(xb[8], xb[9], xb[10], xb[11], xb[12], xb[13], xb[14], xb[15], r);
        const float mx = tk_key2f(ck[0]);
        int eo[2]; float ex[2];
#pragma unroll
        for (int u = 0; u < 2; ++u) { const u32 x = tk_sel16v(ck[0], ck[1], ck[2], ck[3], ck[4], ck[5], ck[6], ck[7], ck[8], ck[9], ck[10], ck[11], ck[12], ck[13], ck[14], ck[15], 2 * r + u);
            const int slot = 127 - (int)(x & 127u), c = slot >> 3, rr = slot & 7;
            const int i = (c < 8) ? c : (rr == 0 ? c : 0), j = (c < 8) ? rr : (rr == 0 ? 0 : c);
            const int sa = ((lane & ~7) + (i & 7)) << 2, sb = ((lane & ~7) + (j & 7)) << 2;
            const u32 ka0 = (u32)__builtin_amdgcn_ds_bpermute(sa, (int)a_l0), ka1 = (u32)__builtin_amdgcn_ds_bpermute(sa, (int)a_l1), kb0 = (u32)__builtin_amdgcn_ds_bpermute(sb, (int)b_l0), kb1 = (u32)__builtin_amdgcn_ds_bpermute(sb, (int)b_l1);
            const u32 ka = (i >= 8) ? ka1 : ka0, kb = (j >= 8) ? kb1 : kb0;
            eo[u] = (127 - (int)(ka & 127u)) * 128 + (127 - (int)(kb & 127u)); ex[u] = __expf(tk_key2f(x) - mx); }
        float sum = ex[0] + ex[1];
        sum += __builtin_bit_cast(float, dppu<DPP_XOR1>(__builtin_bit_cast(u32, sum))); sum += __builtin_bit_cast(float, dppu<0x4E>(__builtin_bit_cast(u32, sum))); sum += __builtin_bit_cast(float, dppu<DPP_HMIRROR>(__builtin_bit_cast(u32, sum)));
        const float inv = 1.f / sum;
        *(u32x2*)(EID + (size_t)tok * 128 + h * 16 + 2 * r) = (u32x2){(u32)eo[0], (u32)eo[1]};
        *(f32x2*)(GW + (size_t)tok * 128 + h * 16 + 2 * r) = (f32x2){ex[0] * inv, ex[1] * inv};
    }
}

__device__ __forceinline__ float dot2bf(unsigned w, unsigned x, float acc) { return __builtin_amdgcn_fdot2_f32_bf16(__builtin_bit_cast(bf16x2_t, w), __builtin_bit_cast(bf16x2_t, x), acc, false); }
constexpr int PNB = 8;
__device__ __forceinline__ void phase_peer_a(const Ctx& C, const Args& a, int l) {
    const int x = C.blk & 7, wg = (C.blk >> 3) * NWAVES + C.wave, nwg = ((C.nblk + 7 - x) >> 3) * NWAVES;
    const __amdgpu_buffer_rsrc_t UC = __builtin_amdgcn_make_buffer_rsrc(a.ws + WS_UB + ((size_t)l * 8 + x) * NEXP * 128, 0, NEXP * 128, 0x00020000);
    const int* EID = (const int*)(a.ws + WS_EID); const bf16* H = (const bf16*)(a.ws + WS_H); const float* HSC = (const float*)(a.ws + WS_HSC); float* PD = (float*)(a.ws + WS_PD);
    LAS float* dl = (LAS float*)(C.lds + C.wave * 1024);
    unsigned z_ = 0u; asm volatile("" : "+v"(z_));
    const int lane = (int)__builtin_amdgcn_mbcnt_hi(~0u, __builtin_amdgcn_mbcnt_lo(~0u, z_)), p = lane & 7, g = lane >> 3;
#define PA_META(t_, ev0_, ev1_, r0_, r1_, hs_) do { ev0_ = EID[(size_t)(t_) * 128 + lane]; ev1_ = EID[(size_t)(t_) * 128 + 64 + lane]; hs_ = HSC[t_]; \
        r0_ = *(const u32x4*)(H + (size_t)(t_) * D + 128 * x + 16 * p); r1_ = *(const u32x4*)(H + (size_t)(t_) * D + 128 * x + 16 * p + 8); } while (0)
#define PA_ISSUE(rows_, ev_) do { _Pragma("unroll") for (int j = 0; j < 8; ++j) { const int e = __builtin_amdgcn_ds_bpermute((8 * j + g) << 2, ev_); \
        rows_[j] = __builtin_bit_cast(u32x4, __builtin_amdgcn_raw_buffer_load_b128(UC, e * 128 + 16 * p, 0, 0)); } } while (0)
#define PA_HALF(rows_, off_) do { _Pragma("unroll") for (int j = 0; j < 8; ++j) { \
            int acc = __builtin_amdgcn_sdot4((int)rows_[j].x, (int)hq.x, 0, false); acc = __builtin_amdgcn_sdot4((int)rows_[j].y, (int)hq.y, acc, false); \
            acc = __builtin_amdgcn_sdot4((int)rows_[j].z, (int)hq.z, acc, false); acc = __builtin_amdgcn_sdot4((int)rows_[j].w, (int)hq.w, acc, false); \
            acc += __builtin_amdgcn_update_dpp(0, acc, 0xB1, 0xf, 0xf, true); acc += __builtin_amdgcn_update_dpp(0, acc, 0x4E, 0xf, 0xf, true); acc += __builtin_amdgcn_update_dpp(0, acc, 0x141, 0xf, 0xf, true);   \
            tot[(off_) + j] = (float)acc; } } while (0)
    int evA0, evA1, evB0, evB1; float hsA, hsB; u32x4 hA0, hA1, hB0, hB1, rows0[8], rows1[8];
#define PA_TOKEN(ev0_, ev1_, h0_, h1_, hs_, tcur_, tload_, evn0_) do { \
        u32x4 hq; { const float inv = hs_ > 0.f ? 1.f / hs_ : 0.f; f32x4 f[4]; unpack8(h0_, f[0], f[1]); unpack8(h1_, f[2], f[3]);   \
            _Pragma("unroll") for (int q = 0; q < 4; ++q) hq[q] = ((unsigned)(int)rintf(f[q].x * inv) & 255u) | (((unsigned)(int)rintf(f[q].y * inv) & 255u) << 8) | (((unsigned)(int)rintf(f[q].z * inv) & 255u) << 16) | ((unsigned)(int)rintf(f[q].w * inv) << 24); } \
        PA_ISSUE(rows1, ev1_);                        \
        PA_META(tload_, ev0_, ev1_, h0_, h1_, hs_);   \
        __builtin_amdgcn_sched_barrier(0);            \
        float tot[16]; \
        PA_HALF(rows0, 0); \
        __builtin_amdgcn_sched_barrier(0); \
        PA_ISSUE(rows0, evn0_);                       \
        __builtin_amdgcn_sched_barrier(0); \
        PA_HALF(rows1, 8); \
        __builtin_amdgcn_sched_barrier(0); \
        if (p == 0) { _Pragma("unroll") for (int j = 0; j < 16; ++j) dl[8 * j + g] = tot[j]; } \
        asm volatile("s_waitcnt lgkmcnt(0)" ::: "memory"); \
        const float d0 = dl[lane], d1 = dl[64 + lane]; \
        if ((tcur_) < M) { PD[((size_t)(tcur_) * 8 + x) * 128 + lane] = d0; PD[((size_t)(tcur_) * 8 + x) * 128 + 64 + lane] = d1; } \
        asm volatile("s_waitcnt lgkmcnt(0)" ::: "memory");   } while (0)
    int t = wg;
    { const int tc = t < M ? t : 0; PA_META(tc, evA0, evA1, hA0, hA1, hsA); }
    { const int tc = t + nwg < M ? t + nwg : 0; PA_META(tc, evB0, evB1, hB0, hB1, hsB); }
    PA_ISSUE(rows0, evA0);
#pragma nounroll
    for (; t < M; t += 2 * nwg) {
        const int t1 = t + nwg, t2 = t + 2 * nwg, t3 = t + 3 * nwg, c2 = t2 < M ? t2 : t, c3 = t3 < M ? t3 : t;
        PA_TOKEN(evA0, evA1, hA0, hA1, hsA, t, c2, evB0);
        PA_TOKEN(evB0, evB1, hB0, hB1, hsB, t1, c3, evA0);
    }
#undef PA_TOKEN
#undef PA_META
#undef PA_ISSUE
#undef PA_HALF
}
__device__ __forceinline__ void phase_peer_c(const Ctx& C, const Args& a, int l) {
    const float* USC = (const float*)(a.ws + WS_USC) + (size_t)l * NEXP; const float* VSC = (const float*)(a.ws + WS_VSC) + (size_t)l * NEXP;
    const int* EID = (const int*)(a.ws + WS_EID); const float* GW = (const float*)(a.ws + WS_GW); const float* HSC = (const float*)(a.ws + WS_HSC); const float* PD = (const float*)(a.ws + WS_PD);
    int* C8 = (int*)(a.ws + WS_COEF); float* CSC = (float*)(a.ws + WS_CSC);
    for (int t = C.gw; t < M; t += C.ngw) { float cf[2]; const float hs = HSC[t];
#pragma unroll
        for (int u = 0; u < 2; ++u) { const int k = 64 * u + C.lane, e = EID[(size_t)t * 128 + k]; float d = 0.f;
#pragma unroll
            for (int xx = 0; xx < 8; ++xx) d += PD[((size_t)t * 8 + xx) * 128 + k];
            const float dd = d * USC[e] * hs; cf[u] = VSC[e] * GW[(size_t)t * 128 + k] * 0.5f * dd * (1.f + erff(dd * 0.70710678118654752f)); }
        const float am = wave_max(fmaxf(fabsf(cf[0]), fabsf(cf[1]))), inv = am > 0.f ? 127.f / am : 0.f;
        const int q0 = (int)rintf(cf[0] * inv) & 255, q1 = (int)rintf(cf[1] * inv) & 255;
        { const int L = C.lane & 31, m = L >> 3, g = L & 7, src = 32 * (m & 1) + g; unsigned w = 0u;
#pragma unroll
          for (int i = 0; i < 4; ++i) { const int b0 = __builtin_amdgcn_ds_bpermute((src + 8 * i) << 2, q0), b1 = __builtin_amdgcn_ds_bpermute((src + 8 * i) << 2, q1); w |= (unsigned)((m >> 1) ? b1 : b0) << (8 * i); }
          if (C.lane < 32) C8[(size_t)t * 32 + L] = (int)w; }
        if (C.lane == 0) CSC[t] = am * (1.f / 127.f); }
}
__device__ __forceinline__ void phase_peer_b(const Ctx& C, const Args& a, int l) {
    const int x = C.blk & 7, wg = (C.blk >> 3) * NWAVES + C.wave, nwg = ((C.nblk + 7 - x) >> 3) * NWAVES;
    const __amdgpu_buffer_rsrc_t VC = __builtin_amdgcn_make_buffer_rsrc(a.ws + WS_VB + ((size_t)l * 8 + x) * NEXP * 128, 0, NEXP * 128, 0x00020000);
    const int* EID = (const int*)(a.ws + WS_EID); const int* C8 = (const int*)(a.ws + WS_COEF); const float* CSC = (const float*)(a.ws + WS_CSC); float* XW = a.out;
    LAS int* ol = (LAS int*)(C.lds + C.wave * 4096);
    unsigned z_ = 0u; asm volatile("" : "+v"(z_));
    const int lane = (int)__builtin_amdgcn_mbcnt_hi(~0u, __builtin_amdgcn_mbcnt_lo(~0u, z_)), p = lane & 7, g = lane >> 3;
#define PB_META(t_, ev0_, ev1_, cf0_, cf1_, cf2_, cf3_) do { ev0_ = EID[(size_t)(t_) * 128 + lane]; ev1_ = EID[(size_t)(t_) * 128 + 64 + lane]; cf0_ = C8[(size_t)(t_) * 32 + g]; cf1_ = C8[(size_t)(t_) * 32 + 8 + g]; cf2_ = C8[(size_t)(t_) * 32 + 16 + g]; cf3_ = C8[(size_t)(t_) * 32 + 24 + g]; } while (0)
#define PB_ISSUE(rows_, ev_) do { _Pragma("unroll") for (int j = 0; j < 8; ++j) { const int e = __builtin_amdgcn_ds_bpermute((8 * j + g) << 2, ev_); \
        rows_[j] = __builtin_bit_cast(u32x4, __builtin_amdgcn_raw_buffer_load_b128(VC, e * 128 + 16 * p, 0, 0)); } } while (0)
#define PB_GROUP(rows_, j0_, ck_) do { _Pragma("unroll") for (int q = 0; q < 4; ++q) { const unsigned a_ = rows_[(j0_)][q], b_ = rows_[(j0_) + 1][q], c_ = rows_[(j0_) + 2][q], d_ = rows_[(j0_) + 3][q]; \
            const unsigned ablo = __builtin_amdgcn_perm(b_, a_, 0x05010400u), abhi = __builtin_amdgcn_perm(b_, a_, 0x07030602u), cdlo = __builtin_amdgcn_perm(d_, c_, 0x05010400u), cdhi = __builtin_amdgcn_perm(d_, c_, 0x07030602u); \
            o[4 * q + 0] = __builtin_amdgcn_sdot4((int)__builtin_amdgcn_perm(cdlo, ablo, 0x05040100u), ck_, o[4 * q + 0], false); o[4 * q + 1] = __builtin_amdgcn_sdot4((int)__builtin_amdgcn_perm(cdlo, ablo, 0x07060302u), ck_, o[4 * q + 1], false); \
            o[4 * q + 2] = __builtin_amdgcn_sdot4((int)__builtin_amdgcn_perm(cdhi, abhi, 0x05040100u), ck_, o[4 * q + 2], false); o[4 * q + 3] = __builtin_amdgcn_sdot4((int)__builtin_amdgcn_perm(cdhi, abhi, 0x07060302u), ck_, o[4 * q + 3], false); } } while (0)
#define PB_HALF(rows_, ck0_, ck1_) do { PB_GROUP(rows_, 0, ck0_); PB_GROUP(rows_, 4, ck1_); } while (0)
    int evA0, evA1, evB0, evB1, cfA0, cfA1, cfA2, cfA3, cfB0, cfB1, cfB2, cfB3; u32x4 rows0[8], rows1[8];
    const f32x2 g2b0 = *(const f32x2*)(modp(a, l, 0, 5) + 128 * x + 2 * lane), g2b1 = *(const f32x2*)(modp(a, l, 1, 5) + 128 * x + 2 * lane);
    int t = wg;
    { const int tc = t < M ? t : 0; PB_META(tc, evA0, evA1, cfA0, cfA1, cfA2, cfA3); }
    { const int tc = t + nwg < M ? t + nwg : 0; PB_META(tc, evB0, evB1, cfB0, cfB1, cfB2, cfB3); }
    PB_ISSUE(rows0, evA0);
    f32x2 xvn; float csn; { const int tc = t < M ? t : 0; xvn = *(const f32x2*)(XW + (size_t)tc * D + 128 * x + 2 * lane); csn = CSC[tc]; }
#pragma nounroll
    for (; t < M; t += nwg) {
        const int t2 = t + 2 * nwg, c2 = t2 < M ? t2 : t;
        const int k0 = cfA0, k1 = cfA1, k2 = cfA2, k3 = cfA3;
        const f32x2 xv = xvn; const float cs = csn;
        PB_ISSUE(rows1, evA1);
        evA0 = evB0; evA1 = evB1; cfA0 = cfB0; cfA1 = cfB1; cfA2 = cfB2; cfA3 = cfB3;
        PB_META(c2, evB0, evB1, cfB0, cfB1, cfB2, cfB3);
        { const int c1 = t + nwg < M ? t + nwg : t; xvn = *(const f32x2*)(XW + (size_t)c1 * D + 128 * x + 2 * lane); csn = CSC[c1]; }
        __builtin_amdgcn_sched_barrier(0);
        int o[16];
#pragma unroll
        for (int i = 0; i < 16; ++i) o[i] = 0;
        PB_HALF(rows0, k0, k1);
        __builtin_amdgcn_sched_barrier(0);
        PB_ISSUE(rows0, evA0);
        __builtin_amdgcn_sched_barrier(0);
        PB_HALF(rows1, k2, k3);
        __builtin_amdgcn_sched_barrier(0);
#pragma unroll
        for (int q = 0; q < 4; ++q) *(LAS u32x4*)(ol + lane * 16 + 4 * q) = (u32x4){(unsigned)o[4 * q], (unsigned)o[4 * q + 1], (unsigned)o[4 * q + 2], (unsigned)o[4 * q + 3]};
        asm volatile("s_waitcnt lgkmcnt(0)" ::: "memory");
        int s0 = 0, s1 = 0;
#pragma unroll
        for (int gg = 0; gg < 8; ++gg) { const u32x2 v = *(const LAS u32x2*)(ol + (gg * 8 + (lane >> 3)) * 16 + 2 * (lane & 7)); s0 += (int)v.x; s1 += (int)v.y; }
        asm volatile("s_waitcnt lgkmcnt(0)" ::: "memory");
        const int c = 128 * x + 2 * lane; const f32x2 g2 = (t >> 13) ? g2b1 : g2b0;
        *(f32x2*)(XW + (size_t)t * D + c) = xv + g2 * (f32x2){(float)s0 * cs, (float)s1 * cs};
    }
#undef PB_META
#undef PB_ISSUE
#undef PB_HALF
}
__device__ __forceinline__ void phase_final(const Ctx& C, const Args& a) {
    for (int m = C.gw; m < M; m += C.ngw) { f32x4 x[4]; float ss = 0.f;
#pragma unroll
        for (int j = 0; j < 4; ++j) { x[j] = *(const f32x4*)(a.out + (size_t)m * D + 4 * C.lane + 256 * j); ss += (x[j].x * x[j].x + x[j].y * x[j].y) + (x[j].z * x[j].z + x[j].w * x[j].w); }
        const float rstd = 1.f / sqrtf(wave_sum(ss) * (1.f / D) + EPS);
#pragma unroll
        for (int j = 0; j < 4; ++j) *(f32x4*)(a.out + (size_t)m * D + 4 * C.lane + 256 * j) = x[j] * rstd * *(const f32x4*)(a.in[I_FG] + 4 * C.lane + 256 * j); }
}

#ifndef USE_NAIVE
#define GEMM mfma_gemm
#else
#define GEMM naive_gemm
#endif
#define RLX_AGENT __ATOMIC_RELAXED, __HIP_MEMORY_SCOPE_AGENT
#define XB_TMO      128
#define XB_XCNT(j)  (256  + 64 * (j))
#define XB_XSUB(j)  (1280 + 64 * (j))
#define XB_XGEN(j)  (2304 + 64 * (j))
#define XB_TOP      3328
#define XB_TOPGEN   3392
#define XCD_BAR_WORDS 3456
#define XB_SPIN_CAP (1u << 18)

__device__ __forceinline__ unsigned xb_ld(unsigned* p)              { return __hip_atomic_load(p, __ATOMIC_RELAXED, __HIP_MEMORY_SCOPE_AGENT); }
__device__ __forceinline__ unsigned xb_add(unsigned* p, unsigned v) { return __hip_atomic_fetch_add(p, v, __ATOMIC_RELAXED, __HIP_MEMORY_SCOPE_AGENT); }
__device__ __forceinline__ unsigned xb_xcc_id() { return (unsigned)__builtin_amdgcn_s_getreg((3 << 11) | 20) & 0xFu; }
#define XB_SPIN(cond, bar) do { unsigned _sp = 0; while (cond) { __builtin_amdgcn_s_sleep(1); \
    if ((++_sp & 255u) == 0u) { if (xb_ld(&(bar)[XB_TMO])) break; if (_sp > XB_SPIN_CAP) { atomicAdd(&(bar)[XB_TMO], 1u); break; } } } } while (0)

struct XcdBarrier {
    unsigned* bar; unsigned x;
    volatile LAS unsigned* st;
};

__device__ __forceinline__ XcdBarrier xcd_barrier_post(unsigned* bar, volatile LAS unsigned* st) {
    XcdBarrier b; b.bar = bar; b.x = xb_xcc_id(); b.st = st;
    if (threadIdx.x == 0) (void)xb_add(&bar[XB_XCNT(b.x)], 1u);
    return b;
}
__device__ __forceinline__ void xcd_barrier_complete(unsigned* bar, unsigned x, unsigned& nloc, unsigned& nx) {
    const unsigned G = gridDim.x * gridDim.y * gridDim.z;
    unsigned sum, cnt, mine, sp = 0u;
    for (;;) {
        sum = 0u; cnt = 0u; mine = 0u;
#pragma unroll
        for (unsigned j = 0; j < 16; ++j) { const unsigned c = xb_ld(&bar[XB_XCNT(j)]); sum += c; cnt += (c > 0u) ? 1u : 0u; mine = (j == x) ? c : mine; }
        if (sum == G) break;
        __builtin_amdgcn_s_sleep(1);
        if ((++sp & 255u) == 0u) { if (xb_ld(&bar[XB_TMO])) break; if (sp > XB_SPIN_CAP) { atomicAdd(&bar[XB_TMO], 1u); break; } }
    }
    nloc = mine > 0u ? mine : 1u; nx = cnt > 0u ? cnt : 1u;
}

__device__ __forceinline__ void xcd_barrier(const XcdBarrier& b, const int tid_) {
    asm volatile("s_waitcnt vmcnt(0)" ::: "memory");
    __syncthreads();
    if (tid_ == 0) {
        unsigned* bar = b.bar;
        __builtin_amdgcn_s_waitcnt(0);
        unsigned nloc = b.st[0], nx = b.st[1];
        if (nloc == 0u) { xcd_barrier_complete(bar, b.x, nloc, nx); b.st[0] = nloc; b.st[1] = nx; }
        const unsigned old = xb_add(&bar[XB_XSUB(b.x)], 1u);
        const unsigned gen = old / nloc;
        if (old + 1u == (gen + 1u) * nloc) {
            __builtin_amdgcn_fence(__ATOMIC_RELEASE, "agent");
            asm volatile("s_waitcnt vmcnt(0)" ::: "memory");
            const unsigned og = xb_add(&bar[XB_TOP], 1u);
            const unsigned tg = og / nx;
            if (og + 1u == (tg + 1u) * nx) xb_add(&bar[XB_TOPGEN], 1u);
            else XB_SPIN(xb_ld(&bar[XB_TOPGEN]) == tg, bar);
            __builtin_amdgcn_fence(__ATOMIC_ACQUIRE, "agent");
            xb_add(&bar[XB_XGEN(b.x)], 1u);
            asm volatile("s_waitcnt vmcnt(0)" ::: "memory");
        } else {
            XB_SPIN(xb_ld(&bar[XB_XGEN(b.x)]) == gen, bar);
            __builtin_amdgcn_fence(__ATOMIC_ACQUIRE, "agent");
            asm volatile("s_waitcnt vmcnt(0)" ::: "memory");
        }
    }
    __syncthreads();
}

constexpr int CW_BAR = 4096;
constexpr size_t CTL_ZERO_BYTES = 65536;
constexpr int LDSCTL_OFF = 131072, MISC_OFF = LDSCTL_OFF + 320;
constexpr int PH_PREP = 0, PH_MODR = 1, PH_N1 = 2, PH_L0 = 3, PH_PER_LAYER = 10, N_PHASES = PH_L0 + DEPTH * PH_PER_LAYER;
__device__ __forceinline__ Ctx make_ctx(LAS unsigned char* lds, int wave_s) {
    unsigned z_ = 0u; asm volatile("" : "+v"(z_));
    int tid_ = (wave_s << 6) | (int)__builtin_amdgcn_mbcnt_hi(~0u, __builtin_amdgcn_mbcnt_lo(~0u, z_)); asm volatile("" : "+v"(tid_));
    Ctx C; C.tid = tid_; C.lane = C.tid & 63; C.wave = __builtin_amdgcn_readfirstlane(C.tid >> 6); C.nblk = gridDim.x; C.blk = blockIdx.x;
    C.gw = C.blk * NWAVES + C.wave; C.ngw = C.nblk * NWAVES; C.lds = lds; return C;
}
#ifndef ONLYPH
#define ONLYPH -1
#endif
constexpr unsigned long long REP_MASK = 0ull;
#define PH(k, ...) if ((ONLYPH < 0 || ONLYPH == (k)) && a.ph_lo <= (k) && (k) < a.ph_hi) { for (int r_ = 0; r_ < 1 + (int)((REP_MASK >> (k)) & 1ull); ++r_) { const Ctx C = make_ctx(lds, wave_s); __VA_ARGS__; } if ((k) + 1 < a.ph_hi) xcd_barrier(bar, make_ctx(lds, wave_s).tid); }
template <int l>
__device__ __forceinline__ void run_layer(const Args& a, LAS unsigned char* lds, const XcdBarrier& bar, const int wave_s) {
    unsigned char* ws = a.ws; constexpr int B0 = PH_L0 + l * PH_PER_LAYER;
    PH(B0 + 0, EpiIn E{a.in[I_BIN] + (size_t)l * DIN, (const float*)(ws + WS_BP) + (size_t)l * 1024, (bf16*)(ws + WS_UG), (bf16*)(ws + WS_ZP), (bf16*)(ws + WS_G)};
               GEMM(C, (const bf16*)(ws + WS_H), D, 0, (const bf16*)(ws + WS_WIN) + (size_t)l * DIN * D, D, M, DIN, D, E))
    PH(B0 + 1, phase_convpool(C, a, l))
    PH(B0 + 2, EpiConv E{(const bf16*)(ws + WS_G), (const bf16*)(ws + WS_PL), a.in[I_POOLS] + (size_t)l * D, (bf16*)(ws + WS_Y)};
               GEMM(C, (const bf16*)(ws + WS_AC), D, 0, (const bf16*)(ws + WS_WCO) + (size_t)l * D * D, D, M, D, D, E))
    PH(B0 + 3, EpiOut E{l == 0 ? a.in[I_X] : a.out, a.out, modp(a, l, 0, 2), a.in[I_BOUT] + (size_t)l * D};
               GEMM(C, (const bf16*)(ws + WS_Y), D, 0, (const bf16*)(ws + WS_WOUT) + (size_t)l * D * D, D, M, D, D, E))
    PH(B0 + 4, phase_norm(C, a, a.out, a.in[I_N2G] + (size_t)l * D, l, 3, 4, (float*)(ws + WS_HSC)))
    PH(B0 + 5, { EpiS E{(float*)(ws + WS_S)}; GEMM(C, (const bf16*)(ws + WS_H), D, 0, (const bf16*)(ws + WS_WQ) + (size_t)l * DQ * D, D, M, DQ, D, E); }
               asm volatile("s_waitcnt vmcnt(0)" ::: "memory"); __syncthreads();
               { const Ctx C3 = make_ctx(lds, wave_s); phase_topk(C3, a); })
    PH(B0 + 6, phase_peer_a(C, a, l))
    PH(B0 + 7, phase_peer_c(C, a, l))
    PH(B0 + 8, phase_peer_b(C, a, l))
    PH(B0 + 9, if (l + 1 < DEPTH) phase_norm(C, a, a.out, a.in[I_N1G] + (size_t)(l + 1) * D, l + 1, 0, 1, nullptr); else phase_final(C, a))
}
__global__ void __launch_bounds__(NTHREADS, 2) fwd_kernel(Args a) {
    extern __shared__ __attribute__((aligned(16))) unsigned char lds_raw[];
    LAS unsigned char* lds = (LAS unsigned char*)lds_raw;
    for (int u = threadIdx.x; u < (LDS_BYTES - LDSCTL_OFF) / 4; u += NTHREADS) ((LAS unsigned*)(lds + LDSCTL_OFF))[u] = 0u;
    __syncthreads();
    const int wave_s = __builtin_amdgcn_readfirstlane((int)threadIdx.x >> 6);
    const XcdBarrier bar = xcd_barrier_post((unsigned*)(a.ws + WS_CTL) + CW_BAR, (volatile LAS unsigned*)(lds + MISC_OFF) + 8);
    PH(PH_PREP, phase_prep(C, a))
    PH(PH_MODR, phase_modreduce(C, a))
    PH(PH_N1, phase_norm(C, a, a.in[I_X], a.in[I_N1G], 0, 0, 1, nullptr);
              for (int lf = 0; lf < DEPTH; ++lf) { const Ctx C2 = make_ctx(lds, wave_s); EpiWT E{(bf16*)(a.ws + WS_WQ) + (size_t)lf * DQ * D};
                  GEMM(C2, (const bf16*)(a.ws + WS_KEYS) + (size_t)lf * 2048 * 256, 256, 0, (const bf16*)(a.ws + WS_WQB) + (size_t)lf * D * DQ, DQ, DQ, D, 256, E, 256, 32 * lf); }
              for (int lf = 0; lf < DEPTH; ++lf) { const Ctx C2 = make_ctx(lds, wave_s); EpiWT E{(bf16*)(a.ws + WS_WIN) + ((size_t)lf * DIN + 2048) * D};
                  GEMM(C2, (const bf16*)(a.ws + WS_POOL) + (size_t)lf * 1024 * 256, 256, 0, (const bf16*)(a.ws + WS_WPB) + (size_t)lf * D * 1024, 1024, 1024, D, 256, E, 256, 64 + 16 * lf); }
              { const Ctx C2 = make_ctx(lds, wave_s);
                for (int o = C2.gw; o < DEPTH * 1024; o += C2.ngw) { const int lf = o >> 10, n = o & 1023, g = n >> 8, d = n & 255; float sacc = 0.f;
                    for (int u = 0; u < 4; ++u) { const int c = C2.lane + 64 * u; sacc += a.in[I_BIN][(size_t)lf * DIN + 2048 + g * 256 + c] * a.in[I_POOLW][(((size_t)lf * 4 + g) * 256 + c) * 256 + d]; }
                    sacc = wave_sum(sacc); if (C2.lane == 0) ((float*)(a.ws + WS_BP))[o] = sacc; } })
    run_layer<0>(a, lds, bar, wave_s);
    run_layer<1>(a, lds, bar, wave_s);
}

extern "C" void kernel_launch(void* const* d_in, const int* in_sizes, int n_in, void* d_out, int out_size, void* d_ws, size_t ws_size, hipStream_t stream) {
    static int grid = 0;
    if (grid == 0) {
        if (n_in != 22 || out_size != M * D || ws_size < WS_END) { fprintf(stderr, "kernel_launch: unexpected shapes (n_in %d out %d ws %zu)\n", n_in, out_size, ws_size); grid = -1; return; }
        int dev = 0, cus = 0;
        if (hipGetDevice(&dev) != hipSuccess || hipDeviceGetAttribute(&cus, hipDeviceAttributeMultiprocessorCount, dev) != hipSuccess) { grid = -1; return; }
        if (hipFuncSetAttribute((const void*)fwd_kernel, hipFuncAttributeMaxDynamicSharedMemorySize, LDS_BYTES) != hipSuccess) { grid = -1; return; }
        grid = cus;
    }
    if (grid < 0) return;
    Args a{};
    for (int i = 0; i < 22; ++i) a.in[i] = (const float*)d_in[i];
    a.out = (float*)d_out; a.ws = (unsigned char*)d_ws;
    (void)hipMemsetAsync((char*)d_ws + WS_CTL, 0, CTL_ZERO_BYTES, stream);
#ifndef ONE_LAUNCH
    for (int ph = 0; ph < N_PHASES; ++ph) { a.ph_lo = ph; a.ph_hi = ph + 1; hipLaunchKernelGGL(fwd_kernel, dim3(grid), dim3(NTHREADS), LDS_BYTES, stream, a); }
#else
    a.ph_lo = 0; a.ph_hi = N_PHASES; hipLaunchKernelGGL(fwd_kernel, dim3(grid), dim3(NTHREADS), LDS_BYTES, stream, a);
#endif
}
```

```cpp
#define ONE_LAUNCH 1
#include <hip/hip_runtime.h>
#include <cstdint>
#include <cstdio>
#include <utility>

#define GAS __attribute__((address_space(1)))
#define LAS __attribute__((address_space(3)))
typedef unsigned short bf16;
typedef float f32x4 __attribute__((ext_vector_type(4)));
typedef float f32x2 __attribute__((ext_vector_type(2)));
typedef unsigned u32x4 __attribute__((ext_vector_type(4)));
typedef unsigned u32x2 __attribute__((ext_vector_type(2)));
typedef __bf16 bf16x2_t __attribute__((ext_vector_type(2)));

constexpr int BATCH = 2, SEQ = 8192, D = 1024, M = BATCH * SEQ, DEPTH = 2;
constexpr int DIN = 5120, NMODV = 6 * D, CONVK = 31, NHEAD = 8, NKEYS = 128, DQ = 2048, TOPK = 16, NEXP = 16384;
constexpr float EPS = 1e-6f;
constexpr int NWAVES = 8, NTHREADS = NWAVES * 64;

constexpr size_t MiB = 1u << 20;
constexpr size_t WS_CTL = 0;
constexpr size_t WS_MODP = 1 * MiB;
constexpr size_t WS_MOD = 4 * MiB;
constexpr size_t WS_WIN = 8 * MiB;
constexpr size_t WS_WCO = 28 * MiB;
constexpr size_t WS_WOUT = 32 * MiB;
constexpr size_t WS_WQ = 36 * MiB;
constexpr size_t WS_POOL = 44 * MiB;
constexpr size_t WS_KEYS = 45 * MiB;
constexpr size_t WS_UB = 48 * MiB;
constexpr size_t WS_USC = 80 * MiB;
constexpr size_t WS_HQ = 84 * MiB;
constexpr size_t WS_VSC = 81 * MiB;
constexpr size_t WS_VB = 112 * MiB;
constexpr size_t WS_H = 176 * MiB;
constexpr size_t WS_UG = 208 * MiB;
constexpr size_t WS_Y = 472 * MiB;
constexpr size_t WS_ZP = 240 * MiB;
constexpr size_t WS_TMP = WS_ZP;
constexpr size_t WS_Q = WS_UG;
constexpr size_t WS_G = 272 * MiB;
constexpr size_t WS_AC = 336 * MiB;
constexpr size_t WS_PL = 368 * MiB;
constexpr size_t WS_S = WS_G;
constexpr size_t WS_EID = 400 * MiB;
constexpr size_t WS_GW = 408 * MiB;
constexpr size_t WS_COEF = 416 * MiB;
constexpr size_t WS_CSC = 424 * MiB + 524288;
constexpr size_t WS_HSC = 424 * MiB;
constexpr size_t WS_HSUM = 424 * MiB + 131072;
constexpr size_t WS_PD = WS_S;
constexpr size_t WS_WQB = 426 * MiB;
constexpr size_t WS_WPB = 434 * MiB;
constexpr size_t WS_BP = 4 * MiB + 262144;
constexpr size_t WS_XB = 440 * MiB;
constexpr size_t WS_END = 504 * MiB;

constexpr int LDS_BYTES = 147456;

__device__ __forceinline__ unsigned f2bf(float f) { unsigned u = __builtin_bit_cast(unsigned, f); return (u + 0x7fffu + ((u >> 16) & 1u)) >> 16; }
__device__ __forceinline__ unsigned pk2(float lo, float hi) { typedef __bf16 bf16x2_t_ __attribute__((ext_vector_type(2))); return __builtin_bit_cast(unsigned, __builtin_convertvector((f32x2){lo, hi}, bf16x2_t_)); }
__device__ __forceinline__ float bflo(unsigned w) { return __builtin_bit_cast(float, w << 16); }
__device__ __forceinline__ float bfhi(unsigned w) { return __builtin_bit_cast(float, w & 0xffff0000u); }
__device__ __forceinline__ float sigm(float x) { return __builtin_amdgcn_rcpf(1.f + __expf(-x)); }
__device__ __forceinline__ float dpp_sum63(float v) {
#define DPPF(x, ctrl, rm, bc) __builtin_bit_cast(float, __builtin_amdgcn_update_dpp(0, __builtin_bit_cast(int, x), ctrl, rm, 0xf, bc))
    v += DPPF(v, 0x111, 0xf, true); v += DPPF(v, 0x112, 0xf, true); v += DPPF(v, 0x114, 0xf, true); v += DPPF(v, 0x118, 0xf, true);
    v += DPPF(v, 0x142, 0xa, false); v += DPPF(v, 0x143, 0xc, false);
#undef DPPF
    return v;
}
__device__ __forceinline__ float wave_sum(float v) { return __builtin_bit_cast(float, __builtin_amdgcn_readlane(__builtin_bit_cast(int, dpp_sum63(v)), 63)); }
__device__ __forceinline__ float wave_max(float v) {
#define DPPF(x, ctrl, rm, bc) __builtin_bit_cast(float, __builtin_amdgcn_update_dpp(0, __builtin_bit_cast(int, x), ctrl, rm, 0xf, bc))
    v = fmaxf(v, DPPF(v, 0x111, 0xf, true)); v = fmaxf(v, DPPF(v, 0x112, 0xf, true)); v = fmaxf(v, DPPF(v, 0x114, 0xf, true)); v = fmaxf(v, DPPF(v, 0x118, 0xf, true));
    v = fmaxf(v, DPPF(v, 0x142, 0xa, false)); v = fmaxf(v, DPPF(v, 0x143, 0xc, false));
#undef DPPF
    return __builtin_bit_cast(float, __builtin_amdgcn_readlane(__builtin_bit_cast(int, v), 63));
}
__device__ __forceinline__ u32x4 pack8(const f32x4& a, const f32x4& b) { u32x4 w; w.x = pk2(a.x, a.y); w.y = pk2(a.z, a.w); w.z = pk2(b.x, b.y); w.w = pk2(b.z, b.w); return w; }
__device__ __forceinline__ void unpack8(const u32x4& w, f32x4& a, f32x4& b) { a = (f32x4){bflo(w.x), bfhi(w.x), bflo(w.y), bfhi(w.y)}; b = (f32x4){bflo(w.z), bfhi(w.z), bflo(w.w), bfhi(w.w)}; }

__device__ __forceinline__ float row16_sum(float v) {
#define DPPF(x, ctrl) __builtin_bit_cast(float, __builtin_amdgcn_update_dpp(0, __builtin_bit_cast(int, x), ctrl, 0xf, 0xf, true))
    v += DPPF(v, 0xB1); v += DPPF(v, 0x4E); v += DPPF(v, 0x141); v += DPPF(v, 0x140);
#undef DPPF
    return v;
}
__device__ __forceinline__ unsigned wave_sum_u(unsigned v) {
#define DPPU(x, ctrl, rm, bc) (unsigned)__builtin_amdgcn_update_dpp(0, (int)(x), ctrl, rm, 0xf, bc)
    v += DPPU(v, 0x111, 0xf, true); v += DPPU(v, 0x112, 0xf, true); v += DPPU(v, 0x114, 0xf, true); v += DPPU(v, 0x118, 0xf, true);
    v += DPPU(v, 0x142, 0xa, false); v += DPPU(v, 0x143, 0xc, false);
#undef DPPU
    return (unsigned)__builtin_amdgcn_readlane((int)v, 63);
}
struct Ctx { int tid, lane, wave, gw, ngw, nblk, blk; LAS unsigned char* lds; };

struct Args { const float* in[22]; float* out; unsigned char* ws; int ph_lo, ph_hi; };
enum { I_X = 0, I_C, I_ADAW, I_ADAB, I_N1G, I_WIN, I_BIN, I_CONVW, I_CONVB, I_LNG, I_LNB, I_WCO, I_POOLW, I_POOLS, I_WOUT, I_BOUT, I_N2G, I_WQ, I_KEYS, I_PU, I_PV, I_FG };

__device__ __forceinline__ void transpose_item(const float* W, int K, int N, int k0, int n0, bf16* WT, int dstrow0, LAS float* scr, int lane) {
#pragma unroll 8
    for (int i = 0; i < 32; ++i) { const int kk = 2 * i + (lane >> 5); scr[kk * 33 + (lane & 31)] = W[(size_t)(k0 + kk) * N + n0 + (lane & 31)]; }
    asm volatile("s_waitcnt lgkmcnt(0)" ::: "memory");
    const int c = lane & 7;
#pragma unroll
    for (int j = 0; j < 4; ++j) { const int n = (lane >> 3) + 8 * j; const LAS float* s = scr + (8 * c) * 33 + n;
        u32x4 o; o.x = pk2(s[0 * 33], s[1 * 33]); o.y = pk2(s[2 * 33], s[3 * 33]); o.z = pk2(s[4 * 33], s[5 * 33]); o.w = pk2(s[6 * 33], s[7 * 33]);
        *(u32x4*)(WT + (size_t)(dstrow0 + n) * K + k0 + 8 * c) = o; }
    asm volatile("s_waitcnt lgkmcnt(0)" ::: "memory");
}
__device__ __forceinline__ int win_dstrow(int n0) {
    if (n0 < 1024) return 256 * (n0 >> 7) + (n0 & 127);
    if (n0 < 2048) { const int c = n0 - 1024; return 256 * (c >> 7) + 128 + (c & 127); }
    return n0;
}
__device__ __forceinline__ void phase_prep(const Ctx& C, const Args& a) {
    unsigned char* ws = a.ws;
    LAS float* scr = (LAS float*)(C.lds + C.wave * 16384);
    constexpr int I_IN = 16 * 160, I_CO = 16 * 32, I_PO = 4 * (4 * 8), I_OUT = 16 * 32, I_L = I_IN + I_CO + I_PO + I_OUT;
    for (int it = C.gw; it < DEPTH * I_L; it += C.ngw) {
        const int l = it / I_L; int r = it % I_L;
        if (r < I_IN) { const int kb = r / 160, nb = r % 160; if (nb < 64 || nb >= 96) transpose_item(a.in[I_WIN] + (size_t)l * D * DIN, D, DIN, 64 * kb, 32 * nb, (bf16*)(ws + WS_WIN) + (size_t)l * DIN * D, win_dstrow(32 * nb), scr, C.lane); continue; } r -= I_IN;
        if (r < I_CO) { const int kb = r / 32, nb = r % 32; transpose_item(a.in[I_WCO] + (size_t)l * D * D, D, D, 64 * kb, 32 * nb, (bf16*)(ws + WS_WCO) + (size_t)l * D * D, 32 * nb, scr, C.lane); continue; } r -= I_CO;
        if (r < I_PO) { const int g = r / 32, q = r % 32, kb = q / 8, nb = q % 8; transpose_item(a.in[I_POOLW] + ((size_t)l * 4 + g) * 256 * 256, 256, 256, 64 * kb, 32 * nb, (bf16*)(ws + WS_POOL) + ((size_t)l * 1024 + 256 * g) * 256, 32 * nb, scr, C.lane); continue; } r -= I_PO;
        { const int kb = r / 32, nb = r % 32; transpose_item(a.in[I_WOUT] + (size_t)l * D * D, D, D, 64 * kb, 32 * nb, (bf16*)(ws + WS_WOUT) + (size_t)l * D * D, 32 * nb, scr, C.lane); }
    }
    const int gt = C.blk * NTHREADS + C.tid, ngt = C.nblk * NTHREADS;
    for (int i = gt; i < DEPTH * D * 1024 / 8; i += ngt) { const int l = i / (D * 128), rr = i % (D * 128), k = rr / 128, c8 = (rr % 128) * 8; const float* sp = a.in[I_WIN] + ((size_t)l * D + k) * DIN + 2048 + c8;
        const f32x4 v0 = *(const f32x4*)sp, v1 = *(const f32x4*)(sp + 4); *(u32x4*)((bf16*)(ws + WS_WPB) + ((size_t)l * D + k) * 1024 + c8) = pack8(v0, v1); }
    for (size_t i = gt; i < (size_t)DEPTH * D * DQ / 8; i += ngt) { const f32x4 v0 = *(const f32x4*)(a.in[I_WQ] + i * 8), v1 = *(const f32x4*)(a.in[I_WQ] + i * 8 + 4); *(u32x4*)((bf16*)(ws + WS_WQB) + i * 8) = pack8(v0, v1); }
    for (int i = gt; i < DEPTH * 2048 * 32; i += ngt) {
        const int l = i / (2048 * 32), r = i % (2048 * 32), n = r / 32, k8 = (r % 32) * 8;
        const int h = n >> 8, p = (n >> 7) & 1, key = n & 127, pk = k8 >> 7, kk = k8 & 127;
        u32x4 o = (u32x4){0u, 0u, 0u, 0u};
        if (pk == p) { const float* s = a.in[I_KEYS] + ((((size_t)l * 8 + h) * 2 + p) * 128 + key) * 128 + kk; const f32x4 v0 = *(const f32x4*)s, v1 = *(const f32x4*)(s + 4); o = pack8(v0, v1); }
        *(u32x4*)((bf16*)(ws + WS_KEYS) + ((size_t)l * 2048 + n) * 256 + k8) = o;
    }
    for (int row0 = 4 * C.gw; row0 < DEPTH * NEXP; row0 += 4 * C.ngw) {
        const float* src = a.in[I_PU]; float* scl = (float*)(ws + WS_USC);
        f32x4 v[4][4];
#pragma unroll
        for (int r = 0; r < 4; ++r)
#pragma unroll
            for (int q = 0; q < 4; ++q) v[r][q] = *(const f32x4*)(src + (size_t)(row0 + r) * D + 16 * C.lane + 4 * q);
#pragma unroll
        for (int r = 0; r < 4; ++r) { float ss = 0.f; const int row = row0 + r;
#pragma unroll
            for (int q = 0; q < 4; ++q) ss += (v[r][q].x * v[r][q].x + v[r][q].y * v[r][q].y) + (v[r][q].z * v[r][q].z + v[r][q].w * v[r][q].w);
            ss = row16_sum(ss);
            const float step = 0.3352f * sqrtf(ss * (1.f / 256.f)), inv = step > 0.f ? 1.f / step : 0.f; u32x2 w = (u32x2){0u, 0u};
#pragma unroll
            for (int q = 0; q < 4; ++q) {
#pragma unroll
                for (int k = 0; k < 4; ++k) { const int qi = (int)fminf(fmaxf(floorf(v[r][q][k] * inv), -8.f), 7.f); const int idx = 4 * q + k; w[idx >> 3] |= ((unsigned)qi & 15u) << (4 * (idx & 7)); } }
            { const int lyr = row / NEXP, e = row % NEXP; *(u32x2*)(ws + WS_UB + (((size_t)lyr * 4 + (C.lane >> 4)) * NEXP + e) * 128 + 8 * (C.lane & 15)) = w; }
            if ((C.lane & 15) == 0) scl[(size_t)row * 4 + (C.lane >> 4)] = step; }
    }
    for (int row0 = 4 * C.gw; row0 < DEPTH * NEXP; row0 += 4 * C.ngw) {
        const float* src = a.in[I_PV]; float* scl = (float*)(ws + WS_VSC);
        f32x4 v[4][4];
#pragma unroll
        for (int r = 0; r < 4; ++r)
#pragma unroll
            for (int q = 0; q < 4; ++q) v[r][q] = *(const f32x4*)(src + (size_t)(row0 + r) * D + 16 * C.lane + 4 * q);
#pragma unroll
        for (int r = 0; r < 4; ++r) { float ss = 0.f; const int row = row0 + r;
#pragma unroll
            for (int q = 0; q < 4; ++q) ss += (v[r][q].x * v[r][q].x + v[r][q].y * v[r][q].y) + (v[r][q].z * v[r][q].z + v[r][q].w * v[r][q].w);
            ss = wave_sum(ss);
            const float step = 0.3352f * sqrtf(ss * (1.f / D)), inv = step > 0.f ? 1.f / step : 0.f; u32x2 w = (u32x2){0u, 0u};
#pragma unroll
            for (int q = 0; q < 4; ++q) {
#pragma unroll
                for (int k = 0; k < 4; ++k) { const int qi = (int)fminf(fmaxf(floorf(v[r][q][k] * inv), -8.f), 7.f); const int idx = 4 * q + k; w[idx >> 3] |= ((unsigned)qi & 15u) << (4 * (idx & 7)); } }
            { const int lyr = row / NEXP, e = row % NEXP; *(u32x2*)(ws + WS_VB + (((size_t)lyr * 4 + (C.lane >> 4)) * NEXP + e) * 128 + 8 * (C.lane & 15)) = w; }
            if (C.lane == 0) scl[row] = step; }
    }
    for (int it = gt; it < 32 * 3072; it += ngt) {
        const int ks = it / 3072, cg = it % 3072, l = cg / 1536, n4 = (cg % 1536) * 4;
        f32x4 a0 = (f32x4){0.f, 0.f, 0.f, 0.f}, a1 = a0;
        const float* wp = a.in[I_ADAW] + ((size_t)l * D + ks * 32) * NMODV + n4; const float* c0 = a.in[I_C] + ks * 32; const float* c1 = c0 + D;
#pragma unroll 8
        for (int kk = 0; kk < 32; ++kk) { const f32x4 w = *(const f32x4*)(wp + (size_t)kk * NMODV); const float x0 = c0[kk], x1 = c1[kk]; a0 += w * (x0 * sigm(x0)); a1 += w * (x1 * sigm(x1)); }
        float* mp = (float*)(ws + WS_MODP) + (((size_t)ks * 2 + l) * 2) * NMODV + n4;
        *(f32x4*)mp = a0; *(f32x4*)(mp + NMODV) = a1;
    }
}
__device__ __forceinline__ void phase_modreduce(const Ctx& C, const Args& a) {
    const int gt = C.blk * NTHREADS + C.tid, ngt = C.nblk * NTHREADS;
    for (int i = gt; i < 2 * 2 * NMODV; i += ngt) {
        const int l = i / (2 * NMODV), n = i % NMODV; float s = a.in[I_ADAB][(size_t)l * NMODV + n];
        const float* mp = (const float*)(a.ws + WS_MODP) + i;
        for (int ks = 0; ks < 32; ++ks) s += mp[(size_t)ks * 4 * NMODV];
        ((float*)(a.ws + WS_MOD))[i] = s;
    }
}
__device__ __forceinline__ const float* modp(const Args& a, int l, int b, int v) { return (const float*)(a.ws + WS_MOD) + ((size_t)l * 2 + b) * NMODV + v * D; }

__device__ __forceinline__ void normmod_row(const f32x4 (&x)[4], const float* g, const float* sh, const float* sc, int lane, f32x4 (&h)[4]) {
    float s = 0.f;
#pragma unroll
    for (int j = 0; j < 4; ++j) s += (x[j].x * x[j].x + x[j].y * x[j].y) + (x[j].z * x[j].z + x[j].w * x[j].w);
    const float rstd = 1.f / sqrtf(wave_sum(s) * (1.f / D) + EPS);
#pragma unroll
    for (int j = 0; j < 4; ++j) { const int c = 4 * lane + 256 * j; const f32x4 gv = *(const f32x4*)(g + c), shv = *(const f32x4*)(sh + c), scv = *(const f32x4*)(sc + c);
        h[j] = (x[j] * rstd) * gv * (scv + 1.f) + shv; }
}
__device__ __forceinline__ void store_row_bf16(bf16* row, const f32x4 (&h)[4], int lane) {
#pragma unroll
    for (int j = 0; j < 4; ++j) { u32x2 w; w.x = pk2(h[j].x, h[j].y); w.y = pk2(h[j].z, h[j].w); *(u32x2*)(row + 4 * lane + 256 * j) = w; }
}
template <bool F32SRC>
__device__ __forceinline__ void phase_norm(const Ctx& C, const Args& a, const float* X, const bf16* X16, const float* g, int l, int vsh, int vsc, float* hsc, int mbeg, int mstep, int mend) {
    bf16* H = (bf16*)(a.ws + WS_H);
    for (int m0 = mbeg; m0 < mend; m0 += mstep) {
        const int b = m0 >> 13; f32x4 xf[4][4]; u32x2 xw[4][4];
#pragma unroll
        for (int i = 0; i < 4; ++i) {
#pragma unroll
            for (int j = 0; j < 4; ++j) { if (F32SRC) xf[i][j] = *(const f32x4*)(X + (size_t)(m0 + i) * D + 4 * C.lane + 256 * j); else xw[i][j] = *(const u32x2*)(X16 + (size_t)(m0 + i) * D + 4 * C.lane + 256 * j); } }
        f32x4 ga[4], sb[4]; const float* sh = modp(a, l, b, vsh); const float* sc = modp(a, l, b, vsc);
#pragma unroll
        for (int j = 0; j < 4; ++j) { const int c = 4 * C.lane + 256 * j; ga[j] = *(const f32x4*)(g + c) * (*(const f32x4*)(sc + c) + 1.f); sb[j] = *(const f32x4*)(sh + c); }
        __builtin_amdgcn_sched_barrier(0);
#pragma unroll
        for (int i = 0; i < 4; ++i) { const int m = m0 + i; f32x4 x[4], h[4]; float s = 0.f;
#pragma unroll
            for (int j = 0; j < 4; ++j) { if (F32SRC) x[j] = xf[i][j]; else x[j] = (f32x4){bflo(xw[i][j].x), bfhi(xw[i][j].x), bflo(xw[i][j].y), bfhi(xw[i][j].y)};
                s += (x[j].x * x[j].x + x[j].y * x[j].y) + (x[j].z * x[j].z + x[j].w * x[j].w); }
            const float rstd = 1.f / sqrtf(wave_sum(s) * (1.f / D) + EPS);
#pragma unroll
            for (int j = 0; j < 4; ++j) h[j] = (x[j] * rstd) * ga[j] + sb[j];
            store_row_bf16(H + (size_t)m * D, h, C.lane);
            if (hsc) { float am = 0.f;
#pragma unroll
                for (int j = 0; j < 4; ++j) am = fmaxf(am, fmaxf(fmaxf(fabsf(h[j].x), fabsf(h[j].y)), fmaxf(fabsf(h[j].z), fabsf(h[j].w))));
                am = wave_max(am); const float qs = am > 0.f ? 119.f / am : 0.f; unsigned ps01 = 0u, ps23 = 0u;
                unsigned char* hq = a.ws + WS_HQ + (size_t)m * 1024 + (C.lane >> 3) * 32 + ((C.lane & 7) >> 1) * 4 + ((C.lane & 1) ? 16 : 0);
#pragma unroll
                for (int j = 0; j < 4; ++j) { unsigned lo16 = 0u, hi16 = 0u; int ps = 0;
#pragma unroll
                    for (int k = 0; k < 4; ++k) { const int q8 = (int)rintf(h[j][k] * qs); lo16 |= ((unsigned)q8 & 15u) << (4 * k); hi16 |= ((unsigned)((q8 + 8) >> 4) & 15u) << (4 * k); ps += q8; }
                    const unsigned mine = hi16 | (lo16 << 16), other = (unsigned)__builtin_amdgcn_update_dpp(0, (int)mine, 0xB1, 0xf, 0xf, true);
                    const unsigned w = (C.lane & 1) ? ((other >> 16) | (mine & 0xffff0000u)) : ((mine & 0xffffu) | (other << 16));
                    *(unsigned*)(hq + j * 256) = w;
                    if (j < 2) ps01 += (unsigned)(ps + 512) << (16 * j); else ps23 += (unsigned)(ps + 512) << (16 * (j - 2)); }
                ps01 = wave_sum_u(ps01); ps23 = wave_sum_u(ps23);
                if (C.lane == 0) { hsc[m] = am * (1.f / 119.f);
                    *(f32x4*)((float*)(a.ws + WS_HSUM) + (size_t)m * 4) = (f32x4){(float)((int)(ps01 & 0xffffu) - 32768), (float)((int)(ps01 >> 16) - 32768), (float)((int)(ps23 & 0xffffu) - 32768), (float)((int)(ps23 >> 16) - 32768)}; } }
        }
    }
}

struct EpiIn {
    const float* bin; const float* bp; bf16 *UG, *ZP, *G;
    struct K { f32x4 a0, a1, b0, b1; };
    __device__ __forceinline__ K pre(int row0, int pn, int cl8) const {
        const float* p; int o;
        if (pn < 8) { p = bin + 128 * pn + cl8; o = 1024; } else if (pn < 12) { p = bp + 256 * (pn - 8) + cl8; o = 128; } else { p = bin + 3072 + 256 * (pn - 12) + cl8; o = 128; }
        K k; k.a0 = *(const f32x4*)p; k.a1 = *(const f32x4*)(p + 4); k.b0 = *(const f32x4*)(p + o); k.b1 = *(const f32x4*)(p + o + 4); return k;
    }
    __device__ __forceinline__ void apply(int row, int pn, int cl8, const K& k, f32x4 a0, f32x4 a1, f32x4 b0, f32x4 b1) const {
        a0 += k.a0; a1 += k.a1; b0 += k.b0; b1 += k.b1;
        if (pn < 8) {
            const int c = 128 * pn + cl8;
            f32x4 u0, u1;
#pragma unroll
            for (int i = 0; i < 4; ++i) { u0[i] = a0[i] * sigm(b0[i]); u1[i] = a1[i] * sigm(b1[i]); }
            *(u32x4*)(UG + (size_t)row * D + c) = pack8(u0, u1);
        } else if (pn < 12) {
            const int c = 256 * (pn - 8) + cl8;
            *(u32x4*)(ZP + (size_t)row * D + c) = pack8(a0, a1); *(u32x4*)(ZP + (size_t)row * D + c + 128) = pack8(b0, b1);
        } else {
            const int c = 256 * (pn - 12) + cl8;
#pragma unroll
            for (int i = 0; i < 4; ++i) { a0[i] = sigm(a0[i]); a1[i] = sigm(a1[i]); b0[i] = sigm(b0[i]); b1[i] = sigm(b1[i]); }
            *(u32x4*)(G + (size_t)row * 2048 + c) = pack8(a0, a1); *(u32x4*)(G + (size_t)row * 2048 + c + 128) = pack8(b0, b1);
        }
    }
};
struct EpiConv {
    const bf16* G; const bf16* PLp; const float* scale; bf16* Y;
    struct K { f32x4 s0, s1, s2, s3; };
    __device__ __forceinline__ K pre(int row0, int pn, int cl8) const { const float* p = scale + 256 * pn + cl8; K k; k.s0 = *(const f32x4*)p; k.s1 = *(const f32x4*)(p + 4); k.s2 = *(const f32x4*)(p + 128); k.s3 = *(const f32x4*)(p + 132); return k; }
    __device__ __forceinline__ void apply(int row, int pn, int cl8, const K& k, f32x4 a0, f32x4 a1, f32x4 b0, f32x4 b1) const {
        const int c = 256 * pn + cl8; f32x4 g0, g1, h0, h1, t0, t1;
        unpack8(*(const u32x4*)(G + (size_t)row * 2048 + c), g0, g1); unpack8(*(const u32x4*)(G + (size_t)row * 2048 + 1024 + c), h0, h1); unpack8(*(const u32x4*)(PLp + (size_t)row * D + c), t0, t1);
        *(u32x4*)(Y + (size_t)row * D + c) = pack8(a0 * g0 + h0 * k.s0 * t0, a1 * g1 + h1 * k.s1 * t1);
        unpack8(*(const u32x4*)(G + (size_t)row * 2048 + c + 128), g0, g1); unpack8(*(const u32x4*)(G + (size_t)row * 2048 + 1024 + c + 128), h0, h1); unpack8(*(const u32x4*)(PLp + (size_t)row * D + c + 128), t0, t1);
        *(u32x4*)(Y + (size_t)row * D + c + 128) = pack8(b0 * g0 + h0 * k.s2 * t0, b1 * g1 + h1 * k.s3 * t1);
    }
};
struct EpiOut {
    const float* xold32; const bf16* xold16; bf16* xnew; const float* g1;   const float* bout;
    struct K { f32x4 g[4], gb[4]; };
    __device__ __forceinline__ K pre(int row0, int pn, int cl8) const { const int c = 256 * pn + cl8; const float* g = g1 + (size_t)(row0 >> 13) * NMODV + c; const float* b = bout + c; K k;
        k.g[0] = *(const f32x4*)g; k.g[1] = *(const f32x4*)(g + 4); k.g[2] = *(const f32x4*)(g + 128); k.g[3] = *(const f32x4*)(g + 132);
        k.gb[0] = k.g[0] * *(const f32x4*)b; k.gb[1] = k.g[1] * *(const f32x4*)(b + 4); k.gb[2] = k.g[2] * *(const f32x4*)(b + 128); k.gb[3] = k.g[3] * *(const f32x4*)(b + 132); return k; }
    __device__ __forceinline__ void apply(int row, int pn, int cl8, const K& k, f32x4 a0, f32x4 a1, f32x4 b0, f32x4 b1) const {
        const int c = 256 * pn + cl8; const size_t o = (size_t)row * D + c;
        f32x4 x0, x1, y0, y1;
        if (xold32) { x0 = *(const f32x4*)(xold32 + o); x1 = *(const f32x4*)(xold32 + o + 4); y0 = *(const f32x4*)(xold32 + o + 128); y1 = *(const f32x4*)(xold32 + o + 132); }
        else { unpack8(*(const u32x4*)(xold16 + o), x0, x1); unpack8(*(const u32x4*)(xold16 + o + 128), y0, y1); }
        x0 += k.g[0] * a0 + k.gb[0]; x1 += k.g[1] * a1 + k.gb[1]; y0 += k.g[2] * b0 + k.gb[2]; y1 += k.g[3] * b1 + k.gb[3];
        *(u32x4*)(xnew + o) = pack8(x0, x1); *(u32x4*)(xnew + o + 128) = pack8(y0, y1);
    }
};
struct EpiQ {
    bf16* Q;
    struct K {}; __device__ __forceinline__ K pre(int, int, int) const { return K{}; }
    __device__ __forceinline__ void apply(int row, int pn, int cl8, const K&, f32x4 a0, f32x4 a1, f32x4 b0, f32x4 b1) const {
        const size_t o = (size_t)row * DQ + 256 * pn + cl8; *(u32x4*)(Q + o) = pack8(a0, a1); *(u32x4*)(Q + o + 128) = pack8(b0, b1);
    }
};
struct EpiWT {
    bf16* W;
    struct K {}; __device__ __forceinline__ K pre(int, int, int) const { return K{}; }
    __device__ __forceinline__ void apply(int row, int pn, int cl8, const K&, f32x4 a0, f32x4 a1, f32x4 b0, f32x4 b1) const {
        const size_t o = (size_t)row * D + 256 * pn + cl8; *(u32x4*)(W + o) = pack8(a0, a1); *(u32x4*)(W + o + 128) = pack8(b0, b1);
    }
};
typedef _Float16 f16x2 __attribute__((ext_vector_type(2)));
__device__ __forceinline__ unsigned pkh(float lo, float hi) { return __builtin_bit_cast(unsigned, __builtin_amdgcn_cvt_pkrtz(lo, hi)); }
struct EpiS {
    unsigned short* S;
    struct K {}; __device__ __forceinline__ K pre(int, int, int) const { return K{}; }
    __device__ __forceinline__ void apply(int row, int pn, int cl8, const K&, f32x4 a0, f32x4 a1, f32x4 b0, f32x4 b1) const {
        const size_t o = (size_t)row * DQ + 256 * pn + cl8;
        *(u32x4*)(S + o) = (u32x4){pkh(a0.x, a0.y), pkh(a0.z, a0.w), pkh(a1.x, a1.y), pkh(a1.z, a1.w)}; *(u32x4*)(S + o + 128) = (u32x4){pkh(b0.x, b0.y), pkh(b0.z, b0.w), pkh(b1.x, b1.y), pkh(b1.z, b1.w)};
    }
};

namespace pg8 {
#define PG8_LAS __attribute__((address_space(3)))
typedef unsigned short bf16_t;
typedef short bf16x8 __attribute__((ext_vector_type(8)));
typedef float f32x4 __attribute__((ext_vector_type(4)));
typedef unsigned u32x4 __attribute__((ext_vector_type(4)));
constexpr int BM = 256, BK = 64, HALF = 128, HTB = HALF * BK * 2  , STAGE_BYTES = 8 * HTB, NXCD = 8, WGM = 8;

__host__ __device__ __forceinline__ int lds_byte(int r, int c) { const int st = (r >> 4) * 2 + (c >> 5), rr = r & 15, cc = c & 31, ob = rr * 64 + cc * 2; return st * 1024 + (ob ^ (((ob >> 9) & 1) << 5)); }
__host__ __device__ __forceinline__ void stage_rc(int b, int& R, int& C) { const int st = b / 1024, sb = b % 1024, swz = sb ^ (((sb >> 9) & 1) << 5); R = (st >> 1) * 16 + swz / 64; C = (st & 1) * 32 + (swz % 64) / 2; }
__host__ __device__ __forceinline__ int perm32(int rho) { const int n = rho >> 4, i = rho & 15; return 8 * (i >> 2) + 4 * n + (i & 3); }

struct Unit { int pm, pn; };
struct Gemm { const bf16_t* A; const bf16_t* Bt; int M, N, K, lda, ldb, acol, bcol; };

struct StaticOrder {
    int nM, nN, nwg, G, c;
    __host__ __device__ void init(int M, int N, int G_, int c_) { nM = M / BM; nN = N / BM; nwg = nM * nN; G = G_; c = c_; }
    __host__ __device__ bool next(int i, Unit& u) const {
        const long L = (long)i * G + c; if (L >= nwg) return false;
        int wgid = (int)L; { const int q = nwg / NXCD, r = nwg % NXCD, xcd = wgid % NXCD, off = wgid / NXCD; wgid = (xcd < r ? xcd * (q + 1) : r * (q + 1) + (xcd - r) * q) + off; }
        const int nig = WGM * nN, gid = wgid / nig, fm = gid * WGM, gsz = (nM - fm) < WGM ? (nM - fm) : WGM;
        u.pm = fm + ((wgid % nig) % gsz); u.pn = (wgid % nig) / gsz; return true;
    }
    __device__ __forceinline__ void a_ready(const Unit&) const {}
    __device__ __forceinline__ void done(const Unit&) const {}
};


template <class Epi, class Sched, bool ALIGN_EPI = false, bool SP2 = false>
__device__ __forceinline__ void gemm_phase(PG8_LAS unsigned char* lds, const Gemm g, const Sched& S, const Epi& E, const int tid) {
    const int wid = __builtin_amdgcn_readfirstlane(tid >> 6), lane = tid & 63, wr = wid >> 2, wc = wid & 3, fr = lane & 15, fq = lane >> 4;
    const int K = g.K, nt = K / BK;
    unsigned voffA[2], voffB[2];
#pragma unroll
    for (int i = 0; i < 2; ++i) { int R, C; stage_rc(tid * 16 + i * 8192, R, C); const int Rb = Epi::PERM ? ((R & ~31) + perm32(R & 31)) : R;
        voffA[i] = (unsigned)(R * g.lda + C) * 2u; voffB[i] = (unsigned)(Rb * g.ldb + C) * 2u; }
    const size_t kstep = (size_t)(BK * 2);
    const size_t hstepA = (size_t)HALF * g.lda * 2, hstepB = (size_t)HALF * g.ldb * 2;
    const size_t tstepA = 2 * hstepA, tstepB = 2 * hstepB, acolb = (size_t)g.acol * 2, bcolb = (size_t)g.bcol * 2;
    const unsigned ldsw = (unsigned)wid * 1024u;
    const int aoff = lds_byte(wr * 64 + fr, fq * 8), boff = lds_byte(wc * 32 + fr, fq * 8);
#define PG8_SA(b, h) (((b) * 2 + (h)) * HTB)
#define PG8_SB(b, h) ((4 + (b) * 2 + (h)) * HTB)
#define PG8_STAGE(bufoff, gbase, voff) do { _Pragma("unroll") for (int _i = 0; _i < 2; ++_i) \
        __builtin_amdgcn_global_load_lds((const unsigned*)((const char*)(gbase) + (voff)[_i]), (PG8_LAS unsigned*)(lds + (bufoff) + ldsw + _i * 8192), 16, 0, 0); } while (0)
#define PG8_LDA(dst, b, h) do { _Pragma("unroll") for (int m = 0; m < 4; ++m) _Pragma("unroll") for (int k = 0; k < 2; ++k) dst[m][k] = *(const PG8_LAS bf16x8*)(lds + PG8_SA(b, h) + aoff + m * 2048 + k * 1024); } while (0)
#define PG8_LDB(dst, b, h) do { _Pragma("unroll") for (int n = 0; n < 2; ++n) _Pragma("unroll") for (int k = 0; k < 2; ++k) dst[n][k] = *(const PG8_LAS bf16x8*)(lds + PG8_SB(b, h) + boff + n * 2048 + k * 1024); } while (0)
#define PG8_MMA(ai, bj, At, Bt) do { __builtin_amdgcn_s_setprio(1); _Pragma("unroll") for (int m = 0; m < 4; ++m) _Pragma("unroll") for (int n = 0; n < 2; ++n) _Pragma("unroll") for (int k = 0; k < 2; ++k) \
        acc[ai][bj][m][n] = __builtin_amdgcn_mfma_f32_16x16x32_bf16(Bt[n][k], At[m][k], acc[ai][bj][m][n], 0, 0, 0); __builtin_amdgcn_s_setprio(0); } while (0)
#define PG8_WAIT_V(n) asm volatile("s_waitcnt vmcnt(" #n ")" ::: "memory")
#define PG8_WAIT_L(n) asm volatile("s_waitcnt lgkmcnt(" #n ")" ::: "memory")
#define PG8_BAR __builtin_amdgcn_s_barrier()
#define PG8_SCHED __builtin_amdgcn_sched_barrier(0)
    Unit cur, nxt; int ui = 0;
    if (!S.next(0, cur)) return;
    f32x4 acc[2][2][4][2];
#pragma unroll
    for (int a = 0; a < 2; ++a)
#pragma unroll
        for (int b = 0; b < 2; ++b)
#pragma unroll
            for (int m = 0; m < 4; ++m)
#pragma unroll
                for (int n = 0; n < 2; ++n) acc[a][b][m][n] = (f32x4){0.f, 0.f, 0.f, 0.f};
    bf16x8 At[4][2], B0[2][2], B1[2][2];
    const char* cA = (const char*)g.A + (size_t)cur.pm * tstepA + (size_t)cur.pn * acolb; const char* cB = (const char*)g.Bt + (size_t)cur.pn * tstepB + (size_t)cur.pm * bcolb;
    S.a_ready(cur);
    if constexpr (SP2) {
        PG8_STAGE(PG8_SB(0, 0), cB, voffB); PG8_STAGE(PG8_SB(0, 1), cB + hstepB, voffB); PG8_STAGE(PG8_SA(0, 0), cA, voffA); PG8_STAGE(PG8_SA(0, 1), cA + hstepA, voffA);
        if (wr == 1) PG8_BAR;
        PG8_WAIT_V(2); PG8_BAR;
        PG8_STAGE(PG8_SB(1, 0), cB + kstep, voffB); PG8_STAGE(PG8_SA(1, 0), cA + kstep, voffA); PG8_STAGE(PG8_SB(1, 1), cB + hstepB + kstep, voffB);
        PG8_WAIT_V(6); PG8_BAR;
    } else {
        PG8_STAGE(PG8_SB(0, 0), cB, voffB); PG8_STAGE(PG8_SA(0, 0), cA, voffA); PG8_STAGE(PG8_SB(0, 1), cB + hstepB, voffB); PG8_STAGE(PG8_SA(0, 1), cA + hstepA, voffA);
        if (wr == 1) PG8_BAR;
        PG8_WAIT_V(4); PG8_BAR;
        PG8_STAGE(PG8_SB(1, 0), cB + kstep, voffB); PG8_STAGE(PG8_SA(1, 0), cA + kstep, voffA); PG8_STAGE(PG8_SB(1, 1), cB + hstepB + kstep, voffB);
        PG8_WAIT_V(6); PG8_BAR;
    }
    for (;;) {
        const bool has_next = S.next(ui + 1, nxt);
        const char* nA = has_next ? (const char*)g.A + (size_t)nxt.pm * tstepA + (size_t)nxt.pn * acolb : cA; const char* nB = has_next ? (const char*)g.Bt + (size_t)nxt.pn * tstepB + (size_t)nxt.pm * bcolb : cB;
#pragma nounroll
        for (int t = 0; t < nt; t += 2) {
            const bool last = (t == nt - 2);
            const char* a1 = cA + (size_t)(t + 1) * kstep;
            const char* a2 = last ? nA : cA + (size_t)(t + 2) * kstep; const char* b2 = last ? nB : cB + (size_t)(t + 2) * kstep;
            const char* a3 = a2 + kstep; const char* b3 = b2 + kstep;
            if (last && has_next) S.a_ready(nxt);
            if constexpr (SP2) {
            PG8_LDB(B0, 0, 0); PG8_LDB(B1, 0, 1); PG8_SCHED; PG8_LDA(At, 0, 0); PG8_STAGE(PG8_SA(1, 1), a1 + hstepA, voffA);
            PG8_WAIT_V(8); PG8_WAIT_L(0); PG8_BAR; PG8_MMA(0, 0, At, B0); PG8_MMA(0, 1, At, B1); PG8_BAR; PG8_SCHED;
            PG8_LDA(At, 0, 1); PG8_STAGE(PG8_SB(0, 0), b2, voffB); PG8_STAGE(PG8_SB(0, 1), b2 + hstepB, voffB); PG8_STAGE(PG8_SA(0, 0), a2, voffA);
            PG8_WAIT_V(8); PG8_WAIT_L(0); PG8_BAR; PG8_MMA(1, 0, At, B0); PG8_MMA(1, 1, At, B1); PG8_BAR; PG8_SCHED;
            PG8_LDB(B0, 1, 0); PG8_LDB(B1, 1, 1); PG8_SCHED; PG8_LDA(At, 1, 0); PG8_STAGE(PG8_SA(0, 1), a2 + hstepA, voffA);
            PG8_WAIT_V(8); PG8_WAIT_L(0); PG8_BAR; PG8_MMA(0, 0, At, B0); PG8_MMA(0, 1, At, B1); PG8_BAR; PG8_SCHED;
            PG8_LDA(At, 1, 1); PG8_STAGE(PG8_SB(1, 0), b3, voffB); PG8_STAGE(PG8_SB(1, 1), b3 + hstepB, voffB); PG8_STAGE(PG8_SA(1, 0), a3, voffA);
            PG8_WAIT_V(8); PG8_WAIT_L(0); PG8_BAR; PG8_MMA(1, 0, At, B0); PG8_MMA(1, 1, At, B1); PG8_BAR; PG8_SCHED;
            } else {
            PG8_LDB(B0, 0, 0); PG8_SCHED; PG8_LDA(At, 0, 0); PG8_STAGE(PG8_SA(1, 1), a1 + hstepA, voffA);
            PG8_WAIT_L(8); PG8_BAR; PG8_WAIT_L(0); PG8_MMA(0, 0, At, B0); PG8_BAR; PG8_SCHED;
            PG8_LDB(B1, 0, 1); PG8_STAGE(PG8_SB(0, 0), b2, voffB);
            PG8_BAR; PG8_WAIT_L(0); PG8_MMA(0, 1, At, B1); PG8_BAR;
            PG8_LDA(At, 0, 1); PG8_STAGE(PG8_SA(0, 0), a2, voffA);
            PG8_BAR; PG8_WAIT_L(0); PG8_MMA(1, 0, At, B0); PG8_BAR; PG8_SCHED;
            PG8_STAGE(PG8_SB(0, 1), b2 + hstepB, voffB);
            PG8_WAIT_V(6); PG8_BAR; PG8_MMA(1, 1, At, B1); PG8_BAR;
            PG8_LDB(B0, 1, 0); PG8_SCHED; PG8_LDA(At, 1, 0); PG8_STAGE(PG8_SA(0, 1), a2 + hstepA, voffA);
            PG8_WAIT_L(8); PG8_BAR; PG8_WAIT_L(0); PG8_MMA(0, 0, At, B0); PG8_BAR; PG8_SCHED;
            PG8_LDB(B1, 1, 1); PG8_STAGE(PG8_SB(1, 0), b3, voffB);
            PG8_BAR; PG8_WAIT_L(0); PG8_MMA(0, 1, At, B1); PG8_BAR;
            PG8_LDA(At, 1, 1); PG8_STAGE(PG8_SA(1, 0), a3, voffA);
            PG8_BAR; PG8_WAIT_L(0); PG8_MMA(1, 0, At, B0); PG8_BAR; PG8_SCHED;
            PG8_STAGE(PG8_SB(1, 1), b3 + hstepB, voffB);
            PG8_WAIT_V(6); PG8_BAR; PG8_MMA(1, 1, At, B1); PG8_BAR;
            }
        }
        if constexpr (ALIGN_EPI) { if (wr == 0) PG8_BAR; }
        if constexpr (!Epi::AFTER_DRAIN) { E(acc, cur, wr, wc, fr, fq); S.done(cur); }
        if (!has_next) break;
#pragma unroll
        for (int a = 0; a < 2; ++a)
#pragma unroll
            for (int b = 0; b < 2; ++b)
#pragma unroll
                for (int m = 0; m < 4; ++m)
#pragma unroll
                    for (int n = 0; n < 2; ++n) acc[a][b][m][n] = (f32x4){0.f, 0.f, 0.f, 0.f};
        cur = nxt; cA = nA; cB = nB; ++ui;
        if constexpr (ALIGN_EPI) { if (wr == 1) PG8_BAR; }
    }
    PG8_WAIT_V(0);
    if constexpr (!ALIGN_EPI) { if (wr == 0) PG8_BAR; }
    PG8_BAR;
    if constexpr (Epi::AFTER_DRAIN) { E.fused(acc, cur, wr, wc, fr, fq, lds, wid, lane); S.done(cur); }
#undef PG8_SA
#undef PG8_SB
#undef PG8_STAGE
#undef PG8_LDA
#undef PG8_LDB
#undef PG8_MMA
#undef PG8_WAIT_V
#undef PG8_WAIT_L
#undef PG8_BAR
#undef PG8_SCHED
}

template <class F> struct EpiW {
    static constexpr bool PERM = true, AFTER_DRAIN = false; F f;
    __device__ __forceinline__ void operator()(const f32x4 (&acc)[2][2][4][2], const Unit& u, int wr, int wc, int fr, int fq) const {
        const typename F::K kc = f.pre(u.pm * BM, u.pn, wc * 32 + 8 * fq);
#pragma unroll
        for (int ai = 0; ai < 2; ++ai)
#pragma unroll
            for (int m = 0; m < 4; ++m) { f.apply(u.pm * BM + ai * HALF + wr * 64 + m * 16 + fr, u.pn, wc * 32 + 8 * fq, kc, acc[ai][0][m][0], acc[ai][0][m][1], acc[ai][1][m][0], acc[ai][1][m][1]);
                asm volatile("" ::: "memory"); }
    }
};
}

template <class F>
__device__ __forceinline__ void mfma_gemm(const Ctx& C, const bf16* A, int lda, int acol, const bf16* Bt, int ldb, int Mr, int N, int K, const F& f, int bcol = 0, int blk_off = 0) {
    pg8::Gemm g{A, Bt, Mr, N, K, lda, ldb, acol, bcol}; pg8::StaticOrder S; S.init(Mr, N, C.nblk, (C.blk + C.nblk - blk_off) % C.nblk); pg8::EpiW<F> E{f};
    pg8::gemm_phase<pg8::EpiW<F>, pg8::StaticOrder, true, true>(C.lds, g, S, E, C.tid);
}

template <int NROWS> struct CpStage { static constexpr int NIT = (NROWS * 128 + NTHREADS - 1) / NTHREADS; u32x4 v[NIT]; };
template <int NROWS>
__device__ __forceinline__ void cp_stage_load(CpStage<NROWS>& st, const bf16* src, int mrow0, int tfirst, int tid) {
    asm volatile("" : "+v"(tid));
#pragma unroll
    for (int i = 0; i < CpStage<NROWS>::NIT; ++i) { const int ch = i * NTHREADS + tid, r = ch >> 7, c = ch & 127; st.v[i] = (u32x4){0u, 0u, 0u, 0u};
        if (ch < NROWS * 128 && tfirst + r >= 0) st.v[i] = *(const u32x4*)(src + (size_t)(mrow0 + r) * D + c * 8); }
}
template <int NROWS>
__device__ __forceinline__ void cp_stage_store(const CpStage<NROWS>& st, LAS unsigned char* tile, int tid) {
    asm volatile("" : "+v"(tid));
#pragma unroll
    for (int i = 0; i < CpStage<NROWS>::NIT; ++i) { const int ch = i * NTHREADS + tid; if (ch < NROWS * 128) *(LAS u32x4*)(tile + ch * 16) = st.v[i]; }
}
template <int W>
__device__ __forceinline__ void pool_item(const LAS unsigned char* tile, bf16* PL, int m0, int t0, int tid) {
    asm volatile("" : "+v"(tid));
    float s0 = 0.f, s1 = 0.f;
#pragma unroll
    for (int j = 1; j < W; ++j) { const unsigned w = *(const LAS unsigned*)(tile + (15 - j) * 2048 + 4 * tid); s0 += bflo(w); s1 += bfhi(w); }
#pragma unroll
    for (int ti = 0; ti < 32; ++ti) {
        const unsigned wc = *(const LAS unsigned*)(tile + (ti + 15) * 2048 + 4 * tid); const float c0 = bflo(wc), c1 = bfhi(wc);
        s0 += c0; s1 += c1;
        const float inv = (t0 == 0 && ti + 1 < W) ? (1.f / (float)(ti + 1)) : (1.f / (float)W);
        *(unsigned*)(PL + (size_t)(m0 + ti) * D + 2 * tid) = pk2(s0 * inv - c0, s1 * inv - c1);
        { const unsigned wo = *(const LAS unsigned*)(tile + (ti + 16 - W) * 2048 + 4 * tid); s0 -= bflo(wo); s1 -= bfhi(wo); }
    }
}
template <int RI>
__device__ __forceinline__ void conv_row(const LAS unsigned char* tile, int tid, const float (&w0)[31], const float (&w1)[31], float (&a0)[32], float (&a1)[32]) {
    const unsigned w = *(const LAS unsigned*)(tile + RI * 2048 + 4 * tid);
    const float u0 = bflo(w), u1 = bfhi(w);
#pragma unroll
    for (int ti = 0; ti < 32; ++ti) { constexpr int dbase = 30 - RI; const int d = ti + dbase; if (d >= 0 && d <= 30) { a0[ti] += w0[30 - d] * u0; a1[ti] += w1[30 - d] * u1; } }
    if constexpr ((RI & 7) == 7) asm volatile("" ::: "memory");
}
template <int... RI>
__device__ __forceinline__ void conv_rows(const LAS unsigned char* tile, int tid, const float (&w0)[31], const float (&w1)[31], float (&a0)[32], float (&a1)[32], std::integer_sequence<int, RI...>) {
    (conv_row<RI>(tile, tid, w0, w1, a0, a1), ...);
}
__device__ __forceinline__ void phase_convpool(const Ctx& C, const Args& a, int l, int item0, int istep, int iend) {
    const bf16* UG = (const bf16*)(a.ws + WS_UG); const bf16* ZP = (const bf16*)(a.ws + WS_ZP);
    bf16* AC = (bf16*)(a.ws + WS_AC); bf16* PL = (bf16*)(a.ws + WS_PL);
    const float* cw = a.in[I_CONVW] + (size_t)l * CONVK * D; const float* cb = a.in[I_CONVB] + (size_t)l * D;
    const float* lng = a.in[I_LNG] + (size_t)l * D; const float* lnb = a.in[I_LNB] + (size_t)l * D;
    LAS float* red = (LAS float*)C.lds;
    LAS float* stat = (LAS float*)(C.lds + 2048);
    LAS unsigned char* tile = C.lds + 4096;
    int tid = C.tid;
    asm volatile("" : "+v"(tid));
    const int c0 = 2 * tid;
    float w0[31], w1[31];
#pragma unroll
    for (int k = 0; k < 31; ++k) { const f32x2 w = *(const f32x2*)(cw + (size_t)k * D + c0); w0[k] = w.x; w1[k] = w.y; }
    const f32x2 bb = *(const f32x2*)(cb + c0), gg = *(const f32x2*)(lng + c0), be = *(const f32x2*)(lnb + c0);
    for (int item = item0; item < iend; item += istep) {
        const int m0 = item * 32, t0 = m0 & (SEQ - 1);
        __syncthreads();
        { CpStage<62> su; cp_stage_load<62>(su, UG, m0 - 30, t0 - 30, tid); cp_stage_store<62>(su, tile, tid); }
        __syncthreads();
        float a0[32], a1[32];
#pragma unroll
        for (int i = 0; i < 32; ++i) { a0[i] = bb.x; a1[i] = bb.y; }
        conv_rows(tile, tid, w0, w1, a0, a1, std::make_integer_sequence<int, 62>{});
        CpStage<47> sp; cp_stage_load<47>(sp, ZP, m0 - 15, t0 - 15, tid);
#pragma unroll
        for (int ti = 0; ti < 32; ++ti) {
            const float s = dpp_sum63(a0[ti] + a1[ti]), q = dpp_sum63(a0[ti] * a0[ti] + a1[ti] * a1[ti]);
            if (C.lane == 63) { red[C.wave * 64 + ti] = s; red[C.wave * 64 + 32 + ti] = q; }
        }
        __syncthreads();
        if (tid < 32) { float s = 0.f, q = 0.f;
#pragma unroll
            for (int w = 0; w < 8; ++w) { s += red[w * 64 + tid]; q += red[w * 64 + 32 + tid]; }
            const float mean = s * (1.f / D), var = fmaxf(q * (1.f / D) - mean * mean, 0.f); stat[tid] = mean; stat[32 + tid] = 1.f / sqrtf(var + EPS); }
        __syncthreads();
#pragma unroll
        for (int ti = 0; ti < 32; ++ti) { const float mean = stat[ti], rstd = stat[32 + ti];
            const float y0 = (a0[ti] - mean) * rstd * gg.x + be.x, y1 = (a1[ti] - mean) * rstd * gg.y + be.y;
            *(unsigned*)(AC + (size_t)(m0 + ti) * D + c0) = pk2(y0 * sigm(y0), y1 * sigm(y1)); }
        asm volatile("" ::: "memory");
        cp_stage_store<47>(sp, tile, tid);
        __syncthreads();
        const int g = tid >> 7;
        if (g == 0) pool_item<2>(tile, PL, m0, t0, tid); else if (g == 1) pool_item<4>(tile, PL, m0, t0, tid); else if (g == 2) pool_item<8>(tile, PL, m0, t0, tid); else pool_item<16>(tile, PL, m0, t0, tid);
    }
}

typedef unsigned u32;
template <int CTRL> __device__ __forceinline__ u32 dppu(u32 x) { return (u32)__builtin_amdgcn_update_dpp(0, (int)x, CTRL, 0xf, 0xf, true); }
constexpr int DPP_XOR1 = 0xB1, DPP_REV4 = 0x1B, DPP_DUPE = 0xA0, DPP_DUPO = 0xF5, DPP_HMIRROR = 0x141, DPP_MIRROR = 0x140;
__device__ __forceinline__ u32 umax_(u32 a, u32 b) { return a > b ? a : b; }
__device__ __forceinline__ u32 umin_(u32 a, u32 b) { return a < b ? a : b; }
#define TK_CE(x, i, j) do { const u32 hi_ = umax_(x[i], x[j]), lo_ = umin_(x[i], x[j]); x[i] = hi_; x[j] = lo_; } while (0)
__device__ __forceinline__ void tk_local_merge(u32 (&x)[8]) {
    TK_CE(x, 0, 4); TK_CE(x, 1, 5); TK_CE(x, 2, 6); TK_CE(x, 3, 7);
    TK_CE(x, 0, 2); TK_CE(x, 1, 3); TK_CE(x, 4, 6); TK_CE(x, 5, 7);
    TK_CE(x, 0, 1); TK_CE(x, 2, 3); TK_CE(x, 4, 5); TK_CE(x, 6, 7);
}
template <int CTRL> __device__ __forceinline__ void tk_level(u32 (&x)[8], bool even) {
    u32 t[8];
#pragma unroll
    for (int c = 0; c < 8; ++c) t[c] = dppu<CTRL>(x[7 - c]);
#pragma unroll
    for (int c = 0; c < 8; ++c) x[c] = umax_(x[c], t[c]);
#pragma unroll
    for (int c = 0; c < 8; ++c) { const u32 p = dppu<DPP_XOR1>(x[c]); x[c] = even ? umax_(x[c], p) : umin_(x[c], p); }
    tk_local_merge(x);
}
__device__ __forceinline__ void tk_top16(u32 (&x)[8], bool even) {
    TK_CE(x, 0, 1); TK_CE(x, 2, 3); TK_CE(x, 4, 5); TK_CE(x, 6, 7);
    TK_CE(x, 0, 2); TK_CE(x, 1, 3); TK_CE(x, 4, 6); TK_CE(x, 5, 7);
    TK_CE(x, 1, 2); TK_CE(x, 5, 6);
    TK_CE(x, 0, 4); TK_CE(x, 1, 5); TK_CE(x, 2, 6); TK_CE(x, 3, 7);
    TK_CE(x, 2, 4); TK_CE(x, 3, 5);
    TK_CE(x, 1, 2); TK_CE(x, 3, 4); TK_CE(x, 5, 6);
    { u32 t[8];
#pragma unroll
      for (int c = 0; c < 8; ++c) t[c] = dppu<DPP_XOR1>(x[7 - c]);
#pragma unroll
      for (int c = 0; c < 8; ++c) x[c] = even ? umax_(x[c], t[c]) : umin_(x[c], t[c]); }
    tk_local_merge(x);
    tk_level<DPP_REV4>(x, even); tk_level<DPP_HMIRROR>(x, even); tk_level<DPP_MIRROR>(x, even);
}
__device__ __forceinline__ u32 tk_f2key(float v, int slot) { const u32 u = __builtin_bit_cast(u32, v); const u32 k = u ^ ((u32)((int)u >> 31) | 0x80000000u); return (k & ~127u) | (u32)(127 - slot); }
__device__ __forceinline__ float tk_key2f(u32 k) { k &= ~127u; const u32 m = (u32)((int)k >> 31); return __builtin_bit_cast(float, k ^ (~m | 0x80000000u)); }
__device__ __forceinline__ u32 tk_sel8v(u32 r0, u32 r1, u32 r2, u32 r3, u32 r4, u32 r5, u32 r6, u32 r7, int idx) {
    const bool b0 = idx & 1, b1 = idx & 2, b2 = idx & 4;
    const u32 s01 = b0 ? r1 : r0, s23 = b0 ? r3 : r2, s45 = b0 ? r5 : r4, s67 = b0 ? r7 : r6;
    const u32 s03 = b1 ? s23 : s01, s47 = b1 ? s67 : s45;
    return b2 ? s47 : s03; }
#define tk_sel8(r, idx) tk_sel8v(r[0], r[1], r[2], r[3], r[4], r[5], r[6], r[7], idx)
__device__ __forceinline__ void tk2_sort16(u32 (&x)[16]) { TK_CE(x, 0, 1); TK_CE(x, 2, 3); TK_CE(x, 0, 2); TK_CE(x, 1, 3); TK_CE(x, 1, 2); TK_CE(x, 4, 5); TK_CE(x, 6, 7); TK_CE(x, 4, 6); TK_CE(x, 5, 7); TK_CE(x, 5, 6); TK_CE(x, 0, 4); TK_CE(x, 2, 6); TK_CE(x, 2, 4); TK_CE(x, 1, 5); TK_CE(x, 3, 7); TK_CE(x, 3, 5); TK_CE(x, 1, 2); TK_CE(x, 3, 4); TK_CE(x, 5, 6); TK_CE(x, 8, 9); TK_CE(x, 10, 11); TK_CE(x, 8, 10); TK_CE(x, 9, 11); TK_CE(x, 9, 10); TK_CE(x, 12, 13); TK_CE(x, 14, 15); TK_CE(x, 12, 14); TK_CE(x, 13, 15); TK_CE(x, 13, 14); TK_CE(x, 8, 12); TK_CE(x, 10, 14); TK_CE(x, 10, 12); TK_CE(x, 9, 13); TK_CE(x, 11, 15); TK_CE(x, 11, 13); TK_CE(x, 9, 10); TK_CE(x, 11, 12); TK_CE(x, 13, 14); TK_CE(x, 0, 8); TK_CE(x, 4, 12); TK_CE(x, 4, 8); TK_CE(x, 2, 10); TK_CE(x, 6, 14); TK_CE(x, 6, 10); TK_CE(x, 2, 4); TK_CE(x, 6, 8); TK_CE(x, 10, 12); TK_CE(x, 1, 9); TK_CE(x, 5, 13); TK_CE(x, 5, 9); TK_CE(x, 3, 11); TK_CE(x, 7, 15); TK_CE(x, 7, 11); TK_CE(x, 3, 5); TK_CE(x, 7, 9); TK_CE(x, 11, 13); TK_CE(x, 1, 2); TK_CE(x, 3, 4); TK_CE(x, 5, 6); TK_CE(x, 7, 8); TK_CE(x, 9, 10); TK_CE(x, 11, 12); TK_CE(x, 13, 14); }
__device__ __forceinline__ void tk2_merge16(u32 (&x)[16]) { TK_CE(x, 0, 8); TK_CE(x, 1, 9); TK_CE(x, 2, 10); TK_CE(x, 3, 11); TK_CE(x, 4, 12); TK_CE(x, 5, 13); TK_CE(x, 6, 14); TK_CE(x, 7, 15); TK_CE(x, 0, 4); TK_CE(x, 1, 5); TK_CE(x, 2, 6); TK_CE(x, 3, 7); TK_CE(x, 8, 12); TK_CE(x, 9, 13); TK_CE(x, 10, 14); TK_CE(x, 11, 15); TK_CE(x, 0, 2); TK_CE(x, 1, 3); TK_CE(x, 4, 6); TK_CE(x, 5, 7); TK_CE(x, 8, 10); TK_CE(x, 9, 11); TK_CE(x, 12, 14); TK_CE(x, 13, 15); TK_CE(x, 0, 1); TK_CE(x, 2, 3); TK_CE(x, 4, 5); TK_CE(x, 6, 7); TK_CE(x, 8, 9); TK_CE(x, 10, 11); TK_CE(x, 12, 13); TK_CE(x, 14, 15); }
template <int CTRL> __device__ __forceinline__ void tk2_level(u32 (&x)[16]) {
    u32 t[16];
#pragma unroll
    for (int c = 0; c < 16; ++c) t[c] = dppu<CTRL>(x[15 - c]);
#pragma unroll
    for (int c = 0; c < 16; ++c) x[c] = umax_(x[c], t[c]);
    tk2_merge16(x);
}
__device__ __forceinline__ void tk2_top16(u32 (&x)[16]) { tk2_sort16(x); tk2_level<DPP_XOR1>(x); tk2_level<DPP_REV4>(x); tk2_level<DPP_HMIRROR>(x); }
__device__ __forceinline__ u32 tk_sel16v(u32 r0, u32 r1, u32 r2, u32 r3, u32 r4, u32 r5, u32 r6, u32 r7, u32 r8, u32 r9, u32 r10, u32 r11, u32 r12, u32 r13, u32 r14, u32 r15, int idx) {
    const u32 lo = tk_sel8v(r0, r1, r2, r3, r4, r5, r6, r7, idx & 7), hi = tk_sel8v(r8, r9, r10, r11, r12, r13, r14, r15, idx & 7); return (idx & 8) ? hi : lo; }
__device__ __forceinline__ float tk_key2f_h(u32 k) { const u32 kk = k & 0xffff0000u, m = (u32)((int)kk >> 31); const u32 hb = kk ^ (0x80000000u | (~m & 0x7fff0000u));
    return (float)__builtin_bit_cast(f16x2, hb).y; }
__device__ __forceinline__ u32 tk_sel4v(u32 a0, u32 a1, u32 a2, u32 a3, int idx) { const u32 s01 = (idx & 1) ? a1 : a0, s23 = (idx & 1) ? a3 : a2; return (idx & 2) ? s23 : s01; }
__device__ __forceinline__ void tk4_half(const unsigned short* sp, int r, u32 (&y)[16]) {
    typedef short s16x2 __attribute__((ext_vector_type(2)));
    u32 lo[16], hi[16];
#pragma unroll
    for (int c4 = 0; c4 < 4; ++c4) { const u32x4 v = *(const u32x4*)(sp + 8 * c4);
#pragma unroll
        for (int c = 0; c < 4; ++c) { const u32 vc = v[c]; const int e = 8 * c4 + 2 * c;
            const u32 mv = __builtin_bit_cast(u32, __builtin_bit_cast(s16x2, vc) >> (s16x2){15, 15});
            const u32 tv = vc ^ (mv | 0x80008000u), s0 = (u32)(127 - (32 * r + e)), s1 = s0 - 1u;
            if (e < 16) { lo[e] = (tv << 16) | s0; lo[e + 1] = (tv & 0xffff0000u) | s1; } else { hi[e - 16] = (tv << 16) | s0; hi[e - 15] = (tv & 0xffff0000u) | s1; } } }
    tk2_sort16(lo); tk2_sort16(hi);
#pragma unroll
    for (int c = 0; c < 16; ++c) y[c] = umax_(lo[c], hi[15 - c]);
    tk2_merge16(y); tk2_level<DPP_XOR1>(y); tk2_level<DPP_REV4>(y);
}
__device__ __forceinline__ u32 tk4_ckey(float v, u32 ia7, u32 ib, bool valid) {
    const u32 fx = umin_((u32)fmaxf((v + 64.f) * 2048.f, 0.f), 0x3ffffu); return valid ? ((fx << 14) | ia7 | ib) : 0u; }
__device__ __forceinline__ void phase_topk(const Ctx& C, const Args& a) {
    const unsigned short* S = (const unsigned short*)(a.ws + WS_S); int* EID = (int*)(a.ws + WS_EID); float* GW = (float*)(a.ws + WS_GW);
    const int lane = C.lane, r = lane & 3, qd = lane >> 2;
    pg8::StaticOrder SO; SO.init(M, DQ, C.nblk, C.blk); pg8::Unit un;
    for (int ui = 0; SO.next(ui, un); ++ui)
    for (int wi = C.wave; wi < 16; wi += NWAVES) {
        const int tok = un.pm * 256 + wi * 16 + qd, h = un.pn;
        u32 ya[16], yb[16];
        { const unsigned short* sp = S + (size_t)tok * DQ + h * 256 + 32 * r; tk4_half(sp, r, ya); tk4_half(sp + 128, r, yb); }
        const u32 kb0 = tk_sel4v(yb[0], yb[1], yb[2], yb[3], r), kb1 = tk_sel4v(yb[4], yb[5], yb[6], yb[7], r), kb2 = tk_sel4v(yb[8], yb[9], yb[10], yb[11], r), kb3 = tk_sel4v(yb[12], yb[13], yb[14], yb[15], r);
        const float vb0 = tk_key2f_h(kb0), vb1 = tk_key2f_h(kb1), vb2 = tk_key2f_h(kb2), vb3 = tk_key2f_h(kb3);
        const u32 ib0 = kb0 & 127u, ib1 = kb1 & 127u, ib2 = kb2 & 127u, ib3 = kb3 & 127u;
        const int limA = (r == 0) ? 15 : (r == 1) ? 7 : (r == 2) ? 4 : 3, limB = (r == 0) ? 2 : 1;
        u32 y[16], l5[5]; float va0 = 0.f; u32 ia0 = 0u;
#pragma unroll
        for (int c = 0; c < 16; ++c) { const float va = tk_key2f_h(ya[c]); const u32 ia7 = (ya[c] & 127u) << 7; if (c == 0) { va0 = va; ia0 = ia7; }
            y[c] = tk4_ckey(va + vb0, ia7, ib0, c <= limA);
            if (c < 3) l5[c] = tk4_ckey(va + vb1, ia7, ib1, c <= limB); }
        l5[3] = tk4_ckey(va0 + vb2, ia0, ib2, true); l5[4] = tk4_ckey(va0 + vb3, ia0, ib3, true);
        TK_CE(l5, 0, 3); TK_CE(l5, 1, 4); TK_CE(l5, 1, 3); TK_CE(l5, 2, 4); TK_CE(l5, 2, 3); TK_CE(l5, 1, 2); TK_CE(l5, 3, 4);
#pragma unroll
        for (int c = 11; c < 16; ++c) y[c] = umax_(y[c], l5[15 - c]);
        tk2_merge16(y); tk2_level<DPP_XOR1>(y);
        { u32 t[16];
#pragma unroll
          for (int c = 0; c < 16; ++c) t[c] = dppu<DPP_REV4>(y[15 - c]);
#pragma unroll
          for (int c = 0; c < 16; ++c) y[c] = umax_(y[c], t[c]); }
        const float fmx = (float)(umax_(y[0], y[15]) >> 14) * (1.f / 2048.f) - 64.f;
        u32 eo[4]; float ex[4];
#pragma unroll
        for (int u = 0; u < 4; ++u) { const u32 x = tk_sel4v(y[u], y[4 + u], y[7 - u], y[3 - u], r);
            eo[u] = (127u - ((x >> 7) & 127u)) * 128u + (127u - (x & 127u)); ex[u] = __expf(((float)(x >> 14) * (1.f / 2048.f) - 64.f) - fmx); }
        float sum = (ex[0] + ex[1]) + (ex[2] + ex[3]);
        sum += __builtin_bit_cast(float, dppu<DPP_XOR1>(__builtin_bit_cast(u32, sum))); sum += __builtin_bit_cast(float, dppu<0x4E>(__builtin_bit_cast(u32, sum)));
        const float inv = 1.f / sum;
        *(u32x4*)(EID + (size_t)tok * 128 + h * 16 + 4 * r) = (u32x4){eo[0], eo[1], eo[2], eo[3]};
        *(f32x4*)(GW + (size_t)tok * 128 + h * 16 + 4 * r) = (f32x4){ex[0] * inv, ex[1] * inv, ex[2] * inv, ex[3] * inv};
    }
}

__device__ __forceinline__ float dot2bf(unsigned w, unsigned x, float acc) { return __builtin_amdgcn_fdot2_f32_bf16(__builtin_bit_cast(bf16x2_t, w), __builtin_bit_cast(bf16x2_t, x), acc, false); }
__device__ __forceinline__ int dot8z(int a, int b) { int d; asm("v_dot8_i32_i4 %0, %1, %2, 0" : "=v"(d) : "v"(a), "v"(b)); return d; }
constexpr int PNB = 8;
__device__ __forceinline__ void phase_peer_a(const Ctx& C, const Args& a, int l) {
    const int x = C.blk & 7, c4 = x & 3, th = x >> 2, wg = (C.blk >> 3) * NWAVES + C.wave, nwg = ((C.nblk + 7 - x) >> 3) * NWAVES;
    const __amdgpu_buffer_rsrc_t UC = __builtin_amdgcn_make_buffer_rsrc(a.ws + WS_UB + ((size_t)l * 4 + c4) * NEXP * 128, 0, NEXP * 128, 0x00020000);
    const int* EID = (const int*)(a.ws + WS_EID); const unsigned char* HQ = a.ws + WS_HQ; unsigned* PD = (unsigned*)(a.ws + WS_PD);
    LAS float* dl = (LAS float*)(C.lds + C.wave * 1024);
    unsigned z_ = 0u; asm volatile("" : "+v"(z_));
    const int lane = (int)__builtin_amdgcn_mbcnt_hi(~0u, __builtin_amdgcn_mbcnt_lo(~0u, z_)), p = lane & 7, g = lane >> 3;
#define PA_META(t_, ev0_, ev1_, r0_, r1_) do { ev0_ = EID[(size_t)(t_) * 128 + lane]; ev1_ = EID[(size_t)(t_) * 128 + 64 + lane]; \
        r0_ = *(const u32x4*)(HQ + (size_t)(t_) * 1024 + c4 * 256 + p * 32); r1_ = *(const u32x4*)(HQ + (size_t)(t_) * 1024 + c4 * 256 + p * 32 + 16); } while (0)
#define PA_ISSUE(rows_, ev_) do { _Pragma("unroll") for (int j = 0; j < 8; ++j) { const int e = __builtin_amdgcn_ds_bpermute((8 * j + g) << 2, ev_); \
        rows_[j] = __builtin_bit_cast(u32x4, __builtin_amdgcn_raw_buffer_load_b128(UC, e * 128 + 16 * p, 0, 0)); } } while (0)
#define PA_HALF(rows_, off_) do { _Pragma("unroll") for (int j = 0; j < 8; ++j) { \
            int ah = dot8z((int)rows_[j].x, (int)hqh.x); ah = __builtin_amdgcn_sdot8((int)rows_[j].y, (int)hqh.y, ah, false); \
            ah = __builtin_amdgcn_sdot8((int)rows_[j].z, (int)hqh.z, ah, false); ah = __builtin_amdgcn_sdot8((int)rows_[j].w, (int)hqh.w, ah, false); \
            int al = dot8z((int)rows_[j].x, (int)hql.x); al = __builtin_amdgcn_sdot8((int)rows_[j].y, (int)hql.y, al, false); \
            al = __builtin_amdgcn_sdot8((int)rows_[j].z, (int)hql.z, al, false); al = __builtin_amdgcn_sdot8((int)rows_[j].w, (int)hql.w, al, false); \
            int acc = (ah << 4) + al; \
            acc += __builtin_amdgcn_update_dpp(0, acc, 0xB1, 0xf, 0xf, true); acc += __builtin_amdgcn_update_dpp(0, acc, 0x4E, 0xf, 0xf, true); acc += __builtin_amdgcn_update_dpp(0, acc, 0x141, 0xf, 0xf, true);   \
            tot[(off_) + j] = (float)acc; } } while (0)
    int evA0, evA1, evB0, evB1; u32x4 hA0, hA1, hB0, hB1, rows0[8], rows1[8];
#define PA_TOKEN(ev0_, ev1_, h0_, h1_, tcur_, tload_, evn0_) do { \
        const u32x4 hqh = h0_, hql = h1_;             \
        PA_ISSUE(rows1, ev1_);                        \
        PA_META(tload_, ev0_, ev1_, h0_, h1_);        \
        __builtin_amdgcn_sched_barrier(0);            \
        float tot[16]; \
        PA_HALF(rows0, 0); \
        __builtin_amdgcn_sched_barrier(0); \
        PA_ISSUE(rows0, evn0_);                       \
        __builtin_amdgcn_sched_barrier(0); \
        PA_HALF(rows1, 8); \
        __builtin_amdgcn_sched_barrier(0); \
        if (p == 0) { _Pragma("unroll") for (int j = 0; j < 16; ++j) dl[8 * j + g] = tot[j]; } \
        asm volatile("s_waitcnt lgkmcnt(0)" ::: "memory"); \
        const float d0 = dl[lane], d1 = dl[64 + lane]; \
        if ((tcur_) < M) PD[((size_t)(tcur_) * 4 + c4) * 64 + lane] = pkh(d0 * 0.015625f, d1 * 0.015625f); \
        asm volatile("s_waitcnt lgkmcnt(0)" ::: "memory");   } while (0)
    constexpr int MH = M / 2;
    int i = wg;
    { const int ic = i < MH ? i : 0; PA_META(2 * ic + th, evA0, evA1, hA0, hA1); }
    { const int ic = i + nwg < MH ? i + nwg : 0; PA_META(2 * ic + th, evB0, evB1, hB0, hB1); }
    PA_ISSUE(rows0, evA0);
#pragma nounroll
    for (; i < MH; i += 2 * nwg) {
        const int i1 = i + nwg, i2 = i + 2 * nwg, i3 = i + 3 * nwg, c2 = i2 < MH ? i2 : i, c3 = i3 < MH ? i3 : i;
        const int tA = 2 * i + th, tB = i1 < MH ? 2 * i1 + th : M;
        PA_TOKEN(evA0, evA1, hA0, hA1, tA, 2 * c2 + th, evB0);
        PA_TOKEN(evB0, evB1, hB0, hB1, tB, 2 * c3 + th, evA0);
    }
#undef PA_TOKEN
#undef PA_META
#undef PA_ISSUE
#undef PA_HALF
}
__device__ __forceinline__ void phase_peer_c(const Ctx& C, const Args& a, int l) {
    const float* USC = (const float*)(a.ws + WS_USC) + (size_t)l * NEXP * 4; const float* VSC = (const float*)(a.ws + WS_VSC) + (size_t)l * NEXP;
    const int* EID = (const int*)(a.ws + WS_EID); const float* GW = (const float*)(a.ws + WS_GW); const float* HSC = (const float*)(a.ws + WS_HSC); const float* HSUM = (const float*)(a.ws + WS_HSUM); const unsigned* PD = (const unsigned*)(a.ws + WS_PD);
    unsigned* C8 = (unsigned*)(a.ws + WS_COEF); float* CSC = (float*)(a.ws + WS_CSC);
    const int l16 = C.lane & 15, tr = C.lane >> 4;
    for (int t0 = 4 * C.gw; t0 < M; t0 += 4 * C.ngw) {
        const int t = t0 + tr;
        u32x4 pw[4], evw[2]; f32x4 gvw[2];
#pragma unroll
        for (int c = 0; c < 4; ++c) pw[c] = *(const u32x4*)(PD + ((size_t)t * 4 + c) * 64 + 4 * l16);
#pragma unroll
        for (int u = 0; u < 2; ++u) { evw[u] = *(const u32x4*)(EID + (size_t)t * 128 + 64 * u + 4 * l16); gvw[u] = *(const f32x4*)(GW + (size_t)t * 128 + 64 * u + 4 * l16); }
        const float hs = HSC[t]; const f32x4 hsum = *(const f32x4*)(HSUM + (size_t)t * 4);
        f32x4 us[8]; float vs[8];
#pragma unroll
        for (int u = 0; u < 2; ++u)
#pragma unroll
            for (int i = 0; i < 4; ++i) { const unsigned e = evw[u][i]; us[4 * u + i] = *(const f32x4*)(USC + (size_t)e * 4); vs[4 * u + i] = VSC[e]; }
        __builtin_amdgcn_sched_barrier(0);
        float cf[8], amax = 0.f;
#pragma unroll
        for (int u = 0; u < 2; ++u)
#pragma unroll
            for (int i = 0; i < 4; ++i) { float d = 0.f;
#pragma unroll
                for (int c = 0; c < 4; ++c) { const unsigned w = pw[c][i]; const f16x2 hv = __builtin_bit_cast(f16x2, w); d += us[4 * u + i][c] * ((float)(u ? hv.y : hv.x) * 64.f + 0.5f * hsum[c]); }
                const float dd = d * hs; const float v = vs[4 * u + i] * gvw[u][i] * 0.5f * dd * (1.f + erff(dd * 0.70710678118654752f)); cf[4 * u + i] = v; amax = fmaxf(amax, fabsf(v)); }
#define DPPF(x, ctrl) __builtin_bit_cast(float, __builtin_amdgcn_update_dpp(0, __builtin_bit_cast(int, x), ctrl, 0xf, 0xf, true))
        amax = fmaxf(amax, DPPF(amax, 0xB1)); amax = fmaxf(amax, DPPF(amax, 0x4E)); amax = fmaxf(amax, DPPF(amax, 0x141)); amax = fmaxf(amax, DPPF(amax, 0x140));
#undef DPPF
        const float inv = amax > 0.f ? 119.f / amax : 0.f;
        unsigned lo[2] = {0u, 0u}, hi[2] = {0u, 0u}; int ks = 0;
#pragma unroll
        for (int u = 0; u < 2; ++u)
#pragma unroll
            for (int i = 0; i < 4; ++i) { const int k = (int)rintf(cf[4 * u + i] * inv); ks += k; lo[u] |= ((unsigned)k & 15u) << (4 * i); hi[u] |= ((unsigned)((k + 8) >> 4) & 15u) << (4 * i); }
        const float ksum = row16_sum((float)ks);
        const int sh = 16 * (l16 & 1);
#pragma unroll
        for (int u = 0; u < 2; ++u) { lo[u] <<= sh; hi[u] <<= sh; lo[u] |= dppu<DPP_XOR1>(lo[u]); hi[u] |= dppu<DPP_XOR1>(hi[u]); }
        { const int u = l16 & 1; *(u32x2*)(C8 + (size_t)t * 32 + 16 * u + 2 * (l16 >> 1)) = (u32x2){u ? lo[1] : lo[0], u ? hi[1] : hi[0]}; }
        if (l16 == 0) { const float cs = amax * (1.f / 119.f); *(f32x2*)(CSC + (size_t)t * 2) = (f32x2){cs, 0.5f * cs * ksum}; }
    }
}
__device__ __forceinline__ void phase_peer_b(const Ctx& C, const Args& a, int l) {
    typedef int v2i32_t __attribute__((ext_vector_type(2)));
    const int x = C.blk & 7, c4 = x & 3, th = x >> 2, wg = (C.blk >> 3) * NWAVES + C.wave, nwg = ((C.nblk + 7 - x) >> 3) * NWAVES;
    const unsigned char* VB = a.ws + WS_VB + ((size_t)l * 4 + c4) * NEXP * 128;
    const int* EID = (const int*)(a.ws + WS_EID); const int* C8 = (const int*)(a.ws + WS_COEF); const float* CSC = (const float*)(a.ws + WS_CSC); bf16* XW = (bf16*)(a.ws + WS_XB);
    LAS unsigned char* wlA = C.lds + C.wave * 16384; LAS unsigned char* wlB = wlA + 8192;
    unsigned z_ = 0u; asm volatile("" : "+v"(z_));
    const int lane = (int)__builtin_amdgcn_mbcnt_hi(~0u, __builtin_amdgcn_mbcnt_lo(~0u, z_)), p = lane & 7, g = lane >> 3;
    const int q = lane >> 4, r = lane & 15;
    const unsigned pcE = 16u * (p ^ (g >> 1)), pcO = 16u * (p ^ (4 + (g >> 1)));
    unsigned rofs[4];
#pragma unroll
    for (int u = 0; u < 4; ++u) { const int blk = 4 * u + q; rofs[u] = 128u * r + 16u * ((blk >> 1) ^ (r >> 1)) + 8u * (blk & 1); }
    const int cbA = 16 * q + (r & 14) + ((lane & 1) ? 128 : 0);
    unsigned ra[4];
#pragma unroll
    for (int u = 0; u < 4; ++u) ra[u] = (unsigned)(size_t)wlA + rofs[u];
#define PB_META(t_, ev0_, ev1_, cf_) do { ev0_ = EID[(size_t)(t_) * 128 + lane]; ev1_ = EID[(size_t)(t_) * 128 + 64 + lane]; cf_ = C8[(size_t)(t_) * 32 + (lane & 31)]; } while (0)
#define PB_ISSUE(buf_, ev_) do { asm volatile("s_waitcnt lgkmcnt(0)" ::: "memory");   \
        _Pragma("unroll") for (int j = 0; j < 8; ++j) { const int e = __builtin_amdgcn_ds_bpermute((8 * j + g) << 2, ev_); \
        __builtin_amdgcn_global_load_lds((const unsigned*)(VB + (size_t)(unsigned)(e * 128) + ((j & 1) ? pcO : pcE)), (LAS unsigned*)(buf_ + 1024 * j), 16, 0, 0); } } while (0)
#define PB_TR4(dst_, addr_, off_) asm volatile("ds_read_b64_tr_b4 %0, %1 offset:%2" : "=v"(dst_) : "v"(addr_), "n"(off_))
#define PB_HALF(bo_, h_, cf_) do { v2i32_t tv[4][4]; \
        _Pragma("unroll") for (int T = 0; T < 4; ++T) { _Pragma("unroll") for (int u = 0; u < 4; ++u) PB_TR4(tv[T][u], ra[u], (bo_) + 2048 * T); } \
        asm volatile("s_waitcnt lgkmcnt(0)" : "+v"(tv[0][0]), "+v"(tv[0][1]), "+v"(tv[0][2]), "+v"(tv[0][3]), "+v"(tv[1][0]), "+v"(tv[1][1]), "+v"(tv[1][2]), "+v"(tv[1][3]), \
                                              "+v"(tv[2][0]), "+v"(tv[2][1]), "+v"(tv[2][2]), "+v"(tv[2][3]), "+v"(tv[3][0]), "+v"(tv[3][1]), "+v"(tv[3][2]), "+v"(tv[3][3]) :: "memory");   \
        _Pragma("unroll") for (int T = 0; T < 4; ++T) { const int kl0 = __builtin_amdgcn_readlane(cf_, 16 * (h_) + 4 * T), kh0 = __builtin_amdgcn_readlane(cf_, 16 * (h_) + 4 * T + 1), kl1 = __builtin_amdgcn_readlane(cf_, 16 * (h_) + 4 * T + 2), kh1 = __builtin_amdgcn_readlane(cf_, 16 * (h_) + 4 * T + 3); \
            _Pragma("unroll") for (int u = 0; u < 4; ++u) { const v2i32_t v = tv[T][u]; \
                ol_[u] = __builtin_amdgcn_sdot8(v.x, kl0, ol_[u], false); ol_[u] = __builtin_amdgcn_sdot8(v.y, kl1, ol_[u], false); oh_[u] = __builtin_amdgcn_sdot8(v.x, kh0, oh_[u], false); oh_[u] = __builtin_amdgcn_sdot8(v.y, kh1, oh_[u], false); } } \
        } while (0)
    int evA0, evA1, evB0, evB1, cfA, cfB;
    const f32x2 gA0 = *(const f32x2*)(modp(a, l, 0, 5) + 256 * c4 + cbA), gB0 = *(const f32x2*)(modp(a, l, 0, 5) + 256 * c4 + cbA + 64), gA1 = *(const f32x2*)(modp(a, l, 1, 5) + 256 * c4 + cbA), gB1 = *(const f32x2*)(modp(a, l, 1, 5) + 256 * c4 + cbA + 64);
    constexpr int MH = M / 2;
    int i = wg;
    { const int ic = i < MH ? i : 0; PB_META(2 * ic + th, evA0, evA1, cfA); }
    { const int ic = i + nwg < MH ? i + nwg : 0; PB_META(2 * ic + th, evB0, evB1, cfB); }
    unsigned xnA, xnB; f32x2 csn; { const int tc = 2 * (i < MH ? i : 0) + th; xnA = *(const unsigned*)(XW + (size_t)tc * D + 256 * c4 + cbA); xnB = *(const unsigned*)(XW + (size_t)tc * D + 256 * c4 + cbA + 64); csn = *(const f32x2*)(CSC + (size_t)tc * 2); }
    asm volatile("s_waitcnt vmcnt(0)" ::: "memory");
    __builtin_amdgcn_sched_barrier(0);
    PB_ISSUE(wlA, evA0);
    __builtin_amdgcn_sched_barrier(0);
#pragma nounroll
    for (; i < MH; i += nwg) {
        const int t = 2 * i + th, i2 = i + 2 * nwg, c2 = i2 < MH ? i2 : i;
        const int kf = cfA;
        const f32x2 xa = (f32x2){bflo(xnA), bfhi(xnA)}, xb = (f32x2){bflo(xnB), bfhi(xnB)}; const f32x2 cs = csn;
        __builtin_amdgcn_sched_barrier(0);
        __builtin_amdgcn_sched_barrier(0);
        PB_ISSUE(wlB, evA1);
        __builtin_amdgcn_sched_barrier(0);
        asm volatile("s_waitcnt vmcnt(8)" ::: "memory");
        __builtin_amdgcn_sched_barrier(0);
        int ol_[4] = {0, 0, 0, 0}, oh_[4] = {0, 0, 0, 0};
        PB_HALF(0, 0, kf);
        __builtin_amdgcn_sched_barrier(0);
        PB_ISSUE(wlA, evB0);
        __builtin_amdgcn_sched_barrier(0);
        asm volatile("s_waitcnt vmcnt(8)" ::: "memory");
        __builtin_amdgcn_sched_barrier(0);
        evA0 = evB0; evA1 = evB1; cfA = cfB;
        PB_META(2 * c2 + th, evB0, evB1, cfB);
        { const int i1 = i + nwg < MH ? i + nwg : i, t1 = 2 * i1 + th; xnA = *(const unsigned*)(XW + (size_t)t1 * D + 256 * c4 + cbA); xnB = *(const unsigned*)(XW + (size_t)t1 * D + 256 * c4 + cbA + 64); csn = *(const f32x2*)(CSC + (size_t)t1 * 2); }
        __builtin_amdgcn_sched_barrier(0);
        PB_HALF(8192, 1, kf);
        __builtin_amdgcn_sched_barrier(0);
        int val[4];
#pragma unroll
        for (int u = 0; u < 4; ++u) val[u] = (oh_[u] << 4) + ol_[u];
        const bool odd = lane & 1;
        const int r0 = __builtin_amdgcn_update_dpp(0, odd ? val[0] : val[2], 0xB1, 0xf, 0xf, true), r1 = __builtin_amdgcn_update_dpp(0, odd ? val[1] : val[3], 0xB1, 0xf, 0xf, true);
        const f32x2 sA = odd ? (f32x2){(float)r0, (float)val[2]} : (f32x2){(float)val[0], (float)r0}, sB = odd ? (f32x2){(float)r1, (float)val[3]} : (f32x2){(float)val[1], (float)r1};
        const f32x2 gA = (t >> 13) ? gA1 : gA0, gB = (t >> 13) ? gB1 : gB0;
        { const f32x2 oa = xa + gA * (sA * cs.x + cs.y), ob = xb + gB * (sB * cs.x + cs.y);
          *(unsigned*)(XW + (size_t)t * D + 256 * c4 + cbA) = pk2(oa.x, oa.y); *(unsigned*)(XW + (size_t)t * D + 256 * c4 + cbA + 64) = pk2(ob.x, ob.y); }
        __builtin_amdgcn_sched_barrier(0);
    }
    asm volatile("s_waitcnt vmcnt(0)" ::: "memory");
#undef PB_META
#undef PB_ISSUE
#undef PB_HALF
#undef PB_TR4
}
__device__ __forceinline__ void phase_final(const Ctx& C, const Args& a) {
    const bf16* XB = (const bf16*)(a.ws + WS_XB);
    for (int m0 = 4 * C.gw; m0 < M; m0 += 4 * C.ngw) { u32x2 xw[4][4]; f32x4 fg[4];
#pragma unroll
        for (int i = 0; i < 4; ++i) {
#pragma unroll
            for (int j = 0; j < 4; ++j) xw[i][j] = *(const u32x2*)(XB + (size_t)(m0 + i) * D + 4 * C.lane + 256 * j); }
#pragma unroll
        for (int j = 0; j < 4; ++j) fg[j] = *(const f32x4*)(a.in[I_FG] + 4 * C.lane + 256 * j);
        __builtin_amdgcn_sched_barrier(0);
#pragma unroll
        for (int i = 0; i < 4; ++i) { const int m = m0 + i; f32x4 x[4]; float ss = 0.f;
#pragma unroll
            for (int j = 0; j < 4; ++j) { const u32x2 w = xw[i][j]; x[j] = (f32x4){bflo(w.x), bfhi(w.x), bflo(w.y), bfhi(w.y)}; ss += (x[j].x * x[j].x + x[j].y * x[j].y) + (x[j].z * x[j].z + x[j].w * x[j].w); }
            const float rstd = 1.f / sqrtf(wave_sum(ss) * (1.f / D) + EPS);
#pragma unroll
            for (int j = 0; j < 4; ++j) *(f32x4*)(a.out + (size_t)m * D + 4 * C.lane + 256 * j) = x[j] * rstd * fg[j]; }
    }
}

#define GEMM mfma_gemm
#define RLX_AGENT __ATOMIC_RELAXED, __HIP_MEMORY_SCOPE_AGENT
#define XB_TMO      128
#define XB_XCNT(j)  (256  + 64 * (j))
#define XB_XSUB(j)  (1280 + 64 * (j))
#define XB_XGEN(j)  (2304 + 64 * (j))
#define XB_TOP      3328
#define XB_TOPGEN   3392
#define XCD_BAR_WORDS 3456
#define XB_SPIN_CAP (1u << 18)

__device__ __forceinline__ unsigned xb_ld(unsigned* p)              { return __hip_atomic_load(p, __ATOMIC_RELAXED, __HIP_MEMORY_SCOPE_AGENT); }
__device__ __forceinline__ unsigned xb_add(unsigned* p, unsigned v) { return __hip_atomic_fetch_add(p, v, __ATOMIC_RELAXED, __HIP_MEMORY_SCOPE_AGENT); }
__device__ __forceinline__ unsigned xb_xcc_id() { return (unsigned)__builtin_amdgcn_s_getreg((3 << 11) | 20) & 0xFu; }
#define XB_SPIN(cond, bar) do { unsigned _sp = 0; while (cond) { __builtin_amdgcn_s_sleep(1); \
    if ((++_sp & 255u) == 0u) { if (xb_ld(&(bar)[XB_TMO])) break; if (_sp > XB_SPIN_CAP) { atomicAdd(&(bar)[XB_TMO], 1u); break; } } } } while (0)

struct XcdBarrier {
    unsigned* bar; unsigned x;
    volatile LAS unsigned* st;
};

__device__ __forceinline__ XcdBarrier xcd_barrier_post(unsigned* bar, volatile LAS unsigned* st) {
    XcdBarrier b; b.bar = bar; b.x = xb_xcc_id(); b.st = st;
    if (threadIdx.x == 0) (void)xb_add(&bar[XB_XCNT(b.x)], 1u);
    return b;
}
__device__ __forceinline__ void xcd_barrier_complete(unsigned* bar, unsigned x, unsigned& nloc, unsigned& nx) {
    const unsigned G = gridDim.x * gridDim.y * gridDim.z;
    unsigned sum, cnt, mine, sp = 0u;
    for (;;) {
        sum = 0u; cnt = 0u; mine = 0u;
#pragma unroll
        for (unsigned j = 0; j < 16; ++j) { const unsigned c = xb_ld(&bar[XB_XCNT(j)]); sum += c; cnt += (c > 0u) ? 1u : 0u; mine = (j == x) ? c : mine; }
        if (sum == G) break;
        __builtin_amdgcn_s_sleep(1);
        if ((++sp & 255u) == 0u) { if (xb_ld(&bar[XB_TMO])) break; if (sp > XB_SPIN_CAP) { atomicAdd(&bar[XB_TMO], 1u); break; } }
    }
    nloc = mine > 0u ? mine : 1u; nx = cnt > 0u ? cnt : 1u;
}

__device__ __forceinline__ void xcd_barrier(const XcdBarrier& b, const int tid_) {
    asm volatile("s_waitcnt vmcnt(0)" ::: "memory");
    __syncthreads();
    if (tid_ == 0) {
        unsigned* bar = b.bar;
        __builtin_amdgcn_s_waitcnt(0);
        unsigned nloc = b.st[0], nx = b.st[1];
        if (nloc == 0u) { xcd_barrier_complete(bar, b.x, nloc, nx); b.st[0] = nloc; b.st[1] = nx; }
        const unsigned old = xb_add(&bar[XB_XSUB(b.x)], 1u);
        const unsigned gen = old / nloc;
        if (old + 1u == (gen + 1u) * nloc) {
            __builtin_amdgcn_fence(__ATOMIC_RELEASE, "agent");
            asm volatile("s_waitcnt vmcnt(0)" ::: "memory");
            (void)xb_add(&bar[XB_TOP], 1u);
            XB_SPIN(xb_ld(&bar[XB_TOP]) < (gen + 1u) * nx, bar);
            __builtin_amdgcn_fence(__ATOMIC_ACQUIRE, "agent");
            xb_add(&bar[XB_XGEN(b.x)], 1u);
            asm volatile("s_waitcnt vmcnt(0)" ::: "memory");
        } else {
            XB_SPIN(xb_ld(&bar[XB_XGEN(b.x)]) == gen, bar);
            __builtin_amdgcn_fence(__ATOMIC_ACQUIRE, "agent");
            asm volatile("s_waitcnt vmcnt(0)" ::: "memory");
        }
    }
    __syncthreads();
}

constexpr int CW_BAR = 4096;
constexpr size_t CTL_ZERO_BYTES = 65536;
constexpr int LDSCTL_OFF = 131072, MISC_OFF = LDSCTL_OFF + 320;
constexpr int PH_PREP = 0, PH_MODR = 1, PH_N1 = 2, PH_L0 = 3, PH_PER_LAYER = 10, N_PHASES = PH_L0 + DEPTH * PH_PER_LAYER;
__device__ __forceinline__ Ctx make_ctx(LAS unsigned char* lds, int wave_s) {
    unsigned z_ = 0u; asm volatile("" : "+v"(z_));
    int tid_ = (wave_s << 6) | (int)__builtin_amdgcn_mbcnt_hi(~0u, __builtin_amdgcn_mbcnt_lo(~0u, z_)); asm volatile("" : "+v"(tid_));
    Ctx C; C.tid = tid_; C.lane = C.tid & 63; C.wave = __builtin_amdgcn_readfirstlane(C.tid >> 6); C.nblk = gridDim.x; C.blk = blockIdx.x;
    C.gw = C.blk * NWAVES + C.wave; C.ngw = C.nblk * NWAVES; C.lds = lds; return C;
}
#define PH(k, ...) if (a.ph_lo <= (k) && (k) < a.ph_hi) { { const Ctx C = make_ctx(lds, wave_s); __VA_ARGS__; } if ((k) + 1 < a.ph_hi) xcd_barrier(bar, make_ctx(lds, wave_s).tid); }
constexpr int CW_XID = 7680, CW_PSYNC = 8192;
__device__ __forceinline__ void panel_of(const Ctx& C, int& P, int& s) { pg8::StaticOrder SO; SO.init(M, D, C.nblk, C.blk); pg8::Unit un; SO.next(0, un); P = un.pm; s = un.pn; }
__device__ __forceinline__ void norm_rows(const Ctx& C, int& mb, int& ms, int& me) {
    if (C.nblk == 256) { int P, s; panel_of(C, P, s); mb = 256 * P + 64 * s + 4 * C.wave; ms = 32; me = 256 * P + 64 * s + 64; } else { mb = 4 * C.gw; ms = 4 * C.ngw; me = M; } }
__device__ __forceinline__ void cp_items(const Ctx& C, int& i0, int& is, int& ie) {
    if (C.nblk == 256) { int P, s; panel_of(C, P, s); i0 = 8 * P + 2 * s; is = 1; ie = i0 + 2; } else { i0 = C.blk; is = C.nblk; ie = M / 32; } }
__device__ __forceinline__ void panel_setup(const Ctx& C, const Args& a, LAS unsigned char* lds) {
    if (C.tid == 0 && C.nblk == 256) { const unsigned* xid = (const unsigned*)(a.ws + WS_CTL) + CW_XID; const int b0 = C.blk & 63;
        const unsigned x0 = xid[b0], x1 = xid[b0 + 64], x2 = xid[b0 + 128], x3 = xid[b0 + 192];
        ((volatile LAS unsigned*)(lds + MISC_OFF))[12] = (x0 != 0u && x0 == x1 && x1 == x2 && x2 == x3) ? 1u : 2u;
        int P, s; panel_of(C, P, s); unsigned nx = 2u;
        if ((P & 31) != 31) { const int Q = P + 1, c0 = (Q >> 3) + 8 * (Q & 7); nx = (xid[c0] == x0 && xid[c0 + 64] == x0 && xid[c0 + 128] == x0 && xid[c0 + 192] == x0) ? 1u : 2u; }
        ((volatile LAS unsigned*)(lds + MISC_OFF))[13] = nx; } }
__device__ __forceinline__ void panel_sync_halo(const Args& a, LAS unsigned char* lds, int idx, const Ctx& C) {
    asm volatile("s_waitcnt vmcnt(0)" ::: "memory");
    __syncthreads();
    if (C.tid == 0) {
        __builtin_amdgcn_s_waitcnt(0);
        int P, s; panel_of(C, P, s);
        unsigned* ctl = (unsigned*)(a.ws + WS_CTL); volatile LAS unsigned* misc = (volatile LAS unsigned*)(lds + MISC_OFF);
        const bool local = misc[12] == 1u && ((P & 31) == 31 || misc[13] == 1u);
        if (!local) { __builtin_amdgcn_fence(__ATOMIC_RELEASE, "agent"); asm volatile("s_waitcnt vmcnt(0)" ::: "memory"); }
        unsigned* w = ctl + CW_PSYNC + (idx * 64 + P) * 8;
        (void)xb_add(w, 1u);
        XB_SPIN(xb_ld(w) < 4u, ctl + CW_BAR);
        if ((P & 31) != 0) XB_SPIN(xb_ld(w - 8) < 4u, ctl + CW_BAR);
        __builtin_amdgcn_fence(__ATOMIC_ACQUIRE, "agent");
        asm volatile("s_waitcnt vmcnt(0)" ::: "memory");
    }
    __syncthreads();
}
#define PHH(k, idx, ...) if (a.ph_lo <= (k) && (k) < a.ph_hi) { { const Ctx C = make_ctx(lds, wave_s); __VA_ARGS__; } if ((k) + 1 < a.ph_hi) { const Ctx Cs = make_ctx(lds, wave_s); if (Cs.nblk == 256) panel_sync_halo(a, lds, idx, Cs); else xcd_barrier(bar, Cs.tid); } }
__device__ __forceinline__ void panel_sync(const Args& a, LAS unsigned char* lds, int idx, const Ctx& C) {
    asm volatile("s_waitcnt vmcnt(0)" ::: "memory");
    __syncthreads();
    if (C.tid == 0) {
        __builtin_amdgcn_s_waitcnt(0);
        int P, s; panel_of(C, P, s);
        unsigned* ctl = (unsigned*)(a.ws + WS_CTL);
        if (((volatile LAS unsigned*)(lds + MISC_OFF))[12] != 1u) { __builtin_amdgcn_fence(__ATOMIC_RELEASE, "agent"); asm volatile("s_waitcnt vmcnt(0)" ::: "memory"); }
        unsigned* w = ctl + CW_PSYNC + (idx * 64 + P) * 8;
        (void)xb_add(w, 1u);
        XB_SPIN(xb_ld(w) < 4u, ctl + CW_BAR);
        __builtin_amdgcn_fence(__ATOMIC_ACQUIRE, "agent");
        asm volatile("s_waitcnt vmcnt(0)" ::: "memory");
    }
    __syncthreads();
}
#define PHP(k, idx, ...) if (a.ph_lo <= (k) && (k) < a.ph_hi) { { const Ctx C = make_ctx(lds, wave_s); __VA_ARGS__; } if ((k) + 1 < a.ph_hi) { const Ctx Cs = make_ctx(lds, wave_s); if (Cs.nblk == 256) panel_sync(a, lds, idx, Cs); else xcd_barrier(bar, Cs.tid); } }
template <int l>
__device__ __forceinline__ void run_layer(const Args& a, LAS unsigned char* lds, const XcdBarrier& bar, const int wave_s) {
    unsigned char* ws = a.ws; constexpr int B0 = PH_L0 + l * PH_PER_LAYER;
    PHH(B0 + 0, 10 + l, EpiIn E{a.in[I_BIN] + (size_t)l * DIN, (const float*)(ws + WS_BP) + (size_t)l * 1024, (bf16*)(ws + WS_UG), (bf16*)(ws + WS_ZP), (bf16*)(ws + WS_G)};
               GEMM(C, (const bf16*)(ws + WS_H), D, 0, (const bf16*)(ws + WS_WIN) + (size_t)l * DIN * D, D, M, DIN, D, E))
    PHP(B0 + 1, 5 * l + 1, int i0, is, ie; cp_items(C, i0, is, ie); phase_convpool(C, a, l, i0, is, ie))
    PHP(B0 + 2, 5 * l + 2, EpiConv E{(const bf16*)(ws + WS_G), (const bf16*)(ws + WS_PL), a.in[I_POOLS] + (size_t)l * D, (bf16*)(ws + WS_Y)};
               GEMM(C, (const bf16*)(ws + WS_AC), D, 0, (const bf16*)(ws + WS_WCO) + (size_t)l * D * D, D, M, D, D, E))
    PHP(B0 + 3, 5 * l + 3, EpiOut E{l == 0 ? a.in[I_X] : nullptr, (const bf16*)(ws + WS_XB), (bf16*)(ws + WS_XB), modp(a, l, 0, 2), a.in[I_BOUT] + (size_t)l * D};
               GEMM(C, (const bf16*)(ws + WS_Y), D, 0, (const bf16*)(ws + WS_WOUT) + (size_t)l * D * D, D, M, D, D, E))
    PHP(B0 + 4, 5 * l + 4, int mb, ms, me; norm_rows(C, mb, ms, me); phase_norm<false>(C, a, nullptr, (const bf16*)(ws + WS_XB), a.in[I_N2G] + (size_t)l * D, l, 3, 4, (float*)(ws + WS_HSC), mb, ms, me))
    PH(B0 + 5, { EpiS E{(unsigned short*)(ws + WS_S)}; GEMM(C, (const bf16*)(ws + WS_H), D, 0, (const bf16*)(ws + WS_WQ) + (size_t)l * DQ * D, D, M, DQ, D, E); }
               asm volatile("s_waitcnt vmcnt(0)" ::: "memory"); __syncthreads();
               { const Ctx C3 = make_ctx(lds, wave_s); phase_topk(C3, a); })
    PH(B0 + 6, phase_peer_a(C, a, l))
    PH(B0 + 7, phase_peer_c(C, a, l))
    PH(B0 + 8, phase_peer_b(C, a, l))
    PHP(B0 + 9, 5 * (l + 1), if (l + 1 < DEPTH) { int mb, ms, me; norm_rows(C, mb, ms, me); phase_norm<false>(C, a, nullptr, (const bf16*)(ws + WS_XB), a.in[I_N1G] + (size_t)(l + 1) * D, l + 1, 0, 1, nullptr, mb, ms, me); } else phase_final(C, a))
}
__global__ void __launch_bounds__(NTHREADS, 2) fwd_kernel(Args a) {
    extern __shared__ __attribute__((aligned(16))) unsigned char lds_raw[];
    LAS unsigned char* lds = (LAS unsigned char*)lds_raw;
    for (int u = threadIdx.x; u < (LDS_BYTES - LDSCTL_OFF) / 4; u += NTHREADS) ((LAS unsigned*)(lds + LDSCTL_OFF))[u] = 0u;
    __syncthreads();
    const int wave_s = __builtin_amdgcn_readfirstlane((int)threadIdx.x >> 6);
    const XcdBarrier bar = xcd_barrier_post((unsigned*)(a.ws + WS_CTL) + CW_BAR, (volatile LAS unsigned*)(lds + MISC_OFF) + 8);
    if (threadIdx.x == 0) ((unsigned*)(a.ws + WS_CTL))[CW_XID + blockIdx.x] = bar.x + 1u;
    PH(PH_PREP, phase_prep(C, a))
    PH(PH_MODR, panel_setup(C, a, lds); phase_modreduce(C, a);
              for (int lf = 0; lf < DEPTH; ++lf) { const Ctx C2 = make_ctx(lds, wave_s); EpiWT E{(bf16*)(a.ws + WS_WQ) + (size_t)lf * DQ * D};
                  GEMM(C2, (const bf16*)(a.ws + WS_KEYS) + (size_t)lf * 2048 * 256, 256, 0, (const bf16*)(a.ws + WS_WQB) + (size_t)lf * D * DQ, DQ, DQ, D, 256, E, 256, 32 * lf); }
              for (int lf = 0; lf < DEPTH; ++lf) { const Ctx C2 = make_ctx(lds, wave_s); EpiWT E{(bf16*)(a.ws + WS_WIN) + ((size_t)lf * DIN + 2048) * D};
                  GEMM(C2, (const bf16*)(a.ws + WS_POOL) + (size_t)lf * 1024 * 256, 256, 0, (const bf16*)(a.ws + WS_WPB) + (size_t)lf * D * 1024, 1024, 1024, D, 256, E, 256, 64 + 16 * lf); }
              { const Ctx C2 = make_ctx(lds, wave_s);
                for (int o = C2.gw; o < DEPTH * 1024; o += C2.ngw) { const int lf = o >> 10, n = o & 1023, g = n >> 8, d = n & 255; float sacc = 0.f;
                    for (int u = 0; u < 4; ++u) { const int c = C2.lane + 64 * u; sacc += a.in[I_BIN][(size_t)lf * DIN + 2048 + g * 256 + c] * a.in[I_POOLW][(((size_t)lf * 4 + g) * 256 + c) * 256 + d]; }
                    sacc = wave_sum(sacc); if (C2.lane == 0) ((float*)(a.ws + WS_BP))[o] = sacc; } })
    PHP(PH_N1, 0, int mb, ms, me; norm_rows(C, mb, ms, me); phase_norm<true>(C, a, a.in[I_X], nullptr, a.in[I_N1G], 0, 0, 1, nullptr, mb, ms, me))
    run_layer<0>(a, lds, bar, wave_s);
    run_layer<1>(a, lds, bar, wave_s);
}

extern "C" void kernel_launch(void* const* d_in, const int* in_sizes, int n_in, void* d_out, int out_size, void* d_ws, size_t ws_size, hipStream_t stream) {
    static int grid = 0;
    if (grid == 0) {
        if (n_in != 22 || out_size != M * D || ws_size < WS_END) { fprintf(stderr, "kernel_launch: unexpected shapes (n_in %d out %d ws %zu)\n", n_in, out_size, ws_size); grid = -1; return; }
        int dev = 0, cus = 0;
        if (hipGetDevice(&dev) != hipSuccess || hipDeviceGetAttribute(&cus, hipDeviceAttributeMultiprocessorCount, dev) != hipSuccess) { grid = -1; return; }
        if (hipFuncSetAttribute((const void*)fwd_kernel, hipFuncAttributeMaxDynamicSharedMemorySize, LDS_BYTES) != hipSuccess) { grid = -1; return; }
        grid = cus;
    }
    if (grid < 0) return;
    Args a{};
    for (int i = 0; i < 22; ++i) a.in[i] = (const float*)d_in[i];
    a.out = (float*)d_out; a.ws = (unsigned char*)d_ws;
    (void)hipMemsetAsync((char*)d_ws + WS_CTL, 0, CTL_ZERO_BYTES, stream);
#ifndef ONE_LAUNCH
    for (int ph = 0; ph < N_PHASES; ++ph) { a.ph_lo = ph; a.ph_hi = ph + 1; hipLaunchKernelGGL(fwd_kernel, dim3(grid), dim3(NTHREADS), LDS_BYTES, stream, a); }
#else
    a.ph_lo = 0; a.ph_hi = N_PHASES; hipLaunchKernelGGL(fwd_kernel, dim3(grid), dim3(NTHREADS), LDS_BYTES, stream, a);
#endif
}
```

```cpp
#define ONE_LAUNCH 1
#include <hip/hip_runtime.h>
#include <cstdint>
#include <cstdio>
#include <utility>

#define GAS __attribute__((address_space(1)))
#define LAS __attribute__((address_space(3)))
typedef unsigned short bf16;
typedef float f32x4 __attribute__((ext_vector_type(4)));
typedef float f32x2 __attribute__((ext_vector_type(2)));
typedef unsigned u32x4 __attribute__((ext_vector_type(4)));
typedef unsigned u32x2 __attribute__((ext_vector_type(2)));
typedef __bf16 bf16x2_t __attribute__((ext_vector_type(2)));

constexpr int BATCH = 2, SEQ = 8192, D = 1024, M = BATCH * SEQ, DEPTH = 2;
constexpr int DIN = 5120, NMODV = 6 * D, CONVK = 31, NHEAD = 8, NKEYS = 128, DQ = 2048, TOPK = 16, NEXP = 16384;
constexpr float EPS = 1e-6f;
constexpr int NWAVES = 8, NTHREADS = NWAVES * 64;

constexpr size_t MiB = 1u << 20;
constexpr size_t WS_CTL = 0;
constexpr size_t WS_MODP = 1 * MiB;
constexpr size_t WS_MOD = 4 * MiB;
constexpr size_t WS_WIN = 8 * MiB;
constexpr size_t WS_WCO = 28 * MiB;
constexpr size_t WS_WOUT = 32 * MiB;
constexpr size_t WS_WQ = 36 * MiB;
constexpr size_t WS_POOL = 44 * MiB;
constexpr size_t WS_KEYS = 45 * MiB;
constexpr size_t WS_UB = 48 * MiB;
constexpr size_t WS_USC = 80 * MiB;
constexpr size_t WS_HQ = 84 * MiB;
constexpr size_t WS_VSC = 81 * MiB;
constexpr size_t WS_VB = 112 * MiB;
constexpr size_t WS_H = 176 * MiB;
constexpr size_t WS_UG = 208 * MiB;
constexpr size_t WS_Y = 472 * MiB;
constexpr size_t WS_ZP = 240 * MiB;
constexpr size_t WS_TMP = WS_ZP;
constexpr size_t WS_Q = WS_UG;
constexpr size_t WS_G = 272 * MiB;
constexpr size_t WS_AC = 336 * MiB;
constexpr size_t WS_PL = 368 * MiB;
constexpr size_t WS_S = WS_G;
constexpr size_t WS_EID = 400 * MiB;
constexpr size_t WS_GW = 408 * MiB;
constexpr size_t WS_COEF = 416 * MiB;
constexpr size_t WS_CSC = 424 * MiB + 524288;
constexpr size_t WS_HSC = 424 * MiB;
constexpr size_t WS_HSUM = 424 * MiB + 131072;
constexpr size_t WS_PD = WS_S;
constexpr size_t WS_WQB = 426 * MiB;
constexpr size_t WS_WPB = 434 * MiB;
constexpr size_t WS_BP = 4 * MiB + 262144;
constexpr size_t WS_XB = 440 * MiB;
constexpr size_t WS_END = 504 * MiB;

constexpr int LDS_BYTES = 147456;

__device__ __forceinline__ unsigned f2bf(float f) { unsigned u = __builtin_bit_cast(unsigned, f); return (u + 0x7fffu + ((u >> 16) & 1u)) >> 16; }
__device__ __forceinline__ unsigned pk2(float lo, float hi) { typedef __bf16 bf16x2_t_ __attribute__((ext_vector_type(2))); return __builtin_bit_cast(unsigned, __builtin_convertvector((f32x2){lo, hi}, bf16x2_t_)); }
__device__ __forceinline__ float bflo(unsigned w) { return __builtin_bit_cast(float, w << 16); }
__device__ __forceinline__ float bfhi(unsigned w) { return __builtin_bit_cast(float, w & 0xffff0000u); }
constexpr float SIG_PRESCALE = -1.4426950408889634f;
__device__ __forceinline__ float sigm2(float y) { return __builtin_amdgcn_rcpf(1.f + __builtin_amdgcn_exp2f(y)); }
__device__ __forceinline__ float sigm(float x) { return __builtin_amdgcn_rcpf(1.f + __expf(-x)); }
__device__ __forceinline__ float dpp_sum63(float v) {
#define DPPF(x, ctrl, rm, bc) __builtin_bit_cast(float, __builtin_amdgcn_update_dpp(0, __builtin_bit_cast(int, x), ctrl, rm, 0xf, bc))
    v += DPPF(v, 0x111, 0xf, true); v += DPPF(v, 0x112, 0xf, true); v += DPPF(v, 0x114, 0xf, true); v += DPPF(v, 0x118, 0xf, true);
    v += DPPF(v, 0x142, 0xa, false); v += DPPF(v, 0x143, 0xc, false);
#undef DPPF
    return v;
}
__device__ __forceinline__ float wave_sum(float v) { return __builtin_bit_cast(float, __builtin_amdgcn_readlane(__builtin_bit_cast(int, dpp_sum63(v)), 63)); }
__device__ __forceinline__ float wave_max(float v) {
#define DPPF(x, ctrl, rm, bc) __builtin_bit_cast(float, __builtin_amdgcn_update_dpp(0, __builtin_bit_cast(int, x), ctrl, rm, 0xf, bc))
    v = fmaxf(v, DPPF(v, 0x111, 0xf, true)); v = fmaxf(v, DPPF(v, 0x112, 0xf, true)); v = fmaxf(v, DPPF(v, 0x114, 0xf, true)); v = fmaxf(v, DPPF(v, 0x118, 0xf, true));
    v = fmaxf(v, DPPF(v, 0x142, 0xa, false)); v = fmaxf(v, DPPF(v, 0x143, 0xc, false));
#undef DPPF
    return __builtin_bit_cast(float, __builtin_amdgcn_readlane(__builtin_bit_cast(int, v), 63));
}
__device__ __forceinline__ u32x4 pack8(const f32x4& a, const f32x4& b) { u32x4 w; w.x = pk2(a.x, a.y); w.y = pk2(a.z, a.w); w.z = pk2(b.x, b.y); w.w = pk2(b.z, b.w); return w; }
__device__ __forceinline__ void unpack8(const u32x4& w, f32x4& a, f32x4& b) { a = (f32x4){bflo(w.x), bfhi(w.x), bflo(w.y), bfhi(w.y)}; b = (f32x4){bflo(w.z), bfhi(w.z), bflo(w.w), bfhi(w.w)}; }

__device__ __forceinline__ float row16_sum(float v) {
#define DPPF(x, ctrl) __builtin_bit_cast(float, __builtin_amdgcn_update_dpp(0, __builtin_bit_cast(int, x), ctrl, 0xf, 0xf, true))
    v += DPPF(v, 0xB1); v += DPPF(v, 0x4E); v += DPPF(v, 0x141); v += DPPF(v, 0x140);
#undef DPPF
    return v;
}
__device__ __forceinline__ unsigned wave_sum_u(unsigned v) {
#define DPPU(x, ctrl, rm, bc) (unsigned)__builtin_amdgcn_update_dpp(0, (int)(x), ctrl, rm, 0xf, bc)
    v += DPPU(v, 0x111, 0xf, true); v += DPPU(v, 0x112, 0xf, true); v += DPPU(v, 0x114, 0xf, true); v += DPPU(v, 0x118, 0xf, true);
    v += DPPU(v, 0x142, 0xa, false); v += DPPU(v, 0x143, 0xc, false);
#undef DPPU
    return (unsigned)__builtin_amdgcn_readlane((int)v, 63);
}
struct Ctx { int tid, lane, wave, gw, ngw, nblk, blk; LAS unsigned char* lds; };

struct Args { const float* in[22]; float* out; unsigned char* ws; int ph_lo, ph_hi; };
enum { I_X = 0, I_C, I_ADAW, I_ADAB, I_N1G, I_WIN, I_BIN, I_CONVW, I_CONVB, I_LNG, I_LNB, I_WCO, I_POOLW, I_POOLS, I_WOUT, I_BOUT, I_N2G, I_WQ, I_KEYS, I_PU, I_PV, I_FG };

__device__ __forceinline__ void transpose_item(const float* W, int K, int N, int k0, int n0, bf16* WT, int dstrow0, LAS float* scr, int lane, float scale = 1.f) {
#pragma unroll 8
    for (int i = 0; i < 32; ++i) { const int kk = 2 * i + (lane >> 5); scr[kk * 33 + (lane & 31)] = W[(size_t)(k0 + kk) * N + n0 + (lane & 31)] * scale; }
    asm volatile("s_waitcnt lgkmcnt(0)" ::: "memory");
    const int c = lane & 7;
#pragma unroll
    for (int j = 0; j < 4; ++j) { const int n = (lane >> 3) + 8 * j; const LAS float* s = scr + (8 * c) * 33 + n;
        u32x4 o; o.x = pk2(s[0 * 33], s[1 * 33]); o.y = pk2(s[2 * 33], s[3 * 33]); o.z = pk2(s[4 * 33], s[5 * 33]); o.w = pk2(s[6 * 33], s[7 * 33]);
        *(u32x4*)(WT + (size_t)(dstrow0 + n) * K + k0 + 8 * c) = o; }
    asm volatile("s_waitcnt lgkmcnt(0)" ::: "memory");
}
__device__ __forceinline__ int win_dstrow(int n0) {
    if (n0 < 1024) return 256 * (n0 >> 7) + (n0 & 127);
    if (n0 < 2048) { const int c = n0 - 1024; return 256 * (c >> 7) + 128 + (c & 127); }
    return n0;
}
__device__ __forceinline__ void phase_prep(const Ctx& C, const Args& a) {
    unsigned char* ws = a.ws;
    LAS float* scr = (LAS float*)(C.lds + C.wave * 16384);
    constexpr int I_IN = 16 * 160, I_CO = 16 * 32, I_PO = 4 * (4 * 8), I_OUT = 16 * 32, I_L = I_IN + I_CO + I_PO + I_OUT;
    for (int it = C.gw; it < DEPTH * I_L; it += C.ngw) {
        const int l = it / I_L; int r = it % I_L;
        if (r < I_IN) { const int kb = r / 160, nb = r % 160; if (nb < 64 || nb >= 96) transpose_item(a.in[I_WIN] + (size_t)l * D * DIN, D, DIN, 64 * kb, 32 * nb, (bf16*)(ws + WS_WIN) + (size_t)l * DIN * D, win_dstrow(32 * nb), scr, C.lane, (nb >= 96 || (nb >= 32 && nb < 64)) ? SIG_PRESCALE : 1.f); continue; } r -= I_IN;
        if (r < I_CO) { const int kb = r / 32, nb = r % 32; transpose_item(a.in[I_WCO] + (size_t)l * D * D, D, D, 64 * kb, 32 * nb, (bf16*)(ws + WS_WCO) + (size_t)l * D * D, 32 * nb, scr, C.lane); continue; } r -= I_CO;
        if (r < I_PO) { const int g = r / 32, q = r % 32, kb = q / 8, nb = q % 8; transpose_item(a.in[I_POOLW] + ((size_t)l * 4 + g) * 256 * 256, 256, 256, 64 * kb, 32 * nb, (bf16*)(ws + WS_POOL) + ((size_t)l * 1024 + 256 * g) * 256, 32 * nb, scr, C.lane); continue; } r -= I_PO;
        { const int kb = r / 32, nb = r % 32; transpose_item(a.in[I_WOUT] + (size_t)l * D * D, D, D, 64 * kb, 32 * nb, (bf16*)(ws + WS_WOUT) + (size_t)l * D * D, 32 * nb, scr, C.lane); }
    }
    const int gt = C.blk * NTHREADS + C.tid, ngt = C.nblk * NTHREADS;
    for (int i = gt; i < DEPTH * D * 1024 / 8; i += ngt) { const int l = i / (D * 128), rr = i % (D * 128), k = rr / 128, c8 = (rr % 128) * 8; const float* sp = a.in[I_WIN] + ((size_t)l * D + k) * DIN + 2048 + c8;
        const f32x4 v0 = *(const f32x4*)sp, v1 = *(const f32x4*)(sp + 4); *(u32x4*)((bf16*)(ws + WS_WPB) + ((size_t)l * D + k) * 1024 + c8) = pack8(v0, v1); }
    for (size_t i = gt; i < (size_t)DEPTH * D * DQ / 8; i += ngt) { const f32x4 v0 = *(const f32x4*)(a.in[I_WQ] + i * 8), v1 = *(const f32x4*)(a.in[I_WQ] + i * 8 + 4); *(u32x4*)((bf16*)(ws + WS_WQB) + i * 8) = pack8(v0, v1); }
    for (int i = gt; i < DEPTH * 2048 * 32; i += ngt) {
        const int l = i / (2048 * 32), r = i % (2048 * 32), n = r / 32, k8 = (r % 32) * 8;
        const int h = n >> 8, p = (n >> 7) & 1, key = n & 127, pk = k8 >> 7, kk = k8 & 127;
        u32x4 o = (u32x4){0u, 0u, 0u, 0u};
        if (pk == p) { const float* s = a.in[I_KEYS] + ((((size_t)l * 8 + h) * 2 + p) * 128 + key) * 128 + kk; const f32x4 v0 = *(const f32x4*)s, v1 = *(const f32x4*)(s + 4); o = pack8(v0, v1); }
        *(u32x4*)((bf16*)(ws + WS_KEYS) + ((size_t)l * 2048 + n) * 256 + k8) = o;
    }
    for (int row0 = 4 * C.gw; row0 < DEPTH * NEXP; row0 += 4 * C.ngw) {
        const float* src = a.in[I_PU]; float* scl = (float*)(ws + WS_USC);
        f32x4 v[4][4];
#pragma unroll
        for (int r = 0; r < 4; ++r)
#pragma unroll
            for (int q = 0; q < 4; ++q) v[r][q] = *(const f32x4*)(src + (size_t)(row0 + r) * D + 16 * C.lane + 4 * q);
#pragma unroll
        for (int r = 0; r < 4; ++r) { float ss = 0.f; const int row = row0 + r;
#pragma unroll
            for (int q = 0; q < 4; ++q) ss += (v[r][q].x * v[r][q].x + v[r][q].y * v[r][q].y) + (v[r][q].z * v[r][q].z + v[r][q].w * v[r][q].w);
            ss = row16_sum(ss);
            const float step = 0.3352f * sqrtf(ss * (1.f / 256.f)), inv = step > 0.f ? 1.f / step : 0.f; u32x2 w = (u32x2){0u, 0u};
#pragma unroll
            for (int q = 0; q < 4; ++q) {
#pragma unroll
                for (int k = 0; k < 4; ++k) { const int qi = (int)fminf(fmaxf(floorf(v[r][q][k] * inv), -8.f), 7.f); const int idx = 4 * q + k; w[idx >> 3] |= ((unsigned)qi & 15u) << (4 * (idx & 7)); } }
            { const int lyr = row / NEXP, e = row % NEXP; *(u32x2*)(ws + WS_UB + (((size_t)lyr * 4 + (C.lane >> 4)) * NEXP + e) * 128 + 8 * (C.lane & 15)) = w; }
            if ((C.lane & 15) == 0) scl[(size_t)row * 4 + (C.lane >> 4)] = step; }
    }
    for (int row0 = 4 * C.gw; row0 < DEPTH * NEXP; row0 += 4 * C.ngw) {
        const float* src = a.in[I_PV]; float* scl = (float*)(ws + WS_VSC);
        f32x4 v[4][4];
#pragma unroll
        for (int r = 0; r < 4; ++r)
#pragma unroll
            for (int q = 0; q < 4; ++q) v[r][q] = *(const f32x4*)(src + (size_t)(row0 + r) * D + 16 * C.lane + 4 * q);
#pragma unroll
        for (int r = 0; r < 4; ++r) { float ss = 0.f; const int row = row0 + r;
#pragma unroll
            for (int q = 0; q < 4; ++q) ss += (v[r][q].x * v[r][q].x + v[r][q].y * v[r][q].y) + (v[r][q].z * v[r][q].z + v[r][q].w * v[r][q].w);
            ss = wave_sum(ss);
            const float step = 0.3352f * sqrtf(ss * (1.f / D)), inv = step > 0.f ? 1.f / step : 0.f; u32x2 w = (u32x2){0u, 0u};
#pragma unroll
            for (int q = 0; q < 4; ++q) {
#pragma unroll
                for (int k = 0; k < 4; ++k) { const int qi = (int)fminf(fmaxf(floorf(v[r][q][k] * inv), -8.f), 7.f); const int idx = 4 * q + k; w[idx >> 3] |= ((unsigned)qi & 15u) << (4 * (idx & 7)); } }
            { const int lyr = row / NEXP, e = row % NEXP; *(u32x2*)(ws + WS_VB + (((size_t)lyr * 4 + (C.lane >> 4)) * NEXP + e) * 128 + 8 * (C.lane & 15)) = w; }
            if (C.lane == 0) scl[row] = step; }
    }
    for (int it = gt; it < 32 * 3072; it += ngt) {
        const int ks = it / 3072, cg = it % 3072, l = cg / 1536, n4 = (cg % 1536) * 4;
        f32x4 a0 = (f32x4){0.f, 0.f, 0.f, 0.f}, a1 = a0;
        const float* wp = a.in[I_ADAW] + ((size_t)l * D + ks * 32) * NMODV + n4; const float* c0 = a.in[I_C] + ks * 32; const float* c1 = c0 + D;
#pragma unroll 8
        for (int kk = 0; kk < 32; ++kk) { const f32x4 w = *(const f32x4*)(wp + (size_t)kk * NMODV); const float x0 = c0[kk], x1 = c1[kk]; a0 += w * (x0 * sigm(x0)); a1 += w * (x1 * sigm(x1)); }
        float* mp = (float*)(ws + WS_MODP) + (((size_t)ks * 2 + l) * 2) * NMODV + n4;
        *(f32x4*)mp = a0; *(f32x4*)(mp + NMODV) = a1;
    }
}
__device__ __forceinline__ void phase_modreduce(const Ctx& C, const Args& a) {
    const int gt = C.blk * NTHREADS + C.tid, ngt = C.nblk * NTHREADS;
    for (int i = gt; i < 2 * 2 * NMODV; i += ngt) {
        const int l = i / (2 * NMODV), n = i % NMODV; float s = a.in[I_ADAB][(size_t)l * NMODV + n];
        const float* mp = (const float*)(a.ws + WS_MODP) + i;
        for (int ks = 0; ks < 32; ++ks) s += mp[(size_t)ks * 4 * NMODV];
        ((float*)(a.ws + WS_MOD))[i] = s;
    }
}
__device__ __forceinline__ const float* modp(const Args& a, int l, int b, int v) { return (const float*)(a.ws + WS_MOD) + ((size_t)l * 2 + b) * NMODV + v * D; }

__device__ __forceinline__ void normmod_row(const f32x4 (&x)[4], const float* g, const float* sh, const float* sc, int lane, f32x4 (&h)[4]) {
    float s = 0.f;
#pragma unroll
    for (int j = 0; j < 4; ++j) s += (x[j].x * x[j].x + x[j].y * x[j].y) + (x[j].z * x[j].z + x[j].w * x[j].w);
    const float rstd = 1.f / sqrtf(wave_sum(s) * (1.f / D) + EPS);
#pragma unroll
    for (int j = 0; j < 4; ++j) { const int c = 4 * lane + 256 * j; const f32x4 gv = *(const f32x4*)(g + c), shv = *(const f32x4*)(sh + c), scv = *(const f32x4*)(sc + c);
        h[j] = (x[j] * rstd) * gv * (scv + 1.f) + shv; }
}
__device__ __forceinline__ void store_row_bf16(bf16* row, const f32x4 (&h)[4], int lane) {
#pragma unroll
    for (int j = 0; j < 4; ++j) { u32x2 w; w.x = pk2(h[j].x, h[j].y); w.y = pk2(h[j].z, h[j].w); *(u32x2*)(row + 4 * lane + 256 * j) = w; }
}
template <bool F32SRC>
__device__ __forceinline__ void phase_norm(const Ctx& C, const Args& a, const float* X, const bf16* X16, const float* g, int l, int vsh, int vsc, float* hsc, int mbeg, int mstep, int mend) {
    bf16* H = (bf16*)(a.ws + WS_H);
    for (int m0 = mbeg; m0 < mend; m0 += mstep) {
        const int b = m0 >> 13; f32x4 xf[4][4]; u32x2 xw[4][4];
#pragma unroll
        for (int i = 0; i < 4; ++i) {
#pragma unroll
            for (int j = 0; j < 4; ++j) { if (F32SRC) xf[i][j] = *(const f32x4*)(X + (size_t)(m0 + i) * D + 4 * C.lane + 256 * j); else xw[i][j] = *(const u32x2*)(X16 + (size_t)(m0 + i) * D + 4 * C.lane + 256 * j); } }
        f32x4 ga[4], sb[4]; const float* sh = modp(a, l, b, vsh); const float* sc = modp(a, l, b, vsc);
#pragma unroll
        for (int j = 0; j < 4; ++j) { const int c = 4 * C.lane + 256 * j; ga[j] = *(const f32x4*)(g + c) * (*(const f32x4*)(sc + c) + 1.f); sb[j] = *(const f32x4*)(sh + c); }
        __builtin_amdgcn_sched_barrier(0);
#pragma unroll
        for (int i = 0; i < 4; ++i) { const int m = m0 + i; f32x4 x[4], h[4]; float s = 0.f;
#pragma unroll
            for (int j = 0; j < 4; ++j) { if (F32SRC) x[j] = xf[i][j]; else x[j] = (f32x4){bflo(xw[i][j].x), bfhi(xw[i][j].x), bflo(xw[i][j].y), bfhi(xw[i][j].y)};
                s += (x[j].x * x[j].x + x[j].y * x[j].y) + (x[j].z * x[j].z + x[j].w * x[j].w); }
            const float rstd = 1.f / sqrtf(wave_sum(s) * (1.f / D) + EPS);
#pragma unroll
            for (int j = 0; j < 4; ++j) h[j] = (x[j] * rstd) * ga[j] + sb[j];
            store_row_bf16(H + (size_t)m * D, h, C.lane);
            if (hsc) { float am = 0.f;
#pragma unroll
                for (int j = 0; j < 4; ++j) am = fmaxf(am, fmaxf(fmaxf(fabsf(h[j].x), fabsf(h[j].y)), fmaxf(fabsf(h[j].z), fabsf(h[j].w))));
                am = wave_max(am); const float qs = am > 0.f ? 119.f / am : 0.f; unsigned ps01 = 0u, ps23 = 0u;
                unsigned char* hq = a.ws + WS_HQ + (size_t)m * 1024 + (C.lane >> 3) * 32 + ((C.lane & 7) >> 1) * 4 + ((C.lane & 1) ? 16 : 0);
#pragma unroll
                for (int j = 0; j < 4; ++j) { unsigned lo16 = 0u, hi16 = 0u; int ps = 0;
#pragma unroll
                    for (int k = 0; k < 4; ++k) { const int q8 = (int)rintf(h[j][k] * qs); lo16 |= ((unsigned)q8 & 15u) << (4 * k); hi16 |= ((unsigned)((q8 + 8) >> 4) & 15u) << (4 * k); ps += q8; }
                    const unsigned mine = hi16 | (lo16 << 16), other = (unsigned)__builtin_amdgcn_update_dpp(0, (int)mine, 0xB1, 0xf, 0xf, true);
                    const unsigned w = (C.lane & 1) ? ((other >> 16) | (mine & 0xffff0000u)) : ((mine & 0xffffu) | (other << 16));
                    *(unsigned*)(hq + j * 256) = w;
                    if (j < 2) ps01 += (unsigned)(ps + 512) << (16 * j); else ps23 += (unsigned)(ps + 512) << (16 * (j - 2)); }
                ps01 = wave_sum_u(ps01); ps23 = wave_sum_u(ps23);
                if (C.lane == 0) { hsc[m] = am * (1.f / 119.f);
                    *(f32x4*)((float*)(a.ws + WS_HSUM) + (size_t)m * 4) = (f32x4){(float)((int)(ps01 & 0xffffu) - 32768), (float)((int)(ps01 >> 16) - 32768), (float)((int)(ps23 & 0xffffu) - 32768), (float)((int)(ps23 >> 16) - 32768)}; } }
        }
    }
}

struct EpiIn {
    const float* bin; const float* bp; bf16 *UG, *ZP, *G;
    struct K { f32x4 a0, a1, b0, b1; };
    __device__ __forceinline__ K pre(int row0, int pn, int cl8) const {
        const float* p; int o;
        if (pn < 8) { p = bin + 128 * pn + cl8; o = 1024; } else if (pn < 12) { p = bp + 256 * (pn - 8) + cl8; o = 128; } else { p = bin + 3072 + 256 * (pn - 12) + cl8; o = 128; }
        K k; k.a0 = *(const f32x4*)p; k.a1 = *(const f32x4*)(p + 4); k.b0 = *(const f32x4*)(p + o); k.b1 = *(const f32x4*)(p + o + 4);
        if (pn < 8) { k.b0 *= SIG_PRESCALE; k.b1 *= SIG_PRESCALE; } else if (pn >= 12) { k.a0 *= SIG_PRESCALE; k.a1 *= SIG_PRESCALE; k.b0 *= SIG_PRESCALE; k.b1 *= SIG_PRESCALE; }
        return k;
    }
    __device__ __forceinline__ void apply(int row, int pn, int cl8, const K& k, f32x4 a0, f32x4 a1, f32x4 b0, f32x4 b1) const {
        a0 += k.a0; a1 += k.a1; b0 += k.b0; b1 += k.b1;
        if (pn < 8) {
            const int c = 128 * pn + cl8;
            f32x4 u0, u1;
#pragma unroll
            for (int i = 0; i < 4; ++i) { u0[i] = a0[i] * sigm2(b0[i]); u1[i] = a1[i] * sigm2(b1[i]); }
            *(u32x4*)(UG + (size_t)row * D + c) = pack8(u0, u1);
        } else if (pn < 12) {
            const int c = 256 * (pn - 8) + cl8;
            *(u32x4*)(ZP + (size_t)row * D + c) = pack8(a0, a1); *(u32x4*)(ZP + (size_t)row * D + c + 128) = pack8(b0, b1);
        } else {
            const int c = 256 * (pn - 12) + cl8;
#pragma unroll
            for (int i = 0; i < 4; ++i) { a0[i] = sigm2(a0[i]); a1[i] = sigm2(a1[i]); b0[i] = sigm2(b0[i]); b1[i] = sigm2(b1[i]); }
            *(u32x4*)(G + (size_t)row * 2048 + c) = pack8(a0, a1); *(u32x4*)(G + (size_t)row * 2048 + c + 128) = pack8(b0, b1);
        }
    }
};
struct EpiConv {
    const bf16* G; const bf16* PLp; const float* scale; bf16* Y;
    struct K { f32x4 s0, s1, s2, s3; };
    __device__ __forceinline__ K pre(int row0, int pn, int cl8) const { const float* p = scale + 256 * pn + cl8; K k; k.s0 = *(const f32x4*)p; k.s1 = *(const f32x4*)(p + 4); k.s2 = *(const f32x4*)(p + 128); k.s3 = *(const f32x4*)(p + 132); return k; }
    __device__ __forceinline__ void apply(int row, int pn, int cl8, const K& k, f32x4 a0, f32x4 a1, f32x4 b0, f32x4 b1) const {
        const int c = 256 * pn + cl8; f32x4 g0, g1, h0, h1, t0, t1;
        unpack8(*(const u32x4*)(G + (size_t)row * 2048 + c), g0, g1); unpack8(*(const u32x4*)(G + (size_t)row * 2048 + 1024 + c), h0, h1); unpack8(*(const u32x4*)(PLp + (size_t)row * D + c), t0, t1);
        *(u32x4*)(Y + (size_t)row * D + c) = pack8(a0 * g0 + h0 * k.s0 * t0, a1 * g1 + h1 * k.s1 * t1);
        unpack8(*(const u32x4*)(G + (size_t)row * 2048 + c + 128), g0, g1); unpack8(*(const u32x4*)(G + (size_t)row * 2048 + 1024 + c + 128), h0, h1); unpack8(*(const u32x4*)(PLp + (size_t)row * D + c + 128), t0, t1);
        *(u32x4*)(Y + (size_t)row * D + c + 128) = pack8(b0 * g0 + h0 * k.s2 * t0, b1 * g1 + h1 * k.s3 * t1);
    }
};
struct EpiOut {
    const float* xold32; const bf16* xold16; bf16* xnew; const float* g1;   const float* bout;
    struct K { f32x4 g[4], gb[4]; };
    __device__ __forceinline__ K pre(int row0, int pn, int cl8) const { const int c = 256 * pn + cl8; const float* g = g1 + (size_t)(row0 >> 13) * NMODV + c; const float* b = bout + c; K k;
        k.g[0] = *(const f32x4*)g; k.g[1] = *(const f32x4*)(g + 4); k.g[2] = *(const f32x4*)(g + 128); k.g[3] = *(const f32x4*)(g + 132);
        k.gb[0] = k.g[0] * *(const f32x4*)b; k.gb[1] = k.g[1] * *(const f32x4*)(b + 4); k.gb[2] = k.g[2] * *(const f32x4*)(b + 128); k.gb[3] = k.g[3] * *(const f32x4*)(b + 132); return k; }
    __device__ __forceinline__ void apply(int row, int pn, int cl8, const K& k, f32x4 a0, f32x4 a1, f32x4 b0, f32x4 b1) const {
        const int c = 256 * pn + cl8; const size_t o = (size_t)row * D + c;
        f32x4 x0, x1, y0, y1;
        if (xold32) { x0 = *(const f32x4*)(xold32 + o); x1 = *(const f32x4*)(xold32 + o + 4); y0 = *(const f32x4*)(xold32 + o + 128); y1 = *(const f32x4*)(xold32 + o + 132); }
        else { unpack8(*(const u32x4*)(xold16 + o), x0, x1); unpack8(*(const u32x4*)(xold16 + o + 128), y0, y1); }
        x0 += k.g[0] * a0 + k.gb[0]; x1 += k.g[1] * a1 + k.gb[1]; y0 += k.g[2] * b0 + k.gb[2]; y1 += k.g[3] * b1 + k.gb[3];
        *(u32x4*)(xnew + o) = pack8(x0, x1); *(u32x4*)(xnew + o + 128) = pack8(y0, y1);
    }
};
struct EpiQ {
    bf16* Q;
    struct K {}; __device__ __forceinline__ K pre(int, int, int) const { return K{}; }
    __device__ __forceinline__ void apply(int row, int pn, int cl8, const K&, f32x4 a0, f32x4 a1, f32x4 b0, f32x4 b1) const {
        const size_t o = (size_t)row * DQ + 256 * pn + cl8; *(u32x4*)(Q + o) = pack8(a0, a1); *(u32x4*)(Q + o + 128) = pack8(b0, b1);
    }
};
struct EpiWT {
    bf16* W;
    struct K {}; __device__ __forceinline__ K pre(int, int, int) const { return K{}; }
    __device__ __forceinline__ void apply(int row, int pn, int cl8, const K&, f32x4 a0, f32x4 a1, f32x4 b0, f32x4 b1) const {
        const size_t o = (size_t)row * D + 256 * pn + cl8; *(u32x4*)(W + o) = pack8(a0, a1); *(u32x4*)(W + o + 128) = pack8(b0, b1);
    }
};
typedef _Float16 f16x2 __attribute__((ext_vector_type(2)));
__device__ __forceinline__ unsigned pkh(float lo, float hi) { return __builtin_bit_cast(unsigned, __builtin_amdgcn_cvt_pkrtz(lo, hi)); }
struct EpiS {
    unsigned short* S;
    struct K {}; __device__ __forceinline__ K pre(int, int, int) const { return K{}; }
    __device__ __forceinline__ void apply(int row, int pn, int cl8, const K&, f32x4 a0, f32x4 a1, f32x4 b0, f32x4 b1) const {
        const size_t o = (size_t)row * DQ + 256 * pn + cl8;
        *(u32x4*)(S + o) = (u32x4){pkh(a0.x, a0.y), pkh(a0.z, a0.w), pkh(a1.x, a1.y), pkh(a1.z, a1.w)}; *(u32x4*)(S + o + 128) = (u32x4){pkh(b0.x, b0.y), pkh(b0.z, b0.w), pkh(b1.x, b1.y), pkh(b1.z, b1.w)};
    }
};

namespace pg8 {
#define PG8_LAS __attribute__((address_space(3)))
typedef unsigned short bf16_t;
typedef short bf16x8 __attribute__((ext_vector_type(8)));
typedef float f32x4 __attribute__((ext_vector_type(4)));
typedef unsigned u32x4 __attribute__((ext_vector_type(4)));
constexpr int BM = 256, BK = 64, HALF = 128, HTB = HALF * BK * 2  , STAGE_BYTES = 8 * HTB, NXCD = 8, WGM = 8;

__host__ __device__ __forceinline__ int lds_byte(int r, int c) { const int st = (r >> 4) * 2 + (c >> 5), rr = r & 15, cc = c & 31, ob = rr * 64 + cc * 2; return st * 1024 + (ob ^ (((ob >> 9) & 1) << 5)); }
__host__ __device__ __forceinline__ void stage_rc(int b, int& R, int& C) { const int st = b / 1024, sb = b % 1024, swz = sb ^ (((sb >> 9) & 1) << 5); R = (st >> 1) * 16 + swz / 64; C = (st & 1) * 32 + (swz % 64) / 2; }
__host__ __device__ __forceinline__ int perm32(int rho) { const int n = rho >> 4, i = rho & 15; return 8 * (i >> 2) + 4 * n + (i & 3); }

struct Unit { int pm, pn; };
struct Gemm { const bf16_t* A; const bf16_t* Bt; int M, N, K, lda, ldb, acol, bcol; };

struct StaticOrder {
    int nM, nN, nwg, G, c;
    __host__ __device__ void init(int M, int N, int G_, int c_) { nM = M / BM; nN = N / BM; nwg = nM * nN; G = G_; c = c_; }
    __host__ __device__ bool next(int i, Unit& u) const {
        const long L = (long)i * G + c; if (L >= nwg) return false;
        int wgid = (int)L; { const int q = nwg / NXCD, r = nwg % NXCD, xcd = wgid % NXCD, off = wgid / NXCD; wgid = (xcd < r ? xcd * (q + 1) : r * (q + 1) + (xcd - r) * q) + off; }
        const int nig = WGM * nN, gid = wgid / nig, fm = gid * WGM, gsz = (nM - fm) < WGM ? (nM - fm) : WGM;
        u.pm = fm + ((wgid % nig) % gsz); u.pn = (wgid % nig) / gsz; return true;
    }
    __device__ __forceinline__ void a_ready(const Unit&) const {}
    __device__ __forceinline__ void done(const Unit&) const {}
};


template <class Epi, class Sched, bool ALIGN_EPI = false, bool SP2 = false>
__device__ __forceinline__ void gemm_phase(PG8_LAS unsigned char* lds, const Gemm g, const Sched& S, const Epi& E, const int tid) {
    const int wid = __builtin_amdgcn_readfirstlane(tid >> 6), lane = tid & 63, wr = wid >> 2, wc = wid & 3, fr = lane & 15, fq = lane >> 4;
    const int K = g.K, nt = K / BK;
    unsigned voffA[2], voffB[2];
#pragma unroll
    for (int i = 0; i < 2; ++i) { int R, C; stage_rc(tid * 16 + i * 8192, R, C); const int Rb = Epi::PERM ? ((R & ~31) + perm32(R & 31)) : R;
        voffA[i] = (unsigned)(R * g.lda + C) * 2u; voffB[i] = (unsigned)(Rb * g.ldb + C) * 2u; }
    const size_t kstep = (size_t)(BK * 2);
    const size_t hstepA = (size_t)HALF * g.lda * 2, hstepB = (size_t)HALF * g.ldb * 2;
    const size_t tstepA = 2 * hstepA, tstepB = 2 * hstepB, acolb = (size_t)g.acol * 2, bcolb = (size_t)g.bcol * 2;
    const unsigned ldsw = (unsigned)wid * 1024u;
    const int aoff = lds_byte(wr * 64 + fr, fq * 8), boff = lds_byte(wc * 32 + fr, fq * 8);
#define PG8_SA(b, h) (((b) * 2 + (h)) * HTB)
#define PG8_SB(b, h) ((4 + (b) * 2 + (h)) * HTB)
#define PG8_STAGE(bufoff, gbase, voff) do { _Pragma("unroll") for (int _i = 0; _i < 2; ++_i) \
        __builtin_amdgcn_global_load_lds((const unsigned*)((const char*)(gbase) + (voff)[_i]), (PG8_LAS unsigned*)(lds + (bufoff) + ldsw + _i * 8192), 16, 0, 0); } while (0)
#define PG8_LDA(dst, b, h) do { _Pragma("unroll") for (int m = 0; m < 4; ++m) _Pragma("unroll") for (int k = 0; k < 2; ++k) dst[m][k] = *(const PG8_LAS bf16x8*)(lds + PG8_SA(b, h) + aoff + m * 2048 + k * 1024); } while (0)
#define PG8_LDB(dst, b, h) do { _Pragma("unroll") for (int n = 0; n < 2; ++n) _Pragma("unroll") for (int k = 0; k < 2; ++k) dst[n][k] = *(const PG8_LAS bf16x8*)(lds + PG8_SB(b, h) + boff + n * 2048 + k * 1024); } while (0)
#define PG8_MMA(ai, bj, At, Bt) do { __builtin_amdgcn_s_setprio(1); _Pragma("unroll") for (int m = 0; m < 4; ++m) _Pragma("unroll") for (int n = 0; n < 2; ++n) _Pragma("unroll") for (int k = 0; k < 2; ++k) \
        acc[ai][bj][m][n] = __builtin_amdgcn_mfma_f32_16x16x32_bf16(Bt[n][k], At[m][k], acc[ai][bj][m][n], 0, 0, 0); __builtin_amdgcn_s_setprio(0); } while (0)
#define PG8_WAIT_V(n) asm volatile("s_waitcnt vmcnt(" #n ")" ::: "memory")
#define PG8_WAIT_L(n) asm volatile("s_waitcnt lgkmcnt(" #n ")" ::: "memory")
#define PG8_BAR __builtin_amdgcn_s_barrier()
#define PG8_SCHED __builtin_amdgcn_sched_barrier(0)
    Unit cur, nxt; int ui = 0;
    if (!S.next(0, cur)) return;
    f32x4 acc[2][2][4][2];
#pragma unroll
    for (int a = 0; a < 2; ++a)
#pragma unroll
        for (int b = 0; b < 2; ++b)
#pragma unroll
            for (int m = 0; m < 4; ++m)
#pragma unroll
                for (int n = 0; n < 2; ++n) acc[a][b][m][n] = (f32x4){0.f, 0.f, 0.f, 0.f};
    bf16x8 At[4][2], B0[2][2], B1[2][2];
    const char* cA = (const char*)g.A + (size_t)cur.pm * tstepA + (size_t)cur.pn * acolb; const char* cB = (const char*)g.Bt + (size_t)cur.pn * tstepB + (size_t)cur.pm * bcolb;
    S.a_ready(cur);
    if constexpr (SP2) {
        PG8_STAGE(PG8_SB(0, 0), cB, voffB); PG8_STAGE(PG8_SB(0, 1), cB + hstepB, voffB); PG8_STAGE(PG8_SA(0, 0), cA, voffA); PG8_STAGE(PG8_SA(0, 1), cA + hstepA, voffA);
        if (wr == 1) PG8_BAR;
        PG8_WAIT_V(2); PG8_BAR;
        PG8_STAGE(PG8_SB(1, 0), cB + kstep, voffB); PG8_STAGE(PG8_SA(1, 0), cA + kstep, voffA); PG8_STAGE(PG8_SB(1, 1), cB + hstepB + kstep, voffB);
        PG8_WAIT_V(6); PG8_BAR;
    } else {
        PG8_STAGE(PG8_SB(0, 0), cB, voffB); PG8_STAGE(PG8_SA(0, 0), cA, voffA); PG8_STAGE(PG8_SB(0, 1), cB + hstepB, voffB); PG8_STAGE(PG8_SA(0, 1), cA + hstepA, voffA);
        if (wr == 1) PG8_BAR;
        PG8_WAIT_V(4); PG8_BAR;
        PG8_STAGE(PG8_SB(1, 0), cB + kstep, voffB); PG8_STAGE(PG8_SA(1, 0), cA + kstep, voffA); PG8_STAGE(PG8_SB(1, 1), cB + hstepB + kstep, voffB);
        PG8_WAIT_V(6); PG8_BAR;
    }
    for (;;) {
        const bool has_next = S.next(ui + 1, nxt);
        const char* nA = has_next ? (const char*)g.A + (size_t)nxt.pm * tstepA + (size_t)nxt.pn * acolb : cA; const char* nB = has_next ? (const char*)g.Bt + (size_t)nxt.pn * tstepB + (size_t)nxt.pm * bcolb : cB;
#pragma nounroll
        for (int t = 0; t < nt; t += 2) {
            const bool last = (t == nt - 2);
            const char* a1 = cA + (size_t)(t + 1) * kstep;
            const char* a2 = last ? nA : cA + (size_t)(t + 2) * kstep; const char* b2 = last ? nB : cB + (size_t)(t + 2) * kstep;
            const char* a3 = a2 + kstep; const char* b3 = b2 + kstep;
            if (last && has_next) S.a_ready(nxt);
            if constexpr (SP2) {
            PG8_LDB(B0, 0, 0); PG8_LDB(B1, 0, 1); PG8_SCHED; PG8_LDA(At, 0, 0); PG8_STAGE(PG8_SA(1, 1), a1 + hstepA, voffA);
            PG8_WAIT_V(8); PG8_WAIT_L(0); PG8_BAR; PG8_MMA(0, 0, At, B0); PG8_MMA(0, 1, At, B1); PG8_BAR; PG8_SCHED;
            PG8_LDA(At, 0, 1); PG8_STAGE(PG8_SB(0, 0), b2, voffB); PG8_STAGE(PG8_SB(0, 1), b2 + hstepB, voffB); PG8_STAGE(PG8_SA(0, 0), a2, voffA);
            PG8_WAIT_V(8); PG8_WAIT_L(0); PG8_BAR; PG8_MMA(1, 0, At, B0); PG8_MMA(1, 1, At, B1); PG8_BAR; PG8_SCHED;
            PG8_LDB(B0, 1, 0); PG8_LDB(B1, 1, 1); PG8_SCHED; PG8_LDA(At, 1, 0); PG8_STAGE(PG8_SA(0, 1), a2 + hstepA, voffA);
            PG8_WAIT_V(8); PG8_WAIT_L(0); PG8_BAR; PG8_MMA(0, 0, At, B0); PG8_MMA(0, 1, At, B1); PG8_BAR; PG8_SCHED;
            PG8_LDA(At, 1, 1); PG8_STAGE(PG8_SB(1, 0), b3, voffB); PG8_STAGE(PG8_SB(1, 1), b3 + hstepB, voffB); PG8_STAGE(PG8_SA(1, 0), a3, voffA);
            PG8_WAIT_V(8); PG8_WAIT_L(0); PG8_BAR; PG8_MMA(1, 0, At, B0); PG8_MMA(1, 1, At, B1); PG8_BAR; PG8_SCHED;
            } else {
            PG8_LDB(B0, 0, 0); PG8_SCHED; PG8_LDA(At, 0, 0); PG8_STAGE(PG8_SA(1, 1), a1 + hstepA, voffA);
            PG8_WAIT_L(8); PG8_BAR; PG8_WAIT_L(0); PG8_MMA(0, 0, At, B0); PG8_BAR; PG8_SCHED;
            PG8_LDB(B1, 0, 1); PG8_STAGE(PG8_SB(0, 0), b2, voffB);
            PG8_BAR; PG8_WAIT_L(0); PG8_MMA(0, 1, At, B1); PG8_BAR;
            PG8_LDA(At, 0, 1); PG8_STAGE(PG8_SA(0, 0), a2, voffA);
            PG8_BAR; PG8_WAIT_L(0); PG8_MMA(1, 0, At, B0); PG8_BAR; PG8_SCHED;
            PG8_STAGE(PG8_SB(0, 1), b2 + hstepB, voffB);
            PG8_WAIT_V(6); PG8_BAR; PG8_MMA(1, 1, At, B1); PG8_BAR;
            PG8_LDB(B0, 1, 0); PG8_SCHED; PG8_LDA(At, 1, 0); PG8_STAGE(PG8_SA(0, 1), a2 + hstepA, voffA);
            PG8_WAIT_L(8); PG8_BAR; PG8_WAIT_L(0); PG8_MMA(0, 0, At, B0); PG8_BAR; PG8_SCHED;
            PG8_LDB(B1, 1, 1); PG8_STAGE(PG8_SB(1, 0), b3, voffB);
            PG8_BAR; PG8_WAIT_L(0); PG8_MMA(0, 1, At, B1); PG8_BAR;
            PG8_LDA(At, 1, 1); PG8_STAGE(PG8_SA(1, 0), a3, voffA);
            PG8_BAR; PG8_WAIT_L(0); PG8_MMA(1, 0, At, B0); PG8_BAR; PG8_SCHED;
            PG8_STAGE(PG8_SB(1, 1), b3 + hstepB, voffB);
            PG8_WAIT_V(6); PG8_BAR; PG8_MMA(1, 1, At, B1); PG8_BAR;
            }
        }
        if constexpr (ALIGN_EPI) { if (wr == 0) PG8_BAR; }
        if constexpr (!Epi::AFTER_DRAIN) { E(acc, cur, wr, wc, fr, fq); S.done(cur); }
        if (!has_next) break;
#pragma unroll
        for (int a = 0; a < 2; ++a)
#pragma unroll
            for (int b = 0; b < 2; ++b)
#pragma unroll
                for (int m = 0; m < 4; ++m)
#pragma unroll
                    for (int n = 0; n < 2; ++n) acc[a][b][m][n] = (f32x4){0.f, 0.f, 0.f, 0.f};
        cur = nxt; cA = nA; cB = nB; ++ui;
        if constexpr (ALIGN_EPI) { if (wr == 1) PG8_BAR; }
    }
    PG8_WAIT_V(0);
    if constexpr (!ALIGN_EPI) { if (wr == 0) PG8_BAR; }
    PG8_BAR;
    if constexpr (Epi::AFTER_DRAIN) { E.fused(acc, cur, wr, wc, fr, fq, lds, wid, lane); S.done(cur); }
#undef PG8_SA
#undef PG8_SB
#undef PG8_STAGE
#undef PG8_LDA
#undef PG8_LDB
#undef PG8_MMA
#undef PG8_WAIT_V
#undef PG8_WAIT_L
#undef PG8_BAR
#undef PG8_SCHED
}

template <class F> struct EpiW {
    static constexpr bool PERM = true, AFTER_DRAIN = false; F f;
    __device__ __forceinline__ void operator()(const f32x4 (&acc)[2][2][4][2], const Unit& u, int wr, int wc, int fr, int fq) const {
        const typename F::K kc = f.pre(u.pm * BM, u.pn, wc * 32 + 8 * fq);
#pragma unroll
        for (int ai = 0; ai < 2; ++ai)
#pragma unroll
            for (int m = 0; m < 4; ++m) { f.apply(u.pm * BM + ai * HALF + wr * 64 + m * 16 + fr, u.pn, wc * 32 + 8 * fq, kc, acc[ai][0][m][0], acc[ai][0][m][1], acc[ai][1][m][0], acc[ai][1][m][1]);
                asm volatile("" ::: "memory"); }
    }
};
}

template <class F>
__device__ __forceinline__ void mfma_gemm(const Ctx& C, const bf16* A, int lda, int acol, const bf16* Bt, int ldb, int Mr, int N, int K, const F& f, int bcol = 0, int blk_off = 0) {
    pg8::Gemm g{A, Bt, Mr, N, K, lda, ldb, acol, bcol}; pg8::StaticOrder S; S.init(Mr, N, C.nblk, (C.blk + C.nblk - blk_off) % C.nblk); pg8::EpiW<F> E{f};
    pg8::gemm_phase<pg8::EpiW<F>, pg8::StaticOrder, true, true>(C.lds, g, S, E, C.tid);
}

template <int NROWS> struct CpStage { static constexpr int NIT = (NROWS * 128 + NTHREADS - 1) / NTHREADS; u32x4 v[NIT]; };
template <int NROWS>
__device__ __forceinline__ void cp_stage_load(CpStage<NROWS>& st, const bf16* src, int mrow0, int tfirst, int tid) {
    asm volatile("" : "+v"(tid));
#pragma unroll
    for (int i = 0; i < CpStage<NROWS>::NIT; ++i) { const int ch = i * NTHREADS + tid, r = ch >> 7, c = ch & 127; st.v[i] = (u32x4){0u, 0u, 0u, 0u};
        if (ch < NROWS * 128 && tfirst + r >= 0) st.v[i] = *(const u32x4*)(src + (size_t)(mrow0 + r) * D + c * 8); }
}
template <int NROWS>
__device__ __forceinline__ void cp_stage_store(const CpStage<NROWS>& st, LAS unsigned char* tile, int tid) {
    asm volatile("" : "+v"(tid));
#pragma unroll
    for (int i = 0; i < CpStage<NROWS>::NIT; ++i) { const int ch = i * NTHREADS + tid; if (ch < NROWS * 128) *(LAS u32x4*)(tile + ch * 16) = st.v[i]; }
}
template <int W>
__device__ __forceinline__ void pool_item(const LAS unsigned char* tile, bf16* PL, int m0, int t0, int tid) {
    asm volatile("" : "+v"(tid));
    float s0 = 0.f, s1 = 0.f;
#pragma unroll
    for (int j = 1; j < W; ++j) { const unsigned w = *(const LAS unsigned*)(tile + (15 - j) * 2048 + 4 * tid); s0 += bflo(w); s1 += bfhi(w); }
#pragma unroll
    for (int ti = 0; ti < 32; ++ti) {
        const unsigned wc = *(const LAS unsigned*)(tile + (ti + 15) * 2048 + 4 * tid); const float c0 = bflo(wc), c1 = bfhi(wc);
        s0 += c0; s1 += c1;
        const float inv = (t0 == 0 && ti + 1 < W) ? (1.f / (float)(ti + 1)) : (1.f / (float)W);
        *(unsigned*)(PL + (size_t)(m0 + ti) * D + 2 * tid) = pk2(s0 * inv - c0, s1 * inv - c1);
        { const unsigned wo = *(const LAS unsigned*)(tile + (ti + 16 - W) * 2048 + 4 * tid); s0 -= bflo(wo); s1 -= bfhi(wo); }
    }
}
template <int RI>
__device__ __forceinline__ void conv_row(const LAS unsigned char* tile, int tid, const float (&w0)[31], const float (&w1)[31], float (&a0)[32], float (&a1)[32]) {
    const unsigned w = *(const LAS unsigned*)(tile + RI * 2048 + 4 * tid);
    const float u0 = bflo(w), u1 = bfhi(w);
#pragma unroll
    for (int ti = 0; ti < 32; ++ti) { constexpr int dbase = 30 - RI; const int d = ti + dbase; if (d >= 0 && d <= 30) { a0[ti] += w0[30 - d] * u0; a1[ti] += w1[30 - d] * u1; } }
    if constexpr ((RI & 7) == 7) asm volatile("" ::: "memory");
}
template <int... RI>
__device__ __forceinline__ void conv_rows(const LAS unsigned char* tile, int tid, const float (&w0)[31], const float (&w1)[31], float (&a0)[32], float (&a1)[32], std::integer_sequence<int, RI...>) {
    (conv_row<RI>(tile, tid, w0, w1, a0, a1), ...);
}
__device__ __forceinline__ void phase_convpool(const Ctx& C, const Args& a, int l, int item0, int istep, int iend) {
    const bf16* UG = (const bf16*)(a.ws + WS_UG); const bf16* ZP = (const bf16*)(a.ws + WS_ZP);
    bf16* AC = (bf16*)(a.ws + WS_AC); bf16* PL = (bf16*)(a.ws + WS_PL);
    const float* cw = a.in[I_CONVW] + (size_t)l * CONVK * D; const float* cb = a.in[I_CONVB] + (size_t)l * D;
    const float* lng = a.in[I_LNG] + (size_t)l * D; const float* lnb = a.in[I_LNB] + (size_t)l * D;
    LAS float* red = (LAS float*)C.lds;
    LAS float* stat = (LAS float*)(C.lds + 2048);
    LAS unsigned char* tile = C.lds + 4096;
    int tid = C.tid;
    asm volatile("" : "+v"(tid));
    const int c0 = 2 * tid;
    float w0[31], w1[31];
#pragma unroll
    for (int k = 0; k < 31; ++k) { const f32x2 w = *(const f32x2*)(cw + (size_t)k * D + c0); w0[k] = w.x; w1[k] = w.y; }
    const f32x2 bb = *(const f32x2*)(cb + c0), gg = *(const f32x2*)(lng + c0), be = *(const f32x2*)(lnb + c0);
    for (int item = item0; item < iend; item += istep) {
        const int m0 = item * 32, t0 = m0 & (SEQ - 1);
        __syncthreads();
        { CpStage<62> su; cp_stage_load<62>(su, UG, m0 - 30, t0 - 30, tid); cp_stage_store<62>(su, tile, tid); }
        __syncthreads();
        float a0[32], a1[32];
#pragma unroll
        for (int i = 0; i < 32; ++i) { a0[i] = bb.x; a1[i] = bb.y; }
        conv_rows(tile, tid, w0, w1, a0, a1, std::make_integer_sequence<int, 62>{});
        CpStage<47> sp; cp_stage_load<47>(sp, ZP, m0 - 15, t0 - 15, tid);
#pragma unroll
        for (int ti = 0; ti < 32; ++ti) {
            const float s = dpp_sum63(a0[ti] + a1[ti]), q = dpp_sum63(a0[ti] * a0[ti] + a1[ti] * a1[ti]);
            if (C.lane == 63) { red[C.wave * 64 + ti] = s; red[C.wave * 64 + 32 + ti] = q; }
        }
        __syncthreads();
        if (tid < 32) { float s = 0.f, q = 0.f;
#pragma unroll
            for (int w = 0; w < 8; ++w) { s += red[w * 64 + tid]; q += red[w * 64 + 32 + tid]; }
            const float mean = s * (1.f / D), var = fmaxf(q * (1.f / D) - mean * mean, 0.f); stat[tid] = mean; stat[32 + tid] = 1.f / sqrtf(var + EPS); }
        __syncthreads();
#pragma unroll
        for (int ti = 0; ti < 32; ++ti) { const float mean = stat[ti], rstd = stat[32 + ti];
            const float y0 = (a0[ti] - mean) * rstd * gg.x + be.x, y1 = (a1[ti] - mean) * rstd * gg.y + be.y;
            *(unsigned*)(AC + (size_t)(m0 + ti) * D + c0) = pk2(y0 * sigm(y0), y1 * sigm(y1)); }
        asm volatile("" ::: "memory");
        cp_stage_store<47>(sp, tile, tid);
        __syncthreads();
        const int g = tid >> 7;
        if (g == 0) pool_item<2>(tile, PL, m0, t0, tid); else if (g == 1) pool_item<4>(tile, PL, m0, t0, tid); else if (g == 2) pool_item<8>(tile, PL, m0, t0, tid); else pool_item<16>(tile, PL, m0, t0, tid);
    }
}

typedef unsigned u32;
template <int CTRL> __device__ __forceinline__ u32 dppu(u32 x) { return (u32)__builtin_amdgcn_update_dpp(0, (int)x, CTRL, 0xf, 0xf, true); }
constexpr int DPP_XOR1 = 0xB1, DPP_REV4 = 0x1B, DPP_DUPE = 0xA0, DPP_DUPO = 0xF5, DPP_HMIRROR = 0x141, DPP_MIRROR = 0x140;
__device__ __forceinline__ u32 umax_(u32 a, u32 b) { return a > b ? a : b; }
__device__ __forceinline__ u32 umin_(u32 a, u32 b) { return a < b ? a : b; }
#define TK_CE(x, i, j) do { const u32 hi_ = umax_(x[i], x[j]), lo_ = umin_(x[i], x[j]); x[i] = hi_; x[j] = lo_; } while (0)
__device__ __forceinline__ void tk_local_merge(u32 (&x)[8]) {
    TK_CE(x, 0, 4); TK_CE(x, 1, 5); TK_CE(x, 2, 6); TK_CE(x, 3, 7);
    TK_CE(x, 0, 2); TK_CE(x, 1, 3); TK_CE(x, 4, 6); TK_CE(x, 5, 7);
    TK_CE(x, 0, 1); TK_CE(x, 2, 3); TK_CE(x, 4, 5); TK_CE(x, 6, 7);
}
template <int CTRL> __device__ __forceinline__ void tk_level(u32 (&x)[8], bool even) {
    u32 t[8];
#pragma unroll
    for (int c = 0; c < 8; ++c) t[c] = dppu<CTRL>(x[7 - c]);
#pragma unroll
    for (int c = 0; c < 8; ++c) x[c] = umax_(x[c], t[c]);
#pragma unroll
    for (int c = 0; c < 8; ++c) { const u32 p = dppu<DPP_XOR1>(x[c]); x[c] = even ? umax_(x[c], p) : umin_(x[c], p); }
    tk_local_merge(x);
}
__device__ __forceinline__ void tk_top16(u32 (&x)[8], bool even) {
    TK_CE(x, 0, 1); TK_CE(x, 2, 3); TK_CE(x, 4, 5); TK_CE(x, 6, 7);
    TK_CE(x, 0, 2); TK_CE(x, 1, 3); TK_CE(x, 4, 6); TK_CE(x, 5, 7);
    TK_CE(x, 1, 2); TK_CE(x, 5, 6);
    TK_CE(x, 0, 4); TK_CE(x, 1, 5); TK_CE(x, 2, 6); TK_CE(x, 3, 7);
    TK_CE(x, 2, 4); TK_CE(x, 3, 5);
    TK_CE(x, 1, 2); TK_CE(x, 3, 4); TK_CE(x, 5, 6);
    { u32 t[8];
#pragma unroll
      for (int c = 0; c < 8; ++c) t[c] = dppu<DPP_XOR1>(x[7 - c]);
#pragma unroll
      for (int c = 0; c < 8; ++c) x[c] = even ? umax_(x[c], t[c]) : umin_(x[c], t[c]); }
    tk_local_merge(x);
    tk_level<DPP_REV4>(x, even); tk_level<DPP_HMIRROR>(x, even); tk_level<DPP_MIRROR>(x, even);
}
__device__ __forceinline__ u32 tk_f2key(float v, int slot) { const u32 u = __builtin_bit_cast(u32, v); const u32 k = u ^ ((u32)((int)u >> 31) | 0x80000000u); return (k & ~127u) | (u32)(127 - slot); }
__device__ __forceinline__ float tk_key2f(u32 k) { k &= ~127u; const u32 m = (u32)((int)k >> 31); return __builtin_bit_cast(float, k ^ (~m | 0x80000000u)); }
__device__ __forceinline__ u32 tk_sel8v(u32 r0, u32 r1, u32 r2, u32 r3, u32 r4, u32 r5, u32 r6, u32 r7, int idx) {
    const bool b0 = idx & 1, b1 = idx & 2, b2 = idx & 4;
    const u32 s01 = b0 ? r1 : r0, s23 = b0 ? r3 : r2, s45 = b0 ? r5 : r4, s67 = b0 ? r7 : r6;
    const u32 s03 = b1 ? s23 : s01, s47 = b1 ? s67 : s45;
    return b2 ? s47 : s03; }
#define tk_sel8(r, idx) tk_sel8v(r[0], r[1], r[2], r[3], r[4], r[5], r[6], r[7], idx)
__device__ __forceinline__ void tk2_sort16(u32 (&x)[16]) { TK_CE(x, 0, 1); TK_CE(x, 2, 3); TK_CE(x, 0, 2); TK_CE(x, 1, 3); TK_CE(x, 1, 2); TK_CE(x, 4, 5); TK_CE(x, 6, 7); TK_CE(x, 4, 6); TK_CE(x, 5, 7); TK_CE(x, 5, 6); TK_CE(x, 0, 4); TK_CE(x, 2, 6); TK_CE(x, 2, 4); TK_CE(x, 1, 5); TK_CE(x, 3, 7); TK_CE(x, 3, 5); TK_CE(x, 1, 2); TK_CE(x, 3, 4); TK_CE(x, 5, 6); TK_CE(x, 8, 9); TK_CE(x, 10, 11); TK_CE(x, 8, 10); TK_CE(x, 9, 11); TK_CE(x, 9, 10); TK_CE(x, 12, 13); TK_CE(x, 14, 15); TK_CE(x, 12, 14); TK_CE(x, 13, 15); TK_CE(x, 13, 14); TK_CE(x, 8, 12); TK_CE(x, 10, 14); TK_CE(x, 10, 12); TK_CE(x, 9, 13); TK_CE(x, 11, 15); TK_CE(x, 11, 13); TK_CE(x, 9, 10); TK_CE(x, 11, 12); TK_CE(x, 13, 14); TK_CE(x, 0, 8); TK_CE(x, 4, 12); TK_CE(x, 4, 8); TK_CE(x, 2, 10); TK_CE(x, 6, 14); TK_CE(x, 6, 10); TK_CE(x, 2, 4); TK_CE(x, 6, 8); TK_CE(x, 10, 12); TK_CE(x, 1, 9); TK_CE(x, 5, 13); TK_CE(x, 5, 9); TK_CE(x, 3, 11); TK_CE(x, 7, 15); TK_CE(x, 7, 11); TK_CE(x, 3, 5); TK_CE(x, 7, 9); TK_CE(x, 11, 13); TK_CE(x, 1, 2); TK_CE(x, 3, 4); TK_CE(x, 5, 6); TK_CE(x, 7, 8); TK_CE(x, 9, 10); TK_CE(x, 11, 12); TK_CE(x, 13, 14); }
__device__ __forceinline__ void tk2_merge16(u32 (&x)[16]) { TK_CE(x, 0, 8); TK_CE(x, 1, 9); TK_CE(x, 2, 10); TK_CE(x, 3, 11); TK_CE(x, 4, 12); TK_CE(x, 5, 13); TK_CE(x, 6, 14); TK_CE(x, 7, 15); TK_CE(x, 0, 4); TK_CE(x, 1, 5); TK_CE(x, 2, 6); TK_CE(x, 3, 7); TK_CE(x, 8, 12); TK_CE(x, 9, 13); TK_CE(x, 10, 14); TK_CE(x, 11, 15); TK_CE(x, 0, 2); TK_CE(x, 1, 3); TK_CE(x, 4, 6); TK_CE(x, 5, 7); TK_CE(x, 8, 10); TK_CE(x, 9, 11); TK_CE(x, 12, 14); TK_CE(x, 13, 15); TK_CE(x, 0, 1); TK_CE(x, 2, 3); TK_CE(x, 4, 5); TK_CE(x, 6, 7); TK_CE(x, 8, 9); TK_CE(x, 10, 11); TK_CE(x, 12, 13); TK_CE(x, 14, 15); }
template <int CTRL> __device__ __forceinline__ void tk2_level(u32 (&x)[16]) {
    u32 t[16];
#pragma unroll
    for (int c = 0; c < 16; ++c) t[c] = dppu<CTRL>(x[15 - c]);
#pragma unroll
    for (int c = 0; c < 16; ++c) x[c] = umax_(x[c], t[c]);
    tk2_merge16(x);
}
__device__ __forceinline__ void tk2_top16(u32 (&x)[16]) { tk2_sort16(x); tk2_level<DPP_XOR1>(x); tk2_level<DPP_REV4>(x); tk2_level<DPP_HMIRROR>(x); }
__device__ __forceinline__ u32 tk_sel16v(u32 r0, u32 r1, u32 r2, u32 r3, u32 r4, u32 r5, u32 r6, u32 r7, u32 r8, u32 r9, u32 r10, u32 r11, u32 r12, u32 r13, u32 r14, u32 r15, int idx) {
    const u32 lo = tk_sel8v(r0, r1, r2, r3, r4, r5, r6, r7, idx & 7), hi = tk_sel8v(r8, r9, r10, r11, r12, r13, r14, r15, idx & 7); return (idx & 8) ? hi : lo; }
__device__ __forceinline__ float tk_key2f_h(u32 k) { const u32 kk = k & 0xffff0000u, m = (u32)((int)kk >> 31); const u32 hb = kk ^ (0x80000000u | (~m & 0x7fff0000u));
    return (float)__builtin_bit_cast(f16x2, hb).y; }
__device__ __forceinline__ u32 tk_sel4v(u32 a0, u32 a1, u32 a2, u32 a3, int idx) { const u32 s01 = (idx & 1) ? a1 : a0, s23 = (idx & 1) ? a3 : a2; return (idx & 2) ? s23 : s01; }
__device__ __forceinline__ void tk4_half(const unsigned short* sp, int r, u32 (&y)[16]) {
    typedef short s16x2 __attribute__((ext_vector_type(2)));
    u32 lo[16], hi[16];
#pragma unroll
    for (int c4 = 0; c4 < 4; ++c4) { const u32x4 v = *(const u32x4*)(sp + 8 * c4);
#pragma unroll
        for (int c = 0; c < 4; ++c) { const u32 vc = v[c]; const int e = 8 * c4 + 2 * c;
            const u32 mv = __builtin_bit_cast(u32, __builtin_bit_cast(s16x2, vc) >> (s16x2){15, 15});
            const u32 tv = vc ^ (mv | 0x80008000u), s0 = (u32)(127 - (32 * r + e)), s1 = s0 - 1u;
            if (e < 16) { lo[e] = (tv << 16) | s0; lo[e + 1] = (tv & 0xffff0000u) | s1; } else { hi[e - 16] = (tv << 16) | s0; hi[e - 15] = (tv & 0xffff0000u) | s1; } } }
    tk2_sort16(lo); tk2_sort16(hi);
#pragma unroll
    for (int c = 0; c < 16; ++c) y[c] = umax_(lo[c], hi[15 - c]);
    tk2_merge16(y); tk2_level<DPP_XOR1>(y); tk2_level<DPP_REV4>(y);
}
__device__ __forceinline__ u32 tk4_ckey(float v, u32 ia7, u32 ib, bool valid) {
    const u32 fx = umin_((u32)fmaxf((v + 64.f) * 2048.f, 0.f), 0x3ffffu); return valid ? ((fx << 14) | ia7 | ib) : 0u; }
__device__ __forceinline__ void phase_topk(const Ctx& C, const Args& a) {
    const unsigned short* S = (const unsigned short*)(a.ws + WS_S); int* EID = (int*)(a.ws + WS_EID); float* GW = (float*)(a.ws + WS_GW);
    const int lane = C.lane, r = lane & 3, qd = lane >> 2;
    pg8::StaticOrder SO; SO.init(M, DQ, C.nblk, C.blk); pg8::Unit un;
    for (int ui = 0; SO.next(ui, un); ++ui)
    for (int wi = C.wave; wi < 16; wi += NWAVES) {
        const int tok = un.pm * 256 + wi * 16 + qd, h = un.pn;
        u32 ya[16], yb[16];
        { const unsigned short* sp = S + (size_t)tok * DQ + h * 256 + 32 * r; tk4_half(sp, r, ya); tk4_half(sp + 128, r, yb); }
        const u32 kb0 = tk_sel4v(yb[0], yb[1], yb[2], yb[3], r), kb1 = tk_sel4v(yb[4], yb[5], yb[6], yb[7], r), kb2 = tk_sel4v(yb[8], yb[9], yb[10], yb[11], r), kb3 = tk_sel4v(yb[12], yb[13], yb[14], yb[15], r);
        const float vb0 = tk_key2f_h(kb0), vb1 = tk_key2f_h(kb1), vb2 = tk_key2f_h(kb2), vb3 = tk_key2f_h(kb3);
        const u32 ib0 = kb0 & 127u, ib1 = kb1 & 127u, ib2 = kb2 & 127u, ib3 = kb3 & 127u;
        const int limA = (r == 0) ? 15 : (r == 1) ? 7 : (r == 2) ? 4 : 3, limB = (r == 0) ? 2 : 1;
        u32 y[16], l5[5]; float va0 = 0.f; u32 ia0 = 0u;
#pragma unroll
        for (int c = 0; c < 16; ++c) { const float va = tk_key2f_h(ya[c]); const u32 ia7 = (ya[c] & 127u) << 7; if (c == 0) { va0 = va; ia0 = ia7; }
            y[c] = tk4_ckey(va + vb0, ia7, ib0, c <= limA);
            if (c < 3) l5[c] = tk4_ckey(va + vb1, ia7, ib1, c <= limB); }
        l5[3] = tk4_ckey(va0 + vb2, ia0, ib2, true); l5[4] = tk4_ckey(va0 + vb3, ia0, ib3, true);
        TK_CE(l5, 0, 3); TK_CE(l5, 1, 4); TK_CE(l5, 1, 3); TK_CE(l5, 2, 4); TK_CE(l5, 2, 3); TK_CE(l5, 1, 2); TK_CE(l5, 3, 4);
#pragma unroll
        for (int c = 11; c < 16; ++c) y[c] = umax_(y[c], l5[15 - c]);
        tk2_merge16(y); tk2_level<DPP_XOR1>(y);
        { u32 t[16];
#pragma unroll
          for (int c = 0; c < 16; ++c) t[c] = dppu<DPP_REV4>(y[15 - c]);
#pragma unroll
          for (int c = 0; c < 16; ++c) y[c] = umax_(y[c], t[c]); }
        const float fmx = (float)(umax_(y[0], y[15]) >> 14) * (1.f / 2048.f) - 64.f;
        u32 eo[4]; float ex[4];
#pragma unroll
        for (int u = 0; u < 4; ++u) { const u32 x = tk_sel4v(y[u], y[4 + u], y[7 - u], y[3 - u], r);
            eo[u] = (127u - ((x >> 7) & 127u)) * 128u + (127u - (x & 127u)); ex[u] = __expf(((float)(x >> 14) * (1.f / 2048.f) - 64.f) - fmx); }
        float sum = (ex[0] + ex[1]) + (ex[2] + ex[3]);
        sum += __builtin_bit_cast(float, dppu<DPP_XOR1>(__builtin_bit_cast(u32, sum))); sum += __builtin_bit_cast(float, dppu<0x4E>(__builtin_bit_cast(u32, sum)));
        const float inv = 1.f / sum;
        *(u32x4*)(EID + (size_t)tok * 128 + h * 16 + 4 * r) = (u32x4){eo[0], eo[1], eo[2], eo[3]};
        *(f32x4*)(GW + (size_t)tok * 128 + h * 16 + 4 * r) = (f32x4){ex[0] * inv, ex[1] * inv, ex[2] * inv, ex[3] * inv};
    }
}

__device__ __forceinline__ float dot2bf(unsigned w, unsigned x, float acc) { return __builtin_amdgcn_fdot2_f32_bf16(__builtin_bit_cast(bf16x2_t, w), __builtin_bit_cast(bf16x2_t, x), acc, false); }
__device__ __forceinline__ int dot8z(int a, int b) { int d; asm("v_dot8_i32_i4 %0, %1, %2, 0" : "=v"(d) : "v"(a), "v"(b)); return d; }
constexpr int PNB = 8;
__device__ __forceinline__ void phase_peer_a(const Ctx& C, const Args& a, int l) {
    const int x = C.blk & 7, c4 = x & 3, th = x >> 2, wg = (C.blk >> 3) * NWAVES + C.wave, nwg = ((C.nblk + 7 - x) >> 3) * NWAVES;
    const __amdgpu_buffer_rsrc_t UC = __builtin_amdgcn_make_buffer_rsrc(a.ws + WS_UB + ((size_t)l * 4 + c4) * NEXP * 128, 0, NEXP * 128, 0x00020000);
    const int* EID = (const int*)(a.ws + WS_EID); const unsigned char* HQ = a.ws + WS_HQ; unsigned* PD = (unsigned*)(a.ws + WS_PD);
    LAS float* dl = (LAS float*)(C.lds + C.wave * 1024);
    unsigned z_ = 0u; asm volatile("" : "+v"(z_));
    const int lane = (int)__builtin_amdgcn_mbcnt_hi(~0u, __builtin_amdgcn_mbcnt_lo(~0u, z_)), p = lane & 7, g = lane >> 3;
#define PA_META(t_, ev0_, ev1_, r0_, r1_) do { ev0_ = EID[(size_t)(t_) * 128 + lane]; ev1_ = EID[(size_t)(t_) * 128 + 64 + lane]; \
        r0_ = *(const u32x4*)(HQ + (size_t)(t_) * 1024 + c4 * 256 + p * 32); r1_ = *(const u32x4*)(HQ + (size_t)(t_) * 1024 + c4 * 256 + p * 32 + 16); } while (0)
#define PA_ISSUE(rows_, ev_) do { _Pragma("unroll") for (int j = 0; j < 8; ++j) { const int e = __builtin_amdgcn_ds_bpermute((8 * j + g) << 2, ev_); \
        rows_[j] = __builtin_bit_cast(u32x4, __builtin_amdgcn_raw_buffer_load_b128(UC, e * 128 + 16 * p, 0, 0)); } } while (0)
#define PA_HALF(rows_, off_) do { _Pragma("unroll") for (int j = 0; j < 8; ++j) { \
            int ah = dot8z((int)rows_[j].x, (int)hqh.x); ah = __builtin_amdgcn_sdot8((int)rows_[j].y, (int)hqh.y, ah, false); \
            ah = __builtin_amdgcn_sdot8((int)rows_[j].z, (int)hqh.z, ah, false); ah = __builtin_amdgcn_sdot8((int)rows_[j].w, (int)hqh.w, ah, false); \
            int al = dot8z((int)rows_[j].x, (int)hql.x); al = __builtin_amdgcn_sdot8((int)rows_[j].y, (int)hql.y, al, false); \
            al = __builtin_amdgcn_sdot8((int)rows_[j].z, (int)hql.z, al, false); al = __builtin_amdgcn_sdot8((int)rows_[j].w, (int)hql.w, al, false); \
            int acc = (ah << 4) + al; \
            acc += __builtin_amdgcn_update_dpp(0, acc, 0xB1, 0xf, 0xf, true); acc += __builtin_amdgcn_update_dpp(0, acc, 0x4E, 0xf, 0xf, true); acc += __builtin_amdgcn_update_dpp(0, acc, 0x141, 0xf, 0xf, true);   \
            tot[(off_) + j] = (float)acc; } } while (0)
    int evA0, evA1, evB0, evB1; u32x4 hA0, hA1, hB0, hB1, rows0[8], rows1[8];
#define PA_TOKEN(ev0_, ev1_, h0_, h1_, tcur_, tload_, evn0_) do { \
        const u32x4 hqh = h0_, hql = h1_;             \
        PA_ISSUE(rows1, ev1_);                        \
        PA_META(tload_, ev0_, ev1_, h0_, h1_);        \
        __builtin_amdgcn_sched_barrier(0);            \
        float tot[16]; \
        PA_HALF(rows0, 0); \
        __builtin_amdgcn_sched_barrier(0); \
        PA_ISSUE(rows0, evn0_);                       \
        __builtin_amdgcn_sched_barrier(0); \
        PA_HALF(rows1, 8); \
        __builtin_amdgcn_sched_barrier(0); \
        if (p == 0) { _Pragma("unroll") for (int j = 0; j < 16; ++j) dl[8 * j + g] = tot[j]; } \
        asm volatile("s_waitcnt lgkmcnt(0)" ::: "memory"); \
        const float d0 = dl[lane], d1 = dl[64 + lane]; \
        if ((tcur_) < M) PD[((size_t)(tcur_) * 4 + c4) * 64 + lane] = pkh(d0 * 0.015625f, d1 * 0.015625f); \
        asm volatile("s_waitcnt lgkmcnt(0)" ::: "memory");   } while (0)
    constexpr int MH = M / 2;
    int i = wg;
    { const int ic = i < MH ? i : 0; PA_META(2 * ic + th, evA0, evA1, hA0, hA1); }
    { const int ic = i + nwg < MH ? i + nwg : 0; PA_META(2 * ic + th, evB0, evB1, hB0, hB1); }
    PA_ISSUE(rows0, evA0);
#pragma nounroll
    for (; i < MH; i += 2 * nwg) {
        const int i1 = i + nwg, i2 = i + 2 * nwg, i3 = i + 3 * nwg, c2 = i2 < MH ? i2 : i, c3 = i3 < MH ? i3 : i;
        const int tA = 2 * i + th, tB = i1 < MH ? 2 * i1 + th : M;
        PA_TOKEN(evA0, evA1, hA0, hA1, tA, 2 * c2 + th, evB0);
        PA_TOKEN(evB0, evB1, hB0, hB1, tB, 2 * c3 + th, evA0);
    }
#undef PA_TOKEN
#undef PA_META
#undef PA_ISSUE
#undef PA_HALF
}
__device__ __forceinline__ void phase_peer_c(const Ctx& C, const Args& a, int l) {
    const float* USC = (const float*)(a.ws + WS_USC) + (size_t)l * NEXP * 4; const float* VSC = (const float*)(a.ws + WS_VSC) + (size_t)l * NEXP;
    const int* EID = (const int*)(a.ws + WS_EID); const float* GW = (const float*)(a.ws + WS_GW); const float* HSC = (const float*)(a.ws + WS_HSC); const float* HSUM = (const float*)(a.ws + WS_HSUM); const unsigned* PD = (const unsigned*)(a.ws + WS_PD);
    unsigned* C8 = (unsigned*)(a.ws + WS_COEF); float* CSC = (float*)(a.ws + WS_CSC);
    for (int t0 = 4 * C.gw; t0 < M; t0 += 4 * C.ngw) {
        unsigned pw[4][4]; int ev[4][2]; float gv[4][2], vs[4][2], hs[4]; f32x4 us[4][2], hsum[4];
#pragma unroll
        for (int i = 0; i < 4; ++i) { const int t = t0 + i; hs[i] = HSC[t]; hsum[i] = *(const f32x4*)(HSUM + (size_t)t * 4);
#pragma unroll
            for (int u = 0; u < 2; ++u) { ev[i][u] = EID[(size_t)t * 128 + 64 * u + C.lane]; gv[i][u] = GW[(size_t)t * 128 + 64 * u + C.lane]; }
#pragma unroll
            for (int xx = 0; xx < 4; ++xx) pw[i][xx] = PD[((size_t)t * 4 + xx) * 64 + C.lane]; }
#pragma unroll
        for (int i = 0; i < 4; ++i) {
#pragma unroll
            for (int u = 0; u < 2; ++u) { us[i][u] = *(const f32x4*)(USC + (size_t)ev[i][u] * 4); vs[i][u] = VSC[ev[i][u]]; } }
        __builtin_amdgcn_sched_barrier(0);
#pragma unroll
        for (int i = 0; i < 4; ++i) { const int t = t0 + i; float cf[2], dsum[2] = {0.f, 0.f};
#pragma unroll
            for (int xx = 0; xx < 4; ++xx) { const unsigned w = pw[i][xx]; const f16x2 hv = __builtin_bit_cast(f16x2, w); const float hh = 0.5f * hsum[i][xx];
                dsum[0] += us[i][0][xx] * ((float)hv.x * 64.f + hh); dsum[1] += us[i][1][xx] * ((float)hv.y * 64.f + hh); }
#pragma unroll
            for (int u = 0; u < 2; ++u) { const float dd = dsum[u] * hs[i]; cf[u] = vs[i][u] * gv[i][u] * 0.5f * dd * (1.f + erff(dd * 0.70710678118654752f)); }
            const float am = wave_max(fmaxf(fabsf(cf[0]), fabsf(cf[1]))), inv = am > 0.f ? 119.f / am : 0.f;
            const int k0 = (int)rintf(cf[0] * inv), k1 = (int)rintf(cf[1] * inv);
            const float ksum = wave_sum((float)(k0 + k1));
            { const int sh = 4 * (C.lane & 7); u32x4 w = (u32x4){((unsigned)k0 & 15u) << sh, ((unsigned)((k0 + 8) >> 4) & 15u) << sh, ((unsigned)k1 & 15u) << sh, ((unsigned)((k1 + 8) >> 4) & 15u) << sh};
#pragma unroll
              for (int c = 0; c < 4; ++c) { unsigned v = w[c]; v |= dppu<DPP_XOR1>(v); v |= dppu<0x4E>(v); v |= dppu<DPP_HMIRROR>(v); w[c] = v; }
              if ((C.lane & 7) == 0) { *(u32x2*)(C8 + (size_t)t * 32 + 2 * (C.lane >> 3)) = (u32x2){w.x, w.y}; *(u32x2*)(C8 + (size_t)t * 32 + 16 + 2 * (C.lane >> 3)) = (u32x2){w.z, w.w}; } }
            if (C.lane == 0) { const float cs = am * (1.f / 119.f); *(f32x2*)(CSC + (size_t)t * 2) = (f32x2){cs, 0.5f * cs * ksum}; } }
    }
}
__device__ __forceinline__ void phase_peer_b(const Ctx& C, const Args& a, int l) {
    typedef int v2i32_t __attribute__((ext_vector_type(2)));
    const int x = C.blk & 7, c4 = x & 3, th = x >> 2, wg = (C.blk >> 3) * NWAVES + C.wave, nwg = ((C.nblk + 7 - x) >> 3) * NWAVES;
    const unsigned char* VB = a.ws + WS_VB + ((size_t)l * 4 + c4) * NEXP * 128;
    const int* EID = (const int*)(a.ws + WS_EID); const int* C8 = (const int*)(a.ws + WS_COEF); const float* CSC = (const float*)(a.ws + WS_CSC); bf16* XW = (bf16*)(a.ws + WS_XB);
    LAS unsigned char* wlA = C.lds + C.wave * 16384; LAS unsigned char* wlB = wlA + 8192;
    unsigned z_ = 0u; asm volatile("" : "+v"(z_));
    const int lane = (int)__builtin_amdgcn_mbcnt_hi(~0u, __builtin_amdgcn_mbcnt_lo(~0u, z_)), p = lane & 7, g = lane >> 3;
    const int q = lane >> 4, r = lane & 15;
    const unsigned pcE = 16u * (p ^ (g >> 1)), pcO = 16u * (p ^ (4 + (g >> 1)));
    unsigned rofs[4];
#pragma unroll
    for (int u = 0; u < 4; ++u) { const int blk = 4 * u + q; rofs[u] = 128u * r + 16u * ((blk >> 1) ^ (r >> 1)) + 8u * (blk & 1); }
    const int cbA = 16 * q + (r & 14) + ((lane & 1) ? 128 : 0);
    unsigned ra[4];
#pragma unroll
    for (int u = 0; u < 4; ++u) ra[u] = (unsigned)(size_t)wlA + rofs[u];
#define PB_META(t_, ev0_, ev1_, cf_) do { ev0_ = EID[(size_t)(t_) * 128 + lane]; ev1_ = EID[(size_t)(t_) * 128 + 64 + lane]; cf_ = C8[(size_t)(t_) * 32 + (lane & 31)]; } while (0)
#define PB_ISSUE(buf_, ev_) do { asm volatile("s_waitcnt lgkmcnt(0)" ::: "memory");   \
        _Pragma("unroll") for (int j = 0; j < 8; ++j) { const int e = __builtin_amdgcn_ds_bpermute((8 * j + g) << 2, ev_); \
        __builtin_amdgcn_global_load_lds((const unsigned*)(VB + (size_t)(unsigned)(e * 128) + ((j & 1) ? pcO : pcE)), (LAS unsigned*)(buf_ + 1024 * j), 16, 0, 0); } } while (0)
#define PB_TR4(dst_, addr_, off_) asm volatile("ds_read_b64_tr_b4 %0, %1 offset:%2" : "=v"(dst_) : "v"(addr_), "n"(off_))
#define PB_HALF(bo_, h_, cf_) do { v2i32_t tv[4][4]; \
        _Pragma("unroll") for (int T = 0; T < 4; ++T) { _Pragma("unroll") for (int u = 0; u < 4; ++u) PB_TR4(tv[T][u], ra[u], (bo_) + 2048 * T); } \
        asm volatile("s_waitcnt lgkmcnt(0)" : "+v"(tv[0][0]), "+v"(tv[0][1]), "+v"(tv[0][2]), "+v"(tv[0][3]), "+v"(tv[1][0]), "+v"(tv[1][1]), "+v"(tv[1][2]), "+v"(tv[1][3]), \
                                              "+v"(tv[2][0]), "+v"(tv[2][1]), "+v"(tv[2][2]), "+v"(tv[2][3]), "+v"(tv[3][0]), "+v"(tv[3][1]), "+v"(tv[3][2]), "+v"(tv[3][3]) :: "memory");   \
        _Pragma("unroll") for (int T = 0; T < 4; ++T) { const int kl0 = __builtin_amdgcn_readlane(cf_, 16 * (h_) + 4 * T), kh0 = __builtin_amdgcn_readlane(cf_, 16 * (h_) + 4 * T + 1), kl1 = __builtin_amdgcn_readlane(cf_, 16 * (h_) + 4 * T + 2), kh1 = __builtin_amdgcn_readlane(cf_, 16 * (h_) + 4 * T + 3); \
            _Pragma("unroll") for (int u = 0; u < 4; ++u) { const v2i32_t v = tv[T][u]; \
                ol_[u] = __builtin_amdgcn_sdot8(v.x, kl0, ol_[u], false); ol_[u] = __builtin_amdgcn_sdot8(v.y, kl1, ol_[u], false); oh_[u] = __builtin_amdgcn_sdot8(v.x, kh0, oh_[u], false); oh_[u] = __builtin_amdgcn_sdot8(v.y, kh1, oh_[u], false); } } \
        } while (0)
    int evA0, evA1, evB0, evB1, cfA, cfB;
    const f32x2 gA0 = *(const f32x2*)(modp(a, l, 0, 5) + 256 * c4 + cbA), gB0 = *(const f32x2*)(modp(a, l, 0, 5) + 256 * c4 + cbA + 64), gA1 = *(const f32x2*)(modp(a, l, 1, 5) + 256 * c4 + cbA), gB1 = *(const f32x2*)(modp(a, l, 1, 5) + 256 * c4 + cbA + 64);
    constexpr int MH = M / 2;
    int i = wg;
    { const int ic = i < MH ? i : 0; PB_META(2 * ic + th, evA0, evA1, cfA); }
    { const int ic = i + nwg < MH ? i + nwg : 0; PB_META(2 * ic + th, evB0, evB1, cfB); }
    unsigned xnA, xnB; f32x2 csn; { const int tc = 2 * (i < MH ? i : 0) + th; xnA = *(const unsigned*)(XW + (size_t)tc * D + 256 * c4 + cbA); xnB = *(const unsigned*)(XW + (size_t)tc * D + 256 * c4 + cbA + 64); csn = *(const f32x2*)(CSC + (size_t)tc * 2); }
    asm volatile("s_waitcnt vmcnt(0)" ::: "memory");
    __builtin_amdgcn_sched_barrier(0);
    PB_ISSUE(wlA, evA0);
    __builtin_amdgcn_sched_barrier(0);
#pragma nounroll
    for (; i < MH; i += nwg) {
        const int t = 2 * i + th, i2 = i + 2 * nwg, c2 = i2 < MH ? i2 : i;
        const int kf = cfA;
        const f32x2 xa = (f32x2){bflo(xnA), bfhi(xnA)}, xb = (f32x2){bflo(xnB), bfhi(xnB)}; const f32x2 cs = csn;
        __builtin_amdgcn_sched_barrier(0);
        __builtin_amdgcn_sched_barrier(0);
        PB_ISSUE(wlB, evA1);
        __builtin_amdgcn_sched_barrier(0);
        asm volatile("s_waitcnt vmcnt(8)" ::: "memory");
        __builtin_amdgcn_sched_barrier(0);
        int ol_[4] = {0, 0, 0, 0}, oh_[4] = {0, 0, 0, 0};
        PB_HALF(0, 0, kf);
        __builtin_amdgcn_sched_barrier(0);
        PB_ISSUE(wlA, evB0);
        __builtin_amdgcn_sched_barrier(0);
        asm volatile("s_waitcnt vmcnt(8)" ::: "memory");
        __builtin_amdgcn_sched_barrier(0);
        evA0 = evB0; evA1 = evB1; cfA = cfB;
        PB_META(2 * c2 + th, evB0, evB1, cfB);
        { const int i1 = i + nwg < MH ? i + nwg : i, t1 = 2 * i1 + th; xnA = *(const unsigned*)(XW + (size_t)t1 * D + 256 * c4 + cbA); xnB = *(const unsigned*)(XW + (size_t)t1 * D + 256 * c4 + cbA + 64); csn = *(const f32x2*)(CSC + (size_t)t1 * 2); }
        __builtin_amdgcn_sched_barrier(0);
        PB_HALF(8192, 1, kf);
        __builtin_amdgcn_sched_barrier(0);
        int val[4];
#pragma unroll
        for (int u = 0; u < 4; ++u) val[u] = (oh_[u] << 4) + ol_[u];
        const bool odd = lane & 1;
        const int r0 = __builtin_amdgcn_update_dpp(0, odd ? val[0] : val[2], 0xB1, 0xf, 0xf, true), r1 = __builtin_amdgcn_update_dpp(0, odd ? val[1] : val[3], 0xB1, 0xf, 0xf, true);
        const f32x2 sA = odd ? (f32x2){(float)r0, (float)val[2]} : (f32x2){(float)val[0], (float)r0}, sB = odd ? (f32x2){(float)r1, (float)val[3]} : (f32x2){(float)val[1], (float)r1};
        const f32x2 gA = (t >> 13) ? gA1 : gA0, gB = (t >> 13) ? gB1 : gB0;
        { const f32x2 oa = xa + gA * (sA * cs.x + cs.y), ob = xb + gB * (sB * cs.x + cs.y);
          *(unsigned*)(XW + (size_t)t * D + 256 * c4 + cbA) = pk2(oa.x, oa.y); *(unsigned*)(XW + (size_t)t * D + 256 * c4 + cbA + 64) = pk2(ob.x, ob.y); }
        __builtin_amdgcn_sched_barrier(0);
    }
    asm volatile("s_waitcnt vmcnt(0)" ::: "memory");
#undef PB_META
#undef PB_ISSUE
#undef PB_HALF
#undef PB_TR4
}
__device__ __forceinline__ void phase_final(const Ctx& C, const Args& a) {
    const bf16* XB = (const bf16*)(a.ws + WS_XB);
    for (int m0 = 4 * C.gw; m0 < M; m0 += 4 * C.ngw) { u32x2 xw[4][4]; f32x4 fg[4];
#pragma unroll
        for (int i = 0; i < 4; ++i) {
#pragma unroll
            for (int j = 0; j < 4; ++j) xw[i][j] = *(const u32x2*)(XB + (size_t)(m0 + i) * D + 4 * C.lane + 256 * j); }
#pragma unroll
        for (int j = 0; j < 4; ++j) fg[j] = *(const f32x4*)(a.in[I_FG] + 4 * C.lane + 256 * j);
        __builtin_amdgcn_sched_barrier(0);
#pragma unroll
        for (int i = 0; i < 4; ++i) { const int m = m0 + i; f32x4 x[4]; float ss = 0.f;
#pragma unroll
            for (int j = 0; j < 4; ++j) { const u32x2 w = xw[i][j]; x[j] = (f32x4){bflo(w.x), bfhi(w.x), bflo(w.y), bfhi(w.y)}; ss += (x[j].x * x[j].x + x[j].y * x[j].y) + (x[j].z * x[j].z + x[j].w * x[j].w); }
            const float rstd = 1.f / sqrtf(wave_sum(ss) * (1.f / D) + EPS);
#pragma unroll
            for (int j = 0; j < 4; ++j) *(f32x4*)(a.out + (size_t)m * D + 4 * C.lane + 256 * j) = x[j] * rstd * fg[j]; }
    }
}

#define GEMM mfma_gemm
#define RLX_AGENT __ATOMIC_RELAXED, __HIP_MEMORY_SCOPE_AGENT
#define XB_TMO      128
#define XB_XCNT(j)  (256  + 64 * (j))
#define XB_XSUB(j)  (1280 + 64 * (j))
#define XB_XGEN(j)  (2304 + 64 * (j))
#define XB_TOP      3328
#define XB_TOPGEN   3392
#define XCD_BAR_WORDS 3456
#define XB_SPIN_CAP (1u << 18)

__device__ __forceinline__ unsigned xb_ld(unsigned* p)              { return __hip_atomic_load(p, __ATOMIC_RELAXED, __HIP_MEMORY_SCOPE_AGENT); }
__device__ __forceinline__ unsigned xb_add(unsigned* p, unsigned v) { return __hip_atomic_fetch_add(p, v, __ATOMIC_RELAXED, __HIP_MEMORY_SCOPE_AGENT); }
__device__ __forceinline__ unsigned xb_xcc_id() { return (unsigned)__builtin_amdgcn_s_getreg((3 << 11) | 20) & 0xFu; }
#define XB_SPIN(cond, bar) do { unsigned _sp = 0; while (cond) { __builtin_amdgcn_s_sleep(1); \
    if ((++_sp & 255u) == 0u) { if (xb_ld(&(bar)[XB_TMO])) break; if (_sp > XB_SPIN_CAP) { atomicAdd(&(bar)[XB_TMO], 1u); break; } } } } while (0)

struct XcdBarrier {
    unsigned* bar; unsigned x;
    volatile LAS unsigned* st;
};

__device__ __forceinline__ XcdBarrier xcd_barrier_post(unsigned* bar, volatile LAS unsigned* st) {
    XcdBarrier b; b.bar = bar; b.x = xb_xcc_id(); b.st = st;
    if (threadIdx.x == 0) (void)xb_add(&bar[XB_XCNT(b.x)], 1u);
    return b;
}
__device__ __forceinline__ void xcd_barrier_complete(unsigned* bar, unsigned x, unsigned& nloc, unsigned& nx) {
    const unsigned G = gridDim.x * gridDim.y * gridDim.z;
    unsigned sum, cnt, mine, sp = 0u;
    for (;;) {
        sum = 0u; cnt = 0u; mine = 0u;
#pragma unroll
        for (unsigned j = 0; j < 16; ++j) { const unsigned c = xb_ld(&bar[XB_XCNT(j)]); sum += c; cnt += (c > 0u) ? 1u : 0u; mine = (j == x) ? c : mine; }
        if (sum == G) break;
        __builtin_amdgcn_s_sleep(1);
        if ((++sp & 255u) == 0u) { if (xb_ld(&bar[XB_TMO])) break; if (sp > XB_SPIN_CAP) { atomicAdd(&bar[XB_TMO], 1u); break; } }
    }
    nloc = mine > 0u ? mine : 1u; nx = cnt > 0u ? cnt : 1u;
}

__device__ __forceinline__ void xcd_barrier(const XcdBarrier& b, const int tid_) {
    asm volatile("s_waitcnt vmcnt(0)" ::: "memory");
    __syncthreads();
    if (tid_ == 0) {
        unsigned* bar = b.bar;
        __builtin_amdgcn_s_waitcnt(0);
        unsigned nloc = b.st[0], nx = b.st[1];
        if (nloc == 0u) { xcd_barrier_complete(bar, b.x, nloc, nx); b.st[0] = nloc; b.st[1] = nx; }
        const unsigned old = xb_add(&bar[XB_XSUB(b.x)], 1u);
        const unsigned gen = old / nloc;
        if (old + 1u == (gen + 1u) * nloc) {
            __builtin_amdgcn_fence(__ATOMIC_RELEASE, "agent");
            asm volatile("s_waitcnt vmcnt(0)" ::: "memory");
            (void)xb_add(&bar[XB_TOP], 1u);
            XB_SPIN(xb_ld(&bar[XB_TOP]) < (gen + 1u) * nx, bar);
            __builtin_amdgcn_fence(__ATOMIC_ACQUIRE, "agent");
            xb_add(&bar[XB_XGEN(b.x)], 1u);
            asm volatile("s_waitcnt vmcnt(0)" ::: "memory");
        } else {
            XB_SPIN(xb_ld(&bar[XB_XGEN(b.x)]) == gen, bar);
            __builtin_amdgcn_fence(__ATOMIC_ACQUIRE, "agent");
            asm volatile("s_waitcnt vmcnt(0)" ::: "memory");
        }
    }
    __syncthreads();
}

constexpr int CW_BAR = 4096;
constexpr size_t CTL_ZERO_BYTES = 65536;
constexpr int LDSCTL_OFF = 131072, MISC_OFF = LDSCTL_OFF + 320;
constexpr int PH_PREP = 0, PH_MODR = 1, PH_N1 = 2, PH_L0 = 3, PH_PER_LAYER = 10, N_PHASES = PH_L0 + DEPTH * PH_PER_LAYER;
__device__ __forceinline__ Ctx make_ctx(LAS unsigned char* lds, int wave_s) {
    unsigned z_ = 0u; asm volatile("" : "+v"(z_));
    int tid_ = (wave_s << 6) | (int)__builtin_amdgcn_mbcnt_hi(~0u, __builtin_amdgcn_mbcnt_lo(~0u, z_)); asm volatile("" : "+v"(tid_));
    Ctx C; C.tid = tid_; C.lane = C.tid & 63; C.wave = __builtin_amdgcn_readfirstlane(C.tid >> 6); C.nblk = gridDim.x; C.blk = blockIdx.x;
    C.gw = C.blk * NWAVES + C.wave; C.ngw = C.nblk * NWAVES; C.lds = lds; return C;
}
#define PH(k, ...) if (a.ph_lo <= (k) && (k) < a.ph_hi) { { const Ctx C = make_ctx(lds, wave_s); __VA_ARGS__; } if ((k) + 1 < a.ph_hi) xcd_barrier(bar, make_ctx(lds, wave_s).tid); }
constexpr int CW_XID = 7680, CW_PSYNC = 8192;
__device__ __forceinline__ void panel_of(const Ctx& C, int& P, int& s) { pg8::StaticOrder SO; SO.init(M, D, C.nblk, C.blk); pg8::Unit un; SO.next(0, un); P = un.pm; s = un.pn; }
__device__ __forceinline__ void norm_rows(const Ctx& C, int& mb, int& ms, int& me) {
    if (C.nblk == 256) { int P, s; panel_of(C, P, s); mb = 256 * P + 64 * s + 4 * C.wave; ms = 32; me = 256 * P + 64 * s + 64; } else { mb = 4 * C.gw; ms = 4 * C.ngw; me = M; } }
__device__ __forceinline__ void cp_items(const Ctx& C, int& i0, int& is, int& ie) {
    if (C.nblk == 256) { int P, s; panel_of(C, P, s); i0 = 8 * P + 2 * s; is = 1; ie = i0 + 2; } else { i0 = C.blk; is = C.nblk; ie = M / 32; } }
__device__ __forceinline__ void panel_setup(const Ctx& C, const Args& a, LAS unsigned char* lds) {
    if (C.tid == 0 && C.nblk == 256) { const unsigned* xid = (const unsigned*)(a.ws + WS_CTL) + CW_XID; const int b0 = C.blk & 63;
        const unsigned x0 = xid[b0], x1 = xid[b0 + 64], x2 = xid[b0 + 128], x3 = xid[b0 + 192];
        ((volatile LAS unsigned*)(lds + MISC_OFF))[12] = (x0 != 0u && x0 == x1 && x1 == x2 && x2 == x3) ? 1u : 2u;
        int P, s; panel_of(C, P, s); unsigned nx = 2u;
        if ((P & 31) != 31) { const int Q = P + 1, c0 = (Q >> 3) + 8 * (Q & 7); nx = (xid[c0] == x0 && xid[c0 + 64] == x0 && xid[c0 + 128] == x0 && xid[c0 + 192] == x0) ? 1u : 2u; }
        ((volatile LAS unsigned*)(lds + MISC_OFF))[13] = nx; } }
__device__ __forceinline__ void panel_sync_halo(const Args& a, LAS unsigned char* lds, int idx, const Ctx& C) {
    asm volatile("s_waitcnt vmcnt(0)" ::: "memory");
    __syncthreads();
    if (C.tid == 0) {
        __builtin_amdgcn_s_waitcnt(0);
        int P, s; panel_of(C, P, s);
        unsigned* ctl = (unsigned*)(a.ws + WS_CTL); volatile LAS unsigned* misc = (volatile LAS unsigned*)(lds + MISC_OFF);
        const bool local = misc[12] == 1u && ((P & 31) == 31 || misc[13] == 1u);
        if (!local) { __builtin_amdgcn_fence(__ATOMIC_RELEASE, "agent"); asm volatile("s_waitcnt vmcnt(0)" ::: "memory"); }
        unsigned* w = ctl + CW_PSYNC + (idx * 64 + P) * 8;
        (void)xb_add(w, 1u);
        XB_SPIN(xb_ld(w) < 4u, ctl + CW_BAR);
        if ((P & 31) != 0) XB_SPIN(xb_ld(w - 8) < 4u, ctl + CW_BAR);
        __builtin_amdgcn_fence(__ATOMIC_ACQUIRE, "agent");
        asm volatile("s_waitcnt vmcnt(0)" ::: "memory");
    }
    __syncthreads();
}
#define PHH(k, idx, ...) if (a.ph_lo <= (k) && (k) < a.ph_hi) { { const Ctx C = make_ctx(lds, wave_s); __VA_ARGS__; } if ((k) + 1 < a.ph_hi) { const Ctx Cs = make_ctx(lds, wave_s); if (Cs.nblk == 256) panel_sync_halo(a, lds, idx, Cs); else xcd_barrier(bar, Cs.tid); } }
__device__ __forceinline__ void panel_sync(const Args& a, LAS unsigned char* lds, int idx, const Ctx& C) {
    asm volatile("s_waitcnt vmcnt(0)" ::: "memory");
    __syncthreads();
    if (C.tid == 0) {
        __builtin_amdgcn_s_waitcnt(0);
        int P, s; panel_of(C, P, s);
        unsigned* ctl = (unsigned*)(a.ws + WS_CTL);
        if (((volatile LAS unsigned*)(lds + MISC_OFF))[12] != 1u) { __builtin_amdgcn_fence(__ATOMIC_RELEASE, "agent"); asm volatile("s_waitcnt vmcnt(0)" ::: "memory"); }
        unsigned* w = ctl + CW_PSYNC + (idx * 64 + P) * 8;
        (void)xb_add(w, 1u);
        XB_SPIN(xb_ld(w) < 4u, ctl + CW_BAR);
        __builtin_amdgcn_fence(__ATOMIC_ACQUIRE, "agent");
        asm volatile("s_waitcnt vmcnt(0)" ::: "memory");
    }
    __syncthreads();
}
#define PHP(k, idx, ...) if (a.ph_lo <= (k) && (k) < a.ph_hi) { { const Ctx C = make_ctx(lds, wave_s); __VA_ARGS__; } if ((k) + 1 < a.ph_hi) { const Ctx Cs = make_ctx(lds, wave_s); if (Cs.nblk == 256) panel_sync(a, lds, idx, Cs); else xcd_barrier(bar, Cs.tid); } }
template <int l>
__device__ __forceinline__ void run_layer(const Args& a, LAS unsigned char* lds, const XcdBarrier& bar, const int wave_s) {
    unsigned char* ws = a.ws; constexpr int B0 = PH_L0 + l * PH_PER_LAYER;
    PHH(B0 + 0, 10 + l, EpiIn E{a.in[I_BIN] + (size_t)l * DIN, (const float*)(ws + WS_BP) + (size_t)l * 1024, (bf16*)(ws + WS_UG), (bf16*)(ws + WS_ZP), (bf16*)(ws + WS_G)};
               GEMM(C, (const bf16*)(ws + WS_H), D, 0, (const bf16*)(ws + WS_WIN) + (size_t)l * DIN * D, D, M, DIN, D, E))
    PHP(B0 + 1, 5 * l + 1, int i0, is, ie; cp_items(C, i0, is, ie); phase_convpool(C, a, l, i0, is, ie))
    PHP(B0 + 2, 5 * l + 2, EpiConv E{(const bf16*)(ws + WS_G), (const bf16*)(ws + WS_PL), a.in[I_POOLS] + (size_t)l * D, (bf16*)(ws + WS_Y)};
               GEMM(C, (const bf16*)(ws + WS_AC), D, 0, (const bf16*)(ws + WS_WCO) + (size_t)l * D * D, D, M, D, D, E))
    PHP(B0 + 3, 5 * l + 3, EpiOut E{l == 0 ? a.in[I_X] : nullptr, (const bf16*)(ws + WS_XB), (bf16*)(ws + WS_XB), modp(a, l, 0, 2), a.in[I_BOUT] + (size_t)l * D};
               GEMM(C, (const bf16*)(ws + WS_Y), D, 0, (const bf16*)(ws + WS_WOUT) + (size_t)l * D * D, D, M, D, D, E))
    PHP(B0 + 4, 5 * l + 4, int mb, ms, me; norm_rows(C, mb, ms, me); phase_norm<false>(C, a, nullptr, (const bf16*)(ws + WS_XB), a.in[I_N2G] + (size_t)l * D, l, 3, 4, (float*)(ws + WS_HSC), mb, ms, me))
    PH(B0 + 5, { EpiS E{(unsigned short*)(ws + WS_S)}; GEMM(C, (const bf16*)(ws + WS_H), D, 0, (const bf16*)(ws + WS_WQ) + (size_t)l * DQ * D, D, M, DQ, D, E); }
               asm volatile("s_waitcnt vmcnt(0)" ::: "memory"); __syncthreads();
               { const Ctx C3 = make_ctx(lds, wave_s); phase_topk(C3, a); })
    PH(B0 + 6, phase_peer_a(C, a, l))
    PH(B0 + 7, phase_peer_c(C, a, l))
    PH(B0 + 8, phase_peer_b(C, a, l))
    PHP(B0 + 9, 5 * (l + 1), if (l + 1 < DEPTH) { int mb, ms, me; norm_rows(C, mb, ms, me); phase_norm<false>(C, a, nullptr, (const bf16*)(ws + WS_XB), a.in[I_N1G] + (size_t)(l + 1) * D, l + 1, 0, 1, nullptr, mb, ms, me); } else phase_final(C, a))
}
__global__ void __launch_bounds__(NTHREADS, 2) fwd_kernel(Args a) {
    extern __shared__ __attribute__((aligned(16))) unsigned char lds_raw[];
    LAS unsigned char* lds = (LAS unsigned char*)lds_raw;
    for (int u = threadIdx.x; u < (LDS_BYTES - LDSCTL_OFF) / 4; u += NTHREADS) ((LAS unsigned*)(lds + LDSCTL_OFF))[u] = 0u;
    __syncthreads();
    const int wave_s = __builtin_amdgcn_readfirstlane((int)threadIdx.x >> 6);
    const XcdBarrier bar = xcd_barrier_post((unsigned*)(a.ws + WS_CTL) + CW_BAR, (volatile LAS unsigned*)(lds + MISC_OFF) + 8);
    if (threadIdx.x == 0) ((unsigned*)(a.ws + WS_CTL))[CW_XID + blockIdx.x] = bar.x + 1u;
    PH(PH_PREP, phase_prep(C, a))
    PH(PH_MODR, panel_setup(C, a, lds); phase_modreduce(C, a);
              for (int lf = 0; lf < DEPTH; ++lf) { const Ctx C2 = make_ctx(lds, wave_s); EpiWT E{(bf16*)(a.ws + WS_WQ) + (size_t)lf * DQ * D};
                  GEMM(C2, (const bf16*)(a.ws + WS_KEYS) + (size_t)lf * 2048 * 256, 256, 0, (const bf16*)(a.ws + WS_WQB) + (size_t)lf * D * DQ, DQ, DQ, D, 256, E, 256, 32 * lf); }
              for (int lf = 0; lf < DEPTH; ++lf) { const Ctx C2 = make_ctx(lds, wave_s); EpiWT E{(bf16*)(a.ws + WS_WIN) + ((size_t)lf * DIN + 2048) * D};
                  GEMM(C2, (const bf16*)(a.ws + WS_POOL) + (size_t)lf * 1024 * 256, 256, 0, (const bf16*)(a.ws + WS_WPB) + (size_t)lf * D * 1024, 1024, 1024, D, 256, E, 256, 64 + 16 * lf); }
              { const Ctx C2 = make_ctx(lds, wave_s);
                for (int o = C2.gw; o < DEPTH * 1024; o += C2.ngw) { const int lf = o >> 10, n = o & 1023, g = n >> 8, d = n & 255; float sacc = 0.f;
                    for (int u = 0; u < 4; ++u) { const int c = C2.lane + 64 * u; sacc += a.in[I_BIN][(size_t)lf * DIN + 2048 + g * 256 + c] * a.in[I_POOLW][(((size_t)lf * 4 + g) * 256 + c) * 256 + d]; }
                    sacc = wave_sum(sacc); if (C2.lane == 0) ((float*)(a.ws + WS_BP))[o] = sacc; } })
    PHP(PH_N1, 0, int mb, ms, me; norm_rows(C, mb, ms, me); phase_norm<true>(C, a, a.in[I_X], nullptr, a.in[I_N1G], 0, 0, 1, nullptr, mb, ms, me))
    run_layer<0>(a, lds, bar, wave_s);
    run_layer<1>(a, lds, bar, wave_s);
}

extern "C" void kernel_launch(void* const* d_in, const int* in_sizes, int n_in, void* d_out, int out_size, void* d_ws, size_t ws_size, hipStream_t stream) {
    static int grid = 0;
    if (grid == 0) {
        if (n_in != 22 || out_size != M * D || ws_size < WS_END) { fprintf(stderr, "kernel_launch: unexpected shapes (n_in %d out %d ws %zu)\n", n_in, out_size, ws_size); grid = -1; return; }
        int dev = 0, cus = 0;
        if (hipGetDevice(&dev) != hipSuccess || hipDeviceGetAttribute(&cus, hipDeviceAttributeMultiprocessorCount, dev) != hipSuccess) { grid = -1; return; }
        if (hipFuncSetAttribute((const void*)fwd_kernel, hipFuncAttributeMaxDynamicSharedMemorySize, LDS_BYTES) != hipSuccess) { grid = -1; return; }
        grid = cus;
    }
    if (grid < 0) return;
    Args a{};
    for (int i = 0; i < 22; ++i) a.in[i] = (const float*)d_in[i];
    a.out = (float*)d_out; a.ws = (unsigned char*)d_ws;
    (void)hipMemsetAsync((char*)d_ws + WS_CTL, 0, CTL_ZERO_BYTES, stream);
#ifndef ONE_LAUNCH
    for (int ph = 0; ph < N_PHASES; ++ph) { a.ph_lo = ph; a.ph_hi = ph + 1; hipLaunchKernelGGL(fwd_kernel, dim3(grid), dim3(NTHREADS), LDS_BYTES, stream, a); }
#else
    a.ph_lo = 0; a.ph_hi = N_PHASES; hipLaunchKernelGGL(fwd_kernel, dim3(grid), dim3(NTHREADS), LDS_BYTES, stream, a);
#endif
}
```

```cpp
#define ONE_LAUNCH 1
#include <hip/hip_runtime.h>
#include <cstdint>
#include <cstdio>
#include <utility>

#define GAS __attribute__((address_space(1)))
#define LAS __attribute__((address_space(3)))
typedef unsigned short bf16;
typedef float f32x4 __attribute__((ext_vector_type(4)));
typedef float f32x2 __attribute__((ext_vector_type(2)));
typedef unsigned u32x4 __attribute__((ext_vector_type(4)));
typedef unsigned u32x2 __attribute__((ext_vector_type(2)));
typedef __bf16 bf16x2_t __attribute__((ext_vector_type(2)));

constexpr int BATCH = 2, SEQ = 8192, D = 1024, M = BATCH * SEQ, DEPTH = 2;
constexpr int DIN = 5120, NMODV = 6 * D, CONVK = 31, NHEAD = 8, NKEYS = 128, DQ = 2048, TOPK = 16, NEXP = 16384;
constexpr float EPS = 1e-6f;
constexpr int NWAVES = 8, NTHREADS = NWAVES * 64;

constexpr size_t MiB = 1u << 20;
constexpr size_t WS_CTL = 0;
constexpr size_t WS_MODP = 1 * MiB;
constexpr size_t WS_MOD = 4 * MiB;
constexpr size_t WS_WIN = 8 * MiB;
constexpr size_t WS_WCO = 28 * MiB;
constexpr size_t WS_WOUT = 32 * MiB;
constexpr size_t WS_WQ = 36 * MiB;
constexpr size_t WS_POOL = 44 * MiB;
constexpr size_t WS_KEYS = 45 * MiB;
constexpr size_t WS_UB = 48 * MiB;
constexpr size_t WS_USC = 80 * MiB;
constexpr size_t WS_HQ = 84 * MiB;
constexpr size_t WS_VSC = 81 * MiB;
constexpr size_t WS_VB = 112 * MiB;
constexpr size_t WS_H = 176 * MiB;
constexpr size_t WS_UG = 208 * MiB;
constexpr size_t WS_Y = 472 * MiB;
constexpr size_t WS_ZP = 240 * MiB;
constexpr size_t WS_TMP = WS_ZP;
constexpr size_t WS_Q = WS_UG;
constexpr size_t WS_G = 272 * MiB;
constexpr size_t WS_AC = 336 * MiB;
constexpr size_t WS_PL = 368 * MiB;
constexpr size_t WS_S = WS_G;
constexpr size_t WS_EID = 400 * MiB;
constexpr size_t WS_GW = 408 * MiB;
constexpr size_t WS_COEF = 416 * MiB;
constexpr size_t WS_CSC = 424 * MiB + 524288;
constexpr size_t WS_HSC = 424 * MiB;
constexpr size_t WS_HSUM = 424 * MiB + 131072;
constexpr size_t WS_PD = WS_S;
constexpr size_t WS_WQB = 426 * MiB;
constexpr size_t WS_WPB = 434 * MiB;
constexpr size_t WS_BP = 4 * MiB + 262144;
constexpr size_t WS_XB = 440 * MiB;
constexpr size_t WS_END = 504 * MiB;

constexpr int LDS_BYTES = 147456;

__device__ __forceinline__ unsigned f2bf(float f) { unsigned u = __builtin_bit_cast(unsigned, f); return (u + 0x7fffu + ((u >> 16) & 1u)) >> 16; }
__device__ __forceinline__ unsigned pk2(float lo, float hi) { typedef __bf16 bf16x2_t_ __attribute__((ext_vector_type(2))); return __builtin_bit_cast(unsigned, __builtin_convertvector((f32x2){lo, hi}, bf16x2_t_)); }
__device__ __forceinline__ float bflo(unsigned w) { return __builtin_bit_cast(float, w << 16); }
__device__ __forceinline__ float bfhi(unsigned w) { return __builtin_bit_cast(float, w & 0xffff0000u); }
__device__ __forceinline__ float sigm(float x) { return __builtin_amdgcn_rcpf(1.f + __expf(-x)); }
__device__ __forceinline__ float dpp_sum63(float v) {
#define DPPF(x, ctrl, rm, bc) __builtin_bit_cast(float, __builtin_amdgcn_update_dpp(0, __builtin_bit_cast(int, x), ctrl, rm, 0xf, bc))
    v += DPPF(v, 0x111, 0xf, true); v += DPPF(v, 0x112, 0xf, true); v += DPPF(v, 0x114, 0xf, true); v += DPPF(v, 0x118, 0xf, true);
    v += DPPF(v, 0x142, 0xa, false); v += DPPF(v, 0x143, 0xc, false);
#undef DPPF
    return v;
}
__device__ __forceinline__ float wave_sum(float v) { return __builtin_bit_cast(float, __builtin_amdgcn_readlane(__builtin_bit_cast(int, dpp_sum63(v)), 63)); }
__device__ __forceinline__ float wave_max(float v) {
#define DPPF(x, ctrl, rm, bc) __builtin_bit_cast(float, __builtin_amdgcn_update_dpp(0, __builtin_bit_cast(int, x), ctrl, rm, 0xf, bc))
    v = fmaxf(v, DPPF(v, 0x111, 0xf, true)); v = fmaxf(v, DPPF(v, 0x112, 0xf, true)); v = fmaxf(v, DPPF(v, 0x114, 0xf, true)); v = fmaxf(v, DPPF(v, 0x118, 0xf, true));
    v = fmaxf(v, DPPF(v, 0x142, 0xa, false)); v = fmaxf(v, DPPF(v, 0x143, 0xc, false));
#undef DPPF
    return __builtin_bit_cast(float, __builtin_amdgcn_readlane(__builtin_bit_cast(int, v), 63));
}
__device__ __forceinline__ u32x4 pack8(const f32x4& a, const f32x4& b) { u32x4 w; w.x = pk2(a.x, a.y); w.y = pk2(a.z, a.w); w.z = pk2(b.x, b.y); w.w = pk2(b.z, b.w); return w; }
__device__ __forceinline__ void unpack8(const u32x4& w, f32x4& a, f32x4& b) { a = (f32x4){bflo(w.x), bfhi(w.x), bflo(w.y), bfhi(w.y)}; b = (f32x4){bflo(w.z), bfhi(w.z), bflo(w.w), bfhi(w.w)}; }

__device__ __forceinline__ float row16_sum(float v) {
#define DPPF(x, ctrl) __builtin_bit_cast(float, __builtin_amdgcn_update_dpp(0, __builtin_bit_cast(int, x), ctrl, 0xf, 0xf, true))
    v += DPPF(v, 0xB1); v += DPPF(v, 0x4E); v += DPPF(v, 0x141); v += DPPF(v, 0x140);
#undef DPPF
    return v;
}
__device__ __forceinline__ unsigned wave_sum_u(unsigned v) {
#define DPPU(x, ctrl, rm, bc) (unsigned)__builtin_amdgcn_update_dpp(0, (int)(x), ctrl, rm, 0xf, bc)
    v += DPPU(v, 0x111, 0xf, true); v += DPPU(v, 0x112, 0xf, true); v += DPPU(v, 0x114, 0xf, true); v += DPPU(v, 0x118, 0xf, true);
    v += DPPU(v, 0x142, 0xa, false); v += DPPU(v, 0x143, 0xc, false);
#undef DPPU
    return (unsigned)__builtin_amdgcn_readlane((int)v, 63);
}
struct Ctx { int tid, lane, wave, gw, ngw, nblk, blk; LAS unsigned char* lds; };

struct Args { const float* in[22]; float* out; unsigned char* ws; int ph_lo, ph_hi; };
enum { I_X = 0, I_C, I_ADAW, I_ADAB, I_N1G, I_WIN, I_BIN, I_CONVW, I_CONVB, I_LNG, I_LNB, I_WCO, I_POOLW, I_POOLS, I_WOUT, I_BOUT, I_N2G, I_WQ, I_KEYS, I_PU, I_PV, I_FG };

struct TrItem { const float* W; bf16* WT; int K, N, k0, n0, dstrow0; };
__device__ __forceinline__ void tr_load(const TrItem& t, int lane, f32x4 (&v)[8]) {
#pragma unroll
    for (int i = 0; i < 8; ++i) v[i] = *(const f32x4*)(t.W + (size_t)(t.k0 + 8 * i + (lane >> 3)) * t.N + t.n0 + 4 * (lane & 7));
}
__device__ __forceinline__ void tr_finish(const TrItem& t, int lane, const f32x4 (&v)[8], LAS float* scr) {
#pragma unroll
    for (int i = 0; i < 8; ++i) { LAS float* d = scr + (8 * i + (lane >> 3)) * 33 + 4 * (lane & 7); d[0] = v[i].x; d[1] = v[i].y; d[2] = v[i].z; d[3] = v[i].w; }
    asm volatile("s_waitcnt lgkmcnt(0)" ::: "memory");
    const int c = lane & 7;
#pragma unroll
    for (int j = 0; j < 4; ++j) { const int n = (lane >> 3) + 8 * j; const LAS float* s = scr + (8 * c) * 33 + n;
        u32x4 o; o.x = pk2(s[0 * 33], s[1 * 33]); o.y = pk2(s[2 * 33], s[3 * 33]); o.z = pk2(s[4 * 33], s[5 * 33]); o.w = pk2(s[6 * 33], s[7 * 33]);
        *(u32x4*)(t.WT + (size_t)(t.dstrow0 + n) * t.K + t.k0 + 8 * c) = o; }
    asm volatile("s_waitcnt lgkmcnt(0)" ::: "memory");
}
__device__ __forceinline__ int win_dstrow(int n0) {
    if (n0 < 1024) return 256 * (n0 >> 7) + (n0 & 127);
    if (n0 < 2048) { const int c = n0 - 1024; return 256 * (c >> 7) + 128 + (c & 127); }
    return n0;
}
__device__ __forceinline__ u32x2 quant16(const f32x4 (&v)[4], const float inv) {
    constexpr unsigned KB = 0x4B400000u; unsigned kc = 0u;
#pragma unroll
    for (int k = 0; k < 8; ++k) kc += KB << (4 * k);
    u32x2 w = (u32x2){0u, 0u};
#pragma unroll
    for (int q = 0; q < 4; ++q) {
#pragma unroll
        for (int h = 0; h < 2; ++h) { const f32x2 x2 = h ? (f32x2){v[q].z, v[q].w} : (f32x2){v[q].x, v[q].y};
            const f32x2 u2 = __builtin_elementwise_fma(x2, (f32x2){inv, inv}, (f32x2){-0.5f, -0.5f});
            const f32x2 t2 = (f32x2){__builtin_amdgcn_fmed3f(u2.x, -8.f, 7.f), __builtin_amdgcn_fmed3f(u2.y, -8.f, 7.f)} + (f32x2){12582920.f, 12582920.f};
#pragma unroll
            for (int k = 0; k < 2; ++k) { const int idx = 4 * q + 2 * h + k; const float tk = k ? t2.y : t2.x; w[idx >> 3] = (__builtin_bit_cast(unsigned, tk) << (4 * (idx & 7))) + w[idx >> 3]; } } }
    return (u32x2){(w.x - kc) ^ 0x88888888u, (w.y - kc) ^ 0x88888888u};
}
__device__ __forceinline__ void quant_load(const Ctx& C, const float* src, const int row0, f32x4 (&v)[4][4]) {
#pragma unroll
    for (int r = 0; r < 4; ++r)
#pragma unroll
        for (int q = 0; q < 4; ++q) v[r][q] = *(const f32x4*)(src + (size_t)(row0 + r) * D + 16 * C.lane + 4 * q);
}
__device__ __forceinline__ void quant_u_finish(const Ctx& C, const Args& a, const int row0, const f32x4 (&v)[4][4]) {
    unsigned char* ws = a.ws; float* scl = (float*)(ws + WS_USC);
#pragma unroll
    for (int r = 0; r < 4; ++r) { float ss = 0.f; f32x2 s2 = (f32x2){0.f, 0.f}; const int row = row0 + r;
#pragma unroll
        for (int q = 0; q < 4; ++q) { const f32x2 lo = (f32x2){v[r][q].x, v[r][q].y}, hi = (f32x2){v[r][q].z, v[r][q].w}; s2 = __builtin_elementwise_fma(lo, lo, s2); s2 = __builtin_elementwise_fma(hi, hi, s2); }
        ss = row16_sum(s2.x + s2.y);
        const float step = 0.3352f * __builtin_amdgcn_sqrtf(ss * (1.f / 256.f)), inv = step > 0.f ? __builtin_amdgcn_rcpf(step) : 0.f; const u32x2 w = quant16(v[r], inv);
        { const int lyr = row / NEXP, e = row % NEXP; *(u32x2*)(ws + WS_UB + (((size_t)lyr * 4 + (C.lane >> 4)) * NEXP + e) * 128 + 8 * (C.lane & 15)) = w; }
        if ((C.lane & 15) == 0) scl[(size_t)row * 4 + (C.lane >> 4)] = step; }
}
__device__ __forceinline__ void quant_v_finish(const Ctx& C, const Args& a, const int row0, const f32x4 (&v)[4][4]) {
    unsigned char* ws = a.ws; float* scl = (float*)(ws + WS_VSC);
#pragma unroll
    for (int r = 0; r < 4; ++r) { float ss = 0.f; f32x2 s2 = (f32x2){0.f, 0.f}; const int row = row0 + r;
#pragma unroll
        for (int q = 0; q < 4; ++q) { const f32x2 lo = (f32x2){v[r][q].x, v[r][q].y}, hi = (f32x2){v[r][q].z, v[r][q].w}; s2 = __builtin_elementwise_fma(lo, lo, s2); s2 = __builtin_elementwise_fma(hi, hi, s2); }
        ss = wave_sum(s2.x + s2.y);
        const float step = 0.3352f * __builtin_amdgcn_sqrtf(ss * (1.f / D)), inv = step > 0.f ? __builtin_amdgcn_rcpf(step) : 0.f; const u32x2 w = quant16(v[r], inv);
        { const int lyr = row / NEXP, e = row % NEXP; *(u32x2*)(ws + WS_VB + (((size_t)lyr * 4 + (C.lane >> 4)) * NEXP + e) * 128 + 8 * (C.lane & 15)) = w; }
        if (C.lane == 0) scl[row] = step; }
}
__device__ __forceinline__ void quant_u_rows(const Ctx& C, const Args& a, const int row0) { f32x4 v[4][4]; quant_load(C, a.in[I_PU], row0, v); quant_u_finish(C, a, row0, v); }
__device__ __forceinline__ void quant_v_rows(const Ctx& C, const Args& a, const int row0) { f32x4 v[4][4]; quant_load(C, a.in[I_PV], row0, v); quant_v_finish(C, a, row0, v); }
constexpr int TR_IN = 16 * 160, TR_CO = 16 * 32, TR_PO = 4 * (4 * 8), TR_OUT = 16 * 32, TR_L = TR_IN + TR_CO + TR_PO + TR_OUT;
__device__ __forceinline__ bool tr_late0(int r) { return (r >= TR_IN && r < TR_IN + TR_CO) || r >= TR_IN + TR_CO + TR_PO; }
__device__ __forceinline__ bool tr_deferred(int r) { return r < TR_IN + TR_CO || r >= TR_IN + TR_CO + TR_PO; }
__device__ __forceinline__ bool tr_item(const Args& a, int l, int r, TrItem& t) {
    unsigned char* ws = a.ws;
    if (r < TR_IN) { const int kb = r / 160, nb = r % 160; t = TrItem{a.in[I_WIN] + (size_t)l * D * DIN, (bf16*)(ws + WS_WIN) + (size_t)l * DIN * D, D, DIN, 64 * kb, 32 * nb, win_dstrow(32 * nb)}; return nb < 64 || nb >= 96; } r -= TR_IN;
    if (r < TR_CO) { const int kb = r / 32, nb = r % 32; t = TrItem{a.in[I_WCO] + (size_t)l * D * D, (bf16*)(ws + WS_WCO) + (size_t)l * D * D, D, D, 64 * kb, 32 * nb, 32 * nb}; return true; } r -= TR_CO;
    if (r < TR_PO) { const int g = r / 32, q = r % 32, kb = q / 8, nb = q % 8; t = TrItem{a.in[I_POOLW] + ((size_t)l * 4 + g) * 256 * 256, (bf16*)(ws + WS_POOL) + ((size_t)l * 1024 + 256 * g) * 256, 256, 256, 64 * kb, 32 * nb, 32 * nb}; return true; } r -= TR_PO;
    { const int kb = r / 32, nb = r % 32; t = TrItem{a.in[I_WOUT] + (size_t)l * D * D, (bf16*)(ws + WS_WOUT) + (size_t)l * D * D, D, D, 64 * kb, 32 * nb, 32 * nb}; return true; }
}
__device__ __forceinline__ void phase_prep(const Ctx& C, const Args& a) {
    unsigned char* ws = a.ws;
    LAS float* scr = (LAS float*)(C.lds + C.wave * 16384);
    for (int it = C.gw; it < TR_L + TR_PO; it += 2 * C.ngw) { TrItem ti, tj; f32x4 tv[8], tw[8];
        const int jt = it + C.ngw, jc = jt < TR_L + TR_PO ? jt : it;
        const bool oki = it < TR_L ? (tr_item(a, 0, it, ti) && !tr_late0(it)) : tr_item(a, 1, TR_IN + TR_CO + (it - TR_L), ti);
        const bool okj = (jc < TR_L ? (tr_item(a, 0, jc, tj) && !tr_late0(jc)) : tr_item(a, 1, TR_IN + TR_CO + (jc - TR_L), tj)) && jt < TR_L + TR_PO;
        tr_load(ti, C.lane, tv); tr_load(tj, C.lane, tw);
        if (oki) tr_finish(ti, C.lane, tv, scr);
        if (okj) tr_finish(tj, C.lane, tw, scr); }
    const int gt = C.blk * NTHREADS + C.tid, ngt = C.nblk * NTHREADS;
    for (int i0 = gt; i0 < DEPTH * D * 1024 / 8; i0 += 2 * ngt) { f32x4 v0[2], v1[2];
#pragma unroll
        for (int j = 0; j < 2; ++j) { const int i = min(i0 + j * ngt, DEPTH * D * 1024 / 8 - 1); const int l = i / (D * 128), rr = i % (D * 128), k = rr / 128, c8 = (rr % 128) * 8; const float* sp = a.in[I_WIN] + ((size_t)l * D + k) * DIN + 2048 + c8;
            v0[j] = *(const f32x4*)sp; v1[j] = *(const f32x4*)(sp + 4); }
#pragma unroll
        for (int j = 0; j < 2; ++j) { const int i = i0 + j * ngt; if (i < DEPTH * D * 1024 / 8) { const int l = i / (D * 128), rr = i % (D * 128), k = rr / 128, c8 = (rr % 128) * 8;
            *(u32x4*)((bf16*)(ws + WS_WPB) + ((size_t)l * D + k) * 1024 + c8) = pack8(v0[j], v1[j]); } } }
    for (int i0 = gt; i0 < DEPTH * D * DQ / 8; i0 += 4 * ngt) { f32x4 v0[4], v1[4];
#pragma unroll
        for (int j = 0; j < 4; ++j) { const size_t i = (size_t)min(i0 + j * ngt, DEPTH * D * DQ / 8 - 1); v0[j] = *(const f32x4*)(a.in[I_WQ] + i * 8); v1[j] = *(const f32x4*)(a.in[I_WQ] + i * 8 + 4); }
#pragma unroll
        for (int j = 0; j < 4; ++j) { const int i = i0 + j * ngt; if (i < DEPTH * D * DQ / 8) *(u32x4*)((bf16*)(ws + WS_WQB) + (size_t)i * 8) = pack8(v0[j], v1[j]); } }
    for (int i = gt; i < DEPTH * 2048 * 32; i += ngt) {
        const int l = i / (2048 * 32), r = i % (2048 * 32), n = r / 32, k8 = (r % 32) * 8;
        const int h = n >> 8, p = (n >> 7) & 1, key = n & 127, pk = k8 >> 7, kk = k8 & 127;
        u32x4 o = (u32x4){0u, 0u, 0u, 0u};
        if (pk == p) { const float* s = a.in[I_KEYS] + ((((size_t)l * 8 + h) * 2 + p) * 128 + key) * 128 + kk; const f32x4 v0 = *(const f32x4*)s, v1 = *(const f32x4*)(s + 4); o = pack8(v0, v1); }
        *(u32x4*)((bf16*)(ws + WS_KEYS) + ((size_t)l * 2048 + n) * 256 + k8) = o;
    }
    for (int it = gt; it < 32 * 3072; it += ngt) {
        const int ks = it / 3072, cg = it % 3072, l = cg / 1536, n4 = (cg % 1536) * 4;
        f32x4 a0 = (f32x4){0.f, 0.f, 0.f, 0.f}, a1 = a0;
        const float* wp = a.in[I_ADAW] + ((size_t)l * D + ks * 32) * NMODV + n4; const float* c0 = a.in[I_C] + ks * 32; const float* c1 = c0 + D;
#pragma unroll
        for (int kk = 0; kk < 32; ++kk) { const f32x4 w = *(const f32x4*)(wp + (size_t)kk * NMODV); const float x0 = c0[kk], x1 = c1[kk]; a0 += w * (x0 * sigm(x0)); a1 += w * (x1 * sigm(x1)); }
        float* mp = (float*)(ws + WS_MODP) + (((size_t)ks * 2 + l) * 2) * NMODV + n4;
        *(f32x4*)mp = a0; *(f32x4*)(mp + NMODV) = a1;
    }
}
__device__ __forceinline__ void phase_modreduce(const Ctx& C, const Args& a) {
    const int gt = C.blk * NTHREADS + C.tid, ngt = C.nblk * NTHREADS;
    for (int i = gt; i < 2 * 2 * NMODV; i += ngt) {
        const int l = i / (2 * NMODV), n = i % NMODV; float s = a.in[I_ADAB][(size_t)l * NMODV + n];
        const float* mp = (const float*)(a.ws + WS_MODP) + i;
        for (int ks = 0; ks < 32; ++ks) s += mp[(size_t)ks * 4 * NMODV];
        ((float*)(a.ws + WS_MOD))[i] = s;
    }
}
__device__ __forceinline__ const float* modp(const Args& a, int l, int b, int v) { return (const float*)(a.ws + WS_MOD) + ((size_t)l * 2 + b) * NMODV + v * D; }

__device__ __forceinline__ void normmod_row(const f32x4 (&x)[4], const float* g, const float* sh, const float* sc, int lane, f32x4 (&h)[4]) {
    float s = 0.f;
#pragma unroll
    for (int j = 0; j < 4; ++j) s += (x[j].x * x[j].x + x[j].y * x[j].y) + (x[j].z * x[j].z + x[j].w * x[j].w);
    const float rstd = 1.f / sqrtf(wave_sum(s) * (1.f / D) + EPS);
#pragma unroll
    for (int j = 0; j < 4; ++j) { const int c = 4 * lane + 256 * j; const f32x4 gv = *(const f32x4*)(g + c), shv = *(const f32x4*)(sh + c), scv = *(const f32x4*)(sc + c);
        h[j] = (x[j] * rstd) * gv * (scv + 1.f) + shv; }
}
__device__ __forceinline__ void store_row_bf16(bf16* row, const f32x4 (&h)[4], int lane) {
#pragma unroll
    for (int j = 0; j < 4; ++j) { u32x2 w; w.x = pk2(h[j].x, h[j].y); w.y = pk2(h[j].z, h[j].w); *(u32x2*)(row + 4 * lane + 256 * j) = w; }
}
template <bool F32SRC>
__device__ __forceinline__ void phase_norm(const Ctx& C, const Args& a, const float* X, const bf16* X16, const float* g, int l, int vsh, int vsc, float* hsc, int mbeg, int mstep, int mend) {
    bf16* H = (bf16*)(a.ws + WS_H);
    for (int m0 = mbeg; m0 < mend; m0 += mstep) {
        const int b = m0 >> 13; f32x4 xf[4][4]; u32x2 xw[4][4];
#pragma unroll
        for (int i = 0; i < 4; ++i) {
#pragma unroll
            for (int j = 0; j < 4; ++j) { if (F32SRC) xf[i][j] = *(const f32x4*)(X + (size_t)(m0 + i) * D + 4 * C.lane + 256 * j); else xw[i][j] = *(const u32x2*)(X16 + (size_t)(m0 + i) * D + 4 * C.lane + 256 * j); } }
        f32x4 ga[4], sb[4]; const float* sh = modp(a, l, b, vsh); const float* sc = modp(a, l, b, vsc);
#pragma unroll
        for (int j = 0; j < 4; ++j) { const int c = 4 * C.lane + 256 * j; ga[j] = *(const f32x4*)(g + c) * (*(const f32x4*)(sc + c) + 1.f); sb[j] = *(const f32x4*)(sh + c); }
        __builtin_amdgcn_sched_barrier(0);
#pragma unroll
        for (int i = 0; i < 4; ++i) { const int m = m0 + i; f32x4 x[4], h[4]; float s = 0.f;
#pragma unroll
            for (int j = 0; j < 4; ++j) { if (F32SRC) x[j] = xf[i][j]; else x[j] = (f32x4){bflo(xw[i][j].x), bfhi(xw[i][j].x), bflo(xw[i][j].y), bfhi(xw[i][j].y)};
                s += (x[j].x * x[j].x + x[j].y * x[j].y) + (x[j].z * x[j].z + x[j].w * x[j].w); }
            const float rstd = 1.f / sqrtf(wave_sum(s) * (1.f / D) + EPS);
#pragma unroll
            for (int j = 0; j < 4; ++j) h[j] = (x[j] * rstd) * ga[j] + sb[j];
            store_row_bf16(H + (size_t)m * D, h, C.lane);
            if (hsc) { float am = 0.f;
#pragma unroll
                for (int j = 0; j < 4; ++j) am = fmaxf(am, fmaxf(fmaxf(fabsf(h[j].x), fabsf(h[j].y)), fmaxf(fabsf(h[j].z), fabsf(h[j].w))));
                am = wave_max(am); const float qs = am > 0.f ? 119.f / am : 0.f; unsigned ps01 = 0u, ps23 = 0u;
                unsigned char* hq = a.ws + WS_HQ + (size_t)m * 1024 + (C.lane >> 3) * 32 + ((C.lane & 7) >> 1) * 4 + ((C.lane & 1) ? 16 : 0);
#pragma unroll
                for (int j = 0; j < 4; ++j) { unsigned lo16 = 0u, hi16 = 0u; int ps = 0;
#pragma unroll
                    for (int k = 0; k < 4; ++k) { const int q8 = (int)rintf(h[j][k] * qs); lo16 |= ((unsigned)q8 & 15u) << (4 * k); hi16 |= ((unsigned)((q8 + 8) >> 4) & 15u) << (4 * k); ps += q8; }
                    const unsigned mine = hi16 | (lo16 << 16), other = (unsigned)__builtin_amdgcn_update_dpp(0, (int)mine, 0xB1, 0xf, 0xf, true);
                    const unsigned w = (C.lane & 1) ? ((other >> 16) | (mine & 0xffff0000u)) : ((mine & 0xffffu) | (other << 16));
                    *(unsigned*)(hq + j * 256) = w;
                    if (j < 2) ps01 += (unsigned)(ps + 512) << (16 * j); else ps23 += (unsigned)(ps + 512) << (16 * (j - 2)); }
                ps01 = wave_sum_u(ps01); ps23 = wave_sum_u(ps23);
                if (C.lane == 0) { hsc[m] = am * (1.f / 119.f);
                    *(f32x4*)((float*)(a.ws + WS_HSUM) + (size_t)m * 4) = (f32x4){(float)((int)(ps01 & 0xffffu) - 32768), (float)((int)(ps01 >> 16) - 32768), (float)((int)(ps23 & 0xffffu) - 32768), (float)((int)(ps23 >> 16) - 32768)}; } }
        }
    }
}

__device__ __forceinline__ u32x2 pack8_f8(const f32x4& a, const f32x4& b) { int w0 = __builtin_amdgcn_cvt_pk_fp8_f32(a.x, a.y, 0, false); w0 = __builtin_amdgcn_cvt_pk_fp8_f32(a.z, a.w, w0, true);
    int w1 = __builtin_amdgcn_cvt_pk_fp8_f32(b.x, b.y, 0, false); w1 = __builtin_amdgcn_cvt_pk_fp8_f32(b.z, b.w, w1, true); return (u32x2){(unsigned)w0, (unsigned)w1}; }
__device__ __forceinline__ void unpack8_f8(const u32x2& w, f32x4& a, f32x4& b) { const f32x2 a01 = __builtin_amdgcn_cvt_pk_f32_fp8((int)w.x, false), a23 = __builtin_amdgcn_cvt_pk_f32_fp8((int)w.x, true), b01 = __builtin_amdgcn_cvt_pk_f32_fp8((int)w.y, false), b23 = __builtin_amdgcn_cvt_pk_f32_fp8((int)w.y, true);
    a = (f32x4){a01.x, a01.y, a23.x, a23.y}; b = (f32x4){b01.x, b01.y, b23.x, b23.y}; }
struct EpiIn {
    const float* bin; const float* bp; unsigned char *UG, *ZP, *G;
    struct K { f32x4 a0, a1, b0, b1; };
    __device__ __forceinline__ K pre(int row0, int pn, int cl8) const {
        const float* p; int o;
        if (pn < 8) { p = bin + 128 * pn + cl8; o = 1024; } else if (pn < 12) { p = bp + 256 * (pn - 8) + cl8; o = 128; } else { p = bin + 3072 + 256 * (pn - 12) + cl8; o = 128; }
        K k; k.a0 = *(const f32x4*)p; k.a1 = *(const f32x4*)(p + 4); k.b0 = *(const f32x4*)(p + o); k.b1 = *(const f32x4*)(p + o + 4); return k;
    }
    __device__ __forceinline__ void apply(int row, int pn, int cl8, const K& k, f32x4 a0, f32x4 a1, f32x4 b0, f32x4 b1) const {
        a0 += k.a0; a1 += k.a1; b0 += k.b0; b1 += k.b1;
        if (pn < 8) {
            const int c = 128 * pn + cl8;
            f32x4 u0, u1;
#pragma unroll
            for (int i = 0; i < 4; ++i) { u0[i] = a0[i] * sigm(b0[i]); u1[i] = a1[i] * sigm(b1[i]); }
            *(u32x2*)(UG + (size_t)row * D + c) = pack8_f8(u0, u1);
        } else if (pn < 12) {
            const int c = 256 * (pn - 8) + cl8;
            *(u32x2*)(ZP + (size_t)row * D + c) = pack8_f8(a0, a1); *(u32x2*)(ZP + (size_t)row * D + c + 128) = pack8_f8(b0, b1);
        } else {
            const int c = 256 * (pn - 12) + cl8;
#pragma unroll
            for (int i = 0; i < 4; ++i) { a0[i] = sigm(a0[i]); a1[i] = sigm(a1[i]); b0[i] = sigm(b0[i]); b1[i] = sigm(b1[i]); }
            *(u32x2*)(G + (size_t)row * 2048 + c) = pack8_f8(a0, a1); *(u32x2*)(G + (size_t)row * 2048 + c + 128) = pack8_f8(b0, b1);
        }
    }
};
struct EpiConv {
    const unsigned char* G; const unsigned char* PLp; const float* scale; bf16* Y;
    struct K { f32x4 s0, s1, s2, s3; };
    __device__ __forceinline__ K pre(int row0, int pn, int cl8) const { const float* p = scale + 256 * pn + cl8; K k; k.s0 = *(const f32x4*)p; k.s1 = *(const f32x4*)(p + 4); k.s2 = *(const f32x4*)(p + 128); k.s3 = *(const f32x4*)(p + 132); return k; }
    __device__ __forceinline__ void apply(int row, int pn, int cl8, const K& k, f32x4 a0, f32x4 a1, f32x4 b0, f32x4 b1) const {
        const int c = 256 * pn + cl8; f32x4 g0, g1, h0, h1, t0, t1;
        unpack8_f8(*(const u32x2*)(G + (size_t)row * 2048 + c), g0, g1); unpack8_f8(*(const u32x2*)(G + (size_t)row * 2048 + 1024 + c), h0, h1); unpack8_f8(*(const u32x2*)(PLp + (size_t)row * D + c), t0, t1);
        *(u32x4*)(Y + (size_t)row * D + c) = pack8(a0 * g0 + h0 * k.s0 * t0, a1 * g1 + h1 * k.s1 * t1);
        unpack8_f8(*(const u32x2*)(G + (size_t)row * 2048 + c + 128), g0, g1); unpack8_f8(*(const u32x2*)(G + (size_t)row * 2048 + 1024 + c + 128), h0, h1); unpack8_f8(*(const u32x2*)(PLp + (size_t)row * D + c + 128), t0, t1);
        *(u32x4*)(Y + (size_t)row * D + c + 128) = pack8(b0 * g0 + h0 * k.s2 * t0, b1 * g1 + h1 * k.s3 * t1);
    }
};
struct EpiOut {
    const float* xold32; const bf16* xold16; bf16* xnew; const float* g1;   const float* bout;
    struct K { f32x4 g[4], gb[4]; };
    __device__ __forceinline__ K pre(int row0, int pn, int cl8) const { const int c = 256 * pn + cl8; const float* g = g1 + (size_t)(row0 >> 13) * NMODV + c; const float* b = bout + c; K k;
        k.g[0] = *(const f32x4*)g; k.g[1] = *(const f32x4*)(g + 4); k.g[2] = *(const f32x4*)(g + 128); k.g[3] = *(const f32x4*)(g + 132);
        k.gb[0] = k.g[0] * *(const f32x4*)b; k.gb[1] = k.g[1] * *(const f32x4*)(b + 4); k.gb[2] = k.g[2] * *(const f32x4*)(b + 128); k.gb[3] = k.g[3] * *(const f32x4*)(b + 132); return k; }
    __device__ __forceinline__ void apply(int row, int pn, int cl8, const K& k, f32x4 a0, f32x4 a1, f32x4 b0, f32x4 b1) const {
        const int c = 256 * pn + cl8; const size_t o = (size_t)row * D + c;
        f32x4 x0, x1, y0, y1;
        if (xold32) { x0 = *(const f32x4*)(xold32 + o); x1 = *(const f32x4*)(xold32 + o + 4); y0 = *(const f32x4*)(xold32 + o + 128); y1 = *(const f32x4*)(xold32 + o + 132); }
        else { unpack8(*(const u32x4*)(xold16 + o), x0, x1); unpack8(*(const u32x4*)(xold16 + o + 128), y0, y1); }
        x0 += k.g[0] * a0 + k.gb[0]; x1 += k.g[1] * a1 + k.gb[1]; y0 += k.g[2] * b0 + k.gb[2]; y1 += k.g[3] * b1 + k.gb[3];
        *(u32x4*)(xnew + o) = pack8(x0, x1); *(u32x4*)(xnew + o + 128) = pack8(y0, y1);
    }
};
struct EpiQ {
    bf16* Q;
    struct K {}; __device__ __forceinline__ K pre(int, int, int) const { return K{}; }
    __device__ __forceinline__ void apply(int row, int pn, int cl8, const K&, f32x4 a0, f32x4 a1, f32x4 b0, f32x4 b1) const {
        const size_t o = (size_t)row * DQ + 256 * pn + cl8; *(u32x4*)(Q + o) = pack8(a0, a1); *(u32x4*)(Q + o + 128) = pack8(b0, b1);
    }
};
struct EpiWT {
    bf16* W;
    struct K {}; __device__ __forceinline__ K pre(int, int, int) const { return K{}; }
    __device__ __forceinline__ void apply(int row, int pn, int cl8, const K&, f32x4 a0, f32x4 a1, f32x4 b0, f32x4 b1) const {
        const size_t o = (size_t)row * D + 256 * pn + cl8; *(u32x4*)(W + o) = pack8(a0, a1); *(u32x4*)(W + o + 128) = pack8(b0, b1);
    }
};
typedef _Float16 f16x2 __attribute__((ext_vector_type(2)));
__device__ __forceinline__ unsigned pkh(float lo, float hi) { return __builtin_bit_cast(unsigned, __builtin_amdgcn_cvt_pkrtz(lo, hi)); }
struct EpiS {
    unsigned short* S;
    struct K {}; __device__ __forceinline__ K pre(int, int, int) const { return K{}; }
    __device__ __forceinline__ void apply(int row, int pn, int cl8, const K&, f32x4 a0, f32x4 a1, f32x4 b0, f32x4 b1) const {
        const size_t o = (size_t)row * DQ + 256 * pn + cl8;
        *(u32x4*)(S + o) = (u32x4){pkh(a0.x, a0.y), pkh(a0.z, a0.w), pkh(a1.x, a1.y), pkh(a1.z, a1.w)}; *(u32x4*)(S + o + 128) = (u32x4){pkh(b0.x, b0.y), pkh(b0.z, b0.w), pkh(b1.x, b1.y), pkh(b1.z, b1.w)};
    }
};

namespace pg8 {
#define PG8_LAS __attribute__((address_space(3)))
typedef unsigned short bf16_t;
typedef short bf16x8 __attribute__((ext_vector_type(8)));
typedef float f32x4 __attribute__((ext_vector_type(4)));
typedef unsigned u32x4 __attribute__((ext_vector_type(4)));
constexpr int BM = 256, BK = 64, HALF = 128, HTB = HALF * BK * 2  , STAGE_BYTES = 8 * HTB, NXCD = 8, WGM = 8;

__host__ __device__ __forceinline__ int lds_byte(int r, int c) { const int st = (r >> 4) * 2 + (c >> 5), rr = r & 15, cc = c & 31, ob = rr * 64 + cc * 2; return st * 1024 + (ob ^ (((ob >> 9) & 1) << 5)); }
__host__ __device__ __forceinline__ void stage_rc(int b, int& R, int& C) { const int st = b / 1024, sb = b % 1024, swz = sb ^ (((sb >> 9) & 1) << 5); R = (st >> 1) * 16 + swz / 64; C = (st & 1) * 32 + (swz % 64) / 2; }
__host__ __device__ __forceinline__ int perm32(int rho) { const int n = rho >> 4, i = rho & 15; return 8 * (i >> 2) + 4 * n + (i & 3); }

struct Unit { int pm, pn; };
struct Gemm { const bf16_t* A; const bf16_t* Bt; int M, N, K, lda, ldb, acol, bcol; };

struct StaticOrder {
    int nM, nN, nwg, G, c;
    __host__ __device__ void init(int M, int N, int G_, int c_) { nM = M / BM; nN = N / BM; nwg = nM * nN; G = G_; c = c_; }
    __host__ __device__ bool next(int i, Unit& u) const {
        const long L = (long)i * G + c; if (L >= nwg) return false;
        int wgid = (int)L; { const int q = nwg / NXCD, r = nwg % NXCD, xcd = wgid % NXCD, off = wgid / NXCD; wgid = (xcd < r ? xcd * (q + 1) : r * (q + 1) + (xcd - r) * q) + off; }
        const int nig = WGM * nN, gid = wgid / nig, fm = gid * WGM, gsz = (nM - fm) < WGM ? (nM - fm) : WGM;
        u.pm = fm + ((wgid % nig) % gsz); u.pn = (wgid % nig) / gsz; return true;
    }
    __device__ __forceinline__ void a_ready(const Unit&) const {}
    __device__ __forceinline__ void done(const Unit&) const {}
};


template <class Epi, class Sched, bool ALIGN_EPI = false, bool SP2 = false>
__device__ __forceinline__ void gemm_phase(PG8_LAS unsigned char* lds, const Gemm g, const Sched& S, const Epi& E, const int tid) {
    const int wid = __builtin_amdgcn_readfirstlane(tid >> 6), lane = tid & 63, wr = wid >> 2, wc = wid & 3, fr = lane & 15, fq = lane >> 4;
    const int K = g.K, nt = K / BK;
    unsigned voffA[2], voffB[2];
#pragma unroll
    for (int i = 0; i < 2; ++i) { int R, C; stage_rc(tid * 16 + i * 8192, R, C); const int Rb = Epi::PERM ? ((R & ~31) + perm32(R & 31)) : R;
        voffA[i] = (unsigned)(R * g.lda + C) * 2u; voffB[i] = (unsigned)(Rb * g.ldb + C) * 2u; }
    const size_t kstep = (size_t)(BK * 2);
    const size_t hstepA = (size_t)HALF * g.lda * 2, hstepB = (size_t)HALF * g.ldb * 2;
    const size_t tstepA = 2 * hstepA, tstepB = 2 * hstepB, acolb = (size_t)g.acol * 2, bcolb = (size_t)g.bcol * 2;
    const unsigned ldsw = (unsigned)wid * 1024u;
    const int aoff = lds_byte(wr * 64 + fr, fq * 8), boff = lds_byte(wc * 32 + fr, fq * 8);
#define PG8_SA(b, h) (((b) * 2 + (h)) * HTB)
#define PG8_SB(b, h) ((4 + (b) * 2 + (h)) * HTB)
#define PG8_STAGE(bufoff, gbase, voff) do { _Pragma("unroll") for (int _i = 0; _i < 2; ++_i) \
        __builtin_amdgcn_global_load_lds((const unsigned*)((const char*)(gbase) + (voff)[_i]), (PG8_LAS unsigned*)(lds + (bufoff) + ldsw + _i * 8192), 16, 0, 0); } while (0)
#define PG8_LDA(dst, b, h) do { _Pragma("unroll") for (int m = 0; m < 4; ++m) _Pragma("unroll") for (int k = 0; k < 2; ++k) dst[m][k] = *(const PG8_LAS bf16x8*)(lds + PG8_SA(b, h) + aoff + m * 2048 + k * 1024); } while (0)
#define PG8_LDB(dst, b, h) do { _Pragma("unroll") for (int n = 0; n < 2; ++n) _Pragma("unroll") for (int k = 0; k < 2; ++k) dst[n][k] = *(const PG8_LAS bf16x8*)(lds + PG8_SB(b, h) + boff + n * 2048 + k * 1024); } while (0)
#define PG8_MMA(ai, bj, At, Bt) do { __builtin_amdgcn_s_setprio(1); _Pragma("unroll") for (int m = 0; m < 4; ++m) _Pragma("unroll") for (int n = 0; n < 2; ++n) _Pragma("unroll") for (int k = 0; k < 2; ++k) \
        acc[ai][bj][m][n] = __builtin_amdgcn_mfma_f32_16x16x32_bf16(Bt[n][k], At[m][k], acc[ai][bj][m][n], 0, 0, 0); __builtin_amdgcn_s_setprio(0); } while (0)
#define PG8_WAIT_V(n) asm volatile("s_waitcnt vmcnt(" #n ")" ::: "memory")
#define PG8_WAIT_L(n) asm volatile("s_waitcnt lgkmcnt(" #n ")" ::: "memory")
#define PG8_BAR __builtin_amdgcn_s_barrier()
#define PG8_SCHED __builtin_amdgcn_sched_barrier(0)
    Unit cur, nxt; int ui = 0;
    if (!S.next(0, cur)) return;
    f32x4 acc[2][2][4][2];
#pragma unroll
    for (int a = 0; a < 2; ++a)
#pragma unroll
        for (int b = 0; b < 2; ++b)
#pragma unroll
            for (int m = 0; m < 4; ++m)
#pragma unroll
                for (int n = 0; n < 2; ++n) acc[a][b][m][n] = (f32x4){0.f, 0.f, 0.f, 0.f};
    bf16x8 At[4][2], B0[2][2], B1[2][2];
    const char* cA = (const char*)g.A + (size_t)cur.pm * tstepA + (size_t)cur.pn * acolb; const char* cB = (const char*)g.Bt + (size_t)cur.pn * tstepB + (size_t)cur.pm * bcolb;
    S.a_ready(cur);
    if constexpr (SP2) {
        PG8_STAGE(PG8_SB(0, 0), cB, voffB); PG8_STAGE(PG8_SB(0, 1), cB + hstepB, voffB); PG8_STAGE(PG8_SA(0, 0), cA, voffA); PG8_STAGE(PG8_SA(0, 1), cA + hstepA, voffA);
        if (wr == 1) PG8_BAR;
        PG8_WAIT_V(2); PG8_BAR;
        PG8_STAGE(PG8_SB(1, 0), cB + kstep, voffB); PG8_STAGE(PG8_SA(1, 0), cA + kstep, voffA); PG8_STAGE(PG8_SB(1, 1), cB + hstepB + kstep, voffB);
        PG8_WAIT_V(6); PG8_BAR;
    } else {
        PG8_STAGE(PG8_SB(0, 0), cB, voffB); PG8_STAGE(PG8_SA(0, 0), cA, voffA); PG8_STAGE(PG8_SB(0, 1), cB + hstepB, voffB); PG8_STAGE(PG8_SA(0, 1), cA + hstepA, voffA);
        if (wr == 1) PG8_BAR;
        PG8_WAIT_V(4); PG8_BAR;
        PG8_STAGE(PG8_SB(1, 0), cB + kstep, voffB); PG8_STAGE(PG8_SA(1, 0), cA + kstep, voffA); PG8_STAGE(PG8_SB(1, 1), cB + hstepB + kstep, voffB);
        PG8_WAIT_V(6); PG8_BAR;
    }
    for (;;) {
        const bool has_next = S.next(ui + 1, nxt);
        const char* nA = has_next ? (const char*)g.A + (size_t)nxt.pm * tstepA + (size_t)nxt.pn * acolb : cA; const char* nB = has_next ? (const char*)g.Bt + (size_t)nxt.pn * tstepB + (size_t)nxt.pm * bcolb : cB;
#pragma nounroll
        for (int t = 0; t < nt; t += 2) {
            const bool last = (t == nt - 2);
            const char* a1 = cA + (size_t)(t + 1) * kstep;
            const char* a2 = last ? nA : cA + (size_t)(t + 2) * kstep; const char* b2 = last ? nB : cB + (size_t)(t + 2) * kstep;
            const char* a3 = a2 + kstep; const char* b3 = b2 + kstep;
            if (last && has_next) S.a_ready(nxt);
            if constexpr (SP2) {
            PG8_LDB(B0, 0, 0); PG8_LDB(B1, 0, 1); PG8_SCHED; PG8_LDA(At, 0, 0); PG8_STAGE(PG8_SA(1, 1), a1 + hstepA, voffA);
            PG8_WAIT_V(8); PG8_WAIT_L(0); PG8_BAR; PG8_MMA(0, 0, At, B0); PG8_MMA(0, 1, At, B1); PG8_BAR; PG8_SCHED;
            PG8_LDA(At, 0, 1); PG8_STAGE(PG8_SB(0, 0), b2, voffB); PG8_STAGE(PG8_SB(0, 1), b2 + hstepB, voffB); PG8_STAGE(PG8_SA(0, 0), a2, voffA);
            PG8_WAIT_V(8); PG8_WAIT_L(0); PG8_BAR; PG8_MMA(1, 0, At, B0); PG8_MMA(1, 1, At, B1); PG8_BAR; PG8_SCHED;
            PG8_LDB(B0, 1, 0); PG8_LDB(B1, 1, 1); PG8_SCHED; PG8_LDA(At, 1, 0); PG8_STAGE(PG8_SA(0, 1), a2 + hstepA, voffA);
            PG8_WAIT_V(8); PG8_WAIT_L(0); PG8_BAR; PG8_MMA(0, 0, At, B0); PG8_MMA(0, 1, At, B1); PG8_BAR; PG8_SCHED;
            PG8_LDA(At, 1, 1); PG8_STAGE(PG8_SB(1, 0), b3, voffB); PG8_STAGE(PG8_SB(1, 1), b3 + hstepB, voffB); PG8_STAGE(PG8_SA(1, 0), a3, voffA);
            PG8_WAIT_V(8); PG8_WAIT_L(0); PG8_BAR; PG8_MMA(1, 0, At, B0); PG8_MMA(1, 1, At, B1); PG8_BAR; PG8_SCHED;
            } else {
            PG8_LDB(B0, 0, 0); PG8_SCHED; PG8_LDA(At, 0, 0); PG8_STAGE(PG8_SA(1, 1), a1 + hstepA, voffA);
            PG8_WAIT_L(8); PG8_BAR; PG8_WAIT_L(0); PG8_MMA(0, 0, At, B0); PG8_BAR; PG8_SCHED;
            PG8_LDB(B1, 0, 1); PG8_STAGE(PG8_SB(0, 0), b2, voffB);
            PG8_BAR; PG8_WAIT_L(0); PG8_MMA(0, 1, At, B1); PG8_BAR;
            PG8_LDA(At, 0, 1); PG8_STAGE(PG8_SA(0, 0), a2, voffA);
            PG8_BAR; PG8_WAIT_L(0); PG8_MMA(1, 0, At, B0); PG8_BAR; PG8_SCHED;
            PG8_STAGE(PG8_SB(0, 1), b2 + hstepB, voffB);
            PG8_WAIT_V(6); PG8_BAR; PG8_MMA(1, 1, At, B1); PG8_BAR;
            PG8_LDB(B0, 1, 0); PG8_SCHED; PG8_LDA(At, 1, 0); PG8_STAGE(PG8_SA(0, 1), a2 + hstepA, voffA);
            PG8_WAIT_L(8); PG8_BAR; PG8_WAIT_L(0); PG8_MMA(0, 0, At, B0); PG8_BAR; PG8_SCHED;
            PG8_LDB(B1, 1, 1); PG8_STAGE(PG8_SB(1, 0), b3, voffB);
            PG8_BAR; PG8_WAIT_L(0); PG8_MMA(0, 1, At, B1); PG8_BAR;
            PG8_LDA(At, 1, 1); PG8_STAGE(PG8_SA(1, 0), a3, voffA);
            PG8_BAR; PG8_WAIT_L(0); PG8_MMA(1, 0, At, B0); PG8_BAR; PG8_SCHED;
            PG8_STAGE(PG8_SB(1, 1), b3 + hstepB, voffB);
            PG8_WAIT_V(6); PG8_BAR; PG8_MMA(1, 1, At, B1); PG8_BAR;
            }
        }
        if constexpr (ALIGN_EPI) { if (wr == 0) PG8_BAR; }
        if constexpr (!Epi::AFTER_DRAIN) { E(acc, cur, wr, wc, fr, fq); S.done(cur); }
        if (!has_next) break;
#pragma unroll
        for (int a = 0; a < 2; ++a)
#pragma unroll
            for (int b = 0; b < 2; ++b)
#pragma unroll
                for (int m = 0; m < 4; ++m)
#pragma unroll
                    for (int n = 0; n < 2; ++n) acc[a][b][m][n] = (f32x4){0.f, 0.f, 0.f, 0.f};
        cur = nxt; cA = nA; cB = nB; ++ui;
        if constexpr (ALIGN_EPI) { if (wr == 1) PG8_BAR; }
    }
    PG8_WAIT_V(0);
    if constexpr (!ALIGN_EPI) { if (wr == 0) PG8_BAR; }
    PG8_BAR;
    if constexpr (Epi::AFTER_DRAIN) { E.fused(acc, cur, wr, wc, fr, fq, lds, wid, lane); S.done(cur); }
#undef PG8_SA
#undef PG8_SB
#undef PG8_STAGE
#undef PG8_LDA
#undef PG8_LDB
#undef PG8_MMA
#undef PG8_WAIT_V
#undef PG8_WAIT_L
#undef PG8_BAR
#undef PG8_SCHED
}

template <class F> struct EpiW {
    static constexpr bool PERM = true, AFTER_DRAIN = false; F f;
    __device__ __forceinline__ void operator()(const f32x4 (&acc)[2][2][4][2], const Unit& u, int wr, int wc, int fr, int fq) const {
        const typename F::K kc = f.pre(u.pm * BM, u.pn, wc * 32 + 8 * fq);
#pragma unroll
        for (int ai = 0; ai < 2; ++ai)
#pragma unroll
            for (int m = 0; m < 4; ++m) { f.apply(u.pm * BM + ai * HALF + wr * 64 + m * 16 + fr, u.pn, wc * 32 + 8 * fq, kc, acc[ai][0][m][0], acc[ai][0][m][1], acc[ai][1][m][0], acc[ai][1][m][1]);
                asm volatile("" ::: "memory"); }
    }
};
struct EpiSLds {
    static constexpr bool PERM = true, AFTER_DRAIN = true;
    __device__ __forceinline__ void operator()(const f32x4 (&)[2][2][4][2], const Unit&, int, int, int, int) const {}
    __device__ __forceinline__ void fused(const f32x4 (&acc)[2][2][4][2], const Unit& u, int wr, int wc, int fr, int fq, PG8_LAS unsigned char* lds, int, int) const {
        const int cha = wc * 4 + fq, chb = 16 + cha;
#pragma unroll
        for (int ai = 0; ai < 2; ++ai)
#pragma unroll
            for (int m = 0; m < 4; ++m) { const int rl = ai * HALF + wr * 64 + m * 16 + fr; PG8_LAS unsigned char* trow = lds + rl * 512; const int sw = rl & 31;
                const f32x4 a0 = acc[ai][0][m][0], a1 = acc[ai][0][m][1], b0 = acc[ai][1][m][0], b1 = acc[ai][1][m][1];
                *(PG8_LAS u32x4*)(trow + ((cha ^ sw) << 4)) = (u32x4){pkh(a0.x, a0.y), pkh(a0.z, a0.w), pkh(a1.x, a1.y), pkh(a1.z, a1.w)};
                *(PG8_LAS u32x4*)(trow + ((chb ^ sw) << 4)) = (u32x4){pkh(b0.x, b0.y), pkh(b0.z, b0.w), pkh(b1.x, b1.y), pkh(b1.z, b1.w)}; }
    }
};
struct OneUnit {
    StaticOrder S; int k;
    __device__ __forceinline__ bool next(int i, Unit& u) const { return i == 0 && S.next(k, u); }
    __device__ __forceinline__ void a_ready(const Unit&) const {}
    __device__ __forceinline__ void done(const Unit&) const {}
};
}

template <class F>
__device__ __forceinline__ void mfma_gemm(const Ctx& C, const bf16* A, int lda, int acol, const bf16* Bt, int ldb, int Mr, int N, int K, const F& f, int bcol = 0, int blk_off = 0) {
    pg8::Gemm g{A, Bt, Mr, N, K, lda, ldb, acol, bcol}; pg8::StaticOrder S; S.init(Mr, N, C.nblk, (C.blk + C.nblk - blk_off) % C.nblk); pg8::EpiW<F> E{f};
    pg8::gemm_phase<pg8::EpiW<F>, pg8::StaticOrder, true, true>(C.lds, g, S, E, C.tid);
}

template <int NROWS, int RP = 128> struct CpStage { static constexpr int NIT = (NROWS * RP + NTHREADS - 1) / NTHREADS; u32x4 v[NIT]; };
template <int NROWS, int RP = 128>
__device__ __forceinline__ void cp_stage_load(CpStage<NROWS, RP>& st, const void* src, int mrow0, int tfirst, int tid) {
    asm volatile("" : "+v"(tid));
#pragma unroll
    for (int i = 0; i < CpStage<NROWS, RP>::NIT; ++i) { const int ch = i * NTHREADS + tid, r = ch / RP, c = ch % RP; st.v[i] = (u32x4){0u, 0u, 0u, 0u};
        if (ch < NROWS * RP && tfirst + r >= 0) st.v[i] = *(const u32x4*)((const unsigned char*)src + ((size_t)(mrow0 + r) * RP + c) * 16); }
}
template <int NROWS, int RP = 128>
__device__ __forceinline__ void cp_stage_store(const CpStage<NROWS, RP>& st, LAS unsigned char* tile, int tid) {
    asm volatile("" : "+v"(tid));
#pragma unroll
    for (int i = 0; i < CpStage<NROWS, RP>::NIT; ++i) { const int ch = i * NTHREADS + tid; if (ch < NROWS * RP) *(LAS u32x4*)(tile + ch * 16) = st.v[i]; }
}
template <int W>
__device__ __forceinline__ void pool_item(const LAS unsigned char* tile, unsigned char* PL, int m0, int t0, int tid) {
    asm volatile("" : "+v"(tid));
    float s0 = 0.f, s1 = 0.f;
#pragma unroll
    for (int j = 1; j < W; ++j) { const unsigned w = *(const LAS unsigned short*)(tile + (15 - j) * 1024 + 2 * tid); const f32x2 v = __builtin_amdgcn_cvt_pk_f32_fp8((int)w, false); s0 += v.x; s1 += v.y; }
#pragma unroll
    for (int ti = 0; ti < 32; ++ti) {
        const unsigned wc = *(const LAS unsigned short*)(tile + (ti + 15) * 1024 + 2 * tid); const f32x2 cv = __builtin_amdgcn_cvt_pk_f32_fp8((int)wc, false); const float c0 = cv.x, c1 = cv.y;
        s0 += c0; s1 += c1;
        const float inv = (t0 == 0 && ti + 1 < W) ? (1.f / (float)(ti + 1)) : (1.f / (float)W);
        *(unsigned short*)(PL + (size_t)(m0 + ti) * D + 2 * tid) = (unsigned short)__builtin_amdgcn_cvt_pk_fp8_f32(s0 * inv - c0, s1 * inv - c1, 0, false);
        { const unsigned wo = *(const LAS unsigned short*)(tile + (ti + 16 - W) * 1024 + 2 * tid); const f32x2 ov = __builtin_amdgcn_cvt_pk_f32_fp8((int)wo, false); s0 -= ov.x; s1 -= ov.y; }
    }
}
template <int RI>
__device__ __forceinline__ void conv_row(const LAS unsigned char* tile, int tid, const float (&w0)[31], const float (&w1)[31], float (&a0)[32], float (&a1)[32]) {
    const unsigned w = *(const LAS unsigned short*)(tile + RI * 1024 + 2 * tid);
    const f32x2 uu = __builtin_amdgcn_cvt_pk_f32_fp8((int)w, false); const float u0 = uu.x, u1 = uu.y;
#pragma unroll
    for (int ti = 0; ti < 32; ++ti) { constexpr int dbase = 30 - RI; const int d = ti + dbase; if (d >= 0 && d <= 30) { a0[ti] += w0[30 - d] * u0; a1[ti] += w1[30 - d] * u1; } }
    if constexpr ((RI & 7) == 7) asm volatile("" ::: "memory");
}
template <int... RI>
__device__ __forceinline__ void conv_rows(const LAS unsigned char* tile, int tid, const float (&w0)[31], const float (&w1)[31], float (&a0)[32], float (&a1)[32], std::integer_sequence<int, RI...>) {
    (conv_row<RI>(tile, tid, w0, w1, a0, a1), ...);
}
__device__ __forceinline__ void phase_convpool(const Ctx& C, const Args& a, int l, int item0, int istep, int iend) {
    const unsigned char* UG = a.ws + WS_UG; const unsigned char* ZP = a.ws + WS_ZP;
    bf16* AC = (bf16*)(a.ws + WS_AC); unsigned char* PL = a.ws + WS_PL;
    const float* cw = a.in[I_CONVW] + (size_t)l * CONVK * D; const float* cb = a.in[I_CONVB] + (size_t)l * D;
    const float* lng = a.in[I_LNG] + (size_t)l * D; const float* lnb = a.in[I_LNB] + (size_t)l * D;
    LAS float* red = (LAS float*)C.lds;
    LAS float* stat = (LAS float*)(C.lds + 2048);
    LAS unsigned char* convT = C.lds + 4096;
    LAS unsigned char* poolT = C.lds + 4096 + 62 * 1024;
    int tid = C.tid;
    asm volatile("" : "+v"(tid));
    const int c0 = 2 * tid;
    float w0[31], w1[31];
#pragma unroll
    for (int k = 0; k < 31; ++k) { const f32x2 w = *(const f32x2*)(cw + (size_t)k * D + c0); w0[k] = w.x; w1[k] = w.y; }
    const f32x2 bb = *(const f32x2*)(cb + c0), gg = *(const f32x2*)(lng + c0), be = *(const f32x2*)(lnb + c0);
    if (item0 < iend) { const int m0 = item0 * 32, t0 = m0 & (SEQ - 1);
        __syncthreads();
        { CpStage<62, 64> su; cp_stage_load<62, 64>(su, UG, m0 - 30, t0 - 30, tid); cp_stage_store<62, 64>(su, convT, tid); } }
    for (int item = item0; item < iend; item += istep) {
        const int m0 = item * 32, t0 = m0 & (SEQ - 1);
        CpStage<47, 64> sp; cp_stage_load<47, 64>(sp, ZP, m0 - 15, t0 - 15, tid);
        __syncthreads();
        float a0[32], a1[32];
#pragma unroll
        for (int i = 0; i < 32; ++i) { a0[i] = bb.x; a1[i] = bb.y; }
        conv_rows(convT, tid, w0, w1, a0, a1, std::make_integer_sequence<int, 62>{});
        cp_stage_store<47, 64>(sp, poolT, tid);
        int m1 = (item + istep < iend ? item + istep : item) * 32; asm volatile("" : "+v"(m1));
        CpStage<62, 64> su; cp_stage_load<62, 64>(su, UG, m1 - 30, (m1 & (SEQ - 1)) - 30, tid);
#pragma unroll
        for (int ti = 0; ti < 32; ++ti) {
            const float s = dpp_sum63(a0[ti] + a1[ti]), q = dpp_sum63(a0[ti] * a0[ti] + a1[ti] * a1[ti]);
            if (C.lane == 63) { red[C.wave * 64 + ti] = s; red[C.wave * 64 + 32 + ti] = q; }
        }
        __syncthreads();
        cp_stage_store<62, 64>(su, convT, tid);
        if (tid < 32) { float s = 0.f, q = 0.f;
#pragma unroll
            for (int w = 0; w < 8; ++w) { s += red[w * 64 + tid]; q += red[w * 64 + 32 + tid]; }
            const float mean = s * (1.f / D), var = fmaxf(q * (1.f / D) - mean * mean, 0.f); stat[tid] = mean; stat[32 + tid] = 1.f / sqrtf(var + EPS); }
        { const int g = tid >> 7;
          if (g == 0) pool_item<2>(poolT, PL, m0, t0, tid); else if (g == 1) pool_item<4>(poolT, PL, m0, t0, tid); else if (g == 2) pool_item<8>(poolT, PL, m0, t0, tid); else pool_item<16>(poolT, PL, m0, t0, tid); }
        __syncthreads();
#pragma unroll
        for (int ti = 0; ti < 32; ++ti) { const float mean = stat[ti], rstd = stat[32 + ti];
            const float y0 = (a0[ti] - mean) * rstd * gg.x + be.x, y1 = (a1[ti] - mean) * rstd * gg.y + be.y;
            *(unsigned*)(AC + (size_t)(m0 + ti) * D + c0) = pk2(y0 * sigm(y0), y1 * sigm(y1)); }
    }
}

typedef unsigned u32;
template <int CTRL> __device__ __forceinline__ u32 dppu(u32 x) { return (u32)__builtin_amdgcn_update_dpp(0, (int)x, CTRL, 0xf, 0xf, true); }
constexpr int DPP_XOR1 = 0xB1, DPP_REV4 = 0x1B, DPP_DUPE = 0xA0, DPP_DUPO = 0xF5, DPP_HMIRROR = 0x141, DPP_MIRROR = 0x140;
__device__ __forceinline__ u32 umax_(u32 a, u32 b) { return a > b ? a : b; }
__device__ __forceinline__ u32 umin_(u32 a, u32 b) { return a < b ? a : b; }
#define TK_CE(x, i, j) do { const u32 hi_ = umax_(x[i], x[j]), lo_ = umin_(x[i], x[j]); x[i] = hi_; x[j] = lo_; } while (0)
__device__ __forceinline__ void tk_local_merge(u32 (&x)[8]) {
    TK_CE(x, 0, 4); TK_CE(x, 1, 5); TK_CE(x, 2, 6); TK_CE(x, 3, 7);
    TK_CE(x, 0, 2); TK_CE(x, 1, 3); TK_CE(x, 4, 6); TK_CE(x, 5, 7);
    TK_CE(x, 0, 1); TK_CE(x, 2, 3); TK_CE(x, 4, 5); TK_CE(x, 6, 7);
}
template <int CTRL> __device__ __forceinline__ void tk_level(u32 (&x)[8], bool even) {
    u32 t[8];
#pragma unroll
    for (int c = 0; c < 8; ++c) t[c] = dppu<CTRL>(x[7 - c]);
#pragma unroll
    for (int c = 0; c < 8; ++c) x[c] = umax_(x[c], t[c]);
#pragma unroll
    for (int c = 0; c < 8; ++c) { const u32 p = dppu<DPP_XOR1>(x[c]); x[c] = even ? umax_(x[c], p) : umin_(x[c], p); }
    tk_local_merge(x);
}
__device__ __forceinline__ void tk_top16(u32 (&x)[8], bool even) {
    TK_CE(x, 0, 1); TK_CE(x, 2, 3); TK_CE(x, 4, 5); TK_CE(x, 6, 7);
    TK_CE(x, 0, 2); TK_CE(x, 1, 3); TK_CE(x, 4, 6); TK_CE(x, 5, 7);
    TK_CE(x, 1, 2); TK_CE(x, 5, 6);
    TK_CE(x, 0, 4); TK_CE(x, 1, 5); TK_CE(x, 2, 6); TK_CE(x, 3, 7);
    TK_CE(x, 2, 4); TK_CE(x, 3, 5);
    TK_CE(x, 1, 2); TK_CE(x, 3, 4); TK_CE(x, 5, 6);
    { u32 t[8];
#pragma unroll
      for (int c = 0; c < 8; ++c) t[c] = dppu<DPP_XOR1>(x[7 - c]);
#pragma unroll
      for (int c = 0; c < 8; ++c) x[c] = even ? umax_(x[c], t[c]) : umin_(x[c], t[c]); }
    tk_local_merge(x);
    tk_level<DPP_REV4>(x, even); tk_level<DPP_HMIRROR>(x, even); tk_level<DPP_MIRROR>(x, even);
}
__device__ __forceinline__ u32 tk_f2key(float v, int slot) { const u32 u = __builtin_bit_cast(u32, v); const u32 k = u ^ ((u32)((int)u >> 31) | 0x80000000u); return (k & ~127u) | (u32)(127 - slot); }
__device__ __forceinline__ float tk_key2f(u32 k) { k &= ~127u; const u32 m = (u32)((int)k >> 31); return __builtin_bit_cast(float, k ^ (~m | 0x80000000u)); }
__device__ __forceinline__ u32 tk_sel8v(u32 r0, u32 r1, u32 r2, u32 r3, u32 r4, u32 r5, u32 r6, u32 r7, int idx) {
    const bool b0 = idx & 1, b1 = idx & 2, b2 = idx & 4;
    const u32 s01 = b0 ? r1 : r0, s23 = b0 ? r3 : r2, s45 = b0 ? r5 : r4, s67 = b0 ? r7 : r6;
    const u32 s03 = b1 ? s23 : s01, s47 = b1 ? s67 : s45;
    return b2 ? s47 : s03; }
#define tk_sel8(r, idx) tk_sel8v(r[0], r[1], r[2], r[3], r[4], r[5], r[6], r[7], idx)
__device__ __forceinline__ void tk2_sort16(u32 (&x)[16]) { TK_CE(x, 0, 1); TK_CE(x, 2, 3); TK_CE(x, 0, 2); TK_CE(x, 1, 3); TK_CE(x, 1, 2); TK_CE(x, 4, 5); TK_CE(x, 6, 7); TK_CE(x, 4, 6); TK_CE(x, 5, 7); TK_CE(x, 5, 6); TK_CE(x, 0, 4); TK_CE(x, 2, 6); TK_CE(x, 2, 4); TK_CE(x, 1, 5); TK_CE(x, 3, 7); TK_CE(x, 3, 5); TK_CE(x, 1, 2); TK_CE(x, 3, 4); TK_CE(x, 5, 6); TK_CE(x, 8, 9); TK_CE(x, 10, 11); TK_CE(x, 8, 10); TK_CE(x, 9, 11); TK_CE(x, 9, 10); TK_CE(x, 12, 13); TK_CE(x, 14, 15); TK_CE(x, 12, 14); TK_CE(x, 13, 15); TK_CE(x, 13, 14); TK_CE(x, 8, 12); TK_CE(x, 10, 14); TK_CE(x, 10, 12); TK_CE(x, 9, 13); TK_CE(x, 11, 15); TK_CE(x, 11, 13); TK_CE(x, 9, 10); TK_CE(x, 11, 12); TK_CE(x, 13, 14); TK_CE(x, 0, 8); TK_CE(x, 4, 12); TK_CE(x, 4, 8); TK_CE(x, 2, 10); TK_CE(x, 6, 14); TK_CE(x, 6, 10); TK_CE(x, 2, 4); TK_CE(x, 6, 8); TK_CE(x, 10, 12); TK_CE(x, 1, 9); TK_CE(x, 5, 13); TK_CE(x, 5, 9); TK_CE(x, 3, 11); TK_CE(x, 7, 15); TK_CE(x, 7, 11); TK_CE(x, 3, 5); TK_CE(x, 7, 9); TK_CE(x, 11, 13); TK_CE(x, 1, 2); TK_CE(x, 3, 4); TK_CE(x, 5, 6); TK_CE(x, 7, 8); TK_CE(x, 9, 10); TK_CE(x, 11, 12); TK_CE(x, 13, 14); }
__device__ __forceinline__ void tk2_merge16(u32 (&x)[16]) { TK_CE(x, 0, 8); TK_CE(x, 1, 9); TK_CE(x, 2, 10); TK_CE(x, 3, 11); TK_CE(x, 4, 12); TK_CE(x, 5, 13); TK_CE(x, 6, 14); TK_CE(x, 7, 15); TK_CE(x, 0, 4); TK_CE(x, 1, 5); TK_CE(x, 2, 6); TK_CE(x, 3, 7); TK_CE(x, 8, 12); TK_CE(x, 9, 13); TK_CE(x, 10, 14); TK_CE(x, 11, 15); TK_CE(x, 0, 2); TK_CE(x, 1, 3); TK_CE(x, 4, 6); TK_CE(x, 5, 7); TK_CE(x, 8, 10); TK_CE(x, 9, 11); TK_CE(x, 12, 14); TK_CE(x, 13, 15); TK_CE(x, 0, 1); TK_CE(x, 2, 3); TK_CE(x, 4, 5); TK_CE(x, 6, 7); TK_CE(x, 8, 9); TK_CE(x, 10, 11); TK_CE(x, 12, 13); TK_CE(x, 14, 15); }
template <int CTRL> __device__ __forceinline__ void tk2_level(u32 (&x)[16]) {
    u32 t[16];
#pragma unroll
    for (int c = 0; c < 16; ++c) t[c] = dppu<CTRL>(x[15 - c]);
#pragma unroll
    for (int c = 0; c < 16; ++c) x[c] = umax_(x[c], t[c]);
    tk2_merge16(x);
}
__device__ __forceinline__ void tk2_top16(u32 (&x)[16]) { tk2_sort16(x); tk2_level<DPP_XOR1>(x); tk2_level<DPP_REV4>(x); tk2_level<DPP_HMIRROR>(x); }
__device__ __forceinline__ u32 tk_sel16v(u32 r0, u32 r1, u32 r2, u32 r3, u32 r4, u32 r5, u32 r6, u32 r7, u32 r8, u32 r9, u32 r10, u32 r11, u32 r12, u32 r13, u32 r14, u32 r15, int idx) {
    const u32 lo = tk_sel8v(r0, r1, r2, r3, r4, r5, r6, r7, idx & 7), hi = tk_sel8v(r8, r9, r10, r11, r12, r13, r14, r15, idx & 7); return (idx & 8) ? hi : lo; }
__device__ __forceinline__ float tk_key2f_h(u32 k) { const u32 kk = k & 0xffff0000u, m = (u32)((int)kk >> 31); const u32 hb = kk ^ (0x80000000u | (~m & 0x7fff0000u));
    return (float)__builtin_bit_cast(f16x2, hb).y; }
__device__ __forceinline__ u32 tk_sel4v(u32 a0, u32 a1, u32 a2, u32 a3, int idx) { const u32 s01 = (idx & 1) ? a1 : a0, s23 = (idx & 1) ? a3 : a2; return (idx & 2) ? s23 : s01; }
__device__ __forceinline__ void tk4_half(const LAS unsigned char* trow, int chunk0, int sw, int r, u32 (&y)[16]) {
    typedef short s16x2 __attribute__((ext_vector_type(2)));
    u32 lo[16], hi[16];
#pragma unroll
    for (int c4 = 0; c4 < 4; ++c4) { const u32x4 v = *(const LAS u32x4*)(trow + (((chunk0 + c4) ^ sw) << 4));
#pragma unroll
        for (int c = 0; c < 4; ++c) { const u32 vc = v[c]; const int e = 8 * c4 + 2 * c;
            const u32 mv = __builtin_bit_cast(u32, __builtin_bit_cast(s16x2, vc) >> (s16x2){15, 15});
            const u32 tv = vc ^ (mv | 0x80008000u), s0 = (u32)(127 - (32 * r + e)), s1 = s0 - 1u;
            if (e < 16) { lo[e] = (tv << 16) | s0; lo[e + 1] = (tv & 0xffff0000u) | s1; } else { hi[e - 16] = (tv << 16) | s0; hi[e - 15] = (tv & 0xffff0000u) | s1; } } }
    tk2_sort16(lo); tk2_sort16(hi);
#pragma unroll
    for (int c = 0; c < 16; ++c) y[c] = umax_(lo[c], hi[15 - c]);
    tk2_merge16(y); tk2_level<DPP_XOR1>(y); tk2_level<DPP_REV4>(y);
}
__device__ __forceinline__ u32 tk4_ckey(float v, u32 ia7, u32 ib, bool valid) {
    const u32 fx = umin_((u32)fmaxf((v + 64.f) * 2048.f, 0.f), 0x3ffffu); return valid ? ((fx << 14) | ia7 | ib) : 0u; }
__device__ __forceinline__ void phase_topk(const Ctx& C, const Args& a, const pg8::Unit un, const int wi0, const int wi1) {
    int* EID = (int*)(a.ws + WS_EID);
    const int lane = C.lane, r = lane & 3, qd = lane >> 2;
    for (int wi = wi0; wi < wi1; wi += NWAVES) {
        const int rl = wi * 16 + qd, tok = un.pm * 256 + rl, h = un.pn;
        u32 ya[16], yb[16];
        { const LAS unsigned char* trow = C.lds + rl * 512; tk4_half(trow, 4 * r, rl & 31, r, ya); tk4_half(trow, 16 + 4 * r, rl & 31, r, yb); }
        const u32 kb0 = tk_sel4v(yb[0], yb[1], yb[2], yb[3], r), kb1 = tk_sel4v(yb[4], yb[5], yb[6], yb[7], r), kb2 = tk_sel4v(yb[8], yb[9], yb[10], yb[11], r), kb3 = tk_sel4v(yb[12], yb[13], yb[14], yb[15], r);
        const float vb0 = tk_key2f_h(kb0), vb1 = tk_key2f_h(kb1), vb2 = tk_key2f_h(kb2), vb3 = tk_key2f_h(kb3);
        const u32 ib0 = kb0 & 127u, ib1 = kb1 & 127u, ib2 = kb2 & 127u, ib3 = kb3 & 127u;
        const int limA = (r == 0) ? 15 : (r == 1) ? 7 : (r == 2) ? 4 : 3, limB = (r == 0) ? 2 : 1;
        u32 y[16], l5[5]; float va0 = 0.f; u32 ia0 = 0u;
#pragma unroll
        for (int c = 0; c < 16; ++c) { const float va = tk_key2f_h(ya[c]); const u32 ia7 = (ya[c] & 127u) << 7; if (c == 0) { va0 = va; ia0 = ia7; }
            y[c] = tk4_ckey(va + vb0, ia7, ib0, c <= limA);
            if (c < 3) l5[c] = tk4_ckey(va + vb1, ia7, ib1, c <= limB); }
        l5[3] = tk4_ckey(va0 + vb2, ia0, ib2, true); l5[4] = tk4_ckey(va0 + vb3, ia0, ib3, true);
        TK_CE(l5, 0, 3); TK_CE(l5, 1, 4); TK_CE(l5, 1, 3); TK_CE(l5, 2, 4); TK_CE(l5, 2, 3); TK_CE(l5, 1, 2); TK_CE(l5, 3, 4);
#pragma unroll
        for (int c = 11; c < 16; ++c) y[c] = umax_(y[c], l5[15 - c]);
        tk2_merge16(y); tk2_level<DPP_XOR1>(y);
        { u32 t[16];
#pragma unroll
          for (int c = 0; c < 16; ++c) t[c] = dppu<DPP_REV4>(y[15 - c]);
#pragma unroll
          for (int c = 0; c < 16; ++c) y[c] = umax_(y[c], t[c]); }
        const float fmx = (float)(umax_(y[0], y[15]) >> 14) * (1.f / 2048.f) - 64.f;
        u32 eo[4]; float ex[4];
#pragma unroll
        for (int u = 0; u < 4; ++u) { const u32 x = tk_sel4v(y[u], y[4 + u], y[7 - u], y[3 - u], r);
            eo[u] = (127u - ((x >> 7) & 127u)) * 128u + (127u - (x & 127u)); ex[u] = __expf(((float)(x >> 14) * (1.f / 2048.f) - 64.f) - fmx); }
        float sum = (ex[0] + ex[1]) + (ex[2] + ex[3]);
        sum += __builtin_bit_cast(float, dppu<DPP_XOR1>(__builtin_bit_cast(u32, sum))); sum += __builtin_bit_cast(float, dppu<0x4E>(__builtin_bit_cast(u32, sum)));
        const float inv = 1.f / sum;
        *(u32x4*)(EID + (size_t)tok * 128 + h * 16 + 4 * r) = (u32x4){eo[0] | pkh(0.f, ex[0] * inv), eo[1] | pkh(0.f, ex[1] * inv), eo[2] | pkh(0.f, ex[2] * inv), eo[3] | pkh(0.f, ex[3] * inv)};
    }
}

__device__ __forceinline__ float dot2bf(unsigned w, unsigned x, float acc) { return __builtin_amdgcn_fdot2_f32_bf16(__builtin_bit_cast(bf16x2_t, w), __builtin_bit_cast(bf16x2_t, x), acc, false); }
__device__ __forceinline__ int dot8z(int a, int b) { int d; asm("v_dot8_i32_i4 %0, %1, %2, 0" : "=v"(d) : "v"(a), "v"(b)); return d; }
constexpr int PNB = 8;
__device__ __forceinline__ void phase_peer_a(const Ctx& C, const Args& a, int l) {
    const int x = C.blk & 7, c4 = x & 3, th = x >> 2, wg = (C.blk >> 3) * NWAVES + C.wave, nwg = ((C.nblk + 7 - x) >> 3) * NWAVES;
    const __amdgpu_buffer_rsrc_t UC = __builtin_amdgcn_make_buffer_rsrc(a.ws + WS_UB + ((size_t)l * 4 + c4) * NEXP * 128, 0, NEXP * 128, 0x00020000);
    const int* EID = (const int*)(a.ws + WS_EID); const unsigned char* HQ = a.ws + WS_HQ; unsigned* PD = (unsigned*)(a.ws + WS_PD);
    LAS float* dl = (LAS float*)(C.lds + C.wave * 1024);
    unsigned z_ = 0u; asm volatile("" : "+v"(z_));
    const int lane = (int)__builtin_amdgcn_mbcnt_hi(~0u, __builtin_amdgcn_mbcnt_lo(~0u, z_)), p = lane & 7, g = lane >> 3;
#define PA_META(t_, ev0_, ev1_, r0_, r1_) do { ev0_ = EID[(size_t)(t_) * 128 + lane] & 0x3fff; ev1_ = EID[(size_t)(t_) * 128 + 64 + lane] & 0x3fff; \
        r0_ = *(const u32x4*)(HQ + (size_t)(t_) * 1024 + c4 * 256 + p * 32); r1_ = *(const u32x4*)(HQ + (size_t)(t_) * 1024 + c4 * 256 + p * 32 + 16); } while (0)
#define PA_ISSUE(rows_, ev_) do { _Pragma("unroll") for (int j = 0; j < 8; ++j) { const int e = __builtin_amdgcn_ds_bpermute((8 * j + g) << 2, ev_); \
        rows_[j] = __builtin_bit_cast(u32x4, __builtin_amdgcn_raw_buffer_load_b128(UC, e * 128 + 16 * p, 0, 0)); } } while (0)
#define PA_HALF(rows_, off_) do { _Pragma("unroll") for (int j = 0; j < 8; ++j) { \
            int ah = dot8z((int)rows_[j].x, (int)hqh.x); ah = __builtin_amdgcn_sdot8((int)rows_[j].y, (int)hqh.y, ah, false); \
            ah = __builtin_amdgcn_sdot8((int)rows_[j].z, (int)hqh.z, ah, false); ah = __builtin_amdgcn_sdot8((int)rows_[j].w, (int)hqh.w, ah, false); \
            int al = dot8z((int)rows_[j].x, (int)hql.x); al = __builtin_amdgcn_sdot8((int)rows_[j].y, (int)hql.y, al, false); \
            al = __builtin_amdgcn_sdot8((int)rows_[j].z, (int)hql.z, al, false); al = __builtin_amdgcn_sdot8((int)rows_[j].w, (int)hql.w, al, false); \
            int acc = (ah << 4) + al; \
            acc += __builtin_amdgcn_update_dpp(0, acc, 0xB1, 0xf, 0xf, true); acc += __builtin_amdgcn_update_dpp(0, acc, 0x4E, 0xf, 0xf, true); acc += __builtin_amdgcn_update_dpp(0, acc, 0x141, 0xf, 0xf, true);   \
            tot[(off_) + j] = (float)acc; } } while (0)
    int evA0, evA1, evB0, evB1; u32x4 hA0, hA1, hB0, hB1, rows0[8], rows1[8];
#define PA_TOKEN(ev0_, ev1_, h0_, h1_, tcur_, tload_, evn0_) do { \
        const u32x4 hqh = h0_, hql = h1_;             \
        PA_ISSUE(rows1, ev1_);                        \
        PA_META(tload_, ev0_, ev1_, h0_, h1_);        \
        __builtin_amdgcn_sched_barrier(0);            \
        float tot[16]; \
        PA_HALF(rows0, 0); \
        __builtin_amdgcn_sched_barrier(0); \
        PA_ISSUE(rows0, evn0_);                       \
        __builtin_amdgcn_sched_barrier(0); \
        PA_HALF(rows1, 8); \
        __builtin_amdgcn_sched_barrier(0); \
        if (p == 0) { _Pragma("unroll") for (int j = 0; j < 16; ++j) dl[8 * j + g] = tot[j]; } \
        asm volatile("s_waitcnt lgkmcnt(0)" ::: "memory"); \
        const float d0 = dl[lane], d1 = dl[64 + lane]; \
        if ((tcur_) < M) PD[((size_t)(tcur_) * 4 + c4) * 64 + lane] = pkh(d0 * 0.015625f, d1 * 0.015625f); \
        asm volatile("s_waitcnt lgkmcnt(0)" ::: "memory");   } while (0)
    constexpr int MH = M / 2;
    int i = wg;
    { const int ic = i < MH ? i : 0; PA_META(2 * ic + th, evA0, evA1, hA0, hA1); }
    { const int ic = i + nwg < MH ? i + nwg : 0; PA_META(2 * ic + th, evB0, evB1, hB0, hB1); }
    PA_ISSUE(rows0, evA0);
#pragma nounroll
    for (; i < MH; i += 2 * nwg) {
        const int i1 = i + nwg, i2 = i + 2 * nwg, i3 = i + 3 * nwg, c2 = i2 < MH ? i2 : i, c3 = i3 < MH ? i3 : i;
        const int tA = 2 * i + th, tB = i1 < MH ? 2 * i1 + th : M;
        PA_TOKEN(evA0, evA1, hA0, hA1, tA, 2 * c2 + th, evB0);
        PA_TOKEN(evB0, evB1, hB0, hB1, tB, 2 * c3 + th, evA0);
    }
#undef PA_TOKEN
#undef PA_META
#undef PA_ISSUE
#undef PA_HALF
}
template <bool TR> __device__ __forceinline__ void phase_peer_c(const Ctx& C, const Args& a, int l) {
    const float* USC = (const float*)(a.ws + WS_USC) + (size_t)l * NEXP * 4; const float* VSC = (const float*)(a.ws + WS_VSC) + (size_t)l * NEXP;
    const int* EID = (const int*)(a.ws + WS_EID); const float* HSC = (const float*)(a.ws + WS_HSC); const float* HSUM = (const float*)(a.ws + WS_HSUM); const unsigned* PD = (const unsigned*)(a.ws + WS_PD);
    unsigned* C8 = (unsigned*)(a.ws + WS_COEF); float* CSC = (float*)(a.ws + WS_CSC);
    LAS float* scr = (LAS float*)(C.lds + C.wave * 16384); int trj = C.gw;
    for (int t0 = 4 * C.gw; t0 < M; t0 += 4 * C.ngw) {
        TrItem ti; f32x4 tv[8]; bool tdo = false;
        if (TR) { tdo = trj < TR_L; const bool ok = tr_item(a, 1, tdo ? trj : 0, ti); tdo = tdo && ok && tr_deferred(trj); tr_load(ti, C.lane, tv); trj += C.ngw; }
        unsigned pw[4][4]; int ev[4][2]; float gv[4][2], vs[4][2], hs[4]; f32x4 us[4][2], hsum[4];
#pragma unroll
        for (int i = 0; i < 4; ++i) { const int t = t0 + i; hs[i] = HSC[t]; hsum[i] = *(const f32x4*)(HSUM + (size_t)t * 4);
#pragma unroll
            for (int u = 0; u < 2; ++u) { const unsigned wv = (unsigned)EID[(size_t)t * 128 + 64 * u + C.lane]; ev[i][u] = (int)(wv & 0x3fffu); gv[i][u] = (float)__builtin_bit_cast(f16x2, wv).y; }
#pragma unroll
            for (int xx = 0; xx < 4; ++xx) pw[i][xx] = PD[((size_t)t * 4 + xx) * 64 + C.lane]; }
#pragma unroll
        for (int i = 0; i < 4; ++i) {
#pragma unroll
            for (int u = 0; u < 2; ++u) { us[i][u] = *(const f32x4*)(USC + (size_t)ev[i][u] * 4); vs[i][u] = VSC[ev[i][u]]; } }
        __builtin_amdgcn_sched_barrier(0);
#pragma unroll
        for (int i = 0; i < 4; ++i) { const int t = t0 + i; float cf[2], dsum[2] = {0.f, 0.f};
#pragma unroll
            for (int xx = 0; xx < 4; ++xx) { const unsigned w = pw[i][xx]; const f16x2 hv = __builtin_bit_cast(f16x2, w); const float hh = 0.5f * hsum[i][xx];
                dsum[0] += us[i][0][xx] * ((float)hv.x * 64.f + hh); dsum[1] += us[i][1][xx] * ((float)hv.y * 64.f + hh); }
#pragma unroll
            for (int u = 0; u < 2; ++u) { const float dd = dsum[u] * hs[i]; cf[u] = vs[i][u] * gv[i][u] * 0.5f * dd * (1.f + erff(dd * 0.70710678118654752f)); }
            const float am = wave_max(fmaxf(fabsf(cf[0]), fabsf(cf[1]))), inv = am > 0.f ? 119.f / am : 0.f;
            const int k0 = (int)rintf(cf[0] * inv), k1 = (int)rintf(cf[1] * inv);
            const float ksum = wave_sum((float)(k0 + k1));
            { const int sh = 4 * (C.lane & 7); u32x4 w = (u32x4){((unsigned)k0 & 15u) << sh, ((unsigned)((k0 + 8) >> 4) & 15u) << sh, ((unsigned)k1 & 15u) << sh, ((unsigned)((k1 + 8) >> 4) & 15u) << sh};
#pragma unroll
              for (int c = 0; c < 4; ++c) { unsigned v = w[c]; v |= dppu<DPP_XOR1>(v); v |= dppu<0x4E>(v); v |= dppu<DPP_HMIRROR>(v); w[c] = v; }
              if ((C.lane & 7) == 0) { *(u32x2*)(C8 + (size_t)t * 32 + 2 * (C.lane >> 3)) = (u32x2){w.x, w.y}; *(u32x2*)(C8 + (size_t)t * 32 + 16 + 2 * (C.lane >> 3)) = (u32x2){w.z, w.w}; } }
            if (C.lane == 0) { const float cs = am * (1.f / 119.f); *(f32x2*)(CSC + (size_t)t * 2) = (f32x2){cs, 0.5f * cs * ksum}; } }
        if (TR && tdo) tr_finish(ti, C.lane, tv, scr);
    }
    if (TR) for (; trj < TR_L; trj += C.ngw) { TrItem ti; f32x4 tv[8]; if (tr_item(a, 1, trj, ti) && tr_deferred(trj)) { tr_load(ti, C.lane, tv); tr_finish(ti, C.lane, tv, scr); } }
}
__device__ __forceinline__ void phase_peer_b(const Ctx& C, const Args& a, int l) {
    typedef int v2i32_t __attribute__((ext_vector_type(2)));
    const int x = C.blk & 7, c4 = x & 3, th = x >> 2, wg = (C.blk >> 3) * NWAVES + C.wave, nwg = ((C.nblk + 7 - x) >> 3) * NWAVES;
    const unsigned char* VB = a.ws + WS_VB + ((size_t)l * 4 + c4) * NEXP * 128;
    const int* EID = (const int*)(a.ws + WS_EID); const int* C8 = (const int*)(a.ws + WS_COEF); const float* CSC = (const float*)(a.ws + WS_CSC); bf16* XW = (bf16*)(a.ws + WS_XB);
    LAS unsigned char* wlA = C.lds + C.wave * 16384; LAS unsigned char* wlB = wlA + 8192;
    unsigned z_ = 0u; asm volatile("" : "+v"(z_));
    const int lane = (int)__builtin_amdgcn_mbcnt_hi(~0u, __builtin_amdgcn_mbcnt_lo(~0u, z_)), p = lane & 7, g = lane >> 3;
    const int q = lane >> 4, r = lane & 15;
    const unsigned pcE = 16u * (p ^ (g >> 1)), pcO = 16u * (p ^ (4 + (g >> 1)));
    unsigned rofs[4];
#pragma unroll
    for (int u = 0; u < 4; ++u) { const int blk = 4 * u + q; rofs[u] = 128u * r + 16u * ((blk >> 1) ^ (r >> 1)) + 8u * (blk & 1); }
    const int cbA = 16 * q + (r & 14) + ((lane & 1) ? 128 : 0);
    unsigned ra[4];
#pragma unroll
    for (int u = 0; u < 4; ++u) ra[u] = (unsigned)(size_t)wlA + rofs[u];
#define PB_META(t_, ev0_, ev1_, cf_) do { ev0_ = EID[(size_t)(t_) * 128 + lane] & 0x3fff; ev1_ = EID[(size_t)(t_) * 128 + 64 + lane] & 0x3fff; cf_ = C8[(size_t)(t_) * 32 + (lane & 31)]; } while (0)
#define PB_ISSUE(buf_, ev_) do { asm volatile("s_waitcnt lgkmcnt(0)" ::: "memory");   \
        _Pragma("unroll") for (int j = 0; j < 8; ++j) { const int e = __builtin_amdgcn_ds_bpermute((8 * j + g) << 2, ev_); \
        __builtin_amdgcn_global_load_lds((const unsigned*)(VB + (size_t)(unsigned)(e * 128) + ((j & 1) ? pcO : pcE)), (LAS unsigned*)(buf_ + 1024 * j), 16, 0, 0); } } while (0)
#define PB_TR4(dst_, addr_, off_) asm volatile("ds_read_b64_tr_b4 %0, %1 offset:%2" : "=v"(dst_) : "v"(addr_), "n"(off_))
#define PB_HALF(bo_, h_, cf_) do { v2i32_t tv[4][4]; \
        _Pragma("unroll") for (int T = 0; T < 4; ++T) { _Pragma("unroll") for (int u = 0; u < 4; ++u) PB_TR4(tv[T][u], ra[u], (bo_) + 2048 * T); } \
        asm volatile("s_waitcnt lgkmcnt(0)" : "+v"(tv[0][0]), "+v"(tv[0][1]), "+v"(tv[0][2]), "+v"(tv[0][3]), "+v"(tv[1][0]), "+v"(tv[1][1]), "+v"(tv[1][2]), "+v"(tv[1][3]), \
                                              "+v"(tv[2][0]), "+v"(tv[2][1]), "+v"(tv[2][2]), "+v"(tv[2][3]), "+v"(tv[3][0]), "+v"(tv[3][1]), "+v"(tv[3][2]), "+v"(tv[3][3]) :: "memory");   \
        _Pragma("unroll") for (int T = 0; T < 4; ++T) { const int kl0 = __builtin_amdgcn_readlane(cf_, 16 * (h_) + 4 * T), kh0 = __builtin_amdgcn_readlane(cf_, 16 * (h_) + 4 * T + 1), kl1 = __builtin_amdgcn_readlane(cf_, 16 * (h_) + 4 * T + 2), kh1 = __builtin_amdgcn_readlane(cf_, 16 * (h_) + 4 * T + 3); \
            _Pragma("unroll") for (int u = 0; u < 4; ++u) { const v2i32_t v = tv[T][u]; \
                ol_[u] = __builtin_amdgcn_sdot8(v.x, kl0, ol_[u], false); ol_[u] = __builtin_amdgcn_sdot8(v.y, kl1, ol_[u], false); oh_[u] = __builtin_amdgcn_sdot8(v.x, kh0, oh_[u], false); oh_[u] = __builtin_amdgcn_sdot8(v.y, kh1, oh_[u], false); } } \
        } while (0)
    int evA0, evA1, evB0, evB1, cfA, cfB;
    const f32x2 gA0 = *(const f32x2*)(modp(a, l, 0, 5) + 256 * c4 + cbA), gB0 = *(const f32x2*)(modp(a, l, 0, 5) + 256 * c4 + cbA + 64), gA1 = *(const f32x2*)(modp(a, l, 1, 5) + 256 * c4 + cbA), gB1 = *(const f32x2*)(modp(a, l, 1, 5) + 256 * c4 + cbA + 64);
    constexpr int MH = M / 2;
    int i = wg;
    { const int ic = i < MH ? i : 0; PB_META(2 * ic + th, evA0, evA1, cfA); }
    { const int ic = i + nwg < MH ? i + nwg : 0; PB_META(2 * ic + th, evB0, evB1, cfB); }
    unsigned xnA, xnB; f32x2 csn; { const int tc = 2 * (i < MH ? i : 0) + th; xnA = *(const unsigned*)(XW + (size_t)tc * D + 256 * c4 + cbA); xnB = *(const unsigned*)(XW + (size_t)tc * D + 256 * c4 + cbA + 64); csn = *(const f32x2*)(CSC + (size_t)tc * 2); }
    asm volatile("s_waitcnt vmcnt(0)" ::: "memory");
    __builtin_amdgcn_sched_barrier(0);
    PB_ISSUE(wlA, evA0);
    __builtin_amdgcn_sched_barrier(0);
#pragma nounroll
    for (; i < MH; i += nwg) {
        const int t = 2 * i + th, i2 = i + 2 * nwg, c2 = i2 < MH ? i2 : i;
        const int kf = cfA;
        const f32x2 xa = (f32x2){bflo(xnA), bfhi(xnA)}, xb = (f32x2){bflo(xnB), bfhi(xnB)}; const f32x2 cs = csn;
        __builtin_amdgcn_sched_barrier(0);
        __builtin_amdgcn_sched_barrier(0);
        PB_ISSUE(wlB, evA1);
        __builtin_amdgcn_sched_barrier(0);
        asm volatile("s_waitcnt vmcnt(8)" ::: "memory");
        __builtin_amdgcn_sched_barrier(0);
        int ol_[4] = {0, 0, 0, 0}, oh_[4] = {0, 0, 0, 0};
        PB_HALF(0, 0, kf);
        __builtin_amdgcn_sched_barrier(0);
        PB_ISSUE(wlA, evB0);
        __builtin_amdgcn_sched_barrier(0);
        asm volatile("s_waitcnt vmcnt(8)" ::: "memory");
        __builtin_amdgcn_sched_barrier(0);
        evA0 = evB0; evA1 = evB1; cfA = cfB;
        PB_META(2 * c2 + th, evB0, evB1, cfB);
        { const int i1 = i + nwg < MH ? i + nwg : i, t1 = 2 * i1 + th; xnA = *(const unsigned*)(XW + (size_t)t1 * D + 256 * c4 + cbA); xnB = *(const unsigned*)(XW + (size_t)t1 * D + 256 * c4 + cbA + 64); csn = *(const f32x2*)(CSC + (size_t)t1 * 2); }
        __builtin_amdgcn_sched_barrier(0);
        PB_HALF(8192, 1, kf);
        __builtin_amdgcn_sched_barrier(0);
        int val[4];
#pragma unroll
        for (int u = 0; u < 4; ++u) val[u] = (oh_[u] << 4) + ol_[u];
        const bool odd = lane & 1;
        const int r0 = __builtin_amdgcn_update_dpp(0, odd ? val[0] : val[2], 0xB1, 0xf, 0xf, true), r1 = __builtin_amdgcn_update_dpp(0, odd ? val[1] : val[3], 0xB1, 0xf, 0xf, true);
        const f32x2 sA = odd ? (f32x2){(float)r0, (float)val[2]} : (f32x2){(float)val[0], (float)r0}, sB = odd ? (f32x2){(float)r1, (float)val[3]} : (f32x2){(float)val[1], (float)r1};
        const f32x2 gA = (t >> 13) ? gA1 : gA0, gB = (t >> 13) ? gB1 : gB0;
        { const f32x2 oa = xa + gA * (sA * cs.x + cs.y), ob = xb + gB * (sB * cs.x + cs.y);
          *(unsigned*)(XW + (size_t)t * D + 256 * c4 + cbA) = pk2(oa.x, oa.y); *(unsigned*)(XW + (size_t)t * D + 256 * c4 + cbA + 64) = pk2(ob.x, ob.y); }
        __builtin_amdgcn_sched_barrier(0);
    }
    asm volatile("s_waitcnt vmcnt(0)" ::: "memory");
#undef PB_META
#undef PB_ISSUE
#undef PB_HALF
#undef PB_TR4
}
__device__ __forceinline__ void phase_final(const Ctx& C, const Args& a) {
    const bf16* XB = (const bf16*)(a.ws + WS_XB);
    for (int m0 = 4 * C.gw; m0 < M; m0 += 4 * C.ngw) { u32x2 xw[4][4]; f32x4 fg[4];
#pragma unroll
        for (int i = 0; i < 4; ++i) {
#pragma unroll
            for (int j = 0; j < 4; ++j) xw[i][j] = *(const u32x2*)(XB + (size_t)(m0 + i) * D + 4 * C.lane + 256 * j); }
#pragma unroll
        for (int j = 0; j < 4; ++j) fg[j] = *(const f32x4*)(a.in[I_FG] + 4 * C.lane + 256 * j);
        __builtin_amdgcn_sched_barrier(0);
#pragma unroll
        for (int i = 0; i < 4; ++i) { const int m = m0 + i; f32x4 x[4]; float ss = 0.f;
#pragma unroll
            for (int j = 0; j < 4; ++j) { const u32x2 w = xw[i][j]; x[j] = (f32x4){bflo(w.x), bfhi(w.x), bflo(w.y), bfhi(w.y)}; ss += (x[j].x * x[j].x + x[j].y * x[j].y) + (x[j].z * x[j].z + x[j].w * x[j].w); }
            const float rstd = 1.f / sqrtf(wave_sum(ss) * (1.f / D) + EPS);
#pragma unroll
            for (int j = 0; j < 4; ++j) *(f32x4*)(a.out + (size_t)m * D + 4 * C.lane + 256 * j) = x[j] * rstd * fg[j]; }
    }
}

#define GEMM mfma_gemm
#define RLX_AGENT __ATOMIC_RELAXED, __HIP_MEMORY_SCOPE_AGENT
#define XB_TMO      128
#define XB_XCNT(j)  (256  + 64 * (j))
#define XB_XSUB(j)  (1280 + 64 * (j))
#define XB_XGEN(j)  (2304 + 64 * (j))
#define XB_TOP      3328
#define XB_TOPGEN   3392
#define XCD_BAR_WORDS 3456
#define XB_SPIN_CAP (1u << 18)

__device__ __forceinline__ unsigned xb_ld(unsigned* p)              { return __hip_atomic_load(p, __ATOMIC_RELAXED, __HIP_MEMORY_SCOPE_AGENT); }
__device__ __forceinline__ unsigned xb_add(unsigned* p, unsigned v) { return __hip_atomic_fetch_add(p, v, __ATOMIC_RELAXED, __HIP_MEMORY_SCOPE_AGENT); }
__device__ __forceinline__ unsigned xb_xcc_id() { return (unsigned)__builtin_amdgcn_s_getreg((3 << 11) | 20) & 0xFu; }
#define XB_SPIN(cond, bar) do { unsigned _sp = 0; while (cond) { __builtin_amdgcn_s_sleep(1); \
    if ((++_sp & 255u) == 0u) { if (xb_ld(&(bar)[XB_TMO])) break; if (_sp > XB_SPIN_CAP) { atomicAdd(&(bar)[XB_TMO], 1u); break; } } } } while (0)

struct XcdBarrier {
    unsigned* bar; unsigned x;
    volatile LAS unsigned* st;
};

__device__ __forceinline__ XcdBarrier xcd_barrier_post(unsigned* bar, volatile LAS unsigned* st) {
    XcdBarrier b; b.bar = bar; b.x = xb_xcc_id(); b.st = st;
    if (threadIdx.x == 0) (void)xb_add(&bar[XB_XCNT(b.x)], 1u);
    return b;
}
__device__ __forceinline__ void xcd_barrier_complete(unsigned* bar, unsigned x, unsigned& nloc, unsigned& nx) {
    const unsigned G = gridDim.x * gridDim.y * gridDim.z;
    unsigned sum, cnt, mine, sp = 0u;
    for (;;) {
        sum = 0u; cnt = 0u; mine = 0u;
#pragma unroll
        for (unsigned j = 0; j < 16; ++j) { const unsigned c = xb_ld(&bar[XB_XCNT(j)]); sum += c; cnt += (c > 0u) ? 1u : 0u; mine = (j == x) ? c : mine; }
        if (sum == G) break;
        __builtin_amdgcn_s_sleep(1);
        if ((++sp & 255u) == 0u) { if (xb_ld(&bar[XB_TMO])) break; if (sp > XB_SPIN_CAP) { atomicAdd(&bar[XB_TMO], 1u); break; } }
    }
    nloc = mine > 0u ? mine : 1u; nx = cnt > 0u ? cnt : 1u;
}

__device__ __forceinline__ void xcd_barrier(const XcdBarrier& b, const int tid_) {
    asm volatile("s_waitcnt vmcnt(0)" ::: "memory");
    __syncthreads();
    if (tid_ == 0) {
        unsigned* bar = b.bar;
        __builtin_amdgcn_s_waitcnt(0);
        unsigned nloc = b.st[0], nx = b.st[1];
        if (nloc == 0u) { xcd_barrier_complete(bar, b.x, nloc, nx); b.st[0] = nloc; b.st[1] = nx; }
        const unsigned old = xb_add(&bar[XB_XSUB(b.x)], 1u);
        const unsigned gen = old / nloc;
        if (old + 1u == (gen + 1u) * nloc) {
            __builtin_amdgcn_fence(__ATOMIC_RELEASE, "agent");
            asm volatile("s_waitcnt vmcnt(0)" ::: "memory");
            (void)xb_add(&bar[XB_TOP], 1u);
            XB_SPIN(xb_ld(&bar[XB_TOP]) < (gen + 1u) * nx, bar);
            __builtin_amdgcn_fence(__ATOMIC_ACQUIRE, "agent");
            xb_add(&bar[XB_XGEN(b.x)], 1u);
            asm volatile("s_waitcnt vmcnt(0)" ::: "memory");
        } else {
            XB_SPIN(xb_ld(&bar[XB_XGEN(b.x)]) == gen, bar);
            __builtin_amdgcn_fence(__ATOMIC_ACQUIRE, "agent");
            asm volatile("s_waitcnt vmcnt(0)" ::: "memory");
        }
    }
    __syncthreads();
}

constexpr int CW_BAR = 4096;
constexpr size_t CTL_ZERO_BYTES = 65536;
constexpr int LDSCTL_OFF = 131072, MISC_OFF = LDSCTL_OFF + 320;
constexpr int PH_PREP = 0, PH_MODR = 1, PH_N1 = 2, PH_L0 = 3, PH_PER_LAYER = 10, N_PHASES = PH_L0 + DEPTH * PH_PER_LAYER;
__device__ __forceinline__ Ctx make_ctx(LAS unsigned char* lds, int wave_s) {
    unsigned z_ = 0u; asm volatile("" : "+v"(z_));
    int tid_ = (wave_s << 6) | (int)__builtin_amdgcn_mbcnt_hi(~0u, __builtin_amdgcn_mbcnt_lo(~0u, z_)); asm volatile("" : "+v"(tid_));
    Ctx C; C.tid = tid_; C.lane = C.tid & 63; C.wave = __builtin_amdgcn_readfirstlane(C.tid >> 6); C.nblk = gridDim.x; C.blk = blockIdx.x;
    C.gw = C.blk * NWAVES + C.wave; C.ngw = C.nblk * NWAVES; C.lds = lds; return C;
}
#define PH(k, ...) if (a.ph_lo <= (k) && (k) < a.ph_hi) { { const Ctx C = make_ctx(lds, wave_s); __VA_ARGS__; } if ((k) + 1 < a.ph_hi) xcd_barrier(bar, make_ctx(lds, wave_s).tid); }
constexpr int CW_XID = 7680, CW_PSYNC = 8192;
__device__ __forceinline__ void panel_of(const Ctx& C, int& P, int& s) { pg8::StaticOrder SO; SO.init(M, D, C.nblk, C.blk); pg8::Unit un; SO.next(0, un); P = un.pm; s = un.pn; }
__device__ __forceinline__ void norm_rows(const Ctx& C, int& mb, int& ms, int& me) {
    if (C.nblk == 256) { int P, s; panel_of(C, P, s); mb = 256 * P + 64 * s + 4 * C.wave; ms = 32; me = 256 * P + 64 * s + 64; } else { mb = 4 * C.gw; ms = 4 * C.ngw; me = M; } }
__device__ __forceinline__ void cp_items(const Ctx& C, int& i0, int& is, int& ie) {
    if (C.nblk == 256) { int P, s; panel_of(C, P, s); i0 = 8 * P + 2 * s; is = 1; ie = i0 + 2; } else { i0 = C.blk; is = C.nblk; ie = M / 32; } }
__device__ __forceinline__ void panel_setup(const Ctx& C, const Args& a, LAS unsigned char* lds) {
    if (C.tid == 0 && C.nblk == 256) { const unsigned* xid = (const unsigned*)(a.ws + WS_CTL) + CW_XID; const int b0 = C.blk & 63;
        const unsigned x0 = xid[b0], x1 = xid[b0 + 64], x2 = xid[b0 + 128], x3 = xid[b0 + 192];
        ((volatile LAS unsigned*)(lds + MISC_OFF))[12] = (x0 != 0u && x0 == x1 && x1 == x2 && x2 == x3) ? 1u : 2u;
        int P, s; panel_of(C, P, s); unsigned nx = 2u;
        if ((P & 31) != 31) { const int Q = P + 1, c0 = (Q >> 3) + 8 * (Q & 7); nx = (xid[c0] == x0 && xid[c0 + 64] == x0 && xid[c0 + 128] == x0 && xid[c0 + 192] == x0) ? 1u : 2u; }
        ((volatile LAS unsigned*)(lds + MISC_OFF))[13] = nx; } }
__device__ __forceinline__ void panel_sync_halo(const Args& a, LAS unsigned char* lds, int idx, const Ctx& C) {
    asm volatile("s_waitcnt vmcnt(0)" ::: "memory");
    __syncthreads();
    if (C.tid == 0) {
        __builtin_amdgcn_s_waitcnt(0);
        int P, s; panel_of(C, P, s);
        unsigned* ctl = (unsigned*)(a.ws + WS_CTL); volatile LAS unsigned* misc = (volatile LAS unsigned*)(lds + MISC_OFF);
        const bool local = misc[12] == 1u && ((P & 31) == 31 || misc[13] == 1u);
        if (!local) { __builtin_amdgcn_fence(__ATOMIC_RELEASE, "agent"); asm volatile("s_waitcnt vmcnt(0)" ::: "memory"); }
        unsigned* w = ctl + CW_PSYNC + (idx * 64 + P) * 8;
        (void)xb_add(w, 1u);
        XB_SPIN(xb_ld(w) < 4u, ctl + CW_BAR);
        if ((P & 31) != 0) XB_SPIN(xb_ld(w - 8) < 4u, ctl + CW_BAR);
        __builtin_amdgcn_fence(__ATOMIC_ACQUIRE, "agent");
        asm volatile("s_waitcnt vmcnt(0)" ::: "memory");
    }
    __syncthreads();
}
#define PHH(k, idx, ...) if (a.ph_lo <= (k) && (k) < a.ph_hi) { { const Ctx C = make_ctx(lds, wave_s); __VA_ARGS__; } if ((k) + 1 < a.ph_hi) { const Ctx Cs = make_ctx(lds, wave_s); if (Cs.nblk == 256) panel_sync_halo(a, lds, idx, Cs); else xcd_barrier(bar, Cs.tid); } }
__device__ __forceinline__ void panel_sync(const Args& a, LAS unsigned char* lds, int idx, const Ctx& C) {
    asm volatile("s_waitcnt vmcnt(0)" ::: "memory");
    __syncthreads();
    if (C.tid == 0) {
        __builtin_amdgcn_s_waitcnt(0);
        int P, s; panel_of(C, P, s);
        unsigned* ctl = (unsigned*)(a.ws + WS_CTL);
        if (((volatile LAS unsigned*)(lds + MISC_OFF))[12] != 1u) { __builtin_amdgcn_fence(__ATOMIC_RELEASE, "agent"); asm volatile("s_waitcnt vmcnt(0)" ::: "memory"); }
        unsigned* w = ctl + CW_PSYNC + (idx * 64 + P) * 8;
        (void)xb_add(w, 1u);
        XB_SPIN(xb_ld(w) < 4u, ctl + CW_BAR);
        __builtin_amdgcn_fence(__ATOMIC_ACQUIRE, "agent");
        asm volatile("s_waitcnt vmcnt(0)" ::: "memory");
    }
    __syncthreads();
}
#define PHP(k, idx, ...) if (a.ph_lo <= (k) && (k) < a.ph_hi) { { const Ctx C = make_ctx(lds, wave_s); __VA_ARGS__; } if ((k) + 1 < a.ph_hi) { const Ctx Cs = make_ctx(lds, wave_s); if (Cs.nblk == 256) panel_sync(a, lds, idx, Cs); else xcd_barrier(bar, Cs.tid); } }
template <int l>
__device__ __forceinline__ void run_layer(const Args& a, LAS unsigned char* lds, const XcdBarrier& bar, const int wave_s) {
    unsigned char* ws = a.ws; constexpr int B0 = PH_L0 + l * PH_PER_LAYER;
    PHH(B0 + 0, 10 + l, EpiIn E{a.in[I_BIN] + (size_t)l * DIN, (const float*)(ws + WS_BP) + (size_t)l * 1024, (unsigned char*)(ws + WS_UG), (unsigned char*)(ws + WS_ZP), (unsigned char*)(ws + WS_G)};
               GEMM(C, (const bf16*)(ws + WS_H), D, 0, (const bf16*)(ws + WS_WIN) + (size_t)l * DIN * D, D, M, DIN, D, E))
    PHP(B0 + 1, 5 * l + 1, int i0, is, ie; cp_items(C, i0, is, ie); phase_convpool(C, a, l, i0, is, ie))
    PHP(B0 + 2, 5 * l + 2, EpiConv E{(const unsigned char*)(ws + WS_G), (const unsigned char*)(ws + WS_PL), a.in[I_POOLS] + (size_t)l * D, (bf16*)(ws + WS_Y)};
               GEMM(C, (const bf16*)(ws + WS_AC), D, 0, (const bf16*)(ws + WS_WCO) + (size_t)l * D * D, D, M, D, D, E))
    PHP(B0 + 3, 5 * l + 3, EpiOut E{l == 0 ? a.in[I_X] : nullptr, (const bf16*)(ws + WS_XB), (bf16*)(ws + WS_XB), modp(a, l, 0, 2), a.in[I_BOUT] + (size_t)l * D};
               GEMM(C, (const bf16*)(ws + WS_Y), D, 0, (const bf16*)(ws + WS_WOUT) + (size_t)l * D * D, D, M, D, D, E))
    PHP(B0 + 4, 5 * l + 4, int mb, ms, me; norm_rows(C, mb, ms, me); phase_norm<false>(C, a, nullptr, (const bf16*)(ws + WS_XB), a.in[I_N2G] + (size_t)l * D, l, 3, 4, (float*)(ws + WS_HSC), mb, ms, me))
    PH(B0 + 5, { pg8::StaticOrder SO; SO.init(M, DQ, C.nblk, C.blk); pg8::Unit un;
                 int ui = 0;
                 for (; SO.next(ui, un); ++ui) { const Ctx C2 = make_ctx(lds, wave_s);
                     { pg8::Gemm g{(const bf16*)(ws + WS_H), (const bf16*)(ws + WS_WQ) + (size_t)l * DQ * D, M, DQ, D, D, D, 0, 0}; pg8::OneUnit OU{SO, ui}; pg8::EpiSLds E;
                       pg8::gemm_phase<pg8::EpiSLds, pg8::OneUnit, true, true>(C2.lds, g, OU, E, C2.tid); }
                     asm volatile("s_waitcnt lgkmcnt(0)" ::: "memory"); __syncthreads();
                     { const Ctx C3 = make_ctx(lds, wave_s);
                       { const int st = ui * C3.ngw + C3.gw; const bool qa = st < NEXP / 4; const int qrow = l * NEXP + 4 * (qa ? st : 0); f32x4 qv[4][4];
                         quant_load(C3, a.in[I_PU], qrow, qv); phase_topk(C3, a, un, C3.wave, 8);
                         if (qa) quant_u_finish(C3, a, qrow, qv);
                         quant_load(C3, a.in[I_PV], qrow, qv); phase_topk(C3, a, un, 8 + C3.wave, 16);
                         if (qa) quant_v_finish(C3, a, qrow, qv); } }
                     asm volatile("s_waitcnt lgkmcnt(0)" ::: "memory"); __syncthreads(); }
                 { const Ctx C4 = make_ctx(lds, wave_s); for (int st = ui * C4.ngw + C4.gw; st < NEXP / 4; st += C4.ngw) { quant_u_rows(C4, a, l * NEXP + 4 * st); quant_v_rows(C4, a, l * NEXP + 4 * st); } } })
    PH(B0 + 6, phase_peer_a(C, a, l))
    PH(B0 + 7, phase_peer_c<(l == 0 && DEPTH > 1)>(C, a, l))
    PH(B0 + 8, phase_peer_b(C, a, l))
    PHP(B0 + 9, 5 * (l + 1), if (l + 1 < DEPTH) { int mb, ms, me; norm_rows(C, mb, ms, me); phase_norm<false>(C, a, nullptr, (const bf16*)(ws + WS_XB), a.in[I_N1G] + (size_t)(l + 1) * D, l + 1, 0, 1, nullptr, mb, ms, me); } else phase_final(C, a))
}
__global__ void __launch_bounds__(NTHREADS, 2) fwd_kernel(Args a) {
    extern __shared__ __attribute__((aligned(16))) unsigned char lds_raw[];
    LAS unsigned char* lds = (LAS unsigned char*)lds_raw;
    for (int u = threadIdx.x; u < (LDS_BYTES - LDSCTL_OFF) / 4; u += NTHREADS) ((LAS unsigned*)(lds + LDSCTL_OFF))[u] = 0u;
    __syncthreads();
    const int wave_s = __builtin_amdgcn_readfirstlane((int)threadIdx.x >> 6);
    const XcdBarrier bar = xcd_barrier_post((unsigned*)(a.ws + WS_CTL) + CW_BAR, (volatile LAS unsigned*)(lds + MISC_OFF) + 8);
    if (threadIdx.x == 0) ((unsigned*)(a.ws + WS_CTL))[CW_XID + blockIdx.x] = bar.x + 1u;
    PH(PH_PREP, phase_prep(C, a))
    PH(PH_MODR, panel_setup(C, a, lds); phase_modreduce(C, a);
              {
                const bool full = C.nblk == 256; const int w0 = full ? (C.blk - 96) * NWAVES + C.wave : C.gw, nw = full ? 160 * NWAVES : C.ngw; LAS float* scr = (LAS float*)(C.lds + C.wave * 16384);
                if (!full || C.blk >= 96) for (int j = w0; j < TR_CO + TR_OUT; j += nw) { TrItem ti; f32x4 tv[8]; tr_item(a, 0, j < TR_CO ? TR_IN + j : TR_IN + TR_CO + TR_PO + (j - TR_CO), ti); tr_load(ti, C.lane, tv); tr_finish(ti, C.lane, tv, scr); }
                asm volatile("s_waitcnt lgkmcnt(0)" ::: "memory"); __syncthreads(); }
              for (int lf = 0; lf < DEPTH; ++lf) { const Ctx C2 = make_ctx(lds, wave_s); EpiWT E{(bf16*)(a.ws + WS_WQ) + (size_t)lf * DQ * D};
                  GEMM(C2, (const bf16*)(a.ws + WS_KEYS) + (size_t)lf * 2048 * 256, 256, 0, (const bf16*)(a.ws + WS_WQB) + (size_t)lf * D * DQ, DQ, DQ, D, 256, E, 256, 32 * lf); }
              for (int lf = 0; lf < DEPTH; ++lf) { const Ctx C2 = make_ctx(lds, wave_s); EpiWT E{(bf16*)(a.ws + WS_WIN) + ((size_t)lf * DIN + 2048) * D};
                  GEMM(C2, (const bf16*)(a.ws + WS_POOL) + (size_t)lf * 1024 * 256, 256, 0, (const bf16*)(a.ws + WS_WPB) + (size_t)lf * D * 1024, 1024, 1024, D, 256, E, 256, 64 + 16 * lf); }
              { const Ctx C2 = make_ctx(lds, wave_s);
                for (int o = C2.gw; o < DEPTH * 1024; o += C2.ngw) { const int lf = o >> 10, n = o & 1023, g = n >> 8, d = n & 255; float sacc = 0.f;
                    for (int u = 0; u < 4; ++u) { const int c = C2.lane + 64 * u; sacc += a.in[I_BIN][(size_t)lf * DIN + 2048 + g * 256 + c] * a.in[I_POOLW][(((size_t)lf * 4 + g) * 256 + c) * 256 + d]; }
                    sacc = wave_sum(sacc); if (C2.lane == 0) ((float*)(a.ws + WS_BP))[o] = sacc; } })
    PHP(PH_N1, 0, int mb, ms, me; norm_rows(C, mb, ms, me); phase_norm<true>(C, a, a.in[I_X], nullptr, a.in[I_N1G], 0, 0, 1, nullptr, mb, ms, me))
    run_layer<0>(a, lds, bar, wave_s);
    run_layer<1>(a, lds, bar, wave_s);
}

extern "C" void kernel_launch(void* const* d_in, const int* in_sizes, int n_in, void* d_out, int out_size, void* d_ws, size_t ws_size, hipStream_t stream) {
    static int grid = 0;
    if (grid == 0) {
        if (n_in != 22 || out_size != M * D || ws_size < WS_END) { fprintf(stderr, "kernel_launch: unexpected shapes (n_in %d out %d ws %zu)\n", n_in, out_size, ws_size); grid = -1; return; }
        int dev = 0, cus = 0;
        if (hipGetDevice(&dev) != hipSuccess || hipDeviceGetAttribute(&cus, hipDeviceAttributeMultiprocessorCount, dev) != hipSuccess) { grid = -1; return; }
        if (hipFuncSetAttribute((const void*)fwd_kernel, hipFuncAttributeMaxDynamicSharedMemorySize, LDS_BYTES) != hipSuccess) { grid = -1; return; }
        grid = cus;
    }
    if (grid < 0) return;
    Args a{};
    for (int i = 0; i < 22; ++i) a.in[i] = (const float*)d_in[i];
    a.out = (float*)d_out; a.ws = (unsigned char*)d_ws;
    (void)hipMemsetAsync((char*)d_ws + WS_CTL, 0, CTL_ZERO_BYTES, stream);
#ifndef ONE_LAUNCH
    for (int ph = 0; ph < N_PHASES; ++ph) { a.ph_lo = ph; a.ph_hi = ph + 1; hipLaunchKernelGGL(fwd_kernel, dim3(grid), dim3(NTHREADS), LDS_BYTES, stream, a); }
#else
    a.ph_lo = 0; a.ph_hi = N_PHASES; hipLaunchKernelGGL(fwd_kernel, dim3(grid), dim3(NTHREADS), LDS_BYTES, stream, a);
#endif
}
```
